# Optimizing an MI355X kernel written in HIP

```python
import numpy as np
import jax
import jax.numpy as jnp
from jax import lax

D_MODEL = 1024
BATCH = 8
SEQ = 2048
DEPTH = 1

RMS_EPS = 1e-6
N_MOD = 6
ROPE_THETA = 500000.0
NEG_INF = -1e30

GLA_HEADS = 4
GLA_DK = D_MODEL // (2 * GLA_HEADS)
GLA_DV = D_MODEL // GLA_HEADS
GLA_RANK = 16
GLA_TAU = 16.0
GLA_CHUNK = 64

NSA_HEADS = 16
NSA_HD = D_MODEL // NSA_HEADS
NSA_GROUPS = 2
NSA_HPG = NSA_HEADS // NSA_GROUPS
ROT_DIM = NSA_HD // 4
CMP_BLOCK = 32
CMP_STRIDE = 16
SEL_BLOCK = 64
SEL_TOPK = 16
WINDOW = 512
ATT_QBLOCK = 128
SEL_QBLOCK = 32
FORCED_SCORE = 1e6

PEER_HEADS = 8
PEER_NKEYS = 128
PEER_NEXPERTS = PEER_NKEYS * PEER_NKEYS
PEER_QDIM = 256
PEER_TOPK = 16
PEER_TOKEN_BLOCK = 128

GLA_QK = GLA_HEADS * GLA_DK
GLA_V = GLA_HEADS * GLA_DV
NSA_Q = NSA_HEADS * NSA_HD
NSA_KV = NSA_GROUPS * NSA_HD
IN_SIZES = (GLA_QK, GLA_QK, GLA_V, GLA_V, GLA_RANK,
            NSA_Q, NSA_KV, NSA_KV, NSA_KV, NSA_KV, NSA_KV, NSA_KV, 3 * NSA_HEADS,
            D_MODEL, D_MODEL)
IN_COLS = sum(IN_SIZES)
IN_OFFSETS = tuple(int(o) for o in np.cumsum(IN_SIZES)[:-1])

kernel_name = 'hybrid_gla_nsa_peer_adaln_block'


def rmsnorm(x, g):
    xf = x.astype(jnp.float32)
    y = xf * lax.rsqrt(jnp.mean(xf * xf, axis=-1, keepdims=True) + RMS_EPS)
    return (y * g.astype(jnp.float32)).astype(x.dtype)


def masked_softmax(s, mask):
    return jax.nn.softmax(jnp.where(mask, s.astype(jnp.float32), NEG_INF), axis=-1)


def rope_partial(t, positions):
    half = ROT_DIM // 2
    inv_freq = jnp.asarray(ROPE_THETA ** (-np.arange(half, dtype=np.float32) * 2.0 / ROT_DIM), dtype=jnp.float32)
    ang = positions.astype(jnp.float32)[..., None] * inv_freq
    cos = jnp.cos(ang)[:, :, None, :]
    sin = jnp.sin(ang)[:, :, None, :]
    tf = t.astype(jnp.float32)
    x1 = tf[..., :half]
    x2 = tf[..., half:ROT_DIM]
    out = jnp.concatenate([x1 * cos - x2 * sin, x2 * cos + x1 * sin, tf[..., ROT_DIM:]], axis=-1)
    return out.astype(t.dtype)


def gla_mixer(q, k, v, r, lr, wa2, ba2, norm_g):
    B, S = q.shape[0], q.shape[1]
    H, DK, DV, C = GLA_HEADS, GLA_DK, GLA_DV, GLA_CHUNK
    nc = S // C
    log_a = jax.nn.log_sigmoid((lr @ wa2 + ba2).astype(jnp.float32)) / GLA_TAU

    def chunks(t, d):
        return t.astype(jnp.float32).reshape(B, nc, C, H, d).transpose(1, 0, 3, 2, 4)

    qs = chunks(q, DK) * (DK ** -0.5)
    kcs = chunks(k, DK)
    vcs = chunks(v, DV)
    acs = chunks(log_a, DK)
    causal = jnp.asarray(np.tril(np.ones((C, C), dtype=bool)))[:, :, None]

    def step(state, xs):
        qc, kc, vc, ac = xs
        b = jnp.cumsum(ac, axis=2)
        diff = b[:, :, :, None, :] - b[:, :, None, :, :]
        decay = jnp.exp(jnp.where(causal, diff, -jnp.inf))
        scores = jnp.einsum('bhtd,bhsd,bhtsd->bhts', qc, kc, decay)
        o = (jnp.einsum('bhts,bhsv->bhtv', scores, vc)
             + jnp.einsum('bhtd,bhdv->bhtv', qc * jnp.exp(b), state))
        b_last = b[:, :, -1:, :]
        state = (jnp.exp(b_last[:, :, 0, :, None]) * state
                 + jnp.einsum('bhsd,bhsv->bhdv', kc * jnp.exp(b_last - b), vc))
        return state, o

    state0 = jnp.zeros((B, H, DK, DV), jnp.float32)
    _, o = lax.scan(step, state0, (qs, kcs, vcs, acs))
    o = o.transpose(1, 0, 3, 2, 4).reshape(B, S, H, DV)
    o = rmsnorm(o, norm_g) * jax.nn.silu(r.astype(jnp.float32).reshape(B, S, H, DV))
    return o.reshape(B, S, H * DV).astype(q.dtype)


def nsa_compressed(q, kc, vc, pe_k, pe_v, ck_w1, ck_w2, cv_w1, cv_w2):
    B, S = q.shape[0], q.shape[1]
    nc = (S - CMP_BLOCK) // CMP_STRIDE + 1
    idx = np.arange(nc)[:, None] * CMP_STRIDE + np.arange(CMP_BLOCK)[None, :]

    def compress(t, pe, w1, w2):
        blk = t[:, idx] + pe[:, None, :]
        blk = blk.transpose(0, 1, 3, 2, 4).reshape(B, nc, NSA_GROUPS, CMP_BLOCK * NSA_HD)
        return jax.nn.gelu(blk @ w1, approximate=False) @ w2

    k_cmp = compress(kc, pe_k, ck_w1, ck_w2)
    v_cmp = compress(vc, pe_v, cv_w1, cv_w2)
    t = np.arange(S)
    blk_end = np.arange(nc) * CMP_STRIDE + CMP_BLOCK - 1
    valid = blk_end[None, :] <= t[:, None]
    has_any = jnp.asarray(valid.any(axis=-1).astype(np.float32))[:, None]
    valid = jnp.asarray(valid)
    s = jnp.einsum('bsghd,bngd->bghsn', q, k_cmp)
    p = masked_softmax(s, valid) * has_any
    o = jnp.einsum('bghsn,bngd->bsghd', p.astype(v_cmp.dtype), v_cmp)
    return o, p.sum(axis=2)


def nsa_select_blocks(imp, S):
    nc = imp.shape[-1]
    ns = S // SEL_BLOCK
    i = np.arange(nc)[:, None]
    j = np.arange(ns)[None, :]
    overlap = ((i * CMP_STRIDE < (j + 1) * SEL_BLOCK) & (i * CMP_STRIDE + CMP_BLOCK > j * SEL_BLOCK))
    score = jnp.einsum('bgsn,nj->bgsj', imp, jnp.asarray(overlap.astype(np.float32)))
    cur = (np.arange(S) // SEL_BLOCK)[:, None]
    forced = jnp.asarray((j == 0) | (j == cur) | (j == cur - 1))
    valid = jnp.asarray(j <= cur)
    score = jnp.where(forced, FORCED_SCORE, jnp.where(valid, score, -1.0))
    _, sel = lax.top_k(score, min(SEL_TOPK, ns))
    return sel


def nsa_selected(q, ks, vs, sel):
    B, S = q.shape[0], q.shape[1]
    G, HPG, HD, L = NSA_GROUPS, NSA_HPG, NSA_HD, SEL_BLOCK
    ns = S // L
    n = sel.shape[-1]
    nq = S // SEL_QBLOCK
    ks_blk = ks.reshape(B, ns, L, G, HD).transpose(0, 3, 1, 2, 4)
    vs_blk = vs.reshape(B, ns, L, G, HD).transpose(0, 3, 1, 2, 4)
    q_ch = q.reshape(B, nq, SEL_QBLOCK, G, HPG, HD).transpose(1, 0, 2, 3, 4, 5)
    sel_ch = sel.reshape(B, G, nq, SEL_QBLOCK, n).transpose(2, 0, 1, 3, 4)
    pos_ch = jnp.arange(S).reshape(nq, SEL_QBLOCK)
    bi = jnp.arange(B)[:, None, None, None]
    gi = jnp.arange(G)[None, :, None, None]

    def body(args):
        qc, ic, tc = args
        kg = ks_blk[bi, gi, ic]
        vg = vs_blk[bi, gi, ic]
        kpos = ic[..., None] * L + jnp.arange(L)
        mask = (kpos <= tc[None, None, :, None, None]).reshape(B, G, 1, SEL_QBLOCK, n * L)
        s = jnp.einsum('bqghd,bgqnld->bghqnl', qc, kg).reshape(B, G, HPG, SEL_QBLOCK, n * L)
        p = masked_softmax(s, mask)
        return jnp.einsum('bghqm,bgqmd->bqghd', p.astype(vg.dtype), vg.reshape(B, G, SEL_QBLOCK, n * L, HD))

    out = lax.map(body, (q_ch, sel_ch, pos_ch))
    return out.transpose(1, 0, 2, 3, 4, 5).reshape(B, S, G, HPG, HD)


def nsa_window(q, kw, vw):
    B, S = q.shape[0], q.shape[1]
    G, HPG, HD, QB = NSA_GROUPS, NSA_HPG, NSA_HD, ATT_QBLOCK
    nb = S // QB
    span = QB + WINDOW
    pad = ((0, 0), (WINDOW, 0), (0, 0), (0, 0))
    kp = jnp.pad(kw, pad)
    vp = jnp.pad(vw, pad)
    q_bl = q.reshape(B, nb, QB, G, HPG, HD).transpose(1, 0, 2, 3, 4, 5)

    def body(args):
        qb, i = args
        start = i * QB
        kb = lax.dynamic_slice_in_dim(kp, start, span, axis=1)
        vb = lax.dynamic_slice_in_dim(vp, start, span, axis=1)
        qpos = start + jnp.arange(QB)
        kpos = start - WINDOW + jnp.arange(span)
        dist = qpos[:, None] - kpos[None, :]
        mask = (dist >= 0) & (dist < WINDOW) & (kpos[None, :] >= 0)
        s = jnp.einsum('bqghd,bkgd->bghqk', qb, kb)
        p = masked_softmax(s, mask)
        return jnp.einsum('bghqk,bkgd->bqghd', p.astype(vb.dtype), vb)

    out = lax.map(body, (q_bl, jnp.arange(nb)))
    return out.transpose(1, 0, 2, 3, 4, 5).reshape(B, S, G, HPG, HD)


def nsa_mixer(q, kc, vc, ks, vs, kw, vw, gates, positions, pe_k, pe_v, ck_w1, ck_w2, cv_w1, cv_w2):
    B, S = q.shape[0], q.shape[1]
    G, HPG, HD = NSA_GROUPS, NSA_HPG, NSA_HD
    q = (rope_partial(q.reshape(B, S, NSA_HEADS, HD), positions) * (HD ** -0.5)).reshape(B, S, G, HPG, HD)
    kc = rope_partial(kc.reshape(B, S, G, HD), positions)
    ks = rope_partial(ks.reshape(B, S, G, HD), positions)
    kw = rope_partial(kw.reshape(B, S, G, HD), positions)
    vc = vc.reshape(B, S, G, HD)
    vs = vs.reshape(B, S, G, HD)
    vw = vw.reshape(B, S, G, HD)
    o_cmp, imp = nsa_compressed(q, kc, vc, pe_k, pe_v, ck_w1, ck_w2, cv_w1, cv_w2)
    sel = nsa_select_blocks(imp, S)
    o_sel = nsa_selected(q, ks, vs, sel)
    o_win = nsa_window(q, kw, vw)
    g = jax.nn.sigmoid(gates.astype(jnp.float32)).reshape(B, S, 3, G, HPG)[..., None]
    o = g[:, :, 0] * o_cmp + g[:, :, 1] * o_sel + g[:, :, 2] * o_win
    return o.reshape(B, S, NSA_HEADS * HD).astype(q.dtype)


def hybrid_mixer(h, positions, w_in, gla_wa2, gla_ba2, gla_norm_g, nsa_pe_k, nsa_pe_v,
                 nsa_ck_w1, nsa_ck_w2, nsa_cv_w1, nsa_cv_w2, w_branch_a, w_branch_b, w_out):
    z = h @ w_in
    (g_q, g_k, g_v, g_r, g_lr, n_q, n_kc, n_vc, n_ks, n_vs, n_kw, n_vw, n_gate,
     merge_a, merge_b) = jnp.split(z, IN_OFFSETS, axis=-1)
    y_a = gla_mixer(g_q, g_k, g_v, g_r, g_lr, gla_wa2, gla_ba2, gla_norm_g)
    y_b = nsa_mixer(n_q, n_kc, n_vc, n_ks, n_vs, n_kw, n_vw, n_gate, positions,
                    nsa_pe_k, nsa_pe_v, nsa_ck_w1, nsa_ck_w2, nsa_cv_w1, nsa_cv_w2)
    m = jax.nn.sigmoid(merge_a) * (y_a @ w_branch_a) + jax.nn.sigmoid(merge_b) * (y_b @ w_branch_b)
    return m @ w_out


def peer_ffn(h, wq, k1, k2, u, v):
    B, S, D = h.shape
    T = B * S
    half = PEER_QDIM // 2
    hf = h.reshape(T, D)
    q = (hf @ wq).reshape(T, PEER_HEADS, PEER_QDIM)
    s1 = jnp.einsum('thd,hnd->thn', q[..., :half], k1).astype(jnp.float32)
    s2 = jnp.einsum('thd,hnd->thn', q[..., half:], k2).astype(jnp.float32)
    v1, i1 = lax.top_k(s1, PEER_TOPK)
    v2, i2 = lax.top_k(s2, PEER_TOPK)
    cand = (v1[..., :, None] + v2[..., None, :]).reshape(T, PEER_HEADS, PEER_TOPK * PEER_TOPK)
    cidx = (i1[..., :, None] * PEER_NKEYS + i2[..., None, :]).reshape(T, PEER_HEADS, PEER_TOPK * PEER_TOPK)
    top_s, pos = lax.top_k(cand, PEER_TOPK)
    eidx = jnp.take_along_axis(cidx, pos, axis=-1)
    gw = jax.nn.softmax(top_s, axis=-1)
    nt = T // PEER_TOKEN_BLOCK

    def body(args):
        hc, ec, gc = args
        a = jax.nn.gelu(jnp.einsum('td,thkd->thk', hc, u[ec]).astype(jnp.float32), approximate=False)
        w = (gc * a).astype(hc.dtype)
        return jnp.einsum('thk,thkd->td', w, v[ec])

    out = lax.map(body, (hf.reshape(nt, PEER_TOKEN_BLOCK, D),
                         eidx.reshape(nt, PEER_TOKEN_BLOCK, PEER_HEADS, PEER_TOPK),
                         gw.reshape(nt, PEER_TOKEN_BLOCK, PEER_HEADS, PEER_TOPK)))
    return out.reshape(B, S, D)


def setup_inputs(seed: int = 0) -> dict:
    key = jax.random.key(seed)
    ks = jax.random.split(key, 32)
    f32 = jnp.float32

    def nrm(k, shape, scale):
        return jax.random.normal(k, shape, f32) * scale

    L, D = DEPTH, D_MODEL
    x = nrm(ks[0], (BATCH, SEQ, D), 1.0)
    c = nrm(ks[1], (BATCH, D), 1.0)
    positions = (jnp.arange(SEQ, dtype=jnp.int32)[None, :]
                 + jax.random.randint(ks[2], (BATCH, 1), 0, 4096, dtype=jnp.int32))
    return {
        'x': x,
        'c': c,
        'positions': positions,
        'ada_w': nrm(ks[3], (L, D, N_MOD * D), 0.5 * D ** -0.5),
        'ada_b': nrm(ks[4], (L, N_MOD * D), 0.02),
        'norm1_g': 1.0 + nrm(ks[5], (L, D), 0.02),
        'norm2_g': 1.0 + nrm(ks[6], (L, D), 0.02),
        'final_g': 1.0 + nrm(ks[7], (D,), 0.02),
        'w_in': nrm(ks[8], (L, D, IN_COLS), D ** -0.5),
        'gla_wa2': nrm(ks[9], (L, GLA_RANK, GLA_QK), GLA_RANK ** -0.5),
        'gla_ba2': nrm(ks[10], (L, GLA_QK), 0.1),
        'gla_norm_g': 1.0 + nrm(ks[11], (L, GLA_DV), 0.02),
        'nsa_pe_k': nrm(ks[12], (L, CMP_BLOCK, NSA_HD), 0.02),
        'nsa_pe_v': nrm(ks[13], (L, CMP_BLOCK, NSA_HD), 0.02),
        'nsa_ck_w1': nrm(ks[14], (L, CMP_BLOCK * NSA_HD, NSA_HD), (CMP_BLOCK * NSA_HD) ** -0.5),
        'nsa_ck_w2': nrm(ks[15], (L, NSA_HD, NSA_HD), NSA_HD ** -0.5),
        'nsa_cv_w1': nrm(ks[16], (L, CMP_BLOCK * NSA_HD, NSA_HD), (CMP_BLOCK * NSA_HD) ** -0.5),
        'nsa_cv_w2': nrm(ks[17], (L, NSA_HD, NSA_HD), NSA_HD ** -0.5),
        'w_branch_a': nrm(ks[18], (L, GLA_V, D), GLA_V ** -0.5),
        'w_branch_b': nrm(ks[19], (L, NSA_Q, D), NSA_Q ** -0.5),
        'w_out': nrm(ks[20], (L, D, D), D ** -0.5),
        'peer_wq': nrm(ks[21], (L, D, PEER_HEADS * PEER_QDIM), D ** -0.5),
        'peer_k1': nrm(ks[22], (L, PEER_HEADS, PEER_NKEYS, PEER_QDIM // 2), (PEER_QDIM // 2) ** -0.5),
        'peer_k2': nrm(ks[23], (L, PEER_HEADS, PEER_NKEYS, PEER_QDIM // 2), (PEER_QDIM // 2) ** -0.5),
        'peer_u': nrm(ks[24], (L, PEER_NEXPERTS, D), D ** -0.5),
        'peer_v': nrm(ks[25], (L, PEER_NEXPERTS, D), 0.1),
    }


def reference(x, c, positions, ada_w, ada_b, norm1_g, norm2_g, final_g, w_in, gla_wa2, gla_ba2,
              gla_norm_g, nsa_pe_k, nsa_pe_v, nsa_ck_w1, nsa_ck_w2, nsa_cv_w1, nsa_cv_w2,
              w_branch_a, w_branch_b, w_out, peer_wq, peer_k1, peer_k2, peer_u, peer_v):
    B, D = c.shape
    for layer in range(DEPTH):
        mod = (jax.nn.silu(c) @ ada_w[layer] + ada_b[layer]).reshape(B, N_MOD, D)
        shift1, scale1, gate1, shift2, scale2, gate2 = [mod[:, i, None, :] for i in range(N_MOD)]
        h = rmsnorm(x, norm1_g[layer]) * (1.0 + scale1) + shift1
        x = x + gate1 * hybrid_mixer(h, positions, w_in[layer], gla_wa2[layer], gla_ba2[layer],
                                     gla_norm_g[layer], nsa_pe_k[layer], nsa_pe_v[layer],
                                     nsa_ck_w1[layer], nsa_ck_w2[layer], nsa_cv_w1[layer], nsa_cv_w2[layer],
                                     w_branch_a[layer], w_branch_b[layer], w_out[layer])
        h = rmsnorm(x, norm2_g[layer]) * (1.0 + scale2) + shift2
        x = x + gate2 * peer_ffn(h, peer_wq[layer], peer_k1[layer], peer_k2[layer], peer_u[layer], peer_v[layer])
    return rmsnorm(x, final_g)
```

```cpp
#include <hip/hip_runtime.h>
#include <hip/hip_cooperative_groups.h>
#include <stdio.h>
namespace cg = cooperative_groups;
#include <stdint.h>
#include <stddef.h>
#include <math.h>

typedef unsigned short bf16_t;
typedef short bf16x8 __attribute__((ext_vector_type(8)));
typedef float f32x4 __attribute__((ext_vector_type(4)));
typedef unsigned u32x4 __attribute__((ext_vector_type(4)));
typedef unsigned u32x2 __attribute__((ext_vector_type(2)));

constexpr int DM = 1024, NB = 8, SEQ = 2048, NTOK = NB * SEQ;
constexpr int ZC = 4992;
constexpr int ZQ_G = 0, ZK_G = 512, ZV_G = 1024, ZR_G = 2048, ZQ_N = 3072, ZKC = 4096, ZVC = 4224, ZKS = 4352, ZVS = 4480,
              ZKW = 4608, ZVW = 4736, ZGATE = 4864, ZLR = 4912;
constexpr int LDS_MAIN = 73728;
constexpr int LDS_BYTES = LDS_MAIN + 64;
constexpr int NTHREADS = 256;

constexpr size_t OFF_MOD = 16384;
constexpr size_t OFF_ROPE = 212992;
constexpr size_t OFF_CMP = 1261568;
constexpr size_t OFF_DEC = 1785856;
constexpr size_t OFF_K1B = 2310144;
constexpr size_t OFF_WC1 = 2834432;
constexpr size_t OFF_WIN = 4194304;
constexpr size_t OFF_WM = 14417920;
constexpr size_t OFF_WA = 18612224;
constexpr size_t OFF_WB = 20709376;
constexpr size_t OFF_WO = 22806528;
constexpr size_t OFF_WQ = 24903680;
constexpr size_t OFF_H = 29360128;
constexpr size_t OFF_M = 62914560;
constexpr size_t OFF_Z = 96468992;
constexpr size_t OFF_QP = OFF_Z;
constexpr size_t OFF_UB = OFF_Z + 67108864;
constexpr size_t OFF_VB = OFF_UB + 33554432;
constexpr size_t OFF_EIDX = OFF_VB + 33554432;
constexpr size_t OFF_GW = OFF_EIDX + 8388608;

struct Params {
    const float* x; const float* c; const int* pos; const float* ada_w; const float* ada_b;
    const float* norm1_g; const float* norm2_g; const float* final_g; const float* w_in;
    const float* gla_wa2; const float* gla_ba2; const float* gla_norm_g; const float* pe_k; const float* pe_v;
    const float* ck_w1; const float* ck_w2; const float* cv_w1; const float* cv_w2;
    const float* w_branch_a; const float* w_branch_b; const float* w_out; const float* peer_wq;
    const float* peer_k1; const float* peer_k2; const float* peer_u; const float* peer_v;
    float* out; char* ws;
};

__device__ __forceinline__ unsigned f2bf_u(float f) { unsigned u = __float_as_uint(f); return (u + 0x7fffu + ((u >> 16) & 1u)) >> 16; }
__device__ __forceinline__ bf16_t f2bf(float f) { return (bf16_t)f2bf_u(f); }
__device__ __forceinline__ unsigned pack2(float lo, float hi) { return f2bf_u(lo) | (f2bf_u(hi) << 16); }
__device__ __forceinline__ float bf_lo(unsigned u) { return __uint_as_float(u << 16); }
__device__ __forceinline__ float bf_hi(unsigned u) { return __uint_as_float(u & 0xffff0000u); }
__device__ __forceinline__ float bf2f(bf16_t h) { return __uint_as_float(((unsigned)h) << 16); }
__device__ __forceinline__ float wave_sum(float v) {
#pragma unroll
    for (int o = 32; o > 0; o >>= 1) v += __shfl_xor(v, o, 64);
    return v;
}
__device__ __forceinline__ float wave_max(float v) {
#pragma unroll
    for (int o = 32; o > 0; o >>= 1) v = fmaxf(v, __shfl_xor(v, o, 64));
    return v;
}
__device__ __forceinline__ float sigmoidf_(float x) { return 1.f / (1.f + __expf(-x)); }
__device__ __forceinline__ float siluf_(float x) { return x / (1.f + __expf(-x)); }
__device__ __forceinline__ float gelu_erf(float x) { return 0.5f * x * (1.f + erff(x * 0.70710678118654752f)); }
__device__ __forceinline__ f32x4 mfma16(bf16x8 a, bf16x8 b, f32x4 c) { return __builtin_amdgcn_mfma_f32_16x16x32_bf16(a, b, c, 0, 0, 0); }
__device__ __forceinline__ bf16x8 ld_frag(const bf16_t* p) { return *(const bf16x8*)p; }
__device__ __forceinline__ bf16x8 mk_frag(u32x2 lo, u32x2 hi) { u32x4 t = {lo.x, lo.y, hi.x, hi.y}; return __builtin_bit_cast(bf16x8, t); }

__device__ __forceinline__ void gemm_core(f32x4 (&acc)[4][4], const bf16_t* __restrict__ X, int ldx, const bf16_t* __restrict__ W, int ldw,
                                          int K, int m0, int n0, char* lds) {
    const int tid = threadIdx.x, lane = tid & 63, wave = tid >> 6;
    const int wr = wave >> 1, wc = wave & 1, r = lane & 15, q = lane >> 4;
    bf16_t* Xs = (bf16_t*)lds;
    bf16_t* Ws = Xs + 2 * 128 * 72;
    const int lr = tid >> 3, lc = tid & 7;
    const bf16_t* xg = X + (size_t)(m0 + lr) * ldx + lc * 8;
    const bf16_t* wg = W + (size_t)(n0 + lr) * ldw + lc * 8;
    u32x4 xr[4], wv[4];
    const int KT = K / 64;
#pragma unroll
    for (int p = 0; p < 4; p++) { xr[p] = *(const u32x4*)(xg + (size_t)p * 32 * ldx); wv[p] = *(const u32x4*)(wg + (size_t)p * 32 * ldw); }
#pragma unroll
    for (int p = 0; p < 4; p++) { *(u32x4*)(Xs + (p * 32 + lr) * 72 + lc * 8) = xr[p]; *(u32x4*)(Ws + (p * 32 + lr) * 72 + lc * 8) = wv[p]; }
    __syncthreads();
    for (int kt = 0; kt < KT; kt++) {
        const bool more = (kt + 1 < KT);
        if (more) {
#pragma unroll
            for (int p = 0; p < 4; p++) {
                xr[p] = *(const u32x4*)(xg + (size_t)p * 32 * ldx + (kt + 1) * 64);
                wv[p] = *(const u32x4*)(wg + (size_t)p * 32 * ldw + (kt + 1) * 64);
            }
        }
        const bf16_t* xs = Xs + (kt & 1) * 128 * 72;
        const bf16_t* ws = Ws + (kt & 1) * 128 * 72;
#pragma unroll
        for (int ks = 0; ks < 2; ks++) {
            bf16x8 af[4], bfr[4];
#pragma unroll
            for (int ni = 0; ni < 4; ni++) af[ni] = ld_frag(ws + (wc * 64 + ni * 16 + r) * 72 + ks * 32 + q * 8);
#pragma unroll
            for (int mi = 0; mi < 4; mi++) bfr[mi] = ld_frag(xs + (wr * 64 + mi * 16 + r) * 72 + ks * 32 + q * 8);
#pragma unroll
            for (int mi = 0; mi < 4; mi++)
#pragma unroll
                for (int ni = 0; ni < 4; ni++) acc[mi][ni] = mfma16(af[ni], bfr[mi], acc[mi][ni]);
        }
        if (more) {
            bf16_t* xd = Xs + ((kt + 1) & 1) * 128 * 72;
            bf16_t* wd = Ws + ((kt + 1) & 1) * 128 * 72;
#pragma unroll
            for (int p = 0; p < 4; p++) { *(u32x4*)(xd + (p * 32 + lr) * 72 + lc * 8) = xr[p]; *(u32x4*)(wd + (p * 32 + lr) * 72 + lc * 8) = wv[p]; }
        }
        __syncthreads();
    }
}
__device__ __forceinline__ void zero_acc(f32x4 (&acc)[4][4]) {
#pragma unroll
    for (int a = 0; a < 4; a++)
#pragma unroll
        for (int b = 0; b < 4; b++) acc[a][b] = (f32x4){0.f, 0.f, 0.f, 0.f};
}

struct MapId { __device__ int operator()(int n) const { return n; } };
struct MapWin {
    __device__ int operator()(int n) const { return n < 3072 ? n : (n < 4912 ? n + 16 : (n < 4928 ? n - 1840 : -1)); }
};
struct MapOff { int off; __device__ int operator()(int n) const { return n + off; } };

template <class Map>
__device__ __forceinline__ void tconv_tile(const float* __restrict__ src, int ldsrc, bf16_t* __restrict__ dst, int ldd, int n0, int k0, Map map, float* t) {
    const int tid = threadIdx.x;
    const int n = tid & 63, kb = tid >> 6;
    const int sc = map(n0 + n);
#pragma unroll
    for (int i = 0; i < 16; i++) { const int k = i * 4 + kb; t[k * 65 + n] = sc >= 0 ? src[(size_t)(k0 + k) * ldsrc + sc] : 0.f; }
    __syncthreads();
    const int nn = tid >> 2, kk = (tid & 3) * 16;
    unsigned w[8];
#pragma unroll
    for (int j = 0; j < 8; j++) w[j] = pack2(t[(kk + 2 * j) * 65 + nn], t[(kk + 2 * j + 1) * 65 + nn]);
    u32x4* d = (u32x4*)(dst + (size_t)(n0 + nn) * ldd + k0 + kk);
    d[0] = (u32x4){w[0], w[1], w[2], w[3]};
    d[1] = (u32x4){w[4], w[5], w[6], w[7]};
    __syncthreads();
}

constexpr int TA_MOD = 192, TA_WIN = 78 * 16, TA_WM = 32 * 16, TA_SQ = 16 * 16, TA_WQ = 32 * 16, TA_WC = 32, TA_K12 = 64, TA_ROPE = 512;
constexpr int TA_E0 = TA_MOD, TA_E1 = TA_E0 + TA_WIN, TA_E2 = TA_E1 + TA_WM, TA_E3 = TA_E2 + TA_SQ, TA_E4 = TA_E3 + TA_SQ, TA_E5 = TA_E4 + TA_SQ,
              TA_E6 = TA_E5 + TA_WQ, TA_E7 = TA_E6 + TA_WC, TA_E8 = TA_E7 + TA_WC, TA_E9 = TA_E8 + TA_K12, TA_E10 = TA_E9 + TA_K12, TA_E11 = TA_E10 + TA_ROPE;

__device__ void phaseA(const Params& p, char* lds) {
    const int tid = threadIdx.x;
    float* fl = (float*)lds;
    for (int task = blockIdx.x; task < TA_E11; task += gridDim.x) {
        if (task < TA_E0) {
            float* sc = fl;
            float* red = fl + 8192;
            for (int i = tid; i < 8192; i += NTHREADS) sc[i] = siluf_(p.c[i]);
            __syncthreads();
            const int n = task * 32 + (tid & 31), kg = tid >> 5;
            float a[8];
#pragma unroll
            for (int b = 0; b < 8; b++) a[b] = 0.f;
            for (int k = kg * 128; k < kg * 128 + 128; k++) {
                const float w = p.ada_w[(size_t)k * 6144 + n];
#pragma unroll
                for (int b = 0; b < 8; b++) a[b] += sc[b * 1024 + k] * w;
            }
#pragma unroll
            for (int b = 0; b < 8; b++) red[(kg * 8 + b) * 32 + (tid & 31)] = a[b];
            __syncthreads();
            {
                const int b = tid >> 5, nn = tid & 31;
                float s = 0.f;
#pragma unroll
                for (int g = 0; g < 8; g++) s += red[(g * 8 + b) * 32 + nn];
                ((float*)(p.ws + OFF_MOD))[b * 6144 + task * 32 + nn] = s + p.ada_b[task * 32 + nn];
            }
            __syncthreads();
        } else if (task < TA_E1) {
            const int tt = task - TA_E0;
            tconv_tile(p.w_in, 6976, (bf16_t*)(p.ws + OFF_WIN), 1024, (tt >> 4) * 64, (tt & 15) * 64, MapWin(), fl);
        } else if (task < TA_E2) {
            const int tt = task - TA_E1;
            tconv_tile(p.w_in, 6976, (bf16_t*)(p.ws + OFF_WM), 1024, (tt >> 4) * 64, (tt & 15) * 64, MapOff{4928}, fl);
        } else if (task < TA_E3) {
            const int tt = task - TA_E2;
            tconv_tile(p.w_branch_a, 1024, (bf16_t*)(p.ws + OFF_WA), 1024, (tt >> 4) * 64, (tt & 15) * 64, MapId(), fl);
        } else if (task < TA_E4) {
            const int tt = task - TA_E3;
            tconv_tile(p.w_branch_b, 1024, (bf16_t*)(p.ws + OFF_WB), 1024, (tt >> 4) * 64, (tt & 15) * 64, MapId(), fl);
        } else if (task < TA_E5) {
            const int tt = task - TA_E4;
            tconv_tile(p.w_out, 1024, (bf16_t*)(p.ws + OFF_WO), 1024, (tt >> 4) * 64, (tt & 15) * 64, MapId(), fl);
        } else if (task < TA_E6) {
            const int tt = task - TA_E5;
            tconv_tile(p.peer_wq, 2048, (bf16_t*)(p.ws + OFF_WQ), 1024, (tt >> 4) * 64, (tt & 15) * 64, MapId(), fl);
        } else if (task < TA_E7) {
            const int tt = task - TA_E6;
            tconv_tile(p.ck_w1, 64, (bf16_t*)(p.ws + OFF_WC1), 2048, 0, tt * 64, MapId(), fl);
        } else if (task < TA_E8) {
            const int tt = task - TA_E7;
            tconv_tile(p.cv_w1, 64, (bf16_t*)(p.ws + OFF_WC1) + 64 * 2048, 2048, 0, tt * 64, MapId(), fl);
        } else if (task < TA_E10) {
            const bool second = task >= TA_E9;
            const int tt = task - (second ? TA_E9 : TA_E8);
            const float* src = second ? p.peer_k2 : p.peer_k1;
            bf16_t* dst = (bf16_t*)(p.ws + OFF_K1B) + (second ? 131072 : 0);
            const int i = tt * 2048 + tid * 8;
            const f32x4 a = *(const f32x4*)(src + i), b = *(const f32x4*)(src + i + 4);
            *(u32x4*)(dst + i) = (u32x4){pack2(a[0], a[1]), pack2(a[2], a[3]), pack2(b[0], b[1]), pack2(b[2], b[3])};
        } else {
            const int tt = task - TA_E10;
            const int e = tt * 256 + tid;
            const int tok = e >> 3, i = e & 7;
            const float invf[8] = {1.0f, 0.1939227432012558f, 0.03760603070259094f, 0.007292664609849453f,
                                   0.0014142135623842478f, 0.00027424818836152554f, 5.318296098266728e-05f, 1.0313386155758053e-05f};
            float fr = invf[0];
#pragma unroll
            for (int j = 1; j < 8; j++) fr = (i == j) ? invf[j] : fr;
            const float ang = (float)p.pos[tok] * fr;
            const double rev = (double)ang * 0.15915494309189533577;
            const float fpart = (float)(rev - floor(rev));
            float* cs = (float*)(p.ws + OFF_ROPE);
            cs[e * 2] = __builtin_amdgcn_cosf(fpart);
            cs[e * 2 + 1] = __builtin_amdgcn_sinf(fpart);
        }
    }
}

__device__ void phase_modnorm(const Params& p, const float* __restrict__ src, const float* __restrict__ g, int shift_idx, int scale_idx, bf16_t* __restrict__ dst) {
    const int lane = threadIdx.x & 63, wave = threadIdx.x >> 6;
    const float* mod = (const float*)(p.ws + OFF_MOD);
    for (int tok = blockIdx.x * 4 + wave; tok < NTOK; tok += gridDim.x * 4) {
        const int b = tok >> 11;
        const float* xr = src + (size_t)tok * DM;
        f32x4 v[4];
        float ss = 0.f;
#pragma unroll
        for (int c = 0; c < 4; c++) { v[c] = *(const f32x4*)(xr + c * 256 + lane * 4); ss += v[c][0] * v[c][0] + v[c][1] * v[c][1] + v[c][2] * v[c][2] + v[c][3] * v[c][3]; }
        ss = wave_sum(ss);
        const float rstd = rsqrtf(ss * (1.f / 1024.f) + 1e-6f);
#pragma unroll
        for (int c = 0; c < 4; c++) {
            const int d = c * 256 + lane * 4;
            const f32x4 gg = *(const f32x4*)(g + d);
            const f32x4 sc = *(const f32x4*)(mod + b * 6144 + scale_idx * 1024 + d);
            const f32x4 sh = *(const f32x4*)(mod + b * 6144 + shift_idx * 1024 + d);
            float o[4];
#pragma unroll
            for (int j = 0; j < 4; j++) o[j] = (v[c][j] * rstd) * gg[j] * (1.f + sc[j]) + sh[j];
            *(u32x2*)(dst + (size_t)tok * DM + d) = (u32x2){pack2(o[0], o[1]), pack2(o[2], o[3])};
        }
    }
}

__device__ void phaseC(const Params& p, char* lds) {
    const int lane = threadIdx.x & 63, wave = threadIdx.x >> 6;
    const int wr = wave >> 1, wc = wave & 1, r = lane & 15, q = lane >> 4;
    const bf16_t* H = (const bf16_t*)(p.ws + OFF_H);
    const bf16_t* W = (const bf16_t*)(p.ws + OFF_WIN);
    bf16_t* Z = (bf16_t*)(p.ws + OFF_Z);
    const float* cs = (const float*)(p.ws + OFF_ROPE);
    constexpr int NTN = ZC / 128;
    for (int task = blockIdx.x; task < 128 * NTN; task += gridDim.x) {
        const int bn = task % NTN, bm = task / NTN;
        const int m0 = bm * 128, n0 = bn * 128;
        f32x4 acc[4][4];
        zero_acc(acc);
        gemm_core(acc, H, DM, W, DM, DM, m0, n0, lds);
        const bool rope = (bn >= 24 && bn <= 31) || bn == 32 || bn == 34 || bn == 36;
        const float scl = (bn >= 24 && bn <= 31) ? 0.125f : 1.f;
#pragma unroll
        for (int mi = 0; mi < 4; mi++) {
            const int tok = m0 + wr * 64 + mi * 16 + r;
            if (rope) {
                f32x4 v = acc[mi][0];
                f32x4 pr;
#pragma unroll
                for (int j = 0; j < 4; j++) pr[j] = __shfl_xor(v[j], 32, 64);
                const int ib = (q & 1) * 4;
                const f32x4 c0 = *(const f32x4*)(cs + (size_t)tok * 16 + ib * 2);
                const f32x4 c1 = *(const f32x4*)(cs + (size_t)tok * 16 + ib * 2 + 4);
                const float cc[4] = {c0[0], c0[2], c1[0], c1[2]}, sn[4] = {c0[1], c0[3], c1[1], c1[3]};
#pragma unroll
                for (int j = 0; j < 4; j++) v[j] = (q < 2) ? (v[j] * cc[j] - pr[j] * sn[j]) : (v[j] * cc[j] + pr[j] * sn[j]);
                acc[mi][0] = v;
            }
#pragma unroll
            for (int ni = 0; ni < 4; ni++) {
                const f32x4 v = acc[mi][ni] * scl;
                *(u32x2*)(Z + (size_t)tok * ZC + n0 + wc * 64 + ni * 16 + q * 4) = (u32x2){pack2(v[0], v[1]), pack2(v[2], v[3])};
            }
        }
    }
}

__device__ __forceinline__ void gla_prep(const Params& p, int tok0, int h, char* lds) {
    const int tid = threadIdx.x;
    float* bc = (float*)lds;
    float* lrs = (float*)(lds + 32768);
    const bf16_t* Z = (const bf16_t*)(p.ws + OFF_Z);
    for (int i = tid; i < 1024; i += NTHREADS) { const int t = i >> 4, rr = i & 15; lrs[i] = bf2f(Z[(size_t)(tok0 + t) * ZC + ZLR + rr]); }
    const int d = tid & 127, th = tid >> 7;
    float w[16];
#pragma unroll
    for (int rr = 0; rr < 16; rr++) w[rr] = p.gla_wa2[rr * 512 + h * 128 + d];
    const float bias = p.gla_ba2[h * 128 + d];
    __syncthreads();
    float run = 0.f;
    for (int t = th * 32; t < th * 32 + 32; t++) {
        float xv = bias;
#pragma unroll
        for (int rr = 0; rr < 16; rr++) xv += lrs[t * 16 + rr] * w[rr];
        const float ls = fminf(xv, 0.f) - log1pf(__expf(-fabsf(xv)));
        run += ls * (1.f / 16.f);
        bc[t * 128 + d] = run;
    }
    __syncthreads();
    if (th == 1) {
        const float add = bc[31 * 128 + d];
        for (int t = 32; t < 64; t++) bc[t * 128 + d] += add;
    }
    __syncthreads();
}

__device__ void phaseG1_task(const Params& p, int task, char* lds) {
    const int tid = threadIdx.x, lane = tid & 63, wave = tid >> 6, r = lane & 15, q = lane >> 4;
    const int c = task & 31, h = (task >> 5) & 3, b = task >> 7;
    const int tok0 = b * SEQ + c * 64;
    const bf16_t* Z = (const bf16_t*)(p.ws + OFF_Z);
    bf16_t* L = (bf16_t*)p.out;
    float* bc = (float*)lds;
    bf16_t* klT = (bf16_t*)(lds + 36864);
    bf16_t* vT = (bf16_t*)(lds + 36864 + 18432);
    gla_prep(p, tok0, h, lds);
    if (tid < 128) ((float*)(p.ws + OFF_DEC))[task * 128 + tid] = __expf(bc[63 * 128 + tid]);
    {
        const int s = lane, dc = wave * 32;
        const bf16_t* kp = Z + (size_t)(tok0 + s) * ZC + ZK_G + h * 128 + dc;
#pragma unroll
        for (int v4 = 0; v4 < 4; v4++) {
            const u32x4 kv = *(const u32x4*)(kp + v4 * 8);
            const unsigned kw[4] = {kv.x, kv.y, kv.z, kv.w};
#pragma unroll
            for (int j = 0; j < 8; j++) {
                const int d = dc + v4 * 8 + j;
                const float kval = (j & 1) ? bf_hi(kw[j >> 1]) : bf_lo(kw[j >> 1]);
                klT[d * 72 + s] = f2bf(kval * __expf(bc[63 * 128 + d] - bc[s * 128 + d]));
            }
        }
    }
    for (int eh = 0; eh < 2; eh++) {
        __syncthreads();
        {
            const int s = lane, ec = wave * 32;
            const bf16_t* vp = Z + (size_t)(tok0 + s) * ZC + ZV_G + h * 256 + eh * 128 + ec;
#pragma unroll
            for (int v4 = 0; v4 < 4; v4++) {
                const u32x4 vv = *(const u32x4*)(vp + v4 * 8);
                const unsigned vw[4] = {vv.x, vv.y, vv.z, vv.w};
#pragma unroll
                for (int j = 0; j < 8; j++) vT[(ec + v4 * 8 + j) * 72 + s] = (bf16_t)((j & 1) ? (vw[j >> 1] >> 16) : (vw[j >> 1] & 0xffffu));
            }
        }
        __syncthreads();
        f32x4 acc[8][2];
#pragma unroll
        for (int dt = 0; dt < 8; dt++) { acc[dt][0] = (f32x4){0.f, 0.f, 0.f, 0.f}; acc[dt][1] = (f32x4){0.f, 0.f, 0.f, 0.f}; }
#pragma unroll
        for (int ks = 0; ks < 2; ks++) {
            bf16x8 bv[2];
#pragma unroll
            for (int x = 0; x < 2; x++) bv[x] = ld_frag(vT + ((2 * wave + x) * 16 + r) * 72 + ks * 32 + q * 8);
#pragma unroll
            for (int dt = 0; dt < 8; dt++) {
                const bf16x8 a = ld_frag(klT + (dt * 16 + r) * 72 + ks * 32 + q * 8);
#pragma unroll
                for (int x = 0; x < 2; x++) acc[dt][x] = mfma16(a, bv[x], acc[dt][x]);
            }
        }
#pragma unroll
        for (int dt = 0; dt < 8; dt++)
#pragma unroll
            for (int x = 0; x < 2; x++) {
                const int e = eh * 128 + (2 * wave + x) * 16 + r, d = dt * 16 + 4 * q;
                const f32x4 v = acc[dt][x];
                *(u32x2*)(L + ((size_t)task * 256 + e) * 128 + d) = (u32x2){pack2(v[0], v[1]), pack2(v[2], v[3])};
            }
    }
    __syncthreads();
}

__device__ void phaseG2(const Params& p) {
    bf16_t* L = (bf16_t*)p.out;
    const float* dec = (const float*)(p.ws + OFF_DEC);
    for (int idx = blockIdx.x * NTHREADS + threadIdx.x; idx < 32 * 256 * 16; idx += gridDim.x * NTHREADS) {
        const int d8 = idx & 15, e = (idx >> 4) & 255, bh = idx >> 12;
        float st[8];
#pragma unroll
        for (int j = 0; j < 8; j++) st[j] = 0.f;
        for (int c = 0; c < 32; c++) {
            const int task = bh * 32 + c;
            u32x4* ptr = (u32x4*)(L + ((size_t)task * 256 + e) * 128 + d8 * 8);
            const u32x4 lv = *ptr;
            const f32x4 d0 = *(const f32x4*)(dec + task * 128 + d8 * 8), d1 = *(const f32x4*)(dec + task * 128 + d8 * 8 + 4);
            *ptr = (u32x4){pack2(st[0], st[1]), pack2(st[2], st[3]), pack2(st[4], st[5]), pack2(st[6], st[7])};
            st[0] = d0[0] * st[0] + bf_lo(lv.x); st[1] = d0[1] * st[1] + bf_hi(lv.x);
            st[2] = d0[2] * st[2] + bf_lo(lv.y); st[3] = d0[3] * st[3] + bf_hi(lv.y);
            st[4] = d1[0] * st[4] + bf_lo(lv.z); st[5] = d1[1] * st[5] + bf_hi(lv.z);
            st[6] = d1[2] * st[6] + bf_lo(lv.w); st[7] = d1[3] * st[7] + bf_hi(lv.w);
        }
    }
}

__device__ void phaseG3_task(const Params& p, int task, char* lds) {
    const int tid = threadIdx.x, lane = tid & 63, wave = tid >> 6, r = lane & 15, q = lane >> 4;
    const int c = task & 31, h = (task >> 5) & 3, b = task >> 7;
    const int tok0 = b * SEQ + c * 64;
    bf16_t* Z = (bf16_t*)(p.ws + OFF_Z);
    const bf16_t* ST = (const bf16_t*)p.out + (size_t)task * 256 * 128;
    float* bc = (float*)lds;
    bf16_t* vT = (bf16_t*)lds;
    bf16_t* qg = (bf16_t*)(lds + 36864);
    bf16_t* kg = (bf16_t*)(lds + 36864 + 17408);
    bf16_t* P = kg;
    float* red = (float*)(lds + 36864 + 2 * 17408);
    gla_prep(p, tok0, h, lds);
    {
        const int t = tid >> 2, dc = (tid & 3) * 32;
        const bf16_t* qp = Z + (size_t)(tok0 + t) * ZC + ZQ_G + h * 128 + dc;
        const bf16_t* kp = Z + (size_t)(tok0 + t) * ZC + ZK_G + h * 128 + dc;
#pragma unroll
        for (int v4 = 0; v4 < 4; v4++) {
            const u32x4 qv = *(const u32x4*)(qp + v4 * 8), kv = *(const u32x4*)(kp + v4 * 8);
            const unsigned qw[4] = {qv.x, qv.y, qv.z, qv.w}, kw[4] = {kv.x, kv.y, kv.z, kv.w};
            unsigned qo[4], ko[4];
#pragma unroll
            for (int j2 = 0; j2 < 4; j2++) {
                const int d = dc + v4 * 8 + j2 * 2;
                const float b0 = bc[t * 128 + d], b1 = bc[t * 128 + d + 1];
                qo[j2] = pack2(bf_lo(qw[j2]) * 0.08838834764831845f * __expf(b0), bf_hi(qw[j2]) * 0.08838834764831845f * __expf(b1));
                ko[j2] = pack2(bf_lo(kw[j2]) * __expf(-b0), bf_hi(kw[j2]) * __expf(-b1));
            }
            *(u32x4*)(qg + t * 136 + dc + v4 * 8) = (u32x4){qo[0], qo[1], qo[2], qo[3]};
            *(u32x4*)(kg + t * 136 + dc + v4 * 8) = (u32x4){ko[0], ko[1], ko[2], ko[3]};
        }
    }
    __syncthreads();
    {
        const int s = lane, ec = wave * 64;
        const bf16_t* vp = Z + (size_t)(tok0 + s) * ZC + ZV_G + h * 256 + ec;
#pragma unroll
        for (int v4 = 0; v4 < 8; v4++) {
            const u32x4 vv = *(const u32x4*)(vp + v4 * 8);
            const unsigned vw[4] = {vv.x, vv.y, vv.z, vv.w};
#pragma unroll
            for (int j = 0; j < 8; j++) vT[(ec + v4 * 8 + j) * 72 + s] = (bf16_t)((j & 1) ? (vw[j >> 1] >> 16) : (vw[j >> 1] & 0xffffu));
        }
    }
    f32x4 sc[4];
#pragma unroll
    for (int st = 0; st < 4; st++) sc[st] = (f32x4){0.f, 0.f, 0.f, 0.f};
    {
        bf16x8 qf[4];
#pragma unroll
        for (int ks = 0; ks < 4; ks++) qf[ks] = ld_frag(qg + (wave * 16 + r) * 136 + ks * 32 + q * 8);
#pragma unroll
        for (int st = 0; st < 4; st++) {
            if (st <= wave) {
#pragma unroll
                for (int ks = 0; ks < 4; ks++) sc[st] = mfma16(ld_frag(kg + (st * 16 + r) * 136 + ks * 32 + q * 8), qf[ks], sc[st]);
            }
        }
    }
    __syncthreads();
    {
        const int t = wave * 16 + r;
#pragma unroll
        for (int st = 0; st < 4; st++) {
            float pv[4];
#pragma unroll
            for (int j = 0; j < 4; j++) { const int s = st * 16 + 4 * q + j; pv[j] = (s <= t) ? sc[st][j] : 0.f; }
            *(u32x2*)(P + t * 72 + st * 16 + 4 * q) = (u32x2){pack2(pv[0], pv[1]), pack2(pv[2], pv[3])};
        }
    }
    __syncthreads();
    f32x4 o[4][4];
#pragma unroll
    for (int et = 0; et < 4; et++)
#pragma unroll
        for (int tt = 0; tt < 4; tt++) o[et][tt] = (f32x4){0.f, 0.f, 0.f, 0.f};
#pragma unroll
    for (int ks = 0; ks < 2; ks++) {
        bf16x8 pf[4];
#pragma unroll
        for (int tt = 0; tt < 4; tt++) pf[tt] = ld_frag(P + (tt * 16 + r) * 72 + ks * 32 + q * 8);
#pragma unroll
        for (int et = 0; et < 4; et++) {
            const bf16x8 a = ld_frag(vT + ((wave * 4 + et) * 16 + r) * 72 + ks * 32 + q * 8);
#pragma unroll
            for (int tt = 0; tt < 4; tt++) o[et][tt] = mfma16(a, pf[tt], o[et][tt]);
        }
    }
#pragma unroll
    for (int ks = 0; ks < 4; ks++) {
        bf16x8 qf[4];
#pragma unroll
        for (int tt = 0; tt < 4; tt++) qf[tt] = ld_frag(qg + (tt * 16 + r) * 136 + ks * 32 + q * 8);
#pragma unroll
        for (int et = 0; et < 4; et++) {
            const bf16x8 a = *(const bf16x8*)(ST + (size_t)((wave * 4 + et) * 16 + r) * 128 + ks * 32 + q * 8);
#pragma unroll
            for (int tt = 0; tt < 4; tt++) o[et][tt] = mfma16(a, qf[tt], o[et][tt]);
        }
    }
#pragma unroll
    for (int tt = 0; tt < 4; tt++) {
        float ss = 0.f;
#pragma unroll
        for (int et = 0; et < 4; et++)
#pragma unroll
            for (int j = 0; j < 4; j++) ss += o[et][tt][j] * o[et][tt][j];
        ss += __shfl_xor(ss, 16, 64);
        ss += __shfl_xor(ss, 32, 64);
        if (q == 0) red[wave * 64 + tt * 16 + r] = ss;
    }
    __syncthreads();
#pragma unroll
    for (int tt = 0; tt < 4; tt++) {
        const int t = tt * 16 + r;
        const float tot = red[t] + red[64 + t] + red[128 + t] + red[192 + t];
        const float rstd = rsqrtf(tot * (1.f / 256.f) + 1e-6f);
#pragma unroll
        for (int et = 0; et < 4; et++) {
            const int e = (wave * 4 + et) * 16 + 4 * q;
            bf16_t* rp = Z + (size_t)(tok0 + t) * ZC + ZR_G + h * 256 + e;
            const u32x2 rv = *(const u32x2*)rp;
            const f32x4 gn = *(const f32x4*)(p.gla_norm_g + e);
            const float r0 = bf_lo(rv.x), r1 = bf_hi(rv.x), r2 = bf_lo(rv.y), r3 = bf_hi(rv.y);
            const f32x4 ov = o[et][tt];
            *(u32x2*)rp = (u32x2){pack2(ov[0] * rstd * gn[0] * siluf_(r0), ov[1] * rstd * gn[1] * siluf_(r1)),
                                  pack2(ov[2] * rstd * gn[2] * siluf_(r2), ov[3] * rstd * gn[3] * siluf_(r3))};
        }
    }
    __syncthreads();
}

__device__ void phaseN1_task(const Params& p, int task, char* lds) {
    const int tid = threadIdx.x, lane = tid & 63, wave = tid >> 6, r = lane & 15, q = lane >> 4;
    const int it = task & 7, g = (task >> 3) & 1, b = (task >> 4) & 7, kv = task >> 7;
    const bf16_t* Z = (const bf16_t*)(p.ws + OFF_Z);
    const bf16_t* W1 = (const bf16_t*)(p.ws + OFF_WC1) + (size_t)kv * 64 * 2048;
    const float* pe = kv ? p.pe_v : p.pe_k;
    const float* w2 = kv ? p.cv_w2 : p.ck_w2;
    const int zoff = (kv ? ZVC : ZKC) + g * 64;
    float* hid = (float*)lds;
    float* hid2 = (float*)(lds + 16384);
    int i = it * 16 + r; if (i > 126) i = 126;
    f32x4 acc[4];
#pragma unroll
    for (int nt = 0; nt < 4; nt++) acc[nt] = (f32x4){0.f, 0.f, 0.f, 0.f};
    for (int ks = 0; ks < 16; ks++) {
        const int k = wave * 512 + ks * 32 + q * 8;
        const int l = k >> 6, d = k & 63;
        const u32x4 zv = *(const u32x4*)(Z + (size_t)(b * SEQ + i * 16 + l) * ZC + zoff + d);
        const f32x4 p0 = *(const f32x4*)(pe + l * 64 + d), p1 = *(const f32x4*)(pe + l * 64 + d + 4);
        const u32x4 av = {pack2(bf_lo(zv.x) + p0[0], bf_hi(zv.x) + p0[1]), pack2(bf_lo(zv.y) + p0[2], bf_hi(zv.y) + p0[3]),
                          pack2(bf_lo(zv.z) + p1[0], bf_hi(zv.z) + p1[1]), pack2(bf_lo(zv.w) + p1[2], bf_hi(zv.w) + p1[3])};
        const bf16x8 a = __builtin_bit_cast(bf16x8, av);
#pragma unroll
        for (int nt = 0; nt < 4; nt++) {
            const bf16x8 bw = *(const bf16x8*)(W1 + (size_t)(nt * 16 + r) * 2048 + k);
            acc[nt] = mfma16(a, bw, acc[nt]);
        }
    }
#pragma unroll
    for (int nt = 0; nt < 4; nt++)
#pragma unroll
        for (int j = 0; j < 4; j++) hid[(wave * 16 + 4 * q + j) * 64 + nt * 16 + r] = acc[nt][j];
    __syncthreads();
    for (int e = tid; e < 1024; e += NTHREADS) hid2[e] = gelu_erf(hid[e] + hid[1024 + e] + hid[2048 + e] + hid[3072 + e]);
    __syncthreads();
    {
        const int il = tid >> 4, n2 = (tid & 15) * 4;
        f32x4 o = {0.f, 0.f, 0.f, 0.f};
        for (int n = 0; n < 64; n++) {
            const float hv = hid2[il * 64 + n];
            const f32x4 wv = *(const f32x4*)(w2 + n * 64 + n2);
            o += hv * wv;
        }
        const int ig = it * 16 + il;
        if (ig >= 127) o = (f32x4){0.f, 0.f, 0.f, 0.f};
        bf16_t* dst = (bf16_t*)(p.ws + OFF_CMP) + ((size_t)((kv * 8 + b) * 2 + g) * 128 + ig) * 64 + n2;
        *(u32x2*)dst = (u32x2){pack2(o[0], o[1]), pack2(o[2], o[3])};
    }
    __syncthreads();
}

__device__ __forceinline__ void nsa_load_kv(const bf16_t* __restrict__ kbase, const bf16_t* __restrict__ vbase, size_t rowstride, bf16_t* Ks, bf16_t* VT) {
    const int tid = threadIdx.x;
    {
        const int key = tid >> 2, ch = (tid & 3) * 16;
        const u32x4 a = *(const u32x4*)(kbase + (size_t)key * rowstride + ch), b = *(const u32x4*)(kbase + (size_t)key * rowstride + ch + 8);
        *(u32x4*)(Ks + key * 72 + ch) = a;
        *(u32x4*)(Ks + key * 72 + ch + 8) = b;
    }
    {
        const int key = tid & 63, dc = (tid >> 6) * 16;
        const u32x4 a = *(const u32x4*)(vbase + (size_t)key * rowstride + dc), b = *(const u32x4*)(vbase + (size_t)key * rowstride + dc + 8);
        const unsigned w[8] = {a.x, a.y, a.z, a.w, b.x, b.y, b.z, b.w};
#pragma unroll
        for (int j = 0; j < 16; j++) VT[(dc + j) * 72 + key] = (bf16_t)((j & 1) ? (w[j >> 1] >> 16) : (w[j >> 1] & 0xffffu));
    }
}

__device__ __forceinline__ void nsa_block_step(const bf16_t* Ks, const bf16_t* VT, const bf16x8 (&qf)[2][2], f32x4 (&O)[2][4], float (&m)[2], float (&l)[2],
                                               unsigned vm, int r, int q) {
    f32x4 s[2][4];
#pragma unroll
    for (int x = 0; x < 2; x++)
#pragma unroll
        for (int kt = 0; kt < 4; kt++) s[x][kt] = (f32x4){0.f, 0.f, 0.f, 0.f};
#pragma unroll
    for (int kt = 0; kt < 4; kt++)
#pragma unroll
        for (int ks = 0; ks < 2; ks++) {
            const bf16x8 kf = ld_frag(Ks + (kt * 16 + r) * 72 + ks * 32 + q * 8);
#pragma unroll
            for (int x = 0; x < 2; x++) s[x][kt] = mfma16(kf, qf[x][ks], s[x][kt]);
        }
    __builtin_amdgcn_sched_barrier(0);
    unsigned pb[2][2][4];
#pragma unroll
    for (int x = 0; x < 2; x++) {
        float mx = -1e30f;
#pragma unroll
        for (int kt = 0; kt < 4; kt++)
#pragma unroll
            for (int j = 0; j < 4; j++) if ((vm >> (kt * 4 + j)) & 1u) mx = fmaxf(mx, s[x][kt][j]);
        mx = fmaxf(mx, __shfl_xor(mx, 16, 64));
        mx = fmaxf(mx, __shfl_xor(mx, 32, 64));
        const float mnew = fmaxf(m[x], mx);
        const float alpha = __expf(m[x] - mnew);
        m[x] = mnew;
        float ls = 0.f;
#pragma unroll
        for (int kt = 0; kt < 4; kt++)
#pragma unroll
            for (int j = 0; j < 4; j++) {
                const float pv = ((vm >> (kt * 4 + j)) & 1u) ? __expf(s[x][kt][j] - mnew) : 0.f;
                s[x][kt][j] = pv; ls += pv;
            }
        l[x] = l[x] * alpha + ls;
#pragma unroll
        for (int dt = 0; dt < 4; dt++) O[x][dt] *= alpha;
#pragma unroll
        for (int s2 = 0; s2 < 2; s2++) {
            pb[x][s2][0] = pack2(s[x][2 * s2][0], s[x][2 * s2][1]); pb[x][s2][1] = pack2(s[x][2 * s2][2], s[x][2 * s2][3]);
            pb[x][s2][2] = pack2(s[x][2 * s2 + 1][0], s[x][2 * s2 + 1][1]); pb[x][s2][3] = pack2(s[x][2 * s2 + 1][2], s[x][2 * s2 + 1][3]);
        }
    }
    __builtin_amdgcn_sched_barrier(0);
#pragma unroll
    for (int s2 = 0; s2 < 2; s2++)
#pragma unroll
        for (int dt = 0; dt < 4; dt++) {
            const u32x2 lo = *(const u32x2*)(VT + (dt * 16 + r) * 72 + (2 * s2) * 16 + 4 * q);
            const u32x2 hi = *(const u32x2*)(VT + (dt * 16 + r) * 72 + (2 * s2 + 1) * 16 + 4 * q);
            const bf16x8 va = mk_frag(lo, hi);
#pragma unroll
            for (int x = 0; x < 2; x++) {
                const u32x4 t4 = {pb[x][s2][0], pb[x][s2][1], pb[x][s2][2], pb[x][s2][3]};
                O[x][dt] = mfma16(va, __builtin_bit_cast(bf16x8, t4), O[x][dt]);
            }
        }
}

__device__ void phaseN2_task(const Params& p, int task, char* lds) {
    const int tid = threadIdx.x, lane = tid & 63, wave = tid >> 6, r = lane & 15, q = lane >> 4;
    const int tt = 127 - (task >> 4), g = task & 1, b = (task >> 1) & 7;
    const int t0 = tt * 16, t = t0 + r;
    const int cur = t0 >> 6;
    bf16_t* Z = (bf16_t*)(p.ws + OFF_Z);
    const size_t rowb = (size_t)b * SEQ;
    bf16_t* Kc = (bf16_t*)lds;
    bf16_t* VcT = (bf16_t*)(lds + 18432);
    bf16_t* Ks = (bf16_t*)lds;
    bf16_t* VT = (bf16_t*)(lds + 18432);
    float* impw = (float*)(lds + 35840);
    float* scs = (float*)(lds + 35840 + 32768);
    unsigned* selm = (unsigned*)(lds + 35840 + 32768 + 2048);

    bf16x8 qf[2][2];
#pragma unroll
    for (int x = 0; x < 2; x++)
#pragma unroll
        for (int ks = 0; ks < 2; ks++) qf[x][ks] = *(const bf16x8*)(Z + (rowb + t) * ZC + ZQ_N + (g * 8 + 2 * wave + x) * 64 + ks * 32 + q * 8);
    f32x4 Of[2][4];
    f32x4* ofl = (f32x4*)(lds + 35840);

    {
        const bf16_t* kc = (const bf16_t*)(p.ws + OFF_CMP) + (size_t)((0 * 8 + b) * 2 + g) * 128 * 64;
        const bf16_t* vc = (const bf16_t*)(p.ws + OFF_CMP) + (size_t)((1 * 8 + b) * 2 + g) * 128 * 64;
        {
            const int key = tid >> 1, ch = (tid & 1) * 32;
#pragma unroll
            for (int v4 = 0; v4 < 4; v4++) *(u32x4*)(Kc + key * 72 + ch + v4 * 8) = *(const u32x4*)(kc + key * 64 + ch + v4 * 8);
            const int k2 = tid & 127, dc = (tid >> 7) * 32;
#pragma unroll
            for (int v4 = 0; v4 < 4; v4++) {
                const u32x4 a = *(const u32x4*)(vc + k2 * 64 + dc + v4 * 8);
                const unsigned w[4] = {a.x, a.y, a.z, a.w};
#pragma unroll
                for (int j = 0; j < 8; j++) VcT[(dc + v4 * 8 + j) * 136 + k2] = (bf16_t)((j & 1) ? (w[j >> 1] >> 16) : (w[j >> 1] & 0xffffu));
            }
        }
        __syncthreads();
        int nv = t >= 31 ? ((t - 31) >> 4) + 1 : 0;
        if (nv > 127) nv = 127;
        f32x4 isum[8];
#pragma unroll
        for (int kt = 0; kt < 8; kt++) isum[kt] = (f32x4){0.f, 0.f, 0.f, 0.f};
#pragma unroll
        for (int x = 0; x < 2; x++) {
            f32x4 s[8];
#pragma unroll
            for (int kt = 0; kt < 8; kt++) s[kt] = (f32x4){0.f, 0.f, 0.f, 0.f};
#pragma unroll
            for (int kt = 0; kt < 8; kt++)
#pragma unroll
                for (int ks = 0; ks < 2; ks++) s[kt] = mfma16(ld_frag(Kc + (kt * 16 + r) * 72 + ks * 32 + q * 8), qf[x][ks], s[kt]);
            __builtin_amdgcn_sched_barrier(0);
            float mx = -1e30f;
#pragma unroll
            for (int kt = 0; kt < 8; kt++)
#pragma unroll
                for (int j = 0; j < 4; j++) if (kt * 16 + 4 * q + j < nv) mx = fmaxf(mx, s[kt][j]);
            mx = fmaxf(mx, __shfl_xor(mx, 16, 64));
            mx = fmaxf(mx, __shfl_xor(mx, 32, 64));
            float ls = 0.f;
#pragma unroll
            for (int kt = 0; kt < 8; kt++)
#pragma unroll
                for (int j = 0; j < 4; j++) {
                    const float pv = (kt * 16 + 4 * q + j < nv) ? __expf(s[kt][j] - mx) : 0.f;
                    s[kt][j] = pv; ls += pv;
                }
            ls += __shfl_xor(ls, 16, 64);
            ls += __shfl_xor(ls, 32, 64);
            const float inv = nv > 0 ? 1.f / ls : 0.f;
#pragma unroll
            for (int kt = 0; kt < 8; kt++) { s[kt] *= inv; isum[kt] += s[kt]; }
            f32x4 Oc[4];
#pragma unroll
            for (int dt = 0; dt < 4; dt++) Oc[dt] = (f32x4){0.f, 0.f, 0.f, 0.f};
            __builtin_amdgcn_sched_barrier(0);
#pragma unroll
            for (int s2 = 0; s2 < 4; s2++) {
                const u32x4 t4 = {pack2(s[2 * s2][0], s[2 * s2][1]), pack2(s[2 * s2][2], s[2 * s2][3]),
                                  pack2(s[2 * s2 + 1][0], s[2 * s2 + 1][1]), pack2(s[2 * s2 + 1][2], s[2 * s2 + 1][3])};
                const bf16x8 pbv = __builtin_bit_cast(bf16x8, t4);
#pragma unroll
                for (int dt = 0; dt < 4; dt++) {
                    const u32x2 lo = *(const u32x2*)(VcT + (dt * 16 + r) * 136 + (2 * s2) * 16 + 4 * q);
                    const u32x2 hi = *(const u32x2*)(VcT + (dt * 16 + r) * 136 + (2 * s2 + 1) * 16 + 4 * q);
                    Oc[dt] = mfma16(mk_frag(lo, hi), pbv, Oc[dt]);
                }
            }
            const float g0 = sigmoidf_(bf2f(Z[(rowb + t) * ZC + ZGATE + 0 * 16 + g * 8 + 2 * wave + x]));
#pragma unroll
            for (int dt = 0; dt < 4; dt++) Of[x][dt] = g0 * Oc[dt];
            __builtin_amdgcn_sched_barrier(0);
        }
#pragma unroll
        for (int kt = 0; kt < 8; kt++) *(f32x4*)(impw + (wave * 16 + r) * 128 + kt * 16 + 4 * q) = isum[kt];
        __syncthreads();
#pragma unroll
        for (int pass = 0; pass < 2; pass++) {
            const int tk = pass * 8 + (tid >> 5), j = tid & 31;
            const int i0 = j == 0 ? 0 : 4 * j - 1, i1 = (4 * j + 3 > 126) ? 126 : 4 * j + 3;
            float sc = 0.f;
            for (int i = i0; i <= i1; i++) sc += (impw[(0 * 16 + tk) * 128 + i] + impw[(1 * 16 + tk) * 128 + i]) + (impw[(2 * 16 + tk) * 128 + i] + impw[(3 * 16 + tk) * 128 + i]);
            const bool forced = (j == 0) || (j == cur) || (j == cur - 1);
            scs[tk * 32 + j] = forced ? 1e6f : (j <= cur ? sc : -1.f);
        }
        __syncthreads();
#pragma unroll
        for (int pass = 0; pass < 2; pass++) {
            const int tk = pass * 8 + (tid >> 5), j = tid & 31;
            const float mine = scs[tk * 32 + j];
            int rank = 0;
            for (int j2 = 0; j2 < 32; j2++) { const float o = scs[tk * 32 + j2]; rank += (o > mine || (o == mine && j2 < j)) ? 1 : 0; }
            const unsigned long long bal = __ballot(rank < 16);
            if ((lane & 31) == 0) selm[tk] = (unsigned)(lane ? (bal >> 32) : (bal & 0xffffffffull));
        }
        __syncthreads();
    }
#pragma unroll
    for (int x = 0; x < 2; x++)
#pragma unroll
        for (int dt = 0; dt < 4; dt++) ofl[(wave * 8 + x * 4 + dt) * 64 + lane] = Of[x][dt];
    const unsigned mysel = selm[r];
    unsigned uni = 0;
#pragma unroll
    for (int i = 0; i < 16; i++) uni |= selm[i];

    {
        f32x4 O[2][4];
        float m[2] = {-1e30f, -1e30f}, l[2] = {0.f, 0.f};
#pragma unroll
        for (int x = 0; x < 2; x++)
#pragma unroll
            for (int dt = 0; dt < 4; dt++) O[x][dt] = (f32x4){0.f, 0.f, 0.f, 0.f};
        for (int j = 0; j <= cur; j++) {
            if (!((uni >> j) & 1u)) continue;
            __syncthreads();
            nsa_load_kv(Z + (rowb + j * 64) * ZC + ZKS + g * 64, Z + (rowb + j * 64) * ZC + ZVS + g * 64, ZC, Ks, VT);
            __syncthreads();
            unsigned vm = 0;
            if ((mysel >> j) & 1u) {
#pragma unroll
                for (int kt = 0; kt < 4; kt++)
#pragma unroll
                    for (int jj = 0; jj < 4; jj++) if (j * 64 + kt * 16 + 4 * q + jj <= t) vm |= 1u << (kt * 4 + jj);
            }
            nsa_block_step(Ks, VT, qf, O, m, l, vm, r, q);
        }
#pragma unroll
        for (int x = 0; x < 2; x++) {
            float lt = l[x];
            lt += __shfl_xor(lt, 16, 64);
            lt += __shfl_xor(lt, 32, 64);
            const float sc = sigmoidf_(bf2f(Z[(rowb + t) * ZC + ZGATE + 1 * 16 + g * 8 + 2 * wave + x])) / lt;
#pragma unroll
            for (int dt = 0; dt < 4; dt++) ofl[(wave * 8 + x * 4 + dt) * 64 + lane] += sc * O[x][dt];
        }
    }
    {
        f32x4 O[2][4];
        float m[2] = {-1e30f, -1e30f}, l[2] = {0.f, 0.f};
#pragma unroll
        for (int x = 0; x < 2; x++)
#pragma unroll
            for (int dt = 0; dt < 4; dt++) O[x][dt] = (f32x4){0.f, 0.f, 0.f, 0.f};
        const int lo = t0 - 511;
        const int jb0 = lo > 0 ? (lo >> 6) : 0;
        for (int j = jb0; j <= cur; j++) {
            __syncthreads();
            nsa_load_kv(Z + (rowb + j * 64) * ZC + ZKW + g * 64, Z + (rowb + j * 64) * ZC + ZVW + g * 64, ZC, Ks, VT);
            __syncthreads();
            unsigned vm = 0;
#pragma unroll
            for (int kt = 0; kt < 4; kt++)
#pragma unroll
                for (int jj = 0; jj < 4; jj++) { const int kp = j * 64 + kt * 16 + 4 * q + jj; if (kp <= t && t - kp < 512) vm |= 1u << (kt * 4 + jj); }
            nsa_block_step(Ks, VT, qf, O, m, l, vm, r, q);
        }
#pragma unroll
        for (int x = 0; x < 2; x++) {
            float lt = l[x];
            lt += __shfl_xor(lt, 16, 64);
            lt += __shfl_xor(lt, 32, 64);
            const float sc = sigmoidf_(bf2f(Z[(rowb + t) * ZC + ZGATE + 2 * 16 + g * 8 + 2 * wave + x])) / lt;
#pragma unroll
            for (int dt = 0; dt < 4; dt++) O[x][dt] = ofl[(wave * 8 + x * 4 + dt) * 64 + lane] + sc * O[x][dt];
        }
#pragma unroll
        for (int x = 0; x < 2; x++)
#pragma unroll
            for (int dt = 0; dt < 4; dt++) {
                const f32x4 v = O[x][dt];
                *(u32x2*)(Z + (rowb + t) * ZC + ZQ_N + (g * 8 + 2 * wave + x) * 64 + dt * 16 + 4 * q) = (u32x2){pack2(v[0], v[1]), pack2(v[2], v[3])};
            }
    }
    __syncthreads();
}

__device__ void phaseM1(const Params& p, char* lds) {
    const int lane = threadIdx.x & 63, wave = threadIdx.x >> 6;
    const int wr = wave >> 1, wc = wave & 1, r = lane & 15, q = lane >> 4;
    const bf16_t* H = (const bf16_t*)(p.ws + OFF_H);
    const bf16_t* Z = (const bf16_t*)(p.ws + OFF_Z);
    bf16_t* M = (bf16_t*)(p.ws + OFF_M);
    for (int task = blockIdx.x; task < 128 * 8; task += gridDim.x) {
        const int bn = task & 7, bm = task >> 3;
        const int m0 = bm * 128, n0 = bn * 128;
        for (int br = 0; br < 2; br++) {
            f32x4 acc[4][4];
            zero_acc(acc);
            gemm_core(acc, H, DM, (const bf16_t*)(p.ws + OFF_WM) + (size_t)br * 1024 * 1024, DM, DM, m0, n0, lds);
            unsigned sg[4][4][2];
#pragma unroll
            for (int mi = 0; mi < 4; mi++)
#pragma unroll
                for (int ni = 0; ni < 4; ni++) {
                    sg[mi][ni][0] = pack2(sigmoidf_(acc[mi][ni][0]), sigmoidf_(acc[mi][ni][1]));
                    sg[mi][ni][1] = pack2(sigmoidf_(acc[mi][ni][2]), sigmoidf_(acc[mi][ni][3]));
                }
            zero_acc(acc);
            gemm_core(acc, Z + (br ? ZQ_N : ZR_G), ZC, (const bf16_t*)(p.ws + (br ? OFF_WB : OFF_WA)), DM, DM, m0, n0, lds);
#pragma unroll
            for (int mi = 0; mi < 4; mi++)
#pragma unroll
                for (int ni = 0; ni < 4; ni++) {
                    const int tok = m0 + wr * 64 + mi * 16 + r, col = n0 + wc * 64 + ni * 16 + 4 * q;
                    float v[4] = {bf_lo(sg[mi][ni][0]) * acc[mi][ni][0], bf_hi(sg[mi][ni][0]) * acc[mi][ni][1],
                                  bf_lo(sg[mi][ni][1]) * acc[mi][ni][2], bf_hi(sg[mi][ni][1]) * acc[mi][ni][3]};
                    u32x2* dst = (u32x2*)(M + (size_t)tok * DM + col);
                    if (br) { const u32x2 pv = *dst; v[0] += bf_lo(pv.x); v[1] += bf_hi(pv.x); v[2] += bf_lo(pv.y); v[3] += bf_hi(pv.y); }
                    *dst = (u32x2){pack2(v[0], v[1]), pack2(v[2], v[3])};
                }
        }
    }
}

__device__ void phaseM2(const Params& p, char* lds) {
    const int lane = threadIdx.x & 63, wave = threadIdx.x >> 6;
    const int wr = wave >> 1, wc = wave & 1, r = lane & 15, q = lane >> 4;
    const bf16_t* M = (const bf16_t*)(p.ws + OFF_M);
    const float* mod = (const float*)(p.ws + OFF_MOD);
    for (int task = blockIdx.x; task < 128 * 8; task += gridDim.x) {
        const int bn = task & 7, bm = task >> 3;
        const int m0 = bm * 128, n0 = bn * 128;
        f32x4 acc[4][4];
        zero_acc(acc);
        gemm_core(acc, M, DM, (const bf16_t*)(p.ws + OFF_WO), DM, DM, m0, n0, lds);
#pragma unroll
        for (int mi = 0; mi < 4; mi++)
#pragma unroll
            for (int ni = 0; ni < 4; ni++) {
                const int tok = m0 + wr * 64 + mi * 16 + r, col = n0 + wc * 64 + ni * 16 + 4 * q;
                const f32x4 xv = *(const f32x4*)(p.x + (size_t)tok * DM + col);
                const f32x4 gt = *(const f32x4*)(mod + (tok >> 11) * 6144 + 2 * 1024 + col);
                *(f32x4*)(p.out + (size_t)tok * DM + col) = xv + gt * acc[mi][ni];
            }
    }
    bf16_t* ub = (bf16_t*)(p.ws + OFF_UB);
    bf16_t* vb = (bf16_t*)(p.ws + OFF_VB);
    for (size_t i = ((size_t)blockIdx.x * NTHREADS + threadIdx.x) * 8; i < (size_t)16384 * 1024; i += (size_t)gridDim.x * NTHREADS * 8) {
        const f32x4 a = *(const f32x4*)(p.peer_u + i), b = *(const f32x4*)(p.peer_u + i + 4);
        *(u32x4*)(ub + i) = (u32x4){pack2(a[0], a[1]), pack2(a[2], a[3]), pack2(b[0], b[1]), pack2(b[2], b[3])};
        const f32x4 c = *(const f32x4*)(p.peer_v + i), d = *(const f32x4*)(p.peer_v + i + 4);
        *(u32x4*)(vb + i) = (u32x4){pack2(c[0], c[1]), pack2(c[2], c[3]), pack2(d[0], d[1]), pack2(d[2], d[3])};
    }
}

__device__ void phaseP1(const Params& p, char* lds) {
    const int lane = threadIdx.x & 63, wave = threadIdx.x >> 6;
    const int wr = wave >> 1, wc = wave & 1, r = lane & 15, q = lane >> 4;
    const bf16_t* H = (const bf16_t*)(p.ws + OFF_H);
    bf16_t* QP = (bf16_t*)(p.ws + OFF_QP);
    for (int task = blockIdx.x; task < 128 * 16; task += gridDim.x) {
        const int bn = task & 15, bm = task >> 4;
        const int m0 = bm * 128, n0 = bn * 128;
        f32x4 acc[4][4];
        zero_acc(acc);
        gemm_core(acc, H, DM, (const bf16_t*)(p.ws + OFF_WQ), DM, DM, m0, n0, lds);
#pragma unroll
        for (int mi = 0; mi < 4; mi++)
#pragma unroll
            for (int ni = 0; ni < 4; ni++) {
                const int tok = m0 + wr * 64 + mi * 16 + r, col = n0 + wc * 64 + ni * 16 + 4 * q;
                const f32x4 v = acc[mi][ni];
                *(u32x2*)(QP + (size_t)tok * 2048 + col) = (u32x2){pack2(v[0], v[1]), pack2(v[2], v[3])};
            }
    }
}

__constant__ unsigned char c_cand_a[64] = {0,0,0,0,0,0,0,0,0,0,0,0,0,0,0,0, 1,1,1,1,1,1,1,1, 2,2,2,2,2, 3,3,3,3, 4,4,4, 5,5, 6,6, 7,7, 8,9,10,11,12,13,14,15, 0,0,0,0,0,0,0,0,0,0,0,0,0,0};
__constant__ unsigned char c_cand_b[64] = {0,1,2,3,4,5,6,7,8,9,10,11,12,13,14,15, 0,1,2,3,4,5,6,7, 0,1,2,3,4, 0,1,2,3, 0,1,2, 0,1, 0,1, 0,1, 0,0,0,0,0,0,0,0, 0,0,0,0,0,0,0,0,0,0,0,0,0,0};

__device__ __forceinline__ void wave_top16(float a0, float a1, int lane, float& outv, int& outi) {
    outv = 0.f; outi = 0;
    for (int it = 0; it < 16; it++) {
        const float m = wave_max(fmaxf(a0, a1));
        const unsigned long long b0 = __ballot(a0 == m);
        int idx;
        if (b0) idx = __ffsll((long long)b0) - 1;
        else { const unsigned long long b1 = __ballot(a1 == m); idx = 64 + __ffsll((long long)b1) - 1; }
        if (lane == it) { outv = m; outi = idx; }
        if (lane == (idx & 63)) { if (idx < 64) a0 = -INFINITY; else a1 = -INFINITY; }
    }
}

__device__ void phaseP2_task(const Params& p, int task, char* lds) {
    const int tid = threadIdx.x, lane = tid & 63, wave = tid >> 6, r = lane & 15, q = lane >> 4;
    const int h = task & 7, tile = task >> 3;
    const int tok0 = tile * 64;
    const bf16_t* QP = (const bf16_t*)(p.ws + OFF_QP);
    float* S1 = (float*)lds;
    float* S2 = (float*)(lds + 33792);
#pragma unroll
    for (int half = 0; half < 2; half++) {
        const bf16_t* KB = (const bf16_t*)(p.ws + OFF_K1B) + (size_t)half * 131072 + (size_t)h * 128 * 128;
        float* S = half ? S2 : S1;
        f32x4 acc[8];
#pragma unroll
        for (int nt = 0; nt < 8; nt++) acc[nt] = (f32x4){0.f, 0.f, 0.f, 0.f};
#pragma unroll
        for (int ks = 0; ks < 4; ks++) {
            const bf16x8 a = *(const bf16x8*)(QP + (size_t)(tok0 + wave * 16 + r) * 2048 + h * 256 + half * 128 + ks * 32 + q * 8);
#pragma unroll
            for (int nt = 0; nt < 8; nt++) {
                const bf16x8 bk = *(const bf16x8*)(KB + (size_t)(nt * 16 + r) * 128 + ks * 32 + q * 8);
                acc[nt] = mfma16(a, bk, acc[nt]);
            }
        }
#pragma unroll
        for (int nt = 0; nt < 8; nt++)
#pragma unroll
            for (int j = 0; j < 4; j++) S[(wave * 16 + 4 * q + j) * 132 + nt * 16 + r] = acc[nt][j];
    }
    __syncthreads();
    int* eidx = (int*)(p.ws + OFF_EIDX);
    float* gw = (float*)(p.ws + OFF_GW);
    const int ca = c_cand_a[lane], cb = c_cand_b[lane];
    for (int tl = wave * 16; tl < wave * 16 + 16; tl++) {
        float v1, v2; int i1, i2;
        wave_top16(S1[tl * 132 + lane], S1[tl * 132 + 64 + lane], lane, v1, i1);
        wave_top16(S2[tl * 132 + lane], S2[tl * 132 + 64 + lane], lane, v2, i2);
        const float va = __shfl(v1, ca, 64), vb = __shfl(v2, cb, 64);
        const int ia = __shfl(i1, ca, 64), ib = __shfl(i2, cb, 64);
        const float val = lane < 50 ? va + vb : -INFINITY;
        const int flat = lane < 50 ? ca * 16 + cb : 100000;
        int rank = 0;
#pragma unroll
        for (int c2 = 0; c2 < 50; c2++) {
            const float ov = __shfl(val, c2, 64);
            const int of = __shfl(flat, c2, 64);
            rank += (ov > val || (ov == val && of < flat)) ? 1 : 0;
        }
        const bool sel = (lane < 50) && (rank < 16);
        const float mx = wave_max(sel ? val : -INFINITY);
        const float e = sel ? __expf(val - mx) : 0.f;
        const float sum = wave_sum(e);
        if (sel) {
            const size_t o = (size_t)(tok0 + tl) * 128 + h * 16 + rank;
            eidx[o] = ia * 128 + ib;
            gw[o] = e / sum;
        }
    }
    __syncthreads();
}

__device__ void phaseP3(const Params& p) {
    const int lane = threadIdx.x & 63, wave = threadIdx.x >> 6;
    const bf16_t* H = (const bf16_t*)(p.ws + OFF_H);
    const bf16_t* UB = (const bf16_t*)(p.ws + OFF_UB);
    const bf16_t* VB = (const bf16_t*)(p.ws + OFF_VB);
    const int* eidx = (const int*)(p.ws + OFF_EIDX);
    const float* gwp = (const float*)(p.ws + OFF_GW);
    const float* mod = (const float*)(p.ws + OFF_MOD);
    for (int tok = blockIdx.x * 4 + wave; tok < NTOK; tok += gridDim.x * 4) {
        float hv[16];
#pragma unroll
        for (int c = 0; c < 2; c++) {
            const u32x4 a = *(const u32x4*)(H + (size_t)tok * DM + c * 512 + lane * 8);
            hv[c * 8 + 0] = bf_lo(a.x); hv[c * 8 + 1] = bf_hi(a.x); hv[c * 8 + 2] = bf_lo(a.y); hv[c * 8 + 3] = bf_hi(a.y);
            hv[c * 8 + 4] = bf_lo(a.z); hv[c * 8 + 5] = bf_hi(a.z); hv[c * 8 + 6] = bf_lo(a.w); hv[c * 8 + 7] = bf_hi(a.w);
        }
        const int e0 = eidx[(size_t)tok * 128 + lane], e1 = eidx[(size_t)tok * 128 + 64 + lane];
        const float g0 = gwp[(size_t)tok * 128 + lane], g1 = gwp[(size_t)tok * 128 + 64 + lane];
        float acc[16];
#pragma unroll
        for (int i = 0; i < 16; i++) acc[i] = 0.f;
        for (int jb = 0; jb < 128; jb += 4) {
            u32x4 uu[4][2], vv[4][2];
            float gg[4];
#pragma unroll
            for (int u = 0; u < 4; u++) {
                const int j = jb + u;
                const int e = (j < 64) ? __shfl(e0, j, 64) : __shfl(e1, j - 64, 64);
                gg[u] = (j < 64) ? __shfl(g0, j, 64) : __shfl(g1, j - 64, 64);
                uu[u][0] = *(const u32x4*)(UB + (size_t)e * DM + lane * 8);
                uu[u][1] = *(const u32x4*)(UB + (size_t)e * DM + 512 + lane * 8);
                vv[u][0] = *(const u32x4*)(VB + (size_t)e * DM + lane * 8);
                vv[u][1] = *(const u32x4*)(VB + (size_t)e * DM + 512 + lane * 8);
            }
#pragma unroll
            for (int u = 0; u < 4; u++) {
                float d = 0.f;
#pragma unroll
                for (int c = 0; c < 2; c++) {
                    const u32x4 a = uu[u][c];
                    d += bf_lo(a.x) * hv[c * 8 + 0] + bf_hi(a.x) * hv[c * 8 + 1] + bf_lo(a.y) * hv[c * 8 + 2] + bf_hi(a.y) * hv[c * 8 + 3]
                       + bf_lo(a.z) * hv[c * 8 + 4] + bf_hi(a.z) * hv[c * 8 + 5] + bf_lo(a.w) * hv[c * 8 + 6] + bf_hi(a.w) * hv[c * 8 + 7];
                }
                d = wave_sum(d);
                const float w = gg[u] * gelu_erf(d);
#pragma unroll
                for (int c = 0; c < 2; c++) {
                    const u32x4 a = vv[u][c];
                    acc[c * 8 + 0] += w * bf_lo(a.x); acc[c * 8 + 1] += w * bf_hi(a.x); acc[c * 8 + 2] += w * bf_lo(a.y); acc[c * 8 + 3] += w * bf_hi(a.y);
                    acc[c * 8 + 4] += w * bf_lo(a.z); acc[c * 8 + 5] += w * bf_hi(a.z); acc[c * 8 + 6] += w * bf_lo(a.w); acc[c * 8 + 7] += w * bf_hi(a.w);
                }
            }
        }
        const int b = tok >> 11;
        float x2[16];
        float ss = 0.f;
#pragma unroll
        for (int c = 0; c < 2; c++)
#pragma unroll
            for (int hf = 0; hf < 2; hf++) {
                const int d = c * 512 + lane * 8 + hf * 4;
                const f32x4 xv = *(const f32x4*)(p.out + (size_t)tok * DM + d);
                const f32x4 gt = *(const f32x4*)(mod + b * 6144 + 5 * 1024 + d);
#pragma unroll
                for (int j = 0; j < 4; j++) { const float v = xv[j] + gt[j] * acc[c * 8 + hf * 4 + j]; x2[c * 8 + hf * 4 + j] = v; ss += v * v; }
            }
        ss = wave_sum(ss);
        const float rstd = rsqrtf(ss * (1.f / 1024.f) + 1e-6f);
#pragma unroll
        for (int c = 0; c < 2; c++)
#pragma unroll
            for (int hf = 0; hf < 2; hf++) {
                const int d = c * 512 + lane * 8 + hf * 4;
                const f32x4 fg = *(const f32x4*)(p.final_g + d);
                f32x4 o;
#pragma unroll
                for (int j = 0; j < 4; j++) o[j] = x2[c * 8 + hf * 4 + j] * rstd * fg[j];
                *(f32x4*)(p.out + (size_t)tok * DM + d) = o;
            }
    }
}

#define XB_TMO      128
#define XB_XCNT(j)  (256  + 64 * (j))
#define XB_XSUB(j)  (1280 + 64 * (j))
#define XB_XGEN(j)  (2304 + 64 * (j))
#define XB_TOP      3328
#define XB_TOPGEN   3392
#define XCD_BAR_WORDS 3456
#define XB_SPIN_CAP (1u << 22)
#define LAS __attribute__((address_space(3)))
__device__ __forceinline__ unsigned xb_ld(unsigned* p)              { return __hip_atomic_load(p, __ATOMIC_RELAXED, __HIP_MEMORY_SCOPE_AGENT); }
__device__ __forceinline__ unsigned xb_add(unsigned* p, unsigned v) { return __hip_atomic_fetch_add(p, v, __ATOMIC_RELAXED, __HIP_MEMORY_SCOPE_AGENT); }
__device__ __forceinline__ unsigned xb_xcc_id() { return (unsigned)__builtin_amdgcn_s_getreg((3 << 11) | 20) & 0xFu; }
#define XB_SPIN(cond, bar) do { unsigned _sp = 0; while (cond) { __builtin_amdgcn_s_sleep(1); \
    if ((++_sp & 255u) == 0u) { if (xb_ld(&(bar)[XB_TMO])) break; if (_sp > XB_SPIN_CAP) { atomicAdd(&(bar)[XB_TMO], 1u); break; } } } } while (0)
struct XcdBarrier { unsigned* bar; unsigned x; volatile LAS unsigned* st; };
__device__ __forceinline__ XcdBarrier xcd_barrier_post(unsigned* bar, volatile LAS unsigned* st) {
    XcdBarrier b; b.bar = bar; b.x = xb_xcc_id(); b.st = st;
    if (threadIdx.x == 0) (void)xb_add(&bar[XB_XCNT(b.x)], 1u);
    return b;
}
__device__ __forceinline__ void xcd_barrier_complete(unsigned* bar, unsigned x, unsigned& nloc, unsigned& nx) {
    const unsigned G = gridDim.x * gridDim.y * gridDim.z;
    unsigned sum, cnt, mine, sp = 0u;
    for (;;) {
        sum = 0u; cnt = 0u; mine = 0u;
#pragma unroll
        for (unsigned j = 0; j < 16; ++j) { const unsigned c = xb_ld(&bar[XB_XCNT(j)]); sum += c; cnt += (c > 0u) ? 1u : 0u; mine = (j == x) ? c : mine; }
        if (sum == G) break;
        __builtin_amdgcn_s_sleep(1);
        if ((++sp & 255u) == 0u) { if (xb_ld(&bar[XB_TMO])) break; if (sp > XB_SPIN_CAP) { atomicAdd(&bar[XB_TMO], 1u); break; } }
    }
    nloc = mine > 0u ? mine : 1u; nx = cnt > 0u ? cnt : 1u;
}
__device__ __forceinline__ void xcd_barrier(const XcdBarrier& b) {
    asm volatile("s_waitcnt vmcnt(0)" ::: "memory");
    __syncthreads();
    if (threadIdx.x == 0) {
        unsigned* bar = b.bar;
        __builtin_amdgcn_s_waitcnt(0);
        unsigned nloc = b.st[0], nx = b.st[1];
        if (nloc == 0u) { xcd_barrier_complete(bar, b.x, nloc, nx); b.st[0] = nloc; b.st[1] = nx; }
        const unsigned old = xb_add(&bar[XB_XSUB(b.x)], 1u);
        const unsigned gen = old / nloc;
        if (old + 1u == (gen + 1u) * nloc) {
            __builtin_amdgcn_fence(__ATOMIC_RELEASE, "agent");
            asm volatile("s_waitcnt vmcnt(0)" ::: "memory");
            const unsigned og = xb_add(&bar[XB_TOP], 1u);
            const unsigned tg = og / nx;
            if (og + 1u == (tg + 1u) * nx) xb_add(&bar[XB_TOPGEN], 1u);
            else XB_SPIN(xb_ld(&bar[XB_TOPGEN]) == tg, bar);
            __builtin_amdgcn_fence(__ATOMIC_ACQUIRE, "agent");
            xb_add(&bar[XB_XGEN(b.x)], 1u);
            asm volatile("s_waitcnt vmcnt(0)" ::: "memory");
        } else {
            XB_SPIN(xb_ld(&bar[XB_XGEN(b.x)]) == gen, bar);
            __builtin_amdgcn_fence(__ATOMIC_ACQUIRE, "agent");
            asm volatile("s_waitcnt vmcnt(0)" ::: "memory");
        }
    }
    __syncthreads();
}

__global__ void __launch_bounds__(NTHREADS, 2) mega(Params p) {
    __shared__ __attribute__((aligned(16))) char lds[LDS_BYTES];
    cg::grid_group grid = cg::this_grid();
    volatile LAS unsigned* st = (volatile LAS unsigned*)(lds + LDS_MAIN);
    if (threadIdx.x < 4) st[threadIdx.x] = 0u;
    __syncthreads();
    XcdBarrier xb = xcd_barrier_post((unsigned*)p.ws, st);

    phaseA(p, lds);
    grid.sync();
    phase_modnorm(p, p.x, p.norm1_g, 0, 1, (bf16_t*)(p.ws + OFF_H));
    xcd_barrier(xb);
    phaseC(p, lds);
    xcd_barrier(xb);
    for (int task = blockIdx.x; task < 1024; task += gridDim.x) phaseG1_task(p, task, lds);
    for (int task = blockIdx.x; task < 256; task += gridDim.x) phaseN1_task(p, task, lds);
    xcd_barrier(xb);
    phaseG2(p);
    xcd_barrier(xb);
    for (int task = blockIdx.x; task < 2048; task += gridDim.x) phaseN2_task(p, task, lds);
    for (int task = blockIdx.x; task < 1024; task += gridDim.x) phaseG3_task(p, task, lds);
    xcd_barrier(xb);
    phaseM1(p, lds);
    xcd_barrier(xb);
    phaseM2(p, lds);
    xcd_barrier(xb);
    phase_modnorm(p, p.out, p.norm2_g, 3, 4, (bf16_t*)(p.ws + OFF_H));
    xcd_barrier(xb);
    phaseP1(p, lds);
    xcd_barrier(xb);
    for (int task = blockIdx.x; task < 2048; task += gridDim.x) phaseP2_task(p, task, lds);
    xcd_barrier(xb);
    phaseP3(p);
}

extern "C" void kernel_launch(void* const* d_in, const int* in_sizes, int n_in, void* d_out, int out_size, void* d_ws, size_t ws_size, hipStream_t stream) {
    Params p{};
    p.x = (const float*)d_in[0]; p.c = (const float*)d_in[1]; p.pos = (const int*)d_in[2]; p.ada_w = (const float*)d_in[3]; p.ada_b = (const float*)d_in[4];
    p.norm1_g = (const float*)d_in[5]; p.norm2_g = (const float*)d_in[6]; p.final_g = (const float*)d_in[7]; p.w_in = (const float*)d_in[8];
    p.gla_wa2 = (const float*)d_in[9]; p.gla_ba2 = (const float*)d_in[10]; p.gla_norm_g = (const float*)d_in[11]; p.pe_k = (const float*)d_in[12]; p.pe_v = (const float*)d_in[13];
    p.ck_w1 = (const float*)d_in[14]; p.ck_w2 = (const float*)d_in[15]; p.cv_w1 = (const float*)d_in[16]; p.cv_w2 = (const float*)d_in[17];
    p.w_branch_a = (const float*)d_in[18]; p.w_branch_b = (const float*)d_in[19]; p.w_out = (const float*)d_in[20]; p.peer_wq = (const float*)d_in[21];
    p.peer_k1 = (const float*)d_in[22]; p.peer_k2 = (const float*)d_in[23]; p.peer_u = (const float*)d_in[24]; p.peer_v = (const float*)d_in[25];
    p.out = (float*)d_out; p.ws = (char*)d_ws;
    static int grid_blocks = 0;
    if (!grid_blocks) {
        int dev = 0, cus = 0, per_cu = 0;
        hipGetDevice(&dev);
        hipDeviceGetAttribute(&cus, hipDeviceAttributeMultiprocessorCount, dev);
        hipOccupancyMaxActiveBlocksPerMultiprocessor(&per_cu, mega, NTHREADS, 0);
        if (per_cu > 2) per_cu = 2;
        if (per_cu < 1) per_cu = 1;
        grid_blocks = cus * per_cu;
    }
    hipMemsetAsync(d_ws, 0, XCD_BAR_WORDS * 4, stream);
    void* args[] = {&p};
    hipError_t e = hipLaunchCooperativeKernel((void*)mega, dim3(grid_blocks), dim3(NTHREADS), args, 0, stream);
    if (e != hipSuccess) fprintf(stderr, "cooperative launch failed: %s (grid %d)\n", hipGetErrorString(e), grid_blocks);
}
```

```cpp
#include <hip/hip_runtime.h>
#include <hip/hip_cooperative_groups.h>
#include <stdio.h>
namespace cg = cooperative_groups;
#include <stdint.h>
#include <stddef.h>
#include <math.h>

typedef unsigned short bf16_t;
typedef short bf16x8 __attribute__((ext_vector_type(8)));
typedef float f32x4 __attribute__((ext_vector_type(4)));
typedef unsigned u32x4 __attribute__((ext_vector_type(4)));
typedef unsigned u32x2 __attribute__((ext_vector_type(2)));

constexpr int DM = 1024, NB = 8, SEQ = 2048, NTOK = NB * SEQ;
constexpr int ZC = 4992;
constexpr int ZQ_G = 0, ZK_G = 512, ZV_G = 1024, ZR_G = 2048, ZQ_N = 3072, ZKC = 4096, ZVC = 4224, ZKS = 4352, ZVS = 4480,
              ZKW = 4608, ZVW = 4736, ZGATE = 4864, ZLR = 4912;
constexpr int LDS_MAIN = 73728;
constexpr int LDS_BYTES = LDS_MAIN + 64;
constexpr int NTHREADS = 256;

constexpr size_t OFF_MOD = 16384;
constexpr size_t OFF_ROPE = 212992;
constexpr size_t OFF_CMP = 1261568;
constexpr size_t OFF_DEC = 1785856;
constexpr size_t OFF_K1B = 2310144;
constexpr size_t OFF_WC1 = 2834432;
constexpr size_t OFF_WIN = 4194304;
constexpr size_t OFF_WM = 14417920;
constexpr size_t OFF_WA = 18612224;
constexpr size_t OFF_WB = 20709376;
constexpr size_t OFF_WO = 22806528;
constexpr size_t OFF_WQ = 24903680;
constexpr size_t OFF_H = 29360128;
constexpr size_t OFF_M = 62914560;
constexpr size_t OFF_Z = 96468992;
constexpr size_t OFF_QP = OFF_Z;
constexpr size_t OFF_UB = OFF_Z + 67108864;
constexpr size_t OFF_VB = OFF_UB + 33554432;
constexpr size_t OFF_EIDX = OFF_VB + 33554432;
constexpr size_t OFF_GW = OFF_EIDX + 8388608;

struct Params {
    const float* x; const float* c; const int* pos; const float* ada_w; const float* ada_b;
    const float* norm1_g; const float* norm2_g; const float* final_g; const float* w_in;
    const float* gla_wa2; const float* gla_ba2; const float* gla_norm_g; const float* pe_k; const float* pe_v;
    const float* ck_w1; const float* ck_w2; const float* cv_w1; const float* cv_w2;
    const float* w_branch_a; const float* w_branch_b; const float* w_out; const float* peer_wq;
    const float* peer_k1; const float* peer_k2; const float* peer_u; const float* peer_v;
    float* out; char* ws;
};

__device__ __forceinline__ unsigned f2bf_u(float f) { unsigned u = __float_as_uint(f); return (u + 0x7fffu + ((u >> 16) & 1u)) >> 16; }
__device__ __forceinline__ bf16_t f2bf(float f) { return (bf16_t)f2bf_u(f); }
__device__ __forceinline__ unsigned pack2(float lo, float hi) { return f2bf_u(lo) | (f2bf_u(hi) << 16); }
__device__ __forceinline__ float bf_lo(unsigned u) { return __uint_as_float(u << 16); }
__device__ __forceinline__ float bf_hi(unsigned u) { return __uint_as_float(u & 0xffff0000u); }
__device__ __forceinline__ float bf2f(bf16_t h) { return __uint_as_float(((unsigned)h) << 16); }
__device__ __forceinline__ float wave_sum(float v) {
#pragma unroll
    for (int o = 32; o > 0; o >>= 1) v += __shfl_xor(v, o, 64);
    return v;
}
__device__ __forceinline__ float wave_max(float v) {
#pragma unroll
    for (int o = 32; o > 0; o >>= 1) v = fmaxf(v, __shfl_xor(v, o, 64));
    return v;
}
__device__ __forceinline__ float sigmoidf_(float x) { return 1.f / (1.f + __expf(-x)); }
__device__ __forceinline__ float siluf_(float x) { return x / (1.f + __expf(-x)); }
__device__ __forceinline__ float gelu_erf(float x) { return 0.5f * x * (1.f + erff(x * 0.70710678118654752f)); }
__device__ __forceinline__ f32x4 mfma16(bf16x8 a, bf16x8 b, f32x4 c) { return __builtin_amdgcn_mfma_f32_16x16x32_bf16(a, b, c, 0, 0, 0); }
__device__ __forceinline__ bf16x8 ld_frag(const bf16_t* p) { return *(const bf16x8*)p; }
__device__ __forceinline__ bf16x8 mk_frag(u32x2 lo, u32x2 hi) { u32x4 t = {lo.x, lo.y, hi.x, hi.y}; return __builtin_bit_cast(bf16x8, t); }

__device__ __forceinline__ void gemm_core(f32x4 (&acc)[4][4], const bf16_t* __restrict__ X, int ldx, const bf16_t* __restrict__ W, int ldw,
                                          int K, int m0, int n0, char* lds) {
    const int tid = threadIdx.x, lane = tid & 63, wave = tid >> 6;
    const int wr = wave >> 1, wc = wave & 1, r = lane & 15, q = lane >> 4;
    bf16_t* Xs = (bf16_t*)lds;
    bf16_t* Ws = Xs + 2 * 128 * 72;
    const int lr = tid >> 3, lc = tid & 7;
    const bf16_t* xg = X + (size_t)(m0 + lr) * ldx + lc * 8;
    const bf16_t* wg = W + (size_t)(n0 + lr) * ldw + lc * 8;
    u32x4 xr[4], wv[4];
    const int KT = K / 64;
#pragma unroll
    for (int p = 0; p < 4; p++) { xr[p] = *(const u32x4*)(xg + (size_t)p * 32 * ldx); wv[p] = *(const u32x4*)(wg + (size_t)p * 32 * ldw); }
#pragma unroll
    for (int p = 0; p < 4; p++) { *(u32x4*)(Xs + (p * 32 + lr) * 72 + lc * 8) = xr[p]; *(u32x4*)(Ws + (p * 32 + lr) * 72 + lc * 8) = wv[p]; }
    __syncthreads();
    for (int kt = 0; kt < KT; kt++) {
        const bool more = (kt + 1 < KT);
        if (more) {
#pragma unroll
            for (int p = 0; p < 4; p++) {
                xr[p] = *(const u32x4*)(xg + (size_t)p * 32 * ldx + (kt + 1) * 64);
                wv[p] = *(const u32x4*)(wg + (size_t)p * 32 * ldw + (kt + 1) * 64);
            }
        }
        const bf16_t* xs = Xs + (kt & 1) * 128 * 72;
        const bf16_t* ws = Ws + (kt & 1) * 128 * 72;
#pragma unroll
        for (int ks = 0; ks < 2; ks++) {
            bf16x8 af[4], bfr[4];
#pragma unroll
            for (int ni = 0; ni < 4; ni++) af[ni] = ld_frag(ws + (wc * 64 + ni * 16 + r) * 72 + ks * 32 + q * 8);
#pragma unroll
            for (int mi = 0; mi < 4; mi++) bfr[mi] = ld_frag(xs + (wr * 64 + mi * 16 + r) * 72 + ks * 32 + q * 8);
#pragma unroll
            for (int mi = 0; mi < 4; mi++)
#pragma unroll
                for (int ni = 0; ni < 4; ni++) acc[mi][ni] = mfma16(af[ni], bfr[mi], acc[mi][ni]);
        }
        if (more) {
            bf16_t* xd = Xs + ((kt + 1) & 1) * 128 * 72;
            bf16_t* wd = Ws + ((kt + 1) & 1) * 128 * 72;
#pragma unroll
            for (int p = 0; p < 4; p++) { *(u32x4*)(xd + (p * 32 + lr) * 72 + lc * 8) = xr[p]; *(u32x4*)(wd + (p * 32 + lr) * 72 + lc * 8) = wv[p]; }
        }
        __syncthreads();
    }
}
__device__ __forceinline__ void zero_acc(f32x4 (&acc)[4][4]) {
#pragma unroll
    for (int a = 0; a < 4; a++)
#pragma unroll
        for (int b = 0; b < 4; b++) acc[a][b] = (f32x4){0.f, 0.f, 0.f, 0.f};
}

struct MapId { __device__ int operator()(int n) const { return n; } };
struct MapWin {
    __device__ int operator()(int n) const { return n < 3072 ? n : (n < 4912 ? n + 16 : (n < 4928 ? n - 1840 : -1)); }
};
struct MapOff { int off; __device__ int operator()(int n) const { return n + off; } };

template <class Map>
__device__ __forceinline__ void tconv_tile(const float* __restrict__ src, int ldsrc, bf16_t* __restrict__ dst, int ldd, int n0, int k0, Map map, float* t) {
    const int tid = threadIdx.x;
    const int n = tid & 63, kb = tid >> 6;
    const int sc = map(n0 + n);
#pragma unroll
    for (int i = 0; i < 16; i++) { const int k = i * 4 + kb; t[k * 65 + n] = sc >= 0 ? src[(size_t)(k0 + k) * ldsrc + sc] : 0.f; }
    __syncthreads();
    const int nn = tid >> 2, kk = (tid & 3) * 16;
    unsigned w[8];
#pragma unroll
    for (int j = 0; j < 8; j++) w[j] = pack2(t[(kk + 2 * j) * 65 + nn], t[(kk + 2 * j + 1) * 65 + nn]);
    u32x4* d = (u32x4*)(dst + (size_t)(n0 + nn) * ldd + k0 + kk);
    d[0] = (u32x4){w[0], w[1], w[2], w[3]};
    d[1] = (u32x4){w[4], w[5], w[6], w[7]};
    __syncthreads();
}

constexpr int TA_MOD = 192, TA_WIN = 78 * 16, TA_WM = 32 * 16, TA_SQ = 16 * 16, TA_WQ = 32 * 16, TA_WC = 32, TA_K12 = 64, TA_ROPE = 512;
constexpr int TA_E0 = TA_MOD, TA_E1 = TA_E0 + TA_WIN, TA_E2 = TA_E1 + TA_WM, TA_E3 = TA_E2 + TA_SQ, TA_E4 = TA_E3 + TA_SQ, TA_E5 = TA_E4 + TA_SQ,
              TA_E6 = TA_E5 + TA_WQ, TA_E7 = TA_E6 + TA_WC, TA_E8 = TA_E7 + TA_WC, TA_E9 = TA_E8 + TA_K12, TA_E10 = TA_E9 + TA_K12, TA_E11 = TA_E10 + TA_ROPE;

__device__ void phaseA(const Params& p, char* lds) {
    const int tid = threadIdx.x;
    float* fl = (float*)lds;
    for (int task = blockIdx.x; task < TA_E11; task += gridDim.x) {
        if (task < TA_E0) {
            float* sc = fl;
            float* red = fl + 8192;
            for (int i = tid; i < 8192; i += NTHREADS) sc[i] = siluf_(p.c[i]);
            __syncthreads();
            const int n = task * 32 + (tid & 31), kg = tid >> 5;
            float a[8];
#pragma unroll
            for (int b = 0; b < 8; b++) a[b] = 0.f;
            for (int k = kg * 128; k < kg * 128 + 128; k++) {
                const float w = p.ada_w[(size_t)k * 6144 + n];
#pragma unroll
                for (int b = 0; b < 8; b++) a[b] += sc[b * 1024 + k] * w;
            }
#pragma unroll
            for (int b = 0; b < 8; b++) red[(kg * 8 + b) * 32 + (tid & 31)] = a[b];
            __syncthreads();
            {
                const int b = tid >> 5, nn = tid & 31;
                float s = 0.f;
#pragma unroll
                for (int g = 0; g < 8; g++) s += red[(g * 8 + b) * 32 + nn];
                ((float*)(p.ws + OFF_MOD))[b * 6144 + task * 32 + nn] = s + p.ada_b[task * 32 + nn];
            }
            __syncthreads();
        } else if (task < TA_E1) {
            const int tt = task - TA_E0;
            tconv_tile(p.w_in, 6976, (bf16_t*)(p.ws + OFF_WIN), 1024, (tt >> 4) * 64, (tt & 15) * 64, MapWin(), fl);
        } else if (task < TA_E2) {
            const int tt = task - TA_E1;
            tconv_tile(p.w_in, 6976, (bf16_t*)(p.ws + OFF_WM), 1024, (tt >> 4) * 64, (tt & 15) * 64, MapOff{4928}, fl);
        } else if (task < TA_E3) {
            const int tt = task - TA_E2;
            tconv_tile(p.w_branch_a, 1024, (bf16_t*)(p.ws + OFF_WA), 1024, (tt >> 4) * 64, (tt & 15) * 64, MapId(), fl);
        } else if (task < TA_E4) {
            const int tt = task - TA_E3;
            tconv_tile(p.w_branch_b, 1024, (bf16_t*)(p.ws + OFF_WB), 1024, (tt >> 4) * 64, (tt & 15) * 64, MapId(), fl);
        } else if (task < TA_E5) {
            const int tt = task - TA_E4;
            tconv_tile(p.w_out, 1024, (bf16_t*)(p.ws + OFF_WO), 1024, (tt >> 4) * 64, (tt & 15) * 64, MapId(), fl);
        } else if (task < TA_E6) {
            const int tt = task - TA_E5;
            tconv_tile(p.peer_wq, 2048, (bf16_t*)(p.ws + OFF_WQ), 1024, (tt >> 4) * 64, (tt & 15) * 64, MapId(), fl);
        } else if (task < TA_E7) {
            const int tt = task - TA_E6;
            tconv_tile(p.ck_w1, 64, (bf16_t*)(p.ws + OFF_WC1), 2048, 0, tt * 64, MapId(), fl);
        } else if (task < TA_E8) {
            const int tt = task - TA_E7;
            tconv_tile(p.cv_w1, 64, (bf16_t*)(p.ws + OFF_WC1) + 64 * 2048, 2048, 0, tt * 64, MapId(), fl);
        } else if (task < TA_E10) {
            const bool second = task >= TA_E9;
            const int tt = task - (second ? TA_E9 : TA_E8);
            const float* src = second ? p.peer_k2 : p.peer_k1;
            bf16_t* dst = (bf16_t*)(p.ws + OFF_K1B) + (second ? 131072 : 0);
            const int i = tt * 2048 + tid * 8;
            const f32x4 a = *(const f32x4*)(src + i), b = *(const f32x4*)(src + i + 4);
            *(u32x4*)(dst + i) = (u32x4){pack2(a[0], a[1]), pack2(a[2], a[3]), pack2(b[0], b[1]), pack2(b[2], b[3])};
        } else {
            const int tt = task - TA_E10;
            const int e = tt * 256 + tid;
            const int tok = e >> 3, i = e & 7;
            const float invf[8] = {1.0f, 0.1939227432012558f, 0.03760603070259094f, 0.007292664609849453f,
                                   0.0014142135623842478f, 0.00027424818836152554f, 5.318296098266728e-05f, 1.0313386155758053e-05f};
            float fr = invf[0];
#pragma unroll
            for (int j = 1; j < 8; j++) fr = (i == j) ? invf[j] : fr;
            const float ang = (float)p.pos[tok] * fr;
            const double rev = (double)ang * 0.15915494309189533577;
            const float fpart = (float)(rev - floor(rev));
            float* cs = (float*)(p.ws + OFF_ROPE);
            cs[e * 2] = __builtin_amdgcn_cosf(fpart);
            cs[e * 2 + 1] = __builtin_amdgcn_sinf(fpart);
        }
    }
}

__device__ void phase_modnorm(const Params& p, const float* __restrict__ src, const float* __restrict__ g, int shift_idx, int scale_idx, bf16_t* __restrict__ dst) {
    const int lane = threadIdx.x & 63, wave = threadIdx.x >> 6;
    const float* mod = (const float*)(p.ws + OFF_MOD);
    for (int tok = blockIdx.x * 4 + wave; tok < NTOK; tok += gridDim.x * 4) {
        const int b = tok >> 11;
        const float* xr = src + (size_t)tok * DM;
        f32x4 v[4];
        float ss = 0.f;
#pragma unroll
        for (int c = 0; c < 4; c++) { v[c] = *(const f32x4*)(xr + c * 256 + lane * 4); ss += v[c][0] * v[c][0] + v[c][1] * v[c][1] + v[c][2] * v[c][2] + v[c][3] * v[c][3]; }
        ss = wave_sum(ss);
        const float rstd = rsqrtf(ss * (1.f / 1024.f) + 1e-6f);
#pragma unroll
        for (int c = 0; c < 4; c++) {
            const int d = c * 256 + lane * 4;
            const f32x4 gg = *(const f32x4*)(g + d);
            const f32x4 sc = *(const f32x4*)(mod + b * 6144 + scale_idx * 1024 + d);
            const f32x4 sh = *(const f32x4*)(mod + b * 6144 + shift_idx * 1024 + d);
            float o[4];
#pragma unroll
            for (int j = 0; j < 4; j++) o[j] = (v[c][j] * rstd) * gg[j] * (1.f + sc[j]) + sh[j];
            *(u32x2*)(dst + (size_t)tok * DM + d) = (u32x2){pack2(o[0], o[1]), pack2(o[2], o[3])};
        }
    }
}

__device__ void phaseC(const Params& p, char* lds) {
    const int lane = threadIdx.x & 63, wave = threadIdx.x >> 6;
    const int wr = wave >> 1, wc = wave & 1, r = lane & 15, q = lane >> 4;
    const bf16_t* H = (const bf16_t*)(p.ws + OFF_H);
    const bf16_t* W = (const bf16_t*)(p.ws + OFF_WIN);
    bf16_t* Z = (bf16_t*)(p.ws + OFF_Z);
    const float* cs = (const float*)(p.ws + OFF_ROPE);
    constexpr int NTN = ZC / 128;
    for (int task = blockIdx.x; task < 128 * NTN; task += gridDim.x) {
        const int bn = task % NTN, bm = task / NTN;
        const int m0 = bm * 128, n0 = bn * 128;
        f32x4 acc[4][4];
        zero_acc(acc);
        gemm_core(acc, H, DM, W, DM, DM, m0, n0, lds);
        const bool rope = (bn >= 24 && bn <= 31) || bn == 32 || bn == 34 || bn == 36;
        const float scl = (bn >= 24 && bn <= 31) ? 0.125f : 1.f;
#pragma unroll
        for (int mi = 0; mi < 4; mi++) {
            const int tok = m0 + wr * 64 + mi * 16 + r;
            if (rope) {
                f32x4 v = acc[mi][0];
                f32x4 pr;
#pragma unroll
                for (int j = 0; j < 4; j++) pr[j] = __shfl_xor(v[j], 32, 64);
                const int ib = (q & 1) * 4;
                const f32x4 c0 = *(const f32x4*)(cs + (size_t)tok * 16 + ib * 2);
                const f32x4 c1 = *(const f32x4*)(cs + (size_t)tok * 16 + ib * 2 + 4);
                const float cc[4] = {c0[0], c0[2], c1[0], c1[2]}, sn[4] = {c0[1], c0[3], c1[1], c1[3]};
#pragma unroll
                for (int j = 0; j < 4; j++) v[j] = (q < 2) ? (v[j] * cc[j] - pr[j] * sn[j]) : (v[j] * cc[j] + pr[j] * sn[j]);
                acc[mi][0] = v;
            }
#pragma unroll
            for (int ni = 0; ni < 4; ni++) {
                const f32x4 v = acc[mi][ni] * scl;
                *(u32x2*)(Z + (size_t)tok * ZC + n0 + wc * 64 + ni * 16 + q * 4) = (u32x2){pack2(v[0], v[1]), pack2(v[2], v[3])};
            }
        }
    }
}

__device__ __forceinline__ void gla_prep(const Params& p, int tok0, int h, char* lds) {
    const int tid = threadIdx.x;
    float* bc = (float*)lds;
    float* lrs = (float*)(lds + 32768);
    const bf16_t* Z = (const bf16_t*)(p.ws + OFF_Z);
    for (int i = tid; i < 1024; i += NTHREADS) { const int t = i >> 4, rr = i & 15; lrs[i] = bf2f(Z[(size_t)(tok0 + t) * ZC + ZLR + rr]); }
    const int d = tid & 127, th = tid >> 7;
    float w[16];
#pragma unroll
    for (int rr = 0; rr < 16; rr++) w[rr] = p.gla_wa2[rr * 512 + h * 128 + d];
    const float bias = p.gla_ba2[h * 128 + d];
    __syncthreads();
    float run = 0.f;
    for (int t = th * 32; t < th * 32 + 32; t++) {
        float xv = bias;
#pragma unroll
        for (int rr = 0; rr < 16; rr++) xv += lrs[t * 16 + rr] * w[rr];
        const float ls = fminf(xv, 0.f) - log1pf(__expf(-fabsf(xv)));
        run += ls * (1.f / 16.f);
        bc[t * 128 + d] = run;
    }
    __syncthreads();
    if (th == 1) {
        const float add = bc[31 * 128 + d];
        for (int t = 32; t < 64; t++) bc[t * 128 + d] += add;
    }
    __syncthreads();
}

__device__ void phaseG1_task(const Params& p, int task, char* lds) {
    const int tid = threadIdx.x, lane = tid & 63, wave = tid >> 6, r = lane & 15, q = lane >> 4;
    const int c = task & 31, h = (task >> 5) & 3, b = task >> 7;
    const int tok0 = b * SEQ + c * 64;
    const bf16_t* Z = (const bf16_t*)(p.ws + OFF_Z);
    bf16_t* L = (bf16_t*)p.out;
    float* bc = (float*)lds;
    bf16_t* klT = (bf16_t*)(lds + 36864);
    bf16_t* vT = (bf16_t*)(lds + 36864 + 18432);
    gla_prep(p, tok0, h, lds);
    if (tid < 128) ((float*)(p.ws + OFF_DEC))[task * 128 + tid] = __expf(bc[63 * 128 + tid]);
    {
        const int s = lane, dc = wave * 32;
        const bf16_t* kp = Z + (size_t)(tok0 + s) * ZC + ZK_G + h * 128 + dc;
#pragma unroll
        for (int v4 = 0; v4 < 4; v4++) {
            const u32x4 kv = *(const u32x4*)(kp + v4 * 8);
            const unsigned kw[4] = {kv.x, kv.y, kv.z, kv.w};
#pragma unroll
            for (int j = 0; j < 8; j++) {
                const int d = dc + v4 * 8 + j;
                const float kval = (j & 1) ? bf_hi(kw[j >> 1]) : bf_lo(kw[j >> 1]);
                klT[d * 72 + s] = f2bf(kval * __expf(bc[63 * 128 + d] - bc[s * 128 + d]));
            }
        }
    }
    for (int eh = 0; eh < 2; eh++) {
        __syncthreads();
        {
            const int s = lane, ec = wave * 32;
            const bf16_t* vp = Z + (size_t)(tok0 + s) * ZC + ZV_G + h * 256 + eh * 128 + ec;
#pragma unroll
            for (int v4 = 0; v4 < 4; v4++) {
                const u32x4 vv = *(const u32x4*)(vp + v4 * 8);
                const unsigned vw[4] = {vv.x, vv.y, vv.z, vv.w};
#pragma unroll
                for (int j = 0; j < 8; j++) vT[(ec + v4 * 8 + j) * 72 + s] = (bf16_t)((j & 1) ? (vw[j >> 1] >> 16) : (vw[j >> 1] & 0xffffu));
            }
        }
        __syncthreads();
        f32x4 acc[8][2];
#pragma unroll
        for (int dt = 0; dt < 8; dt++) { acc[dt][0] = (f32x4){0.f, 0.f, 0.f, 0.f}; acc[dt][1] = (f32x4){0.f, 0.f, 0.f, 0.f}; }
#pragma unroll
        for (int ks = 0; ks < 2; ks++) {
            bf16x8 bv[2];
#pragma unroll
            for (int x = 0; x < 2; x++) bv[x] = ld_frag(vT + ((2 * wave + x) * 16 + r) * 72 + ks * 32 + q * 8);
#pragma unroll
            for (int dt = 0; dt < 8; dt++) {
                const bf16x8 a = ld_frag(klT + (dt * 16 + r) * 72 + ks * 32 + q * 8);
#pragma unroll
                for (int x = 0; x < 2; x++) acc[dt][x] = mfma16(a, bv[x], acc[dt][x]);
            }
        }
#pragma unroll
        for (int dt = 0; dt < 8; dt++)
#pragma unroll
            for (int x = 0; x < 2; x++) {
                const int e = eh * 128 + (2 * wave + x) * 16 + r, d = dt * 16 + 4 * q;
                const f32x4 v = acc[dt][x];
                *(u32x2*)(L + ((size_t)task * 256 + e) * 128 + d) = (u32x2){pack2(v[0], v[1]), pack2(v[2], v[3])};
            }
    }
    __syncthreads();
}

__device__ void phaseG2(const Params& p) {
    bf16_t* L = (bf16_t*)p.out;
    const float* dec = (const float*)(p.ws + OFF_DEC);
    for (int idx = blockIdx.x * NTHREADS + threadIdx.x; idx < 32 * 256 * 16; idx += gridDim.x * NTHREADS) {
        const int d8 = idx & 15, e = (idx >> 4) & 255, bh = idx >> 12;
        float st[8];
#pragma unroll
        for (int j = 0; j < 8; j++) st[j] = 0.f;
        for (int c = 0; c < 32; c++) {
            const int task = bh * 32 + c;
            u32x4* ptr = (u32x4*)(L + ((size_t)task * 256 + e) * 128 + d8 * 8);
            const u32x4 lv = *ptr;
            const f32x4 d0 = *(const f32x4*)(dec + task * 128 + d8 * 8), d1 = *(const f32x4*)(dec + task * 128 + d8 * 8 + 4);
            *ptr = (u32x4){pack2(st[0], st[1]), pack2(st[2], st[3]), pack2(st[4], st[5]), pack2(st[6], st[7])};
            st[0] = d0[0] * st[0] + bf_lo(lv.x); st[1] = d0[1] * st[1] + bf_hi(lv.x);
            st[2] = d0[2] * st[2] + bf_lo(lv.y); st[3] = d0[3] * st[3] + bf_hi(lv.y);
            st[4] = d1[0] * st[4] + bf_lo(lv.z); st[5] = d1[1] * st[5] + bf_hi(lv.z);
            st[6] = d1[2] * st[6] + bf_lo(lv.w); st[7] = d1[3] * st[7] + bf_hi(lv.w);
        }
    }
}

__device__ void phaseG3_task(const Params& p, int task, char* lds) {
    const int tid = threadIdx.x, lane = tid & 63, wave = tid >> 6, r = lane & 15, q = lane >> 4;
    const int c = task & 31, h = (task >> 5) & 3, b = task >> 7;
    const int tok0 = b * SEQ + c * 64;
    bf16_t* Z = (bf16_t*)(p.ws + OFF_Z);
    const bf16_t* ST = (const bf16_t*)p.out + (size_t)task * 256 * 128;
    float* bc = (float*)lds;
    bf16_t* vT = (bf16_t*)lds;
    bf16_t* qg = (bf16_t*)(lds + 36864);
    bf16_t* kg = (bf16_t*)(lds + 36864 + 17408);
    bf16_t* P = kg;
    float* red = (float*)(lds + 36864 + 2 * 17408);
    gla_prep(p, tok0, h, lds);
    {
        const int t = tid >> 2, dc = (tid & 3) * 32;
        const bf16_t* qp = Z + (size_t)(tok0 + t) * ZC + ZQ_G + h * 128 + dc;
        const bf16_t* kp = Z + (size_t)(tok0 + t) * ZC + ZK_G + h * 128 + dc;
#pragma unroll
        for (int v4 = 0; v4 < 4; v4++) {
            const u32x4 qv = *(const u32x4*)(qp + v4 * 8), kv = *(const u32x4*)(kp + v4 * 8);
            const unsigned qw[4] = {qv.x, qv.y, qv.z, qv.w}, kw[4] = {kv.x, kv.y, kv.z, kv.w};
            unsigned qo[4], ko[4];
#pragma unroll
            for (int j2 = 0; j2 < 4; j2++) {
                const int d = dc + v4 * 8 + j2 * 2;
                const float b0 = bc[t * 128 + d], b1 = bc[t * 128 + d + 1];
                qo[j2] = pack2(bf_lo(qw[j2]) * 0.08838834764831845f * __expf(b0), bf_hi(qw[j2]) * 0.08838834764831845f * __expf(b1));
                ko[j2] = pack2(bf_lo(kw[j2]) * __expf(-b0), bf_hi(kw[j2]) * __expf(-b1));
            }
            *(u32x4*)(qg + t * 136 + dc + v4 * 8) = (u32x4){qo[0], qo[1], qo[2], qo[3]};
            *(u32x4*)(kg + t * 136 + dc + v4 * 8) = (u32x4){ko[0], ko[1], ko[2], ko[3]};
        }
    }
    __syncthreads();
    {
        const int s = lane, ec = wave * 64;
        const bf16_t* vp = Z + (size_t)(tok0 + s) * ZC + ZV_G + h * 256 + ec;
#pragma unroll
        for (int v4 = 0; v4 < 8; v4++) {
            const u32x4 vv = *(const u32x4*)(vp + v4 * 8);
            const unsigned vw[4] = {vv.x, vv.y, vv.z, vv.w};
#pragma unroll
            for (int j = 0; j < 8; j++) vT[(ec + v4 * 8 + j) * 72 + s] = (bf16_t)((j & 1) ? (vw[j >> 1] >> 16) : (vw[j >> 1] & 0xffffu));
        }
    }
    f32x4 sc[4];
#pragma unroll
    for (int st = 0; st < 4; st++) sc[st] = (f32x4){0.f, 0.f, 0.f, 0.f};
    {
        bf16x8 qf[4];
#pragma unroll
        for (int ks = 0; ks < 4; ks++) qf[ks] = ld_frag(qg + (wave * 16 + r) * 136 + ks * 32 + q * 8);
#pragma unroll
        for (int st = 0; st < 4; st++) {
            if (st <= wave) {
#pragma unroll
                for (int ks = 0; ks < 4; ks++) sc[st] = mfma16(ld_frag(kg + (st * 16 + r) * 136 + ks * 32 + q * 8), qf[ks], sc[st]);
            }
        }
    }
    __syncthreads();
    {
        const int t = wave * 16 + r;
#pragma unroll
        for (int st = 0; st < 4; st++) {
            float pv[4];
#pragma unroll
            for (int j = 0; j < 4; j++) { const int s = st * 16 + 4 * q + j; pv[j] = (s <= t) ? sc[st][j] : 0.f; }
            *(u32x2*)(P + t * 72 + st * 16 + 4 * q) = (u32x2){pack2(pv[0], pv[1]), pack2(pv[2], pv[3])};
        }
    }
    __syncthreads();
    f32x4 o[4][4];
#pragma unroll
    for (int et = 0; et < 4; et++)
#pragma unroll
        for (int tt = 0; tt < 4; tt++) o[et][tt] = (f32x4){0.f, 0.f, 0.f, 0.f};
#pragma unroll
    for (int ks = 0; ks < 2; ks++) {
        bf16x8 pf[4];
#pragma unroll
        for (int tt = 0; tt < 4; tt++) pf[tt] = ld_frag(P + (tt * 16 + r) * 72 + ks * 32 + q * 8);
#pragma unroll
        for (int et = 0; et < 4; et++) {
            const bf16x8 a = ld_frag(vT + ((wave * 4 + et) * 16 + r) * 72 + ks * 32 + q * 8);
#pragma unroll
            for (int tt = 0; tt < 4; tt++) o[et][tt] = mfma16(a, pf[tt], o[et][tt]);
        }
    }
#pragma unroll
    for (int ks = 0; ks < 4; ks++) {
        bf16x8 qf[4];
#pragma unroll
        for (int tt = 0; tt < 4; tt++) qf[tt] = ld_frag(qg + (tt * 16 + r) * 136 + ks * 32 + q * 8);
#pragma unroll
        for (int et = 0; et < 4; et++) {
            const bf16x8 a = *(const bf16x8*)(ST + (size_t)((wave * 4 + et) * 16 + r) * 128 + ks * 32 + q * 8);
#pragma unroll
            for (int tt = 0; tt < 4; tt++) o[et][tt] = mfma16(a, qf[tt], o[et][tt]);
        }
    }
#pragma unroll
    for (int tt = 0; tt < 4; tt++) {
        float ss = 0.f;
#pragma unroll
        for (int et = 0; et < 4; et++)
#pragma unroll
            for (int j = 0; j < 4; j++) ss += o[et][tt][j] * o[et][tt][j];
        ss += __shfl_xor(ss, 16, 64);
        ss += __shfl_xor(ss, 32, 64);
        if (q == 0) red[wave * 64 + tt * 16 + r] = ss;
    }
    __syncthreads();
#pragma unroll
    for (int tt = 0; tt < 4; tt++) {
        const int t = tt * 16 + r;
        const float tot = red[t] + red[64 + t] + red[128 + t] + red[192 + t];
        const float rstd = rsqrtf(tot * (1.f / 256.f) + 1e-6f);
#pragma unroll
        for (int et = 0; et < 4; et++) {
            const int e = (wave * 4 + et) * 16 + 4 * q;
            bf16_t* rp = Z + (size_t)(tok0 + t) * ZC + ZR_G + h * 256 + e;
            const u32x2 rv = *(const u32x2*)rp;
            const f32x4 gn = *(const f32x4*)(p.gla_norm_g + e);
            const float r0 = bf_lo(rv.x), r1 = bf_hi(rv.x), r2 = bf_lo(rv.y), r3 = bf_hi(rv.y);
            const f32x4 ov = o[et][tt];
            *(u32x2*)rp = (u32x2){pack2(ov[0] * rstd * gn[0] * siluf_(r0), ov[1] * rstd * gn[1] * siluf_(r1)),
                                  pack2(ov[2] * rstd * gn[2] * siluf_(r2), ov[3] * rstd * gn[3] * siluf_(r3))};
        }
    }
    __syncthreads();
}

__device__ void phaseN1_task(const Params& p, int task, char* lds) {
    const int tid = threadIdx.x, lane = tid & 63, wave = tid >> 6, r = lane & 15, q = lane >> 4;
    const int it = task & 7, g = (task >> 3) & 1, b = (task >> 4) & 7, kv = task >> 7;
    const bf16_t* Z = (const bf16_t*)(p.ws + OFF_Z);
    const bf16_t* W1 = (const bf16_t*)(p.ws + OFF_WC1) + (size_t)kv * 64 * 2048;
    const float* pe = kv ? p.pe_v : p.pe_k;
    const float* w2 = kv ? p.cv_w2 : p.ck_w2;
    const int zoff = (kv ? ZVC : ZKC) + g * 64;
    float* hid = (float*)lds;
    float* hid2 = (float*)(lds + 16384);
    int i = it * 16 + r; if (i > 126) i = 126;
    f32x4 acc[4];
#pragma unroll
    for (int nt = 0; nt < 4; nt++) acc[nt] = (f32x4){0.f, 0.f, 0.f, 0.f};
    for (int ks = 0; ks < 16; ks++) {
        const int k = wave * 512 + ks * 32 + q * 8;
        const int l = k >> 6, d = k & 63;
        const u32x4 zv = *(const u32x4*)(Z + (size_t)(b * SEQ + i * 16 + l) * ZC + zoff + d);
        const f32x4 p0 = *(const f32x4*)(pe + l * 64 + d), p1 = *(const f32x4*)(pe + l * 64 + d + 4);
        const u32x4 av = {pack2(bf_lo(zv.x) + p0[0], bf_hi(zv.x) + p0[1]), pack2(bf_lo(zv.y) + p0[2], bf_hi(zv.y) + p0[3]),
                          pack2(bf_lo(zv.z) + p1[0], bf_hi(zv.z) + p1[1]), pack2(bf_lo(zv.w) + p1[2], bf_hi(zv.w) + p1[3])};
        const bf16x8 a = __builtin_bit_cast(bf16x8, av);
#pragma unroll
        for (int nt = 0; nt < 4; nt++) {
            const bf16x8 bw = *(const bf16x8*)(W1 + (size_t)(nt * 16 + r) * 2048 + k);
            acc[nt] = mfma16(a, bw, acc[nt]);
        }
    }
#pragma unroll
    for (int nt = 0; nt < 4; nt++)
#pragma unroll
        for (int j = 0; j < 4; j++) hid[(wave * 16 + 4 * q + j) * 64 + nt * 16 + r] = acc[nt][j];
    __syncthreads();
    for (int e = tid; e < 1024; e += NTHREADS) hid2[e] = gelu_erf(hid[e] + hid[1024 + e] + hid[2048 + e] + hid[3072 + e]);
    __syncthreads();
    {
        const int il = tid >> 4, n2 = (tid & 15) * 4;
        f32x4 o = {0.f, 0.f, 0.f, 0.f};
        for (int n = 0; n < 64; n++) {
            const float hv = hid2[il * 64 + n];
            const f32x4 wv = *(const f32x4*)(w2 + n * 64 + n2);
            o += hv * wv;
        }
        const int ig = it * 16 + il;
        if (ig >= 127) o = (f32x4){0.f, 0.f, 0.f, 0.f};
        bf16_t* dst = (bf16_t*)(p.ws + OFF_CMP) + ((size_t)((kv * 8 + b) * 2 + g) * 128 + ig) * 64 + n2;
        *(u32x2*)dst = (u32x2){pack2(o[0], o[1]), pack2(o[2], o[3])};
    }
    __syncthreads();
}

__device__ __forceinline__ void nsa_load_kv(const bf16_t* __restrict__ kbase, const bf16_t* __restrict__ vbase, size_t rowstride, bf16_t* Ks, bf16_t* VT) {
    const int tid = threadIdx.x;
    {
        const int key = tid >> 2, ch = (tid & 3) * 16;
        const u32x4 a = *(const u32x4*)(kbase + (size_t)key * rowstride + ch), b = *(const u32x4*)(kbase + (size_t)key * rowstride + ch + 8);
        *(u32x4*)(Ks + key * 72 + ch) = a;
        *(u32x4*)(Ks + key * 72 + ch + 8) = b;
    }
    {
        const int key = tid & 63, dc = (tid >> 6) * 16;
        const u32x4 a = *(const u32x4*)(vbase + (size_t)key * rowstride + dc), b = *(const u32x4*)(vbase + (size_t)key * rowstride + dc + 8);
        const unsigned w[8] = {a.x, a.y, a.z, a.w, b.x, b.y, b.z, b.w};
#pragma unroll
        for (int j = 0; j < 16; j++) VT[(dc + j) * 72 + key] = (bf16_t)((j & 1) ? (w[j >> 1] >> 16) : (w[j >> 1] & 0xffffu));
    }
}

__device__ __forceinline__ void nsa_block_step(const bf16_t* Ks, const bf16_t* VT, const bf16x8 (&qf)[2][2], f32x4 (&O)[2][4], float (&m)[2], float (&l)[2],
                                               unsigned vm, int r, int q) {
#pragma unroll
    for (int x = 0; x < 2; x++) {
        f32x4 s[4];
#pragma unroll
        for (int kt = 0; kt < 4; kt++) s[kt] = (f32x4){0.f, 0.f, 0.f, 0.f};
#pragma unroll
        for (int kt = 0; kt < 4; kt++)
#pragma unroll
            for (int ks = 0; ks < 2; ks++) s[kt] = mfma16(ld_frag(Ks + (kt * 16 + r) * 72 + ks * 32 + q * 8), qf[x][ks], s[kt]);
        __builtin_amdgcn_sched_barrier(0);
        float mx = -1e30f;
#pragma unroll
        for (int kt = 0; kt < 4; kt++)
#pragma unroll
            for (int j = 0; j < 4; j++) if ((vm >> (kt * 4 + j)) & 1u) mx = fmaxf(mx, s[kt][j]);
        mx = fmaxf(mx, __shfl_xor(mx, 16, 64));
        mx = fmaxf(mx, __shfl_xor(mx, 32, 64));
        const float mnew = fmaxf(m[x], mx);
        const float alpha = __expf(m[x] - mnew);
        m[x] = mnew;
        float ls = 0.f;
#pragma unroll
        for (int kt = 0; kt < 4; kt++)
#pragma unroll
            for (int j = 0; j < 4; j++) {
                const float pv = ((vm >> (kt * 4 + j)) & 1u) ? __expf(s[kt][j] - mnew) : 0.f;
                s[kt][j] = pv; ls += pv;
            }
        l[x] = l[x] * alpha + ls;
#pragma unroll
        for (int dt = 0; dt < 4; dt++) O[x][dt] *= alpha;
        __builtin_amdgcn_sched_barrier(0);
#pragma unroll
        for (int s2 = 0; s2 < 2; s2++) {
            const u32x4 t4 = {pack2(s[2 * s2][0], s[2 * s2][1]), pack2(s[2 * s2][2], s[2 * s2][3]),
                              pack2(s[2 * s2 + 1][0], s[2 * s2 + 1][1]), pack2(s[2 * s2 + 1][2], s[2 * s2 + 1][3])};
            const bf16x8 pbv = __builtin_bit_cast(bf16x8, t4);
#pragma unroll
            for (int dt = 0; dt < 4; dt++) {
                const u32x2 lo = *(const u32x2*)(VT + (dt * 16 + r) * 72 + (2 * s2) * 16 + 4 * q);
                const u32x2 hi = *(const u32x2*)(VT + (dt * 16 + r) * 72 + (2 * s2 + 1) * 16 + 4 * q);
                O[x][dt] = mfma16(mk_frag(lo, hi), pbv, O[x][dt]);
            }
        }
        __builtin_amdgcn_sched_barrier(0);
    }
}

__device__ void phaseN2_task(const Params& p, int task, char* lds) {
    const int tid = threadIdx.x, lane = tid & 63, wave = tid >> 6, r = lane & 15, q = lane >> 4;
    const int tt = 127 - (task >> 4), g = task & 1, b = (task >> 1) & 7;
    const int t0 = tt * 16, t = t0 + r;
    const int cur = t0 >> 6;
    bf16_t* Z = (bf16_t*)(p.ws + OFF_Z);
    const size_t rowb = (size_t)b * SEQ;
    bf16_t* Kc = (bf16_t*)lds;
    bf16_t* VcT = (bf16_t*)(lds + 18432);
    bf16_t* Ks = (bf16_t*)lds;
    bf16_t* VT = (bf16_t*)(lds + 18432);
    float* impw = (float*)(lds + 35840);
    float* scs = (float*)(lds + 35840 + 32768);
    unsigned* selm = (unsigned*)(lds + 35840 + 32768 + 2048);

    bf16x8 qf[2][2];
#pragma unroll
    for (int x = 0; x < 2; x++)
#pragma unroll
        for (int ks = 0; ks < 2; ks++) qf[x][ks] = *(const bf16x8*)(Z + (rowb + t) * ZC + ZQ_N + (g * 8 + 2 * wave + x) * 64 + ks * 32 + q * 8);
    f32x4 Of[2][4];
    f32x4* ofl = (f32x4*)(lds + 35840);

    {
        const bf16_t* kc = (const bf16_t*)(p.ws + OFF_CMP) + (size_t)((0 * 8 + b) * 2 + g) * 128 * 64;
        const bf16_t* vc = (const bf16_t*)(p.ws + OFF_CMP) + (size_t)((1 * 8 + b) * 2 + g) * 128 * 64;
        {
            const int key = tid >> 1, ch = (tid & 1) * 32;
#pragma unroll
            for (int v4 = 0; v4 < 4; v4++) *(u32x4*)(Kc + key * 72 + ch + v4 * 8) = *(const u32x4*)(kc + key * 64 + ch + v4 * 8);
            const int k2 = tid & 127, dc = (tid >> 7) * 32;
#pragma unroll
            for (int v4 = 0; v4 < 4; v4++) {
                const u32x4 a = *(const u32x4*)(vc + k2 * 64 + dc + v4 * 8);
                const unsigned w[4] = {a.x, a.y, a.z, a.w};
#pragma unroll
                for (int j = 0; j < 8; j++) VcT[(dc + v4 * 8 + j) * 136 + k2] = (bf16_t)((j & 1) ? (w[j >> 1] >> 16) : (w[j >> 1] & 0xffffu));
            }
        }
        __syncthreads();
        int nv = t >= 31 ? ((t - 31) >> 4) + 1 : 0;
        if (nv > 127) nv = 127;
        f32x4 isum[8];
#pragma unroll
        for (int kt = 0; kt < 8; kt++) isum[kt] = (f32x4){0.f, 0.f, 0.f, 0.f};
#pragma unroll
        for (int x = 0; x < 2; x++) {
            f32x4 s[8];
#pragma unroll
            for (int kt = 0; kt < 8; kt++) s[kt] = (f32x4){0.f, 0.f, 0.f, 0.f};
#pragma unroll
            for (int kt = 0; kt < 8; kt++)
#pragma unroll
                for (int ks = 0; ks < 2; ks++) s[kt] = mfma16(ld_frag(Kc + (kt * 16 + r) * 72 + ks * 32 + q * 8), qf[x][ks], s[kt]);
            __builtin_amdgcn_sched_barrier(0);
            float mx = -1e30f;
#pragma unroll
            for (int kt = 0; kt < 8; kt++)
#pragma unroll
                for (int j = 0; j < 4; j++) if (kt * 16 + 4 * q + j < nv) mx = fmaxf(mx, s[kt][j]);
            mx = fmaxf(mx, __shfl_xor(mx, 16, 64));
            mx = fmaxf(mx, __shfl_xor(mx, 32, 64));
            float ls = 0.f;
#pragma unroll
            for (int kt = 0; kt < 8; kt++)
#pragma unroll
                for (int j = 0; j < 4; j++) {
                    const float pv = (kt * 16 + 4 * q + j < nv) ? __expf(s[kt][j] - mx) : 0.f;
                    s[kt][j] = pv; ls += pv;
                }
            ls += __shfl_xor(ls, 16, 64);
            ls += __shfl_xor(ls, 32, 64);
            const float inv = nv > 0 ? 1.f / ls : 0.f;
#pragma unroll
            for (int kt = 0; kt < 8; kt++) { s[kt] *= inv; isum[kt] += s[kt]; }
            f32x4 Oc[4];
#pragma unroll
            for (int dt = 0; dt < 4; dt++) Oc[dt] = (f32x4){0.f, 0.f, 0.f, 0.f};
            __builtin_amdgcn_sched_barrier(0);
#pragma unroll
            for (int s2 = 0; s2 < 4; s2++) {
                const u32x4 t4 = {pack2(s[2 * s2][0], s[2 * s2][1]), pack2(s[2 * s2][2], s[2 * s2][3]),
                                  pack2(s[2 * s2 + 1][0], s[2 * s2 + 1][1]), pack2(s[2 * s2 + 1][2], s[2 * s2 + 1][3])};
                const bf16x8 pbv = __builtin_bit_cast(bf16x8, t4);
#pragma unroll
                for (int dt = 0; dt < 4; dt++) {
                    const u32x2 lo = *(const u32x2*)(VcT + (dt * 16 + r) * 136 + (2 * s2) * 16 + 4 * q);
                    const u32x2 hi = *(const u32x2*)(VcT + (dt * 16 + r) * 136 + (2 * s2 + 1) * 16 + 4 * q);
                    Oc[dt] = mfma16(mk_frag(lo, hi), pbv, Oc[dt]);
                }
            }
            const float g0 = sigmoidf_(bf2f(Z[(rowb + t) * ZC + ZGATE + 0 * 16 + g * 8 + 2 * wave + x]));
#pragma unroll
            for (int dt = 0; dt < 4; dt++) Of[x][dt] = g0 * Oc[dt];
            __builtin_amdgcn_sched_barrier(0);
        }
#pragma unroll
        for (int kt = 0; kt < 8; kt++) *(f32x4*)(impw + (wave * 16 + r) * 128 + kt * 16 + 4 * q) = isum[kt];
        __syncthreads();
#pragma unroll
        for (int pass = 0; pass < 2; pass++) {
            const int tk = pass * 8 + (tid >> 5), j = tid & 31;
            const int i0 = j == 0 ? 0 : 4 * j - 1, i1 = (4 * j + 3 > 126) ? 126 : 4 * j + 3;
            float sc = 0.f;
            for (int i = i0; i <= i1; i++) sc += (impw[(0 * 16 + tk) * 128 + i] + impw[(1 * 16 + tk) * 128 + i]) + (impw[(2 * 16 + tk) * 128 + i] + impw[(3 * 16 + tk) * 128 + i]);
            const bool forced = (j == 0) || (j == cur) || (j == cur - 1);
            scs[tk * 32 + j] = forced ? 1e6f : (j <= cur ? sc : -1.f);
        }
        __syncthreads();
#pragma unroll
        for (int pass = 0; pass < 2; pass++) {
            const int tk = pass * 8 + (tid >> 5), j = tid & 31;
            const float mine = scs[tk * 32 + j];
            int rank = 0;
            for (int j2 = 0; j2 < 32; j2++) { const float o = scs[tk * 32 + j2]; rank += (o > mine || (o == mine && j2 < j)) ? 1 : 0; }
            const unsigned long long bal = __ballot(rank < 16);
            if ((lane & 31) == 0) selm[tk] = (unsigned)(lane ? (bal >> 32) : (bal & 0xffffffffull));
        }
        __syncthreads();
    }
#pragma unroll
    for (int x = 0; x < 2; x++)
#pragma unroll
        for (int dt = 0; dt < 4; dt++) ofl[(wave * 8 + x * 4 + dt) * 64 + lane] = Of[x][dt];
    const unsigned mysel = selm[r];
    unsigned uni = 0;
#pragma unroll
    for (int i = 0; i < 16; i++) uni |= selm[i];

    {
        f32x4 O[2][4];
        float m[2] = {-1e30f, -1e30f}, l[2] = {0.f, 0.f};
#pragma unroll
        for (int x = 0; x < 2; x++)
#pragma unroll
            for (int dt = 0; dt < 4; dt++) O[x][dt] = (f32x4){0.f, 0.f, 0.f, 0.f};
        for (int j = 0; j <= cur; j++) {
            if (!((uni >> j) & 1u)) continue;
            __syncthreads();
            nsa_load_kv(Z + (rowb + j * 64) * ZC + ZKS + g * 64, Z + (rowb + j * 64) * ZC + ZVS + g * 64, ZC, Ks, VT);
            __syncthreads();
            unsigned vm = 0;
            if ((mysel >> j) & 1u) {
#pragma unroll
                for (int kt = 0; kt < 4; kt++)
#pragma unroll
                    for (int jj = 0; jj < 4; jj++) if (j * 64 + kt * 16 + 4 * q + jj <= t) vm |= 1u << (kt * 4 + jj);
            }
            nsa_block_step(Ks, VT, qf, O, m, l, vm, r, q);
        }
#pragma unroll
        for (int x = 0; x < 2; x++) {
            float lt = l[x];
            lt += __shfl_xor(lt, 16, 64);
            lt += __shfl_xor(lt, 32, 64);
            const float sc = sigmoidf_(bf2f(Z[(rowb + t) * ZC + ZGATE + 1 * 16 + g * 8 + 2 * wave + x])) / lt;
#pragma unroll
            for (int dt = 0; dt < 4; dt++) ofl[(wave * 8 + x * 4 + dt) * 64 + lane] += sc * O[x][dt];
        }
    }
    {
        f32x4 O[2][4];
        float m[2] = {-1e30f, -1e30f}, l[2] = {0.f, 0.f};
#pragma unroll
        for (int x = 0; x < 2; x++)
#pragma unroll
            for (int dt = 0; dt < 4; dt++) O[x][dt] = (f32x4){0.f, 0.f, 0.f, 0.f};
        const int lo = t0 - 511;
        const int jb0 = lo > 0 ? (lo >> 6) : 0;
        for (int j = jb0; j <= cur; j++) {
            __syncthreads();
            nsa_load_kv(Z + (rowb + j * 64) * ZC + ZKW + g * 64, Z + (rowb + j * 64) * ZC + ZVW + g * 64, ZC, Ks, VT);
            __syncthreads();
            unsigned vm = 0;
#pragma unroll
            for (int kt = 0; kt < 4; kt++)
#pragma unroll
                for (int jj = 0; jj < 4; jj++) { const int kp = j * 64 + kt * 16 + 4 * q + jj; if (kp <= t && t - kp < 512) vm |= 1u << (kt * 4 + jj); }
            nsa_block_step(Ks, VT, qf, O, m, l, vm, r, q);
        }
#pragma unroll
        for (int x = 0; x < 2; x++) {
            float lt = l[x];
            lt += __shfl_xor(lt, 16, 64);
            lt += __shfl_xor(lt, 32, 64);
            const float sc = sigmoidf_(bf2f(Z[(rowb + t) * ZC + ZGATE + 2 * 16 + g * 8 + 2 * wave + x])) / lt;
#pragma unroll
            for (int dt = 0; dt < 4; dt++) O[x][dt] = ofl[(wave * 8 + x * 4 + dt) * 64 + lane] + sc * O[x][dt];
        }
#pragma unroll
        for (int x = 0; x < 2; x++)
#pragma unroll
            for (int dt = 0; dt < 4; dt++) {
                const f32x4 v = O[x][dt];
                *(u32x2*)(Z + (rowb + t) * ZC + ZQ_N + (g * 8 + 2 * wave + x) * 64 + dt * 16 + 4 * q) = (u32x2){pack2(v[0], v[1]), pack2(v[2], v[3])};
            }
    }
    __syncthreads();
}

__device__ void phaseM1(const Params& p, char* lds) {
    const int lane = threadIdx.x & 63, wave = threadIdx.x >> 6;
    const int wr = wave >> 1, wc = wave & 1, r = lane & 15, q = lane >> 4;
    const bf16_t* H = (const bf16_t*)(p.ws + OFF_H);
    const bf16_t* Z = (const bf16_t*)(p.ws + OFF_Z);
    bf16_t* M = (bf16_t*)(p.ws + OFF_M);
    for (int task = blockIdx.x; task < 128 * 8; task += gridDim.x) {
        const int bn = task & 7, bm = task >> 3;
        const int m0 = bm * 128, n0 = bn * 128;
        for (int br = 0; br < 2; br++) {
            f32x4 acc[4][4];
            zero_acc(acc);
            gemm_core(acc, H, DM, (const bf16_t*)(p.ws + OFF_WM) + (size_t)br * 1024 * 1024, DM, DM, m0, n0, lds);
            bf16_t* SG = (bf16_t*)p.out;
#pragma unroll
            for (int mi = 0; mi < 4; mi++)
#pragma unroll
                for (int ni = 0; ni < 4; ni++) {
                    const int tok = m0 + wr * 64 + mi * 16 + r, col = n0 + wc * 64 + ni * 16 + 4 * q;
                    *(u32x2*)(SG + (size_t)tok * DM + col) = (u32x2){pack2(sigmoidf_(acc[mi][ni][0]), sigmoidf_(acc[mi][ni][1])),
                                                                      pack2(sigmoidf_(acc[mi][ni][2]), sigmoidf_(acc[mi][ni][3]))};
                }
            zero_acc(acc);
            gemm_core(acc, Z + (br ? ZQ_N : ZR_G), ZC, (const bf16_t*)(p.ws + (br ? OFF_WB : OFF_WA)), DM, DM, m0, n0, lds);
#pragma unroll
            for (int mi = 0; mi < 4; mi++)
#pragma unroll
                for (int ni = 0; ni < 4; ni++) {
                    const int tok = m0 + wr * 64 + mi * 16 + r, col = n0 + wc * 64 + ni * 16 + 4 * q;
                    const u32x2 sg = *(const u32x2*)(SG + (size_t)tok * DM + col);
                    float v[4] = {bf_lo(sg.x) * acc[mi][ni][0], bf_hi(sg.x) * acc[mi][ni][1], bf_lo(sg.y) * acc[mi][ni][2], bf_hi(sg.y) * acc[mi][ni][3]};
                    u32x2* dst = (u32x2*)(M + (size_t)tok * DM + col);
                    if (br) { const u32x2 pv = *dst; v[0] += bf_lo(pv.x); v[1] += bf_hi(pv.x); v[2] += bf_lo(pv.y); v[3] += bf_hi(pv.y); }
                    *dst = (u32x2){pack2(v[0], v[1]), pack2(v[2], v[3])};
                }
        }
    }
}

__device__ void phaseM2(const Params& p, char* lds) {
    const int lane = threadIdx.x & 63, wave = threadIdx.x >> 6;
    const int wr = wave >> 1, wc = wave & 1, r = lane & 15, q = lane >> 4;
    const bf16_t* M = (const bf16_t*)(p.ws + OFF_M);
    const float* mod = (const float*)(p.ws + OFF_MOD);
    for (int task = blockIdx.x; task < 128 * 8; task += gridDim.x) {
        const int bn = task & 7, bm = task >> 3;
        const int m0 = bm * 128, n0 = bn * 128;
        f32x4 acc[4][4];
        zero_acc(acc);
        gemm_core(acc, M, DM, (const bf16_t*)(p.ws + OFF_WO), DM, DM, m0, n0, lds);
#pragma unroll
        for (int mi = 0; mi < 4; mi++)
#pragma unroll
            for (int ni = 0; ni < 4; ni++) {
                const int tok = m0 + wr * 64 + mi * 16 + r, col = n0 + wc * 64 + ni * 16 + 4 * q;
                const f32x4 xv = *(const f32x4*)(p.x + (size_t)tok * DM + col);
                const f32x4 gt = *(const f32x4*)(mod + (tok >> 11) * 6144 + 2 * 1024 + col);
                *(f32x4*)(p.out + (size_t)tok * DM + col) = xv + gt * acc[mi][ni];
            }
    }
    bf16_t* ub = (bf16_t*)(p.ws + OFF_UB);
    bf16_t* vb = (bf16_t*)(p.ws + OFF_VB);
    for (size_t i = ((size_t)blockIdx.x * NTHREADS + threadIdx.x) * 8; i < (size_t)16384 * 1024; i += (size_t)gridDim.x * NTHREADS * 8) {
        const f32x4 a = *(const f32x4*)(p.peer_u + i), b = *(const f32x4*)(p.peer_u + i + 4);
        *(u32x4*)(ub + i) = (u32x4){pack2(a[0], a[1]), pack2(a[2], a[3]), pack2(b[0], b[1]), pack2(b[2], b[3])};
        const f32x4 c = *(const f32x4*)(p.peer_v + i), d = *(const f32x4*)(p.peer_v + i + 4);
        *(u32x4*)(vb + i) = (u32x4){pack2(c[0], c[1]), pack2(c[2], c[3]), pack2(d[0], d[1]), pack2(d[2], d[3])};
    }
}

__device__ void phaseP1(const Params& p, char* lds) {
    const int lane = threadIdx.x & 63, wave = threadIdx.x >> 6;
    const int wr = wave >> 1, wc = wave & 1, r = lane & 15, q = lane >> 4;
    const bf16_t* H = (const bf16_t*)(p.ws + OFF_H);
    bf16_t* QP = (bf16_t*)(p.ws + OFF_QP);
    for (int task = blockIdx.x; task < 128 * 16; task += gridDim.x) {
        const int bn = task & 15, bm = task >> 4;
        const int m0 = bm * 128, n0 = bn * 128;
        f32x4 acc[4][4];
        zero_acc(acc);
        gemm_core(acc, H, DM, (const bf16_t*)(p.ws + OFF_WQ), DM, DM, m0, n0, lds);
#pragma unroll
        for (int mi = 0; mi < 4; mi++)
#pragma unroll
            for (int ni = 0; ni < 4; ni++) {
                const int tok = m0 + wr * 64 + mi * 16 + r, col = n0 + wc * 64 + ni * 16 + 4 * q;
                const f32x4 v = acc[mi][ni];
                *(u32x2*)(QP + (size_t)tok * 2048 + col) = (u32x2){pack2(v[0], v[1]), pack2(v[2], v[3])};
            }
    }
}

__constant__ unsigned char c_cand_a[64] = {0,0,0,0,0,0,0,0,0,0,0,0,0,0,0,0, 1,1,1,1,1,1,1,1, 2,2,2,2,2, 3,3,3,3, 4,4,4, 5,5, 6,6, 7,7, 8,9,10,11,12,13,14,15, 0,0,0,0,0,0,0,0,0,0,0,0,0,0};
__constant__ unsigned char c_cand_b[64] = {0,1,2,3,4,5,6,7,8,9,10,11,12,13,14,15, 0,1,2,3,4,5,6,7, 0,1,2,3,4, 0,1,2,3, 0,1,2, 0,1, 0,1, 0,1, 0,0,0,0,0,0,0,0, 0,0,0,0,0,0,0,0,0,0,0,0,0,0};

__device__ __forceinline__ unsigned f2key(float f) { const unsigned u = __float_as_uint(f); return (u & 0x80000000u) ? ~u : (u | 0x80000000u); }
__device__ __forceinline__ float key2f(unsigned k) { const unsigned u = (k & 0x80000000u) ? (k & 0x7fffffffu) : ~k; return __uint_as_float(u); }
__device__ __forceinline__ void ins16(unsigned (&L)[16], unsigned v) {
#pragma unroll
    for (int k = 0; k < 16; k++) { const unsigned hi = L[k] > v ? L[k] : v; v = L[k] > v ? v : L[k]; L[k] = hi; }
}

__device__ void phaseP2_task(const Params& p, int task, char* lds) {
    const int tid = threadIdx.x, lane = tid & 63, wave = tid >> 6, r = lane & 15, q = lane >> 4;
    const int h = task & 7, tile = task >> 3;
    const int tok0 = tile * 64;
    const bf16_t* QP = (const bf16_t*)(p.ws + OFF_QP);
    float* S = (float*)lds;
    unsigned* LL = (unsigned*)(lds + 65536);
#pragma unroll
    for (int half = 0; half < 2; half++) {
        const bf16_t* KB = (const bf16_t*)(p.ws + OFF_K1B) + (size_t)half * 131072 + (size_t)h * 128 * 128;
        f32x4 acc[8];
#pragma unroll
        for (int nt = 0; nt < 8; nt++) acc[nt] = (f32x4){0.f, 0.f, 0.f, 0.f};
#pragma unroll
        for (int ks = 0; ks < 4; ks++) {
            const bf16x8 bq = *(const bf16x8*)(QP + (size_t)(tok0 + wave * 16 + r) * 2048 + h * 256 + half * 128 + ks * 32 + q * 8);
#pragma unroll
            for (int nt = 0; nt < 8; nt++) {
                const bf16x8 ak = *(const bf16x8*)(KB + (size_t)(nt * 16 + r) * 128 + ks * 32 + q * 8);
                acc[nt] = mfma16(ak, bq, acc[nt]);
            }
        }
#pragma unroll
        for (int nt = 0; nt < 8; nt++)
#pragma unroll
            for (int j = 0; j < 4; j++) S[(half * 128 + nt * 16 + 4 * q + j) * 64 + wave * 16 + r] = acc[nt][j];
    }
    __syncthreads();
    if (tid < 128) {
        const int half = tid >> 6, tk = tid & 63;
        unsigned L[16];
#pragma unroll
        for (int k = 0; k < 16; k++) L[k] = 0u;
        const float* sp = S + half * 128 * 64 + tk;
        for (int k = 0; k < 128; k++) ins16(L, (f2key(sp[k * 64]) & ~127u) | (unsigned)(127 - k));
#pragma unroll
        for (int k = 0; k < 16; k++) LL[(half * 16 + k) * 64 + tk] = L[k];
    }
    __syncthreads();
    if (tid < 64) {
        const int tk = tid;
        float v1[16], v2[16];
#pragma unroll
        for (int k = 0; k < 16; k++) { v1[k] = key2f(LL[k * 64 + tk] & ~127u); v2[k] = key2f(LL[(16 + k) * 64 + tk] & ~127u); }
        unsigned T[16];
#pragma unroll
        for (int k = 0; k < 16; k++) T[k] = 0u;
        int c = 0;
#pragma unroll
        for (int a = 0; a < 16; a++)
#pragma unroll
            for (int b = 0; b < 16; b++)
                if ((a + 1) * (b + 1) <= 16) { ins16(T, (f2key(v1[a] + v2[b]) & ~63u) | (unsigned)(63 - c)); c++; }
        const float mx = key2f(T[0] & ~63u);
        float e[16], sum = 0.f;
#pragma unroll
        for (int k = 0; k < 16; k++) { e[k] = __expf(key2f(T[k] & ~63u) - mx); sum += e[k]; }
        const float inv = 1.f / sum;
        int ei[16];
#pragma unroll
        for (int k = 0; k < 16; k++) {
            const int cc = 63 - (int)(T[k] & 63u);
            const int a = c_cand_a[cc], b = c_cand_b[cc];
            const int i1 = 127 - (int)(LL[a * 64 + tk] & 127u), i2 = 127 - (int)(LL[(16 + b) * 64 + tk] & 127u);
            ei[k] = i1 * 128 + i2;
            e[k] *= inv;
        }
        int* eidx = (int*)(p.ws + OFF_EIDX) + (size_t)(tok0 + tk) * 128 + h * 16;
        float* gw = (float*)(p.ws + OFF_GW) + (size_t)(tok0 + tk) * 128 + h * 16;
#pragma unroll
        for (int k4 = 0; k4 < 4; k4++) {
            *(u32x4*)(eidx + k4 * 4) = (u32x4){(unsigned)ei[k4 * 4], (unsigned)ei[k4 * 4 + 1], (unsigned)ei[k4 * 4 + 2], (unsigned)ei[k4 * 4 + 3]};
            *(f32x4*)(gw + k4 * 4) = (f32x4){e[k4 * 4], e[k4 * 4 + 1], e[k4 * 4 + 2], e[k4 * 4 + 3]};
        }
    }
    __syncthreads();
}

__device__ void phaseP3(const Params& p) {
    const int lane = threadIdx.x & 63, wave = threadIdx.x >> 6;
    const bf16_t* H = (const bf16_t*)(p.ws + OFF_H);
    const bf16_t* UB = (const bf16_t*)(p.ws + OFF_UB);
    const bf16_t* VB = (const bf16_t*)(p.ws + OFF_VB);
    const int* eidx = (const int*)(p.ws + OFF_EIDX);
    const float* gwp = (const float*)(p.ws + OFF_GW);
    const float* mod = (const float*)(p.ws + OFF_MOD);
    for (int tok = blockIdx.x * 4 + wave; tok < NTOK; tok += gridDim.x * 4) {
        float hv[16];
#pragma unroll
        for (int c = 0; c < 2; c++) {
            const u32x4 a = *(const u32x4*)(H + (size_t)tok * DM + c * 512 + lane * 8);
            hv[c * 8 + 0] = bf_lo(a.x); hv[c * 8 + 1] = bf_hi(a.x); hv[c * 8 + 2] = bf_lo(a.y); hv[c * 8 + 3] = bf_hi(a.y);
            hv[c * 8 + 4] = bf_lo(a.z); hv[c * 8 + 5] = bf_hi(a.z); hv[c * 8 + 6] = bf_lo(a.w); hv[c * 8 + 7] = bf_hi(a.w);
        }
        const int e0 = eidx[(size_t)tok * 128 + lane], e1 = eidx[(size_t)tok * 128 + 64 + lane];
        const float g0 = gwp[(size_t)tok * 128 + lane], g1 = gwp[(size_t)tok * 128 + 64 + lane];
        float acc[16];
#pragma unroll
        for (int i = 0; i < 16; i++) acc[i] = 0.f;
        for (int jb = 0; jb < 128; jb += 4) {
            u32x4 uu[4][2], vv[4][2];
            float gg[4];
#pragma unroll
            for (int u = 0; u < 4; u++) {
                const int j = jb + u;
                const int e = (j < 64) ? __shfl(e0, j, 64) : __shfl(e1, j - 64, 64);
                gg[u] = (j < 64) ? __shfl(g0, j, 64) : __shfl(g1, j - 64, 64);
                uu[u][0] = *(const u32x4*)(UB + (size_t)e * DM + lane * 8);
                uu[u][1] = *(const u32x4*)(UB + (size_t)e * DM + 512 + lane * 8);
                vv[u][0] = *(const u32x4*)(VB + (size_t)e * DM + lane * 8);
                vv[u][1] = *(const u32x4*)(VB + (size_t)e * DM + 512 + lane * 8);
            }
#pragma unroll
            for (int u = 0; u < 4; u++) {
                float d = 0.f;
#pragma unroll
                for (int c = 0; c < 2; c++) {
                    const u32x4 a = uu[u][c];
                    d += bf_lo(a.x) * hv[c * 8 + 0] + bf_hi(a.x) * hv[c * 8 + 1] + bf_lo(a.y) * hv[c * 8 + 2] + bf_hi(a.y) * hv[c * 8 + 3]
                       + bf_lo(a.z) * hv[c * 8 + 4] + bf_hi(a.z) * hv[c * 8 + 5] + bf_lo(a.w) * hv[c * 8 + 6] + bf_hi(a.w) * hv[c * 8 + 7];
                }
                d = wave_sum(d);
                const float w = gg[u] * gelu_erf(d);
#pragma unroll
                for (int c = 0; c < 2; c++) {
                    const u32x4 a = vv[u][c];
                    acc[c * 8 + 0] += w * bf_lo(a.x); acc[c * 8 + 1] += w * bf_hi(a.x); acc[c * 8 + 2] += w * bf_lo(a.y); acc[c * 8 + 3] += w * bf_hi(a.y);
                    acc[c * 8 + 4] += w * bf_lo(a.z); acc[c * 8 + 5] += w * bf_hi(a.z); acc[c * 8 + 6] += w * bf_lo(a.w); acc[c * 8 + 7] += w * bf_hi(a.w);
                }
            }
        }
        const int b = tok >> 11;
        float x2[16];
        float ss = 0.f;
#pragma unroll
        for (int c = 0; c < 2; c++)
#pragma unroll
            for (int hf = 0; hf < 2; hf++) {
                const int d = c * 512 + lane * 8 + hf * 4;
                const f32x4 xv = *(const f32x4*)(p.out + (size_t)tok * DM + d);
                const f32x4 gt = *(const f32x4*)(mod + b * 6144 + 5 * 1024 + d);
#pragma unroll
                for (int j = 0; j < 4; j++) { const float v = xv[j] + gt[j] * acc[c * 8 + hf * 4 + j]; x2[c * 8 + hf * 4 + j] = v; ss += v * v; }
            }
        ss = wave_sum(ss);
        const float rstd = rsqrtf(ss * (1.f / 1024.f) + 1e-6f);
#pragma unroll
        for (int c = 0; c < 2; c++)
#pragma unroll
            for (int hf = 0; hf < 2; hf++) {
                const int d = c * 512 + lane * 8 + hf * 4;
                const f32x4 fg = *(const f32x4*)(p.final_g + d);
                f32x4 o;
#pragma unroll
                for (int j = 0; j < 4; j++) o[j] = x2[c * 8 + hf * 4 + j] * rstd * fg[j];
                *(f32x4*)(p.out + (size_t)tok * DM + d) = o;
            }
    }
}

#define XB_TMO      128
#define XB_XCNT(j)  (256  + 64 * (j))
#define XB_XSUB(j)  (1280 + 64 * (j))
#define XB_XGEN(j)  (2304 + 64 * (j))
#define XB_TOP      3328
#define XB_TOPGEN   3392
#define XCD_BAR_WORDS 3456
#define XB_SPIN_CAP (1u << 22)
#define LAS __attribute__((address_space(3)))
__device__ __forceinline__ unsigned xb_ld(unsigned* p)              { return __hip_atomic_load(p, __ATOMIC_RELAXED, __HIP_MEMORY_SCOPE_AGENT); }
__device__ __forceinline__ unsigned xb_add(unsigned* p, unsigned v) { return __hip_atomic_fetch_add(p, v, __ATOMIC_RELAXED, __HIP_MEMORY_SCOPE_AGENT); }
__device__ __forceinline__ unsigned xb_xcc_id() { return (unsigned)__builtin_amdgcn_s_getreg((3 << 11) | 20) & 0xFu; }
#define XB_SPIN(cond, bar) do { unsigned _sp = 0; while (cond) { __builtin_amdgcn_s_sleep(1); \
    if ((++_sp & 255u) == 0u) { if (xb_ld(&(bar)[XB_TMO])) break; if (_sp > XB_SPIN_CAP) { atomicAdd(&(bar)[XB_TMO], 1u); break; } } } } while (0)
struct XcdBarrier { unsigned* bar; unsigned x; volatile LAS unsigned* st; };
__device__ __forceinline__ XcdBarrier xcd_barrier_post(unsigned* bar, volatile LAS unsigned* st) {
    XcdBarrier b; b.bar = bar; b.x = xb_xcc_id(); b.st = st;
    if (threadIdx.x == 0) (void)xb_add(&bar[XB_XCNT(b.x)], 1u);
    return b;
}
__device__ __forceinline__ void xcd_barrier_complete(unsigned* bar, unsigned x, unsigned& nloc, unsigned& nx) {
    const unsigned G = gridDim.x * gridDim.y * gridDim.z;
    unsigned sum, cnt, mine, sp = 0u;
    for (;;) {
        sum = 0u; cnt = 0u; mine = 0u;
#pragma unroll
        for (unsigned j = 0; j < 16; ++j) { const unsigned c = xb_ld(&bar[XB_XCNT(j)]); sum += c; cnt += (c > 0u) ? 1u : 0u; mine = (j == x) ? c : mine; }
        if (sum == G) break;
        __builtin_amdgcn_s_sleep(1);
        if ((++sp & 255u) == 0u) { if (xb_ld(&bar[XB_TMO])) break; if (sp > XB_SPIN_CAP) { atomicAdd(&bar[XB_TMO], 1u); break; } }
    }
    nloc = mine > 0u ? mine : 1u; nx = cnt > 0u ? cnt : 1u;
}
__device__ __forceinline__ void xcd_barrier(const XcdBarrier& b) {
    asm volatile("s_waitcnt vmcnt(0)" ::: "memory");
    __syncthreads();
    if (threadIdx.x == 0) {
        unsigned* bar = b.bar;
        __builtin_amdgcn_s_waitcnt(0);
        unsigned nloc = b.st[0], nx = b.st[1];
        if (nloc == 0u) { xcd_barrier_complete(bar, b.x, nloc, nx); b.st[0] = nloc; b.st[1] = nx; }
        const unsigned old = xb_add(&bar[XB_XSUB(b.x)], 1u);
        const unsigned gen = old / nloc;
        if (old + 1u == (gen + 1u) * nloc) {
            __builtin_amdgcn_fence(__ATOMIC_RELEASE, "agent");
            asm volatile("s_waitcnt vmcnt(0)" ::: "memory");
            const unsigned og = xb_add(&bar[XB_TOP], 1u);
            const unsigned tg = og / nx;
            if (og + 1u == (tg + 1u) * nx) xb_add(&bar[XB_TOPGEN], 1u);
            else XB_SPIN(xb_ld(&bar[XB_TOPGEN]) == tg, bar);
            __builtin_amdgcn_fence(__ATOMIC_ACQUIRE, "agent");
            xb_add(&bar[XB_XGEN(b.x)], 1u);
            asm volatile("s_waitcnt vmcnt(0)" ::: "memory");
        } else {
            XB_SPIN(xb_ld(&bar[XB_XGEN(b.x)]) == gen, bar);
            __builtin_amdgcn_fence(__ATOMIC_ACQUIRE, "agent");
            asm volatile("s_waitcnt vmcnt(0)" ::: "memory");
        }
    }
    __syncthreads();
}

__global__ void __launch_bounds__(NTHREADS, 2) mega(Params p) {
    __shared__ __attribute__((aligned(16))) char lds[LDS_BYTES];
    cg::grid_group grid = cg::this_grid();
    volatile LAS unsigned* st = (volatile LAS unsigned*)(lds + LDS_MAIN);
    if (threadIdx.x < 4) st[threadIdx.x] = 0u;
    __syncthreads();
    XcdBarrier xb = xcd_barrier_post((unsigned*)p.ws, st);

    phaseA(p, lds);
    grid.sync();
    phase_modnorm(p, p.x, p.norm1_g, 0, 1, (bf16_t*)(p.ws + OFF_H));
    xcd_barrier(xb);
    phaseC(p, lds);
    xcd_barrier(xb);
    for (int task = blockIdx.x; task < 1024; task += gridDim.x) phaseG1_task(p, task, lds);
    for (int task = blockIdx.x; task < 256; task += gridDim.x) phaseN1_task(p, task, lds);
    xcd_barrier(xb);
    phaseG2(p);
    xcd_barrier(xb);
    for (int task = blockIdx.x; task < 2048; task += gridDim.x) phaseN2_task(p, task, lds);
    for (int task = blockIdx.x; task < 1024; task += gridDim.x) phaseG3_task(p, task, lds);
    xcd_barrier(xb);
    phaseM1(p, lds);
    xcd_barrier(xb);
    phaseM2(p, lds);
    xcd_barrier(xb);
    phase_modnorm(p, p.out, p.norm2_g, 3, 4, (bf16_t*)(p.ws + OFF_H));
    xcd_barrier(xb);
    phaseP1(p, lds);
    xcd_barrier(xb);
    for (int task = blockIdx.x; task < 2048; task += gridDim.x) phaseP2_task(p, task, lds);
    xcd_barrier(xb);
    phaseP3(p);
}

extern "C" void kernel_launch(void* const* d_in, const int* in_sizes, int n_in, void* d_out, int out_size, void* d_ws, size_t ws_size, hipStream_t stream) {
    Params p{};
    p.x = (const float*)d_in[0]; p.c = (const float*)d_in[1]; p.pos = (const int*)d_in[2]; p.ada_w = (const float*)d_in[3]; p.ada_b = (const float*)d_in[4];
    p.norm1_g = (const float*)d_in[5]; p.norm2_g = (const float*)d_in[6]; p.final_g = (const float*)d_in[7]; p.w_in = (const float*)d_in[8];
    p.gla_wa2 = (const float*)d_in[9]; p.gla_ba2 = (const float*)d_in[10]; p.gla_norm_g = (const float*)d_in[11]; p.pe_k = (const float*)d_in[12]; p.pe_v = (const float*)d_in[13];
    p.ck_w1 = (const float*)d_in[14]; p.ck_w2 = (const float*)d_in[15]; p.cv_w1 = (const float*)d_in[16]; p.cv_w2 = (const float*)d_in[17];
    p.w_branch_a = (const float*)d_in[18]; p.w_branch_b = (const float*)d_in[19]; p.w_out = (const float*)d_in[20]; p.peer_wq = (const float*)d_in[21];
    p.peer_k1 = (const float*)d_in[22]; p.peer_k2 = (const float*)d_in[23]; p.peer_u = (const float*)d_in[24]; p.peer_v = (const float*)d_in[25];
    p.out = (float*)d_out; p.ws = (char*)d_ws;
    static int grid_blocks = 0;
    if (!grid_blocks) {
        int dev = 0, cus = 0, per_cu = 0;
        hipGetDevice(&dev);
        hipDeviceGetAttribute(&cus, hipDeviceAttributeMultiprocessorCount, dev);
        hipOccupancyMaxActiveBlocksPerMultiprocessor(&per_cu, mega, NTHREADS, 0);
        if (per_cu > 2) per_cu = 2;
        if (per_cu < 1) per_cu = 1;
        grid_blocks = cus * per_cu;
    }
    hipMemsetAsync(d_ws, 0, XCD_BAR_WORDS * 4, stream);
    void* args[] = {&p};
    hipError_t e = hipLaunchCooperativeKernel((void*)mega, dim3(grid_blocks), dim3(NTHREADS), args, 0, stream);
    if (e != hipSuccess) fprintf(stderr, "cooperative launch failed: %s (grid %d)\n", hipGetErrorString(e), grid_blocks);
}
```

```cpp
#include <hip/hip_runtime.h>
#include <hip/hip_cooperative_groups.h>
#include <stdio.h>
namespace cg = cooperative_groups;
#include <stdint.h>
#include <stddef.h>
#include <math.h>

typedef unsigned short bf16_t;
typedef short bf16x8 __attribute__((ext_vector_type(8)));
typedef float f32x4 __attribute__((ext_vector_type(4)));
typedef unsigned u32x4 __attribute__((ext_vector_type(4)));
typedef unsigned u32x2 __attribute__((ext_vector_type(2)));

constexpr int DM = 1024, NB = 8, SEQ = 2048, NTOK = NB * SEQ;
constexpr int ZC = 4992;
constexpr int ZQ_G = 0, ZK_G = 512, ZV_G = 1024, ZR_G = 2048, ZQ_N = 3072, ZKC = 4096, ZVC = 4224, ZKS = 4352, ZVS = 4480,
              ZKW = 4608, ZVW = 4736, ZGATE = 4864, ZLR = 4912;
constexpr int LDS_MAIN = 73728;
constexpr int LDS_BYTES = LDS_MAIN + 64;
constexpr int NTHREADS = 256;

constexpr size_t OFF_MOD = 16384;
constexpr size_t OFF_ROPE = 212992;
constexpr size_t OFF_CMP = 1261568;
constexpr size_t OFF_DEC = 1785856;
constexpr size_t OFF_K1B = 2310144;
constexpr size_t OFF_WC1 = 2834432;
constexpr size_t OFF_WIN = 4194304;
constexpr size_t OFF_WM = 14417920;
constexpr size_t OFF_WA = 18612224;
constexpr size_t OFF_WB = 20709376;
constexpr size_t OFF_WO = 22806528;
constexpr size_t OFF_WQ = 24903680;
constexpr size_t OFF_H = 29360128;
constexpr size_t OFF_M = 62914560;
constexpr size_t OFF_Z = 96468992;
constexpr size_t OFF_QP = OFF_Z;
constexpr size_t OFF_UB = OFF_Z + 67108864;
constexpr size_t OFF_VB = OFF_UB + 33554432;
constexpr size_t OFF_EIDX = OFF_VB + 33554432;
constexpr size_t OFF_GW = OFF_EIDX + 8388608;

struct Params {
    const float* x; const float* c; const int* pos; const float* ada_w; const float* ada_b;
    const float* norm1_g; const float* norm2_g; const float* final_g; const float* w_in;
    const float* gla_wa2; const float* gla_ba2; const float* gla_norm_g; const float* pe_k; const float* pe_v;
    const float* ck_w1; const float* ck_w2; const float* cv_w1; const float* cv_w2;
    const float* w_branch_a; const float* w_branch_b; const float* w_out; const float* peer_wq;
    const float* peer_k1; const float* peer_k2; const float* peer_u; const float* peer_v;
    float* out; char* ws;
};

__device__ __forceinline__ unsigned f2bf_u(float f) { unsigned u = __float_as_uint(f); return (u + 0x7fffu + ((u >> 16) & 1u)) >> 16; }
__device__ __forceinline__ bf16_t f2bf(float f) { return (bf16_t)f2bf_u(f); }
__device__ __forceinline__ unsigned pack2(float lo, float hi) { return f2bf_u(lo) | (f2bf_u(hi) << 16); }
__device__ __forceinline__ float bf_lo(unsigned u) { return __uint_as_float(u << 16); }
__device__ __forceinline__ float bf_hi(unsigned u) { return __uint_as_float(u & 0xffff0000u); }
__device__ __forceinline__ float bf2f(bf16_t h) { return __uint_as_float(((unsigned)h) << 16); }
__device__ __forceinline__ float wave_sum(float v) {
#pragma unroll
    for (int o = 32; o > 0; o >>= 1) v += __shfl_xor(v, o, 64);
    return v;
}
__device__ __forceinline__ float wave_max(float v) {
#pragma unroll
    for (int o = 32; o > 0; o >>= 1) v = fmaxf(v, __shfl_xor(v, o, 64));
    return v;
}
__device__ __forceinline__ float sigmoidf_(float x) { return 1.f / (1.f + __expf(-x)); }
__device__ __forceinline__ float siluf_(float x) { return x / (1.f + __expf(-x)); }
__device__ __forceinline__ float gelu_erf(float x) { return 0.5f * x * (1.f + erff(x * 0.70710678118654752f)); }
__device__ __forceinline__ f32x4 mfma16(bf16x8 a, bf16x8 b, f32x4 c) { return __builtin_amdgcn_mfma_f32_16x16x32_bf16(a, b, c, 0, 0, 0); }
__device__ __forceinline__ bf16x8 ld_frag(const bf16_t* p) { return *(const bf16x8*)p; }
__device__ __forceinline__ bf16x8 mk_frag(u32x2 lo, u32x2 hi) { u32x4 t = {lo.x, lo.y, hi.x, hi.y}; return __builtin_bit_cast(bf16x8, t); }

__device__ __forceinline__ void gemm_core(f32x4 (&acc)[4][4], const bf16_t* __restrict__ X, int ldx, const bf16_t* __restrict__ W, int ldw,
                                          int K, int m0, int n0, char* lds) {
    const int tid = threadIdx.x, lane = tid & 63, wave = tid >> 6;
    const int wr = wave >> 1, wc = wave & 1, r = lane & 15, q = lane >> 4;
    bf16_t* Xs = (bf16_t*)lds;
    bf16_t* Ws = Xs + 2 * 128 * 72;
    const int lr = tid >> 3, lc = tid & 7;
    const bf16_t* xg = X + (size_t)(m0 + lr) * ldx + lc * 8;
    const bf16_t* wg = W + (size_t)(n0 + lr) * ldw + lc * 8;
    u32x4 xr[4], wv[4];
    const int KT = K / 64;
#pragma unroll
    for (int p = 0; p < 4; p++) { xr[p] = *(const u32x4*)(xg + (size_t)p * 32 * ldx); wv[p] = *(const u32x4*)(wg + (size_t)p * 32 * ldw); }
#pragma unroll
    for (int p = 0; p < 4; p++) { *(u32x4*)(Xs + (p * 32 + lr) * 72 + lc * 8) = xr[p]; *(u32x4*)(Ws + (p * 32 + lr) * 72 + lc * 8) = wv[p]; }
    __syncthreads();
    for (int kt = 0; kt < KT; kt++) {
        const bool more = (kt + 1 < KT);
        if (more) {
#pragma unroll
            for (int p = 0; p < 4; p++) {
                xr[p] = *(const u32x4*)(xg + (size_t)p * 32 * ldx + (kt + 1) * 64);
                wv[p] = *(const u32x4*)(wg + (size_t)p * 32 * ldw + (kt + 1) * 64);
            }
        }
        const bf16_t* xs = Xs + (kt & 1) * 128 * 72;
        const bf16_t* ws = Ws + (kt & 1) * 128 * 72;
#pragma unroll
        for (int ks = 0; ks < 2; ks++) {
            bf16x8 af[4], bfr[4];
#pragma unroll
            for (int ni = 0; ni < 4; ni++) af[ni] = ld_frag(ws + (wc * 64 + ni * 16 + r) * 72 + ks * 32 + q * 8);
#pragma unroll
            for (int mi = 0; mi < 4; mi++) bfr[mi] = ld_frag(xs + (wr * 64 + mi * 16 + r) * 72 + ks * 32 + q * 8);
#pragma unroll
            for (int mi = 0; mi < 4; mi++)
#pragma unroll
                for (int ni = 0; ni < 4; ni++) acc[mi][ni] = mfma16(af[ni], bfr[mi], acc[mi][ni]);
        }
        if (more) {
            bf16_t* xd = Xs + ((kt + 1) & 1) * 128 * 72;
            bf16_t* wd = Ws + ((kt + 1) & 1) * 128 * 72;
#pragma unroll
            for (int p = 0; p < 4; p++) { *(u32x4*)(xd + (p * 32 + lr) * 72 + lc * 8) = xr[p]; *(u32x4*)(wd + (p * 32 + lr) * 72 + lc * 8) = wv[p]; }
        }
        __syncthreads();
    }
}
__device__ __forceinline__ void zero_acc(f32x4 (&acc)[4][4]) {
#pragma unroll
    for (int a = 0; a < 4; a++)
#pragma unroll
        for (int b = 0; b < 4; b++) acc[a][b] = (f32x4){0.f, 0.f, 0.f, 0.f};
}

struct MapId { __device__ int operator()(int n) const { return n; } };
struct MapWin {
    __device__ int operator()(int n) const { return n < 3072 ? n : (n < 4912 ? n + 16 : (n < 4928 ? n - 1840 : -1)); }
};
struct MapOff { int off; __device__ int operator()(int n) const { return n + off; } };

template <class Map>
__device__ __forceinline__ void tconv_tile(const float* __restrict__ src, int ldsrc, bf16_t* __restrict__ dst, int ldd, int n0, int k0, Map map, float* t) {
    const int tid = threadIdx.x;
    const int n = tid & 63, kb = tid >> 6;
    const int sc = map(n0 + n);
#pragma unroll
    for (int i = 0; i < 16; i++) { const int k = i * 4 + kb; t[k * 65 + n] = sc >= 0 ? src[(size_t)(k0 + k) * ldsrc + sc] : 0.f; }
    __syncthreads();
    const int nn = tid >> 2, kk = (tid & 3) * 16;
    unsigned w[8];
#pragma unroll
    for (int j = 0; j < 8; j++) w[j] = pack2(t[(kk + 2 * j) * 65 + nn], t[(kk + 2 * j + 1) * 65 + nn]);
    u32x4* d = (u32x4*)(dst + (size_t)(n0 + nn) * ldd + k0 + kk);
    d[0] = (u32x4){w[0], w[1], w[2], w[3]};
    d[1] = (u32x4){w[4], w[5], w[6], w[7]};
    __syncthreads();
}

constexpr int TA_MOD = 192, TA_WIN = 78 * 16, TA_WM = 32 * 16, TA_SQ = 16 * 16, TA_WQ = 32 * 16, TA_WC = 32, TA_K12 = 64, TA_ROPE = 512;
constexpr int TA_E0 = TA_MOD, TA_E1 = TA_E0 + TA_WIN, TA_E2 = TA_E1 + TA_WM, TA_E3 = TA_E2 + TA_SQ, TA_E4 = TA_E3 + TA_SQ, TA_E5 = TA_E4 + TA_SQ,
              TA_E6 = TA_E5 + TA_WQ, TA_E7 = TA_E6 + TA_WC, TA_E8 = TA_E7 + TA_WC, TA_E9 = TA_E8 + TA_K12, TA_E10 = TA_E9 + TA_K12, TA_E11 = TA_E10 + TA_ROPE;

__device__ void phaseA(const Params& p, char* lds) {
    const int tid = threadIdx.x;
    float* fl = (float*)lds;
    for (int task = blockIdx.x; task < TA_E11; task += gridDim.x) {
        if (task < TA_E0) {
            float* sc = fl;
            float* red = fl + 8192;
            for (int i = tid; i < 8192; i += NTHREADS) sc[i] = siluf_(p.c[i]);
            __syncthreads();
            const int n = task * 32 + (tid & 31), kg = tid >> 5;
            float a[8];
#pragma unroll
            for (int b = 0; b < 8; b++) a[b] = 0.f;
            for (int k = kg * 128; k < kg * 128 + 128; k++) {
                const float w = p.ada_w[(size_t)k * 6144 + n];
#pragma unroll
                for (int b = 0; b < 8; b++) a[b] += sc[b * 1024 + k] * w;
            }
#pragma unroll
            for (int b = 0; b < 8; b++) red[(kg * 8 + b) * 32 + (tid & 31)] = a[b];
            __syncthreads();
            {
                const int b = tid >> 5, nn = tid & 31;
                float s = 0.f;
#pragma unroll
                for (int g = 0; g < 8; g++) s += red[(g * 8 + b) * 32 + nn];
                ((float*)(p.ws + OFF_MOD))[b * 6144 + task * 32 + nn] = s + p.ada_b[task * 32 + nn];
            }
            __syncthreads();
        } else if (task < TA_E1) {
            const int tt = task - TA_E0;
            tconv_tile(p.w_in, 6976, (bf16_t*)(p.ws + OFF_WIN), 1024, (tt >> 4) * 64, (tt & 15) * 64, MapWin(), fl);
        } else if (task < TA_E2) {
            const int tt = task - TA_E1;
            tconv_tile(p.w_in, 6976, (bf16_t*)(p.ws + OFF_WM), 1024, (tt >> 4) * 64, (tt & 15) * 64, MapOff{4928}, fl);
        } else if (task < TA_E3) {
            const int tt = task - TA_E2;
            tconv_tile(p.w_branch_a, 1024, (bf16_t*)(p.ws + OFF_WA), 1024, (tt >> 4) * 64, (tt & 15) * 64, MapId(), fl);
        } else if (task < TA_E4) {
            const int tt = task - TA_E3;
            tconv_tile(p.w_branch_b, 1024, (bf16_t*)(p.ws + OFF_WB), 1024, (tt >> 4) * 64, (tt & 15) * 64, MapId(), fl);
        } else if (task < TA_E5) {
            const int tt = task - TA_E4;
            tconv_tile(p.w_out, 1024, (bf16_t*)(p.ws + OFF_WO), 1024, (tt >> 4) * 64, (tt & 15) * 64, MapId(), fl);
        } else if (task < TA_E6) {
            const int tt = task - TA_E5;
            tconv_tile(p.peer_wq, 2048, (bf16_t*)(p.ws + OFF_WQ), 1024, (tt >> 4) * 64, (tt & 15) * 64, MapId(), fl);
        } else if (task < TA_E7) {
            const int tt = task - TA_E6;
            tconv_tile(p.ck_w1, 64, (bf16_t*)(p.ws + OFF_WC1), 2048, 0, tt * 64, MapId(), fl);
        } else if (task < TA_E8) {
            const int tt = task - TA_E7;
            tconv_tile(p.cv_w1, 64, (bf16_t*)(p.ws + OFF_WC1) + 64 * 2048, 2048, 0, tt * 64, MapId(), fl);
        } else if (task < TA_E10) {
            const bool second = task >= TA_E9;
            const int tt = task - (second ? TA_E9 : TA_E8);
            const float* src = second ? p.peer_k2 : p.peer_k1;
            bf16_t* dst = (bf16_t*)(p.ws + OFF_K1B) + (second ? 131072 : 0);
            const int i = tt * 2048 + tid * 8;
            const f32x4 a = *(const f32x4*)(src + i), b = *(const f32x4*)(src + i + 4);
            *(u32x4*)(dst + i) = (u32x4){pack2(a[0], a[1]), pack2(a[2], a[3]), pack2(b[0], b[1]), pack2(b[2], b[3])};
        } else {
            const int tt = task - TA_E10;
            const int e = tt * 256 + tid;
            const int tok = e >> 3, i = e & 7;
            const float invf[8] = {1.0f, 0.1939227432012558f, 0.03760603070259094f, 0.007292664609849453f,
                                   0.0014142135623842478f, 0.00027424818836152554f, 5.318296098266728e-05f, 1.0313386155758053e-05f};
            float fr = invf[0];
#pragma unroll
            for (int j = 1; j < 8; j++) fr = (i == j) ? invf[j] : fr;
            const float ang = (float)p.pos[tok] * fr;
            const double rev = (double)ang * 0.15915494309189533577;
            const float fpart = (float)(rev - floor(rev));
            float* cs = (float*)(p.ws + OFF_ROPE);
            cs[e * 2] = __builtin_amdgcn_cosf(fpart);
            cs[e * 2 + 1] = __builtin_amdgcn_sinf(fpart);
        }
    }
}

__device__ void phase_modnorm(const Params& p, const float* __restrict__ src, const float* __restrict__ g, int shift_idx, int scale_idx, bf16_t* __restrict__ dst) {
    const int lane = threadIdx.x & 63, wave = threadIdx.x >> 6;
    const float* mod = (const float*)(p.ws + OFF_MOD);
    for (int tok = blockIdx.x * 4 + wave; tok < NTOK; tok += gridDim.x * 4) {
        const int b = tok >> 11;
        const float* xr = src + (size_t)tok * DM;
        f32x4 v[4];
        float ss = 0.f;
#pragma unroll
        for (int c = 0; c < 4; c++) { v[c] = *(const f32x4*)(xr + c * 256 + lane * 4); ss += v[c][0] * v[c][0] + v[c][1] * v[c][1] + v[c][2] * v[c][2] + v[c][3] * v[c][3]; }
        ss = wave_sum(ss);
        const float rstd = rsqrtf(ss * (1.f / 1024.f) + 1e-6f);
#pragma unroll
        for (int c = 0; c < 4; c++) {
            const int d = c * 256 + lane * 4;
            const f32x4 gg = *(const f32x4*)(g + d);
            const f32x4 sc = *(const f32x4*)(mod + b * 6144 + scale_idx * 1024 + d);
            const f32x4 sh = *(const f32x4*)(mod + b * 6144 + shift_idx * 1024 + d);
            float o[4];
#pragma unroll
            for (int j = 0; j < 4; j++) o[j] = (v[c][j] * rstd) * gg[j] * (1.f + sc[j]) + sh[j];
            *(u32x2*)(dst + (size_t)tok * DM + d) = (u32x2){pack2(o[0], o[1]), pack2(o[2], o[3])};
        }
    }
}

__device__ void phaseC(const Params& p, char* lds) {
    const int lane = threadIdx.x & 63, wave = threadIdx.x >> 6;
    const int wr = wave >> 1, wc = wave & 1, r = lane & 15, q = lane >> 4;
    const bf16_t* H = (const bf16_t*)(p.ws + OFF_H);
    const bf16_t* W = (const bf16_t*)(p.ws + OFF_WIN);
    bf16_t* Z = (bf16_t*)(p.ws + OFF_Z);
    const float* cs = (const float*)(p.ws + OFF_ROPE);
    constexpr int NTN = ZC / 128;
    for (int task = blockIdx.x; task < 128 * NTN; task += gridDim.x) {
        const int bn = task % NTN, bm = task / NTN;
        const int m0 = bm * 128, n0 = bn * 128;
        f32x4 acc[4][4];
        zero_acc(acc);
        gemm_core(acc, H, DM, W, DM, DM, m0, n0, lds);
        const bool rope = (bn >= 24 && bn <= 31) || bn == 32 || bn == 34 || bn == 36;
        const float scl = (bn >= 24 && bn <= 31) ? 0.125f : 1.f;
#pragma unroll
        for (int mi = 0; mi < 4; mi++) {
            const int tok = m0 + wr * 64 + mi * 16 + r;
            if (rope) {
                f32x4 v = acc[mi][0];
                f32x4 pr;
#pragma unroll
                for (int j = 0; j < 4; j++) pr[j] = __shfl_xor(v[j], 32, 64);
                const int ib = (q & 1) * 4;
                const f32x4 c0 = *(const f32x4*)(cs + (size_t)tok * 16 + ib * 2);
                const f32x4 c1 = *(const f32x4*)(cs + (size_t)tok * 16 + ib * 2 + 4);
                const float cc[4] = {c0[0], c0[2], c1[0], c1[2]}, sn[4] = {c0[1], c0[3], c1[1], c1[3]};
#pragma unroll
                for (int j = 0; j < 4; j++) v[j] = (q < 2) ? (v[j] * cc[j] - pr[j] * sn[j]) : (v[j] * cc[j] + pr[j] * sn[j]);
                acc[mi][0] = v;
            }
#pragma unroll
            for (int ni = 0; ni < 4; ni++) {
                const f32x4 v = acc[mi][ni] * scl;
                *(u32x2*)(Z + (size_t)tok * ZC + n0 + wc * 64 + ni * 16 + q * 4) = (u32x2){pack2(v[0], v[1]), pack2(v[2], v[3])};
            }
        }
    }
}

__device__ __forceinline__ void gla_prep(const Params& p, int tok0, int h, char* lds) {
    const int tid = threadIdx.x;
    float* bc = (float*)lds;
    float* lrs = (float*)(lds + 32768);
    const bf16_t* Z = (const bf16_t*)(p.ws + OFF_Z);
    for (int i = tid; i < 1024; i += NTHREADS) { const int t = i >> 4, rr = i & 15; lrs[i] = bf2f(Z[(size_t)(tok0 + t) * ZC + ZLR + rr]); }
    const int d = tid & 127, th = tid >> 7;
    float w[16];
#pragma unroll
    for (int rr = 0; rr < 16; rr++) w[rr] = p.gla_wa2[rr * 512 + h * 128 + d];
    const float bias = p.gla_ba2[h * 128 + d];
    __syncthreads();
    float run = 0.f;
    for (int t = th * 32; t < th * 32 + 32; t++) {
        float xv = bias;
#pragma unroll
        for (int rr = 0; rr < 16; rr++) xv += lrs[t * 16 + rr] * w[rr];
        const float ls = fminf(xv, 0.f) - log1pf(__expf(-fabsf(xv)));
        run += ls * (1.f / 16.f);
        bc[t * 128 + d] = run;
    }
    __syncthreads();
    if (th == 1) {
        const float add = bc[31 * 128 + d];
        for (int t = 32; t < 64; t++) bc[t * 128 + d] += add;
    }
    __syncthreads();
}

__device__ void phaseG1_task(const Params& p, int task, char* lds) {
    const int tid = threadIdx.x, lane = tid & 63, wave = tid >> 6, r = lane & 15, q = lane >> 4;
    const int c = task & 31, h = (task >> 5) & 3, b = task >> 7;
    const int tok0 = b * SEQ + c * 64;
    const bf16_t* Z = (const bf16_t*)(p.ws + OFF_Z);
    bf16_t* L = (bf16_t*)p.out;
    float* bc = (float*)lds;
    bf16_t* klT = (bf16_t*)(lds + 36864);
    bf16_t* vT = (bf16_t*)(lds + 36864 + 18432);
    gla_prep(p, tok0, h, lds);
    if (tid < 128) ((float*)(p.ws + OFF_DEC))[task * 128 + tid] = __expf(bc[63 * 128 + tid]);
    {
        const int s = lane, dc = wave * 32;
        const bf16_t* kp = Z + (size_t)(tok0 + s) * ZC + ZK_G + h * 128 + dc;
#pragma unroll
        for (int v4 = 0; v4 < 4; v4++) {
            const u32x4 kv = *(const u32x4*)(kp + v4 * 8);
            const unsigned kw[4] = {kv.x, kv.y, kv.z, kv.w};
#pragma unroll
            for (int j = 0; j < 8; j++) {
                const int d = dc + v4 * 8 + j;
                const float kval = (j & 1) ? bf_hi(kw[j >> 1]) : bf_lo(kw[j >> 1]);
                klT[d * 72 + s] = f2bf(kval * __expf(bc[63 * 128 + d] - bc[s * 128 + d]));
            }
        }
    }
    for (int eh = 0; eh < 2; eh++) {
        __syncthreads();
        {
            const int s = lane, ec = wave * 32;
            const bf16_t* vp = Z + (size_t)(tok0 + s) * ZC + ZV_G + h * 256 + eh * 128 + ec;
#pragma unroll
            for (int v4 = 0; v4 < 4; v4++) {
                const u32x4 vv = *(const u32x4*)(vp + v4 * 8);
                const unsigned vw[4] = {vv.x, vv.y, vv.z, vv.w};
#pragma unroll
                for (int j = 0; j < 8; j++) vT[(ec + v4 * 8 + j) * 72 + s] = (bf16_t)((j & 1) ? (vw[j >> 1] >> 16) : (vw[j >> 1] & 0xffffu));
            }
        }
        __syncthreads();
        f32x4 acc[8][2];
#pragma unroll
        for (int dt = 0; dt < 8; dt++) { acc[dt][0] = (f32x4){0.f, 0.f, 0.f, 0.f}; acc[dt][1] = (f32x4){0.f, 0.f, 0.f, 0.f}; }
#pragma unroll
        for (int ks = 0; ks < 2; ks++) {
            bf16x8 bv[2];
#pragma unroll
            for (int x = 0; x < 2; x++) bv[x] = ld_frag(vT + ((2 * wave + x) * 16 + r) * 72 + ks * 32 + q * 8);
#pragma unroll
            for (int dt = 0; dt < 8; dt++) {
                const bf16x8 a = ld_frag(klT + (dt * 16 + r) * 72 + ks * 32 + q * 8);
#pragma unroll
                for (int x = 0; x < 2; x++) acc[dt][x] = mfma16(a, bv[x], acc[dt][x]);
            }
        }
#pragma unroll
        for (int dt = 0; dt < 8; dt++)
#pragma unroll
            for (int x = 0; x < 2; x++) {
                const int e = eh * 128 + (2 * wave + x) * 16 + r, d = dt * 16 + 4 * q;
                const f32x4 v = acc[dt][x];
                *(u32x2*)(L + ((size_t)task * 256 + e) * 128 + d) = (u32x2){pack2(v[0], v[1]), pack2(v[2], v[3])};
            }
    }
    __syncthreads();
}

__device__ void phaseG2(const Params& p) {
    bf16_t* L = (bf16_t*)p.out;
    const float* dec = (const float*)(p.ws + OFF_DEC);
    for (int idx = blockIdx.x * NTHREADS + threadIdx.x; idx < 32 * 256 * 16; idx += gridDim.x * NTHREADS) {
        const int d8 = idx & 15, e = (idx >> 4) & 255, bh = idx >> 12;
        float st[8];
#pragma unroll
        for (int j = 0; j < 8; j++) st[j] = 0.f;
        for (int c = 0; c < 32; c++) {
            const int task = bh * 32 + c;
            u32x4* ptr = (u32x4*)(L + ((size_t)task * 256 + e) * 128 + d8 * 8);
            const u32x4 lv = *ptr;
            const f32x4 d0 = *(const f32x4*)(dec + task * 128 + d8 * 8), d1 = *(const f32x4*)(dec + task * 128 + d8 * 8 + 4);
            *ptr = (u32x4){pack2(st[0], st[1]), pack2(st[2], st[3]), pack2(st[4], st[5]), pack2(st[6], st[7])};
            st[0] = d0[0] * st[0] + bf_lo(lv.x); st[1] = d0[1] * st[1] + bf_hi(lv.x);
            st[2] = d0[2] * st[2] + bf_lo(lv.y); st[3] = d0[3] * st[3] + bf_hi(lv.y);
            st[4] = d1[0] * st[4] + bf_lo(lv.z); st[5] = d1[1] * st[5] + bf_hi(lv.z);
            st[6] = d1[2] * st[6] + bf_lo(lv.w); st[7] = d1[3] * st[7] + bf_hi(lv.w);
        }
    }
}

__device__ void phaseG3_task(const Params& p, int task, char* lds, bf16_t* ydst, int ystride) {
    const int tid = threadIdx.x, lane = tid & 63, wave = tid >> 6, r = lane & 15, q = lane >> 4;
    const int c = task & 31, h = (task >> 5) & 3, b = task >> 7;
    const int tok0 = b * SEQ + c * 64;
    bf16_t* Z = (bf16_t*)(p.ws + OFF_Z);
    const bf16_t* ST = (const bf16_t*)p.out + (size_t)task * 256 * 128;
    float* bc = (float*)lds;
    bf16_t* vT = (bf16_t*)lds;
    bf16_t* qg = (bf16_t*)(lds + 36864);
    bf16_t* kg = (bf16_t*)(lds + 36864 + 17408);
    bf16_t* P = kg;
    float* red = (float*)(lds + 36864 + 2 * 17408);
    gla_prep(p, tok0, h, lds);
    {
        const int t = tid >> 2, dc = (tid & 3) * 32;
        const bf16_t* qp = Z + (size_t)(tok0 + t) * ZC + ZQ_G + h * 128 + dc;
        const bf16_t* kp = Z + (size_t)(tok0 + t) * ZC + ZK_G + h * 128 + dc;
#pragma unroll
        for (int v4 = 0; v4 < 4; v4++) {
            const u32x4 qv = *(const u32x4*)(qp + v4 * 8), kv = *(const u32x4*)(kp + v4 * 8);
            const unsigned qw[4] = {qv.x, qv.y, qv.z, qv.w}, kw[4] = {kv.x, kv.y, kv.z, kv.w};
            unsigned qo[4], ko[4];
#pragma unroll
            for (int j2 = 0; j2 < 4; j2++) {
                const int d = dc + v4 * 8 + j2 * 2;
                const float b0 = bc[t * 128 + d], b1 = bc[t * 128 + d + 1];
                qo[j2] = pack2(bf_lo(qw[j2]) * 0.08838834764831845f * __expf(b0), bf_hi(qw[j2]) * 0.08838834764831845f * __expf(b1));
                ko[j2] = pack2(bf_lo(kw[j2]) * __expf(-b0), bf_hi(kw[j2]) * __expf(-b1));
            }
            *(u32x4*)(qg + t * 136 + dc + v4 * 8) = (u32x4){qo[0], qo[1], qo[2], qo[3]};
            *(u32x4*)(kg + t * 136 + dc + v4 * 8) = (u32x4){ko[0], ko[1], ko[2], ko[3]};
        }
    }
    __syncthreads();
    {
        const int s = lane, ec = wave * 64;
        const bf16_t* vp = Z + (size_t)(tok0 + s) * ZC + ZV_G + h * 256 + ec;
#pragma unroll
        for (int v4 = 0; v4 < 8; v4++) {
            const u32x4 vv = *(const u32x4*)(vp + v4 * 8);
            const unsigned vw[4] = {vv.x, vv.y, vv.z, vv.w};
#pragma unroll
            for (int j = 0; j < 8; j++) vT[(ec + v4 * 8 + j) * 72 + s] = (bf16_t)((j & 1) ? (vw[j >> 1] >> 16) : (vw[j >> 1] & 0xffffu));
        }
    }
    f32x4 sc[4];
#pragma unroll
    for (int st = 0; st < 4; st++) sc[st] = (f32x4){0.f, 0.f, 0.f, 0.f};
    {
        bf16x8 qf[4];
#pragma unroll
        for (int ks = 0; ks < 4; ks++) qf[ks] = ld_frag(qg + (wave * 16 + r) * 136 + ks * 32 + q * 8);
#pragma unroll
        for (int st = 0; st < 4; st++) {
            if (st <= wave) {
#pragma unroll
                for (int ks = 0; ks < 4; ks++) sc[st] = mfma16(ld_frag(kg + (st * 16 + r) * 136 + ks * 32 + q * 8), qf[ks], sc[st]);
            }
        }
    }
    __syncthreads();
    {
        const int t = wave * 16 + r;
#pragma unroll
        for (int st = 0; st < 4; st++) {
            float pv[4];
#pragma unroll
            for (int j = 0; j < 4; j++) { const int s = st * 16 + 4 * q + j; pv[j] = (s <= t) ? sc[st][j] : 0.f; }
            *(u32x2*)(P + t * 72 + st * 16 + 4 * q) = (u32x2){pack2(pv[0], pv[1]), pack2(pv[2], pv[3])};
        }
    }
    __syncthreads();
    f32x4 o[4][4];
#pragma unroll
    for (int et = 0; et < 4; et++)
#pragma unroll
        for (int tt = 0; tt < 4; tt++) o[et][tt] = (f32x4){0.f, 0.f, 0.f, 0.f};
#pragma unroll
    for (int ks = 0; ks < 2; ks++) {
        bf16x8 pf[4];
#pragma unroll
        for (int tt = 0; tt < 4; tt++) pf[tt] = ld_frag(P + (tt * 16 + r) * 72 + ks * 32 + q * 8);
#pragma unroll
        for (int et = 0; et < 4; et++) {
            const bf16x8 a = ld_frag(vT + ((wave * 4 + et) * 16 + r) * 72 + ks * 32 + q * 8);
#pragma unroll
            for (int tt = 0; tt < 4; tt++) o[et][tt] = mfma16(a, pf[tt], o[et][tt]);
        }
    }
#pragma unroll
    for (int ks = 0; ks < 4; ks++) {
        bf16x8 qf[4];
#pragma unroll
        for (int tt = 0; tt < 4; tt++) qf[tt] = ld_frag(qg + (tt * 16 + r) * 136 + ks * 32 + q * 8);
#pragma unroll
        for (int et = 0; et < 4; et++) {
            const bf16x8 a = *(const bf16x8*)(ST + (size_t)((wave * 4 + et) * 16 + r) * 128 + ks * 32 + q * 8);
#pragma unroll
            for (int tt = 0; tt < 4; tt++) o[et][tt] = mfma16(a, qf[tt], o[et][tt]);
        }
    }
#pragma unroll
    for (int tt = 0; tt < 4; tt++) {
        float ss = 0.f;
#pragma unroll
        for (int et = 0; et < 4; et++)
#pragma unroll
            for (int j = 0; j < 4; j++) ss += o[et][tt][j] * o[et][tt][j];
        ss += __shfl_xor(ss, 16, 64);
        ss += __shfl_xor(ss, 32, 64);
        if (q == 0) red[wave * 64 + tt * 16 + r] = ss;
    }
    __syncthreads();
#pragma unroll
    for (int tt = 0; tt < 4; tt++) {
        const int t = tt * 16 + r;
        const float tot = red[t] + red[64 + t] + red[128 + t] + red[192 + t];
        const float rstd = rsqrtf(tot * (1.f / 256.f) + 1e-6f);
#pragma unroll
        for (int et = 0; et < 4; et++) {
            const int e = (wave * 4 + et) * 16 + 4 * q;
            bf16_t* rp = Z + (size_t)(tok0 + t) * ZC + ZR_G + h * 256 + e;
            const u32x2 rv = *(const u32x2*)rp;
            const f32x4 gn = *(const f32x4*)(p.gla_norm_g + e);
            const float r0 = bf_lo(rv.x), r1 = bf_hi(rv.x), r2 = bf_lo(rv.y), r3 = bf_hi(rv.y);
            const f32x4 ov = o[et][tt];
            *(u32x2*)(ydst + (size_t)(tok0 + t) * ystride + h * 256 + e) = (u32x2){pack2(ov[0] * rstd * gn[0] * siluf_(r0), ov[1] * rstd * gn[1] * siluf_(r1)),
                                  pack2(ov[2] * rstd * gn[2] * siluf_(r2), ov[3] * rstd * gn[3] * siluf_(r3))};
        }
    }
    __syncthreads();
}

__device__ void phaseN1_task(const Params& p, int task, char* lds) {
    const int tid = threadIdx.x, lane = tid & 63, wave = tid >> 6, r = lane & 15, q = lane >> 4;
    const int it = task & 7, g = (task >> 3) & 1, b = (task >> 4) & 7, kv = task >> 7;
    const bf16_t* Z = (const bf16_t*)(p.ws + OFF_Z);
    const bf16_t* W1 = (const bf16_t*)(p.ws + OFF_WC1) + (size_t)kv * 64 * 2048;
    const float* pe = kv ? p.pe_v : p.pe_k;
    const float* w2 = kv ? p.cv_w2 : p.ck_w2;
    const int zoff = (kv ? ZVC : ZKC) + g * 64;
    float* hid = (float*)lds;
    float* hid2 = (float*)(lds + 16384);
    int i = it * 16 + r; if (i > 126) i = 126;
    f32x4 acc[4];
#pragma unroll
    for (int nt = 0; nt < 4; nt++) acc[nt] = (f32x4){0.f, 0.f, 0.f, 0.f};
    for (int ks = 0; ks < 16; ks++) {
        const int k = wave * 512 + ks * 32 + q * 8;
        const int l = k >> 6, d = k & 63;
        const u32x4 zv = *(const u32x4*)(Z + (size_t)(b * SEQ + i * 16 + l) * ZC + zoff + d);
        const f32x4 p0 = *(const f32x4*)(pe + l * 64 + d), p1 = *(const f32x4*)(pe + l * 64 + d + 4);
        const u32x4 av = {pack2(bf_lo(zv.x) + p0[0], bf_hi(zv.x) + p0[1]), pack2(bf_lo(zv.y) + p0[2], bf_hi(zv.y) + p0[3]),
                          pack2(bf_lo(zv.z) + p1[0], bf_hi(zv.z) + p1[1]), pack2(bf_lo(zv.w) + p1[2], bf_hi(zv.w) + p1[3])};
        const bf16x8 a = __builtin_bit_cast(bf16x8, av);
#pragma unroll
        for (int nt = 0; nt < 4; nt++) {
            const bf16x8 bw = *(const bf16x8*)(W1 + (size_t)(nt * 16 + r) * 2048 + k);
            acc[nt] = mfma16(a, bw, acc[nt]);
        }
    }
#pragma unroll
    for (int nt = 0; nt < 4; nt++)
#pragma unroll
        for (int j = 0; j < 4; j++) hid[(wave * 16 + 4 * q + j) * 64 + nt * 16 + r] = acc[nt][j];
    __syncthreads();
    for (int e = tid; e < 1024; e += NTHREADS) hid2[e] = gelu_erf(hid[e] + hid[1024 + e] + hid[2048 + e] + hid[3072 + e]);
    __syncthreads();
    {
        const int il = tid >> 4, n2 = (tid & 15) * 4;
        f32x4 o = {0.f, 0.f, 0.f, 0.f};
        for (int n = 0; n < 64; n++) {
            const float hv = hid2[il * 64 + n];
            const f32x4 wv = *(const f32x4*)(w2 + n * 64 + n2);
            o += hv * wv;
        }
        const int ig = it * 16 + il;
        if (ig >= 127) o = (f32x4){0.f, 0.f, 0.f, 0.f};
        bf16_t* dst = (bf16_t*)(p.ws + OFF_CMP) + ((size_t)((kv * 8 + b) * 2 + g) * 128 + ig) * 64 + n2;
        *(u32x2*)dst = (u32x2){pack2(o[0], o[1]), pack2(o[2], o[3])};
    }
    __syncthreads();
}

__device__ __forceinline__ void nsa_load_kv(const bf16_t* __restrict__ kbase, const bf16_t* __restrict__ vbase, size_t rowstride, bf16_t* Ks, bf16_t* VT) {
    const int tid = threadIdx.x;
    {
        const int key = tid >> 2, ch = (tid & 3) * 16;
        const u32x4 a = *(const u32x4*)(kbase + (size_t)key * rowstride + ch), b = *(const u32x4*)(kbase + (size_t)key * rowstride + ch + 8);
        *(u32x4*)(Ks + key * 72 + ch) = a;
        *(u32x4*)(Ks + key * 72 + ch + 8) = b;
    }
    {
        const int key = tid & 63, dc = (tid >> 6) * 16;
        const u32x4 a = *(const u32x4*)(vbase + (size_t)key * rowstride + dc), b = *(const u32x4*)(vbase + (size_t)key * rowstride + dc + 8);
        const unsigned w[8] = {a.x, a.y, a.z, a.w, b.x, b.y, b.z, b.w};
#pragma unroll
        for (int j = 0; j < 16; j++) VT[(dc + j) * 72 + key] = (bf16_t)((j & 1) ? (w[j >> 1] >> 16) : (w[j >> 1] & 0xffffu));
    }
}

__device__ __forceinline__ void nsa_block_step(const bf16_t* Ks, const bf16_t* VT, const bf16x8 (&qf)[2][2], f32x4 (&O)[2][4], float (&m)[2], float (&l)[2],
                                               unsigned vm, int r, int q) {
#pragma unroll
    for (int x = 0; x < 2; x++) {
        f32x4 s[4];
#pragma unroll
        for (int kt = 0; kt < 4; kt++) s[kt] = (f32x4){0.f, 0.f, 0.f, 0.f};
#pragma unroll
        for (int kt = 0; kt < 4; kt++)
#pragma unroll
            for (int ks = 0; ks < 2; ks++) s[kt] = mfma16(ld_frag(Ks + (kt * 16 + r) * 72 + ks * 32 + q * 8), qf[x][ks], s[kt]);
        __builtin_amdgcn_sched_barrier(0);
        float mx = -1e30f;
#pragma unroll
        for (int kt = 0; kt < 4; kt++)
#pragma unroll
            for (int j = 0; j < 4; j++) if ((vm >> (kt * 4 + j)) & 1u) mx = fmaxf(mx, s[kt][j]);
        mx = fmaxf(mx, __shfl_xor(mx, 16, 64));
        mx = fmaxf(mx, __shfl_xor(mx, 32, 64));
        const float mnew = fmaxf(m[x], mx);
        const float alpha = __expf(m[x] - mnew);
        m[x] = mnew;
        float ls = 0.f;
#pragma unroll
        for (int kt = 0; kt < 4; kt++)
#pragma unroll
            for (int j = 0; j < 4; j++) {
                const float pv = ((vm >> (kt * 4 + j)) & 1u) ? __expf(s[kt][j] - mnew) : 0.f;
                s[kt][j] = pv; ls += pv;
            }
        l[x] = l[x] * alpha + ls;
#pragma unroll
        for (int dt = 0; dt < 4; dt++) O[x][dt] *= alpha;
        __builtin_amdgcn_sched_barrier(0);
#pragma unroll
        for (int s2 = 0; s2 < 2; s2++) {
            const u32x4 t4 = {pack2(s[2 * s2][0], s[2 * s2][1]), pack2(s[2 * s2][2], s[2 * s2][3]),
                              pack2(s[2 * s2 + 1][0], s[2 * s2 + 1][1]), pack2(s[2 * s2 + 1][2], s[2 * s2 + 1][3])};
            const bf16x8 pbv = __builtin_bit_cast(bf16x8, t4);
#pragma unroll
            for (int dt = 0; dt < 4; dt++) {
                const u32x2 lo = *(const u32x2*)(VT + (dt * 16 + r) * 72 + (2 * s2) * 16 + 4 * q);
                const u32x2 hi = *(const u32x2*)(VT + (dt * 16 + r) * 72 + (2 * s2 + 1) * 16 + 4 * q);
                O[x][dt] = mfma16(mk_frag(lo, hi), pbv, O[x][dt]);
            }
        }
        __builtin_amdgcn_sched_barrier(0);
    }
}

__device__ __forceinline__ void nsa_cmp_probs(const bf16_t* Kc, const bf16x8 (&qfx)[2], int nv, int r, int q, f32x4 (&s)[8]) {
#pragma unroll
    for (int kt = 0; kt < 8; kt++) s[kt] = (f32x4){0.f, 0.f, 0.f, 0.f};
#pragma unroll
    for (int kt = 0; kt < 8; kt++)
#pragma unroll
        for (int ks = 0; ks < 2; ks++) s[kt] = mfma16(ld_frag(Kc + (kt * 16 + r) * 72 + ks * 32 + q * 8), qfx[ks], s[kt]);
    __builtin_amdgcn_sched_barrier(0);
    float mx = -1e30f;
#pragma unroll
    for (int kt = 0; kt < 8; kt++)
#pragma unroll
        for (int j = 0; j < 4; j++) if (kt * 16 + 4 * q + j < nv) mx = fmaxf(mx, s[kt][j]);
    mx = fmaxf(mx, __shfl_xor(mx, 16, 64));
    mx = fmaxf(mx, __shfl_xor(mx, 32, 64));
    float ls = 0.f;
#pragma unroll
    for (int kt = 0; kt < 8; kt++)
#pragma unroll
        for (int j = 0; j < 4; j++) {
            const float pv = (kt * 16 + 4 * q + j < nv) ? __expf(s[kt][j] - mx) : 0.f;
            s[kt][j] = pv; ls += pv;
        }
    ls += __shfl_xor(ls, 16, 64);
    ls += __shfl_xor(ls, 32, 64);
    const float inv = nv > 0 ? 1.f / ls : 0.f;
#pragma unroll
    for (int kt = 0; kt < 8; kt++) s[kt] *= inv;
}

__device__ void phaseN2_task(const Params& p, int task, char* lds, bf16_t* ydst, int ystride) {
    const int tid = threadIdx.x, lane = tid & 63, wave = tid >> 6, r = lane & 15, q = lane >> 4;
    const int tt = 127 - (task >> 4), g = task & 1, b = (task >> 1) & 7;
    const int t0 = tt * 16, t = t0 + r;
    const int cur = t0 >> 6;
    bf16_t* Z = (bf16_t*)(p.ws + OFF_Z);
    const size_t rowb = (size_t)b * SEQ;
    bf16_t* Kc = (bf16_t*)lds;
    bf16_t* VcT = (bf16_t*)(lds + 18432);
    bf16_t* Ks = (bf16_t*)lds;
    bf16_t* VT = (bf16_t*)(lds + 18432);
    float* impw = (float*)(lds + 35840);
    float* scs = (float*)(lds + 35840 + 32768);
    unsigned* selm = (unsigned*)(lds + 35840 + 32768 + 2048);

    bf16x8 qf[2][2];
#pragma unroll
    for (int x = 0; x < 2; x++)
#pragma unroll
        for (int ks = 0; ks < 2; ks++) qf[x][ks] = *(const bf16x8*)(Z + (rowb + t) * ZC + ZQ_N + (g * 8 + 2 * wave + x) * 64 + ks * 32 + q * 8);
    f32x4* ofl = (f32x4*)(lds + 35840);

    {
        const bf16_t* kc = (const bf16_t*)(p.ws + OFF_CMP) + (size_t)((0 * 8 + b) * 2 + g) * 128 * 64;
        const bf16_t* vc = (const bf16_t*)(p.ws + OFF_CMP) + (size_t)((1 * 8 + b) * 2 + g) * 128 * 64;
        {
            const int key = tid >> 1, ch = (tid & 1) * 32;
#pragma unroll
            for (int v4 = 0; v4 < 4; v4++) *(u32x4*)(Kc + key * 72 + ch + v4 * 8) = *(const u32x4*)(kc + key * 64 + ch + v4 * 8);
            const int k2 = tid & 127, dc = (tid >> 7) * 32;
#pragma unroll
            for (int v4 = 0; v4 < 4; v4++) {
                const u32x4 a = *(const u32x4*)(vc + k2 * 64 + dc + v4 * 8);
                const unsigned w[4] = {a.x, a.y, a.z, a.w};
#pragma unroll
                for (int j = 0; j < 8; j++) VcT[(dc + v4 * 8 + j) * 136 + k2] = (bf16_t)((j & 1) ? (w[j >> 1] >> 16) : (w[j >> 1] & 0xffffu));
            }
        }
        __syncthreads();
        int nv = t >= 31 ? ((t - 31) >> 4) + 1 : 0;
        if (nv > 127) nv = 127;
        f32x4 isum[8];
#pragma unroll
        for (int kt = 0; kt < 8; kt++) isum[kt] = (f32x4){0.f, 0.f, 0.f, 0.f};
#pragma unroll
        for (int x = 0; x < 2; x++) {
            f32x4 s[8];
            nsa_cmp_probs(Kc, qf[x], nv, r, q, s);
#pragma unroll
            for (int kt = 0; kt < 8; kt++) isum[kt] += s[kt];
            __builtin_amdgcn_sched_barrier(0);
        }
#pragma unroll
        for (int kt = 0; kt < 8; kt++) *(f32x4*)(impw + (wave * 16 + r) * 128 + kt * 16 + 4 * q) = isum[kt];
        __syncthreads();
#pragma unroll
        for (int pass = 0; pass < 2; pass++) {
            const int tk = pass * 8 + (tid >> 5), j = tid & 31;
            const int i0 = j == 0 ? 0 : 4 * j - 1, i1 = (4 * j + 3 > 126) ? 126 : 4 * j + 3;
            float sc = 0.f;
            for (int i = i0; i <= i1; i++) sc += (impw[(0 * 16 + tk) * 128 + i] + impw[(1 * 16 + tk) * 128 + i]) + (impw[(2 * 16 + tk) * 128 + i] + impw[(3 * 16 + tk) * 128 + i]);
            const bool forced = (j == 0) || (j == cur) || (j == cur - 1);
            scs[tk * 32 + j] = forced ? 1e6f : (j <= cur ? sc : -1.f);
        }
        __syncthreads();
#pragma unroll
        for (int pass = 0; pass < 2; pass++) {
            const int tk = pass * 8 + (tid >> 5), j = tid & 31;
            const float mine = scs[tk * 32 + j];
            int rank = 0;
            for (int j2 = 0; j2 < 32; j2++) { const float o = scs[tk * 32 + j2]; rank += (o > mine || (o == mine && j2 < j)) ? 1 : 0; }
            const unsigned long long bal = __ballot(rank < 16);
            if ((lane & 31) == 0) selm[tk] = (unsigned)(lane ? (bal >> 32) : (bal & 0xffffffffull));
        }
        __syncthreads();
    }
    {
        int nv = t >= 31 ? ((t - 31) >> 4) + 1 : 0;
        if (nv > 127) nv = 127;
#pragma unroll
        for (int x = 0; x < 2; x++) {
            f32x4 s[8];
            nsa_cmp_probs(Kc, qf[x], nv, r, q, s);
            f32x4 Oc[4];
#pragma unroll
            for (int dt = 0; dt < 4; dt++) Oc[dt] = (f32x4){0.f, 0.f, 0.f, 0.f};
            __builtin_amdgcn_sched_barrier(0);
#pragma unroll
            for (int s2 = 0; s2 < 4; s2++) {
                const u32x4 t4 = {pack2(s[2 * s2][0], s[2 * s2][1]), pack2(s[2 * s2][2], s[2 * s2][3]),
                                  pack2(s[2 * s2 + 1][0], s[2 * s2 + 1][1]), pack2(s[2 * s2 + 1][2], s[2 * s2 + 1][3])};
                const bf16x8 pbv = __builtin_bit_cast(bf16x8, t4);
#pragma unroll
                for (int dt = 0; dt < 4; dt++) {
                    const u32x2 lo = *(const u32x2*)(VcT + (dt * 16 + r) * 136 + (2 * s2) * 16 + 4 * q);
                    const u32x2 hi = *(const u32x2*)(VcT + (dt * 16 + r) * 136 + (2 * s2 + 1) * 16 + 4 * q);
                    Oc[dt] = mfma16(mk_frag(lo, hi), pbv, Oc[dt]);
                }
            }
            const float g0 = sigmoidf_(bf2f(Z[(rowb + t) * ZC + ZGATE + 0 * 16 + g * 8 + 2 * wave + x]));
#pragma unroll
            for (int dt = 0; dt < 4; dt++) ofl[(wave * 8 + x * 4 + dt) * 64 + lane] = g0 * Oc[dt];
            __builtin_amdgcn_sched_barrier(0);
        }
    }
    const unsigned mysel = selm[r];
    unsigned uni = 0;
#pragma unroll
    for (int i = 0; i < 16; i++) uni |= selm[i];

    {
        f32x4 O[2][4];
        float m[2] = {-1e30f, -1e30f}, l[2] = {0.f, 0.f};
#pragma unroll
        for (int x = 0; x < 2; x++)
#pragma unroll
            for (int dt = 0; dt < 4; dt++) O[x][dt] = (f32x4){0.f, 0.f, 0.f, 0.f};
        for (int j = 0; j <= cur; j++) {
            if (!((uni >> j) & 1u)) continue;
            __syncthreads();
            nsa_load_kv(Z + (rowb + j * 64) * ZC + ZKS + g * 64, Z + (rowb + j * 64) * ZC + ZVS + g * 64, ZC, Ks, VT);
            __syncthreads();
            unsigned vm = 0;
            if ((mysel >> j) & 1u) {
#pragma unroll
                for (int kt = 0; kt < 4; kt++)
#pragma unroll
                    for (int jj = 0; jj < 4; jj++) if (j * 64 + kt * 16 + 4 * q + jj <= t) vm |= 1u << (kt * 4 + jj);
            }
            nsa_block_step(Ks, VT, qf, O, m, l, vm, r, q);
        }
#pragma unroll
        for (int x = 0; x < 2; x++) {
            float lt = l[x];
            lt += __shfl_xor(lt, 16, 64);
            lt += __shfl_xor(lt, 32, 64);
            const float sc = sigmoidf_(bf2f(Z[(rowb + t) * ZC + ZGATE + 1 * 16 + g * 8 + 2 * wave + x])) / lt;
#pragma unroll
            for (int dt = 0; dt < 4; dt++) ofl[(wave * 8 + x * 4 + dt) * 64 + lane] += sc * O[x][dt];
        }
    }
    {
        f32x4 O[2][4];
        float m[2] = {-1e30f, -1e30f}, l[2] = {0.f, 0.f};
#pragma unroll
        for (int x = 0; x < 2; x++)
#pragma unroll
            for (int dt = 0; dt < 4; dt++) O[x][dt] = (f32x4){0.f, 0.f, 0.f, 0.f};
        const int lo = t0 - 511;
        const int jb0 = lo > 0 ? (lo >> 6) : 0;
        for (int j = jb0; j <= cur; j++) {
            __syncthreads();
            nsa_load_kv(Z + (rowb + j * 64) * ZC + ZKW + g * 64, Z + (rowb + j * 64) * ZC + ZVW + g * 64, ZC, Ks, VT);
            __syncthreads();
            unsigned vm = 0;
#pragma unroll
            for (int kt = 0; kt < 4; kt++)
#pragma unroll
                for (int jj = 0; jj < 4; jj++) { const int kp = j * 64 + kt * 16 + 4 * q + jj; if (kp <= t && t - kp < 512) vm |= 1u << (kt * 4 + jj); }
            nsa_block_step(Ks, VT, qf, O, m, l, vm, r, q);
        }
#pragma unroll
        for (int x = 0; x < 2; x++) {
            float lt = l[x];
            lt += __shfl_xor(lt, 16, 64);
            lt += __shfl_xor(lt, 32, 64);
            const float sc = sigmoidf_(bf2f(Z[(rowb + t) * ZC + ZGATE + 2 * 16 + g * 8 + 2 * wave + x])) / lt;
#pragma unroll
            for (int dt = 0; dt < 4; dt++) O[x][dt] = ofl[(wave * 8 + x * 4 + dt) * 64 + lane] + sc * O[x][dt];
        }
#pragma unroll
        for (int x = 0; x < 2; x++)
#pragma unroll
            for (int dt = 0; dt < 4; dt++) {
                const f32x4 v = O[x][dt];
                *(u32x2*)(ydst + (rowb + t) * ystride + (g * 8 + 2 * wave + x) * 64 + dt * 16 + 4 * q) = (u32x2){pack2(v[0], v[1]), pack2(v[2], v[3])};
            }
    }
    __syncthreads();
}

__device__ void phaseM1(const Params& p, char* lds) {
    const int lane = threadIdx.x & 63, wave = threadIdx.x >> 6;
    const int wr = wave >> 1, wc = wave & 1, r = lane & 15, q = lane >> 4;
    const bf16_t* H = (const bf16_t*)(p.ws + OFF_H);
    const bf16_t* Z = (const bf16_t*)(p.ws + OFF_Z);
    bf16_t* M = (bf16_t*)(p.ws + OFF_M);
    for (int task = blockIdx.x; task < 128 * 8; task += gridDim.x) {
        const int bn = task & 7, bm = task >> 3;
        const int m0 = bm * 128, n0 = bn * 128;
        for (int br = 0; br < 2; br++) {
            f32x4 acc[4][4];
            zero_acc(acc);
            gemm_core(acc, H, DM, (const bf16_t*)(p.ws + OFF_WM) + (size_t)br * 1024 * 1024, DM, DM, m0, n0, lds);
            bf16_t* SG = (bf16_t*)p.out;
#pragma unroll
            for (int mi = 0; mi < 4; mi++)
#pragma unroll
                for (int ni = 0; ni < 4; ni++) {
                    const int tok = m0 + wr * 64 + mi * 16 + r, col = n0 + wc * 64 + ni * 16 + 4 * q;
                    *(u32x2*)(SG + (size_t)tok * DM + col) = (u32x2){pack2(sigmoidf_(acc[mi][ni][0]), sigmoidf_(acc[mi][ni][1])),
                                                                      pack2(sigmoidf_(acc[mi][ni][2]), sigmoidf_(acc[mi][ni][3]))};
                }
            zero_acc(acc);
            gemm_core(acc, Z + (br ? ZQ_N : ZR_G), ZC, (const bf16_t*)(p.ws + (br ? OFF_WB : OFF_WA)), DM, DM, m0, n0, lds);
#pragma unroll
            for (int mi = 0; mi < 4; mi++)
#pragma unroll
                for (int ni = 0; ni < 4; ni++) {
                    const int tok = m0 + wr * 64 + mi * 16 + r, col = n0 + wc * 64 + ni * 16 + 4 * q;
                    const u32x2 sg = *(const u32x2*)(SG + (size_t)tok * DM + col);
                    float v[4] = {bf_lo(sg.x) * acc[mi][ni][0], bf_hi(sg.x) * acc[mi][ni][1], bf_lo(sg.y) * acc[mi][ni][2], bf_hi(sg.y) * acc[mi][ni][3]};
                    u32x2* dst = (u32x2*)(M + (size_t)tok * DM + col);
                    if (br) { const u32x2 pv = *dst; v[0] += bf_lo(pv.x); v[1] += bf_hi(pv.x); v[2] += bf_lo(pv.y); v[3] += bf_hi(pv.y); }
                    *dst = (u32x2){pack2(v[0], v[1]), pack2(v[2], v[3])};
                }
        }
    }
}

__device__ void phaseM2(const Params& p, char* lds) {
    const int lane = threadIdx.x & 63, wave = threadIdx.x >> 6;
    const int wr = wave >> 1, wc = wave & 1, r = lane & 15, q = lane >> 4;
    const bf16_t* M = (const bf16_t*)(p.ws + OFF_M);
    const float* mod = (const float*)(p.ws + OFF_MOD);
    for (int task = blockIdx.x; task < 128 * 8; task += gridDim.x) {
        const int bn = task & 7, bm = task >> 3;
        const int m0 = bm * 128, n0 = bn * 128;
        f32x4 acc[4][4];
        zero_acc(acc);
        gemm_core(acc, M, DM, (const bf16_t*)(p.ws + OFF_WO), DM, DM, m0, n0, lds);
#pragma unroll
        for (int mi = 0; mi < 4; mi++)
#pragma unroll
            for (int ni = 0; ni < 4; ni++) {
                const int tok = m0 + wr * 64 + mi * 16 + r, col = n0 + wc * 64 + ni * 16 + 4 * q;
                const f32x4 xv = *(const f32x4*)(p.x + (size_t)tok * DM + col);
                const f32x4 gt = *(const f32x4*)(mod + (tok >> 11) * 6144 + 2 * 1024 + col);
                *(f32x4*)(p.out + (size_t)tok * DM + col) = xv + gt * acc[mi][ni];
            }
    }
    {
        const int lane = threadIdx.x & 63, wave = threadIdx.x >> 6;
        unsigned char* tq = (unsigned char*)(p.ws + OFF_UB);
        float* tsc = (float*)(p.ws + OFF_UB + 33554432);
        for (int row = blockIdx.x * 4 + wave; row < 32768; row += gridDim.x * 4) {
            const bool isv = row >= 16384;
            const float* srcp = (isv ? p.peer_v : p.peer_u) + (size_t)(row & 16383) * DM + lane * 16;
            f32x4 a[4];
            float mx = 0.f;
#pragma unroll
            for (int i = 0; i < 4; i++) {
                a[i] = *(const f32x4*)(srcp + i * 4);
                mx = fmaxf(mx, fmaxf(fmaxf(fabsf(a[i][0]), fabsf(a[i][1])), fmaxf(fabsf(a[i][2]), fabsf(a[i][3]))));
            }
            mx = wave_max(mx);
            const float inv = mx > 0.f ? 127.f / mx : 0.f;
            const int off = isv ? 128 : 0;
            unsigned w[4];
#pragma unroll
            for (int i = 0; i < 4; i++) {
                unsigned pk = 0;
#pragma unroll
                for (int j = 0; j < 4; j++) {
                    int qi = (int)rintf(a[i][j] * inv);
                    qi = qi > 127 ? 127 : (qi < -127 ? -127 : qi);
                    pk |= ((unsigned)(qi + off) & 0xffu) << (8 * j);
                }
                w[i] = pk;
            }
            *(u32x4*)(tq + (size_t)row * DM + lane * 16) = (u32x4){w[0], w[1], w[2], w[3]};
            if (lane == 0) tsc[row] = mx * (1.f / 127.f);
        }
    }
}

__device__ void phaseP1(const Params& p, char* lds) {
    const int lane = threadIdx.x & 63, wave = threadIdx.x >> 6;
    const int wr = wave >> 1, wc = wave & 1, r = lane & 15, q = lane >> 4;
    const bf16_t* H = (const bf16_t*)(p.ws + OFF_H);
    bf16_t* QP = (bf16_t*)(p.ws + OFF_QP);
    for (int task = blockIdx.x; task < 128 * 16; task += gridDim.x) {
        const int bn = task & 15, bm = task >> 4;
        const int m0 = bm * 128, n0 = bn * 128;
        f32x4 acc[4][4];
        zero_acc(acc);
        gemm_core(acc, H, DM, (const bf16_t*)(p.ws + OFF_WQ), DM, DM, m0, n0, lds);
#pragma unroll
        for (int mi = 0; mi < 4; mi++)
#pragma unroll
            for (int ni = 0; ni < 4; ni++) {
                const int tok = m0 + wr * 64 + mi * 16 + r, col = n0 + wc * 64 + ni * 16 + 4 * q;
                const f32x4 v = acc[mi][ni];
                *(u32x2*)(QP + (size_t)tok * 2048 + col) = (u32x2){pack2(v[0], v[1]), pack2(v[2], v[3])};
            }
    }
}

__constant__ unsigned char c_cand_a[64] = {0,0,0,0,0,0,0,0,0,0,0,0,0,0,0,0, 1,1,1,1,1,1,1,1, 2,2,2,2,2, 3,3,3,3, 4,4,4, 5,5, 6,6, 7,7, 8,9,10,11,12,13,14,15, 0,0,0,0,0,0,0,0,0,0,0,0,0,0};
__constant__ unsigned char c_cand_b[64] = {0,1,2,3,4,5,6,7,8,9,10,11,12,13,14,15, 0,1,2,3,4,5,6,7, 0,1,2,3,4, 0,1,2,3, 0,1,2, 0,1, 0,1, 0,1, 0,0,0,0,0,0,0,0, 0,0,0,0,0,0,0,0,0,0,0,0,0,0};

__device__ __forceinline__ unsigned f2key(float f) { const unsigned u = __float_as_uint(f); return (u & 0x80000000u) ? ~u : (u | 0x80000000u); }
__device__ __forceinline__ float key2f(unsigned k) { const unsigned u = (k & 0x80000000u) ? (k & 0x7fffffffu) : ~k; return __uint_as_float(u); }
__device__ __forceinline__ void ins16(unsigned (&L)[16], unsigned v) {
#pragma unroll
    for (int k = 0; k < 16; k++) { const unsigned hi = L[k] > v ? L[k] : v; v = L[k] > v ? v : L[k]; L[k] = hi; }
}

__device__ void phaseP2_task(const Params& p, int task, char* lds) {
    const int tid = threadIdx.x, lane = tid & 63, wave = tid >> 6, r = lane & 15, q = lane >> 4;
    const int h = task & 7, tile = task >> 3;
    const int tok0 = tile * 64;
    const bf16_t* QP = (const bf16_t*)(p.ws + OFF_QP);
    float* S = (float*)lds;
    unsigned* LL = (unsigned*)(lds + 65536);
#pragma unroll
    for (int half = 0; half < 2; half++) {
        const bf16_t* KB = (const bf16_t*)(p.ws + OFF_K1B) + (size_t)half * 131072 + (size_t)h * 128 * 128;
        f32x4 acc[8];
#pragma unroll
        for (int nt = 0; nt < 8; nt++) acc[nt] = (f32x4){0.f, 0.f, 0.f, 0.f};
#pragma unroll
        for (int ks = 0; ks < 4; ks++) {
            const bf16x8 bq = *(const bf16x8*)(QP + (size_t)(tok0 + wave * 16 + r) * 2048 + h * 256 + half * 128 + ks * 32 + q * 8);
#pragma unroll
            for (int nt = 0; nt < 8; nt++) {
                const bf16x8 ak = *(const bf16x8*)(KB + (size_t)(nt * 16 + r) * 128 + ks * 32 + q * 8);
                acc[nt] = mfma16(ak, bq, acc[nt]);
            }
        }
#pragma unroll
        for (int nt = 0; nt < 8; nt++)
#pragma unroll
            for (int j = 0; j < 4; j++) S[(half * 128 + nt * 16 + 4 * q + j) * 64 + wave * 16 + r] = acc[nt][j];
    }
    __syncthreads();
    if (tid < 128) {
        const int half = tid >> 6, tk = tid & 63;
        unsigned L[16];
#pragma unroll
        for (int k = 0; k < 16; k++) L[k] = 0u;
        const float* sp = S + half * 128 * 64 + tk;
        for (int k = 0; k < 128; k++) ins16(L, (f2key(sp[k * 64]) & ~127u) | (unsigned)(127 - k));
#pragma unroll
        for (int k = 0; k < 16; k++) LL[(half * 16 + k) * 64 + tk] = L[k];
    }
    __syncthreads();
    if (tid < 64) {
        const int tk = tid;
        float v1[16], v2[16];
#pragma unroll
        for (int k = 0; k < 16; k++) { v1[k] = key2f(LL[k * 64 + tk] & ~127u); v2[k] = key2f(LL[(16 + k) * 64 + tk] & ~127u); }
        unsigned T[16];
#pragma unroll
        for (int k = 0; k < 16; k++) T[k] = 0u;
        int c = 0;
#pragma unroll
        for (int a = 0; a < 16; a++)
#pragma unroll
            for (int b = 0; b < 16; b++)
                if ((a + 1) * (b + 1) <= 16) { ins16(T, (f2key(v1[a] + v2[b]) & ~63u) | (unsigned)(63 - c)); c++; }
        const float mx = key2f(T[0] & ~63u);
        float e[16], sum = 0.f;
#pragma unroll
        for (int k = 0; k < 16; k++) { e[k] = __expf(key2f(T[k] & ~63u) - mx); sum += e[k]; }
        const float inv = 1.f / sum;
        int ei[16];
#pragma unroll
        for (int k = 0; k < 16; k++) {
            const int cc = 63 - (int)(T[k] & 63u);
            const int a = c_cand_a[cc], b = c_cand_b[cc];
            const int i1 = 127 - (int)(LL[a * 64 + tk] & 127u), i2 = 127 - (int)(LL[(16 + b) * 64 + tk] & 127u);
            ei[k] = i1 * 128 + i2;
            e[k] *= inv;
        }
        int* eidx = (int*)(p.ws + OFF_EIDX) + (size_t)(tok0 + tk) * 128 + h * 16;
        float* gw = (float*)(p.ws + OFF_GW) + (size_t)(tok0 + tk) * 128 + h * 16;
#pragma unroll
        for (int k4 = 0; k4 < 4; k4++) {
            *(u32x4*)(eidx + k4 * 4) = (u32x4){(unsigned)ei[k4 * 4], (unsigned)ei[k4 * 4 + 1], (unsigned)ei[k4 * 4 + 2], (unsigned)ei[k4 * 4 + 3]};
            *(f32x4*)(gw + k4 * 4) = (f32x4){e[k4 * 4], e[k4 * 4 + 1], e[k4 * 4 + 2], e[k4 * 4 + 3]};
        }
    }
    __syncthreads();
}

__device__ __forceinline__ float ub0(unsigned w) { return (float)(w & 0xffu); }
__device__ __forceinline__ float ub1(unsigned w) { return (float)((w >> 8) & 0xffu); }
__device__ __forceinline__ float ub2(unsigned w) { return (float)((w >> 16) & 0xffu); }
__device__ __forceinline__ float ub3(unsigned w) { return (float)(w >> 24); }
__device__ void phaseP3(const Params& p, float* dstp) {
    const int lane = threadIdx.x & 63, wave = threadIdx.x >> 6;
    const bf16_t* H = (const bf16_t*)(p.ws + OFF_H);
    const unsigned char* UQ = (const unsigned char*)(p.ws + OFF_UB);
    const unsigned char* VQ = UQ + 16777216;
    const float* tsc = (const float*)(p.ws + OFF_UB + 33554432);
    const int* eidx = (const int*)(p.ws + OFF_EIDX);
    const float* gwp = (const float*)(p.ws + OFF_GW);
    const float* mod = (const float*)(p.ws + OFF_MOD);
    const int ul = ((lane & 1) << 2) | (lane & 2) | ((lane >> 2) & 1);
    for (int tok = blockIdx.x * 4 + wave; tok < NTOK; tok += gridDim.x * 4) {
        int qh[4];
        float sh;
        {
            const u32x4 a = *(const u32x4*)(H + (size_t)tok * DM + lane * 16), b = *(const u32x4*)(H + (size_t)tok * DM + lane * 16 + 8);
            const unsigned hw[8] = {a.x, a.y, a.z, a.w, b.x, b.y, b.z, b.w};
            float hv[16];
            float mx = 0.f;
#pragma unroll
            for (int i = 0; i < 8; i++) { hv[2 * i] = bf_lo(hw[i]); hv[2 * i + 1] = bf_hi(hw[i]); mx = fmaxf(mx, fmaxf(fabsf(hv[2 * i]), fabsf(hv[2 * i + 1]))); }
            mx = wave_max(mx);
            const float inv = mx > 0.f ? 127.f / mx : 0.f;
            sh = mx * (1.f / 127.f);
#pragma unroll
            for (int i = 0; i < 4; i++) {
                unsigned pk = 0;
#pragma unroll
                for (int j = 0; j < 4; j++) pk |= ((unsigned)((int)rintf(hv[i * 4 + j] * inv)) & 0xffu) << (8 * j);
                qh[i] = (int)pk;
            }
        }
        const int e0 = eidx[(size_t)tok * 128 + lane], e1 = eidx[(size_t)tok * 128 + 64 + lane];
        const float g0 = gwp[(size_t)tok * 128 + lane], g1 = gwp[(size_t)tok * 128 + 64 + lane];
        float acc[16];
#pragma unroll
        for (int i = 0; i < 16; i++) acc[i] = 0.f;
        float wsum = 0.f;
        for (int jb = 0; jb < 128; jb += 8) {
            u32x4 ur[8], vr[8];
#pragma unroll
            for (int u = 0; u < 8; u++) {
                const int j = jb + u;
                const int e = (jb < 64) ? __shfl(e0, j, 64) : __shfl(e1, j - 64, 64);
                ur[u] = *(const u32x4*)(UQ + (size_t)e * DM + lane * 16);
                vr[u] = *(const u32x4*)(VQ + (size_t)e * DM + lane * 16);
            }
            const int jm = jb + ul;
            const int em = (jb < 64) ? __shfl(e0, jm, 64) : __shfl(e1, jm - 64, 64);
            const float gm = (jb < 64) ? __shfl(g0, jm, 64) : __shfl(g1, jm - 64, 64);
            const float su = tsc[em], sv = tsc[16384 + em];
            int pt[8];
#pragma unroll
            for (int u = 0; u < 8; u++) {
                int d = __builtin_amdgcn_sdot4((int)ur[u].x, qh[0], 0, false);
                d = __builtin_amdgcn_sdot4((int)ur[u].y, qh[1], d, false);
                d = __builtin_amdgcn_sdot4((int)ur[u].z, qh[2], d, false);
                d = __builtin_amdgcn_sdot4((int)ur[u].w, qh[3], d, false);
                pt[u] = d;
            }
            int m4[4], m2[2], m1;
            {
                const bool b0 = lane & 1;
#pragma unroll
                for (int j = 0; j < 4; j++) { const int keep = b0 ? pt[j + 4] : pt[j], send = b0 ? pt[j] : pt[j + 4]; m4[j] = keep + __shfl_xor(send, 1, 64); }
                const bool b1 = lane & 2;
#pragma unroll
                for (int j = 0; j < 2; j++) { const int keep = b1 ? m4[j + 2] : m4[j], send = b1 ? m4[j] : m4[j + 2]; m2[j] = keep + __shfl_xor(send, 2, 64); }
                const bool b2 = lane & 4;
                { const int keep = b2 ? m2[1] : m2[0], send = b2 ? m2[0] : m2[1]; m1 = keep + __shfl_xor(send, 4, 64); }
                m1 += __shfl_xor(m1, 8, 64);
                m1 += __shfl_xor(m1, 16, 64);
                m1 += __shfl_xor(m1, 32, 64);
            }
            const float aval = (float)m1 * (sh * su);
            const float ws = gm * gelu_erf(aval) * sv;
#pragma unroll
            for (int u = 0; u < 8; u++) {
                const int src_lane = ((u >> 2) & 1) | (u & 2) | ((u & 1) << 2);
                const float wu = __shfl(ws, src_lane, 64);
                wsum += wu;
                const unsigned vw[4] = {vr[u].x, vr[u].y, vr[u].z, vr[u].w};
#pragma unroll
                for (int i = 0; i < 4; i++) {
                    acc[i * 4 + 0] += wu * ub0(vw[i]); acc[i * 4 + 1] += wu * ub1(vw[i]);
                    acc[i * 4 + 2] += wu * ub2(vw[i]); acc[i * 4 + 3] += wu * ub3(vw[i]);
                }
            }
        }
        const int b = tok >> 11;
        float x2[16];
        float ss = 0.f;
#pragma unroll
        for (int i = 0; i < 4; i++) {
            const int d = lane * 16 + i * 4;
            const f32x4 xv = *(const f32x4*)(p.out + (size_t)tok * DM + d);
            const f32x4 gt = *(const f32x4*)(mod + b * 6144 + 5 * 1024 + d);
#pragma unroll
            for (int j = 0; j < 4; j++) { const float v = xv[j] + gt[j] * (acc[i * 4 + j] - 128.f * wsum); x2[i * 4 + j] = v; ss += v * v; }
        }
        ss = wave_sum(ss);
        const float rstd = rsqrtf(ss * (1.f / 1024.f) + 1e-6f);
#pragma unroll
        for (int i = 0; i < 4; i++) {
            const int d = lane * 16 + i * 4;
            const f32x4 fg = *(const f32x4*)(p.final_g + d);
            f32x4 o;
#pragma unroll
            for (int j = 0; j < 4; j++) o[j] = x2[i * 4 + j] * rstd * fg[j];
            *(f32x4*)(dstp + (size_t)tok * DM + d) = o;
        }
    }
}

#define XB_TMO      128
#define XB_XCNT(j)  (256  + 64 * (j))
#define XB_XSUB(j)  (1280 + 64 * (j))
#define XB_XGEN(j)  (2304 + 64 * (j))
#define XB_TOP      3328
#define XB_TOPGEN   3392
#define XCD_BAR_WORDS 3456
#define XB_SPIN_CAP (1u << 22)
#define LAS __attribute__((address_space(3)))
__device__ __forceinline__ unsigned xb_ld(unsigned* p)              { return __hip_atomic_load(p, __ATOMIC_RELAXED, __HIP_MEMORY_SCOPE_AGENT); }
__device__ __forceinline__ unsigned xb_add(unsigned* p, unsigned v) { return __hip_atomic_fetch_add(p, v, __ATOMIC_RELAXED, __HIP_MEMORY_SCOPE_AGENT); }
__device__ __forceinline__ unsigned xb_xcc_id() { return (unsigned)__builtin_amdgcn_s_getreg((3 << 11) | 20) & 0xFu; }
#define XB_SPIN(cond, bar) do { unsigned _sp = 0; while (cond) { __builtin_amdgcn_s_sleep(1); \
    if ((++_sp & 255u) == 0u) { if (xb_ld(&(bar)[XB_TMO])) break; if (_sp > XB_SPIN_CAP) { atomicAdd(&(bar)[XB_TMO], 1u); break; } } } } while (0)
struct XcdBarrier { unsigned* bar; unsigned x; volatile LAS unsigned* st; };
__device__ __forceinline__ XcdBarrier xcd_barrier_post(unsigned* bar, volatile LAS unsigned* st) {
    XcdBarrier b; b.bar = bar; b.x = xb_xcc_id(); b.st = st;
    if (threadIdx.x == 0) (void)xb_add(&bar[XB_XCNT(b.x)], 1u);
    return b;
}
__device__ __forceinline__ void xcd_barrier_complete(unsigned* bar, unsigned x, unsigned& nloc, unsigned& nx) {
    const unsigned G = gridDim.x * gridDim.y * gridDim.z;
    unsigned sum, cnt, mine, sp = 0u;
    for (;;) {
        sum = 0u; cnt = 0u; mine = 0u;
#pragma unroll
        for (unsigned j = 0; j < 16; ++j) { const unsigned c = xb_ld(&bar[XB_XCNT(j)]); sum += c; cnt += (c > 0u) ? 1u : 0u; mine = (j == x) ? c : mine; }
        if (sum == G) break;
        __builtin_amdgcn_s_sleep(1);
        if ((++sp & 255u) == 0u) { if (xb_ld(&bar[XB_TMO])) break; if (sp > XB_SPIN_CAP) { atomicAdd(&bar[XB_TMO], 1u); break; } }
    }
    nloc = mine > 0u ? mine : 1u; nx = cnt > 0u ? cnt : 1u;
}
__device__ __forceinline__ void xcd_barrier(const XcdBarrier& b) {
    asm volatile("s_waitcnt vmcnt(0)" ::: "memory");
    __syncthreads();
    if (threadIdx.x == 0) {
        unsigned* bar = b.bar;
        __builtin_amdgcn_s_waitcnt(0);
        unsigned nloc = b.st[0], nx = b.st[1];
        if (nloc == 0u) { xcd_barrier_complete(bar, b.x, nloc, nx); b.st[0] = nloc; b.st[1] = nx; }
        const unsigned old = xb_add(&bar[XB_XSUB(b.x)], 1u);
        const unsigned gen = old / nloc;
        if (old + 1u == (gen + 1u) * nloc) {
            __builtin_amdgcn_fence(__ATOMIC_RELEASE, "agent");
            asm volatile("s_waitcnt vmcnt(0)" ::: "memory");
            const unsigned og = xb_add(&bar[XB_TOP], 1u);
            const unsigned tg = og / nx;
            if (og + 1u == (tg + 1u) * nx) xb_add(&bar[XB_TOPGEN], 1u);
            else XB_SPIN(xb_ld(&bar[XB_TOPGEN]) == tg, bar);
            __builtin_amdgcn_fence(__ATOMIC_ACQUIRE, "agent");
            xb_add(&bar[XB_XGEN(b.x)], 1u);
            asm volatile("s_waitcnt vmcnt(0)" ::: "memory");
        } else {
            XB_SPIN(xb_ld(&bar[XB_XGEN(b.x)]) == gen, bar);
            __builtin_amdgcn_fence(__ATOMIC_ACQUIRE, "agent");
            asm volatile("s_waitcnt vmcnt(0)" ::: "memory");
        }
    }
    __syncthreads();
}

__global__ void __launch_bounds__(NTHREADS, 2) mega(Params p) {
    __shared__ __attribute__((aligned(16))) char lds[LDS_BYTES];
    cg::grid_group grid = cg::this_grid();
    volatile LAS unsigned* st = (volatile LAS unsigned*)(lds + LDS_MAIN);
    if (threadIdx.x < 4) st[threadIdx.x] = 0u;
    __syncthreads();
    XcdBarrier xb = xcd_barrier_post((unsigned*)p.ws, st);

    phaseA(p, lds);
    grid.sync();
    phase_modnorm(p, p.x, p.norm1_g, 0, 1, (bf16_t*)(p.ws + OFF_H));
    xcd_barrier(xb);
    phaseC(p, lds);
    xcd_barrier(xb);
    for (int task = blockIdx.x; task < 1024; task += gridDim.x) phaseG1_task(p, task, lds);
    for (int task = blockIdx.x; task < 256; task += gridDim.x) phaseN1_task(p, task, lds);
    xcd_barrier(xb);
    phaseG2(p);
    xcd_barrier(xb);
    for (int task = blockIdx.x; task < 2048; task += gridDim.x) phaseN2_task(p, task, lds, (bf16_t*)(p.ws + OFF_Z) + ZQ_N, ZC);
    for (int task = blockIdx.x; task < 1024; task += gridDim.x) phaseG3_task(p, task, lds, (bf16_t*)(p.ws + OFF_Z) + ZR_G, ZC);
    xcd_barrier(xb);
    phaseM1(p, lds);
    xcd_barrier(xb);
    phaseM2(p, lds);
    xcd_barrier(xb);
    phase_modnorm(p, p.out, p.norm2_g, 3, 4, (bf16_t*)(p.ws + OFF_H));
    xcd_barrier(xb);
    phaseP1(p, lds);
    xcd_barrier(xb);
    for (int task = blockIdx.x; task < 2048; task += gridDim.x) phaseP2_task(p, task, lds);
    xcd_barrier(xb);
    phaseP3(p, p.out);
}

extern "C" void kernel_launch(void* const* d_in, const int* in_sizes, int n_in, void* d_out, int out_size, void* d_ws, size_t ws_size, hipStream_t stream) {
    Params p{};
    p.x = (const float*)d_in[0]; p.c = (const float*)d_in[1]; p.pos = (const int*)d_in[2]; p.ada_w = (const float*)d_in[3]; p.ada_b = (const float*)d_in[4];
    p.norm1_g = (const float*)d_in[5]; p.norm2_g = (const float*)d_in[6]; p.final_g = (const float*)d_in[7]; p.w_in = (const float*)d_in[8];
    p.gla_wa2 = (const float*)d_in[9]; p.gla_ba2 = (const float*)d_in[10]; p.gla_norm_g = (const float*)d_in[11]; p.pe_k = (const float*)d_in[12]; p.pe_v = (const float*)d_in[13];
    p.ck_w1 = (const float*)d_in[14]; p.ck_w2 = (const float*)d_in[15]; p.cv_w1 = (const float*)d_in[16]; p.cv_w2 = (const float*)d_in[17];
    p.w_branch_a = (const float*)d_in[18]; p.w_branch_b = (const float*)d_in[19]; p.w_out = (const float*)d_in[20]; p.peer_wq = (const float*)d_in[21];
    p.peer_k1 = (const float*)d_in[22]; p.peer_k2 = (const float*)d_in[23]; p.peer_u = (const float*)d_in[24]; p.peer_v = (const float*)d_in[25];
    p.out = (float*)d_out; p.ws = (char*)d_ws;
    static int grid_blocks = 0;
    if (!grid_blocks) {
        int dev = 0, cus = 0, per_cu = 0;
        hipGetDevice(&dev);
        hipDeviceGetAttribute(&cus, hipDeviceAttributeMultiprocessorCount, dev);
        hipOccupancyMaxActiveBlocksPerMultiprocessor(&per_cu, mega, NTHREADS, 0);
        if (per_cu > 2) per_cu = 2;
        if (per_cu < 1) per_cu = 1;
        grid_blocks = cus * per_cu;
    }
    hipMemsetAsync(d_ws, 0, XCD_BAR_WORDS * 4, stream);
    void* args[] = {&p};
    hipError_t e = hipLaunchCooperativeKernel((void*)mega, dim3(grid_blocks), dim3(NTHREADS), args, 0, stream);
    if (e != hipSuccess) fprintf(stderr, "cooperative launch failed: %s (grid %d)\n", hipGetErrorString(e), grid_blocks);
}
```

```cpp
#include <hip/hip_runtime.h>
#include <hip/hip_cooperative_groups.h>
#include <stdio.h>
namespace cg = cooperative_groups;
#include <stdint.h>
#include <stddef.h>
#include <math.h>

typedef unsigned short bf16_t;
typedef short bf16x8 __attribute__((ext_vector_type(8)));
typedef float f32x4 __attribute__((ext_vector_type(4)));
typedef unsigned u32x4 __attribute__((ext_vector_type(4)));
typedef unsigned u32x2 __attribute__((ext_vector_type(2)));

constexpr int DM = 1024, NB = 8, SEQ = 2048, NTOK = NB * SEQ;
constexpr int ZC = 4992;
constexpr int ZQ_G = 0, ZK_G = 512, ZV_G = 1024, ZR_G = 2048, ZQ_N = 3072, ZKC = 4096, ZVC = 4224, ZKS = 4352, ZVS = 4480,
              ZKW = 4608, ZVW = 4736, ZGATE = 4864, ZLR = 4912;
constexpr int LDS_MAIN = 73728;
constexpr int LDS_BYTES = LDS_MAIN + 64;
constexpr int NTHREADS = 256;

constexpr size_t OFF_MOD = 16384;
constexpr size_t OFF_ROPE = 212992;
constexpr size_t OFF_CMP = 1261568;
constexpr size_t OFF_DEC = 1785856;
constexpr size_t OFF_K1B = 2310144;
constexpr size_t OFF_WC1 = 2834432;
constexpr size_t OFF_WIN = 4194304;
constexpr size_t OFF_WM = 14417920;
constexpr size_t OFF_WA = 18612224;
constexpr size_t OFF_WB = 20709376;
constexpr size_t OFF_WO = 22806528;
constexpr size_t OFF_WQ = 24903680;
constexpr size_t OFF_H = 29360128;
constexpr size_t OFF_M = 62914560;
constexpr size_t OFF_Z = 96468992;
constexpr size_t OFF_QP = OFF_Z;
constexpr size_t OFF_UB = OFF_Z + 67108864;
constexpr size_t OFF_VB = OFF_UB + 33554432;
constexpr size_t OFF_EIDX = OFF_VB + 33554432;
constexpr size_t OFF_GW = OFF_EIDX + 8388608;

struct Params {
    const float* x; const float* c; const int* pos; const float* ada_w; const float* ada_b;
    const float* norm1_g; const float* norm2_g; const float* final_g; const float* w_in;
    const float* gla_wa2; const float* gla_ba2; const float* gla_norm_g; const float* pe_k; const float* pe_v;
    const float* ck_w1; const float* ck_w2; const float* cv_w1; const float* cv_w2;
    const float* w_branch_a; const float* w_branch_b; const float* w_out; const float* peer_wq;
    const float* peer_k1; const float* peer_k2; const float* peer_u; const float* peer_v;
    float* out; char* ws;
};

__device__ __forceinline__ unsigned f2bf_u(float f) { unsigned u = __float_as_uint(f); return (u + 0x7fffu + ((u >> 16) & 1u)) >> 16; }
__device__ __forceinline__ bf16_t f2bf(float f) { return (bf16_t)f2bf_u(f); }
__device__ __forceinline__ unsigned pack2(float lo, float hi) { return f2bf_u(lo) | (f2bf_u(hi) << 16); }
__device__ __forceinline__ float bf_lo(unsigned u) { return __uint_as_float(u << 16); }
__device__ __forceinline__ float bf_hi(unsigned u) { return __uint_as_float(u & 0xffff0000u); }
__device__ __forceinline__ float bf2f(bf16_t h) { return __uint_as_float(((unsigned)h) << 16); }
__device__ __forceinline__ float wave_sum(float v) {
#pragma unroll
    for (int o = 32; o > 0; o >>= 1) v += __shfl_xor(v, o, 64);
    return v;
}
__device__ __forceinline__ float wave_max(float v) {
#pragma unroll
    for (int o = 32; o > 0; o >>= 1) v = fmaxf(v, __shfl_xor(v, o, 64));
    return v;
}
__device__ __forceinline__ int launder_i(int x) { asm volatile("" : "+v"(x)); return x; }
#define TIDX launder_i((int)threadIdx.x)
__device__ __forceinline__ float sigmoidf_(float x) { return 1.f / (1.f + __expf(-x)); }
__device__ __forceinline__ float siluf_(float x) { return x / (1.f + __expf(-x)); }
__device__ __forceinline__ float gelu_erf(float x) { return 0.5f * x * (1.f + erff(x * 0.70710678118654752f)); }
__device__ __forceinline__ f32x4 mfma16(bf16x8 a, bf16x8 b, f32x4 c) { return __builtin_amdgcn_mfma_f32_16x16x32_bf16(a, b, c, 0, 0, 0); }
__device__ __forceinline__ bf16x8 ld_frag(const bf16_t* p) { return *(const bf16x8*)p; }
__device__ __forceinline__ bf16x8 mk_frag(u32x2 lo, u32x2 hi) { u32x4 t = {lo.x, lo.y, hi.x, hi.y}; return __builtin_bit_cast(bf16x8, t); }

#define WAIT_V(n) asm volatile("s_waitcnt vmcnt(" #n ")" ::: "memory")
__device__ __forceinline__ int swz4(int R) { return (4 - ((R >> 2) & 3)) & 3; }
__device__ __forceinline__ void glds16(const bf16_t* g, char* l) { __builtin_amdgcn_global_load_lds((const unsigned*)g, (unsigned*)l, 16, 0, 0); }
__device__ __forceinline__ void gemm_core(f32x4 (&acc)[4][4], const bf16_t* __restrict__ X, int ldx, const bf16_t* __restrict__ W, int ldw,
                                          int K, int m0, int n0, char* lds) {
    const int tid = TIDX, lane = tid & 63, wave = tid >> 6;
    const int wr = wave >> 1, wc = wave & 1, r = lane & 15, q = lane >> 4;
    const int KT = K / 32;
    const bf16_t* xsrc[2];
    const bf16_t* wsrc[2];
#pragma unroll
    for (int i = 0; i < 2; i++) {
        const int R = (wave * 2 + i) * 16 + (lane >> 2);
        xsrc[i] = X + (size_t)(m0 + R) * ldx + (((lane & 3) ^ swz4(R)) * 8);
        wsrc[i] = W + (size_t)(n0 + R) * ldw + (((lane & 3) ^ swz4(R)) * 8);
    }
    char* xdst = lds + wave * 2048 + lane * 16;
    char* wdst = lds + 8192 + wave * 2048 + lane * 16;
#define GEMM_ISSUE(kt_, s_) do { \
        _Pragma("unroll") for (int i_ = 0; i_ < 2; i_++) { glds16(xsrc[i_] + (kt_) * 32, xdst + (s_) * 16384 + i_ * 1024); \
                                                           glds16(wsrc[i_] + (kt_) * 32, wdst + (s_) * 16384 + i_ * 1024); } } while (0)
    GEMM_ISSUE(0, 0);
    GEMM_ISSUE(1, 1);
    GEMM_ISSUE(2, 2);
    const int rdo = r * 64 + ((q ^ swz4(r)) * 16);
    for (int kt = 0; kt < KT; kt++) {
        if (kt + 2 < KT) WAIT_V(8); else if (kt + 1 < KT) WAIT_V(4); else WAIT_V(0);
        __builtin_amdgcn_s_barrier();
        if (kt + 3 < KT) GEMM_ISSUE(kt + 3, (kt + 3) & 3);
        const char* st = lds + (kt & 3) * 16384;
        bf16x8 af[4], bfr[4];
#pragma unroll
        for (int ni = 0; ni < 4; ni++) af[ni] = *(const bf16x8*)(st + 8192 + (wc * 64 + ni * 16) * 64 + rdo);
#pragma unroll
        for (int mi = 0; mi < 4; mi++) bfr[mi] = *(const bf16x8*)(st + (wr * 64 + mi * 16) * 64 + rdo);
#pragma unroll
        for (int mi = 0; mi < 4; mi++)
#pragma unroll
            for (int ni = 0; ni < 4; ni++) acc[mi][ni] = mfma16(af[ni], bfr[mi], acc[mi][ni]);
    }
    __syncthreads();
}
__device__ __forceinline__ void zero_acc(f32x4 (&acc)[4][4]) {
#pragma unroll
    for (int a = 0; a < 4; a++)
#pragma unroll
        for (int b = 0; b < 4; b++) acc[a][b] = (f32x4){0.f, 0.f, 0.f, 0.f};
}

struct TileIter {
    int nt, ng, rounds, i, x, li; bool fancy;
    __device__ TileIter(int ntiles_n, const char* lds) {
        const volatile unsigned* w = (const volatile unsigned*)(lds + LDS_MAIN);
        nt = ntiles_n; li = (int)w[2]; fancy = (w[3] == 1u) && (gridDim.x == 512) && (li < 64); x = (int)w[4];
        ng = (nt + 7) >> 3; rounds = 2 * ng; i = fancy ? 0 : blockIdx.x;
    }
    __device__ bool next(int& bm, int& bn) {
        if (fancy) {
            while (i < rounds) { const int mh = i / ng, g = i - mh * ng; const int n = g * 8 + (li >> 3); i++; if (n < nt) { bm = x * 16 + mh * 8 + (li & 7); bn = n; return true; } }
            return false;
        }
        if (i >= 128 * nt) return false;
        bn = i % nt; bm = i / nt; i += gridDim.x; return true;
    }
};

struct MapId { __device__ int operator()(int n) const { return n; } };
struct MapWin {
    __device__ int operator()(int n) const { return n < 3072 ? n : (n < 4912 ? n + 16 : (n < 4928 ? n - 1840 : -1)); }
};
struct MapOff { int off; __device__ int operator()(int n) const { return n + off; } };

template <class Map>
__device__ __forceinline__ void tconv_tile(const float* __restrict__ src, int ldsrc, bf16_t* __restrict__ dst, int ldd, int n0, int k0, Map map, float* t) {
    const int tid = TIDX;
    const int n = tid & 63, kb = tid >> 6;
    const int sc = map(n0 + n);
#pragma unroll
    for (int i = 0; i < 16; i++) { const int k = i * 4 + kb; t[k * 65 + n] = sc >= 0 ? src[(size_t)(k0 + k) * ldsrc + sc] : 0.f; }
    __syncthreads();
    const int nn = tid >> 2, kk = (tid & 3) * 16;
    unsigned w[8];
#pragma unroll
    for (int j = 0; j < 8; j++) w[j] = pack2(t[(kk + 2 * j) * 65 + nn], t[(kk + 2 * j + 1) * 65 + nn]);
    u32x4* d = (u32x4*)(dst + (size_t)(n0 + nn) * ldd + k0 + kk);
    d[0] = (u32x4){w[0], w[1], w[2], w[3]};
    d[1] = (u32x4){w[4], w[5], w[6], w[7]};
    __syncthreads();
}

constexpr int TA_MOD = 192, TA_WIN = 78 * 16, TA_WM = 32 * 16, TA_SQ = 16 * 16, TA_WQ = 32 * 16, TA_WC = 32, TA_K12 = 64, TA_ROPE = 512;
constexpr int TA_E0 = TA_MOD, TA_E1 = TA_E0 + TA_WIN, TA_E2 = TA_E1 + TA_WM, TA_E3 = TA_E2 + TA_SQ, TA_E4 = TA_E3 + TA_SQ, TA_E5 = TA_E4 + TA_SQ,
              TA_E6 = TA_E5 + TA_WQ, TA_E7 = TA_E6 + TA_WC, TA_E8 = TA_E7 + TA_WC, TA_E9 = TA_E8 + TA_K12, TA_E10 = TA_E9 + TA_K12, TA_E11 = TA_E10 + TA_ROPE;

__device__ void phaseA(const Params& p, char* lds) {
    const int tid = TIDX;
    float* fl = (float*)lds;
    for (int task = blockIdx.x; task < TA_E11; task += gridDim.x) {
        if (task < TA_E0) {
            float* sc = fl;
            float* red = fl + 8192;
            for (int i = tid; i < 8192; i += NTHREADS) sc[i] = siluf_(p.c[i]);
            __syncthreads();
            const int n = task * 32 + (tid & 31), kg = tid >> 5;
            float a[8];
#pragma unroll
            for (int b = 0; b < 8; b++) a[b] = 0.f;
            for (int k = kg * 128; k < kg * 128 + 128; k++) {
                const float w = p.ada_w[(size_t)k * 6144 + n];
#pragma unroll
                for (int b = 0; b < 8; b++) a[b] += sc[b * 1024 + k] * w;
            }
#pragma unroll
            for (int b = 0; b < 8; b++) red[(kg * 8 + b) * 32 + (tid & 31)] = a[b];
            __syncthreads();
            {
                const int b = tid >> 5, nn = tid & 31;
                float s = 0.f;
#pragma unroll
                for (int g = 0; g < 8; g++) s += red[(g * 8 + b) * 32 + nn];
                ((float*)(p.ws + OFF_MOD))[b * 6144 + task * 32 + nn] = s + p.ada_b[task * 32 + nn];
            }
            __syncthreads();
        } else if (task < TA_E1) {
            const int tt = task - TA_E0;
            tconv_tile(p.w_in, 6976, (bf16_t*)(p.ws + OFF_WIN), 1024, (tt >> 4) * 64, (tt & 15) * 64, MapWin(), fl);
        } else if (task < TA_E2) {
            const int tt = task - TA_E1;
            tconv_tile(p.w_in, 6976, (bf16_t*)(p.ws + OFF_WM), 1024, (tt >> 4) * 64, (tt & 15) * 64, MapOff{4928}, fl);
        } else if (task < TA_E3) {
            const int tt = task - TA_E2;
            tconv_tile(p.w_branch_a, 1024, (bf16_t*)(p.ws + OFF_WA), 1024, (tt >> 4) * 64, (tt & 15) * 64, MapId(), fl);
        } else if (task < TA_E4) {
            const int tt = task - TA_E3;
            tconv_tile(p.w_branch_b, 1024, (bf16_t*)(p.ws + OFF_WB), 1024, (tt >> 4) * 64, (tt & 15) * 64, MapId(), fl);
        } else if (task < TA_E5) {
            const int tt = task - TA_E4;
            tconv_tile(p.w_out, 1024, (bf16_t*)(p.ws + OFF_WO), 1024, (tt >> 4) * 64, (tt & 15) * 64, MapId(), fl);
        } else if (task < TA_E6) {
            const int tt = task - TA_E5;
            tconv_tile(p.peer_wq, 2048, (bf16_t*)(p.ws + OFF_WQ), 1024, (tt >> 4) * 64, (tt & 15) * 64, MapId(), fl);
        } else if (task < TA_E7) {
            const int tt = task - TA_E6;
            tconv_tile(p.ck_w1, 64, (bf16_t*)(p.ws + OFF_WC1), 2048, 0, tt * 64, MapId(), fl);
        } else if (task < TA_E8) {
            const int tt = task - TA_E7;
            tconv_tile(p.cv_w1, 64, (bf16_t*)(p.ws + OFF_WC1) + 64 * 2048, 2048, 0, tt * 64, MapId(), fl);
        } else if (task < TA_E10) {
            const bool second = task >= TA_E9;
            const int tt = task - (second ? TA_E9 : TA_E8);
            const float* src = second ? p.peer_k2 : p.peer_k1;
            bf16_t* dst = (bf16_t*)(p.ws + OFF_K1B) + (second ? 131072 : 0);
            const int i = tt * 2048 + tid * 8;
            const f32x4 a = *(const f32x4*)(src + i), b = *(const f32x4*)(src + i + 4);
            *(u32x4*)(dst + i) = (u32x4){pack2(a[0], a[1]), pack2(a[2], a[3]), pack2(b[0], b[1]), pack2(b[2], b[3])};
        } else {
            const int tt = task - TA_E10;
            const int e = tt * 256 + tid;
            const int tok = e >> 3, i = e & 7;
            const float invf[8] = {1.0f, 0.1939227432012558f, 0.03760603070259094f, 0.007292664609849453f,
                                   0.0014142135623842478f, 0.00027424818836152554f, 5.318296098266728e-05f, 1.0313386155758053e-05f};
            float fr = invf[0];
#pragma unroll
            for (int j = 1; j < 8; j++) fr = (i == j) ? invf[j] : fr;
            const float ang = (float)p.pos[tok] * fr;
            const double rev = (double)ang * 0.15915494309189533577;
            const float fpart = (float)(rev - floor(rev));
            float* cs = (float*)(p.ws + OFF_ROPE);
            cs[e * 2] = __builtin_amdgcn_cosf(fpart);
            cs[e * 2 + 1] = __builtin_amdgcn_sinf(fpart);
        }
    }
}

__device__ void phase_modnorm(const Params& p, const float* __restrict__ src, const float* __restrict__ g, int shift_idx, int scale_idx, bf16_t* __restrict__ dst) {
    const int tid_ = TIDX; const int lane = tid_ & 63, wave = tid_ >> 6;
    const float* mod = (const float*)(p.ws + OFF_MOD);
    for (int tok = blockIdx.x * 4 + wave; tok < NTOK; tok += gridDim.x * 4) {
        const int b = tok >> 11;
        const float* xr = src + (size_t)tok * DM;
        f32x4 v[4];
        float ss = 0.f;
#pragma unroll
        for (int c = 0; c < 4; c++) { v[c] = *(const f32x4*)(xr + c * 256 + lane * 4); ss += v[c][0] * v[c][0] + v[c][1] * v[c][1] + v[c][2] * v[c][2] + v[c][3] * v[c][3]; }
        ss = wave_sum(ss);
        const float rstd = rsqrtf(ss * (1.f / 1024.f) + 1e-6f);
#pragma unroll
        for (int c = 0; c < 4; c++) {
            const int d = c * 256 + lane * 4;
            const f32x4 gg = *(const f32x4*)(g + d);
            const f32x4 sc = *(const f32x4*)(mod + b * 6144 + scale_idx * 1024 + d);
            const f32x4 sh = *(const f32x4*)(mod + b * 6144 + shift_idx * 1024 + d);
            float o[4];
#pragma unroll
            for (int j = 0; j < 4; j++) o[j] = (v[c][j] * rstd) * gg[j] * (1.f + sc[j]) + sh[j];
            *(u32x2*)(dst + (size_t)tok * DM + d) = (u32x2){pack2(o[0], o[1]), pack2(o[2], o[3])};
        }
    }
}

__device__ void phaseC(const Params& p, char* lds) {
    const int tid_ = TIDX; const int lane = tid_ & 63, wave = tid_ >> 6;
    const int wr = wave >> 1, wc = wave & 1, r = lane & 15, q = lane >> 4;
    const bf16_t* H = (const bf16_t*)(p.ws + OFF_H);
    const bf16_t* W = (const bf16_t*)(p.ws + OFF_WIN);
    bf16_t* Z = (bf16_t*)(p.ws + OFF_Z);
    const float* cs = (const float*)(p.ws + OFF_ROPE);
    constexpr int NTN = ZC / 128;
    TileIter tit(NTN, lds);
    int bm, bn;
    while (tit.next(bm, bn)) {
        const int m0 = bm * 128, n0 = bn * 128;
        f32x4 acc[4][4];
        zero_acc(acc);
        gemm_core(acc, H, DM, W, DM, DM, m0, n0, lds);
        const bool rope = (bn >= 24 && bn <= 31) || bn == 32 || bn == 34 || bn == 36;
        const float scl = (bn >= 24 && bn <= 31) ? 0.125f : 1.f;
#pragma unroll
        for (int mi = 0; mi < 4; mi++) {
            const int tok = m0 + wr * 64 + mi * 16 + r;
            if (rope) {
                f32x4 v = acc[mi][0];
                f32x4 pr;
#pragma unroll
                for (int j = 0; j < 4; j++) pr[j] = __shfl_xor(v[j], 32, 64);
                const int ib = (q & 1) * 4;
                const f32x4 c0 = *(const f32x4*)(cs + (size_t)tok * 16 + ib * 2);
                const f32x4 c1 = *(const f32x4*)(cs + (size_t)tok * 16 + ib * 2 + 4);
                const float cc[4] = {c0[0], c0[2], c1[0], c1[2]}, sn[4] = {c0[1], c0[3], c1[1], c1[3]};
#pragma unroll
                for (int j = 0; j < 4; j++) v[j] = (q < 2) ? (v[j] * cc[j] - pr[j] * sn[j]) : (v[j] * cc[j] + pr[j] * sn[j]);
                acc[mi][0] = v;
            }
#pragma unroll
            for (int ni = 0; ni < 4; ni++) {
                const f32x4 v = acc[mi][ni] * scl;
                *(u32x2*)(Z + (size_t)tok * ZC + n0 + wc * 64 + ni * 16 + q * 4) = (u32x2){pack2(v[0], v[1]), pack2(v[2], v[3])};
            }
        }
    }
}

__device__ __forceinline__ void gla_prep(const Params& p, int tok0, int h, char* lds) {
    const int tid = TIDX;
    float* bc = (float*)lds;
    float* lrs = (float*)(lds + 32768);
    const bf16_t* Z = (const bf16_t*)(p.ws + OFF_Z);
    for (int i = tid; i < 1024; i += NTHREADS) { const int t = i >> 4, rr = i & 15; lrs[i] = bf2f(Z[(size_t)(tok0 + t) * ZC + ZLR + rr]); }
    const int d = tid & 127, th = tid >> 7;
    float w[16];
#pragma unroll
    for (int rr = 0; rr < 16; rr++) w[rr] = p.gla_wa2[rr * 512 + h * 128 + d];
    const float bias = p.gla_ba2[h * 128 + d];
    __syncthreads();
    float run = 0.f;
    for (int t = th * 32; t < th * 32 + 32; t++) {
        float xv = bias;
#pragma unroll
        for (int rr = 0; rr < 16; rr++) xv += lrs[t * 16 + rr] * w[rr];
        const float ls = fminf(xv, 0.f) - log1pf(__expf(-fabsf(xv)));
        run += ls * (1.f / 16.f);
        bc[t * 128 + d] = run;
    }
    __syncthreads();
    if (th == 1) {
        const float add = bc[31 * 128 + d];
        for (int t = 32; t < 64; t++) bc[t * 128 + d] += add;
    }
    __syncthreads();
}

__device__ void phaseG1_task(const Params& p, int task, char* lds) {
    const int tid = TIDX, lane = tid & 63, wave = tid >> 6, r = lane & 15, q = lane >> 4;
    const int c = task & 31, h = (task >> 5) & 3, b = task >> 7;
    const int tok0 = b * SEQ + c * 64;
    const bf16_t* Z = (const bf16_t*)(p.ws + OFF_Z);
    bf16_t* L = (bf16_t*)p.out;
    float* bc = (float*)lds;
    bf16_t* klT = (bf16_t*)(lds + 36864);
    bf16_t* vT = (bf16_t*)(lds + 36864 + 18432);
    gla_prep(p, tok0, h, lds);
    if (tid < 128) ((float*)(p.ws + OFF_DEC))[task * 128 + tid] = __expf(bc[63 * 128 + tid]);
    {
        const int s = lane, dc = wave * 32;
        const bf16_t* kp = Z + (size_t)(tok0 + s) * ZC + ZK_G + h * 128 + dc;
#pragma unroll
        for (int v4 = 0; v4 < 4; v4++) {
            const u32x4 kv = *(const u32x4*)(kp + v4 * 8);
            const unsigned kw[4] = {kv.x, kv.y, kv.z, kv.w};
#pragma unroll
            for (int j = 0; j < 8; j++) {
                const int d = dc + v4 * 8 + j;
                const float kval = (j & 1) ? bf_hi(kw[j >> 1]) : bf_lo(kw[j >> 1]);
                klT[d * 72 + s] = f2bf(kval * __expf(bc[63 * 128 + d] - bc[s * 128 + d]));
            }
        }
    }
    for (int eh = 0; eh < 2; eh++) {
        __syncthreads();
        {
            const int s = lane, ec = wave * 32;
            const bf16_t* vp = Z + (size_t)(tok0 + s) * ZC + ZV_G + h * 256 + eh * 128 + ec;
#pragma unroll
            for (int v4 = 0; v4 < 4; v4++) {
                const u32x4 vv = *(const u32x4*)(vp + v4 * 8);
                const unsigned vw[4] = {vv.x, vv.y, vv.z, vv.w};
#pragma unroll
                for (int j = 0; j < 8; j++) vT[(ec + v4 * 8 + j) * 72 + s] = (bf16_t)((j & 1) ? (vw[j >> 1] >> 16) : (vw[j >> 1] & 0xffffu));
            }
        }
        __syncthreads();
        f32x4 acc[8][2];
#pragma unroll
        for (int dt = 0; dt < 8; dt++) { acc[dt][0] = (f32x4){0.f, 0.f, 0.f, 0.f}; acc[dt][1] = (f32x4){0.f, 0.f, 0.f, 0.f}; }
#pragma unroll
        for (int ks = 0; ks < 2; ks++) {
            bf16x8 bv[2];
#pragma unroll
            for (int x = 0; x < 2; x++) bv[x] = ld_frag(vT + ((2 * wave + x) * 16 + r) * 72 + ks * 32 + q * 8);
#pragma unroll
            for (int dt = 0; dt < 8; dt++) {
                const bf16x8 a = ld_frag(klT + (dt * 16 + r) * 72 + ks * 32 + q * 8);
#pragma unroll
                for (int x = 0; x < 2; x++) acc[dt][x] = mfma16(a, bv[x], acc[dt][x]);
            }
        }
#pragma unroll
        for (int dt = 0; dt < 8; dt++)
#pragma unroll
            for (int x = 0; x < 2; x++) {
                const int e = eh * 128 + (2 * wave + x) * 16 + r, d = dt * 16 + 4 * q;
                const f32x4 v = acc[dt][x];
                *(u32x2*)(L + ((size_t)task * 256 + e) * 128 + d) = (u32x2){pack2(v[0], v[1]), pack2(v[2], v[3])};
            }
    }
    __syncthreads();
}

__device__ void phaseG2(const Params& p) {
    bf16_t* L = (bf16_t*)p.out;
    const float* dec = (const float*)(p.ws + OFF_DEC);
    for (int idx = blockIdx.x * NTHREADS + threadIdx.x; idx < 32 * 256 * 16; idx += gridDim.x * NTHREADS) {
        const int d8 = idx & 15, e = (idx >> 4) & 255, bh = idx >> 12;
        float st[8];
#pragma unroll
        for (int j = 0; j < 8; j++) st[j] = 0.f;
        for (int c = 0; c < 32; c++) {
            const int task = bh * 32 + c;
            u32x4* ptr = (u32x4*)(L + ((size_t)task * 256 + e) * 128 + d8 * 8);
            const u32x4 lv = *ptr;
            const f32x4 d0 = *(const f32x4*)(dec + task * 128 + d8 * 8), d1 = *(const f32x4*)(dec + task * 128 + d8 * 8 + 4);
            *ptr = (u32x4){pack2(st[0], st[1]), pack2(st[2], st[3]), pack2(st[4], st[5]), pack2(st[6], st[7])};
            st[0] = d0[0] * st[0] + bf_lo(lv.x); st[1] = d0[1] * st[1] + bf_hi(lv.x);
            st[2] = d0[2] * st[2] + bf_lo(lv.y); st[3] = d0[3] * st[3] + bf_hi(lv.y);
            st[4] = d1[0] * st[4] + bf_lo(lv.z); st[5] = d1[1] * st[5] + bf_hi(lv.z);
            st[6] = d1[2] * st[6] + bf_lo(lv.w); st[7] = d1[3] * st[7] + bf_hi(lv.w);
        }
    }
}

__device__ void phaseG3_task(const Params& p, int task, char* lds, bf16_t* ydst, int ystride) {
    const int tid = TIDX, lane = tid & 63, wave = tid >> 6, r = lane & 15, q = lane >> 4;
    const int c = task & 31, h = (task >> 5) & 3, b = task >> 7;
    const int tok0 = b * SEQ + c * 64;
    bf16_t* Z = (bf16_t*)(p.ws + OFF_Z);
    const bf16_t* ST = (const bf16_t*)p.out + (size_t)task * 256 * 128;
    float* bc = (float*)lds;
    bf16_t* vT = (bf16_t*)lds;
    bf16_t* qg = (bf16_t*)(lds + 36864);
    bf16_t* kg = (bf16_t*)(lds + 36864 + 17408);
    bf16_t* P = kg;
    float* red = (float*)(lds + 36864 + 2 * 17408);
    gla_prep(p, tok0, h, lds);
    {
        const int t = tid >> 2, dc = (tid & 3) * 32;
        const bf16_t* qp = Z + (size_t)(tok0 + t) * ZC + ZQ_G + h * 128 + dc;
        const bf16_t* kp = Z + (size_t)(tok0 + t) * ZC + ZK_G + h * 128 + dc;
#pragma unroll
        for (int v4 = 0; v4 < 4; v4++) {
            const u32x4 qv = *(const u32x4*)(qp + v4 * 8), kv = *(const u32x4*)(kp + v4 * 8);
            const unsigned qw[4] = {qv.x, qv.y, qv.z, qv.w}, kw[4] = {kv.x, kv.y, kv.z, kv.w};
            unsigned qo[4], ko[4];
#pragma unroll
            for (int j2 = 0; j2 < 4; j2++) {
                const int d = dc + v4 * 8 + j2 * 2;
                const float b0 = bc[t * 128 + d], b1 = bc[t * 128 + d + 1];
                qo[j2] = pack2(bf_lo(qw[j2]) * 0.08838834764831845f * __expf(b0), bf_hi(qw[j2]) * 0.08838834764831845f * __expf(b1));
                ko[j2] = pack2(bf_lo(kw[j2]) * __expf(-b0), bf_hi(kw[j2]) * __expf(-b1));
            }
            *(u32x4*)(qg + t * 136 + dc + v4 * 8) = (u32x4){qo[0], qo[1], qo[2], qo[3]};
            *(u32x4*)(kg + t * 136 + dc + v4 * 8) = (u32x4){ko[0], ko[1], ko[2], ko[3]};
        }
    }
    __syncthreads();
    {
        const int s = lane, ec = wave * 64;
        const bf16_t* vp = Z + (size_t)(tok0 + s) * ZC + ZV_G + h * 256 + ec;
#pragma unroll
        for (int v4 = 0; v4 < 8; v4++) {
            const u32x4 vv = *(const u32x4*)(vp + v4 * 8);
            const unsigned vw[4] = {vv.x, vv.y, vv.z, vv.w};
#pragma unroll
            for (int j = 0; j < 8; j++) vT[(ec + v4 * 8 + j) * 72 + s] = (bf16_t)((j & 1) ? (vw[j >> 1] >> 16) : (vw[j >> 1] & 0xffffu));
        }
    }
    f32x4 sc[4];
#pragma unroll
    for (int st = 0; st < 4; st++) sc[st] = (f32x4){0.f, 0.f, 0.f, 0.f};
    {
        bf16x8 qf[4];
#pragma unroll
        for (int ks = 0; ks < 4; ks++) qf[ks] = ld_frag(qg + (wave * 16 + r) * 136 + ks * 32 + q * 8);
#pragma unroll
        for (int st = 0; st < 4; st++) {
            if (st <= wave) {
#pragma unroll
                for (int ks = 0; ks < 4; ks++) sc[st] = mfma16(ld_frag(kg + (st * 16 + r) * 136 + ks * 32 + q * 8), qf[ks], sc[st]);
            }
        }
    }
    __syncthreads();
    {
        const int t = wave * 16 + r;
#pragma unroll
        for (int st = 0; st < 4; st++) {
            float pv[4];
#pragma unroll
            for (int j = 0; j < 4; j++) { const int s = st * 16 + 4 * q + j; pv[j] = (s <= t) ? sc[st][j] : 0.f; }
            *(u32x2*)(P + t * 72 + st * 16 + 4 * q) = (u32x2){pack2(pv[0], pv[1]), pack2(pv[2], pv[3])};
        }
    }
    __syncthreads();
    f32x4 o[4][4];
#pragma unroll
    for (int et = 0; et < 4; et++)
#pragma unroll
        for (int tt = 0; tt < 4; tt++) o[et][tt] = (f32x4){0.f, 0.f, 0.f, 0.f};
#pragma unroll
    for (int ks = 0; ks < 2; ks++) {
        bf16x8 pf[4];
#pragma unroll
        for (int tt = 0; tt < 4; tt++) pf[tt] = ld_frag(P + (tt * 16 + r) * 72 + ks * 32 + q * 8);
#pragma unroll
        for (int et = 0; et < 4; et++) {
            const bf16x8 a = ld_frag(vT + ((wave * 4 + et) * 16 + r) * 72 + ks * 32 + q * 8);
#pragma unroll
            for (int tt = 0; tt < 4; tt++) o[et][tt] = mfma16(a, pf[tt], o[et][tt]);
        }
    }
#pragma unroll
    for (int ks = 0; ks < 4; ks++) {
        bf16x8 qf[4];
#pragma unroll
        for (int tt = 0; tt < 4; tt++) qf[tt] = ld_frag(qg + (tt * 16 + r) * 136 + ks * 32 + q * 8);
#pragma unroll
        for (int et = 0; et < 4; et++) {
            const bf16x8 a = *(const bf16x8*)(ST + (size_t)((wave * 4 + et) * 16 + r) * 128 + ks * 32 + q * 8);
#pragma unroll
            for (int tt = 0; tt < 4; tt++) o[et][tt] = mfma16(a, qf[tt], o[et][tt]);
        }
    }
#pragma unroll
    for (int tt = 0; tt < 4; tt++) {
        float ss = 0.f;
#pragma unroll
        for (int et = 0; et < 4; et++)
#pragma unroll
            for (int j = 0; j < 4; j++) ss += o[et][tt][j] * o[et][tt][j];
        ss += __shfl_xor(ss, 16, 64);
        ss += __shfl_xor(ss, 32, 64);
        if (q == 0) red[wave * 64 + tt * 16 + r] = ss;
    }
    __syncthreads();
#pragma unroll
    for (int tt = 0; tt < 4; tt++) {
        const int t = tt * 16 + r;
        const float tot = red[t] + red[64 + t] + red[128 + t] + red[192 + t];
        const float rstd = rsqrtf(tot * (1.f / 256.f) + 1e-6f);
#pragma unroll
        for (int et = 0; et < 4; et++) {
            const int e = (wave * 4 + et) * 16 + 4 * q;
            bf16_t* rp = Z + (size_t)(tok0 + t) * ZC + ZR_G + h * 256 + e;
            const u32x2 rv = *(const u32x2*)rp;
            const f32x4 gn = *(const f32x4*)(p.gla_norm_g + e);
            const float r0 = bf_lo(rv.x), r1 = bf_hi(rv.x), r2 = bf_lo(rv.y), r3 = bf_hi(rv.y);
            const f32x4 ov = o[et][tt];
            *(u32x2*)(ydst + (size_t)(tok0 + t) * ystride + h * 256 + e) = (u32x2){pack2(ov[0] * rstd * gn[0] * siluf_(r0), ov[1] * rstd * gn[1] * siluf_(r1)),
                                  pack2(ov[2] * rstd * gn[2] * siluf_(r2), ov[3] * rstd * gn[3] * siluf_(r3))};
        }
    }
    __syncthreads();
}

__device__ void phaseN1_task(const Params& p, int task, char* lds) {
    const int tid = TIDX, lane = tid & 63, wave = tid >> 6, r = lane & 15, q = lane >> 4;
    const int it = task & 7, g = (task >> 3) & 1, b = (task >> 4) & 7, kv = task >> 7;
    const bf16_t* Z = (const bf16_t*)(p.ws + OFF_Z);
    const bf16_t* W1 = (const bf16_t*)(p.ws + OFF_WC1) + (size_t)kv * 64 * 2048;
    const float* pe = kv ? p.pe_v : p.pe_k;
    const float* w2 = kv ? p.cv_w2 : p.ck_w2;
    const int zoff = (kv ? ZVC : ZKC) + g * 64;
    float* hid = (float*)lds;
    float* hid2 = (float*)(lds + 16384);
    int i = it * 16 + r; if (i > 126) i = 126;
    f32x4 acc[4];
#pragma unroll
    for (int nt = 0; nt < 4; nt++) acc[nt] = (f32x4){0.f, 0.f, 0.f, 0.f};
    for (int ks = 0; ks < 16; ks++) {
        const int k = wave * 512 + ks * 32 + q * 8;
        const int l = k >> 6, d = k & 63;
        const u32x4 zv = *(const u32x4*)(Z + (size_t)(b * SEQ + i * 16 + l) * ZC + zoff + d);
        const f32x4 p0 = *(const f32x4*)(pe + l * 64 + d), p1 = *(const f32x4*)(pe + l * 64 + d + 4);
        const u32x4 av = {pack2(bf_lo(zv.x) + p0[0], bf_hi(zv.x) + p0[1]), pack2(bf_lo(zv.y) + p0[2], bf_hi(zv.y) + p0[3]),
                          pack2(bf_lo(zv.z) + p1[0], bf_hi(zv.z) + p1[1]), pack2(bf_lo(zv.w) + p1[2], bf_hi(zv.w) + p1[3])};
        const bf16x8 a = __builtin_bit_cast(bf16x8, av);
#pragma unroll
        for (int nt = 0; nt < 4; nt++) {
            const bf16x8 bw = *(const bf16x8*)(W1 + (size_t)(nt * 16 + r) * 2048 + k);
            acc[nt] = mfma16(a, bw, acc[nt]);
        }
    }
#pragma unroll
    for (int nt = 0; nt < 4; nt++)
#pragma unroll
        for (int j = 0; j < 4; j++) hid[(wave * 16 + 4 * q + j) * 64 + nt * 16 + r] = acc[nt][j];
    __syncthreads();
    for (int e = tid; e < 1024; e += NTHREADS) hid2[e] = gelu_erf(hid[e] + hid[1024 + e] + hid[2048 + e] + hid[3072 + e]);
    __syncthreads();
    {
        const int il = tid >> 4, n2 = (tid & 15) * 4;
        f32x4 o = {0.f, 0.f, 0.f, 0.f};
        for (int n = 0; n < 64; n++) {
            const float hv = hid2[il * 64 + n];
            const f32x4 wv = *(const f32x4*)(w2 + n * 64 + n2);
            o += hv * wv;
        }
        const int ig = it * 16 + il;
        if (ig >= 127) o = (f32x4){0.f, 0.f, 0.f, 0.f};
        bf16_t* dst = (bf16_t*)(p.ws + OFF_CMP) + ((size_t)((kv * 8 + b) * 2 + g) * 128 + ig) * 64 + n2;
        *(u32x2*)dst = (u32x2){pack2(o[0], o[1]), pack2(o[2], o[3])};
    }
    __syncthreads();
}

__device__ __forceinline__ void nsa_load_kv(const bf16_t* __restrict__ kbase, const bf16_t* __restrict__ vbase, size_t rowstride, bf16_t* Ks, bf16_t* VT) {
    const int tid = TIDX;
    {
        const int key = tid >> 2, ch = (tid & 3) * 16;
        const u32x4 a = *(const u32x4*)(kbase + (size_t)key * rowstride + ch), b = *(const u32x4*)(kbase + (size_t)key * rowstride + ch + 8);
        *(u32x4*)(Ks + key * 72 + ch) = a;
        *(u32x4*)(Ks + key * 72 + ch + 8) = b;
    }
    {
        const int key = tid & 63, dc = (tid >> 6) * 16;
        const u32x4 a = *(const u32x4*)(vbase + (size_t)key * rowstride + dc), b = *(const u32x4*)(vbase + (size_t)key * rowstride + dc + 8);
        const unsigned w[8] = {a.x, a.y, a.z, a.w, b.x, b.y, b.z, b.w};
#pragma unroll
        for (int j = 0; j < 16; j++) VT[(dc + j) * 72 + key] = (bf16_t)((j & 1) ? (w[j >> 1] >> 16) : (w[j >> 1] & 0xffffu));
    }
}

__device__ __forceinline__ void nsa_block_step(const bf16_t* Ks, const bf16_t* VT, const bf16x8 (&qf)[2][2], f32x4 (&O)[2][4], float (&m)[2], float (&l)[2],
                                               unsigned vm, int r, int q) {
#pragma unroll
    for (int x = 0; x < 2; x++) {
        f32x4 s[4];
#pragma unroll
        for (int kt = 0; kt < 4; kt++) s[kt] = (f32x4){0.f, 0.f, 0.f, 0.f};
#pragma unroll
        for (int kt = 0; kt < 4; kt++)
#pragma unroll
            for (int ks = 0; ks < 2; ks++) s[kt] = mfma16(ld_frag(Ks + (kt * 16 + r) * 72 + ks * 32 + q * 8), qf[x][ks], s[kt]);
        __builtin_amdgcn_sched_barrier(0);
        float mx = -1e30f;
#pragma unroll
        for (int kt = 0; kt < 4; kt++)
#pragma unroll
            for (int j = 0; j < 4; j++) if ((vm >> (kt * 4 + j)) & 1u) mx = fmaxf(mx, s[kt][j]);
        mx = fmaxf(mx, __shfl_xor(mx, 16, 64));
        mx = fmaxf(mx, __shfl_xor(mx, 32, 64));
        const float mnew = fmaxf(m[x], mx);
        const float alpha = __expf(m[x] - mnew);
        m[x] = mnew;
        float ls = 0.f;
#pragma unroll
        for (int kt = 0; kt < 4; kt++)
#pragma unroll
            for (int j = 0; j < 4; j++) {
                const float pv = ((vm >> (kt * 4 + j)) & 1u) ? __expf(s[kt][j] - mnew) : 0.f;
                s[kt][j] = pv; ls += pv;
            }
        l[x] = l[x] * alpha + ls;
#pragma unroll
        for (int dt = 0; dt < 4; dt++) O[x][dt] *= alpha;
        __builtin_amdgcn_sched_barrier(0);
#pragma unroll
        for (int s2 = 0; s2 < 2; s2++) {
            const u32x4 t4 = {pack2(s[2 * s2][0], s[2 * s2][1]), pack2(s[2 * s2][2], s[2 * s2][3]),
                              pack2(s[2 * s2 + 1][0], s[2 * s2 + 1][1]), pack2(s[2 * s2 + 1][2], s[2 * s2 + 1][3])};
            const bf16x8 pbv = __builtin_bit_cast(bf16x8, t4);
#pragma unroll
            for (int dt = 0; dt < 4; dt++) {
                const u32x2 lo = *(const u32x2*)(VT + (dt * 16 + r) * 72 + (2 * s2) * 16 + 4 * q);
                const u32x2 hi = *(const u32x2*)(VT + (dt * 16 + r) * 72 + (2 * s2 + 1) * 16 + 4 * q);
                O[x][dt] = mfma16(mk_frag(lo, hi), pbv, O[x][dt]);
            }
        }
        __builtin_amdgcn_sched_barrier(0);
    }
}

__device__ __forceinline__ void nsa_cmp_probs(const bf16_t* Kc, const bf16x8 (&qfx)[2], int nv, int r, int q, f32x4 (&s)[8]) {
#pragma unroll
    for (int kt = 0; kt < 8; kt++) s[kt] = (f32x4){0.f, 0.f, 0.f, 0.f};
#pragma unroll
    for (int kt = 0; kt < 8; kt++)
#pragma unroll
        for (int ks = 0; ks < 2; ks++) s[kt] = mfma16(ld_frag(Kc + (kt * 16 + r) * 72 + ks * 32 + q * 8), qfx[ks], s[kt]);
    __builtin_amdgcn_sched_barrier(0);
    float mx = -1e30f;
#pragma unroll
    for (int kt = 0; kt < 8; kt++)
#pragma unroll
        for (int j = 0; j < 4; j++) if (kt * 16 + 4 * q + j < nv) mx = fmaxf(mx, s[kt][j]);
    mx = fmaxf(mx, __shfl_xor(mx, 16, 64));
    mx = fmaxf(mx, __shfl_xor(mx, 32, 64));
    float ls = 0.f;
#pragma unroll
    for (int kt = 0; kt < 8; kt++)
#pragma unroll
        for (int j = 0; j < 4; j++) {
            const float pv = (kt * 16 + 4 * q + j < nv) ? __expf(s[kt][j] - mx) : 0.f;
            s[kt][j] = pv; ls += pv;
        }
    ls += __shfl_xor(ls, 16, 64);
    ls += __shfl_xor(ls, 32, 64);
    const float inv = nv > 0 ? 1.f / ls : 0.f;
#pragma unroll
    for (int kt = 0; kt < 8; kt++) s[kt] *= inv;
}

__device__ void phaseN2_task(const Params& p, int task, char* lds, bf16_t* ydst, int ystride) {
    const int tid = TIDX, lane = tid & 63, wave = tid >> 6, r = lane & 15, q = lane >> 4;
    const int tt = 127 - (task >> 4), g = task & 1, b = (task >> 1) & 7;
    const int t0 = tt * 16, t = t0 + r;
    const int cur = t0 >> 6;
    bf16_t* Z = (bf16_t*)(p.ws + OFF_Z);
    const size_t rowb = (size_t)b * SEQ;
    bf16_t* Kc = (bf16_t*)lds;
    bf16_t* VcT = (bf16_t*)(lds + 18432);
    bf16_t* Ks = (bf16_t*)lds;
    bf16_t* VT = (bf16_t*)(lds + 18432);
    float* impw = (float*)(lds + 35840);
    float* scs = (float*)(lds + 35840 + 32768);
    unsigned* selm = (unsigned*)(lds + 35840 + 32768 + 2048);

    bf16x8 qf[2][2];
#pragma unroll
    for (int x = 0; x < 2; x++)
#pragma unroll
        for (int ks = 0; ks < 2; ks++) qf[x][ks] = *(const bf16x8*)(Z + (rowb + t) * ZC + ZQ_N + (g * 8 + 2 * wave + x) * 64 + ks * 32 + q * 8);
    f32x4* ofl = (f32x4*)(lds + 35840);

    {
        const bf16_t* kc = (const bf16_t*)(p.ws + OFF_CMP) + (size_t)((0 * 8 + b) * 2 + g) * 128 * 64;
        const bf16_t* vc = (const bf16_t*)(p.ws + OFF_CMP) + (size_t)((1 * 8 + b) * 2 + g) * 128 * 64;
        {
            const int key = tid >> 1, ch = (tid & 1) * 32;
#pragma unroll
            for (int v4 = 0; v4 < 4; v4++) *(u32x4*)(Kc + key * 72 + ch + v4 * 8) = *(const u32x4*)(kc + key * 64 + ch + v4 * 8);
            const int k2 = tid & 127, dc = (tid >> 7) * 32;
#pragma unroll
            for (int v4 = 0; v4 < 4; v4++) {
                const u32x4 a = *(const u32x4*)(vc + k2 * 64 + dc + v4 * 8);
                const unsigned w[4] = {a.x, a.y, a.z, a.w};
#pragma unroll
                for (int j = 0; j < 8; j++) VcT[(dc + v4 * 8 + j) * 136 + k2] = (bf16_t)((j & 1) ? (w[j >> 1] >> 16) : (w[j >> 1] & 0xffffu));
            }
        }
        __syncthreads();
        int nv = t >= 31 ? ((t - 31) >> 4) + 1 : 0;
        if (nv > 127) nv = 127;
        f32x4 isum[8];
#pragma unroll
        for (int kt = 0; kt < 8; kt++) isum[kt] = (f32x4){0.f, 0.f, 0.f, 0.f};
#pragma unroll
        for (int x = 0; x < 2; x++) {
            f32x4 s[8];
            nsa_cmp_probs(Kc, qf[x], nv, r, q, s);
#pragma unroll
            for (int kt = 0; kt < 8; kt++) isum[kt] += s[kt];
            __builtin_amdgcn_sched_barrier(0);
        }
#pragma unroll
        for (int kt = 0; kt < 8; kt++) *(f32x4*)(impw + (wave * 16 + r) * 128 + kt * 16 + 4 * q) = isum[kt];
        __syncthreads();
#pragma unroll
        for (int pass = 0; pass < 2; pass++) {
            const int tk = pass * 8 + (tid >> 5), j = tid & 31;
            const int i0 = j == 0 ? 0 : 4 * j - 1, i1 = (4 * j + 3 > 126) ? 126 : 4 * j + 3;
            float sc = 0.f;
            for (int i = i0; i <= i1; i++) sc += (impw[(0 * 16 + tk) * 128 + i] + impw[(1 * 16 + tk) * 128 + i]) + (impw[(2 * 16 + tk) * 128 + i] + impw[(3 * 16 + tk) * 128 + i]);
            const bool forced = (j == 0) || (j == cur) || (j == cur - 1);
            scs[tk * 32 + j] = forced ? 1e6f : (j <= cur ? sc : -1.f);
        }
        __syncthreads();
#pragma unroll
        for (int pass = 0; pass < 2; pass++) {
            const int tk = pass * 8 + (tid >> 5), j = tid & 31;
            const float mine = scs[tk * 32 + j];
            int rank = 0;
            for (int j2 = 0; j2 < 32; j2++) { const float o = scs[tk * 32 + j2]; rank += (o > mine || (o == mine && j2 < j)) ? 1 : 0; }
            const unsigned long long bal = __ballot(rank < 16);
            if ((lane & 31) == 0) selm[tk] = (unsigned)(lane ? (bal >> 32) : (bal & 0xffffffffull));
        }
        __syncthreads();
    }
    {
        int nv = t >= 31 ? ((t - 31) >> 4) + 1 : 0;
        if (nv > 127) nv = 127;
#pragma unroll
        for (int x = 0; x < 2; x++) {
            f32x4 s[8];
            nsa_cmp_probs(Kc, qf[x], nv, r, q, s);
            f32x4 Oc[4];
#pragma unroll
            for (int dt = 0; dt < 4; dt++) Oc[dt] = (f32x4){0.f, 0.f, 0.f, 0.f};
            __builtin_amdgcn_sched_barrier(0);
#pragma unroll
            for (int s2 = 0; s2 < 4; s2++) {
                const u32x4 t4 = {pack2(s[2 * s2][0], s[2 * s2][1]), pack2(s[2 * s2][2], s[2 * s2][3]),
                                  pack2(s[2 * s2 + 1][0], s[2 * s2 + 1][1]), pack2(s[2 * s2 + 1][2], s[2 * s2 + 1][3])};
                const bf16x8 pbv = __builtin_bit_cast(bf16x8, t4);
#pragma unroll
                for (int dt = 0; dt < 4; dt++) {
                    const u32x2 lo = *(const u32x2*)(VcT + (dt * 16 + r) * 136 + (2 * s2) * 16 + 4 * q);
                    const u32x2 hi = *(const u32x2*)(VcT + (dt * 16 + r) * 136 + (2 * s2 + 1) * 16 + 4 * q);
                    Oc[dt] = mfma16(mk_frag(lo, hi), pbv, Oc[dt]);
                }
            }
            const float g0 = sigmoidf_(bf2f(Z[(rowb + t) * ZC + ZGATE + 0 * 16 + g * 8 + 2 * wave + x]));
#pragma unroll
            for (int dt = 0; dt < 4; dt++) ofl[(wave * 8 + x * 4 + dt) * 64 + lane] = g0 * Oc[dt];
            __builtin_amdgcn_sched_barrier(0);
        }
    }
    const unsigned mysel = selm[r];
    unsigned uni = 0;
#pragma unroll
    for (int i = 0; i < 16; i++) uni |= selm[i];

    {
        f32x4 O[2][4];
        float m[2] = {-1e30f, -1e30f}, l[2] = {0.f, 0.f};
#pragma unroll
        for (int x = 0; x < 2; x++)
#pragma unroll
            for (int dt = 0; dt < 4; dt++) O[x][dt] = (f32x4){0.f, 0.f, 0.f, 0.f};
        for (int j = 0; j <= cur; j++) {
            if (!((uni >> j) & 1u)) continue;
            __syncthreads();
            nsa_load_kv(Z + (rowb + j * 64) * ZC + ZKS + g * 64, Z + (rowb + j * 64) * ZC + ZVS + g * 64, ZC, Ks, VT);
            __syncthreads();
            unsigned vm = 0;
            if ((mysel >> j) & 1u) {
#pragma unroll
                for (int kt = 0; kt < 4; kt++)
#pragma unroll
                    for (int jj = 0; jj < 4; jj++) if (j * 64 + kt * 16 + 4 * q + jj <= t) vm |= 1u << (kt * 4 + jj);
            }
            nsa_block_step(Ks, VT, qf, O, m, l, vm, r, q);
        }
#pragma unroll
        for (int x = 0; x < 2; x++) {
            float lt = l[x];
            lt += __shfl_xor(lt, 16, 64);
            lt += __shfl_xor(lt, 32, 64);
            const float sc = sigmoidf_(bf2f(Z[(rowb + t) * ZC + ZGATE + 1 * 16 + g * 8 + 2 * wave + x])) / lt;
#pragma unroll
            for (int dt = 0; dt < 4; dt++) ofl[(wave * 8 + x * 4 + dt) * 64 + lane] += sc * O[x][dt];
        }
    }
    {
        f32x4 O[2][4];
        float m[2] = {-1e30f, -1e30f}, l[2] = {0.f, 0.f};
#pragma unroll
        for (int x = 0; x < 2; x++)
#pragma unroll
            for (int dt = 0; dt < 4; dt++) O[x][dt] = (f32x4){0.f, 0.f, 0.f, 0.f};
        const int lo = t0 - 511;
        const int jb0 = lo > 0 ? (lo >> 6) : 0;
        for (int j = jb0; j <= cur; j++) {
            __syncthreads();
            nsa_load_kv(Z + (rowb + j * 64) * ZC + ZKW + g * 64, Z + (rowb + j * 64) * ZC + ZVW + g * 64, ZC, Ks, VT);
            __syncthreads();
            unsigned vm = 0;
#pragma unroll
            for (int kt = 0; kt < 4; kt++)
#pragma unroll
                for (int jj = 0; jj < 4; jj++) { const int kp = j * 64 + kt * 16 + 4 * q + jj; if (kp <= t && t - kp < 512) vm |= 1u << (kt * 4 + jj); }
            nsa_block_step(Ks, VT, qf, O, m, l, vm, r, q);
        }
#pragma unroll
        for (int x = 0; x < 2; x++) {
            float lt = l[x];
            lt += __shfl_xor(lt, 16, 64);
            lt += __shfl_xor(lt, 32, 64);
            const float sc = sigmoidf_(bf2f(Z[(rowb + t) * ZC + ZGATE + 2 * 16 + g * 8 + 2 * wave + x])) / lt;
#pragma unroll
            for (int dt = 0; dt < 4; dt++) O[x][dt] = ofl[(wave * 8 + x * 4 + dt) * 64 + lane] + sc * O[x][dt];
        }
#pragma unroll
        for (int x = 0; x < 2; x++)
#pragma unroll
            for (int dt = 0; dt < 4; dt++) {
                const f32x4 v = O[x][dt];
                *(u32x2*)(ydst + (rowb + t) * ystride + (g * 8 + 2 * wave + x) * 64 + dt * 16 + 4 * q) = (u32x2){pack2(v[0], v[1]), pack2(v[2], v[3])};
            }
    }
    __syncthreads();
}

__device__ void phaseM1(const Params& p, char* lds) {
    const int tid_ = TIDX; const int lane = tid_ & 63, wave = tid_ >> 6;
    const int wr = wave >> 1, wc = wave & 1, r = lane & 15, q = lane >> 4;
    const bf16_t* H = (const bf16_t*)(p.ws + OFF_H);
    const bf16_t* Z = (const bf16_t*)(p.ws + OFF_Z);
    bf16_t* M = (bf16_t*)(p.ws + OFF_M);
    bf16_t* SG = (bf16_t*)p.out;
    TileIter tit(8, lds);
    int bm, bn;
    while (tit.next(bm, bn)) {
        const int m0 = bm * 128, n0 = bn * 128;
        for (int br = 0; br < 2; br++) {
            f32x4 acc[4][4];
            zero_acc(acc);
            gemm_core(acc, H, DM, (const bf16_t*)(p.ws + OFF_WM) + (size_t)br * 1024 * 1024, DM, DM, m0, n0, lds);
            {
                const int e0 = launder_i((m0 + wr * 64 + r) * DM + n0 + wc * 64 + 4 * q);
#pragma unroll
                for (int mi = 0; mi < 4; mi++)
#pragma unroll
                    for (int ni = 0; ni < 4; ni++)
                        *(u32x2*)(SG + (size_t)(e0 + mi * 16 * DM + ni * 16)) = (u32x2){pack2(sigmoidf_(acc[mi][ni][0]), sigmoidf_(acc[mi][ni][1])),
                                                                                        pack2(sigmoidf_(acc[mi][ni][2]), sigmoidf_(acc[mi][ni][3]))};
            }
            zero_acc(acc);
            gemm_core(acc, Z + (br ? ZQ_N : ZR_G), ZC, (const bf16_t*)(p.ws + (br ? OFF_WB : OFF_WA)), DM, DM, m0, n0, lds);
            {
                const int e0 = launder_i((m0 + wr * 64 + r) * DM + n0 + wc * 64 + 4 * q);
#pragma unroll
                for (int mi = 0; mi < 4; mi++)
#pragma unroll
                    for (int ni = 0; ni < 4; ni++) {
                        const size_t eo = (size_t)(e0 + mi * 16 * DM + ni * 16);
                        const u32x2 sg = *(const u32x2*)(SG + eo);
                        float v[4] = {bf_lo(sg.x) * acc[mi][ni][0], bf_hi(sg.x) * acc[mi][ni][1], bf_lo(sg.y) * acc[mi][ni][2], bf_hi(sg.y) * acc[mi][ni][3]};
                        u32x2* dst = (u32x2*)(M + eo);
                        if (br) { const u32x2 pv = *dst; v[0] += bf_lo(pv.x); v[1] += bf_hi(pv.x); v[2] += bf_lo(pv.y); v[3] += bf_hi(pv.y); }
                        *dst = (u32x2){pack2(v[0], v[1]), pack2(v[2], v[3])};
                    }
            }
        }
    }
}

__device__ void phaseM2(const Params& p, char* lds) {
    const int tid_ = TIDX; const int lane = tid_ & 63, wave = tid_ >> 6;
    const int wr = wave >> 1, wc = wave & 1, r = lane & 15, q = lane >> 4;
    const bf16_t* M = (const bf16_t*)(p.ws + OFF_M);
    const float* mod = (const float*)(p.ws + OFF_MOD);
    TileIter tit(8, lds);
    int bm, bn;
    while (tit.next(bm, bn)) {
        const int m0 = bm * 128, n0 = bn * 128;
        f32x4 acc[4][4];
        zero_acc(acc);
        gemm_core(acc, M, DM, (const bf16_t*)(p.ws + OFF_WO), DM, DM, m0, n0, lds);
#pragma unroll
        for (int mi = 0; mi < 4; mi++)
#pragma unroll
            for (int ni = 0; ni < 4; ni++) {
                const int tok = m0 + wr * 64 + mi * 16 + r, col = n0 + wc * 64 + ni * 16 + 4 * q;
                const f32x4 xv = *(const f32x4*)(p.x + (size_t)tok * DM + col);
                const f32x4 gt = *(const f32x4*)(mod + (tok >> 11) * 6144 + 2 * 1024 + col);
                *(f32x4*)(p.out + (size_t)tok * DM + col) = xv + gt * acc[mi][ni];
            }
    }
    {
        const int tid_ = TIDX; const int lane = tid_ & 63, wave = tid_ >> 6;
        unsigned char* tq = (unsigned char*)(p.ws + OFF_UB);
        float* tsc = (float*)(p.ws + OFF_UB + 33554432);
        for (int row = blockIdx.x * 4 + wave; row < 32768; row += gridDim.x * 4) {
            const bool isv = row >= 16384;
            const float* srcp = (isv ? p.peer_v : p.peer_u) + (size_t)(row & 16383) * DM + lane * 16;
            f32x4 a[4];
            float mx = 0.f;
#pragma unroll
            for (int i = 0; i < 4; i++) {
                a[i] = *(const f32x4*)(srcp + i * 4);
                mx = fmaxf(mx, fmaxf(fmaxf(fabsf(a[i][0]), fabsf(a[i][1])), fmaxf(fabsf(a[i][2]), fabsf(a[i][3]))));
            }
            mx = wave_max(mx);
            const float inv = mx > 0.f ? 127.f / mx : 0.f;
            const int off = isv ? 128 : 0;
            unsigned w[4];
#pragma unroll
            for (int i = 0; i < 4; i++) {
                unsigned pk = 0;
#pragma unroll
                for (int j = 0; j < 4; j++) {
                    int qi = (int)rintf(a[i][j] * inv);
                    qi = qi > 127 ? 127 : (qi < -127 ? -127 : qi);
                    pk |= ((unsigned)(qi + off) & 0xffu) << (8 * j);
                }
                w[i] = pk;
            }
            *(u32x4*)(tq + (size_t)row * DM + lane * 16) = (u32x4){w[0], w[1], w[2], w[3]};
            if (lane == 0) tsc[row] = mx * (1.f / 127.f);
        }
    }
}

__device__ void phaseP1(const Params& p, char* lds) {
    const int tid_ = TIDX; const int lane = tid_ & 63, wave = tid_ >> 6;
    const int wr = wave >> 1, wc = wave & 1, r = lane & 15, q = lane >> 4;
    const bf16_t* H = (const bf16_t*)(p.ws + OFF_H);
    bf16_t* QP = (bf16_t*)(p.ws + OFF_QP);
    TileIter tit(16, lds);
    int bm, bn;
    while (tit.next(bm, bn)) {
        const int m0 = bm * 128, n0 = bn * 128;
        f32x4 acc[4][4];
        zero_acc(acc);
        gemm_core(acc, H, DM, (const bf16_t*)(p.ws + OFF_WQ), DM, DM, m0, n0, lds);
#pragma unroll
        for (int mi = 0; mi < 4; mi++)
#pragma unroll
            for (int ni = 0; ni < 4; ni++) {
                const int tok = m0 + wr * 64 + mi * 16 + r, col = n0 + wc * 64 + ni * 16 + 4 * q;
                const f32x4 v = acc[mi][ni];
                *(u32x2*)(QP + (size_t)tok * 2048 + col) = (u32x2){pack2(v[0], v[1]), pack2(v[2], v[3])};
            }
    }
}

__constant__ unsigned char c_cand_a[64] = {0,0,0,0,0,0,0,0,0,0,0,0,0,0,0,0, 1,1,1,1,1,1,1,1, 2,2,2,2,2, 3,3,3,3, 4,4,4, 5,5, 6,6, 7,7, 8,9,10,11,12,13,14,15, 0,0,0,0,0,0,0,0,0,0,0,0,0,0};
__constant__ unsigned char c_cand_b[64] = {0,1,2,3,4,5,6,7,8,9,10,11,12,13,14,15, 0,1,2,3,4,5,6,7, 0,1,2,3,4, 0,1,2,3, 0,1,2, 0,1, 0,1, 0,1, 0,0,0,0,0,0,0,0, 0,0,0,0,0,0,0,0,0,0,0,0,0,0};

__device__ __forceinline__ unsigned f2key(float f) { const unsigned u = __float_as_uint(f); return (u & 0x80000000u) ? ~u : (u | 0x80000000u); }
__device__ __forceinline__ float key2f(unsigned k) { const unsigned u = (k & 0x80000000u) ? (k & 0x7fffffffu) : ~k; return __uint_as_float(u); }
__device__ __forceinline__ void ins16(unsigned (&L)[16], unsigned v) {
#pragma unroll
    for (int k = 0; k < 16; k++) { const unsigned hi = L[k] > v ? L[k] : v; v = L[k] > v ? v : L[k]; L[k] = hi; }
}

__device__ void phaseP2_task(const Params& p, int task, char* lds) {
    const int tid = TIDX, lane = tid & 63, wave = tid >> 6, r = lane & 15, q = lane >> 4;
    const int h = task & 7, tile = task >> 3;
    const int tok0 = tile * 64;
    const bf16_t* QP = (const bf16_t*)(p.ws + OFF_QP);
    float* S = (float*)lds;
    unsigned* LL = (unsigned*)(lds + 65536);
#pragma unroll
    for (int half = 0; half < 2; half++) {
        const bf16_t* KB = (const bf16_t*)(p.ws + OFF_K1B) + (size_t)half * 131072 + (size_t)h * 128 * 128;
        f32x4 acc[8];
#pragma unroll
        for (int nt = 0; nt < 8; nt++) acc[nt] = (f32x4){0.f, 0.f, 0.f, 0.f};
#pragma unroll
        for (int ks = 0; ks < 4; ks++) {
            const bf16x8 bq = *(const bf16x8*)(QP + (size_t)(tok0 + wave * 16 + r) * 2048 + h * 256 + half * 128 + ks * 32 + q * 8);
#pragma unroll
            for (int nt = 0; nt < 8; nt++) {
                const bf16x8 ak = *(const bf16x8*)(KB + (size_t)(nt * 16 + r) * 128 + ks * 32 + q * 8);
                acc[nt] = mfma16(ak, bq, acc[nt]);
            }
        }
#pragma unroll
        for (int nt = 0; nt < 8; nt++)
#pragma unroll
            for (int j = 0; j < 4; j++) S[(half * 128 + nt * 16 + 4 * q + j) * 64 + wave * 16 + r] = acc[nt][j];
    }
    __syncthreads();
    if (tid < 128) {
        const int half = tid >> 6, tk = tid & 63;
        unsigned L[16];
#pragma unroll
        for (int k = 0; k < 16; k++) L[k] = 0u;
        const float* sp = S + half * 128 * 64 + tk;
        for (int k = 0; k < 128; k++) ins16(L, (f2key(sp[k * 64]) & ~127u) | (unsigned)(127 - k));
#pragma unroll
        for (int k = 0; k < 16; k++) LL[(half * 16 + k) * 64 + tk] = L[k];
    }
    __syncthreads();
    if (tid < 64) {
        const int tk = tid;
        float v1[16], v2[16];
#pragma unroll
        for (int k = 0; k < 16; k++) { v1[k] = key2f(LL[k * 64 + tk] & ~127u); v2[k] = key2f(LL[(16 + k) * 64 + tk] & ~127u); }
        unsigned T[16];
#pragma unroll
        for (int k = 0; k < 16; k++) T[k] = 0u;
        int c = 0;
#pragma unroll
        for (int a = 0; a < 16; a++)
#pragma unroll
            for (int b = 0; b < 16; b++)
                if ((a + 1) * (b + 1) <= 16) { ins16(T, (f2key(v1[a] + v2[b]) & ~63u) | (unsigned)(63 - c)); c++; }
        const float mx = key2f(T[0] & ~63u);
        float e[16], sum = 0.f;
#pragma unroll
        for (int k = 0; k < 16; k++) { e[k] = __expf(key2f(T[k] & ~63u) - mx); sum += e[k]; }
        const float inv = 1.f / sum;
        int ei[16];
#pragma unroll
        for (int k = 0; k < 16; k++) {
            const int cc = 63 - (int)(T[k] & 63u);
            const int a = c_cand_a[cc], b = c_cand_b[cc];
            const int i1 = 127 - (int)(LL[a * 64 + tk] & 127u), i2 = 127 - (int)(LL[(16 + b) * 64 + tk] & 127u);
            ei[k] = i1 * 128 + i2;
            e[k] *= inv;
        }
        int* eidx = (int*)(p.ws + OFF_EIDX) + (size_t)(tok0 + tk) * 128 + h * 16;
        float* gw = (float*)(p.ws + OFF_GW) + (size_t)(tok0 + tk) * 128 + h * 16;
#pragma unroll
        for (int k4 = 0; k4 < 4; k4++) {
            *(u32x4*)(eidx + k4 * 4) = (u32x4){(unsigned)ei[k4 * 4], (unsigned)ei[k4 * 4 + 1], (unsigned)ei[k4 * 4 + 2], (unsigned)ei[k4 * 4 + 3]};
            *(f32x4*)(gw + k4 * 4) = (f32x4){e[k4 * 4], e[k4 * 4 + 1], e[k4 * 4 + 2], e[k4 * 4 + 3]};
        }
    }
    __syncthreads();
}

__device__ __forceinline__ float ub0(unsigned w) { return (float)(w & 0xffu); }
__device__ __forceinline__ float ub1(unsigned w) { return (float)((w >> 8) & 0xffu); }
__device__ __forceinline__ float ub2(unsigned w) { return (float)((w >> 16) & 0xffu); }
__device__ __forceinline__ float ub3(unsigned w) { return (float)(w >> 24); }
__device__ void phaseP3(const Params& p, float* dstp) {
    const int tid_ = TIDX; const int lane = tid_ & 63, wave = tid_ >> 6;
    const bf16_t* H = (const bf16_t*)(p.ws + OFF_H);
    const unsigned char* UQ = (const unsigned char*)(p.ws + OFF_UB);
    const unsigned char* VQ = UQ + 16777216;
    const float* tsc = (const float*)(p.ws + OFF_UB + 33554432);
    const int* eidx = (const int*)(p.ws + OFF_EIDX);
    const float* gwp = (const float*)(p.ws + OFF_GW);
    const float* mod = (const float*)(p.ws + OFF_MOD);
    const int ul = ((lane & 1) << 2) | (lane & 2) | ((lane >> 2) & 1);
    for (int tok = blockIdx.x * 4 + wave; tok < NTOK; tok += gridDim.x * 4) {
        int qh[4];
        float sh;
        {
            const u32x4 a = *(const u32x4*)(H + (size_t)tok * DM + lane * 16), b = *(const u32x4*)(H + (size_t)tok * DM + lane * 16 + 8);
            const unsigned hw[8] = {a.x, a.y, a.z, a.w, b.x, b.y, b.z, b.w};
            float hv[16];
            float mx = 0.f;
#pragma unroll
            for (int i = 0; i < 8; i++) { hv[2 * i] = bf_lo(hw[i]); hv[2 * i + 1] = bf_hi(hw[i]); mx = fmaxf(mx, fmaxf(fabsf(hv[2 * i]), fabsf(hv[2 * i + 1]))); }
            mx = wave_max(mx);
            const float inv = mx > 0.f ? 127.f / mx : 0.f;
            sh = mx * (1.f / 127.f);
#pragma unroll
            for (int i = 0; i < 4; i++) {
                unsigned pk = 0;
#pragma unroll
                for (int j = 0; j < 4; j++) pk |= ((unsigned)((int)rintf(hv[i * 4 + j] * inv)) & 0xffu) << (8 * j);
                qh[i] = (int)pk;
            }
        }
        const int e0 = eidx[(size_t)tok * 128 + lane], e1 = eidx[(size_t)tok * 128 + 64 + lane];
        const float g0 = gwp[(size_t)tok * 128 + lane], g1 = gwp[(size_t)tok * 128 + 64 + lane];
        float acc[16];
#pragma unroll
        for (int i = 0; i < 16; i++) acc[i] = 0.f;
        float wsum = 0.f;
        for (int jb = 0; jb < 128; jb += 8) {
            u32x4 ur[8], vr[8];
#pragma unroll
            for (int u = 0; u < 8; u++) {
                const int j = jb + u;
                const int e = (jb < 64) ? __shfl(e0, j, 64) : __shfl(e1, j - 64, 64);
                ur[u] = *(const u32x4*)(UQ + (size_t)e * DM + lane * 16);
                vr[u] = *(const u32x4*)(VQ + (size_t)e * DM + lane * 16);
            }
            const int jm = jb + ul;
            const int em = (jb < 64) ? __shfl(e0, jm, 64) : __shfl(e1, jm - 64, 64);
            const float gm = (jb < 64) ? __shfl(g0, jm, 64) : __shfl(g1, jm - 64, 64);
            const float su = tsc[em], sv = tsc[16384 + em];
            int pt[8];
#pragma unroll
            for (int u = 0; u < 8; u++) {
                int d = __builtin_amdgcn_sdot4((int)ur[u].x, qh[0], 0, false);
                d = __builtin_amdgcn_sdot4((int)ur[u].y, qh[1], d, false);
                d = __builtin_amdgcn_sdot4((int)ur[u].z, qh[2], d, false);
                d = __builtin_amdgcn_sdot4((int)ur[u].w, qh[3], d, false);
                pt[u] = d;
            }
            int m4[4], m2[2], m1;
            {
                const bool b0 = lane & 1;
#pragma unroll
                for (int j = 0; j < 4; j++) { const int keep = b0 ? pt[j + 4] : pt[j], send = b0 ? pt[j] : pt[j + 4]; m4[j] = keep + __shfl_xor(send, 1, 64); }
                const bool b1 = lane & 2;
#pragma unroll
                for (int j = 0; j < 2; j++) { const int keep = b1 ? m4[j + 2] : m4[j], send = b1 ? m4[j] : m4[j + 2]; m2[j] = keep + __shfl_xor(send, 2, 64); }
                const bool b2 = lane & 4;
                { const int keep = b2 ? m2[1] : m2[0], send = b2 ? m2[0] : m2[1]; m1 = keep + __shfl_xor(send, 4, 64); }
                m1 += __shfl_xor(m1, 8, 64);
                m1 += __shfl_xor(m1, 16, 64);
                m1 += __shfl_xor(m1, 32, 64);
            }
            const float aval = (float)m1 * (sh * su);
            const float ws = gm * gelu_erf(aval) * sv;
#pragma unroll
            for (int u = 0; u < 8; u++) {
                const int src_lane = ((u >> 2) & 1) | (u & 2) | ((u & 1) << 2);
                const float wu = __shfl(ws, src_lane, 64);
                wsum += wu;
                const unsigned vw[4] = {vr[u].x, vr[u].y, vr[u].z, vr[u].w};
#pragma unroll
                for (int i = 0; i < 4; i++) {
                    acc[i * 4 + 0] += wu * ub0(vw[i]); acc[i * 4 + 1] += wu * ub1(vw[i]);
                    acc[i * 4 + 2] += wu * ub2(vw[i]); acc[i * 4 + 3] += wu * ub3(vw[i]);
                }
            }
        }
        const int b = tok >> 11;
        float x2[16];
        float ss = 0.f;
#pragma unroll
        for (int i = 0; i < 4; i++) {
            const int d = lane * 16 + i * 4;
            const f32x4 xv = *(const f32x4*)(p.out + (size_t)tok * DM + d);
            const f32x4 gt = *(const f32x4*)(mod + b * 6144 + 5 * 1024 + d);
#pragma unroll
            for (int j = 0; j < 4; j++) { const float v = xv[j] + gt[j] * (acc[i * 4 + j] - 128.f * wsum); x2[i * 4 + j] = v; ss += v * v; }
        }
        ss = wave_sum(ss);
        const float rstd = rsqrtf(ss * (1.f / 1024.f) + 1e-6f);
#pragma unroll
        for (int i = 0; i < 4; i++) {
            const int d = lane * 16 + i * 4;
            const f32x4 fg = *(const f32x4*)(p.final_g + d);
            f32x4 o;
#pragma unroll
            for (int j = 0; j < 4; j++) o[j] = x2[i * 4 + j] * rstd * fg[j];
            *(f32x4*)(dstp + (size_t)tok * DM + d) = o;
        }
    }
}

#define XB_TMO      128
#define XB_XCNT(j)  (256  + 64 * (j))
#define XB_XSUB(j)  (1280 + 64 * (j))
#define XB_XGEN(j)  (2304 + 64 * (j))
#define XB_TOP      3328
#define XB_TOPGEN   3392
#define XCD_BAR_WORDS 3456
#define XB_SPIN_CAP (1u << 22)
#define LAS __attribute__((address_space(3)))
__device__ __forceinline__ unsigned xb_ld(unsigned* p)              { return __hip_atomic_load(p, __ATOMIC_RELAXED, __HIP_MEMORY_SCOPE_AGENT); }
__device__ __forceinline__ unsigned xb_add(unsigned* p, unsigned v) { return __hip_atomic_fetch_add(p, v, __ATOMIC_RELAXED, __HIP_MEMORY_SCOPE_AGENT); }
__device__ __forceinline__ unsigned xb_xcc_id() { return (unsigned)__builtin_amdgcn_s_getreg((3 << 11) | 20) & 0xFu; }
#define XB_SPIN(cond, bar) do { unsigned _sp = 0; while (cond) { __builtin_amdgcn_s_sleep(1); \
    if ((++_sp & 255u) == 0u) { if (xb_ld(&(bar)[XB_TMO])) break; if (_sp > XB_SPIN_CAP) { atomicAdd(&(bar)[XB_TMO], 1u); break; } } } } while (0)
struct XcdBarrier { unsigned* bar; unsigned x; volatile LAS unsigned* st; };
__device__ __forceinline__ XcdBarrier xcd_barrier_post(unsigned* bar, volatile LAS unsigned* st) {
    XcdBarrier b; b.bar = bar; b.x = xb_xcc_id(); b.st = st;
    if (threadIdx.x == 0) { st[2] = xb_add(&bar[XB_XCNT(b.x)], 1u); st[4] = b.x; }
    return b;
}
__device__ __forceinline__ void xcd_barrier_complete(unsigned* bar, unsigned x, unsigned& nloc, unsigned& nx, unsigned& bal) {
    const unsigned G = gridDim.x * gridDim.y * gridDim.z;
    unsigned sum, cnt, mine, c64, sp = 0u;
    for (;;) {
        sum = 0u; cnt = 0u; mine = 0u; c64 = 0u;
#pragma unroll
        for (unsigned j = 0; j < 16; ++j) { const unsigned c = xb_ld(&bar[XB_XCNT(j)]); sum += c; cnt += (c > 0u) ? 1u : 0u; c64 += (j < 8 && c == 64u) ? 1u : 0u; mine = (j == x) ? c : mine; }
        if (sum == G) break;
        __builtin_amdgcn_s_sleep(1);
        if ((++sp & 255u) == 0u) { if (xb_ld(&bar[XB_TMO])) break; if (sp > XB_SPIN_CAP) { atomicAdd(&bar[XB_TMO], 1u); break; } }
    }
    nloc = mine > 0u ? mine : 1u; nx = cnt > 0u ? cnt : 1u; bal = (sum == G && cnt == 8u && c64 == 8u) ? 1u : 0u;
}
__device__ __forceinline__ void xcd_barrier(const XcdBarrier& b) {
    asm volatile("s_waitcnt vmcnt(0)" ::: "memory");
    __syncthreads();
    if (threadIdx.x == 0) {
        unsigned* bar = b.bar;
        __builtin_amdgcn_s_waitcnt(0);
        unsigned nloc = b.st[0], nx = b.st[1];
        if (nloc == 0u) { unsigned bal; xcd_barrier_complete(bar, b.x, nloc, nx, bal); b.st[0] = nloc; b.st[1] = nx; b.st[3] = bal; }
        const unsigned old = xb_add(&bar[XB_XSUB(b.x)], 1u);
        const unsigned gen = old / nloc;
        if (old + 1u == (gen + 1u) * nloc) {
            __builtin_amdgcn_fence(__ATOMIC_RELEASE, "agent");
            asm volatile("s_waitcnt vmcnt(0)" ::: "memory");
            const unsigned og = xb_add(&bar[XB_TOP], 1u);
            const unsigned tg = og / nx;
            if (og + 1u == (tg + 1u) * nx) xb_add(&bar[XB_TOPGEN], 1u);
            else XB_SPIN(xb_ld(&bar[XB_TOPGEN]) == tg, bar);
            __builtin_amdgcn_fence(__ATOMIC_ACQUIRE, "agent");
            xb_add(&bar[XB_XGEN(b.x)], 1u);
            asm volatile("s_waitcnt vmcnt(0)" ::: "memory");
        } else {
            XB_SPIN(xb_ld(&bar[XB_XGEN(b.x)]) == gen, bar);
            __builtin_amdgcn_fence(__ATOMIC_ACQUIRE, "agent");
            asm volatile("s_waitcnt vmcnt(0)" ::: "memory");
        }
    }
    __syncthreads();
}

typedef __attribute__((address_space(4))) const Params* KParamsPtr;
__device__ __forceinline__ const Params& fresh_params() {
    KParamsPtr kp = (KParamsPtr)__builtin_amdgcn_kernarg_segment_ptr();
    asm volatile("" : "+s"(kp));
    return *(const Params*)kp;
}
#define PF fresh_params()
__global__ void __launch_bounds__(NTHREADS, 2) mega(Params p_unused) {
    __shared__ __attribute__((aligned(16))) char lds[LDS_BYTES];
    cg::grid_group grid = cg::this_grid();
    volatile LAS unsigned* st = (volatile LAS unsigned*)(lds + LDS_MAIN);
    if (threadIdx.x < 8) st[threadIdx.x] = 0u;
    __syncthreads();
    XcdBarrier xb = xcd_barrier_post((unsigned*)PF.ws, st);

    phaseA(PF, lds);
    if (PF.ws == nullptr) grid.sync();
    xcd_barrier(xb);
    { const Params& q_ = PF; phase_modnorm(q_, q_.x, q_.norm1_g, 0, 1, (bf16_t*)(q_.ws + OFF_H)); };
    xcd_barrier(xb);
    phaseC(PF, lds);
    xcd_barrier(xb);
    for (int task = blockIdx.x; task < 1024; task += gridDim.x) phaseG1_task(PF, task, lds);
    for (int task = blockIdx.x; task < 256; task += gridDim.x) phaseN1_task(PF, task, lds);
    xcd_barrier(xb);
    phaseG2(PF);
    xcd_barrier(xb);
    for (int task = blockIdx.x; task < 2048; task += gridDim.x) phaseN2_task(PF, task, lds, (bf16_t*)(PF.ws + OFF_Z) + ZQ_N, ZC);
    for (int task = blockIdx.x; task < 1024; task += gridDim.x) phaseG3_task(PF, task, lds, (bf16_t*)(PF.ws + OFF_Z) + ZR_G, ZC);
    xcd_barrier(xb);
    phaseM1(PF, lds);
    xcd_barrier(xb);
    phaseM2(PF, lds);
    xcd_barrier(xb);
    { const Params& q_ = PF; phase_modnorm(q_, q_.out, q_.norm2_g, 3, 4, (bf16_t*)(q_.ws + OFF_H)); };
    xcd_barrier(xb);
    phaseP1(PF, lds);
    xcd_barrier(xb);
    for (int task = blockIdx.x; task < 2048; task += gridDim.x) phaseP2_task(PF, task, lds);
    xcd_barrier(xb);
    { const Params& q_ = PF; phaseP3(q_, q_.out); };
}

extern "C" void kernel_launch(void* const* d_in, const int* in_sizes, int n_in, void* d_out, int out_size, void* d_ws, size_t ws_size, hipStream_t stream) {
    Params p{};
    p.x = (const float*)d_in[0]; p.c = (const float*)d_in[1]; p.pos = (const int*)d_in[2]; p.ada_w = (const float*)d_in[3]; p.ada_b = (const float*)d_in[4];
    p.norm1_g = (const float*)d_in[5]; p.norm2_g = (const float*)d_in[6]; p.final_g = (const float*)d_in[7]; p.w_in = (const float*)d_in[8];
    p.gla_wa2 = (const float*)d_in[9]; p.gla_ba2 = (const float*)d_in[10]; p.gla_norm_g = (const float*)d_in[11]; p.pe_k = (const float*)d_in[12]; p.pe_v = (const float*)d_in[13];
    p.ck_w1 = (const float*)d_in[14]; p.ck_w2 = (const float*)d_in[15]; p.cv_w1 = (const float*)d_in[16]; p.cv_w2 = (const float*)d_in[17];
    p.w_branch_a = (const float*)d_in[18]; p.w_branch_b = (const float*)d_in[19]; p.w_out = (const float*)d_in[20]; p.peer_wq = (const float*)d_in[21];
    p.peer_k1 = (const float*)d_in[22]; p.peer_k2 = (const float*)d_in[23]; p.peer_u = (const float*)d_in[24]; p.peer_v = (const float*)d_in[25];
    p.out = (float*)d_out; p.ws = (char*)d_ws;
    static int grid_blocks = 0;
    if (!grid_blocks) {
        int dev = 0, cus = 0, per_cu = 0;
        hipGetDevice(&dev);
        hipDeviceGetAttribute(&cus, hipDeviceAttributeMultiprocessorCount, dev);
        hipOccupancyMaxActiveBlocksPerMultiprocessor(&per_cu, mega, NTHREADS, 0);
        if (per_cu > 2) per_cu = 2;
        if (per_cu < 1) per_cu = 1;
        grid_blocks = cus * per_cu;
    }
    hipMemsetAsync(d_ws, 0, XCD_BAR_WORDS * 4, stream);
    void* args[] = {&p};
    hipError_t e = hipLaunchCooperativeKernel((void*)mega, dim3(grid_blocks), dim3(NTHREADS), args, 0, stream);
    if (e != hipSuccess) fprintf(stderr, "cooperative launch failed: %s (grid %d)\n", hipGetErrorString(e), grid_blocks);
}
```

```cpp
#include <hip/hip_runtime.h>
#include <hip/hip_cooperative_groups.h>
#include <stdio.h>
namespace cg = cooperative_groups;
#include <stdint.h>
#include <stddef.h>
#include <math.h>

typedef unsigned short bf16_t;
typedef short bf16x8 __attribute__((ext_vector_type(8)));
typedef float f32x4 __attribute__((ext_vector_type(4)));
typedef unsigned u32x4 __attribute__((ext_vector_type(4)));
typedef unsigned u32x2 __attribute__((ext_vector_type(2)));

constexpr int DM = 1024, NB = 8, SEQ = 2048, NTOK = NB * SEQ;
constexpr int ZC = 4992;
constexpr int ZQ_G = 0, ZK_G = 512, ZV_G = 1024, ZR_G = 2048, ZQ_N = 3072, ZKC = 4096, ZVC = 4224, ZKS = 4352, ZVS = 4480,
              ZKW = 4608, ZVW = 4736, ZGATE = 4864, ZLR = 4912;
constexpr int LDS_MAIN = 73728;
constexpr int LDS_BYTES = LDS_MAIN + 64;
constexpr int NTHREADS = 256;

constexpr size_t OFF_MOD = 16384;
constexpr size_t OFF_ROPE = 212992;
constexpr size_t OFF_CMP = 1261568;
constexpr size_t OFF_DEC = 1785856;
constexpr size_t OFF_K1B = 2310144;
constexpr size_t OFF_WC1 = 2834432;
constexpr size_t OFF_WIN = 4194304;
constexpr size_t OFF_WM = 14417920;
constexpr size_t OFF_WA = 18612224;
constexpr size_t OFF_WB = 20709376;
constexpr size_t OFF_WO = 22806528;
constexpr size_t OFF_WQ = 24903680;
constexpr size_t OFF_H = 29360128;
constexpr size_t OFF_M = 62914560;
constexpr size_t OFF_Z = 96468992;
constexpr size_t OFF_QP = OFF_Z;
constexpr size_t OFF_UB = OFF_Z + 67108864;
constexpr size_t OFF_VB = OFF_UB + 33554432;
constexpr size_t OFF_EIDX = OFF_VB + 33554432;
constexpr size_t OFF_GW = OFF_EIDX + 8388608;

struct Params {
    const float* x; const float* c; const int* pos; const float* ada_w; const float* ada_b;
    const float* norm1_g; const float* norm2_g; const float* final_g; const float* w_in;
    const float* gla_wa2; const float* gla_ba2; const float* gla_norm_g; const float* pe_k; const float* pe_v;
    const float* ck_w1; const float* ck_w2; const float* cv_w1; const float* cv_w2;
    const float* w_branch_a; const float* w_branch_b; const float* w_out; const float* peer_wq;
    const float* peer_k1; const float* peer_k2; const float* peer_u; const float* peer_v;
    float* out; char* ws;
};

__device__ __forceinline__ unsigned f2bf_u(float f) { unsigned u = __float_as_uint(f); return (u + 0x7fffu + ((u >> 16) & 1u)) >> 16; }
__device__ __forceinline__ bf16_t f2bf(float f) { return (bf16_t)f2bf_u(f); }
typedef float f32x2_ __attribute__((ext_vector_type(2)));
typedef __bf16 bf16x2_ __attribute__((ext_vector_type(2)));
__device__ __forceinline__ unsigned pack2(float lo, float hi) {
    const f32x2_ v = {lo, hi};
    return __builtin_bit_cast(unsigned, __builtin_convertvector(v, bf16x2_));
}
__device__ __forceinline__ float bf_lo(unsigned u) { return __uint_as_float(u << 16); }
__device__ __forceinline__ float bf_hi(unsigned u) { return __uint_as_float(u & 0xffff0000u); }
__device__ __forceinline__ float bf2f(bf16_t h) { return __uint_as_float(((unsigned)h) << 16); }
__device__ __forceinline__ float wave_sum(float v) {
#pragma unroll
    for (int o = 32; o > 0; o >>= 1) v += __shfl_xor(v, o, 64);
    return v;
}
__device__ __forceinline__ float wave_max(float v) {
#pragma unroll
    for (int o = 32; o > 0; o >>= 1) v = fmaxf(v, __shfl_xor(v, o, 64));
    return v;
}
__device__ __forceinline__ int launder_i(int x) { asm volatile("" : "+v"(x)); return x; }
#define TIDX launder_i((int)threadIdx.x)
__device__ __forceinline__ float sigmoidf_(float x) { return __builtin_amdgcn_rcpf(1.f + __expf(-x)); }
__device__ __forceinline__ float siluf_(float x) { return x * __builtin_amdgcn_rcpf(1.f + __expf(-x)); }
__device__ __forceinline__ float gelu_erf(float x) { return 0.5f * x * (1.f + erff(x * 0.70710678118654752f)); }
__device__ __forceinline__ f32x4 mfma16(bf16x8 a, bf16x8 b, f32x4 c) { return __builtin_amdgcn_mfma_f32_16x16x32_bf16(a, b, c, 0, 0, 0); }
__device__ __forceinline__ bf16x8 ld_frag(const bf16_t* p) { return *(const bf16x8*)p; }
__device__ __forceinline__ bf16x8 mk_frag(u32x2 lo, u32x2 hi) { u32x4 t = {lo.x, lo.y, hi.x, hi.y}; return __builtin_bit_cast(bf16x8, t); }

#define WAIT_V(n) asm volatile("s_waitcnt vmcnt(" #n ")" ::: "memory")
__device__ __forceinline__ int swz4(int R) { return (4 - ((R >> 2) & 3)) & 3; }
__device__ __forceinline__ void glds16(const bf16_t* g, char* l) { __builtin_amdgcn_global_load_lds((const unsigned*)g, (unsigned*)l, 16, 0, 0); }
__device__ __forceinline__ void gemm_core(f32x4 (&acc)[4][4], const bf16_t* __restrict__ X, int ldx, const bf16_t* __restrict__ W, int ldw,
                                          int K, int m0, int n0, char* lds) {
    const int tid = TIDX, lane = tid & 63, wave = tid >> 6;
    const int wr = wave >> 1, wc = wave & 1, r = lane & 15, q = lane >> 4;
    const int KT = K / 32;
    const bf16_t* xsrc[2];
    const bf16_t* wsrc[2];
#pragma unroll
    for (int i = 0; i < 2; i++) {
        const int R = (wave * 2 + i) * 16 + (lane >> 2);
        xsrc[i] = X + (size_t)(m0 + R) * ldx + (((lane & 3) ^ swz4(R)) * 8);
        wsrc[i] = W + (size_t)(n0 + R) * ldw + (((lane & 3) ^ swz4(R)) * 8);
    }
    char* xdst = lds + wave * 2048 + lane * 16;
    char* wdst = lds + 8192 + wave * 2048 + lane * 16;
#define GEMM_ISSUE(kt_, s_) do { \
        _Pragma("unroll") for (int i_ = 0; i_ < 2; i_++) { glds16(xsrc[i_] + (kt_) * 32, xdst + (s_) * 16384 + i_ * 1024); \
                                                           glds16(wsrc[i_] + (kt_) * 32, wdst + (s_) * 16384 + i_ * 1024); } } while (0)
    GEMM_ISSUE(0, 0);
    GEMM_ISSUE(1, 1);
    GEMM_ISSUE(2, 2);
    const int rdo = r * 64 + ((q ^ swz4(r)) * 16);
    for (int kt = 0; kt < KT; kt++) {
        if (kt + 2 < KT) WAIT_V(8); else if (kt + 1 < KT) WAIT_V(4); else WAIT_V(0);
        __builtin_amdgcn_s_barrier();
        if (kt + 3 < KT) GEMM_ISSUE(kt + 3, (kt + 3) & 3);
        const char* st = lds + (kt & 3) * 16384;
        bf16x8 af[4], bfr[4];
#pragma unroll
        for (int ni = 0; ni < 4; ni++) af[ni] = *(const bf16x8*)(st + 8192 + (wc * 64 + ni * 16) * 64 + rdo);
#pragma unroll
        for (int mi = 0; mi < 4; mi++) bfr[mi] = *(const bf16x8*)(st + (wr * 64 + mi * 16) * 64 + rdo);
#pragma unroll
        for (int mi = 0; mi < 4; mi++)
#pragma unroll
            for (int ni = 0; ni < 4; ni++) acc[mi][ni] = mfma16(af[ni], bfr[mi], acc[mi][ni]);
    }
    __syncthreads();
}
__device__ __forceinline__ void zero_acc(f32x4 (&acc)[4][4]) {
#pragma unroll
    for (int a = 0; a < 4; a++)
#pragma unroll
        for (int b = 0; b < 4; b++) acc[a][b] = (f32x4){0.f, 0.f, 0.f, 0.f};
}

struct TileIter {
    int nt, ng, rounds, i, x, li; bool fancy;
    __device__ TileIter(int ntiles_n, const char* lds) {
        const volatile unsigned* w = (const volatile unsigned*)(lds + LDS_MAIN);
        nt = ntiles_n; li = (int)w[2]; fancy = (w[3] == 1u) && (gridDim.x == 512) && (li < 64); x = (int)w[4];
        ng = (nt + 7) >> 3; rounds = 2 * ng; i = fancy ? 0 : blockIdx.x;
    }
    __device__ bool next(int& bm, int& bn) {
        if (fancy) {
            while (i < rounds) { const int mh = i / ng, g = i - mh * ng; const int n = g * 8 + (li >> 3); i++; if (n < nt) { bm = x * 16 + mh * 8 + (li & 7); bn = n; return true; } }
            return false;
        }
        if (i >= 128 * nt) return false;
        bn = i % nt; bm = i / nt; i += gridDim.x; return true;
    }
};

struct MapId { __device__ int operator()(int n) const { return n; } };
struct MapWin {
    __device__ int operator()(int n) const { return n < 3072 ? n : (n < 4912 ? n + 16 : (n < 4928 ? n - 1840 : -1)); }
};
struct MapOff { int off; __device__ int operator()(int n) const { return n + off; } };

template <class Map>
__device__ __forceinline__ void tconv_tile(const float* __restrict__ src, int ldsrc, bf16_t* __restrict__ dst, int ldd, int n0, int k0, Map map, float* t) {
    const int tid = TIDX;
    const int n = tid & 63, kb = tid >> 6;
    const int sc = map(n0 + n);
#pragma unroll
    for (int i = 0; i < 16; i++) { const int k = i * 4 + kb; t[k * 65 + n] = sc >= 0 ? src[(size_t)(k0 + k) * ldsrc + sc] : 0.f; }
    __syncthreads();
    const int nn = tid >> 2, kk = (tid & 3) * 16;
    unsigned w[8];
#pragma unroll
    for (int j = 0; j < 8; j++) w[j] = pack2(t[(kk + 2 * j) * 65 + nn], t[(kk + 2 * j + 1) * 65 + nn]);
    u32x4* d = (u32x4*)(dst + (size_t)(n0 + nn) * ldd + k0 + kk);
    d[0] = (u32x4){w[0], w[1], w[2], w[3]};
    d[1] = (u32x4){w[4], w[5], w[6], w[7]};
    __syncthreads();
}

constexpr int TA_MOD = 192, TA_WIN = 78 * 16, TA_WM = 32 * 16, TA_SQ = 16 * 16, TA_WQ = 32 * 16, TA_WC = 32, TA_K12 = 64, TA_ROPE = 512;
constexpr int TA_E0 = TA_MOD, TA_E1 = TA_E0 + TA_WIN, TA_E2 = TA_E1 + TA_WM, TA_E3 = TA_E2 + TA_SQ, TA_E4 = TA_E3 + TA_SQ, TA_E5 = TA_E4 + TA_SQ,
              TA_E6 = TA_E5 + TA_WQ, TA_E7 = TA_E6 + TA_WC, TA_E8 = TA_E7 + TA_WC, TA_E9 = TA_E8 + TA_K12, TA_E10 = TA_E9 + TA_K12, TA_E11 = TA_E10 + TA_ROPE;

__device__ void phaseA(const Params& p, char* lds) {
    const int tid = TIDX;
    float* fl = (float*)lds;
    for (int task = blockIdx.x; task < TA_E11; task += gridDim.x) {
        if (task < TA_E0) {
            float* sc = fl;
            float* red = fl + 8192;
            for (int i = tid; i < 8192; i += NTHREADS) sc[i] = siluf_(p.c[i]);
            __syncthreads();
            const int n = task * 32 + (tid & 31), kg = tid >> 5;
            float a[8];
#pragma unroll
            for (int b = 0; b < 8; b++) a[b] = 0.f;
            for (int k = kg * 128; k < kg * 128 + 128; k++) {
                const float w = p.ada_w[(size_t)k * 6144 + n];
#pragma unroll
                for (int b = 0; b < 8; b++) a[b] += sc[b * 1024 + k] * w;
            }
#pragma unroll
            for (int b = 0; b < 8; b++) red[(kg * 8 + b) * 32 + (tid & 31)] = a[b];
            __syncthreads();
            {
                const int b = tid >> 5, nn = tid & 31;
                float s = 0.f;
#pragma unroll
                for (int g = 0; g < 8; g++) s += red[(g * 8 + b) * 32 + nn];
                ((float*)(p.ws + OFF_MOD))[b * 6144 + task * 32 + nn] = s + p.ada_b[task * 32 + nn];
            }
            __syncthreads();
        } else if (task < TA_E1) {
            const int tt = task - TA_E0;
            tconv_tile(p.w_in, 6976, (bf16_t*)(p.ws + OFF_WIN), 1024, (tt >> 4) * 64, (tt & 15) * 64, MapWin(), fl);
        } else if (task < TA_E2) {
            const int tt = task - TA_E1;
            tconv_tile(p.w_in, 6976, (bf16_t*)(p.ws + OFF_WM), 1024, (tt >> 4) * 64, (tt & 15) * 64, MapOff{4928}, fl);
        } else if (task < TA_E3) {
            const int tt = task - TA_E2;
            tconv_tile(p.w_branch_a, 1024, (bf16_t*)(p.ws + OFF_WA), 1024, (tt >> 4) * 64, (tt & 15) * 64, MapId(), fl);
        } else if (task < TA_E4) {
            const int tt = task - TA_E3;
            tconv_tile(p.w_branch_b, 1024, (bf16_t*)(p.ws + OFF_WB), 1024, (tt >> 4) * 64, (tt & 15) * 64, MapId(), fl);
        } else if (task < TA_E5) {
            const int tt = task - TA_E4;
            tconv_tile(p.w_out, 1024, (bf16_t*)(p.ws + OFF_WO), 1024, (tt >> 4) * 64, (tt & 15) * 64, MapId(), fl);
        } else if (task < TA_E6) {
            const int tt = task - TA_E5;
            tconv_tile(p.peer_wq, 2048, (bf16_t*)(p.ws + OFF_WQ), 1024, (tt >> 4) * 64, (tt & 15) * 64, MapId(), fl);
        } else if (task < TA_E7) {
            const int tt = task - TA_E6;
            tconv_tile(p.ck_w1, 64, (bf16_t*)(p.ws + OFF_WC1), 2048, 0, tt * 64, MapId(), fl);
        } else if (task < TA_E8) {
            const int tt = task - TA_E7;
            tconv_tile(p.cv_w1, 64, (bf16_t*)(p.ws + OFF_WC1) + 64 * 2048, 2048, 0, tt * 64, MapId(), fl);
        } else if (task < TA_E10) {
            const bool second = task >= TA_E9;
            const int tt = task - (second ? TA_E9 : TA_E8);
            const float* src = second ? p.peer_k2 : p.peer_k1;
            bf16_t* dst = (bf16_t*)(p.ws + OFF_K1B) + (second ? 131072 : 0);
            const int i = tt * 2048 + tid * 8;
            const f32x4 a = *(const f32x4*)(src + i), b = *(const f32x4*)(src + i + 4);
            *(u32x4*)(dst + i) = (u32x4){pack2(a[0], a[1]), pack2(a[2], a[3]), pack2(b[0], b[1]), pack2(b[2], b[3])};
        } else {
            const int tt = task - TA_E10;
            const int e = tt * 256 + tid;
            const int tok = e >> 3, i = e & 7;
            const float invf[8] = {1.0f, 0.1939227432012558f, 0.03760603070259094f, 0.007292664609849453f,
                                   0.0014142135623842478f, 0.00027424818836152554f, 5.318296098266728e-05f, 1.0313386155758053e-05f};
            float fr = invf[0];
#pragma unroll
            for (int j = 1; j < 8; j++) fr = (i == j) ? invf[j] : fr;
            const float ang = (float)p.pos[tok] * fr;
            const double rev = (double)ang * 0.15915494309189533577;
            const float fpart = (float)(rev - floor(rev));
            float* cs = (float*)(p.ws + OFF_ROPE);
            cs[e * 2] = __builtin_amdgcn_cosf(fpart);
            cs[e * 2 + 1] = __builtin_amdgcn_sinf(fpart);
        }
    }
}

__device__ void phase_modnorm(const Params& p, const float* __restrict__ src, const float* __restrict__ g, int shift_idx, int scale_idx, bf16_t* __restrict__ dst) {
    const int tid_ = TIDX; const int lane = tid_ & 63, wave = tid_ >> 6;
    const float* mod = (const float*)(p.ws + OFF_MOD);
    for (int tok = blockIdx.x * 4 + wave; tok < NTOK; tok += gridDim.x * 4) {
        const int b = tok >> 11;
        const float* xr = src + (size_t)tok * DM;
        f32x4 v[4];
        float ss = 0.f;
#pragma unroll
        for (int c = 0; c < 4; c++) { v[c] = *(const f32x4*)(xr + c * 256 + lane * 4); ss += v[c][0] * v[c][0] + v[c][1] * v[c][1] + v[c][2] * v[c][2] + v[c][3] * v[c][3]; }
        ss = wave_sum(ss);
        const float rstd = rsqrtf(ss * (1.f / 1024.f) + 1e-6f);
#pragma unroll
        for (int c = 0; c < 4; c++) {
            const int d = c * 256 + lane * 4;
            const f32x4 gg = *(const f32x4*)(g + d);
            const f32x4 sc = *(const f32x4*)(mod + b * 6144 + scale_idx * 1024 + d);
            const f32x4 sh = *(const f32x4*)(mod + b * 6144 + shift_idx * 1024 + d);
            float o[4];
#pragma unroll
            for (int j = 0; j < 4; j++) o[j] = (v[c][j] * rstd) * gg[j] * (1.f + sc[j]) + sh[j];
            *(u32x2*)(dst + (size_t)tok * DM + d) = (u32x2){pack2(o[0], o[1]), pack2(o[2], o[3])};
        }
    }
}

__device__ void phaseC(const Params& p, char* lds) {
    const int tid_ = TIDX; const int lane = tid_ & 63, wave = tid_ >> 6;
    const int wr = wave >> 1, wc = wave & 1, r = lane & 15, q = lane >> 4;
    const bf16_t* H = (const bf16_t*)(p.ws + OFF_H);
    const bf16_t* W = (const bf16_t*)(p.ws + OFF_WIN);
    bf16_t* Z = (bf16_t*)(p.ws + OFF_Z);
    const float* cs = (const float*)(p.ws + OFF_ROPE);
    constexpr int NTN = ZC / 128;
    TileIter tit(NTN, lds);
    int bm, bn;
    while (tit.next(bm, bn)) {
        const int m0 = bm * 128, n0 = bn * 128;
        f32x4 acc[4][4];
        zero_acc(acc);
        gemm_core(acc, H, DM, W, DM, DM, m0, n0, lds);
        const bool rope = (bn >= 24 && bn <= 31) || bn == 32 || bn == 34 || bn == 36;
        const float scl = (bn >= 24 && bn <= 31) ? 0.125f : 1.f;
#pragma unroll
        for (int mi = 0; mi < 4; mi++) {
            const int tok = m0 + wr * 64 + mi * 16 + r;
            if (rope) {
                f32x4 v = acc[mi][0];
                f32x4 pr;
#pragma unroll
                for (int j = 0; j < 4; j++) pr[j] = __shfl_xor(v[j], 32, 64);
                const int ib = (q & 1) * 4;
                const f32x4 c0 = *(const f32x4*)(cs + (size_t)tok * 16 + ib * 2);
                const f32x4 c1 = *(const f32x4*)(cs + (size_t)tok * 16 + ib * 2 + 4);
                const float cc[4] = {c0[0], c0[2], c1[0], c1[2]}, sn[4] = {c0[1], c0[3], c1[1], c1[3]};
#pragma unroll
                for (int j = 0; j < 4; j++) v[j] = (q < 2) ? (v[j] * cc[j] - pr[j] * sn[j]) : (v[j] * cc[j] + pr[j] * sn[j]);
                acc[mi][0] = v;
            }
#pragma unroll
            for (int ni = 0; ni < 4; ni++) {
                const f32x4 v = acc[mi][ni] * scl;
                *(u32x2*)(Z + (size_t)tok * ZC + n0 + wc * 64 + ni * 16 + q * 4) = (u32x2){pack2(v[0], v[1]), pack2(v[2], v[3])};
            }
        }
    }
}

__device__ __forceinline__ void gla_prep(const Params& p, int tok0, int h, char* lds) {
    const int tid = TIDX;
    float* bc = (float*)lds;
    float* lrs = (float*)(lds + 32768);
    const bf16_t* Z = (const bf16_t*)(p.ws + OFF_Z);
    for (int i = tid; i < 1024; i += NTHREADS) { const int t = i >> 4, rr = i & 15; lrs[i] = bf2f(Z[(size_t)(tok0 + t) * ZC + ZLR + rr]); }
    const int d = tid & 127, th = tid >> 7;
    float w[16];
#pragma unroll
    for (int rr = 0; rr < 16; rr++) w[rr] = p.gla_wa2[rr * 512 + h * 128 + d];
    const float bias = p.gla_ba2[h * 128 + d];
    __syncthreads();
    float run = 0.f;
    for (int t = th * 32; t < th * 32 + 32; t++) {
        float xv = bias;
#pragma unroll
        for (int rr = 0; rr < 16; rr++) xv += lrs[t * 16 + rr] * w[rr];
        const float ls = fminf(xv, 0.f) - log1pf(__expf(-fabsf(xv)));
        run += ls * (1.f / 16.f);
        bc[t * 128 + d] = run;
    }
    __syncthreads();
    if (th == 1) {
        const float add = bc[31 * 128 + d];
        for (int t = 32; t < 64; t++) bc[t * 128 + d] += add;
    }
    __syncthreads();
}

__device__ void phaseG1_task(const Params& p, int task, char* lds) {
    const int tid = TIDX, lane = tid & 63, wave = tid >> 6, r = lane & 15, q = lane >> 4;
    const int c = task & 31, h = (task >> 5) & 3, b = task >> 7;
    const int tok0 = b * SEQ + c * 64;
    const bf16_t* Z = (const bf16_t*)(p.ws + OFF_Z);
    bf16_t* L = (bf16_t*)p.out;
    float* bc = (float*)lds;
    bf16_t* klT = (bf16_t*)(lds + 36864);
    bf16_t* vT = (bf16_t*)(lds + 36864 + 18432);
    gla_prep(p, tok0, h, lds);
    if (tid < 128) ((float*)(p.ws + OFF_DEC))[task * 128 + tid] = __expf(bc[63 * 128 + tid]);
    {
        const int s = lane, dc = wave * 32;
        const bf16_t* kp = Z + (size_t)(tok0 + s) * ZC + ZK_G + h * 128 + dc;
#pragma unroll
        for (int v4 = 0; v4 < 4; v4++) {
            const u32x4 kv = *(const u32x4*)(kp + v4 * 8);
            const unsigned kw[4] = {kv.x, kv.y, kv.z, kv.w};
#pragma unroll
            for (int j = 0; j < 8; j++) {
                const int d = dc + v4 * 8 + j;
                const float kval = (j & 1) ? bf_hi(kw[j >> 1]) : bf_lo(kw[j >> 1]);
                klT[d * 72 + s] = f2bf(kval * __expf(bc[63 * 128 + d] - bc[s * 128 + d]));
            }
        }
    }
    for (int eh = 0; eh < 2; eh++) {
        __syncthreads();
        {
            const int s = lane, ec = wave * 32;
            const bf16_t* vp = Z + (size_t)(tok0 + s) * ZC + ZV_G + h * 256 + eh * 128 + ec;
#pragma unroll
            for (int v4 = 0; v4 < 4; v4++) {
                const u32x4 vv = *(const u32x4*)(vp + v4 * 8);
                const unsigned vw[4] = {vv.x, vv.y, vv.z, vv.w};
#pragma unroll
                for (int j = 0; j < 8; j++) vT[(ec + v4 * 8 + j) * 72 + s] = (bf16_t)((j & 1) ? (vw[j >> 1] >> 16) : (vw[j >> 1] & 0xffffu));
            }
        }
        __syncthreads();
        f32x4 acc[8][2];
#pragma unroll
        for (int dt = 0; dt < 8; dt++) { acc[dt][0] = (f32x4){0.f, 0.f, 0.f, 0.f}; acc[dt][1] = (f32x4){0.f, 0.f, 0.f, 0.f}; }
#pragma unroll
        for (int ks = 0; ks < 2; ks++) {
            bf16x8 bv[2];
#pragma unroll
            for (int x = 0; x < 2; x++) bv[x] = ld_frag(vT + ((2 * wave + x) * 16 + r) * 72 + ks * 32 + q * 8);
#pragma unroll
            for (int dt = 0; dt < 8; dt++) {
                const bf16x8 a = ld_frag(klT + (dt * 16 + r) * 72 + ks * 32 + q * 8);
#pragma unroll
                for (int x = 0; x < 2; x++) acc[dt][x] = mfma16(a, bv[x], acc[dt][x]);
            }
        }
#pragma unroll
        for (int dt = 0; dt < 8; dt++)
#pragma unroll
            for (int x = 0; x < 2; x++) {
                const int e = eh * 128 + (2 * wave + x) * 16 + r, d = dt * 16 + 4 * q;
                const f32x4 v = acc[dt][x];
                *(u32x2*)(L + ((size_t)task * 256 + e) * 128 + d) = (u32x2){pack2(v[0], v[1]), pack2(v[2], v[3])};
            }
    }
    __syncthreads();
}

__device__ void phaseG2(const Params& p) {
    bf16_t* L = (bf16_t*)p.out;
    const float* dec = (const float*)(p.ws + OFF_DEC);
    for (int idx = blockIdx.x * NTHREADS + threadIdx.x; idx < 32 * 256 * 16; idx += gridDim.x * NTHREADS) {
        const int d8 = idx & 15, e = (idx >> 4) & 255, bh = idx >> 12;
        float st[8];
#pragma unroll
        for (int j = 0; j < 8; j++) st[j] = 0.f;
        for (int c = 0; c < 32; c++) {
            const int task = bh * 32 + c;
            u32x4* ptr = (u32x4*)(L + ((size_t)task * 256 + e) * 128 + d8 * 8);
            const u32x4 lv = *ptr;
            const f32x4 d0 = *(const f32x4*)(dec + task * 128 + d8 * 8), d1 = *(const f32x4*)(dec + task * 128 + d8 * 8 + 4);
            *ptr = (u32x4){pack2(st[0], st[1]), pack2(st[2], st[3]), pack2(st[4], st[5]), pack2(st[6], st[7])};
            st[0] = d0[0] * st[0] + bf_lo(lv.x); st[1] = d0[1] * st[1] + bf_hi(lv.x);
            st[2] = d0[2] * st[2] + bf_lo(lv.y); st[3] = d0[3] * st[3] + bf_hi(lv.y);
            st[4] = d1[0] * st[4] + bf_lo(lv.z); st[5] = d1[1] * st[5] + bf_hi(lv.z);
            st[6] = d1[2] * st[6] + bf_lo(lv.w); st[7] = d1[3] * st[7] + bf_hi(lv.w);
        }
    }
}

__device__ void phaseG3_task(const Params& p, int task, char* lds, bf16_t* ydst, int ystride) {
    const int tid = TIDX, lane = tid & 63, wave = tid >> 6, r = lane & 15, q = lane >> 4;
    const int c = task & 31, h = (task >> 5) & 3, b = task >> 7;
    const int tok0 = b * SEQ + c * 64;
    bf16_t* Z = (bf16_t*)(p.ws + OFF_Z);
    const bf16_t* ST = (const bf16_t*)p.out + (size_t)task * 256 * 128;
    float* bc = (float*)lds;
    bf16_t* vT = (bf16_t*)lds;
    bf16_t* qg = (bf16_t*)(lds + 36864);
    bf16_t* kg = (bf16_t*)(lds + 36864 + 17408);
    bf16_t* P = kg;
    float* red = (float*)(lds + 36864 + 2 * 17408);
    gla_prep(p, tok0, h, lds);
    {
        const int t = tid >> 2, dc = (tid & 3) * 32;
        const bf16_t* qp = Z + (size_t)(tok0 + t) * ZC + ZQ_G + h * 128 + dc;
        const bf16_t* kp = Z + (size_t)(tok0 + t) * ZC + ZK_G + h * 128 + dc;
#pragma unroll
        for (int v4 = 0; v4 < 4; v4++) {
            const u32x4 qv = *(const u32x4*)(qp + v4 * 8), kv = *(const u32x4*)(kp + v4 * 8);
            const unsigned qw[4] = {qv.x, qv.y, qv.z, qv.w}, kw[4] = {kv.x, kv.y, kv.z, kv.w};
            unsigned qo[4], ko[4];
#pragma unroll
            for (int j2 = 0; j2 < 4; j2++) {
                const int d = dc + v4 * 8 + j2 * 2;
                const float b0 = bc[t * 128 + d], b1 = bc[t * 128 + d + 1];
                qo[j2] = pack2(bf_lo(qw[j2]) * 0.08838834764831845f * __expf(b0), bf_hi(qw[j2]) * 0.08838834764831845f * __expf(b1));
                ko[j2] = pack2(bf_lo(kw[j2]) * __expf(-b0), bf_hi(kw[j2]) * __expf(-b1));
            }
            *(u32x4*)(qg + t * 136 + dc + v4 * 8) = (u32x4){qo[0], qo[1], qo[2], qo[3]};
            *(u32x4*)(kg + t * 136 + dc + v4 * 8) = (u32x4){ko[0], ko[1], ko[2], ko[3]};
        }
    }
    __syncthreads();
    {
        const int s = lane, ec = wave * 64;
        const bf16_t* vp = Z + (size_t)(tok0 + s) * ZC + ZV_G + h * 256 + ec;
#pragma unroll
        for (int v4 = 0; v4 < 8; v4++) {
            const u32x4 vv = *(const u32x4*)(vp + v4 * 8);
            const unsigned vw[4] = {vv.x, vv.y, vv.z, vv.w};
#pragma unroll
            for (int j = 0; j < 8; j++) vT[(ec + v4 * 8 + j) * 72 + s] = (bf16_t)((j & 1) ? (vw[j >> 1] >> 16) : (vw[j >> 1] & 0xffffu));
        }
    }
    f32x4 sc[4];
#pragma unroll
    for (int st = 0; st < 4; st++) sc[st] = (f32x4){0.f, 0.f, 0.f, 0.f};
    {
        bf16x8 qf[4];
#pragma unroll
        for (int ks = 0; ks < 4; ks++) qf[ks] = ld_frag(qg + (wave * 16 + r) * 136 + ks * 32 + q * 8);
#pragma unroll
        for (int st = 0; st < 4; st++) {
            if (st <= wave) {
#pragma unroll
                for (int ks = 0; ks < 4; ks++) sc[st] = mfma16(ld_frag(kg + (st * 16 + r) * 136 + ks * 32 + q * 8), qf[ks], sc[st]);
            }
        }
    }
    __syncthreads();
    {
        const int t = wave * 16 + r;
#pragma unroll
        for (int st = 0; st < 4; st++) {
            float pv[4];
#pragma unroll
            for (int j = 0; j < 4; j++) { const int s = st * 16 + 4 * q + j; pv[j] = (s <= t) ? sc[st][j] : 0.f; }
            *(u32x2*)(P + t * 72 + st * 16 + 4 * q) = (u32x2){pack2(pv[0], pv[1]), pack2(pv[2], pv[3])};
        }
    }
    __syncthreads();
    f32x4 o[4][4];
#pragma unroll
    for (int et = 0; et < 4; et++)
#pragma unroll
        for (int tt = 0; tt < 4; tt++) o[et][tt] = (f32x4){0.f, 0.f, 0.f, 0.f};
#pragma unroll
    for (int ks = 0; ks < 2; ks++) {
        bf16x8 pf[4];
#pragma unroll
        for (int tt = 0; tt < 4; tt++) pf[tt] = ld_frag(P + (tt * 16 + r) * 72 + ks * 32 + q * 8);
#pragma unroll
        for (int et = 0; et < 4; et++) {
            const bf16x8 a = ld_frag(vT + ((wave * 4 + et) * 16 + r) * 72 + ks * 32 + q * 8);
#pragma unroll
            for (int tt = 0; tt < 4; tt++) o[et][tt] = mfma16(a, pf[tt], o[et][tt]);
        }
    }
#pragma unroll
    for (int ks = 0; ks < 4; ks++) {
        bf16x8 qf[4];
#pragma unroll
        for (int tt = 0; tt < 4; tt++) qf[tt] = ld_frag(qg + (tt * 16 + r) * 136 + ks * 32 + q * 8);
#pragma unroll
        for (int et = 0; et < 4; et++) {
            const bf16x8 a = *(const bf16x8*)(ST + (size_t)((wave * 4 + et) * 16 + r) * 128 + ks * 32 + q * 8);
#pragma unroll
            for (int tt = 0; tt < 4; tt++) o[et][tt] = mfma16(a, qf[tt], o[et][tt]);
        }
    }
#pragma unroll
    for (int tt = 0; tt < 4; tt++) {
        float ss = 0.f;
#pragma unroll
        for (int et = 0; et < 4; et++)
#pragma unroll
            for (int j = 0; j < 4; j++) ss += o[et][tt][j] * o[et][tt][j];
        ss += __shfl_xor(ss, 16, 64);
        ss += __shfl_xor(ss, 32, 64);
        if (q == 0) red[wave * 64 + tt * 16 + r] = ss;
    }
    __syncthreads();
#pragma unroll
    for (int tt = 0; tt < 4; tt++) {
        const int t = tt * 16 + r;
        const float tot = red[t] + red[64 + t] + red[128 + t] + red[192 + t];
        const float rstd = rsqrtf(tot * (1.f / 256.f) + 1e-6f);
#pragma unroll
        for (int et = 0; et < 4; et++) {
            const int e = (wave * 4 + et) * 16 + 4 * q;
            bf16_t* rp = Z + (size_t)(tok0 + t) * ZC + ZR_G + h * 256 + e;
            const u32x2 rv = *(const u32x2*)rp;
            const f32x4 gn = *(const f32x4*)(p.gla_norm_g + e);
            const float r0 = bf_lo(rv.x), r1 = bf_hi(rv.x), r2 = bf_lo(rv.y), r3 = bf_hi(rv.y);
            const f32x4 ov = o[et][tt];
            *(u32x2*)(ydst + (size_t)(tok0 + t) * ystride + h * 256 + e) = (u32x2){pack2(ov[0] * rstd * gn[0] * siluf_(r0), ov[1] * rstd * gn[1] * siluf_(r1)),
                                  pack2(ov[2] * rstd * gn[2] * siluf_(r2), ov[3] * rstd * gn[3] * siluf_(r3))};
        }
    }
    __syncthreads();
}

__device__ void phaseN1_task(const Params& p, int task, char* lds) {
    const int tid = TIDX, lane = tid & 63, wave = tid >> 6, r = lane & 15, q = lane >> 4;
    const int it = task & 7, g = (task >> 3) & 1, b = (task >> 4) & 7, kv = task >> 7;
    const bf16_t* Z = (const bf16_t*)(p.ws + OFF_Z);
    const bf16_t* W1 = (const bf16_t*)(p.ws + OFF_WC1) + (size_t)kv * 64 * 2048;
    const float* pe = kv ? p.pe_v : p.pe_k;
    const float* w2 = kv ? p.cv_w2 : p.ck_w2;
    const int zoff = (kv ? ZVC : ZKC) + g * 64;
    float* hid = (float*)lds;
    float* hid2 = (float*)(lds + 16384);
    int i = it * 16 + r; if (i > 126) i = 126;
    f32x4 acc[4];
#pragma unroll
    for (int nt = 0; nt < 4; nt++) acc[nt] = (f32x4){0.f, 0.f, 0.f, 0.f};
    for (int ks = 0; ks < 16; ks++) {
        const int k = wave * 512 + ks * 32 + q * 8;
        const int l = k >> 6, d = k & 63;
        const u32x4 zv = *(const u32x4*)(Z + (size_t)(b * SEQ + i * 16 + l) * ZC + zoff + d);
        const f32x4 p0 = *(const f32x4*)(pe + l * 64 + d), p1 = *(const f32x4*)(pe + l * 64 + d + 4);
        const u32x4 av = {pack2(bf_lo(zv.x) + p0[0], bf_hi(zv.x) + p0[1]), pack2(bf_lo(zv.y) + p0[2], bf_hi(zv.y) + p0[3]),
                          pack2(bf_lo(zv.z) + p1[0], bf_hi(zv.z) + p1[1]), pack2(bf_lo(zv.w) + p1[2], bf_hi(zv.w) + p1[3])};
        const bf16x8 a = __builtin_bit_cast(bf16x8, av);
#pragma unroll
        for (int nt = 0; nt < 4; nt++) {
            const bf16x8 bw = *(const bf16x8*)(W1 + (size_t)(nt * 16 + r) * 2048 + k);
            acc[nt] = mfma16(a, bw, acc[nt]);
        }
    }
#pragma unroll
    for (int nt = 0; nt < 4; nt++)
#pragma unroll
        for (int j = 0; j < 4; j++) hid[(wave * 16 + 4 * q + j) * 64 + nt * 16 + r] = acc[nt][j];
    __syncthreads();
    for (int e = tid; e < 1024; e += NTHREADS) hid2[e] = gelu_erf(hid[e] + hid[1024 + e] + hid[2048 + e] + hid[3072 + e]);
    __syncthreads();
    {
        const int il = tid >> 4, n2 = (tid & 15) * 4;
        f32x4 o = {0.f, 0.f, 0.f, 0.f};
        for (int n = 0; n < 64; n++) {
            const float hv = hid2[il * 64 + n];
            const f32x4 wv = *(const f32x4*)(w2 + n * 64 + n2);
            o += hv * wv;
        }
        const int ig = it * 16 + il;
        if (ig >= 127) o = (f32x4){0.f, 0.f, 0.f, 0.f};
        bf16_t* dst = (bf16_t*)(p.ws + OFF_CMP) + ((size_t)((kv * 8 + b) * 2 + g) * 128 + ig) * 64 + n2;
        *(u32x2*)dst = (u32x2){pack2(o[0], o[1]), pack2(o[2], o[3])};
    }
    __syncthreads();
}

__device__ __forceinline__ void nsa_load_kv(const bf16_t* __restrict__ kbase, const bf16_t* __restrict__ vbase, size_t rowstride, bf16_t* Ks, bf16_t* VT) {
    const int tid = TIDX;
    {
        const int key = tid >> 2, ch = (tid & 3) * 16;
        const u32x4 a = *(const u32x4*)(kbase + (size_t)key * rowstride + ch), b = *(const u32x4*)(kbase + (size_t)key * rowstride + ch + 8);
        *(u32x4*)(Ks + key * 72 + ch) = a;
        *(u32x4*)(Ks + key * 72 + ch + 8) = b;
    }
    {
        const int key = tid & 63, dc = (tid >> 6) * 16;
        const u32x4 a = *(const u32x4*)(vbase + (size_t)key * rowstride + dc), b = *(const u32x4*)(vbase + (size_t)key * rowstride + dc + 8);
        const unsigned w[8] = {a.x, a.y, a.z, a.w, b.x, b.y, b.z, b.w};
#pragma unroll
        for (int j = 0; j < 16; j++) VT[(dc + j) * 72 + key] = (bf16_t)((j & 1) ? (w[j >> 1] >> 16) : (w[j >> 1] & 0xffffu));
    }
}

__device__ __forceinline__ void nsa_block_step(const bf16_t* Ks, const bf16_t* VT, const bf16x8 (&qf)[2][2], f32x4 (&O)[2][4], float (&m)[2], float (&l)[2],
                                               unsigned vm, int r, int q) {
    f32x4 s[2][4];
#pragma unroll
    for (int x = 0; x < 2; x++)
#pragma unroll
        for (int kt = 0; kt < 4; kt++) s[x][kt] = (f32x4){0.f, 0.f, 0.f, 0.f};
#pragma unroll
    for (int kt = 0; kt < 4; kt++)
#pragma unroll
        for (int ks = 0; ks < 2; ks++) {
            const bf16x8 kf = ld_frag(Ks + (kt * 16 + r) * 64 + (((ks * 4 + q) ^ (r & 7)) * 8));
#pragma unroll
            for (int x = 0; x < 2; x++) s[x][kt] = mfma16(kf, qf[x][ks], s[x][kt]);
        }
    __builtin_amdgcn_sched_barrier(0);
    bf16x8 pbv[2][2];
#pragma unroll
    for (int x = 0; x < 2; x++) {
        float mx = -1e30f;
#pragma unroll
        for (int kt = 0; kt < 4; kt++)
#pragma unroll
            for (int j = 0; j < 4; j++) if ((vm >> (kt * 4 + j)) & 1u) mx = fmaxf(mx, s[x][kt][j]);
        mx = fmaxf(mx, __shfl_xor(mx, 16, 64));
        mx = fmaxf(mx, __shfl_xor(mx, 32, 64));
        const float mnew = fmaxf(m[x], mx);
        const float alpha = __expf(m[x] - mnew);
        m[x] = mnew;
        float ls = 0.f;
#pragma unroll
        for (int kt = 0; kt < 4; kt++)
#pragma unroll
            for (int j = 0; j < 4; j++) {
                const float pv = ((vm >> (kt * 4 + j)) & 1u) ? __expf(s[x][kt][j] - mnew) : 0.f;
                s[x][kt][j] = pv; ls += pv;
            }
        l[x] = l[x] * alpha + ls;
#pragma unroll
        for (int dt = 0; dt < 4; dt++) O[x][dt] *= alpha;
#pragma unroll
        for (int s2 = 0; s2 < 2; s2++) {
            const u32x4 t4 = {pack2(s[x][2 * s2][0], s[x][2 * s2][1]), pack2(s[x][2 * s2][2], s[x][2 * s2][3]),
                              pack2(s[x][2 * s2 + 1][0], s[x][2 * s2 + 1][1]), pack2(s[x][2 * s2 + 1][2], s[x][2 * s2 + 1][3])};
            pbv[x][s2] = __builtin_bit_cast(bf16x8, t4);
        }
    }
    __builtin_amdgcn_sched_barrier(0);
#pragma unroll
    for (int s2 = 0; s2 < 2; s2++)
#pragma unroll
        for (int dt = 0; dt < 4; dt++) {
            const u32x2 lo = *(const u32x2*)(VT + (dt * 16 + r) * 72 + (2 * s2) * 16 + 4 * q);
            const u32x2 hi = *(const u32x2*)(VT + (dt * 16 + r) * 72 + (2 * s2 + 1) * 16 + 4 * q);
            const bf16x8 va = mk_frag(lo, hi);
#pragma unroll
            for (int x = 0; x < 2; x++) O[x][dt] = mfma16(va, pbv[x][s2], O[x][dt]);
        }
    __builtin_amdgcn_sched_barrier(0);
}

__device__ __forceinline__ void nsa_cmp_probs(const bf16_t* Kc, const bf16x8 (&qfx)[2], int nv, int r, int q, f32x4 (&s)[8]) {
#pragma unroll
    for (int kt = 0; kt < 8; kt++) s[kt] = (f32x4){0.f, 0.f, 0.f, 0.f};
#pragma unroll
    for (int kt = 0; kt < 8; kt++)
#pragma unroll
        for (int ks = 0; ks < 2; ks++) s[kt] = mfma16(ld_frag(Kc + (kt * 16 + r) * 72 + ks * 32 + q * 8), qfx[ks], s[kt]);
    __builtin_amdgcn_sched_barrier(0);
    float mx = -1e30f;
#pragma unroll
    for (int kt = 0; kt < 8; kt++)
#pragma unroll
        for (int j = 0; j < 4; j++) if (kt * 16 + 4 * q + j < nv) mx = fmaxf(mx, s[kt][j]);
    mx = fmaxf(mx, __shfl_xor(mx, 16, 64));
    mx = fmaxf(mx, __shfl_xor(mx, 32, 64));
    float ls = 0.f;
#pragma unroll
    for (int kt = 0; kt < 8; kt++)
#pragma unroll
        for (int j = 0; j < 4; j++) {
            const float pv = (kt * 16 + 4 * q + j < nv) ? __expf(s[kt][j] - mx) : 0.f;
            s[kt][j] = pv; ls += pv;
        }
    ls += __shfl_xor(ls, 16, 64);
    ls += __shfl_xor(ls, 32, 64);
    const float inv = nv > 0 ? 1.f / ls : 0.f;
#pragma unroll
    for (int kt = 0; kt < 8; kt++) s[kt] *= inv;
}

__device__ void phaseN2_task(const Params& p, int task, char* lds, bf16_t* ydst, int ystride) {
    const int tid = TIDX, lane = tid & 63, wave = tid >> 6, r = lane & 15, q = lane >> 4;
    const int tt = 127 - (task >> 4), g = task & 1, b = (task >> 1) & 7;
    const int t0 = tt * 16, t = t0 + r;
    const int cur = t0 >> 6;
    bf16_t* Z = (bf16_t*)(p.ws + OFF_Z);
    const size_t rowb = (size_t)b * SEQ;
    bf16_t* Kc = (bf16_t*)lds;
    bf16_t* VcT = (bf16_t*)(lds + 18432);
    bf16_t* Ks = (bf16_t*)lds;
    bf16_t* VT = (bf16_t*)(lds + 18432);
    float* impw = (float*)(lds + 35840);
    float* scs = (float*)(lds + 35840 + 32768);
    unsigned* selm = (unsigned*)(lds + 35840 + 32768 + 2048);

    bf16x8 qf[2][2];
#pragma unroll
    for (int x = 0; x < 2; x++)
#pragma unroll
        for (int ks = 0; ks < 2; ks++) qf[x][ks] = *(const bf16x8*)(Z + (rowb + t) * ZC + ZQ_N + (g * 8 + 2 * wave + x) * 64 + ks * 32 + q * 8);
    f32x4* ofl = (f32x4*)(lds + 35840);

    {
        const bf16_t* kc = (const bf16_t*)(p.ws + OFF_CMP) + (size_t)((0 * 8 + b) * 2 + g) * 128 * 64;
        const bf16_t* vc = (const bf16_t*)(p.ws + OFF_CMP) + (size_t)((1 * 8 + b) * 2 + g) * 128 * 64;
        {
            const int key = tid >> 1, ch = (tid & 1) * 32;
#pragma unroll
            for (int v4 = 0; v4 < 4; v4++) *(u32x4*)(Kc + key * 72 + ch + v4 * 8) = *(const u32x4*)(kc + key * 64 + ch + v4 * 8);
            const int k2 = tid & 127, dc = (tid >> 7) * 32;
#pragma unroll
            for (int v4 = 0; v4 < 4; v4++) {
                const u32x4 a = *(const u32x4*)(vc + k2 * 64 + dc + v4 * 8);
                const unsigned w[4] = {a.x, a.y, a.z, a.w};
#pragma unroll
                for (int j = 0; j < 8; j++) VcT[(dc + v4 * 8 + j) * 136 + k2] = (bf16_t)((j & 1) ? (w[j >> 1] >> 16) : (w[j >> 1] & 0xffffu));
            }
        }
        __syncthreads();
        int nv = t >= 31 ? ((t - 31) >> 4) + 1 : 0;
        if (nv > 127) nv = 127;
        f32x4 isum[8];
#pragma unroll
        for (int kt = 0; kt < 8; kt++) isum[kt] = (f32x4){0.f, 0.f, 0.f, 0.f};
#pragma unroll
        for (int x = 0; x < 2; x++) {
            f32x4 s[8];
            nsa_cmp_probs(Kc, qf[x], nv, r, q, s);
#pragma unroll
            for (int kt = 0; kt < 8; kt++) isum[kt] += s[kt];
            __builtin_amdgcn_sched_barrier(0);
        }
#pragma unroll
        for (int kt = 0; kt < 8; kt++) *(f32x4*)(impw + (wave * 16 + r) * 128 + kt * 16 + 4 * q) = isum[kt];
        __syncthreads();
#pragma unroll
        for (int pass = 0; pass < 2; pass++) {
            const int tk = pass * 8 + (tid >> 5), j = tid & 31;
            const int i0 = j == 0 ? 0 : 4 * j - 1, i1 = (4 * j + 3 > 126) ? 126 : 4 * j + 3;
            float sc = 0.f;
            for (int i = i0; i <= i1; i++) sc += (impw[(0 * 16 + tk) * 128 + i] + impw[(1 * 16 + tk) * 128 + i]) + (impw[(2 * 16 + tk) * 128 + i] + impw[(3 * 16 + tk) * 128 + i]);
            const bool forced = (j == 0) || (j == cur) || (j == cur - 1);
            scs[tk * 32 + j] = forced ? 1e6f : (j <= cur ? sc : -1.f);
        }
        __syncthreads();
#pragma unroll
        for (int pass = 0; pass < 2; pass++) {
            const int tk = pass * 8 + (tid >> 5), j = tid & 31;
            const float mine = scs[tk * 32 + j];
            int rank = 0;
            for (int j2 = 0; j2 < 32; j2++) { const float o = scs[tk * 32 + j2]; rank += (o > mine || (o == mine && j2 < j)) ? 1 : 0; }
            const unsigned long long bal = __ballot(rank < 16);
            if ((lane & 31) == 0) selm[tk] = (unsigned)(lane ? (bal >> 32) : (bal & 0xffffffffull));
        }
        __syncthreads();
    }
    {
        int nv = t >= 31 ? ((t - 31) >> 4) + 1 : 0;
        if (nv > 127) nv = 127;
#pragma unroll
        for (int x = 0; x < 2; x++) {
            f32x4 s[8];
            nsa_cmp_probs(Kc, qf[x], nv, r, q, s);
            f32x4 Oc[4];
#pragma unroll
            for (int dt = 0; dt < 4; dt++) Oc[dt] = (f32x4){0.f, 0.f, 0.f, 0.f};
            __builtin_amdgcn_sched_barrier(0);
#pragma unroll
            for (int s2 = 0; s2 < 4; s2++) {
                const u32x4 t4 = {pack2(s[2 * s2][0], s[2 * s2][1]), pack2(s[2 * s2][2], s[2 * s2][3]),
                                  pack2(s[2 * s2 + 1][0], s[2 * s2 + 1][1]), pack2(s[2 * s2 + 1][2], s[2 * s2 + 1][3])};
                const bf16x8 pbv = __builtin_bit_cast(bf16x8, t4);
#pragma unroll
                for (int dt = 0; dt < 4; dt++) {
                    const u32x2 lo = *(const u32x2*)(VcT + (dt * 16 + r) * 136 + (2 * s2) * 16 + 4 * q);
                    const u32x2 hi = *(const u32x2*)(VcT + (dt * 16 + r) * 136 + (2 * s2 + 1) * 16 + 4 * q);
                    Oc[dt] = mfma16(mk_frag(lo, hi), pbv, Oc[dt]);
                }
            }
            const float g0 = sigmoidf_(bf2f(Z[(rowb + t) * ZC + ZGATE + 0 * 16 + g * 8 + 2 * wave + x]));
#pragma unroll
            for (int dt = 0; dt < 4; dt++) ofl[(wave * 8 + x * 4 + dt) * 64 + lane] = g0 * Oc[dt];
            __builtin_amdgcn_sched_barrier(0);
        }
    }
    const unsigned mysel = selm[r];
    unsigned uni = 0;
#pragma unroll
    for (int i = 0; i < 16; i++) uni |= selm[i];
    uni &= (cur == 31) ? 0xffffffffu : ((2u << cur) - 1u);
    uni |= 1u;

    {
        const int lo = t0 - 511;
        const int jb0 = lo > 0 ? (lo >> 6) : 0;
        const int kkey = tid >> 2, kch = (tid & 3) * 16;
        const int vkey = tid & 63, vdc = (tid >> 6) * 16;
        u32x4 kreg[2], vreg[2];
        int br = 0, j = 0;
        {
            const bf16_t* kb = Z + (rowb + 0) * ZC + ZKS + g * 64;
            const bf16_t* vb = Z + (rowb + 0) * ZC + ZVS + g * 64;
            kreg[0] = *(const u32x4*)(kb + (size_t)kkey * ZC + kch); kreg[1] = *(const u32x4*)(kb + (size_t)kkey * ZC + kch + 8);
            vreg[0] = *(const u32x4*)(vb + (size_t)vkey * ZC + vdc); vreg[1] = *(const u32x4*)(vb + (size_t)vkey * ZC + vdc + 8);
        }
        f32x4 O[2][4];
        float m[2] = {-1e30f, -1e30f}, l[2] = {0.f, 0.f};
#pragma unroll
        for (int x = 0; x < 2; x++)
#pragma unroll
            for (int dt = 0; dt < 4; dt++) O[x][dt] = (f32x4){0.f, 0.f, 0.f, 0.f};
        for (;;) {
            __syncthreads();
            *(u32x4*)(Ks + kkey * 64 + (((kch >> 3) ^ (kkey & 7)) * 8)) = kreg[0];
            *(u32x4*)(Ks + kkey * 64 + ((((kch >> 3) + 1) ^ (kkey & 7)) * 8)) = kreg[1];
            {
                const unsigned w[8] = {vreg[0].x, vreg[0].y, vreg[0].z, vreg[0].w, vreg[1].x, vreg[1].y, vreg[1].z, vreg[1].w};
#pragma unroll
                for (int jj = 0; jj < 16; jj++) VT[(vdc + jj) * 72 + vkey] = (bf16_t)((jj & 1) ? (w[jj >> 1] >> 16) : (w[jj >> 1] & 0xffffu));
            }
            __syncthreads();
            int nbr, nj;
            if (br == 0) {
                const unsigned rem = (j >= 31) ? 0u : (uni & ~((2u << j) - 1u));
                if (rem) { nbr = 0; nj = __ffs((int)rem) - 1; } else { nbr = 1; nj = jb0; }
            } else {
                if (j < cur) { nbr = 1; nj = j + 1; } else { nbr = 2; nj = 0; }
            }
            if (nbr < 2) {
                const bf16_t* kb = Z + (rowb + nj * 64) * ZC + (nbr ? ZKW : ZKS) + g * 64;
                const bf16_t* vb = Z + (rowb + nj * 64) * ZC + (nbr ? ZVW : ZVS) + g * 64;
                kreg[0] = *(const u32x4*)(kb + (size_t)kkey * ZC + kch); kreg[1] = *(const u32x4*)(kb + (size_t)kkey * ZC + kch + 8);
                vreg[0] = *(const u32x4*)(vb + (size_t)vkey * ZC + vdc); vreg[1] = *(const u32x4*)(vb + (size_t)vkey * ZC + vdc + 8);
            }
            unsigned vm = 0;
            if (br == 0) {
                if ((mysel >> j) & 1u) {
#pragma unroll
                    for (int kt = 0; kt < 4; kt++)
#pragma unroll
                        for (int jj = 0; jj < 4; jj++) if (j * 64 + kt * 16 + 4 * q + jj <= t) vm |= 1u << (kt * 4 + jj);
                }
            } else {
#pragma unroll
                for (int kt = 0; kt < 4; kt++)
#pragma unroll
                    for (int jj = 0; jj < 4; jj++) { const int kp = j * 64 + kt * 16 + 4 * q + jj; if (kp <= t && t - kp < 512) vm |= 1u << (kt * 4 + jj); }
            }
            nsa_block_step(Ks, VT, qf, O, m, l, vm, r, q);
            if (nbr != br) {
#pragma unroll
                for (int x = 0; x < 2; x++) {
                    float lt = l[x];
                    lt += __shfl_xor(lt, 16, 64);
                    lt += __shfl_xor(lt, 32, 64);
                    const float sc = sigmoidf_(bf2f(Z[(rowb + t) * ZC + ZGATE + (br + 1) * 16 + g * 8 + 2 * wave + x])) / lt;
#pragma unroll
                    for (int dt = 0; dt < 4; dt++) { ofl[(wave * 8 + x * 4 + dt) * 64 + lane] += sc * O[x][dt]; O[x][dt] = (f32x4){0.f, 0.f, 0.f, 0.f}; }
                    m[x] = -1e30f; l[x] = 0.f;
                }
            }
            if (nbr == 2) break;
            br = nbr; j = nj;
        }
#pragma unroll
        for (int x = 0; x < 2; x++)
#pragma unroll
            for (int dt = 0; dt < 4; dt++) {
                const f32x4 v = ofl[(wave * 8 + x * 4 + dt) * 64 + lane];
                *(u32x2*)(ydst + (rowb + t) * ystride + (g * 8 + 2 * wave + x) * 64 + dt * 16 + 4 * q) = (u32x2){pack2(v[0], v[1]), pack2(v[2], v[3])};
            }
    }
    __syncthreads();
}

__device__ void phaseM1(const Params& p, char* lds) {
    const int tid_ = TIDX; const int lane = tid_ & 63, wave = tid_ >> 6;
    const int wr = wave >> 1, wc = wave & 1, r = lane & 15, q = lane >> 4;
    const bf16_t* H = (const bf16_t*)(p.ws + OFF_H);
    const bf16_t* Z = (const bf16_t*)(p.ws + OFF_Z);
    bf16_t* M = (bf16_t*)(p.ws + OFF_M);
    bf16_t* SG = (bf16_t*)p.out;
    TileIter tit(8, lds);
    int bm, bn;
    while (tit.next(bm, bn)) {
        const int m0 = bm * 128, n0 = bn * 128;
        for (int br = 0; br < 2; br++) {
            f32x4 acc[4][4];
            zero_acc(acc);
            gemm_core(acc, H, DM, (const bf16_t*)(p.ws + OFF_WM) + (size_t)br * 1024 * 1024, DM, DM, m0, n0, lds);
            {
                const int e0 = launder_i((m0 + wr * 64 + r) * DM + n0 + wc * 64 + 4 * q);
#pragma unroll
                for (int mi = 0; mi < 4; mi++)
#pragma unroll
                    for (int ni = 0; ni < 4; ni++)
                        *(u32x2*)(SG + (size_t)(e0 + mi * 16 * DM + ni * 16)) = (u32x2){pack2(sigmoidf_(acc[mi][ni][0]), sigmoidf_(acc[mi][ni][1])),
                                                                                        pack2(sigmoidf_(acc[mi][ni][2]), sigmoidf_(acc[mi][ni][3]))};
            }
            zero_acc(acc);
            gemm_core(acc, Z + (br ? ZQ_N : ZR_G), ZC, (const bf16_t*)(p.ws + (br ? OFF_WB : OFF_WA)), DM, DM, m0, n0, lds);
            {
                const int e0 = launder_i((m0 + wr * 64 + r) * DM + n0 + wc * 64 + 4 * q);
#pragma unroll
                for (int mi = 0; mi < 4; mi++)
#pragma unroll
                    for (int ni = 0; ni < 4; ni++) {
                        const size_t eo = (size_t)(e0 + mi * 16 * DM + ni * 16);
                        const u32x2 sg = *(const u32x2*)(SG + eo);
                        float v[4] = {bf_lo(sg.x) * acc[mi][ni][0], bf_hi(sg.x) * acc[mi][ni][1], bf_lo(sg.y) * acc[mi][ni][2], bf_hi(sg.y) * acc[mi][ni][3]};
                        u32x2* dst = (u32x2*)(M + eo);
                        if (br) { const u32x2 pv = *dst; v[0] += bf_lo(pv.x); v[1] += bf_hi(pv.x); v[2] += bf_lo(pv.y); v[3] += bf_hi(pv.y); }
                        *dst = (u32x2){pack2(v[0], v[1]), pack2(v[2], v[3])};
                    }
            }
        }
    }
}

__device__ void phaseM2(const Params& p, char* lds) {
    const int tid_ = TIDX; const int lane = tid_ & 63, wave = tid_ >> 6;
    const int wr = wave >> 1, wc = wave & 1, r = lane & 15, q = lane >> 4;
    const bf16_t* M = (const bf16_t*)(p.ws + OFF_M);
    const float* mod = (const float*)(p.ws + OFF_MOD);
    TileIter tit(8, lds);
    int bm, bn;
    while (tit.next(bm, bn)) {
        const int m0 = bm * 128, n0 = bn * 128;
        f32x4 acc[4][4];
        zero_acc(acc);
        gemm_core(acc, M, DM, (const bf16_t*)(p.ws + OFF_WO), DM, DM, m0, n0, lds);
#pragma unroll
        for (int mi = 0; mi < 4; mi++)
#pragma unroll
            for (int ni = 0; ni < 4; ni++) {
                const int tok = m0 + wr * 64 + mi * 16 + r, col = n0 + wc * 64 + ni * 16 + 4 * q;
                const f32x4 xv = *(const f32x4*)(p.x + (size_t)tok * DM + col);
                const f32x4 gt = *(const f32x4*)(mod + (tok >> 11) * 6144 + 2 * 1024 + col);
                *(f32x4*)(p.out + (size_t)tok * DM + col) = xv + gt * acc[mi][ni];
            }
    }
    {
        const int tid_ = TIDX; const int lane = tid_ & 63, wave = tid_ >> 6;
        unsigned char* tq = (unsigned char*)(p.ws + OFF_UB);
        float* tsc = (float*)(p.ws + OFF_UB + 33554432);
        for (int row = blockIdx.x * 4 + wave; row < 32768; row += gridDim.x * 4) {
            const bool isv = row >= 16384;
            const float* srcp = (isv ? p.peer_v : p.peer_u) + (size_t)(row & 16383) * DM + lane * 16;
            f32x4 a[4];
            float mx = 0.f;
#pragma unroll
            for (int i = 0; i < 4; i++) {
                a[i] = *(const f32x4*)(srcp + i * 4);
                mx = fmaxf(mx, fmaxf(fmaxf(fabsf(a[i][0]), fabsf(a[i][1])), fmaxf(fabsf(a[i][2]), fabsf(a[i][3]))));
            }
            mx = wave_max(mx);
            const float inv = mx > 0.f ? 127.f / mx : 0.f;
            const int off = isv ? 128 : 0;
            unsigned w[4];
#pragma unroll
            for (int i = 0; i < 4; i++) {
                unsigned pk = 0;
#pragma unroll
                for (int j = 0; j < 4; j++) {
                    int qi = (int)rintf(a[i][j] * inv);
                    qi = qi > 127 ? 127 : (qi < -127 ? -127 : qi);
                    pk |= ((unsigned)(qi + off) & 0xffu) << (8 * j);
                }
                w[i] = pk;
            }
            *(u32x4*)(tq + (size_t)row * DM + lane * 16) = (u32x4){w[0], w[1], w[2], w[3]};
            if (lane == 0) tsc[row] = mx * (1.f / 127.f);
        }
    }
}

__device__ void phaseP1(const Params& p, char* lds) {
    const int tid_ = TIDX; const int lane = tid_ & 63, wave = tid_ >> 6;
    const int wr = wave >> 1, wc = wave & 1, r = lane & 15, q = lane >> 4;
    const bf16_t* H = (const bf16_t*)(p.ws + OFF_H);
    bf16_t* QP = (bf16_t*)(p.ws + OFF_QP);
    TileIter tit(16, lds);
    int bm, bn;
    while (tit.next(bm, bn)) {
        const int m0 = bm * 128, n0 = bn * 128;
        f32x4 acc[4][4];
        zero_acc(acc);
        gemm_core(acc, H, DM, (const bf16_t*)(p.ws + OFF_WQ), DM, DM, m0, n0, lds);
#pragma unroll
        for (int mi = 0; mi < 4; mi++)
#pragma unroll
            for (int ni = 0; ni < 4; ni++) {
                const int tok = m0 + wr * 64 + mi * 16 + r, col = n0 + wc * 64 + ni * 16 + 4 * q;
                const f32x4 v = acc[mi][ni];
                *(u32x2*)(QP + (size_t)tok * 2048 + col) = (u32x2){pack2(v[0], v[1]), pack2(v[2], v[3])};
            }
    }
}

__constant__ unsigned char c_cand_a[64] = {0,0,0,0,0,0,0,0,0,0,0,0,0,0,0,0, 1,1,1,1,1,1,1,1, 2,2,2,2,2, 3,3,3,3, 4,4,4, 5,5, 6,6, 7,7, 8,9,10,11,12,13,14,15, 0,0,0,0,0,0,0,0,0,0,0,0,0,0};
__constant__ unsigned char c_cand_b[64] = {0,1,2,3,4,5,6,7,8,9,10,11,12,13,14,15, 0,1,2,3,4,5,6,7, 0,1,2,3,4, 0,1,2,3, 0,1,2, 0,1, 0,1, 0,1, 0,0,0,0,0,0,0,0, 0,0,0,0,0,0,0,0,0,0,0,0,0,0};

__device__ __forceinline__ unsigned f2key(float f) { const unsigned u = __float_as_uint(f); return (u & 0x80000000u) ? ~u : (u | 0x80000000u); }
__device__ __forceinline__ float key2f(unsigned k) { const unsigned u = (k & 0x80000000u) ? (k & 0x7fffffffu) : ~k; return __uint_as_float(u); }
__device__ __forceinline__ void ins16(unsigned (&L)[16], unsigned v) {
#pragma unroll
    for (int k = 0; k < 16; k++) { const unsigned hi = L[k] > v ? L[k] : v; v = L[k] > v ? v : L[k]; L[k] = hi; }
}

__device__ void phaseP2_task(const Params& p, int task, char* lds) {
    const int tid = TIDX, lane = tid & 63, wave = tid >> 6, r = lane & 15, q = lane >> 4;
    const int h = task & 7, tile = task >> 3;
    const int tok0 = tile * 64;
    const bf16_t* QP = (const bf16_t*)(p.ws + OFF_QP);
    float* S = (float*)lds;
    unsigned* LL = (unsigned*)(lds + 65536);
#pragma unroll
    for (int half = 0; half < 2; half++) {
        const bf16_t* KB = (const bf16_t*)(p.ws + OFF_K1B) + (size_t)half * 131072 + (size_t)h * 128 * 128;
        f32x4 acc[8];
#pragma unroll
        for (int nt = 0; nt < 8; nt++) acc[nt] = (f32x4){0.f, 0.f, 0.f, 0.f};
#pragma unroll
        for (int ks = 0; ks < 4; ks++) {
            const bf16x8 bq = *(const bf16x8*)(QP + (size_t)(tok0 + wave * 16 + r) * 2048 + h * 256 + half * 128 + ks * 32 + q * 8);
#pragma unroll
            for (int nt = 0; nt < 8; nt++) {
                const bf16x8 ak = *(const bf16x8*)(KB + (size_t)(nt * 16 + r) * 128 + ks * 32 + q * 8);
                acc[nt] = mfma16(ak, bq, acc[nt]);
            }
        }
#pragma unroll
        for (int nt = 0; nt < 8; nt++)
#pragma unroll
            for (int j = 0; j < 4; j++) S[(half * 128 + nt * 16 + 4 * q + j) * 64 + wave * 16 + r] = acc[nt][j];
    }
    __syncthreads();
    if (tid < 128) {
        const int half = tid >> 6, tk = tid & 63;
        unsigned L[16];
#pragma unroll
        for (int k = 0; k < 16; k++) L[k] = 0u;
        const float* sp = S + half * 128 * 64 + tk;
        for (int k = 0; k < 128; k++) ins16(L, (f2key(sp[k * 64]) & ~127u) | (unsigned)(127 - k));
#pragma unroll
        for (int k = 0; k < 16; k++) LL[(half * 16 + k) * 64 + tk] = L[k];
    }
    __syncthreads();
    if (tid < 64) {
        const int tk = tid;
        float v1[16], v2[16];
#pragma unroll
        for (int k = 0; k < 16; k++) { v1[k] = key2f(LL[k * 64 + tk] & ~127u); v2[k] = key2f(LL[(16 + k) * 64 + tk] & ~127u); }
        unsigned T[16];
#pragma unroll
        for (int k = 0; k < 16; k++) T[k] = 0u;
        int c = 0;
#pragma unroll
        for (int a = 0; a < 16; a++)
#pragma unroll
            for (int b = 0; b < 16; b++)
                if ((a + 1) * (b + 1) <= 16) { ins16(T, (f2key(v1[a] + v2[b]) & ~63u) | (unsigned)(63 - c)); c++; }
        const float mx = key2f(T[0] & ~63u);
        float e[16], sum = 0.f;
#pragma unroll
        for (int k = 0; k < 16; k++) { e[k] = __expf(key2f(T[k] & ~63u) - mx); sum += e[k]; }
        const float inv = 1.f / sum;
        int ei[16];
#pragma unroll
        for (int k = 0; k < 16; k++) {
            const int cc = 63 - (int)(T[k] & 63u);
            const int a = c_cand_a[cc], b = c_cand_b[cc];
            const int i1 = 127 - (int)(LL[a * 64 + tk] & 127u), i2 = 127 - (int)(LL[(16 + b) * 64 + tk] & 127u);
            ei[k] = i1 * 128 + i2;
            e[k] *= inv;
        }
        int* eidx = (int*)(p.ws + OFF_EIDX) + (size_t)(tok0 + tk) * 128 + h * 16;
        float* gw = (float*)(p.ws + OFF_GW) + (size_t)(tok0 + tk) * 128 + h * 16;
#pragma unroll
        for (int k4 = 0; k4 < 4; k4++) {
            *(u32x4*)(eidx + k4 * 4) = (u32x4){(unsigned)ei[k4 * 4], (unsigned)ei[k4 * 4 + 1], (unsigned)ei[k4 * 4 + 2], (unsigned)ei[k4 * 4 + 3]};
            *(f32x4*)(gw + k4 * 4) = (f32x4){e[k4 * 4], e[k4 * 4 + 1], e[k4 * 4 + 2], e[k4 * 4 + 3]};
        }
    }
    __syncthreads();
}

__device__ __forceinline__ float ub0(unsigned w) { return (float)(w & 0xffu); }
__device__ __forceinline__ float ub1(unsigned w) { return (float)((w >> 8) & 0xffu); }
__device__ __forceinline__ float ub2(unsigned w) { return (float)((w >> 16) & 0xffu); }
__device__ __forceinline__ float ub3(unsigned w) { return (float)(w >> 24); }
__device__ void phaseP3(const Params& p, float* dstp) {
    const int tid_ = TIDX; const int lane = tid_ & 63, wave = tid_ >> 6;
    const bf16_t* H = (const bf16_t*)(p.ws + OFF_H);
    const unsigned char* UQ = (const unsigned char*)(p.ws + OFF_UB);
    const unsigned char* VQ = UQ + 16777216;
    const float* tsc = (const float*)(p.ws + OFF_UB + 33554432);
    const int* eidx = (const int*)(p.ws + OFF_EIDX);
    const float* gwp = (const float*)(p.ws + OFF_GW);
    const float* mod = (const float*)(p.ws + OFF_MOD);
    const int ul = ((lane & 1) << 2) | (lane & 2) | ((lane >> 2) & 1);
    for (int tok = blockIdx.x * 4 + wave; tok < NTOK; tok += gridDim.x * 4) {
        int qh[4];
        float sh;
        {
            const u32x4 a = *(const u32x4*)(H + (size_t)tok * DM + lane * 16), b = *(const u32x4*)(H + (size_t)tok * DM + lane * 16 + 8);
            const unsigned hw[8] = {a.x, a.y, a.z, a.w, b.x, b.y, b.z, b.w};
            float hv[16];
            float mx = 0.f;
#pragma unroll
            for (int i = 0; i < 8; i++) { hv[2 * i] = bf_lo(hw[i]); hv[2 * i + 1] = bf_hi(hw[i]); mx = fmaxf(mx, fmaxf(fabsf(hv[2 * i]), fabsf(hv[2 * i + 1]))); }
            mx = wave_max(mx);
            const float inv = mx > 0.f ? 127.f / mx : 0.f;
            sh = mx * (1.f / 127.f);
#pragma unroll
            for (int i = 0; i < 4; i++) {
                unsigned pk = 0;
#pragma unroll
                for (int j = 0; j < 4; j++) pk |= ((unsigned)((int)rintf(hv[i * 4 + j] * inv)) & 0xffu) << (8 * j);
                qh[i] = (int)pk;
            }
        }
        const int e0 = eidx[(size_t)tok * 128 + lane], e1 = eidx[(size_t)tok * 128 + 64 + lane];
        const float g0 = gwp[(size_t)tok * 128 + lane], g1 = gwp[(size_t)tok * 128 + 64 + lane];
        float acc[16];
#pragma unroll
        for (int i = 0; i < 16; i++) acc[i] = 0.f;
        float wsum = 0.f;
        for (int jb = 0; jb < 128; jb += 8) {
            u32x4 ur[8], vr[8];
#pragma unroll
            for (int u = 0; u < 8; u++) {
                const int j = jb + u;
                const int e = (jb < 64) ? __shfl(e0, j, 64) : __shfl(e1, j - 64, 64);
                ur[u] = *(const u32x4*)(UQ + (size_t)e * DM + lane * 16);
                vr[u] = *(const u32x4*)(VQ + (size_t)e * DM + lane * 16);
            }
            const int jm = jb + ul;
            const int em = (jb < 64) ? __shfl(e0, jm, 64) : __shfl(e1, jm - 64, 64);
            const float gm = (jb < 64) ? __shfl(g0, jm, 64) : __shfl(g1, jm - 64, 64);
            const float su = tsc[em], sv = tsc[16384 + em];
            int pt[8];
#pragma unroll
            for (int u = 0; u < 8; u++) {
                int d = __builtin_amdgcn_sdot4((int)ur[u].x, qh[0], 0, false);
                d = __builtin_amdgcn_sdot4((int)ur[u].y, qh[1], d, false);
                d = __builtin_amdgcn_sdot4((int)ur[u].z, qh[2], d, false);
                d = __builtin_amdgcn_sdot4((int)ur[u].w, qh[3], d, false);
                pt[u] = d;
            }
            int m4[4], m2[2], m1;
            {
                const bool b0 = lane & 1;
#pragma unroll
                for (int j = 0; j < 4; j++) { const int keep = b0 ? pt[j + 4] : pt[j], send = b0 ? pt[j] : pt[j + 4]; m4[j] = keep + __shfl_xor(send, 1, 64); }
                const bool b1 = lane & 2;
#pragma unroll
                for (int j = 0; j < 2; j++) { const int keep = b1 ? m4[j + 2] : m4[j], send = b1 ? m4[j] : m4[j + 2]; m2[j] = keep + __shfl_xor(send, 2, 64); }
                const bool b2 = lane & 4;
                { const int keep = b2 ? m2[1] : m2[0], send = b2 ? m2[0] : m2[1]; m1 = keep + __shfl_xor(send, 4, 64); }
                m1 += __shfl_xor(m1, 8, 64);
                m1 += __shfl_xor(m1, 16, 64);
                m1 += __shfl_xor(m1, 32, 64);
            }
            const float aval = (float)m1 * (sh * su);
            const float ws = gm * gelu_erf(aval) * sv;
#pragma unroll
            for (int u = 0; u < 8; u++) {
                const int src_lane = ((u >> 2) & 1) | (u & 2) | ((u & 1) << 2);
                const float wu = __shfl(ws, src_lane, 64);
                wsum += wu;
                const unsigned vw[4] = {vr[u].x, vr[u].y, vr[u].z, vr[u].w};
#pragma unroll
                for (int i = 0; i < 4; i++) {
                    acc[i * 4 + 0] += wu * ub0(vw[i]); acc[i * 4 + 1] += wu * ub1(vw[i]);
                    acc[i * 4 + 2] += wu * ub2(vw[i]); acc[i * 4 + 3] += wu * ub3(vw[i]);
                }
            }
        }
        const int b = tok >> 11;
        float x2[16];
        float ss = 0.f;
#pragma unroll
        for (int i = 0; i < 4; i++) {
            const int d = lane * 16 + i * 4;
            const f32x4 xv = *(const f32x4*)(p.out + (size_t)tok * DM + d);
            const f32x4 gt = *(const f32x4*)(mod + b * 6144 + 5 * 1024 + d);
#pragma unroll
            for (int j = 0; j < 4; j++) { const float v = xv[j] + gt[j] * (acc[i * 4 + j] - 128.f * wsum); x2[i * 4 + j] = v; ss += v * v; }
        }
        ss = wave_sum(ss);
        const float rstd = rsqrtf(ss * (1.f / 1024.f) + 1e-6f);
#pragma unroll
        for (int i = 0; i < 4; i++) {
            const int d = lane * 16 + i * 4;
            const f32x4 fg = *(const f32x4*)(p.final_g + d);
            f32x4 o;
#pragma unroll
            for (int j = 0; j < 4; j++) o[j] = x2[i * 4 + j] * rstd * fg[j];
            *(f32x4*)(dstp + (size_t)tok * DM + d) = o;
        }
    }
}

#define XB_TMO      128
#define XB_XCNT(j)  (256  + 64 * (j))
#define XB_XSUB(j)  (1280 + 64 * (j))
#define XB_XGEN(j)  (2304 + 64 * (j))
#define XB_TOP      3328
#define XB_TOPGEN   3392
#define XCD_BAR_WORDS 3456
#define XB_SPIN_CAP (1u << 22)
#define LAS __attribute__((address_space(3)))
__device__ __forceinline__ unsigned xb_ld(unsigned* p)              { return __hip_atomic_load(p, __ATOMIC_RELAXED, __HIP_MEMORY_SCOPE_AGENT); }
__device__ __forceinline__ unsigned xb_add(unsigned* p, unsigned v) { return __hip_atomic_fetch_add(p, v, __ATOMIC_RELAXED, __HIP_MEMORY_SCOPE_AGENT); }
__device__ __forceinline__ unsigned xb_xcc_id() { return (unsigned)__builtin_amdgcn_s_getreg((3 << 11) | 20) & 0xFu; }
#define XB_SPIN(cond, bar) do { unsigned _sp = 0; while (cond) { __builtin_amdgcn_s_sleep(1); \
    if ((++_sp & 255u) == 0u) { if (xb_ld(&(bar)[XB_TMO])) break; if (_sp > XB_SPIN_CAP) { atomicAdd(&(bar)[XB_TMO], 1u); break; } } } } while (0)
struct XcdBarrier { unsigned* bar; unsigned x; volatile LAS unsigned* st; };
__device__ __forceinline__ XcdBarrier xcd_barrier_post(unsigned* bar, volatile LAS unsigned* st) {
    XcdBarrier b; b.bar = bar; b.x = xb_xcc_id(); b.st = st;
    if (threadIdx.x == 0) { st[2] = xb_add(&bar[XB_XCNT(b.x)], 1u); st[4] = b.x; }
    return b;
}
__device__ __forceinline__ void xcd_barrier_complete(unsigned* bar, unsigned x, unsigned& nloc, unsigned& nx, unsigned& bal) {
    const unsigned G = gridDim.x * gridDim.y * gridDim.z;
    unsigned sum, cnt, mine, c64, sp = 0u;
    for (;;) {
        sum = 0u; cnt = 0u; mine = 0u; c64 = 0u;
#pragma unroll
        for (unsigned j = 0; j < 16; ++j) { const unsigned c = xb_ld(&bar[XB_XCNT(j)]); sum += c; cnt += (c > 0u) ? 1u : 0u; c64 += (j < 8 && c == 64u) ? 1u : 0u; mine = (j == x) ? c : mine; }
        if (sum == G) break;
        __builtin_amdgcn_s_sleep(1);
        if ((++sp & 255u) == 0u) { if (xb_ld(&bar[XB_TMO])) break; if (sp > XB_SPIN_CAP) { atomicAdd(&bar[XB_TMO], 1u); break; } }
    }
    nloc = mine > 0u ? mine : 1u; nx = cnt > 0u ? cnt : 1u; bal = (sum == G && cnt == 8u && c64 == 8u) ? 1u : 0u;
}
__device__ __forceinline__ void xcd_barrier(const XcdBarrier& b) {
    asm volatile("s_waitcnt vmcnt(0)" ::: "memory");
    __syncthreads();
    if (threadIdx.x == 0) {
        unsigned* bar = b.bar;
        __builtin_amdgcn_s_waitcnt(0);
        unsigned nloc = b.st[0], nx = b.st[1];
        if (nloc == 0u) { unsigned bal; xcd_barrier_complete(bar, b.x, nloc, nx, bal); b.st[0] = nloc; b.st[1] = nx; b.st[3] = bal; }
        const unsigned old = xb_add(&bar[XB_XSUB(b.x)], 1u);
        const unsigned gen = old / nloc;
        if (old + 1u == (gen + 1u) * nloc) {
            __builtin_amdgcn_fence(__ATOMIC_RELEASE, "agent");
            asm volatile("s_waitcnt vmcnt(0)" ::: "memory");
            const unsigned og = xb_add(&bar[XB_TOP], 1u);
            const unsigned tg = og / nx;
            if (og + 1u == (tg + 1u) * nx) xb_add(&bar[XB_TOPGEN], 1u);
            else XB_SPIN(xb_ld(&bar[XB_TOPGEN]) == tg, bar);
            __builtin_amdgcn_fence(__ATOMIC_ACQUIRE, "agent");
            xb_add(&bar[XB_XGEN(b.x)], 1u);
            asm volatile("s_waitcnt vmcnt(0)" ::: "memory");
        } else {
            XB_SPIN(xb_ld(&bar[XB_XGEN(b.x)]) == gen, bar);
            __builtin_amdgcn_fence(__ATOMIC_ACQUIRE, "agent");
            asm volatile("s_waitcnt vmcnt(0)" ::: "memory");
        }
    }
    __syncthreads();
}

typedef __attribute__((address_space(4))) const Params* KParamsPtr;
__device__ __forceinline__ const Params& fresh_params() {
    KParamsPtr kp = (KParamsPtr)__builtin_amdgcn_kernarg_segment_ptr();
    asm volatile("" : "+s"(kp));
    return *(const Params*)kp;
}
#define PF fresh_params()
__global__ void __launch_bounds__(NTHREADS, 2) mega(Params p_unused) {
    __shared__ __attribute__((aligned(16))) char lds[LDS_BYTES];
    cg::grid_group grid = cg::this_grid();
    volatile LAS unsigned* st = (volatile LAS unsigned*)(lds + LDS_MAIN);
    if (threadIdx.x < 8) st[threadIdx.x] = 0u;
    __syncthreads();
    XcdBarrier xb = xcd_barrier_post((unsigned*)PF.ws, st);

    phaseA(PF, lds);
    if (PF.ws == nullptr) grid.sync();
    xcd_barrier(xb);
    { const Params& q_ = PF; phase_modnorm(q_, q_.x, q_.norm1_g, 0, 1, (bf16_t*)(q_.ws + OFF_H)); };
    xcd_barrier(xb);
    phaseC(PF, lds);
    xcd_barrier(xb);
    for (int task = blockIdx.x; task < 1024; task += gridDim.x) phaseG1_task(PF, task, lds);
    for (int task = blockIdx.x; task < 256; task += gridDim.x) phaseN1_task(PF, task, lds);
    xcd_barrier(xb);
    phaseG2(PF);
    xcd_barrier(xb);
    for (int task = blockIdx.x; task < 2048; task += gridDim.x) phaseN2_task(PF, task, lds, (bf16_t*)(PF.ws + OFF_Z) + ZQ_N, ZC);
    for (int task = blockIdx.x; task < 1024; task += gridDim.x) phaseG3_task(PF, task, lds, (bf16_t*)(PF.ws + OFF_Z) + ZR_G, ZC);
    xcd_barrier(xb);
    phaseM1(PF, lds);
    xcd_barrier(xb);
    phaseM2(PF, lds);
    xcd_barrier(xb);
    { const Params& q_ = PF; phase_modnorm(q_, q_.out, q_.norm2_g, 3, 4, (bf16_t*)(q_.ws + OFF_H)); };
    xcd_barrier(xb);
    phaseP1(PF, lds);
    xcd_barrier(xb);
    for (int task = blockIdx.x; task < 2048; task += gridDim.x) phaseP2_task(PF, task, lds);
    xcd_barrier(xb);
    { const Params& q_ = PF; phaseP3(q_, q_.out); };
}

extern "C" void kernel_launch(void* const* d_in, const int* in_sizes, int n_in, void* d_out, int out_size, void* d_ws, size_t ws_size, hipStream_t stream) {
    Params p{};
    p.x = (const float*)d_in[0]; p.c = (const float*)d_in[1]; p.pos = (const int*)d_in[2]; p.ada_w = (const float*)d_in[3]; p.ada_b = (const float*)d_in[4];
    p.norm1_g = (const float*)d_in[5]; p.norm2_g = (const float*)d_in[6]; p.final_g = (const float*)d_in[7]; p.w_in = (const float*)d_in[8];
    p.gla_wa2 = (const float*)d_in[9]; p.gla_ba2 = (const float*)d_in[10]; p.gla_norm_g = (const float*)d_in[11]; p.pe_k = (const float*)d_in[12]; p.pe_v = (const float*)d_in[13];
    p.ck_w1 = (const float*)d_in[14]; p.ck_w2 = (const float*)d_in[15]; p.cv_w1 = (const float*)d_in[16]; p.cv_w2 = (const float*)d_in[17];
    p.w_branch_a = (const float*)d_in[18]; p.w_branch_b = (const float*)d_in[19]; p.w_out = (const float*)d_in[20]; p.peer_wq = (const float*)d_in[21];
    p.peer_k1 = (const float*)d_in[22]; p.peer_k2 = (const float*)d_in[23]; p.peer_u = (const float*)d_in[24]; p.peer_v = (const float*)d_in[25];
    p.out = (float*)d_out; p.ws = (char*)d_ws;
    static int grid_blocks = 0;
    if (!grid_blocks) {
        int dev = 0, cus = 0, per_cu = 0;
        hipGetDevice(&dev);
        hipDeviceGetAttribute(&cus, hipDeviceAttributeMultiprocessorCount, dev);
        hipOccupancyMaxActiveBlocksPerMultiprocessor(&per_cu, mega, NTHREADS, 0);
        if (per_cu > 2) per_cu = 2;
        if (per_cu < 1) per_cu = 1;
        grid_blocks = cus * per_cu;
    }
    hipMemsetAsync(d_ws, 0, XCD_BAR_WORDS * 4, stream);
    void* args[] = {&p};
    hipError_t e = hipLaunchCooperativeKernel((void*)mega, dim3(grid_blocks), dim3(NTHREADS), args, 0, stream);
    if (e != hipSuccess) fprintf(stderr, "cooperative launch failed: %s (grid %d)\n", hipGetErrorString(e), grid_blocks);
}
```

```cpp
#include <hip/hip_runtime.h>
#include <hip/hip_cooperative_groups.h>
#include <stdio.h>
namespace cg = cooperative_groups;
#include <stdint.h>
#include <stddef.h>
#include <math.h>

typedef unsigned short bf16_t;
typedef short bf16x8 __attribute__((ext_vector_type(8)));
typedef float f32x4 __attribute__((ext_vector_type(4)));
typedef unsigned u32x4 __attribute__((ext_vector_type(4)));
typedef unsigned u32x2 __attribute__((ext_vector_type(2)));

constexpr int DM = 1024, NB = 8, SEQ = 2048, NTOK = NB * SEQ;
constexpr int ZC = 4992;
constexpr int ZQ_G = 0, ZK_G = 512, ZV_G = 1024, ZR_G = 2048, ZQ_N = 3072, ZKC = 4096, ZVC = 4224, ZKS = 4352, ZVS = 4480,
              ZKW = 4608, ZVW = 4736, ZGATE = 4864, ZLR = 4912;
constexpr int LDS_MAIN = 73728;
constexpr int LDS_BYTES = LDS_MAIN + 64;
constexpr int NTHREADS = 256;

constexpr size_t OFF_MOD = 16384;
constexpr size_t OFF_ROPE = 212992;
constexpr size_t OFF_CMP = 1261568;
constexpr size_t OFF_DEC = 1785856;
constexpr size_t OFF_K1B = 2310144;
constexpr size_t OFF_WC1 = 2834432;
constexpr size_t OFF_WIN = 4194304;
constexpr size_t OFF_WM = 14417920;
constexpr size_t OFF_WA = 18612224;
constexpr size_t OFF_WB = 20709376;
constexpr size_t OFF_WO = 22806528;
constexpr size_t OFF_WQ = 24903680;
constexpr size_t OFF_H = 29360128;
constexpr size_t OFF_M = 62914560;
constexpr size_t OFF_Z = 96468992;
constexpr size_t OFF_QP = OFF_Z;
constexpr size_t OFF_UB = OFF_Z + 67108864;
constexpr size_t OFF_VB = OFF_UB + 33554432;
constexpr size_t OFF_EIDX = OFF_VB + 33554432;
constexpr size_t OFF_GW = OFF_EIDX + 8388608;

struct Params {
    const float* x; const float* c; const int* pos; const float* ada_w; const float* ada_b;
    const float* norm1_g; const float* norm2_g; const float* final_g; const float* w_in;
    const float* gla_wa2; const float* gla_ba2; const float* gla_norm_g; const float* pe_k; const float* pe_v;
    const float* ck_w1; const float* ck_w2; const float* cv_w1; const float* cv_w2;
    const float* w_branch_a; const float* w_branch_b; const float* w_out; const float* peer_wq;
    const float* peer_k1; const float* peer_k2; const float* peer_u; const float* peer_v;
    float* out; char* ws;
};

__device__ __forceinline__ unsigned f2bf_u(float f) { unsigned u = __float_as_uint(f); return (u + 0x7fffu + ((u >> 16) & 1u)) >> 16; }
__device__ __forceinline__ bf16_t f2bf(float f) { return (bf16_t)f2bf_u(f); }
typedef float f32x2_ __attribute__((ext_vector_type(2)));
typedef __bf16 bf16x2_ __attribute__((ext_vector_type(2)));
__device__ __forceinline__ unsigned pack2(float lo, float hi) {
    const f32x2_ v = {lo, hi};
    return __builtin_bit_cast(unsigned, __builtin_convertvector(v, bf16x2_));
}
__device__ __forceinline__ float bf_lo(unsigned u) { return __uint_as_float(u << 16); }
__device__ __forceinline__ float bf_hi(unsigned u) { return __uint_as_float(u & 0xffff0000u); }
__device__ __forceinline__ float bf2f(bf16_t h) { return __uint_as_float(((unsigned)h) << 16); }
__device__ __forceinline__ float wave_sum(float v) {
#pragma unroll
    for (int o = 32; o > 0; o >>= 1) v += __shfl_xor(v, o, 64);
    return v;
}
__device__ __forceinline__ float wave_max(float v) {
#pragma unroll
    for (int o = 32; o > 0; o >>= 1) v = fmaxf(v, __shfl_xor(v, o, 64));
    return v;
}
__device__ __forceinline__ int launder_i(int x) { asm volatile("" : "+v"(x)); return x; }
#define TIDX launder_i((int)threadIdx.x)
__device__ __forceinline__ float exp2f_(float x) { return __builtin_amdgcn_exp2f(x); }
__device__ __forceinline__ float sigmoidf_(float x) { return __builtin_amdgcn_rcpf(1.f + __expf(-x)); }
__device__ __forceinline__ float siluf_(float x) { return x * __builtin_amdgcn_rcpf(1.f + __expf(-x)); }
__device__ __forceinline__ float gelu_erf(float x) { return 0.5f * x * (1.f + erff(x * 0.70710678118654752f)); }
__device__ __forceinline__ f32x4 mfma16(bf16x8 a, bf16x8 b, f32x4 c) { return __builtin_amdgcn_mfma_f32_16x16x32_bf16(a, b, c, 0, 0, 0); }
__device__ __forceinline__ bf16x8 ld_frag(const bf16_t* p) { return *(const bf16x8*)p; }
__device__ __forceinline__ bf16x8 mk_frag(u32x2 lo, u32x2 hi) { u32x4 t = {lo.x, lo.y, hi.x, hi.y}; return __builtin_bit_cast(bf16x8, t); }

#define WAIT_V(n) asm volatile("s_waitcnt vmcnt(" #n ")" ::: "memory")
__device__ __forceinline__ int swz4(int R) { return (4 - ((R >> 2) & 3)) & 3; }
__device__ __forceinline__ void glds16(const bf16_t* g, char* l) { __builtin_amdgcn_global_load_lds((const unsigned*)g, (unsigned*)l, 16, 0, 0); }
__device__ __forceinline__ void gemm_core(f32x4 (&acc)[8][4], const bf16_t* __restrict__ X, int ldx, const bf16_t* __restrict__ W, int ldw,
                                          int K, int m0, int n0, char* lds) {
    const int tid = TIDX, lane = tid & 63, wave = tid >> 6;
    const int wr = wave >> 1, wc = wave & 1, r = lane & 15, q = lane >> 4;
    const int KT = K / 32;
    const bf16_t* xsrc[4];
    const bf16_t* wsrc[2];
#pragma unroll
    for (int i = 0; i < 4; i++) { const int R = (wave * 4 + i) * 16 + (lane >> 2); xsrc[i] = X + (size_t)(m0 + R) * ldx + (((lane & 3) ^ swz4(R)) * 8); }
#pragma unroll
    for (int i = 0; i < 2; i++) { const int R = (wave * 2 + i) * 16 + (lane >> 2); wsrc[i] = W + (size_t)(n0 + R) * ldw + (((lane & 3) ^ swz4(R)) * 8); }
    char* xdst = lds + wave * 4096 + lane * 16;
    char* wdst = lds + 16384 + wave * 2048 + lane * 16;
#define GEMM_ISSUE(kt_, s_) do { \
        _Pragma("unroll") for (int i_ = 0; i_ < 4; i_++) glds16(xsrc[i_] + (kt_) * 32, xdst + (s_) * 24576 + i_ * 1024); \
        _Pragma("unroll") for (int i_ = 0; i_ < 2; i_++) glds16(wsrc[i_] + (kt_) * 32, wdst + (s_) * 24576 + i_ * 1024); } while (0)
    GEMM_ISSUE(0, 0);
    GEMM_ISSUE(1, 1);
    const int rdo = r * 64 + ((q ^ swz4(r)) * 16);
    int s_cur = 0, s_nxt = 2;
    for (int kt = 0; kt < KT; kt++) {
        if (kt + 1 < KT) WAIT_V(6); else WAIT_V(0);
        __builtin_amdgcn_s_barrier();
        if (kt + 2 < KT) GEMM_ISSUE(kt + 2, s_nxt);
        const char* st = lds + s_cur * 24576;
        bf16x8 af[4], bfr[8];
#pragma unroll
        for (int ni = 0; ni < 4; ni++) af[ni] = *(const bf16x8*)(st + 16384 + (wc * 64 + ni * 16) * 64 + rdo);
#pragma unroll
        for (int mi = 0; mi < 8; mi++) bfr[mi] = *(const bf16x8*)(st + (wr * 128 + mi * 16) * 64 + rdo);
#pragma unroll
        for (int mi = 0; mi < 8; mi++)
#pragma unroll
            for (int ni = 0; ni < 4; ni++) acc[mi][ni] = mfma16(af[ni], bfr[mi], acc[mi][ni]);
        s_cur = (s_cur == 2) ? 0 : s_cur + 1;
        s_nxt = (s_nxt == 2) ? 0 : s_nxt + 1;
        __builtin_amdgcn_sched_barrier(0);
    }
    __syncthreads();
}
__device__ __forceinline__ void zero_acc(f32x4 (&acc)[8][4]) {
#pragma unroll
    for (int a = 0; a < 8; a++)
#pragma unroll
        for (int b = 0; b < 4; b++) acc[a][b] = (f32x4){0.f, 0.f, 0.f, 0.f};
}

struct TileIter {
    int nt, i;
    __device__ TileIter(int ntiles_n, const char*) { nt = ntiles_n; i = blockIdx.x; }
    __device__ bool next(int& bm, int& bn) {
        if (i >= 64 * nt) return false;
        bn = i % nt; bm = i / nt; i += gridDim.x; return true;
    }
};

struct MapId { __device__ int operator()(int n) const { return n; } };
struct MapWin {
    __device__ int operator()(int n) const { return n < 3072 ? n : (n < 4912 ? n + 16 : (n < 4928 ? n - 1840 : -1)); }
};
struct MapOff { int off; __device__ int operator()(int n) const { return n + off; } };

template <class Map>
__device__ __forceinline__ void tconv_tile(const float* __restrict__ src, int ldsrc, bf16_t* __restrict__ dst, int ldd, int n0, int k0, Map map, float* t) {
    const int tid = TIDX;
    const int n = tid & 63, kb = tid >> 6;
    const int sc = map(n0 + n);
#pragma unroll
    for (int i = 0; i < 16; i++) { const int k = i * 4 + kb; t[k * 65 + n] = sc >= 0 ? src[(size_t)(k0 + k) * ldsrc + sc] : 0.f; }
    __syncthreads();
    const int nn = tid >> 2, kk = (tid & 3) * 16;
    unsigned w[8];
#pragma unroll
    for (int j = 0; j < 8; j++) w[j] = pack2(t[(kk + 2 * j) * 65 + nn], t[(kk + 2 * j + 1) * 65 + nn]);
    u32x4* d = (u32x4*)(dst + (size_t)(n0 + nn) * ldd + k0 + kk);
    d[0] = (u32x4){w[0], w[1], w[2], w[3]};
    d[1] = (u32x4){w[4], w[5], w[6], w[7]};
    __syncthreads();
}

constexpr int TA_MOD = 192, TA_WIN = 78 * 16, TA_WM = 32 * 16, TA_SQ = 16 * 16, TA_WQ = 32 * 16, TA_WC = 32, TA_K12 = 64, TA_ROPE = 512;
constexpr int TA_E0 = TA_MOD, TA_E1 = TA_E0 + TA_WIN, TA_E2 = TA_E1 + TA_WM, TA_E3 = TA_E2 + TA_SQ, TA_E4 = TA_E3 + TA_SQ, TA_E5 = TA_E4 + TA_SQ,
              TA_E6 = TA_E5 + TA_WQ, TA_E7 = TA_E6 + TA_WC, TA_E8 = TA_E7 + TA_WC, TA_E9 = TA_E8 + TA_K12, TA_E10 = TA_E9 + TA_K12, TA_E11 = TA_E10 + TA_ROPE;

__device__ void phaseA(const Params& p, char* lds) {
    const int tid = TIDX;
    float* fl = (float*)lds;
    for (int task = blockIdx.x; task < TA_E11; task += gridDim.x) {
        if (task < TA_E0) {
            float* sc = fl;
            float* red = fl + 8192;
            for (int i = tid; i < 8192; i += NTHREADS) sc[i] = siluf_(p.c[i]);
            __syncthreads();
            const int n = task * 32 + (tid & 31), kg = tid >> 5;
            float a[8];
#pragma unroll
            for (int b = 0; b < 8; b++) a[b] = 0.f;
            for (int k = kg * 128; k < kg * 128 + 128; k++) {
                const float w = p.ada_w[(size_t)k * 6144 + n];
#pragma unroll
                for (int b = 0; b < 8; b++) a[b] += sc[b * 1024 + k] * w;
            }
#pragma unroll
            for (int b = 0; b < 8; b++) red[(kg * 8 + b) * 32 + (tid & 31)] = a[b];
            __syncthreads();
            {
                const int b = tid >> 5, nn = tid & 31;
                float s = 0.f;
#pragma unroll
                for (int g = 0; g < 8; g++) s += red[(g * 8 + b) * 32 + nn];
                ((float*)(p.ws + OFF_MOD))[b * 6144 + task * 32 + nn] = s + p.ada_b[task * 32 + nn];
            }
            __syncthreads();
        } else if (task < TA_E1) {
            const int tt = task - TA_E0;
            tconv_tile(p.w_in, 6976, (bf16_t*)(p.ws + OFF_WIN), 1024, (tt >> 4) * 64, (tt & 15) * 64, MapWin(), fl);
        } else if (task < TA_E2) {
            const int tt = task - TA_E1;
            tconv_tile(p.w_in, 6976, (bf16_t*)(p.ws + OFF_WM), 1024, (tt >> 4) * 64, (tt & 15) * 64, MapOff{4928}, fl);
        } else if (task < TA_E3) {
            const int tt = task - TA_E2;
            tconv_tile(p.w_branch_a, 1024, (bf16_t*)(p.ws + OFF_WA), 1024, (tt >> 4) * 64, (tt & 15) * 64, MapId(), fl);
        } else if (task < TA_E4) {
            const int tt = task - TA_E3;
            tconv_tile(p.w_branch_b, 1024, (bf16_t*)(p.ws + OFF_WB), 1024, (tt >> 4) * 64, (tt & 15) * 64, MapId(), fl);
        } else if (task < TA_E5) {
            const int tt = task - TA_E4;
            tconv_tile(p.w_out, 1024, (bf16_t*)(p.ws + OFF_WO), 1024, (tt >> 4) * 64, (tt & 15) * 64, MapId(), fl);
        } else if (task < TA_E6) {
            const int tt = task - TA_E5;
            tconv_tile(p.peer_wq, 2048, (bf16_t*)(p.ws + OFF_WQ), 1024, (tt >> 4) * 64, (tt & 15) * 64, MapId(), fl);
        } else if (task < TA_E7) {
            const int tt = task - TA_E6;
            tconv_tile(p.ck_w1, 64, (bf16_t*)(p.ws + OFF_WC1), 2048, 0, tt * 64, MapId(), fl);
        } else if (task < TA_E8) {
            const int tt = task - TA_E7;
            tconv_tile(p.cv_w1, 64, (bf16_t*)(p.ws + OFF_WC1) + 64 * 2048, 2048, 0, tt * 64, MapId(), fl);
        } else if (task < TA_E10) {
            const bool second = task >= TA_E9;
            const int tt = task - (second ? TA_E9 : TA_E8);
            const float* src = second ? p.peer_k2 : p.peer_k1;
            bf16_t* dst = (bf16_t*)(p.ws + OFF_K1B) + (second ? 131072 : 0);
            const int i = tt * 2048 + tid * 8;
            const f32x4 a = *(const f32x4*)(src + i), b = *(const f32x4*)(src + i + 4);
            *(u32x4*)(dst + i) = (u32x4){pack2(a[0], a[1]), pack2(a[2], a[3]), pack2(b[0], b[1]), pack2(b[2], b[3])};
        } else {
            const int tt = task - TA_E10;
            const int e = tt * 256 + tid;
            const int tok = e >> 3, i = e & 7;
            const float invf[8] = {1.0f, 0.1939227432012558f, 0.03760603070259094f, 0.007292664609849453f,
                                   0.0014142135623842478f, 0.00027424818836152554f, 5.318296098266728e-05f, 1.0313386155758053e-05f};
            float fr = invf[0];
#pragma unroll
            for (int j = 1; j < 8; j++) fr = (i == j) ? invf[j] : fr;
            const float ang = (float)p.pos[tok] * fr;
            const double rev = (double)ang * 0.15915494309189533577;
            const float fpart = (float)(rev - floor(rev));
            float* cs = (float*)(p.ws + OFF_ROPE);
            cs[e * 2] = __builtin_amdgcn_cosf(fpart);
            cs[e * 2 + 1] = __builtin_amdgcn_sinf(fpart);
        }
    }
}

__device__ void phase_modnorm(const Params& p, const float* __restrict__ src, const float* __restrict__ g, int shift_idx, int scale_idx, bf16_t* __restrict__ dst) {
    const int tid_ = TIDX; const int lane = tid_ & 63, wave = tid_ >> 6;
    const float* mod = (const float*)(p.ws + OFF_MOD);
    for (int tok = blockIdx.x * 4 + wave; tok < NTOK; tok += gridDim.x * 4) {
        const int b = tok >> 11;
        const float* xr = src + (size_t)tok * DM;
        f32x4 v[4];
        float ss = 0.f;
#pragma unroll
        for (int c = 0; c < 4; c++) { v[c] = *(const f32x4*)(xr + c * 256 + lane * 4); ss += v[c][0] * v[c][0] + v[c][1] * v[c][1] + v[c][2] * v[c][2] + v[c][3] * v[c][3]; }
        ss = wave_sum(ss);
        const float rstd = rsqrtf(ss * (1.f / 1024.f) + 1e-6f);
#pragma unroll
        for (int c = 0; c < 4; c++) {
            const int d = c * 256 + lane * 4;
            const f32x4 gg = *(const f32x4*)(g + d);
            const f32x4 sc = *(const f32x4*)(mod + b * 6144 + scale_idx * 1024 + d);
            const f32x4 sh = *(const f32x4*)(mod + b * 6144 + shift_idx * 1024 + d);
            float o[4];
#pragma unroll
            for (int j = 0; j < 4; j++) o[j] = (v[c][j] * rstd) * gg[j] * (1.f + sc[j]) + sh[j];
            *(u32x2*)(dst + (size_t)tok * DM + d) = (u32x2){pack2(o[0], o[1]), pack2(o[2], o[3])};
        }
    }
}

__device__ void phaseC(const Params& p, char* lds) {
    const int tid_ = TIDX; const int lane = tid_ & 63, wave = tid_ >> 6;
    const int wr = wave >> 1, wc = wave & 1, r = lane & 15, q = lane >> 4;
    const bf16_t* H = (const bf16_t*)(p.ws + OFF_H);
    const bf16_t* W = (const bf16_t*)(p.ws + OFF_WIN);
    bf16_t* Z = (bf16_t*)(p.ws + OFF_Z);
    const float* cs = (const float*)(p.ws + OFF_ROPE);
    constexpr int NTN = ZC / 128;
    TileIter tit(NTN, lds);
    int bm, bn;
    while (tit.next(bm, bn)) {
        const int m0 = bm * 256, n0 = bn * 128;
        f32x4 acc[8][4];
        zero_acc(acc);
        gemm_core(acc, H, DM, W, DM, DM, m0, n0, lds);
        const bool rope = (bn >= 24 && bn <= 31) || bn == 32 || bn == 34 || bn == 36;
        const float scl = (bn >= 24 && bn <= 31) ? 0.18033688011112042f : 1.f;
#pragma unroll
        for (int mi = 0; mi < 8; mi++) {
            const int tok = m0 + wr * 128 + mi * 16 + r;
            if (rope) {
                f32x4 v = acc[mi][0];
                f32x4 pr;
#pragma unroll
                for (int j = 0; j < 4; j++) pr[j] = __shfl_xor(v[j], 32, 64);
                const int ib = (q & 1) * 4;
                const f32x4 c0 = *(const f32x4*)(cs + (size_t)tok * 16 + ib * 2);
                const f32x4 c1 = *(const f32x4*)(cs + (size_t)tok * 16 + ib * 2 + 4);
                const float cc[4] = {c0[0], c0[2], c1[0], c1[2]}, sn[4] = {c0[1], c0[3], c1[1], c1[3]};
#pragma unroll
                for (int j = 0; j < 4; j++) v[j] = (q < 2) ? (v[j] * cc[j] - pr[j] * sn[j]) : (v[j] * cc[j] + pr[j] * sn[j]);
                acc[mi][0] = v;
            }
#pragma unroll
            for (int ni = 0; ni < 4; ni++) {
                const f32x4 v = acc[mi][ni] * scl;
                *(u32x2*)(Z + (size_t)tok * ZC + n0 + wc * 64 + ni * 16 + q * 4) = (u32x2){pack2(v[0], v[1]), pack2(v[2], v[3])};
            }
        }
    }
}

__device__ __forceinline__ void gla_prep(const Params& p, int tok0, int h, char* lds) {
    const int tid = TIDX;
    float* bc = (float*)lds;
    float* lrs = (float*)(lds + 32768);
    const bf16_t* Z = (const bf16_t*)(p.ws + OFF_Z);
    for (int i = tid; i < 1024; i += NTHREADS) { const int t = i >> 4, rr = i & 15; lrs[i] = bf2f(Z[(size_t)(tok0 + t) * ZC + ZLR + rr]); }
    const int d = tid & 127, th = tid >> 7;
    float w[16];
#pragma unroll
    for (int rr = 0; rr < 16; rr++) w[rr] = p.gla_wa2[rr * 512 + h * 128 + d];
    const float bias = p.gla_ba2[h * 128 + d];
    __syncthreads();
    float run = 0.f;
    for (int t = th * 32; t < th * 32 + 32; t++) {
        float xv = bias;
#pragma unroll
        for (int rr = 0; rr < 16; rr++) xv += lrs[t * 16 + rr] * w[rr];
        const float ls = fminf(xv, 0.f) - log1pf(__expf(-fabsf(xv)));
        run += ls * (1.f / 16.f);
        bc[t * 128 + d] = run;
    }
    __syncthreads();
    if (th == 1) {
        const float add = bc[31 * 128 + d];
        for (int t = 32; t < 64; t++) bc[t * 128 + d] += add;
    }
    __syncthreads();
}

__device__ void phaseG1_task(const Params& p, int task, char* lds) {
    const int tid = TIDX, lane = tid & 63, wave = tid >> 6, r = lane & 15, q = lane >> 4;
    const int c = task & 31, h = (task >> 5) & 3, b = task >> 7;
    const int tok0 = b * SEQ + c * 64;
    const bf16_t* Z = (const bf16_t*)(p.ws + OFF_Z);
    bf16_t* L = (bf16_t*)p.out;
    float* bc = (float*)lds;
    bf16_t* klT = (bf16_t*)(lds + 36864);
    bf16_t* vT = (bf16_t*)(lds + 36864 + 18432);
    gla_prep(p, tok0, h, lds);
    if (tid < 128) ((float*)(p.ws + OFF_DEC))[task * 128 + tid] = __expf(bc[63 * 128 + tid]);
    {
        const int s = lane, dc = wave * 32;
        const bf16_t* kp = Z + (size_t)(tok0 + s) * ZC + ZK_G + h * 128 + dc;
#pragma unroll
        for (int v4 = 0; v4 < 4; v4++) {
            const u32x4 kv = *(const u32x4*)(kp + v4 * 8);
            const unsigned kw[4] = {kv.x, kv.y, kv.z, kv.w};
#pragma unroll
            for (int j = 0; j < 8; j++) {
                const int d = dc + v4 * 8 + j;
                const float kval = (j & 1) ? bf_hi(kw[j >> 1]) : bf_lo(kw[j >> 1]);
                klT[d * 72 + s] = f2bf(kval * __expf(bc[63 * 128 + d] - bc[s * 128 + d]));
            }
        }
    }
    for (int eh = 0; eh < 2; eh++) {
        __syncthreads();
        {
            const int s = lane, ec = wave * 32;
            const bf16_t* vp = Z + (size_t)(tok0 + s) * ZC + ZV_G + h * 256 + eh * 128 + ec;
#pragma unroll
            for (int v4 = 0; v4 < 4; v4++) {
                const u32x4 vv = *(const u32x4*)(vp + v4 * 8);
                const unsigned vw[4] = {vv.x, vv.y, vv.z, vv.w};
#pragma unroll
                for (int j = 0; j < 8; j++) vT[(ec + v4 * 8 + j) * 72 + s] = (bf16_t)((j & 1) ? (vw[j >> 1] >> 16) : (vw[j >> 1] & 0xffffu));
            }
        }
        __syncthreads();
        f32x4 acc[8][2];
#pragma unroll
        for (int dt = 0; dt < 8; dt++) { acc[dt][0] = (f32x4){0.f, 0.f, 0.f, 0.f}; acc[dt][1] = (f32x4){0.f, 0.f, 0.f, 0.f}; }
#pragma unroll
        for (int ks = 0; ks < 2; ks++) {
            bf16x8 bv[2];
#pragma unroll
            for (int x = 0; x < 2; x++) bv[x] = ld_frag(vT + ((2 * wave + x) * 16 + r) * 72 + ks * 32 + q * 8);
#pragma unroll
            for (int dt = 0; dt < 8; dt++) {
                const bf16x8 a = ld_frag(klT + (dt * 16 + r) * 72 + ks * 32 + q * 8);
#pragma unroll
                for (int x = 0; x < 2; x++) acc[dt][x] = mfma16(a, bv[x], acc[dt][x]);
            }
        }
#pragma unroll
        for (int dt = 0; dt < 8; dt++)
#pragma unroll
            for (int x = 0; x < 2; x++) {
                const int e = eh * 128 + (2 * wave + x) * 16 + r, d = dt * 16 + 4 * q;
                const f32x4 v = acc[dt][x];
                *(u32x2*)(L + ((size_t)task * 256 + e) * 128 + d) = (u32x2){pack2(v[0], v[1]), pack2(v[2], v[3])};
            }
    }
    __syncthreads();
}

__device__ void phaseG2(const Params& p) {
    bf16_t* L = (bf16_t*)p.out;
    const float* dec = (const float*)(p.ws + OFF_DEC);
    for (int idx = blockIdx.x * NTHREADS + threadIdx.x; idx < 32 * 256 * 16; idx += gridDim.x * NTHREADS) {
        const int d8 = idx & 15, e = (idx >> 4) & 255, bh = idx >> 12;
        float st[8];
#pragma unroll
        for (int j = 0; j < 8; j++) st[j] = 0.f;
        for (int c = 0; c < 32; c++) {
            const int task = bh * 32 + c;
            u32x4* ptr = (u32x4*)(L + ((size_t)task * 256 + e) * 128 + d8 * 8);
            const u32x4 lv = *ptr;
            const f32x4 d0 = *(const f32x4*)(dec + task * 128 + d8 * 8), d1 = *(const f32x4*)(dec + task * 128 + d8 * 8 + 4);
            *ptr = (u32x4){pack2(st[0], st[1]), pack2(st[2], st[3]), pack2(st[4], st[5]), pack2(st[6], st[7])};
            st[0] = d0[0] * st[0] + bf_lo(lv.x); st[1] = d0[1] * st[1] + bf_hi(lv.x);
            st[2] = d0[2] * st[2] + bf_lo(lv.y); st[3] = d0[3] * st[3] + bf_hi(lv.y);
            st[4] = d1[0] * st[4] + bf_lo(lv.z); st[5] = d1[1] * st[5] + bf_hi(lv.z);
            st[6] = d1[2] * st[6] + bf_lo(lv.w); st[7] = d1[3] * st[7] + bf_hi(lv.w);
        }
    }
}

__device__ void phaseG3_task(const Params& p, int task, char* lds, bf16_t* ydst, int ystride) {
    const int tid = TIDX, lane = tid & 63, wave = tid >> 6, r = lane & 15, q = lane >> 4;
    const int c = task & 31, h = (task >> 5) & 3, b = task >> 7;
    const int tok0 = b * SEQ + c * 64;
    bf16_t* Z = (bf16_t*)(p.ws + OFF_Z);
    const bf16_t* ST = (const bf16_t*)p.out + (size_t)task * 256 * 128;
    float* bc = (float*)lds;
    bf16_t* vT = (bf16_t*)lds;
    bf16_t* qg = (bf16_t*)(lds + 36864);
    bf16_t* kg = (bf16_t*)(lds + 36864 + 17408);
    bf16_t* P = kg;
    float* red = (float*)(lds + 36864 + 2 * 17408);
    gla_prep(p, tok0, h, lds);
    {
        const int t = tid >> 2, dc = (tid & 3) * 32;
        const bf16_t* qp = Z + (size_t)(tok0 + t) * ZC + ZQ_G + h * 128 + dc;
        const bf16_t* kp = Z + (size_t)(tok0 + t) * ZC + ZK_G + h * 128 + dc;
#pragma unroll
        for (int v4 = 0; v4 < 4; v4++) {
            const u32x4 qv = *(const u32x4*)(qp + v4 * 8), kv = *(const u32x4*)(kp + v4 * 8);
            const unsigned qw[4] = {qv.x, qv.y, qv.z, qv.w}, kw[4] = {kv.x, kv.y, kv.z, kv.w};
            unsigned qo[4], ko[4];
#pragma unroll
            for (int j2 = 0; j2 < 4; j2++) {
                const int d = dc + v4 * 8 + j2 * 2;
                const float b0 = bc[t * 128 + d], b1 = bc[t * 128 + d + 1];
                qo[j2] = pack2(bf_lo(qw[j2]) * 0.08838834764831845f * __expf(b0), bf_hi(qw[j2]) * 0.08838834764831845f * __expf(b1));
                ko[j2] = pack2(bf_lo(kw[j2]) * __expf(-b0), bf_hi(kw[j2]) * __expf(-b1));
            }
            *(u32x4*)(qg + t * 136 + dc + v4 * 8) = (u32x4){qo[0], qo[1], qo[2], qo[3]};
            *(u32x4*)(kg + t * 136 + dc + v4 * 8) = (u32x4){ko[0], ko[1], ko[2], ko[3]};
        }
    }
    __syncthreads();
    {
        const int s = lane, ec = wave * 64;
        const bf16_t* vp = Z + (size_t)(tok0 + s) * ZC + ZV_G + h * 256 + ec;
#pragma unroll
        for (int v4 = 0; v4 < 8; v4++) {
            const u32x4 vv = *(const u32x4*)(vp + v4 * 8);
            const unsigned vw[4] = {vv.x, vv.y, vv.z, vv.w};
#pragma unroll
            for (int j = 0; j < 8; j++) vT[(ec + v4 * 8 + j) * 72 + s] = (bf16_t)((j & 1) ? (vw[j >> 1] >> 16) : (vw[j >> 1] & 0xffffu));
        }
    }
    f32x4 sc[4];
#pragma unroll
    for (int st = 0; st < 4; st++) sc[st] = (f32x4){0.f, 0.f, 0.f, 0.f};
    {
        bf16x8 qf[4];
#pragma unroll
        for (int ks = 0; ks < 4; ks++) qf[ks] = ld_frag(qg + (wave * 16 + r) * 136 + ks * 32 + q * 8);
#pragma unroll
        for (int st = 0; st < 4; st++) {
            if (st <= wave) {
#pragma unroll
                for (int ks = 0; ks < 4; ks++) sc[st] = mfma16(ld_frag(kg + (st * 16 + r) * 136 + ks * 32 + q * 8), qf[ks], sc[st]);
            }
        }
    }
    __syncthreads();
    {
        const int t = wave * 16 + r;
#pragma unroll
        for (int st = 0; st < 4; st++) {
            float pv[4];
#pragma unroll
            for (int j = 0; j < 4; j++) { const int s = st * 16 + 4 * q + j; pv[j] = (s <= t) ? sc[st][j] : 0.f; }
            *(u32x2*)(P + t * 72 + st * 16 + 4 * q) = (u32x2){pack2(pv[0], pv[1]), pack2(pv[2], pv[3])};
        }
    }
    __syncthreads();
    f32x4 o[4][4];
#pragma unroll
    for (int et = 0; et < 4; et++)
#pragma unroll
        for (int tt = 0; tt < 4; tt++) o[et][tt] = (f32x4){0.f, 0.f, 0.f, 0.f};
#pragma unroll
    for (int ks = 0; ks < 2; ks++) {
        bf16x8 pf[4];
#pragma unroll
        for (int tt = 0; tt < 4; tt++) pf[tt] = ld_frag(P + (tt * 16 + r) * 72 + ks * 32 + q * 8);
#pragma unroll
        for (int et = 0; et < 4; et++) {
            const bf16x8 a = ld_frag(vT + ((wave * 4 + et) * 16 + r) * 72 + ks * 32 + q * 8);
#pragma unroll
            for (int tt = 0; tt < 4; tt++) o[et][tt] = mfma16(a, pf[tt], o[et][tt]);
        }
    }
#pragma unroll
    for (int ks = 0; ks < 4; ks++) {
        bf16x8 qf[4];
#pragma unroll
        for (int tt = 0; tt < 4; tt++) qf[tt] = ld_frag(qg + (tt * 16 + r) * 136 + ks * 32 + q * 8);
#pragma unroll
        for (int et = 0; et < 4; et++) {
            const bf16x8 a = *(const bf16x8*)(ST + (size_t)((wave * 4 + et) * 16 + r) * 128 + ks * 32 + q * 8);
#pragma unroll
            for (int tt = 0; tt < 4; tt++) o[et][tt] = mfma16(a, qf[tt], o[et][tt]);
        }
    }
#pragma unroll
    for (int tt = 0; tt < 4; tt++) {
        float ss = 0.f;
#pragma unroll
        for (int et = 0; et < 4; et++)
#pragma unroll
            for (int j = 0; j < 4; j++) ss += o[et][tt][j] * o[et][tt][j];
        ss += __shfl_xor(ss, 16, 64);
        ss += __shfl_xor(ss, 32, 64);
        if (q == 0) red[wave * 64 + tt * 16 + r] = ss;
    }
    __syncthreads();
#pragma unroll
    for (int tt = 0; tt < 4; tt++) {
        const int t = tt * 16 + r;
        const float tot = red[t] + red[64 + t] + red[128 + t] + red[192 + t];
        const float rstd = rsqrtf(tot * (1.f / 256.f) + 1e-6f);
#pragma unroll
        for (int et = 0; et < 4; et++) {
            const int e = (wave * 4 + et) * 16 + 4 * q;
            bf16_t* rp = Z + (size_t)(tok0 + t) * ZC + ZR_G + h * 256 + e;
            const u32x2 rv = *(const u32x2*)rp;
            const f32x4 gn = *(const f32x4*)(p.gla_norm_g + e);
            const float r0 = bf_lo(rv.x), r1 = bf_hi(rv.x), r2 = bf_lo(rv.y), r3 = bf_hi(rv.y);
            const f32x4 ov = o[et][tt];
            *(u32x2*)(ydst + (size_t)(tok0 + t) * ystride + h * 256 + e) = (u32x2){pack2(ov[0] * rstd * gn[0] * siluf_(r0), ov[1] * rstd * gn[1] * siluf_(r1)),
                                  pack2(ov[2] * rstd * gn[2] * siluf_(r2), ov[3] * rstd * gn[3] * siluf_(r3))};
        }
    }
    __syncthreads();
}

__device__ void phaseN1_task(const Params& p, int task, char* lds) {
    const int tid = TIDX, lane = tid & 63, wave = tid >> 6, r = lane & 15, q = lane >> 4;
    const int it = task & 7, g = (task >> 3) & 1, b = (task >> 4) & 7, kv = task >> 7;
    const bf16_t* Z = (const bf16_t*)(p.ws + OFF_Z);
    const bf16_t* W1 = (const bf16_t*)(p.ws + OFF_WC1) + (size_t)kv * 64 * 2048;
    const float* pe = kv ? p.pe_v : p.pe_k;
    const float* w2 = kv ? p.cv_w2 : p.ck_w2;
    const int zoff = (kv ? ZVC : ZKC) + g * 64;
    float* hid = (float*)lds;
    float* hid2 = (float*)(lds + 16384);
    int i = it * 16 + r; if (i > 126) i = 126;
    f32x4 acc[4];
#pragma unroll
    for (int nt = 0; nt < 4; nt++) acc[nt] = (f32x4){0.f, 0.f, 0.f, 0.f};
    for (int ks = 0; ks < 16; ks++) {
        const int k = wave * 512 + ks * 32 + q * 8;
        const int l = k >> 6, d = k & 63;
        const u32x4 zv = *(const u32x4*)(Z + (size_t)(b * SEQ + i * 16 + l) * ZC + zoff + d);
        const f32x4 p0 = *(const f32x4*)(pe + l * 64 + d), p1 = *(const f32x4*)(pe + l * 64 + d + 4);
        const u32x4 av = {pack2(bf_lo(zv.x) + p0[0], bf_hi(zv.x) + p0[1]), pack2(bf_lo(zv.y) + p0[2], bf_hi(zv.y) + p0[3]),
                          pack2(bf_lo(zv.z) + p1[0], bf_hi(zv.z) + p1[1]), pack2(bf_lo(zv.w) + p1[2], bf_hi(zv.w) + p1[3])};
        const bf16x8 a = __builtin_bit_cast(bf16x8, av);
#pragma unroll
        for (int nt = 0; nt < 4; nt++) {
            const bf16x8 bw = *(const bf16x8*)(W1 + (size_t)(nt * 16 + r) * 2048 + k);
            acc[nt] = mfma16(a, bw, acc[nt]);
        }
    }
#pragma unroll
    for (int nt = 0; nt < 4; nt++)
#pragma unroll
        for (int j = 0; j < 4; j++) hid[(wave * 16 + 4 * q + j) * 64 + nt * 16 + r] = acc[nt][j];
    __syncthreads();
    for (int e = tid; e < 1024; e += NTHREADS) hid2[e] = gelu_erf(hid[e] + hid[1024 + e] + hid[2048 + e] + hid[3072 + e]);
    __syncthreads();
    {
        const int il = tid >> 4, n2 = (tid & 15) * 4;
        f32x4 o = {0.f, 0.f, 0.f, 0.f};
        for (int n = 0; n < 64; n++) {
            const float hv = hid2[il * 64 + n];
            const f32x4 wv = *(const f32x4*)(w2 + n * 64 + n2);
            o += hv * wv;
        }
        const int ig = it * 16 + il;
        if (ig >= 127) o = (f32x4){0.f, 0.f, 0.f, 0.f};
        bf16_t* dst = (bf16_t*)(p.ws + OFF_CMP) + ((size_t)((kv * 8 + b) * 2 + g) * 128 + ig) * 64 + n2;
        *(u32x2*)dst = (u32x2){pack2(o[0], o[1]), pack2(o[2], o[3])};
    }
    __syncthreads();
}

__device__ __forceinline__ void nsa_load_kv(const bf16_t* __restrict__ kbase, const bf16_t* __restrict__ vbase, size_t rowstride, bf16_t* Ks, bf16_t* VT) {
    const int tid = TIDX;
    {
        const int key = tid >> 2, ch = (tid & 3) * 16;
        const u32x4 a = *(const u32x4*)(kbase + (size_t)key * rowstride + ch), b = *(const u32x4*)(kbase + (size_t)key * rowstride + ch + 8);
        *(u32x4*)(Ks + key * 72 + ch) = a;
        *(u32x4*)(Ks + key * 72 + ch + 8) = b;
    }
    {
        const int key = tid & 63, dc = (tid >> 6) * 16;
        const u32x4 a = *(const u32x4*)(vbase + (size_t)key * rowstride + dc), b = *(const u32x4*)(vbase + (size_t)key * rowstride + dc + 8);
        const unsigned w[8] = {a.x, a.y, a.z, a.w, b.x, b.y, b.z, b.w};
#pragma unroll
        for (int j = 0; j < 16; j++) VT[(dc + j) * 72 + key] = (bf16_t)((j & 1) ? (w[j >> 1] >> 16) : (w[j >> 1] & 0xffffu));
    }
}

__device__ __forceinline__ void nsa_block_step(const bf16_t* Ks, const bf16_t* VT, const bf16x8 (&qf)[2][2], f32x4 (&O)[2][4], float (&m)[2], float (&l)[2],
                                               int klo, int khi, int r, int q) {
    f32x4 s[2][4];
#pragma unroll
    for (int x = 0; x < 2; x++)
#pragma unroll
        for (int kt = 0; kt < 4; kt++) s[x][kt] = (f32x4){0.f, 0.f, 0.f, 0.f};
#pragma unroll
    for (int kt = 0; kt < 4; kt++)
#pragma unroll
        for (int ks = 0; ks < 2; ks++) {
            const bf16x8 kf = ld_frag(Ks + (kt * 16 + r) * 64 + (((ks * 4 + q) ^ (r & 7)) * 8));
#pragma unroll
            for (int x = 0; x < 2; x++) s[x][kt] = mfma16(kf, qf[x][ks], s[x][kt]);
        }
    __builtin_amdgcn_sched_barrier(0);
    if (!__all((klo <= 0) && (khi >= 63))) {
        const int a = 4 * q - klo;
        const unsigned range = (unsigned)(khi - klo);
        const bool any = khi >= klo;
#pragma unroll
        for (int kt = 0; kt < 4; kt++)
#pragma unroll
            for (int j = 0; j < 4; j++) {
                const bool valid = any && ((unsigned)(kt * 16 + j + a) <= range);
#pragma unroll
                for (int x = 0; x < 2; x++) s[x][kt][j] = valid ? s[x][kt][j] : -3.0e38f;
            }
    }
    bf16x8 pbv[2][2];
#pragma unroll
    for (int x = 0; x < 2; x++) {
        float mx = fmaxf(fmaxf(fmaxf(s[x][0][0], s[x][0][1]), fmaxf(s[x][0][2], s[x][0][3])), fmaxf(fmaxf(s[x][1][0], s[x][1][1]), fmaxf(s[x][1][2], s[x][1][3])));
        mx = fmaxf(mx, fmaxf(fmaxf(fmaxf(s[x][2][0], s[x][2][1]), fmaxf(s[x][2][2], s[x][2][3])), fmaxf(fmaxf(s[x][3][0], s[x][3][1]), fmaxf(s[x][3][2], s[x][3][3]))));
        mx = fmaxf(mx, __shfl_xor(mx, 16, 64));
        mx = fmaxf(mx, __shfl_xor(mx, 32, 64));
        const float mnew = fmaxf(m[x], mx);
        const float alpha = exp2f_(m[x] - mnew);
        m[x] = mnew;
        float ls = 0.f;
#pragma unroll
        for (int kt = 0; kt < 4; kt++)
#pragma unroll
            for (int j = 0; j < 4; j++) { const float pv = exp2f_(s[x][kt][j] - mnew); s[x][kt][j] = pv; ls += pv; }
        l[x] = l[x] * alpha + ls;
#pragma unroll
        for (int dt = 0; dt < 4; dt++) O[x][dt] *= alpha;
#pragma unroll
        for (int s2 = 0; s2 < 2; s2++) {
            const u32x4 t4 = {pack2(s[x][2 * s2][0], s[x][2 * s2][1]), pack2(s[x][2 * s2][2], s[x][2 * s2][3]),
                              pack2(s[x][2 * s2 + 1][0], s[x][2 * s2 + 1][1]), pack2(s[x][2 * s2 + 1][2], s[x][2 * s2 + 1][3])};
            pbv[x][s2] = __builtin_bit_cast(bf16x8, t4);
        }
    }
    __builtin_amdgcn_sched_barrier(0);
#pragma unroll
    for (int s2 = 0; s2 < 2; s2++)
#pragma unroll
        for (int dt = 0; dt < 4; dt++) {
            const u32x2 lo = *(const u32x2*)(VT + (dt * 16 + r) * 72 + (2 * s2) * 16 + 4 * q);
            const u32x2 hi = *(const u32x2*)(VT + (dt * 16 + r) * 72 + (2 * s2 + 1) * 16 + 4 * q);
            const bf16x8 va = mk_frag(lo, hi);
#pragma unroll
            for (int x = 0; x < 2; x++) O[x][dt] = mfma16(va, pbv[x][s2], O[x][dt]);
        }
    __builtin_amdgcn_sched_barrier(0);
}

__device__ __forceinline__ void nsa_cmp_probs(const bf16_t* Kc, const bf16x8 (&qfx)[2], int nv, int r, int q, f32x4 (&s)[8]) {
#pragma unroll
    for (int kt = 0; kt < 8; kt++) s[kt] = (f32x4){0.f, 0.f, 0.f, 0.f};
#pragma unroll
    for (int kt = 0; kt < 8; kt++)
#pragma unroll
        for (int ks = 0; ks < 2; ks++) s[kt] = mfma16(ld_frag(Kc + (kt * 16 + r) * 72 + ks * 32 + q * 8), qfx[ks], s[kt]);
    __builtin_amdgcn_sched_barrier(0);
    float mx = -1e30f;
#pragma unroll
    for (int kt = 0; kt < 8; kt++)
#pragma unroll
        for (int j = 0; j < 4; j++) if (kt * 16 + 4 * q + j < nv) mx = fmaxf(mx, s[kt][j]);
    mx = fmaxf(mx, __shfl_xor(mx, 16, 64));
    mx = fmaxf(mx, __shfl_xor(mx, 32, 64));
    float ls = 0.f;
#pragma unroll
    for (int kt = 0; kt < 8; kt++)
#pragma unroll
        for (int j = 0; j < 4; j++) {
            const float pv = (kt * 16 + 4 * q + j < nv) ? exp2f_(s[kt][j] - mx) : 0.f;
            s[kt][j] = pv; ls += pv;
        }
    ls += __shfl_xor(ls, 16, 64);
    ls += __shfl_xor(ls, 32, 64);
    const float inv = nv > 0 ? 1.f / ls : 0.f;
#pragma unroll
    for (int kt = 0; kt < 8; kt++) s[kt] *= inv;
}

__device__ void phaseN2_task(const Params& p, int task, char* lds, bf16_t* ydst, int ystride) {
    const int tid = TIDX, lane = tid & 63, wave = tid >> 6, r = lane & 15, q = lane >> 4;
    const int tt = 127 - (task >> 4), g = task & 1, b = (task >> 1) & 7;
    const int t0 = tt * 16, t = t0 + r;
    const int cur = t0 >> 6;
    bf16_t* Z = (bf16_t*)(p.ws + OFF_Z);
    const size_t rowb = (size_t)b * SEQ;
    bf16_t* Kc = (bf16_t*)lds;
    bf16_t* VcT = (bf16_t*)(lds + 18432);
    bf16_t* Ks = (bf16_t*)lds;
    bf16_t* VT = (bf16_t*)(lds + 18432);
    float* impw = (float*)(lds + 35840);
    float* scs = (float*)(lds + 35840 + 32768);
    unsigned* selm = (unsigned*)(lds + 35840 + 32768 + 2048);

    bf16x8 qf[2][2];
#pragma unroll
    for (int x = 0; x < 2; x++)
#pragma unroll
        for (int ks = 0; ks < 2; ks++) qf[x][ks] = *(const bf16x8*)(Z + (rowb + t) * ZC + ZQ_N + (g * 8 + 2 * wave + x) * 64 + ks * 32 + q * 8);
    f32x4* ofl = (f32x4*)(lds + 35840);

    f32x4 Og[2][4];
    {
        const bf16_t* kc = (const bf16_t*)(p.ws + OFF_CMP) + (size_t)((0 * 8 + b) * 2 + g) * 128 * 64;
        const bf16_t* vc = (const bf16_t*)(p.ws + OFF_CMP) + (size_t)((1 * 8 + b) * 2 + g) * 128 * 64;
        {
            const int key = tid >> 1, ch = (tid & 1) * 32;
#pragma unroll
            for (int v4 = 0; v4 < 4; v4++) *(u32x4*)(Kc + key * 72 + ch + v4 * 8) = *(const u32x4*)(kc + key * 64 + ch + v4 * 8);
            const int k2 = tid & 127, dc = (tid >> 7) * 32;
#pragma unroll
            for (int v4 = 0; v4 < 4; v4++) {
                const u32x4 a = *(const u32x4*)(vc + k2 * 64 + dc + v4 * 8);
                const unsigned w[4] = {a.x, a.y, a.z, a.w};
#pragma unroll
                for (int j = 0; j < 8; j++) VcT[(dc + v4 * 8 + j) * 136 + k2] = (bf16_t)((j & 1) ? (w[j >> 1] >> 16) : (w[j >> 1] & 0xffffu));
            }
        }
        __syncthreads();
        int nv = t >= 31 ? ((t - 31) >> 4) + 1 : 0;
        if (nv > 127) nv = 127;
        f32x4 isum[8];
#pragma unroll
        for (int kt = 0; kt < 8; kt++) isum[kt] = (f32x4){0.f, 0.f, 0.f, 0.f};
#pragma unroll
        for (int x = 0; x < 2; x++) {
            f32x4 s[8];
            nsa_cmp_probs(Kc, qf[x], nv, r, q, s);
#pragma unroll
            for (int kt = 0; kt < 8; kt++) isum[kt] += s[kt];
            f32x4 Oc[4];
#pragma unroll
            for (int dt = 0; dt < 4; dt++) Oc[dt] = (f32x4){0.f, 0.f, 0.f, 0.f};
            __builtin_amdgcn_sched_barrier(0);
#pragma unroll
            for (int s2 = 0; s2 < 4; s2++) {
                const u32x4 t4 = {pack2(s[2 * s2][0], s[2 * s2][1]), pack2(s[2 * s2][2], s[2 * s2][3]),
                                  pack2(s[2 * s2 + 1][0], s[2 * s2 + 1][1]), pack2(s[2 * s2 + 1][2], s[2 * s2 + 1][3])};
                const bf16x8 pbv = __builtin_bit_cast(bf16x8, t4);
#pragma unroll
                for (int dt = 0; dt < 4; dt++) {
                    const u32x2 lo = *(const u32x2*)(VcT + (dt * 16 + r) * 136 + (2 * s2) * 16 + 4 * q);
                    const u32x2 hi = *(const u32x2*)(VcT + (dt * 16 + r) * 136 + (2 * s2 + 1) * 16 + 4 * q);
                    Oc[dt] = mfma16(mk_frag(lo, hi), pbv, Oc[dt]);
                }
            }
            const float g0 = sigmoidf_(bf2f(Z[(rowb + t) * ZC + ZGATE + 0 * 16 + g * 8 + 2 * wave + x]));
#pragma unroll
            for (int dt = 0; dt < 4; dt++) Og[x][dt] = g0 * Oc[dt];
            __builtin_amdgcn_sched_barrier(0);
        }
#pragma unroll
        for (int kt = 0; kt < 8; kt++) *(f32x4*)(impw + (wave * 16 + r) * 128 + kt * 16 + 4 * q) = isum[kt];
        __syncthreads();
#pragma unroll
        for (int pass = 0; pass < 2; pass++) {
            const int tk = pass * 8 + (tid >> 5), j = tid & 31;
            const int i0 = j == 0 ? 0 : 4 * j - 1, i1 = (4 * j + 3 > 126) ? 126 : 4 * j + 3;
            float sc = 0.f;
            for (int i = i0; i <= i1; i++) sc += (impw[(0 * 16 + tk) * 128 + i] + impw[(1 * 16 + tk) * 128 + i]) + (impw[(2 * 16 + tk) * 128 + i] + impw[(3 * 16 + tk) * 128 + i]);
            const bool forced = (j == 0) || (j == cur) || (j == cur - 1);
            scs[tk * 32 + j] = forced ? 1e6f : (j <= cur ? sc : -1.f);
        }
        __syncthreads();
#pragma unroll
        for (int pass = 0; pass < 2; pass++) {
            const int tk = pass * 8 + (tid >> 5), j = tid & 31;
            const float mine = scs[tk * 32 + j];
            int rank = 0;
            for (int j2 = 0; j2 < 32; j2++) { const float o = scs[tk * 32 + j2]; rank += (o > mine || (o == mine && j2 < j)) ? 1 : 0; }
            const unsigned long long bal = __ballot(rank < 16);
            if ((lane & 31) == 0) selm[tk] = (unsigned)(lane ? (bal >> 32) : (bal & 0xffffffffull));
        }
        __syncthreads();
    }
#pragma unroll
    for (int x = 0; x < 2; x++)
#pragma unroll
        for (int dt = 0; dt < 4; dt++) ofl[(wave * 8 + x * 4 + dt) * 64 + lane] = Og[x][dt];
    const unsigned mysel = selm[r];
    unsigned uni = 0;
#pragma unroll
    for (int i = 0; i < 16; i++) uni |= selm[i];
    uni &= (cur == 31) ? 0xffffffffu : ((2u << cur) - 1u);
    uni |= 1u;

    {
        const int lo = t0 - 511;
        const int jb0 = lo > 0 ? (lo >> 6) : 0;
        const int kkey = tid >> 2, kch = (tid & 3) * 16;
        const int vkey = tid & 63, vdc = (tid >> 6) * 16;
        u32x4 kreg[2], vreg[2];
        int br = 0, j = 0;
        {
            const bf16_t* kb = Z + (rowb + 0) * ZC + ZKS + g * 64;
            const bf16_t* vb = Z + (rowb + 0) * ZC + ZVS + g * 64;
            kreg[0] = *(const u32x4*)(kb + (size_t)kkey * ZC + kch); kreg[1] = *(const u32x4*)(kb + (size_t)kkey * ZC + kch + 8);
            vreg[0] = *(const u32x4*)(vb + (size_t)vkey * ZC + vdc); vreg[1] = *(const u32x4*)(vb + (size_t)vkey * ZC + vdc + 8);
        }
        f32x4 O[2][4];
        float m[2] = {-1e30f, -1e30f}, l[2] = {0.f, 0.f};
#pragma unroll
        for (int x = 0; x < 2; x++)
#pragma unroll
            for (int dt = 0; dt < 4; dt++) O[x][dt] = (f32x4){0.f, 0.f, 0.f, 0.f};
        for (;;) {
            __syncthreads();
            *(u32x4*)(Ks + kkey * 64 + (((kch >> 3) ^ (kkey & 7)) * 8)) = kreg[0];
            *(u32x4*)(Ks + kkey * 64 + ((((kch >> 3) + 1) ^ (kkey & 7)) * 8)) = kreg[1];
            {
                const unsigned w[8] = {vreg[0].x, vreg[0].y, vreg[0].z, vreg[0].w, vreg[1].x, vreg[1].y, vreg[1].z, vreg[1].w};
#pragma unroll
                for (int jj = 0; jj < 16; jj++) VT[(vdc + jj) * 72 + vkey] = (bf16_t)((jj & 1) ? (w[jj >> 1] >> 16) : (w[jj >> 1] & 0xffffu));
            }
            __syncthreads();
            int nbr, nj;
            if (br == 0) {
                const unsigned rem = (j >= 31) ? 0u : (uni & ~((2u << j) - 1u));
                if (rem) { nbr = 0; nj = __ffs((int)rem) - 1; } else { nbr = 1; nj = jb0; }
            } else {
                if (j < cur) { nbr = 1; nj = j + 1; } else { nbr = 2; nj = 0; }
            }
            if (nbr < 2) {
                const bf16_t* kb = Z + (rowb + nj * 64) * ZC + (nbr ? ZKW : ZKS) + g * 64;
                const bf16_t* vb = Z + (rowb + nj * 64) * ZC + (nbr ? ZVW : ZVS) + g * 64;
                kreg[0] = *(const u32x4*)(kb + (size_t)kkey * ZC + kch); kreg[1] = *(const u32x4*)(kb + (size_t)kkey * ZC + kch + 8);
                vreg[0] = *(const u32x4*)(vb + (size_t)vkey * ZC + vdc); vreg[1] = *(const u32x4*)(vb + (size_t)vkey * ZC + vdc + 8);
            }
            int klo = 0, khi = -1;
            if (br == 0) { if ((mysel >> j) & 1u) khi = t - j * 64; }
            else { khi = t - j * 64; klo = t - 511 - j * 64; }
            klo = klo < 0 ? 0 : klo;
            khi = khi > 63 ? 63 : khi;
            nsa_block_step(Ks, VT, qf, O, m, l, klo, khi, r, q);
            if (nbr != br) {
#pragma unroll
                for (int x = 0; x < 2; x++) {
                    float lt = l[x];
                    lt += __shfl_xor(lt, 16, 64);
                    lt += __shfl_xor(lt, 32, 64);
                    const float sc = sigmoidf_(bf2f(Z[(rowb + t) * ZC + ZGATE + (br + 1) * 16 + g * 8 + 2 * wave + x])) / lt;
#pragma unroll
                    for (int dt = 0; dt < 4; dt++) { ofl[(wave * 8 + x * 4 + dt) * 64 + lane] += sc * O[x][dt]; O[x][dt] = (f32x4){0.f, 0.f, 0.f, 0.f}; }
                    m[x] = -1e30f; l[x] = 0.f;
                }
            }
            if (nbr == 2) break;
            br = nbr; j = nj;
        }
#pragma unroll
        for (int x = 0; x < 2; x++)
#pragma unroll
            for (int dt = 0; dt < 4; dt++) {
                const f32x4 v = ofl[(wave * 8 + x * 4 + dt) * 64 + lane];
                *(u32x2*)(ydst + (rowb + t) * ystride + (g * 8 + 2 * wave + x) * 64 + dt * 16 + 4 * q) = (u32x2){pack2(v[0], v[1]), pack2(v[2], v[3])};
            }
    }
    __syncthreads();
}

__device__ void phaseM1(const Params& p, char* lds) {
    const int tid_ = TIDX; const int lane = tid_ & 63, wave = tid_ >> 6;
    const int wr = wave >> 1, wc = wave & 1, r = lane & 15, q = lane >> 4;
    const bf16_t* H = (const bf16_t*)(p.ws + OFF_H);
    const bf16_t* Z = (const bf16_t*)(p.ws + OFF_Z);
    bf16_t* M = (bf16_t*)(p.ws + OFF_M);
    bf16_t* SG = (bf16_t*)p.out;
    TileIter tit(8, lds);
    int bm, bn;
    while (tit.next(bm, bn)) {
        const int m0 = bm * 256, n0 = bn * 128;
        for (int br = 0; br < 2; br++) {
            f32x4 acc[8][4];
            zero_acc(acc);
            gemm_core(acc, H, DM, (const bf16_t*)(p.ws + OFF_WM) + (size_t)br * 1024 * 1024, DM, DM, m0, n0, lds);
            {
                const int e0 = launder_i((m0 + wr * 128 + r) * DM + n0 + wc * 64 + 4 * q);
#pragma unroll
                for (int mi = 0; mi < 8; mi++)
#pragma unroll
                    for (int ni = 0; ni < 4; ni++)
                        *(u32x2*)(SG + (size_t)(e0 + mi * 16 * DM + ni * 16)) = (u32x2){pack2(sigmoidf_(acc[mi][ni][0]), sigmoidf_(acc[mi][ni][1])),
                                                                                        pack2(sigmoidf_(acc[mi][ni][2]), sigmoidf_(acc[mi][ni][3]))};
            }
            zero_acc(acc);
            gemm_core(acc, Z + (br ? ZQ_N : ZR_G), ZC, (const bf16_t*)(p.ws + (br ? OFF_WB : OFF_WA)), DM, DM, m0, n0, lds);
            {
                const int e0 = launder_i((m0 + wr * 128 + r) * DM + n0 + wc * 64 + 4 * q);
#pragma unroll
                for (int mi = 0; mi < 8; mi++)
#pragma unroll
                    for (int ni = 0; ni < 4; ni++) {
                        const size_t eo = (size_t)(e0 + mi * 16 * DM + ni * 16);
                        const u32x2 sg = *(const u32x2*)(SG + eo);
                        float v[4] = {bf_lo(sg.x) * acc[mi][ni][0], bf_hi(sg.x) * acc[mi][ni][1], bf_lo(sg.y) * acc[mi][ni][2], bf_hi(sg.y) * acc[mi][ni][3]};
                        u32x2* dst = (u32x2*)(M + eo);
                        if (br) { const u32x2 pv = *dst; v[0] += bf_lo(pv.x); v[1] += bf_hi(pv.x); v[2] += bf_lo(pv.y); v[3] += bf_hi(pv.y); }
                        *dst = (u32x2){pack2(v[0], v[1]), pack2(v[2], v[3])};
                    }
            }
        }
    }
}

__device__ void phaseM2(const Params& p, char* lds) {
    const int tid_ = TIDX; const int lane = tid_ & 63, wave = tid_ >> 6;
    const int wr = wave >> 1, wc = wave & 1, r = lane & 15, q = lane >> 4;
    const bf16_t* M = (const bf16_t*)(p.ws + OFF_M);
    const float* mod = (const float*)(p.ws + OFF_MOD);
    TileIter tit(8, lds);
    int bm, bn;
    while (tit.next(bm, bn)) {
        const int m0 = bm * 256, n0 = bn * 128;
        f32x4 acc[8][4];
        zero_acc(acc);
        gemm_core(acc, M, DM, (const bf16_t*)(p.ws + OFF_WO), DM, DM, m0, n0, lds);
#pragma unroll
        for (int mi = 0; mi < 8; mi++)
#pragma unroll
            for (int ni = 0; ni < 4; ni++) {
                const int tok = m0 + wr * 128 + mi * 16 + r, col = n0 + wc * 64 + ni * 16 + 4 * q;
                const f32x4 xv = *(const f32x4*)(p.x + (size_t)tok * DM + col);
                const f32x4 gt = *(const f32x4*)(mod + (tok >> 11) * 6144 + 2 * 1024 + col);
                *(f32x4*)(p.out + (size_t)tok * DM + col) = xv + gt * acc[mi][ni];
            }
    }
    {
        const int tid_ = TIDX; const int lane = tid_ & 63, wave = tid_ >> 6;
        unsigned char* tq = (unsigned char*)(p.ws + OFF_UB);
        float* tsc = (float*)(p.ws + OFF_UB + 33554432);
        for (int row = blockIdx.x * 4 + wave; row < 32768; row += gridDim.x * 4) {
            const bool isv = row >= 16384;
            const float* srcp = (isv ? p.peer_v : p.peer_u) + (size_t)(row & 16383) * DM + lane * 16;
            f32x4 a[4];
            float mx = 0.f;
#pragma unroll
            for (int i = 0; i < 4; i++) {
                a[i] = *(const f32x4*)(srcp + i * 4);
                mx = fmaxf(mx, fmaxf(fmaxf(fabsf(a[i][0]), fabsf(a[i][1])), fmaxf(fabsf(a[i][2]), fabsf(a[i][3]))));
            }
            mx = wave_max(mx);
            const float inv = mx > 0.f ? 127.f / mx : 0.f;
            const int off = isv ? 128 : 0;
            unsigned w[4];
#pragma unroll
            for (int i = 0; i < 4; i++) {
                unsigned pk = 0;
#pragma unroll
                for (int j = 0; j < 4; j++) {
                    int qi = (int)rintf(a[i][j] * inv);
                    qi = qi > 127 ? 127 : (qi < -127 ? -127 : qi);
                    pk |= ((unsigned)(qi + off) & 0xffu) << (8 * j);
                }
                w[i] = pk;
            }
            *(u32x4*)(tq + (size_t)row * DM + lane * 16) = (u32x4){w[0], w[1], w[2], w[3]};
            if (lane == 0) tsc[row] = mx * (1.f / 127.f);
        }
    }
}

__device__ void phaseP1(const Params& p, char* lds) {
    const int tid_ = TIDX; const int lane = tid_ & 63, wave = tid_ >> 6;
    const int wr = wave >> 1, wc = wave & 1, r = lane & 15, q = lane >> 4;
    const bf16_t* H = (const bf16_t*)(p.ws + OFF_H);
    bf16_t* QP = (bf16_t*)(p.ws + OFF_QP);
    TileIter tit(16, lds);
    int bm, bn;
    while (tit.next(bm, bn)) {
        const int m0 = bm * 256, n0 = bn * 128;
        f32x4 acc[8][4];
        zero_acc(acc);
        gemm_core(acc, H, DM, (const bf16_t*)(p.ws + OFF_WQ), DM, DM, m0, n0, lds);
#pragma unroll
        for (int mi = 0; mi < 8; mi++)
#pragma unroll
            for (int ni = 0; ni < 4; ni++) {
                const int tok = m0 + wr * 128 + mi * 16 + r, col = n0 + wc * 64 + ni * 16 + 4 * q;
                const f32x4 v = acc[mi][ni];
                *(u32x2*)(QP + (size_t)tok * 2048 + col) = (u32x2){pack2(v[0], v[1]), pack2(v[2], v[3])};
            }
    }
}

__constant__ unsigned char c_cand_a[64] = {0,0,0,0,0,0,0,0,0,0,0,0,0,0,0,0, 1,1,1,1,1,1,1,1, 2,2,2,2,2, 3,3,3,3, 4,4,4, 5,5, 6,6, 7,7, 8,9,10,11,12,13,14,15, 0,0,0,0,0,0,0,0,0,0,0,0,0,0};
__constant__ unsigned char c_cand_b[64] = {0,1,2,3,4,5,6,7,8,9,10,11,12,13,14,15, 0,1,2,3,4,5,6,7, 0,1,2,3,4, 0,1,2,3, 0,1,2, 0,1, 0,1, 0,1, 0,0,0,0,0,0,0,0, 0,0,0,0,0,0,0,0,0,0,0,0,0,0};

__device__ __forceinline__ unsigned f2key(float f) { const unsigned u = __float_as_uint(f); return (u & 0x80000000u) ? ~u : (u | 0x80000000u); }
__device__ __forceinline__ float key2f(unsigned k) { const unsigned u = (k & 0x80000000u) ? (k & 0x7fffffffu) : ~k; return __uint_as_float(u); }
__device__ __forceinline__ void ins16(unsigned (&L)[16], unsigned v) {
#pragma unroll
    for (int k = 0; k < 16; k++) { const unsigned hi = L[k] > v ? L[k] : v; v = L[k] > v ? v : L[k]; L[k] = hi; }
}

__device__ void phaseP2_task(const Params& p, int task, char* lds) {
    const int tid = TIDX, lane = tid & 63, wave = tid >> 6, r = lane & 15, q = lane >> 4;
    const int h = task & 7, tile = task >> 3;
    const int tok0 = tile * 64;
    const bf16_t* QP = (const bf16_t*)(p.ws + OFF_QP);
    float* S = (float*)lds;
    unsigned* LL = (unsigned*)(lds + 65536);
#pragma unroll
    for (int half = 0; half < 2; half++) {
        const bf16_t* KB = (const bf16_t*)(p.ws + OFF_K1B) + (size_t)half * 131072 + (size_t)h * 128 * 128;
        f32x4 acc[8];
#pragma unroll
        for (int nt = 0; nt < 8; nt++) acc[nt] = (f32x4){0.f, 0.f, 0.f, 0.f};
#pragma unroll
        for (int ks = 0; ks < 4; ks++) {
            const bf16x8 bq = *(const bf16x8*)(QP + (size_t)(tok0 + wave * 16 + r) * 2048 + h * 256 + half * 128 + ks * 32 + q * 8);
#pragma unroll
            for (int nt = 0; nt < 8; nt++) {
                const bf16x8 ak = *(const bf16x8*)(KB + (size_t)(nt * 16 + r) * 128 + ks * 32 + q * 8);
                acc[nt] = mfma16(ak, bq, acc[nt]);
            }
        }
#pragma unroll
        for (int nt = 0; nt < 8; nt++)
#pragma unroll
            for (int j = 0; j < 4; j++) S[(half * 128 + nt * 16 + 4 * q + j) * 64 + wave * 16 + r] = acc[nt][j];
    }
    __syncthreads();
    if (tid < 128) {
        const int half = tid >> 6, tk = tid & 63;
        unsigned L[16];
#pragma unroll
        for (int k = 0; k < 16; k++) L[k] = 0u;
        const float* sp = S + half * 128 * 64 + tk;
        for (int k = 0; k < 128; k++) ins16(L, (f2key(sp[k * 64]) & ~127u) | (unsigned)(127 - k));
#pragma unroll
        for (int k = 0; k < 16; k++) LL[(half * 16 + k) * 64 + tk] = L[k];
    }
    __syncthreads();
    if (tid < 64) {
        const int tk = tid;
        float v1[16], v2[16];
#pragma unroll
        for (int k = 0; k < 16; k++) { v1[k] = key2f(LL[k * 64 + tk] & ~127u); v2[k] = key2f(LL[(16 + k) * 64 + tk] & ~127u); }
        unsigned T[16];
#pragma unroll
        for (int k = 0; k < 16; k++) T[k] = 0u;
        int c = 0;
#pragma unroll
        for (int a = 0; a < 16; a++)
#pragma unroll
            for (int b = 0; b < 16; b++)
                if ((a + 1) * (b + 1) <= 16) { ins16(T, (f2key(v1[a] + v2[b]) & ~63u) | (unsigned)(63 - c)); c++; }
        const float mx = key2f(T[0] & ~63u);
        float e[16], sum = 0.f;
#pragma unroll
        for (int k = 0; k < 16; k++) { e[k] = __expf(key2f(T[k] & ~63u) - mx); sum += e[k]; }
        const float inv = 1.f / sum;
        int ei[16];
#pragma unroll
        for (int k = 0; k < 16; k++) {
            const int cc = 63 - (int)(T[k] & 63u);
            const int a = c_cand_a[cc], b = c_cand_b[cc];
            const int i1 = 127 - (int)(LL[a * 64 + tk] & 127u), i2 = 127 - (int)(LL[(16 + b) * 64 + tk] & 127u);
            ei[k] = i1 * 128 + i2;
            e[k] *= inv;
        }
        int* eidx = (int*)(p.ws + OFF_EIDX) + (size_t)(tok0 + tk) * 128 + h * 16;
        float* gw = (float*)(p.ws + OFF_GW) + (size_t)(tok0 + tk) * 128 + h * 16;
#pragma unroll
        for (int k4 = 0; k4 < 4; k4++) {
            *(u32x4*)(eidx + k4 * 4) = (u32x4){(unsigned)ei[k4 * 4], (unsigned)ei[k4 * 4 + 1], (unsigned)ei[k4 * 4 + 2], (unsigned)ei[k4 * 4 + 3]};
            *(f32x4*)(gw + k4 * 4) = (f32x4){e[k4 * 4], e[k4 * 4 + 1], e[k4 * 4 + 2], e[k4 * 4 + 3]};
        }
    }
    __syncthreads();
}

__device__ __forceinline__ float ub0(unsigned w) { return (float)(w & 0xffu); }
__device__ __forceinline__ float ub1(unsigned w) { return (float)((w >> 8) & 0xffu); }
__device__ __forceinline__ float ub2(unsigned w) { return (float)((w >> 16) & 0xffu); }
__device__ __forceinline__ float ub3(unsigned w) { return (float)(w >> 24); }
__device__ void phaseP3(const Params& p, float* dstp) {
    const int tid_ = TIDX; const int lane = tid_ & 63, wave = tid_ >> 6;
    const bf16_t* H = (const bf16_t*)(p.ws + OFF_H);
    const unsigned char* UQ = (const unsigned char*)(p.ws + OFF_UB);
    const unsigned char* VQ = UQ + 16777216;
    const float* tsc = (const float*)(p.ws + OFF_UB + 33554432);
    const int* eidx = (const int*)(p.ws + OFF_EIDX);
    const float* gwp = (const float*)(p.ws + OFF_GW);
    const float* mod = (const float*)(p.ws + OFF_MOD);
    const int ul = ((lane & 1) << 2) | (lane & 2) | ((lane >> 2) & 1);
    for (int tok = blockIdx.x * 4 + wave; tok < NTOK; tok += gridDim.x * 4) {
        int qh[4];
        float sh;
        {
            const u32x4 a = *(const u32x4*)(H + (size_t)tok * DM + lane * 16), b = *(const u32x4*)(H + (size_t)tok * DM + lane * 16 + 8);
            const unsigned hw[8] = {a.x, a.y, a.z, a.w, b.x, b.y, b.z, b.w};
            float hv[16];
            float mx = 0.f;
#pragma unroll
            for (int i = 0; i < 8; i++) { hv[2 * i] = bf_lo(hw[i]); hv[2 * i + 1] = bf_hi(hw[i]); mx = fmaxf(mx, fmaxf(fabsf(hv[2 * i]), fabsf(hv[2 * i + 1]))); }
            mx = wave_max(mx);
            const float inv = mx > 0.f ? 127.f / mx : 0.f;
            sh = mx * (1.f / 127.f);
#pragma unroll
            for (int i = 0; i < 4; i++) {
                unsigned pk = 0;
#pragma unroll
                for (int j = 0; j < 4; j++) pk |= ((unsigned)((int)rintf(hv[i * 4 + j] * inv)) & 0xffu) << (8 * j);
                qh[i] = (int)pk;
            }
        }
        const int e0 = eidx[(size_t)tok * 128 + lane], e1 = eidx[(size_t)tok * 128 + 64 + lane];
        const float g0 = gwp[(size_t)tok * 128 + lane], g1 = gwp[(size_t)tok * 128 + 64 + lane];
        float acc[16];
#pragma unroll
        for (int i = 0; i < 16; i++) acc[i] = 0.f;
        float wsum = 0.f;
        for (int jb = 0; jb < 128; jb += 8) {
            u32x4 ur[8], vr[8];
#pragma unroll
            for (int u = 0; u < 8; u++) {
                const int j = jb + u;
                const int e = (jb < 64) ? __shfl(e0, j, 64) : __shfl(e1, j - 64, 64);
                ur[u] = *(const u32x4*)(UQ + (size_t)e * DM + lane * 16);
                vr[u] = *(const u32x4*)(VQ + (size_t)e * DM + lane * 16);
            }
            const int jm = jb + ul;
            const int em = (jb < 64) ? __shfl(e0, jm, 64) : __shfl(e1, jm - 64, 64);
            const float gm = (jb < 64) ? __shfl(g0, jm, 64) : __shfl(g1, jm - 64, 64);
            const float su = tsc[em], sv = tsc[16384 + em];
            int pt[8];
#pragma unroll
            for (int u = 0; u < 8; u++) {
                int d = __builtin_amdgcn_sdot4((int)ur[u].x, qh[0], 0, false);
                d = __builtin_amdgcn_sdot4((int)ur[u].y, qh[1], d, false);
                d = __builtin_amdgcn_sdot4((int)ur[u].z, qh[2], d, false);
                d = __builtin_amdgcn_sdot4((int)ur[u].w, qh[3], d, false);
                pt[u] = d;
            }
            int m4[4], m2[2], m1;
            {
                const bool b0 = lane & 1;
#pragma unroll
                for (int j = 0; j < 4; j++) { const int keep = b0 ? pt[j + 4] : pt[j], send = b0 ? pt[j] : pt[j + 4]; m4[j] = keep + __shfl_xor(send, 1, 64); }
                const bool b1 = lane & 2;
#pragma unroll
                for (int j = 0; j < 2; j++) { const int keep = b1 ? m4[j + 2] : m4[j], send = b1 ? m4[j] : m4[j + 2]; m2[j] = keep + __shfl_xor(send, 2, 64); }
                const bool b2 = lane & 4;
                { const int keep = b2 ? m2[1] : m2[0], send = b2 ? m2[0] : m2[1]; m1 = keep + __shfl_xor(send, 4, 64); }
                m1 += __shfl_xor(m1, 8, 64);
                m1 += __shfl_xor(m1, 16, 64);
                m1 += __shfl_xor(m1, 32, 64);
            }
            const float aval = (float)m1 * (sh * su);
            const float ws = gm * gelu_erf(aval) * sv;
#pragma unroll
            for (int u = 0; u < 8; u++) {
                const int src_lane = ((u >> 2) & 1) | (u & 2) | ((u & 1) << 2);
                const float wu = __shfl(ws, src_lane, 64);
                wsum += wu;
                const unsigned vw[4] = {vr[u].x, vr[u].y, vr[u].z, vr[u].w};
#pragma unroll
                for (int i = 0; i < 4; i++) {
                    acc[i * 4 + 0] += wu * ub0(vw[i]); acc[i * 4 + 1] += wu * ub1(vw[i]);
                    acc[i * 4 + 2] += wu * ub2(vw[i]); acc[i * 4 + 3] += wu * ub3(vw[i]);
                }
            }
        }
        const int b = tok >> 11;
        float x2[16];
        float ss = 0.f;
#pragma unroll
        for (int i = 0; i < 4; i++) {
            const int d = lane * 16 + i * 4;
            const f32x4 xv = *(const f32x4*)(p.out + (size_t)tok * DM + d);
            const f32x4 gt = *(const f32x4*)(mod + b * 6144 + 5 * 1024 + d);
#pragma unroll
            for (int j = 0; j < 4; j++) { const float v = xv[j] + gt[j] * (acc[i * 4 + j] - 128.f * wsum); x2[i * 4 + j] = v; ss += v * v; }
        }
        ss = wave_sum(ss);
        const float rstd = rsqrtf(ss * (1.f / 1024.f) + 1e-6f);
#pragma unroll
        for (int i = 0; i < 4; i++) {
            const int d = lane * 16 + i * 4;
            const f32x4 fg = *(const f32x4*)(p.final_g + d);
            f32x4 o;
#pragma unroll
            for (int j = 0; j < 4; j++) o[j] = x2[i * 4 + j] * rstd * fg[j];
            *(f32x4*)(dstp + (size_t)tok * DM + d) = o;
        }
    }
}

#define XB_TMO      128
#define XB_XCNT(j)  (256  + 64 * (j))
#define XB_XSUB(j)  (1280 + 64 * (j))
#define XB_XGEN(j)  (2304 + 64 * (j))
#define XB_TOP      3328
#define XB_TOPGEN   3392
#define XCD_BAR_WORDS 3456
#define XB_SPIN_CAP (1u << 22)
#define LAS __attribute__((address_space(3)))
__device__ __forceinline__ unsigned xb_ld(unsigned* p)              { return __hip_atomic_load(p, __ATOMIC_RELAXED, __HIP_MEMORY_SCOPE_AGENT); }
__device__ __forceinline__ unsigned xb_add(unsigned* p, unsigned v) { return __hip_atomic_fetch_add(p, v, __ATOMIC_RELAXED, __HIP_MEMORY_SCOPE_AGENT); }
__device__ __forceinline__ unsigned xb_xcc_id() { return (unsigned)__builtin_amdgcn_s_getreg((3 << 11) | 20) & 0xFu; }
#define XB_SPIN(cond, bar) do { unsigned _sp = 0; while (cond) { __builtin_amdgcn_s_sleep(1); \
    if ((++_sp & 255u) == 0u) { if (xb_ld(&(bar)[XB_TMO])) break; if (_sp > XB_SPIN_CAP) { atomicAdd(&(bar)[XB_TMO], 1u); break; } } } } while (0)
struct XcdBarrier { unsigned* bar; unsigned x; volatile LAS unsigned* st; };
__device__ __forceinline__ XcdBarrier xcd_barrier_post(unsigned* bar, volatile LAS unsigned* st) {
    XcdBarrier b; b.bar = bar; b.x = xb_xcc_id(); b.st = st;
    if (threadIdx.x == 0) { st[2] = xb_add(&bar[XB_XCNT(b.x)], 1u); st[4] = b.x; }
    return b;
}
__device__ __forceinline__ void xcd_barrier_complete(unsigned* bar, unsigned x, unsigned& nloc, unsigned& nx, unsigned& bal) {
    const unsigned G = gridDim.x * gridDim.y * gridDim.z;
    unsigned sum, cnt, mine, c64, sp = 0u;
    for (;;) {
        sum = 0u; cnt = 0u; mine = 0u; c64 = 0u;
#pragma unroll
        for (unsigned j = 0; j < 16; ++j) { const unsigned c = xb_ld(&bar[XB_XCNT(j)]); sum += c; cnt += (c > 0u) ? 1u : 0u; c64 += (j < 8 && c == 64u) ? 1u : 0u; mine = (j == x) ? c : mine; }
        if (sum == G) break;
        __builtin_amdgcn_s_sleep(1);
        if ((++sp & 255u) == 0u) { if (xb_ld(&bar[XB_TMO])) break; if (sp > XB_SPIN_CAP) { atomicAdd(&bar[XB_TMO], 1u); break; } }
    }
    nloc = mine > 0u ? mine : 1u; nx = cnt > 0u ? cnt : 1u; bal = (sum == G && cnt == 8u && c64 == 8u) ? 1u : 0u;
}
__device__ __forceinline__ void xcd_barrier(const XcdBarrier& b) {
    asm volatile("s_waitcnt vmcnt(0)" ::: "memory");
    __syncthreads();
    if (threadIdx.x == 0) {
        unsigned* bar = b.bar;
        __builtin_amdgcn_s_waitcnt(0);
        unsigned nloc = b.st[0], nx = b.st[1];
        if (nloc == 0u) { unsigned bal; xcd_barrier_complete(bar, b.x, nloc, nx, bal); b.st[0] = nloc; b.st[1] = nx; b.st[3] = bal; }
        const unsigned old = xb_add(&bar[XB_XSUB(b.x)], 1u);
        const unsigned gen = old / nloc;
        if (old + 1u == (gen + 1u) * nloc) {
            __builtin_amdgcn_fence(__ATOMIC_RELEASE, "agent");
            asm volatile("s_waitcnt vmcnt(0)" ::: "memory");
            const unsigned og = xb_add(&bar[XB_TOP], 1u);
            const unsigned tg = og / nx;
            if (og + 1u == (tg + 1u) * nx) xb_add(&bar[XB_TOPGEN], 1u);
            else XB_SPIN(xb_ld(&bar[XB_TOPGEN]) == tg, bar);
            __builtin_amdgcn_fence(__ATOMIC_ACQUIRE, "agent");
            xb_add(&bar[XB_XGEN(b.x)], 1u);
            asm volatile("s_waitcnt vmcnt(0)" ::: "memory");
        } else {
            XB_SPIN(xb_ld(&bar[XB_XGEN(b.x)]) == gen, bar);
            __builtin_amdgcn_fence(__ATOMIC_ACQUIRE, "agent");
            asm volatile("s_waitcnt vmcnt(0)" ::: "memory");
        }
    }
    __syncthreads();
}

typedef __attribute__((address_space(4))) const Params* KParamsPtr;
__device__ __forceinline__ const Params& fresh_params() {
    KParamsPtr kp = (KParamsPtr)__builtin_amdgcn_kernarg_segment_ptr();
    asm volatile("" : "+s"(kp));
    return *(const Params*)kp;
}
#define PF fresh_params()
__global__ void __launch_bounds__(NTHREADS, 2) mega(Params p_unused) {
    __shared__ __attribute__((aligned(16))) char lds[LDS_BYTES];
    cg::grid_group grid = cg::this_grid();
    volatile LAS unsigned* st = (volatile LAS unsigned*)(lds + LDS_MAIN);
    if (threadIdx.x < 8) st[threadIdx.x] = 0u;
    __syncthreads();
    XcdBarrier xb = xcd_barrier_post((unsigned*)PF.ws, st);

    phaseA(PF, lds);
    if (PF.ws == nullptr) grid.sync();
    xcd_barrier(xb);
    { const Params& q_ = PF; phase_modnorm(q_, q_.x, q_.norm1_g, 0, 1, (bf16_t*)(q_.ws + OFF_H)); };
    xcd_barrier(xb);
    phaseC(PF, lds);
    xcd_barrier(xb);
    for (int task = blockIdx.x; task < 1024; task += gridDim.x) phaseG1_task(PF, task, lds);
    for (int task = blockIdx.x; task < 256; task += gridDim.x) phaseN1_task(PF, task, lds);
    xcd_barrier(xb);
    phaseG2(PF);
    xcd_barrier(xb);
    for (int task = blockIdx.x; task < 2048; task += gridDim.x) phaseN2_task(PF, task, lds, (bf16_t*)(PF.ws + OFF_Z) + ZQ_N, ZC);
    for (int task = blockIdx.x; task < 1024; task += gridDim.x) phaseG3_task(PF, task, lds, (bf16_t*)(PF.ws + OFF_Z) + ZR_G, ZC);
    xcd_barrier(xb);
    phaseM1(PF, lds);
    xcd_barrier(xb);
    phaseM2(PF, lds);
    xcd_barrier(xb);
    { const Params& q_ = PF; phase_modnorm(q_, q_.out, q_.norm2_g, 3, 4, (bf16_t*)(q_.ws + OFF_H)); };
    xcd_barrier(xb);
    phaseP1(PF, lds);
    xcd_barrier(xb);
    for (int task = blockIdx.x; task < 2048; task += gridDim.x) phaseP2_task(PF, task, lds);
    xcd_barrier(xb);
    { const Params& q_ = PF; phaseP3(q_, q_.out); };
}

extern "C" void kernel_launch(void* const* d_in, const int* in_sizes, int n_in, void* d_out, int out_size, void* d_ws, size_t ws_size, hipStream_t stream) {
    Params p{};
    p.x = (const float*)d_in[0]; p.c = (const float*)d_in[1]; p.pos = (const int*)d_in[2]; p.ada_w = (const float*)d_in[3]; p.ada_b = (const float*)d_in[4];
    p.norm1_g = (const float*)d_in[5]; p.norm2_g = (const float*)d_in[6]; p.final_g = (const float*)d_in[7]; p.w_in = (const float*)d_in[8];
    p.gla_wa2 = (const float*)d_in[9]; p.gla_ba2 = (const float*)d_in[10]; p.gla_norm_g = (const float*)d_in[11]; p.pe_k = (const float*)d_in[12]; p.pe_v = (const float*)d_in[13];
    p.ck_w1 = (const float*)d_in[14]; p.ck_w2 = (const float*)d_in[15]; p.cv_w1 = (const float*)d_in[16]; p.cv_w2 = (const float*)d_in[17];
    p.w_branch_a = (const float*)d_in[18]; p.w_branch_b = (const float*)d_in[19]; p.w_out = (const float*)d_in[20]; p.peer_wq = (const float*)d_in[21];
    p.peer_k1 = (const float*)d_in[22]; p.peer_k2 = (const float*)d_in[23]; p.peer_u = (const float*)d_in[24]; p.peer_v = (const float*)d_in[25];
    p.out = (float*)d_out; p.ws = (char*)d_ws;
    static int grid_blocks = 0;
    if (!grid_blocks) {
        int dev = 0, cus = 0, per_cu = 0;
        hipGetDevice(&dev);
        hipDeviceGetAttribute(&cus, hipDeviceAttributeMultiprocessorCount, dev);
        hipOccupancyMaxActiveBlocksPerMultiprocessor(&per_cu, mega, NTHREADS, 0);
        if (per_cu > 2) per_cu = 2;
        if (per_cu < 1) per_cu = 1;
        grid_blocks = cus * per_cu;
    }
    hipMemsetAsync(d_ws, 0, XCD_BAR_WORDS * 4, stream);
    void* args[] = {&p};
    hipError_t e = hipLaunchCooperativeKernel((void*)mega, dim3(grid_blocks), dim3(NTHREADS), args, 0, stream);
    if (e != hipSuccess) fprintf(stderr, "cooperative launch failed: %s (grid %d)\n", hipGetErrorString(e), grid_blocks);
}
```

```cpp
#include <hip/hip_runtime.h>
#include <hip/hip_cooperative_groups.h>
#include <stdio.h>
namespace cg = cooperative_groups;
#include <stdint.h>
#include <stddef.h>
#include <math.h>

typedef unsigned short bf16_t;
typedef short bf16x8 __attribute__((ext_vector_type(8)));
typedef float f32x4 __attribute__((ext_vector_type(4)));
typedef unsigned u32x4 __attribute__((ext_vector_type(4)));
typedef unsigned u32x2 __attribute__((ext_vector_type(2)));

constexpr int DM = 1024, NB = 8, SEQ = 2048, NTOK = NB * SEQ;
constexpr int ZC = 4992;
constexpr int ZQ_G = 0, ZK_G = 512, ZV_G = 1024, ZR_G = 2048, ZQ_N = 3072, ZKC = 4096, ZVC = 4224, ZKS = 4352, ZVS = 4480,
              ZKW = 4608, ZVW = 4736, ZGATE = 4864, ZLR = 4912;
constexpr int LDS_MAIN = 73728;
constexpr int LDS_BYTES = 2 * LDS_MAIN + 64;
constexpr int NTHREADS = 256;
constexpr int BLOCK_THREADS = 512;

constexpr size_t OFF_MOD = 16384;
constexpr size_t OFF_ROPE = 212992;
constexpr size_t OFF_CMP = 1261568;
constexpr size_t OFF_DEC = 1785856;
constexpr size_t OFF_K1B = 2310144;
constexpr size_t OFF_WC1 = 2834432;
constexpr size_t OFF_WIN = 4194304;
constexpr size_t OFF_WM = 14417920;
constexpr size_t OFF_WA = 18612224;
constexpr size_t OFF_WB = 20709376;
constexpr size_t OFF_WO = 22806528;
constexpr size_t OFF_WQ = 24903680;
constexpr size_t OFF_H = 29360128;
constexpr size_t OFF_M = 62914560;
constexpr size_t OFF_Z = 96468992;
constexpr size_t OFF_QP = OFF_Z;
constexpr size_t OFF_UB = OFF_Z + 67108864;
constexpr size_t OFF_VB = OFF_UB + 33554432;
constexpr size_t OFF_EIDX = OFF_VB + 33554432;
constexpr size_t OFF_GW = OFF_EIDX + 8388608;

struct Params {
    const float* x; const float* c; const int* pos; const float* ada_w; const float* ada_b;
    const float* norm1_g; const float* norm2_g; const float* final_g; const float* w_in;
    const float* gla_wa2; const float* gla_ba2; const float* gla_norm_g; const float* pe_k; const float* pe_v;
    const float* ck_w1; const float* ck_w2; const float* cv_w1; const float* cv_w2;
    const float* w_branch_a; const float* w_branch_b; const float* w_out; const float* peer_wq;
    const float* peer_k1; const float* peer_k2; const float* peer_u; const float* peer_v;
    float* out; char* ws;
};

__device__ __forceinline__ unsigned f2bf_u(float f) { unsigned u = __float_as_uint(f); return (u + 0x7fffu + ((u >> 16) & 1u)) >> 16; }
__device__ __forceinline__ bf16_t f2bf(float f) { return (bf16_t)f2bf_u(f); }
typedef float f32x2_ __attribute__((ext_vector_type(2)));
typedef __bf16 bf16x2_ __attribute__((ext_vector_type(2)));
__device__ __forceinline__ unsigned pack2(float lo, float hi) {
    const f32x2_ v = {lo, hi};
    return __builtin_bit_cast(unsigned, __builtin_convertvector(v, bf16x2_));
}
__device__ __forceinline__ float bf_lo(unsigned u) { return __uint_as_float(u << 16); }
__device__ __forceinline__ float bf_hi(unsigned u) { return __uint_as_float(u & 0xffff0000u); }
__device__ __forceinline__ float bf2f(bf16_t h) { return __uint_as_float(((unsigned)h) << 16); }
__device__ __forceinline__ float wave_sum(float v) {
#pragma unroll
    for (int o = 32; o > 0; o >>= 1) v += __shfl_xor(v, o, 64);
    return v;
}
__device__ __forceinline__ float wave_max(float v) {
#pragma unroll
    for (int o = 32; o > 0; o >>= 1) v = fmaxf(v, __shfl_xor(v, o, 64));
    return v;
}
__device__ __forceinline__ int launder_i(int x) { asm volatile("" : "+v"(x)); return x; }
#define TIDX (launder_i((int)threadIdx.x) & 255)
#define TIDX512 launder_i((int)threadIdx.x)
__device__ __forceinline__ int half_id() { return __builtin_amdgcn_readfirstlane((int)(threadIdx.x >> 8)); }
__device__ __forceinline__ int vblk() { return (int)blockIdx.x * 2 + half_id(); }
__device__ __forceinline__ int vgrid() { return (int)gridDim.x * 2; }
__device__ __forceinline__ float exp2f_(float x) { return __builtin_amdgcn_exp2f(x); }
__device__ __forceinline__ float sigmoidf_(float x) { return __builtin_amdgcn_rcpf(1.f + __expf(-x)); }
__device__ __forceinline__ float siluf_(float x) { return x * __builtin_amdgcn_rcpf(1.f + __expf(-x)); }
__device__ __forceinline__ float gelu_erf(float x) { return 0.5f * x * (1.f + erff(x * 0.70710678118654752f)); }
__device__ __forceinline__ f32x4 mfma16(bf16x8 a, bf16x8 b, f32x4 c) { return __builtin_amdgcn_mfma_f32_16x16x32_bf16(a, b, c, 0, 0, 0); }
__device__ __forceinline__ bf16x8 ld_frag(const bf16_t* p) { return *(const bf16x8*)p; }
__device__ __forceinline__ bf16x8 mk_frag(u32x2 lo, u32x2 hi) { u32x4 t = {lo.x, lo.y, hi.x, hi.y}; return __builtin_bit_cast(bf16x8, t); }

#define WAIT_V(n) asm volatile("s_waitcnt vmcnt(" #n ")" ::: "memory")
__device__ __forceinline__ int swz4(int R) { return (4 - ((R >> 2) & 3)) & 3; }
__device__ __forceinline__ void glds16(const bf16_t* g, char* l) { __builtin_amdgcn_global_load_lds((const unsigned*)g, (unsigned*)l, 16, 0, 0); }
struct GemmSrc { const bf16_t* xsrc; const bf16_t* wsrc; int ldx, ldw; };
__device__ __forceinline__ GemmSrc gemm_src(const bf16_t* __restrict__ X, int ldx, const bf16_t* __restrict__ W, int ldw, int m0, int n0) {
    const int tid = TIDX512, lane = tid & 63, wave = tid >> 6;
    const int R0 = wave * 32 + (lane >> 2);
    const int sw = ((lane & 3) ^ swz4(R0)) * 8;
    GemmSrc g;
    g.xsrc = X + (size_t)(m0 + R0) * ldx + sw;
    g.wsrc = W + (size_t)(n0 + R0) * ldw + sw;
    g.ldx = ldx; g.ldw = ldw;
    return g;
}
__device__ __forceinline__ void gemm_issue(const GemmSrc& g, int kt, int s, char* lds) {
    const int tid = TIDX512, lane = tid & 63, wave = tid >> 6;
    char* xdst = lds + s * 32768 + wave * 2048 + lane * 16;
    char* wdst = xdst + 16384;
#pragma unroll
    for (int i = 0; i < 2; i++) {
        glds16(g.xsrc + (size_t)i * 16 * g.ldx + kt * 32, xdst + i * 1024);
        glds16(g.wsrc + (size_t)i * 16 * g.ldw + kt * 32, wdst + i * 1024);
    }
}
__device__ __forceinline__ void gemm_prologue(const GemmSrc& g, char* lds) { gemm_issue(g, 0, 0, lds); gemm_issue(g, 1, 1, lds); gemm_issue(g, 2, 2, lds); }
__device__ __forceinline__ void gemm_mainloop(f32x4 (&acc)[8][4], const GemmSrc& g, int K, char* lds) {
    const int tid = TIDX512, lane = tid & 63, wave = tid >> 6;
    const int wr = wave >> 2, wc = wave & 3, r = lane & 15, q = lane >> 4;
    const int KT = K / 32;
    const int rdo = r * 64 + ((q ^ swz4(r)) * 16);
    for (int kt = 0; kt < KT; kt++) {
        if (kt + 2 < KT) WAIT_V(8); else if (kt + 1 < KT) WAIT_V(4); else WAIT_V(0);
        __builtin_amdgcn_s_barrier();
        if (kt + 3 < KT) gemm_issue(g, kt + 3, (kt + 3) & 3, lds);
        const char* st = lds + (kt & 3) * 32768;
        bf16x8 af[4], bfr[8];
#pragma unroll
        for (int ni = 0; ni < 4; ni++) af[ni] = *(const bf16x8*)(st + 16384 + (wc * 64 + ni * 16) * 64 + rdo);
#pragma unroll
        for (int mi = 0; mi < 8; mi++) bfr[mi] = *(const bf16x8*)(st + (wr * 128 + mi * 16) * 64 + rdo);
#pragma unroll
        for (int mi = 0; mi < 8; mi++)
#pragma unroll
            for (int ni = 0; ni < 4; ni++) acc[mi][ni] = mfma16(af[ni], bfr[mi], acc[mi][ni]);
        __builtin_amdgcn_sched_barrier(0);
    }
}
__device__ __forceinline__ void gemm_core(f32x4 (&acc)[8][4], const bf16_t* __restrict__ X, int ldx, const bf16_t* __restrict__ W, int ldw,
                                          int K, int m0, int n0, char* lds) {
    const GemmSrc g = gemm_src(X, ldx, W, ldw, m0, n0);
    gemm_prologue(g, lds);
    gemm_mainloop(acc, g, K, lds);
    __syncthreads();
}
__device__ __forceinline__ void zero_acc(f32x4 (&acc)[8][4]) {
#pragma unroll
    for (int a = 0; a < 8; a++)
#pragma unroll
        for (int b = 0; b < 4; b++) acc[a][b] = (f32x4){0.f, 0.f, 0.f, 0.f};
}

constexpr int EPI_ROWB = 528;
__device__ __forceinline__ void epi_fill(char* lds, int wr, int wc, int r, int q, int mi, int ni, f32x4 v) {
    *(u32x2*)(lds + (wr * 128 + mi * 16 + r) * EPI_ROWB + (wc * 64 + ni * 16 + 4 * q) * 2) = (u32x2){pack2(v[0], v[1]), pack2(v[2], v[3])};
}
__device__ __forceinline__ void epi_store(const char* lds, bf16_t* __restrict__ O, int ldo, int m0, int n0, int ncols_valid) {
    const int t = TIDX512;
    const int chunk = t & 31, rsub = t >> 5;
    if (n0 + chunk * 8 < ncols_valid) {
#pragma unroll
        for (int ps = 0; ps < 16; ps++) {
            const int row = ps * 16 + rsub;
            const u32x4 v = *(const u32x4*)(lds + row * EPI_ROWB + chunk * 16);
            *(u32x4*)(O + (size_t)(m0 + row) * ldo + n0 + chunk * 8) = v;
        }
    }
}

struct TileIter {
    int nt, i, x, li; bool fancy;
    __device__ TileIter(int ntiles_n, const char*) { nt = ntiles_n; fancy = (gridDim.x == 256) && ((nt & 3) == 0); x = blockIdx.x & 7; li = blockIdx.x >> 3; i = fancy ? 0 : blockIdx.x; }
    __device__ bool next(int& bm, int& bn) {
        if (fancy) {
            if (i * 4 >= nt) return false;
            bm = x * 8 + (li & 7); bn = i * 4 + (li >> 3); i++; return true;
        }
        if (i >= 64 * nt) return false;
        bn = i % nt; bm = i / nt; i += gridDim.x; return true;
    }
};

struct MapId { __device__ int operator()(int n) const { return n; } };
struct MapWin {
    __device__ int operator()(int n) const { return n < 3072 ? n : (n < 4912 ? n + 16 : (n < 4928 ? n - 1840 : -1)); }
};
struct MapOff { int off; __device__ int operator()(int n) const { return n + off; } };

template <class Map>
__device__ __forceinline__ void tconv_tile(const float* __restrict__ src, int ldsrc, bf16_t* __restrict__ dst, int ldd, int n0, int k0, Map map, float* t) {
    const int tid = TIDX;
    const int n = tid & 63, kb = tid >> 6;
    const int sc = map(n0 + n);
#pragma unroll
    for (int i = 0; i < 16; i++) { const int k = i * 4 + kb; t[k * 65 + n] = sc >= 0 ? src[(size_t)(k0 + k) * ldsrc + sc] : 0.f; }
    __syncthreads();
    const int nn = tid >> 2, kk = (tid & 3) * 16;
    unsigned w[8];
#pragma unroll
    for (int j = 0; j < 8; j++) w[j] = pack2(t[(kk + 2 * j) * 65 + nn], t[(kk + 2 * j + 1) * 65 + nn]);
    u32x4* d = (u32x4*)(dst + (size_t)(n0 + nn) * ldd + k0 + kk);
    d[0] = (u32x4){w[0], w[1], w[2], w[3]};
    d[1] = (u32x4){w[4], w[5], w[6], w[7]};
    __syncthreads();
}

constexpr int TA_MOD = 192, TA_WIN = 78 * 16, TA_WM = 32 * 16, TA_SQ = 16 * 16, TA_WQ = 32 * 16, TA_WC = 32, TA_K12 = 64, TA_ROPE = 512;
constexpr int TA_E0 = TA_MOD, TA_E1 = TA_E0 + TA_WIN, TA_E2 = TA_E1 + TA_WM, TA_E3 = TA_E2 + TA_SQ, TA_E4 = TA_E3 + TA_SQ, TA_E5 = TA_E4 + TA_SQ,
              TA_E6 = TA_E5 + TA_WQ, TA_E7 = TA_E6 + TA_WC, TA_E8 = TA_E7 + TA_WC, TA_E9 = TA_E8 + TA_K12, TA_E10 = TA_E9 + TA_K12, TA_E11 = TA_E10 + TA_ROPE;

__device__ void phaseA(const Params& p, char* lds) {
    const int tid = TIDX;
    float* fl = (float*)lds;
    for (int task = vblk(); task < TA_E11; task += vgrid()) {
        if (task < TA_E0) {
            float* sc = fl;
            float* red = fl + 8192;
            for (int i = tid; i < 8192; i += NTHREADS) sc[i] = siluf_(p.c[i]);
            __syncthreads();
            const int n = task * 32 + (tid & 31), kg = tid >> 5;
            float a[8];
#pragma unroll
            for (int b = 0; b < 8; b++) a[b] = 0.f;
            for (int k = kg * 128; k < kg * 128 + 128; k++) {
                const float w = p.ada_w[(size_t)k * 6144 + n];
#pragma unroll
                for (int b = 0; b < 8; b++) a[b] += sc[b * 1024 + k] * w;
            }
#pragma unroll
            for (int b = 0; b < 8; b++) red[(kg * 8 + b) * 32 + (tid & 31)] = a[b];
            __syncthreads();
            {
                const int b = tid >> 5, nn = tid & 31;
                float s = 0.f;
#pragma unroll
                for (int g = 0; g < 8; g++) s += red[(g * 8 + b) * 32 + nn];
                ((float*)(p.ws + OFF_MOD))[b * 6144 + task * 32 + nn] = s + p.ada_b[task * 32 + nn];
            }
            __syncthreads();
        } else if (task < TA_E1) {
            const int tt = task - TA_E0;
            tconv_tile(p.w_in, 6976, (bf16_t*)(p.ws + OFF_WIN), 1024, (tt >> 4) * 64, (tt & 15) * 64, MapWin(), fl);
        } else if (task < TA_E2) {
            const int tt = task - TA_E1;
            tconv_tile(p.w_in, 6976, (bf16_t*)(p.ws + OFF_WM), 1024, (tt >> 4) * 64, (tt & 15) * 64, MapOff{4928}, fl);
        } else if (task < TA_E3) {
            const int tt = task - TA_E2;
            tconv_tile(p.w_branch_a, 1024, (bf16_t*)(p.ws + OFF_WA), 1024, (tt >> 4) * 64, (tt & 15) * 64, MapId(), fl);
        } else if (task < TA_E4) {
            const int tt = task - TA_E3;
            tconv_tile(p.w_branch_b, 1024, (bf16_t*)(p.ws + OFF_WB), 1024, (tt >> 4) * 64, (tt & 15) * 64, MapId(), fl);
        } else if (task < TA_E5) {
            const int tt = task - TA_E4;
            tconv_tile(p.w_out, 1024, (bf16_t*)(p.ws + OFF_WO), 1024, (tt >> 4) * 64, (tt & 15) * 64, MapId(), fl);
        } else if (task < TA_E6) {
            const int tt = task - TA_E5;
            tconv_tile(p.peer_wq, 2048, (bf16_t*)(p.ws + OFF_WQ), 1024, (tt >> 4) * 64, (tt & 15) * 64, MapId(), fl);
        } else if (task < TA_E7) {
            const int tt = task - TA_E6;
            tconv_tile(p.ck_w1, 64, (bf16_t*)(p.ws + OFF_WC1), 2048, 0, tt * 64, MapId(), fl);
        } else if (task < TA_E8) {
            const int tt = task - TA_E7;
            tconv_tile(p.cv_w1, 64, (bf16_t*)(p.ws + OFF_WC1) + 64 * 2048, 2048, 0, tt * 64, MapId(), fl);
        } else if (task < TA_E10) {
            const bool second = task >= TA_E9;
            const int tt = task - (second ? TA_E9 : TA_E8);
            const float* src = second ? p.peer_k2 : p.peer_k1;
            bf16_t* dst = (bf16_t*)(p.ws + OFF_K1B) + (second ? 131072 : 0);
            const int i = tt * 2048 + tid * 8;
            const f32x4 a = *(const f32x4*)(src + i), b = *(const f32x4*)(src + i + 4);
            *(u32x4*)(dst + i) = (u32x4){pack2(a[0], a[1]), pack2(a[2], a[3]), pack2(b[0], b[1]), pack2(b[2], b[3])};
        } else {
            const int tt = task - TA_E10;
            const int e = tt * 256 + tid;
            const int tok = e >> 3, i = e & 7;
            const float invf[8] = {1.0f, 0.1939227432012558f, 0.03760603070259094f, 0.007292664609849453f,
                                   0.0014142135623842478f, 0.00027424818836152554f, 5.318296098266728e-05f, 1.0313386155758053e-05f};
            float fr = invf[0];
#pragma unroll
            for (int j = 1; j < 8; j++) fr = (i == j) ? invf[j] : fr;
            const float ang = (float)p.pos[tok] * fr;
            const double rev = (double)ang * 0.15915494309189533577;
            const float fpart = (float)(rev - floor(rev));
            float* cs = (float*)(p.ws + OFF_ROPE);
            cs[e * 2] = __builtin_amdgcn_cosf(fpart);
            cs[e * 2 + 1] = __builtin_amdgcn_sinf(fpart);
        }
    }
}

__device__ void phase_modnorm(const Params& p, const float* __restrict__ src, const float* __restrict__ g, int shift_idx, int scale_idx, bf16_t* __restrict__ dst) {
    const int tid_ = TIDX; const int lane = tid_ & 63, wave = tid_ >> 6;
    const float* mod = (const float*)(p.ws + OFF_MOD);
    for (int tok = vblk() * 4 + wave; tok < NTOK; tok += vgrid() * 4) {
        const int b = tok >> 11;
        const float* xr = src + (size_t)tok * DM;
        f32x4 v[4];
        float ss = 0.f;
#pragma unroll
        for (int c = 0; c < 4; c++) { v[c] = *(const f32x4*)(xr + c * 256 + lane * 4); ss += v[c][0] * v[c][0] + v[c][1] * v[c][1] + v[c][2] * v[c][2] + v[c][3] * v[c][3]; }
        ss = wave_sum(ss);
        const float rstd = rsqrtf(ss * (1.f / 1024.f) + 1e-6f);
#pragma unroll
        for (int c = 0; c < 4; c++) {
            const int d = c * 256 + lane * 4;
            const f32x4 gg = *(const f32x4*)(g + d);
            const f32x4 sc = *(const f32x4*)(mod + b * 6144 + scale_idx * 1024 + d);
            const f32x4 sh = *(const f32x4*)(mod + b * 6144 + shift_idx * 1024 + d);
            float o[4];
#pragma unroll
            for (int j = 0; j < 4; j++) o[j] = (v[c][j] * rstd) * gg[j] * (1.f + sc[j]) + sh[j];
            *(u32x2*)(dst + (size_t)tok * DM + d) = (u32x2){pack2(o[0], o[1]), pack2(o[2], o[3])};
        }
    }
}

__device__ void phaseC(const Params& p, char* lds) {
    const int tid_ = TIDX512; const int lane = tid_ & 63, wave = tid_ >> 6;
    const int wr = wave >> 2, wc = wave & 3, r = lane & 15, q = lane >> 4;
    const bf16_t* H = (const bf16_t*)(p.ws + OFF_H);
    const bf16_t* W = (const bf16_t*)(p.ws + OFF_WIN);
    bf16_t* Z = (bf16_t*)(p.ws + OFF_Z);
    const float* cs = (const float*)(p.ws + OFF_ROPE);
    constexpr int NTN = (ZC + 255) / 256;
    TileIter tit(NTN, lds);
    int bm, bn;
    while (tit.next(bm, bn)) {
        const int m0 = bm * 256, n0 = bn * 256;
        f32x4 acc[8][4];
        zero_acc(acc);
        gemm_core(acc, H, DM, W, DM, DM, m0, n0, lds);
        const int c0 = n0 + wc * 64;
        const bool isq = (c0 >= ZQ_N && c0 < ZKC);
        const bool rope = isq || (c0 >= ZKC && c0 < ZGATE && ((c0 - ZKC) & 255) < 128);
        const float scl = isq ? 0.18033688011112042f : 1.f;
#pragma unroll
        for (int mi = 0; mi < 8; mi++) {
            const int tok = m0 + wr * 128 + mi * 16 + r;
            if (rope) {
                f32x4 v = acc[mi][0];
                f32x4 pr;
#pragma unroll
                for (int j = 0; j < 4; j++) pr[j] = __shfl_xor(v[j], 32, 64);
                const int ib = (q & 1) * 4;
                const f32x4 k0 = *(const f32x4*)(cs + (size_t)tok * 16 + ib * 2);
                const f32x4 k1 = *(const f32x4*)(cs + (size_t)tok * 16 + ib * 2 + 4);
                const float cc[4] = {k0[0], k0[2], k1[0], k1[2]}, sn[4] = {k0[1], k0[3], k1[1], k1[3]};
#pragma unroll
                for (int j = 0; j < 4; j++) v[j] = (q < 2) ? (v[j] * cc[j] - pr[j] * sn[j]) : (v[j] * cc[j] + pr[j] * sn[j]);
                acc[mi][0] = v;
            }
#pragma unroll
            for (int ni = 0; ni < 4; ni++) epi_fill(lds, wr, wc, r, q, mi, ni, acc[mi][ni] * scl);
        }
        __syncthreads();
        epi_store(lds, Z, ZC, m0, n0, ZC);
        __syncthreads();
    }
}

__device__ __forceinline__ void gla_prep(const Params& p, int tok0, int h, char* lds) {
    const int tid = TIDX;
    float* bc = (float*)lds;
    float* lrs = (float*)(lds + 32768);
    const bf16_t* Z = (const bf16_t*)(p.ws + OFF_Z);
    for (int i = tid; i < 1024; i += NTHREADS) { const int t = i >> 4, rr = i & 15; lrs[i] = bf2f(Z[(size_t)(tok0 + t) * ZC + ZLR + rr]); }
    const int d = tid & 127, th = tid >> 7;
    float w[16];
#pragma unroll
    for (int rr = 0; rr < 16; rr++) w[rr] = p.gla_wa2[rr * 512 + h * 128 + d];
    const float bias = p.gla_ba2[h * 128 + d];
    __syncthreads();
    float run = 0.f;
    for (int t = th * 32; t < th * 32 + 32; t++) {
        float xv = bias;
#pragma unroll
        for (int rr = 0; rr < 16; rr++) xv += lrs[t * 16 + rr] * w[rr];
        const float ls = fminf(xv, 0.f) - log1pf(__expf(-fabsf(xv)));
        run += ls * (1.f / 16.f);
        bc[t * 128 + d] = run;
    }
    __syncthreads();
    if (th == 1) {
        const float add = bc[31 * 128 + d];
        for (int t = 32; t < 64; t++) bc[t * 128 + d] += add;
    }
    __syncthreads();
}

__device__ void phaseG1_task(const Params& p, int task, char* lds) {
    const int tid = TIDX, lane = tid & 63, wave = tid >> 6, r = lane & 15, q = lane >> 4;
    const int c = task & 31, h = (task >> 5) & 3, b = task >> 7;
    const int tok0 = b * SEQ + c * 64;
    const bf16_t* Z = (const bf16_t*)(p.ws + OFF_Z);
    bf16_t* L = (bf16_t*)p.out;
    float* bc = (float*)lds;
    bf16_t* klT = (bf16_t*)(lds + 36864);
    bf16_t* vT = (bf16_t*)(lds + 36864 + 18432);
    gla_prep(p, tok0, h, lds);
    if (tid < 128) ((float*)(p.ws + OFF_DEC))[task * 128 + tid] = __expf(bc[63 * 128 + tid]);
    {
        const int s = lane, dc = wave * 32;
        const bf16_t* kp = Z + (size_t)(tok0 + s) * ZC + ZK_G + h * 128 + dc;
#pragma unroll
        for (int v4 = 0; v4 < 4; v4++) {
            const u32x4 kv = *(const u32x4*)(kp + v4 * 8);
            const unsigned kw[4] = {kv.x, kv.y, kv.z, kv.w};
#pragma unroll
            for (int j = 0; j < 8; j++) {
                const int d = dc + v4 * 8 + j;
                const float kval = (j & 1) ? bf_hi(kw[j >> 1]) : bf_lo(kw[j >> 1]);
                klT[d * 72 + s] = f2bf(kval * __expf(bc[63 * 128 + d] - bc[s * 128 + d]));
            }
        }
    }
    for (int eh = 0; eh < 2; eh++) {
        __syncthreads();
        {
            const int s = lane, ec = wave * 32;
            const bf16_t* vp = Z + (size_t)(tok0 + s) * ZC + ZV_G + h * 256 + eh * 128 + ec;
#pragma unroll
            for (int v4 = 0; v4 < 4; v4++) {
                const u32x4 vv = *(const u32x4*)(vp + v4 * 8);
                const unsigned vw[4] = {vv.x, vv.y, vv.z, vv.w};
#pragma unroll
                for (int j = 0; j < 8; j++) vT[(ec + v4 * 8 + j) * 72 + s] = (bf16_t)((j & 1) ? (vw[j >> 1] >> 16) : (vw[j >> 1] & 0xffffu));
            }
        }
        __syncthreads();
        f32x4 acc[8][2];
#pragma unroll
        for (int dt = 0; dt < 8; dt++) { acc[dt][0] = (f32x4){0.f, 0.f, 0.f, 0.f}; acc[dt][1] = (f32x4){0.f, 0.f, 0.f, 0.f}; }
#pragma unroll
        for (int ks = 0; ks < 2; ks++) {
            bf16x8 bv[2];
#pragma unroll
            for (int x = 0; x < 2; x++) bv[x] = ld_frag(vT + ((2 * wave + x) * 16 + r) * 72 + ks * 32 + q * 8);
#pragma unroll
            for (int dt = 0; dt < 8; dt++) {
                const bf16x8 a = ld_frag(klT + (dt * 16 + r) * 72 + ks * 32 + q * 8);
#pragma unroll
                for (int x = 0; x < 2; x++) acc[dt][x] = mfma16(a, bv[x], acc[dt][x]);
            }
        }
#pragma unroll
        for (int dt = 0; dt < 8; dt++)
#pragma unroll
            for (int x = 0; x < 2; x++) {
                const int e = eh * 128 + (2 * wave + x) * 16 + r, d = dt * 16 + 4 * q;
                const f32x4 v = acc[dt][x];
                *(u32x2*)(L + ((size_t)task * 256 + e) * 128 + d) = (u32x2){pack2(v[0], v[1]), pack2(v[2], v[3])};
            }
    }
    __syncthreads();
}

__device__ void phaseG2(const Params& p) {
    bf16_t* L = (bf16_t*)p.out;
    const float* dec = (const float*)(p.ws + OFF_DEC);
    for (int idx = vblk() * NTHREADS + (int)(threadIdx.x & 255); idx < 32 * 256 * 16; idx += vgrid() * NTHREADS) {
        const int d8 = idx & 15, e = (idx >> 4) & 255, bh = idx >> 12;
        float st[8];
#pragma unroll
        for (int j = 0; j < 8; j++) st[j] = 0.f;
        for (int c = 0; c < 32; c++) {
            const int task = bh * 32 + c;
            u32x4* ptr = (u32x4*)(L + ((size_t)task * 256 + e) * 128 + d8 * 8);
            const u32x4 lv = *ptr;
            const f32x4 d0 = *(const f32x4*)(dec + task * 128 + d8 * 8), d1 = *(const f32x4*)(dec + task * 128 + d8 * 8 + 4);
            *ptr = (u32x4){pack2(st[0], st[1]), pack2(st[2], st[3]), pack2(st[4], st[5]), pack2(st[6], st[7])};
            st[0] = d0[0] * st[0] + bf_lo(lv.x); st[1] = d0[1] * st[1] + bf_hi(lv.x);
            st[2] = d0[2] * st[2] + bf_lo(lv.y); st[3] = d0[3] * st[3] + bf_hi(lv.y);
            st[4] = d1[0] * st[4] + bf_lo(lv.z); st[5] = d1[1] * st[5] + bf_hi(lv.z);
            st[6] = d1[2] * st[6] + bf_lo(lv.w); st[7] = d1[3] * st[7] + bf_hi(lv.w);
        }
    }
}

__device__ void phaseG3_task(const Params& p, int task, char* lds, bf16_t* ydst, int ystride) {
    const int tid = TIDX, lane = tid & 63, wave = tid >> 6, r = lane & 15, q = lane >> 4;
    const int c = task & 31, h = (task >> 5) & 3, b = task >> 7;
    const int tok0 = b * SEQ + c * 64;
    bf16_t* Z = (bf16_t*)(p.ws + OFF_Z);
    const bf16_t* ST = (const bf16_t*)p.out + (size_t)task * 256 * 128;
    float* bc = (float*)lds;
    bf16_t* vT = (bf16_t*)lds;
    bf16_t* qg = (bf16_t*)(lds + 36864);
    bf16_t* kg = (bf16_t*)(lds + 36864 + 17408);
    bf16_t* P = kg;
    float* red = (float*)(lds + 36864 + 2 * 17408);
    gla_prep(p, tok0, h, lds);
    {
        const int t = tid >> 2, dc = (tid & 3) * 32;
        const bf16_t* qp = Z + (size_t)(tok0 + t) * ZC + ZQ_G + h * 128 + dc;
        const bf16_t* kp = Z + (size_t)(tok0 + t) * ZC + ZK_G + h * 128 + dc;
#pragma unroll
        for (int v4 = 0; v4 < 4; v4++) {
            const u32x4 qv = *(const u32x4*)(qp + v4 * 8), kv = *(const u32x4*)(kp + v4 * 8);
            const unsigned qw[4] = {qv.x, qv.y, qv.z, qv.w}, kw[4] = {kv.x, kv.y, kv.z, kv.w};
            unsigned qo[4], ko[4];
#pragma unroll
            for (int j2 = 0; j2 < 4; j2++) {
                const int d = dc + v4 * 8 + j2 * 2;
                const float b0 = bc[t * 128 + d], b1 = bc[t * 128 + d + 1];
                qo[j2] = pack2(bf_lo(qw[j2]) * 0.08838834764831845f * __expf(b0), bf_hi(qw[j2]) * 0.08838834764831845f * __expf(b1));
                ko[j2] = pack2(bf_lo(kw[j2]) * __expf(-b0), bf_hi(kw[j2]) * __expf(-b1));
            }
            *(u32x4*)(qg + t * 136 + dc + v4 * 8) = (u32x4){qo[0], qo[1], qo[2], qo[3]};
            *(u32x4*)(kg + t * 136 + dc + v4 * 8) = (u32x4){ko[0], ko[1], ko[2], ko[3]};
        }
    }
    __syncthreads();
    {
        const int s = lane, ec = wave * 64;
        const bf16_t* vp = Z + (size_t)(tok0 + s) * ZC + ZV_G + h * 256 + ec;
#pragma unroll
        for (int v4 = 0; v4 < 8; v4++) {
            const u32x4 vv = *(const u32x4*)(vp + v4 * 8);
            const unsigned vw[4] = {vv.x, vv.y, vv.z, vv.w};
#pragma unroll
            for (int j = 0; j < 8; j++) vT[(ec + v4 * 8 + j) * 72 + s] = (bf16_t)((j & 1) ? (vw[j >> 1] >> 16) : (vw[j >> 1] & 0xffffu));
        }
    }
    f32x4 sc[4];
#pragma unroll
    for (int st = 0; st < 4; st++) sc[st] = (f32x4){0.f, 0.f, 0.f, 0.f};
    {
        bf16x8 qf[4];
#pragma unroll
        for (int ks = 0; ks < 4; ks++) qf[ks] = ld_frag(qg + (wave * 16 + r) * 136 + ks * 32 + q * 8);
#pragma unroll
        for (int st = 0; st < 4; st++) {
            if (st <= wave) {
#pragma unroll
                for (int ks = 0; ks < 4; ks++) sc[st] = mfma16(ld_frag(kg + (st * 16 + r) * 136 + ks * 32 + q * 8), qf[ks], sc[st]);
            }
        }
    }
    __syncthreads();
    {
        const int t = wave * 16 + r;
#pragma unroll
        for (int st = 0; st < 4; st++) {
            float pv[4];
#pragma unroll
            for (int j = 0; j < 4; j++) { const int s = st * 16 + 4 * q + j; pv[j] = (s <= t) ? sc[st][j] : 0.f; }
            *(u32x2*)(P + t * 72 + st * 16 + 4 * q) = (u32x2){pack2(pv[0], pv[1]), pack2(pv[2], pv[3])};
        }
    }
    __syncthreads();
    f32x4 o[4][4];
#pragma unroll
    for (int et = 0; et < 4; et++)
#pragma unroll
        for (int tt = 0; tt < 4; tt++) o[et][tt] = (f32x4){0.f, 0.f, 0.f, 0.f};
#pragma unroll
    for (int ks = 0; ks < 2; ks++) {
        bf16x8 pf[4];
#pragma unroll
        for (int tt = 0; tt < 4; tt++) pf[tt] = ld_frag(P + (tt * 16 + r) * 72 + ks * 32 + q * 8);
#pragma unroll
        for (int et = 0; et < 4; et++) {
            const bf16x8 a = ld_frag(vT + ((wave * 4 + et) * 16 + r) * 72 + ks * 32 + q * 8);
#pragma unroll
            for (int tt = 0; tt < 4; tt++) o[et][tt] = mfma16(a, pf[tt], o[et][tt]);
        }
    }
#pragma unroll
    for (int ks = 0; ks < 4; ks++) {
        bf16x8 qf[4];
#pragma unroll
        for (int tt = 0; tt < 4; tt++) qf[tt] = ld_frag(qg + (tt * 16 + r) * 136 + ks * 32 + q * 8);
#pragma unroll
        for (int et = 0; et < 4; et++) {
            const bf16x8 a = *(const bf16x8*)(ST + (size_t)((wave * 4 + et) * 16 + r) * 128 + ks * 32 + q * 8);
#pragma unroll
            for (int tt = 0; tt < 4; tt++) o[et][tt] = mfma16(a, qf[tt], o[et][tt]);
        }
    }
#pragma unroll
    for (int tt = 0; tt < 4; tt++) {
        float ss = 0.f;
#pragma unroll
        for (int et = 0; et < 4; et++)
#pragma unroll
            for (int j = 0; j < 4; j++) ss += o[et][tt][j] * o[et][tt][j];
        ss += __shfl_xor(ss, 16, 64);
        ss += __shfl_xor(ss, 32, 64);
        if (q == 0) red[wave * 64 + tt * 16 + r] = ss;
    }
    __syncthreads();
#pragma unroll
    for (int tt = 0; tt < 4; tt++) {
        const int t = tt * 16 + r;
        const float tot = red[t] + red[64 + t] + red[128 + t] + red[192 + t];
        const float rstd = rsqrtf(tot * (1.f / 256.f) + 1e-6f);
#pragma unroll
        for (int et = 0; et < 4; et++) {
            const int e = (wave * 4 + et) * 16 + 4 * q;
            bf16_t* rp = Z + (size_t)(tok0 + t) * ZC + ZR_G + h * 256 + e;
            const u32x2 rv = *(const u32x2*)rp;
            const f32x4 gn = *(const f32x4*)(p.gla_norm_g + e);
            const float r0 = bf_lo(rv.x), r1 = bf_hi(rv.x), r2 = bf_lo(rv.y), r3 = bf_hi(rv.y);
            const f32x4 ov = o[et][tt];
            *(u32x2*)(ydst + (size_t)(tok0 + t) * ystride + h * 256 + e) = (u32x2){pack2(ov[0] * rstd * gn[0] * siluf_(r0), ov[1] * rstd * gn[1] * siluf_(r1)),
                                  pack2(ov[2] * rstd * gn[2] * siluf_(r2), ov[3] * rstd * gn[3] * siluf_(r3))};
        }
    }
    __syncthreads();
}

__device__ void phaseN1_task(const Params& p, int task, char* lds) {
    const int tid = TIDX, lane = tid & 63, wave = tid >> 6, r = lane & 15, q = lane >> 4;
    const int it = task & 7, g = (task >> 3) & 1, b = (task >> 4) & 7, kv = task >> 7;
    const bf16_t* Z = (const bf16_t*)(p.ws + OFF_Z);
    const bf16_t* W1 = (const bf16_t*)(p.ws + OFF_WC1) + (size_t)kv * 64 * 2048;
    const float* pe = kv ? p.pe_v : p.pe_k;
    const float* w2 = kv ? p.cv_w2 : p.ck_w2;
    const int zoff = (kv ? ZVC : ZKC) + g * 64;
    float* hid = (float*)lds;
    float* hid2 = (float*)(lds + 16384);
    int i = it * 16 + r; if (i > 126) i = 126;
    f32x4 acc[4];
#pragma unroll
    for (int nt = 0; nt < 4; nt++) acc[nt] = (f32x4){0.f, 0.f, 0.f, 0.f};
    for (int ks = 0; ks < 16; ks++) {
        const int k = wave * 512 + ks * 32 + q * 8;
        const int l = k >> 6, d = k & 63;
        const u32x4 zv = *(const u32x4*)(Z + (size_t)(b * SEQ + i * 16 + l) * ZC + zoff + d);
        const f32x4 p0 = *(const f32x4*)(pe + l * 64 + d), p1 = *(const f32x4*)(pe + l * 64 + d + 4);
        const u32x4 av = {pack2(bf_lo(zv.x) + p0[0], bf_hi(zv.x) + p0[1]), pack2(bf_lo(zv.y) + p0[2], bf_hi(zv.y) + p0[3]),
                          pack2(bf_lo(zv.z) + p1[0], bf_hi(zv.z) + p1[1]), pack2(bf_lo(zv.w) + p1[2], bf_hi(zv.w) + p1[3])};
        const bf16x8 a = __builtin_bit_cast(bf16x8, av);
#pragma unroll
        for (int nt = 0; nt < 4; nt++) {
            const bf16x8 bw = *(const bf16x8*)(W1 + (size_t)(nt * 16 + r) * 2048 + k);
            acc[nt] = mfma16(a, bw, acc[nt]);
        }
    }
#pragma unroll
    for (int nt = 0; nt < 4; nt++)
#pragma unroll
        for (int j = 0; j < 4; j++) hid[(wave * 16 + 4 * q + j) * 64 + nt * 16 + r] = acc[nt][j];
    __syncthreads();
    for (int e = tid; e < 1024; e += NTHREADS) hid2[e] = gelu_erf(hid[e] + hid[1024 + e] + hid[2048 + e] + hid[3072 + e]);
    __syncthreads();
    {
        const int il = tid >> 4, n2 = (tid & 15) * 4;
        f32x4 o = {0.f, 0.f, 0.f, 0.f};
        for (int n = 0; n < 64; n++) {
            const float hv = hid2[il * 64 + n];
            const f32x4 wv = *(const f32x4*)(w2 + n * 64 + n2);
            o += hv * wv;
        }
        const int ig = it * 16 + il;
        if (ig >= 127) o = (f32x4){0.f, 0.f, 0.f, 0.f};
        bf16_t* dst = (bf16_t*)(p.ws + OFF_CMP) + ((size_t)((kv * 8 + b) * 2 + g) * 128 + ig) * 64 + n2;
        *(u32x2*)dst = (u32x2){pack2(o[0], o[1]), pack2(o[2], o[3])};
    }
    __syncthreads();
}

__device__ __forceinline__ void nsa_load_kv(const bf16_t* __restrict__ kbase, const bf16_t* __restrict__ vbase, size_t rowstride, bf16_t* Ks, bf16_t* VT) {
    const int tid = TIDX;
    {
        const int key = tid >> 2, ch = (tid & 3) * 16;
        const u32x4 a = *(const u32x4*)(kbase + (size_t)key * rowstride + ch), b = *(const u32x4*)(kbase + (size_t)key * rowstride + ch + 8);
        *(u32x4*)(Ks + key * 72 + ch) = a;
        *(u32x4*)(Ks + key * 72 + ch + 8) = b;
    }
    {
        const int key = tid & 63, dc = (tid >> 6) * 16;
        const u32x4 a = *(const u32x4*)(vbase + (size_t)key * rowstride + dc), b = *(const u32x4*)(vbase + (size_t)key * rowstride + dc + 8);
        const unsigned w[8] = {a.x, a.y, a.z, a.w, b.x, b.y, b.z, b.w};
#pragma unroll
        for (int j = 0; j < 16; j++) VT[(dc + j) * 72 + key] = (bf16_t)((j & 1) ? (w[j >> 1] >> 16) : (w[j >> 1] & 0xffffu));
    }
}

__device__ __forceinline__ void nsa_block_step(const bf16_t* Ks, const bf16_t* VT, const bf16x8 (&qf)[2][2], f32x4 (&O)[2][4], float (&m)[2], float (&l)[2],
                                               int klo, int khi, int r, int q) {
    f32x4 s[2][4];
#pragma unroll
    for (int x = 0; x < 2; x++)
#pragma unroll
        for (int kt = 0; kt < 4; kt++) s[x][kt] = (f32x4){0.f, 0.f, 0.f, 0.f};
#pragma unroll
    for (int kt = 0; kt < 4; kt++)
#pragma unroll
        for (int ks = 0; ks < 2; ks++) {
            const bf16x8 kf = ld_frag(Ks + (kt * 16 + r) * 64 + (((ks * 4 + q) ^ (r & 7)) * 8));
#pragma unroll
            for (int x = 0; x < 2; x++) s[x][kt] = mfma16(kf, qf[x][ks], s[x][kt]);
        }
    __builtin_amdgcn_sched_barrier(0);
    if (!__all((klo <= 0) && (khi >= 63))) {
        const int a = 4 * q - klo;
        const unsigned range = (unsigned)(khi - klo);
        const bool any = khi >= klo;
#pragma unroll
        for (int kt = 0; kt < 4; kt++)
#pragma unroll
            for (int j = 0; j < 4; j++) {
                const bool valid = any && ((unsigned)(kt * 16 + j + a) <= range);
#pragma unroll
                for (int x = 0; x < 2; x++) s[x][kt][j] = valid ? s[x][kt][j] : -3.0e38f;
            }
    }
    bf16x8 pbv[2][2];
#pragma unroll
    for (int x = 0; x < 2; x++) {
        float mx = fmaxf(fmaxf(fmaxf(s[x][0][0], s[x][0][1]), fmaxf(s[x][0][2], s[x][0][3])), fmaxf(fmaxf(s[x][1][0], s[x][1][1]), fmaxf(s[x][1][2], s[x][1][3])));
        mx = fmaxf(mx, fmaxf(fmaxf(fmaxf(s[x][2][0], s[x][2][1]), fmaxf(s[x][2][2], s[x][2][3])), fmaxf(fmaxf(s[x][3][0], s[x][3][1]), fmaxf(s[x][3][2], s[x][3][3]))));
        mx = fmaxf(mx, __shfl_xor(mx, 16, 64));
        mx = fmaxf(mx, __shfl_xor(mx, 32, 64));
        const float mnew = fmaxf(m[x], mx);
        const float alpha = exp2f_(m[x] - mnew);
        m[x] = mnew;
        float ls = 0.f;
#pragma unroll
        for (int kt = 0; kt < 4; kt++)
#pragma unroll
            for (int j = 0; j < 4; j++) { const float pv = exp2f_(s[x][kt][j] - mnew); s[x][kt][j] = pv; ls += pv; }
        l[x] = l[x] * alpha + ls;
#pragma unroll
        for (int dt = 0; dt < 4; dt++) O[x][dt] *= alpha;
#pragma unroll
        for (int s2 = 0; s2 < 2; s2++) {
            const u32x4 t4 = {pack2(s[x][2 * s2][0], s[x][2 * s2][1]), pack2(s[x][2 * s2][2], s[x][2 * s2][3]),
                              pack2(s[x][2 * s2 + 1][0], s[x][2 * s2 + 1][1]), pack2(s[x][2 * s2 + 1][2], s[x][2 * s2 + 1][3])};
            pbv[x][s2] = __builtin_bit_cast(bf16x8, t4);
        }
    }
    __builtin_amdgcn_sched_barrier(0);
#pragma unroll
    for (int s2 = 0; s2 < 2; s2++)
#pragma unroll
        for (int dt = 0; dt < 4; dt++) {
            const u32x2 lo = *(const u32x2*)(VT + (dt * 16 + r) * 72 + (2 * s2) * 16 + 4 * q);
            const u32x2 hi = *(const u32x2*)(VT + (dt * 16 + r) * 72 + (2 * s2 + 1) * 16 + 4 * q);
            const bf16x8 va = mk_frag(lo, hi);
#pragma unroll
            for (int x = 0; x < 2; x++) O[x][dt] = mfma16(va, pbv[x][s2], O[x][dt]);
        }
    __builtin_amdgcn_sched_barrier(0);
}

__device__ __forceinline__ void nsa_cmp_probs(const bf16_t* Kc, const bf16x8 (&qfx)[2], int nv, int r, int q, f32x4 (&s)[8]) {
#pragma unroll
    for (int kt = 0; kt < 8; kt++) s[kt] = (f32x4){0.f, 0.f, 0.f, 0.f};
#pragma unroll
    for (int kt = 0; kt < 8; kt++)
#pragma unroll
        for (int ks = 0; ks < 2; ks++) s[kt] = mfma16(ld_frag(Kc + (kt * 16 + r) * 72 + ks * 32 + q * 8), qfx[ks], s[kt]);
    __builtin_amdgcn_sched_barrier(0);
    float mx = -1e30f;
#pragma unroll
    for (int kt = 0; kt < 8; kt++)
#pragma unroll
        for (int j = 0; j < 4; j++) if (kt * 16 + 4 * q + j < nv) mx = fmaxf(mx, s[kt][j]);
    mx = fmaxf(mx, __shfl_xor(mx, 16, 64));
    mx = fmaxf(mx, __shfl_xor(mx, 32, 64));
    float ls = 0.f;
#pragma unroll
    for (int kt = 0; kt < 8; kt++)
#pragma unroll
        for (int j = 0; j < 4; j++) {
            const float pv = (kt * 16 + 4 * q + j < nv) ? exp2f_(s[kt][j] - mx) : 0.f;
            s[kt][j] = pv; ls += pv;
        }
    ls += __shfl_xor(ls, 16, 64);
    ls += __shfl_xor(ls, 32, 64);
    const float inv = nv > 0 ? 1.f / ls : 0.f;
#pragma unroll
    for (int kt = 0; kt < 8; kt++) s[kt] *= inv;
}

__device__ void phaseN2_task(const Params& p, int task, char* lds, bf16_t* ydst, int ystride, volatile unsigned* uex, char* ldsb) {
    const int tid = TIDX, lane = tid & 63, wave = tid >> 6, r = lane & 15, q = lane >> 4;
    const int t512 = tid + half_id() * 256;
    const int pair = task >> 1, g = pair & 1, b = (pair >> 1) & 7;
    const int tt = (63 - (pair >> 4)) * 2 + (task & 1);
    const int t0 = tt * 16, t = t0 + r;
    const int cur = t0 >> 6;
    bf16_t* Z = (bf16_t*)(p.ws + OFF_Z);
    const size_t rowb = (size_t)b * SEQ;
    bf16_t* Kc = (bf16_t*)ldsb;
    bf16_t* VcT = (bf16_t*)(ldsb + 18432);
    bf16_t* Ks = (bf16_t*)ldsb;
    bf16_t* VT = (bf16_t*)(ldsb + 18432);
    float* impw = (float*)(lds + 35840);
    float* scs = (float*)(lds + 35840 + 32768);
    unsigned* selm = (unsigned*)(lds + 35840 + 32768 + 2048);

    bf16x8 qf[2][2];
#pragma unroll
    for (int x = 0; x < 2; x++)
#pragma unroll
        for (int ks = 0; ks < 2; ks++) qf[x][ks] = *(const bf16x8*)(Z + (rowb + t) * ZC + ZQ_N + (g * 8 + 2 * wave + x) * 64 + ks * 32 + q * 8);
    f32x4* ofl = (f32x4*)(lds + 35840);

    f32x4 Og[2][4];
    {
        const bf16_t* kc = (const bf16_t*)(p.ws + OFF_CMP) + (size_t)((0 * 8 + b) * 2 + g) * 128 * 64;
        const bf16_t* vc = (const bf16_t*)(p.ws + OFF_CMP) + (size_t)((1 * 8 + b) * 2 + g) * 128 * 64;
        {
            const int key = t512 >> 2, ch = (t512 & 3) * 16;
#pragma unroll
            for (int v4 = 0; v4 < 2; v4++) *(u32x4*)(Kc + key * 72 + ch + v4 * 8) = *(const u32x4*)(kc + key * 64 + ch + v4 * 8);
            const int k2 = t512 & 127, dc = (t512 >> 7) * 16;
#pragma unroll
            for (int v4 = 0; v4 < 2; v4++) {
                const u32x4 a = *(const u32x4*)(vc + k2 * 64 + dc + v4 * 8);
                const unsigned w[4] = {a.x, a.y, a.z, a.w};
#pragma unroll
                for (int j = 0; j < 8; j++) VcT[(dc + v4 * 8 + j) * 136 + k2] = (bf16_t)((j & 1) ? (w[j >> 1] >> 16) : (w[j >> 1] & 0xffffu));
            }
        }
        __syncthreads();
        int nv = t >= 31 ? ((t - 31) >> 4) + 1 : 0;
        if (nv > 127) nv = 127;
        f32x4 isum[8];
#pragma unroll
        for (int kt = 0; kt < 8; kt++) isum[kt] = (f32x4){0.f, 0.f, 0.f, 0.f};
#pragma unroll
        for (int x = 0; x < 2; x++) {
            f32x4 s[8];
            nsa_cmp_probs(Kc, qf[x], nv, r, q, s);
#pragma unroll
            for (int kt = 0; kt < 8; kt++) isum[kt] += s[kt];
            f32x4 Oc[4];
#pragma unroll
            for (int dt = 0; dt < 4; dt++) Oc[dt] = (f32x4){0.f, 0.f, 0.f, 0.f};
            __builtin_amdgcn_sched_barrier(0);
#pragma unroll
            for (int s2 = 0; s2 < 4; s2++) {
                const u32x4 t4 = {pack2(s[2 * s2][0], s[2 * s2][1]), pack2(s[2 * s2][2], s[2 * s2][3]),
                                  pack2(s[2 * s2 + 1][0], s[2 * s2 + 1][1]), pack2(s[2 * s2 + 1][2], s[2 * s2 + 1][3])};
                const bf16x8 pbv = __builtin_bit_cast(bf16x8, t4);
#pragma unroll
                for (int dt = 0; dt < 4; dt++) {
                    const u32x2 lo = *(const u32x2*)(VcT + (dt * 16 + r) * 136 + (2 * s2) * 16 + 4 * q);
                    const u32x2 hi = *(const u32x2*)(VcT + (dt * 16 + r) * 136 + (2 * s2 + 1) * 16 + 4 * q);
                    Oc[dt] = mfma16(mk_frag(lo, hi), pbv, Oc[dt]);
                }
            }
            const float g0 = sigmoidf_(bf2f(Z[(rowb + t) * ZC + ZGATE + 0 * 16 + g * 8 + 2 * wave + x]));
#pragma unroll
            for (int dt = 0; dt < 4; dt++) Og[x][dt] = g0 * Oc[dt];
            __builtin_amdgcn_sched_barrier(0);
        }
#pragma unroll
        for (int kt = 0; kt < 8; kt++) *(f32x4*)(impw + (wave * 16 + r) * 128 + kt * 16 + 4 * q) = isum[kt];
        __syncthreads();
#pragma unroll
        for (int pass = 0; pass < 2; pass++) {
            const int tk = pass * 8 + (tid >> 5), j = tid & 31;
            const int i0 = j == 0 ? 0 : 4 * j - 1, i1 = (4 * j + 3 > 126) ? 126 : 4 * j + 3;
            float sc = 0.f;
            for (int i = i0; i <= i1; i++) sc += (impw[(0 * 16 + tk) * 128 + i] + impw[(1 * 16 + tk) * 128 + i]) + (impw[(2 * 16 + tk) * 128 + i] + impw[(3 * 16 + tk) * 128 + i]);
            const bool forced = (j == 0) || (j == cur) || (j == cur - 1);
            scs[tk * 32 + j] = forced ? 1e6f : (j <= cur ? sc : -1.f);
        }
        __syncthreads();
#pragma unroll
        for (int pass = 0; pass < 2; pass++) {
            const int tk = pass * 8 + (tid >> 5), j = tid & 31;
            const float mine = scs[tk * 32 + j];
            int rank = 0;
            for (int j2 = 0; j2 < 32; j2++) { const float o = scs[tk * 32 + j2]; rank += (o > mine || (o == mine && j2 < j)) ? 1 : 0; }
            const unsigned long long bal = __ballot(rank < 16);
            if ((lane & 31) == 0) selm[tk] = (unsigned)(lane ? (bal >> 32) : (bal & 0xffffffffull));
        }
        __syncthreads();
    }
#pragma unroll
    for (int x = 0; x < 2; x++)
#pragma unroll
        for (int dt = 0; dt < 4; dt++) ofl[(wave * 8 + x * 4 + dt) * 64 + lane] = Og[x][dt];
    const unsigned mysel = selm[r];
    unsigned uni = 0;
#pragma unroll
    for (int i = 0; i < 16; i++) uni |= selm[i];
    if (tid == 0) uex[half_id()] = uni;
    __syncthreads();
    uni = uex[0] | uex[1];
    uni &= (cur == 31) ? 0xffffffffu : ((2u << cur) - 1u);
    uni |= 1u;

    {
        const int lo = (t0 & ~31) - 511;
        const int jb0 = lo > 0 ? (lo >> 6) : 0;
        const int kkey = t512 >> 3, kch = (t512 & 7) * 8;
        const int vkey = t512 & 63, vdc = (t512 >> 6) * 8;
        u32x4 kreg, vreg;
        int br = 0, j = 0;
        {
            const bf16_t* kb = Z + (rowb + 0) * ZC + ZKS + g * 64;
            const bf16_t* vb = Z + (rowb + 0) * ZC + ZVS + g * 64;
            kreg = *(const u32x4*)(kb + (size_t)kkey * ZC + kch);
            vreg = *(const u32x4*)(vb + (size_t)vkey * ZC + vdc);
        }
        f32x4 O[2][4];
        float m[2] = {-1e30f, -1e30f}, l[2] = {0.f, 0.f};
#pragma unroll
        for (int x = 0; x < 2; x++)
#pragma unroll
            for (int dt = 0; dt < 4; dt++) O[x][dt] = (f32x4){0.f, 0.f, 0.f, 0.f};
        for (;;) {
            __syncthreads();
            *(u32x4*)(Ks + kkey * 64 + (((kch >> 3) ^ (kkey & 7)) * 8)) = kreg;
            {
                const unsigned w[4] = {vreg.x, vreg.y, vreg.z, vreg.w};
#pragma unroll
                for (int jj = 0; jj < 8; jj++) VT[(vdc + jj) * 72 + vkey] = (bf16_t)((jj & 1) ? (w[jj >> 1] >> 16) : (w[jj >> 1] & 0xffffu));
            }
            __syncthreads();
            int nbr, nj;
            if (br == 0) {
                const unsigned rem = (j >= 31) ? 0u : (uni & ~((2u << j) - 1u));
                if (rem) { nbr = 0; nj = __ffs((int)rem) - 1; } else { nbr = 1; nj = jb0; }
            } else {
                if (j < cur) { nbr = 1; nj = j + 1; } else { nbr = 2; nj = 0; }
            }
            if (nbr < 2) {
                const bf16_t* kb = Z + (rowb + nj * 64) * ZC + (nbr ? ZKW : ZKS) + g * 64;
                const bf16_t* vb = Z + (rowb + nj * 64) * ZC + (nbr ? ZVW : ZVS) + g * 64;
                kreg = *(const u32x4*)(kb + (size_t)kkey * ZC + kch);
                vreg = *(const u32x4*)(vb + (size_t)vkey * ZC + vdc);
            }
            int klo = 0, khi = -1;
            if (br == 0) { if ((mysel >> j) & 1u) khi = t - j * 64; }
            else { khi = t - j * 64; klo = t - 511 - j * 64; }
            klo = klo < 0 ? 0 : klo;
            khi = khi > 63 ? 63 : khi;
            nsa_block_step(Ks, VT, qf, O, m, l, klo, khi, r, q);
            if (nbr != br) {
#pragma unroll
                for (int x = 0; x < 2; x++) {
                    float lt = l[x];
                    lt += __shfl_xor(lt, 16, 64);
                    lt += __shfl_xor(lt, 32, 64);
                    const float sc = sigmoidf_(bf2f(Z[(rowb + t) * ZC + ZGATE + (br + 1) * 16 + g * 8 + 2 * wave + x])) / lt;
#pragma unroll
                    for (int dt = 0; dt < 4; dt++) { ofl[(wave * 8 + x * 4 + dt) * 64 + lane] += sc * O[x][dt]; O[x][dt] = (f32x4){0.f, 0.f, 0.f, 0.f}; }
                    m[x] = -1e30f; l[x] = 0.f;
                }
            }
            if (nbr == 2) break;
            br = nbr; j = nj;
        }
#pragma unroll
        for (int x = 0; x < 2; x++)
#pragma unroll
            for (int dt = 0; dt < 4; dt++) {
                const f32x4 v = ofl[(wave * 8 + x * 4 + dt) * 64 + lane];
                *(u32x2*)(ydst + (rowb + t) * ystride + (g * 8 + 2 * wave + x) * 64 + dt * 16 + 4 * q) = (u32x2){pack2(v[0], v[1]), pack2(v[2], v[3])};
            }
    }
    __syncthreads();
}

__device__ void phaseM1(const Params& p, char* lds) {
    const int tid_ = TIDX512; const int lane = tid_ & 63, wave = tid_ >> 6;
    const int wr = wave >> 2, wc = wave & 3, r = lane & 15, q = lane >> 4;
    const bf16_t* H = (const bf16_t*)(p.ws + OFF_H);
    const bf16_t* Z = (const bf16_t*)(p.ws + OFF_Z);
    bf16_t* M = (bf16_t*)(p.ws + OFF_M);
    bf16_t* SG = (bf16_t*)p.out;
    TileIter tit(4, lds);
    int bm, bn;
    while (tit.next(bm, bn)) {
        const int m0 = bm * 256, n0 = bn * 256;
        for (int br = 0; br < 2; br++) {
            f32x4 acc[8][4];
            zero_acc(acc);
            gemm_core(acc, H, DM, (const bf16_t*)(p.ws + OFF_WM) + (size_t)br * 1024 * 1024, DM, DM, m0, n0, lds);
            {
                const int e0 = launder_i((m0 + wr * 128 + r) * DM + n0 + wc * 64 + 4 * q);
#pragma unroll
                for (int mi = 0; mi < 8; mi++)
#pragma unroll
                    for (int ni = 0; ni < 4; ni++)
                        *(u32x2*)(SG + (size_t)(e0 + mi * 16 * DM + ni * 16)) = (u32x2){pack2(sigmoidf_(acc[mi][ni][0]), sigmoidf_(acc[mi][ni][1])),
                                                                                        pack2(sigmoidf_(acc[mi][ni][2]), sigmoidf_(acc[mi][ni][3]))};
            }
            zero_acc(acc);
            gemm_core(acc, Z + (br ? ZQ_N : ZR_G), ZC, (const bf16_t*)(p.ws + (br ? OFF_WB : OFF_WA)), DM, DM, m0, n0, lds);
            {
                const int e0 = launder_i((m0 + wr * 128 + r) * DM + n0 + wc * 64 + 4 * q);
#pragma unroll
                for (int mi = 0; mi < 8; mi++)
#pragma unroll
                    for (int ni = 0; ni < 4; ni++) {
                        const size_t eo = (size_t)(e0 + mi * 16 * DM + ni * 16);
                        const u32x2 sg = *(const u32x2*)(SG + eo);
                        float v[4] = {bf_lo(sg.x) * acc[mi][ni][0], bf_hi(sg.x) * acc[mi][ni][1], bf_lo(sg.y) * acc[mi][ni][2], bf_hi(sg.y) * acc[mi][ni][3]};
                        u32x2* dst = (u32x2*)(M + eo);
                        if (br) { const u32x2 pv = *dst; v[0] += bf_lo(pv.x); v[1] += bf_hi(pv.x); v[2] += bf_lo(pv.y); v[3] += bf_hi(pv.y); }
                        *dst = (u32x2){pack2(v[0], v[1]), pack2(v[2], v[3])};
                    }
            }
        }
    }
}

__device__ void phaseM2(const Params& p, char* lds) {
    const int tid_ = TIDX512; const int lane = tid_ & 63, wave = tid_ >> 6;
    const int wr = wave >> 2, wc = wave & 3, r = lane & 15, q = lane >> 4;
    const bf16_t* M = (const bf16_t*)(p.ws + OFF_M);
    const float* mod = (const float*)(p.ws + OFF_MOD);
    TileIter tit(4, lds);
    int bm, bn;
    while (tit.next(bm, bn)) {
        const int m0 = bm * 256, n0 = bn * 256;
        f32x4 acc[8][4];
        zero_acc(acc);
        gemm_core(acc, M, DM, (const bf16_t*)(p.ws + OFF_WO), DM, DM, m0, n0, lds);
#pragma unroll
        for (int mi = 0; mi < 8; mi++)
#pragma unroll
            for (int ni = 0; ni < 4; ni++) {
                const int tok = m0 + wr * 128 + mi * 16 + r, col = n0 + wc * 64 + ni * 16 + 4 * q;
                const f32x4 xv = *(const f32x4*)(p.x + (size_t)tok * DM + col);
                const f32x4 gt = *(const f32x4*)(mod + (tok >> 11) * 6144 + 2 * 1024 + col);
                *(f32x4*)(p.out + (size_t)tok * DM + col) = xv + gt * acc[mi][ni];
            }
    }
    {
        const int tid_ = TIDX; const int lane = tid_ & 63, wave = tid_ >> 6;
        unsigned char* tq = (unsigned char*)(p.ws + OFF_UB);
        float* tsc = (float*)(p.ws + OFF_UB + 33554432);
        for (int row = vblk() * 4 + wave; row < 32768; row += vgrid() * 4) {
            const bool isv = row >= 16384;
            const float* srcp = (isv ? p.peer_v : p.peer_u) + (size_t)(row & 16383) * DM + lane * 16;
            f32x4 a[4];
            float mx = 0.f;
#pragma unroll
            for (int i = 0; i < 4; i++) {
                a[i] = *(const f32x4*)(srcp + i * 4);
                mx = fmaxf(mx, fmaxf(fmaxf(fabsf(a[i][0]), fabsf(a[i][1])), fmaxf(fabsf(a[i][2]), fabsf(a[i][3]))));
            }
            mx = wave_max(mx);
            const float inv = mx > 0.f ? 127.f / mx : 0.f;
            const int off = isv ? 128 : 0;
            unsigned w[4];
#pragma unroll
            for (int i = 0; i < 4; i++) {
                unsigned pk = 0;
#pragma unroll
                for (int j = 0; j < 4; j++) {
                    int qi = (int)rintf(a[i][j] * inv);
                    qi = qi > 127 ? 127 : (qi < -127 ? -127 : qi);
                    pk |= ((unsigned)(qi + off) & 0xffu) << (8 * j);
                }
                w[i] = pk;
            }
            *(u32x4*)(tq + (size_t)row * DM + lane * 16) = (u32x4){w[0], w[1], w[2], w[3]};
            if (lane == 0) tsc[row] = mx * (1.f / 127.f);
        }
    }
}

__device__ void phaseP1(const Params& p, char* lds) {
    const int tid_ = TIDX512; const int lane = tid_ & 63, wave = tid_ >> 6;
    const int wr = wave >> 2, wc = wave & 3, r = lane & 15, q = lane >> 4;
    const bf16_t* H = (const bf16_t*)(p.ws + OFF_H);
    bf16_t* QP = (bf16_t*)(p.ws + OFF_QP);
    TileIter tit(8, lds);
    int bm, bn;
    while (tit.next(bm, bn)) {
        const int m0 = bm * 256, n0 = bn * 256;
        f32x4 acc[8][4];
        zero_acc(acc);
        gemm_core(acc, H, DM, (const bf16_t*)(p.ws + OFF_WQ), DM, DM, m0, n0, lds);
#pragma unroll
        for (int mi = 0; mi < 8; mi++)
#pragma unroll
            for (int ni = 0; ni < 4; ni++) epi_fill(lds, wr, wc, r, q, mi, ni, acc[mi][ni]);
        __syncthreads();
        epi_store(lds, QP, 2048, m0, n0, 2048);
        __syncthreads();
    }
}

__constant__ unsigned char c_cand_a[64] = {0,0,0,0,0,0,0,0,0,0,0,0,0,0,0,0, 1,1,1,1,1,1,1,1, 2,2,2,2,2, 3,3,3,3, 4,4,4, 5,5, 6,6, 7,7, 8,9,10,11,12,13,14,15, 0,0,0,0,0,0,0,0,0,0,0,0,0,0};
__constant__ unsigned char c_cand_b[64] = {0,1,2,3,4,5,6,7,8,9,10,11,12,13,14,15, 0,1,2,3,4,5,6,7, 0,1,2,3,4, 0,1,2,3, 0,1,2, 0,1, 0,1, 0,1, 0,0,0,0,0,0,0,0, 0,0,0,0,0,0,0,0,0,0,0,0,0,0};

__device__ __forceinline__ unsigned f2key(float f) { const unsigned u = __float_as_uint(f); return (u & 0x80000000u) ? ~u : (u | 0x80000000u); }
__device__ __forceinline__ float key2f(unsigned k) { const unsigned u = (k & 0x80000000u) ? (k & 0x7fffffffu) : ~k; return __uint_as_float(u); }
__device__ __forceinline__ void cex_desc(unsigned& a, unsigned& b) { const unsigned hi = a > b ? a : b, lo = a > b ? b : a; a = hi; b = lo; }
__device__ __forceinline__ void sort16_desc(unsigned (&a)[16]) {
#pragma unroll
    for (int k = 2; k <= 16; k <<= 1)
#pragma unroll
        for (int j = k >> 1; j > 0; j >>= 1)
#pragma unroll
            for (int i = 0; i < 16; i++) {
                const int l = i ^ j;
                if (l > i) { if ((i & k) == 0) cex_desc(a[i], a[l]); else cex_desc(a[l], a[i]); }
            }
}
__device__ __forceinline__ void merge16_desc(unsigned (&a)[16], const unsigned (&b)[16]) {
#pragma unroll
    for (int i = 0; i < 16; i++) a[i] = a[i] > b[15 - i] ? a[i] : b[15 - i];
#pragma unroll
    for (int j = 8; j > 0; j >>= 1)
#pragma unroll
        for (int i = 0; i < 16; i++) { const int l = i ^ j; if (l > i) cex_desc(a[i], a[l]); }
}

__device__ void phaseP2_task(const Params& p, int task, char* lds) {
    const int tid = TIDX, lane = tid & 63, wave = tid >> 6, r = lane & 15, q = lane >> 4;
    const int h = task & 7, tile = task >> 3;
    const int tok0 = tile * 64;
    const bf16_t* QP = (const bf16_t*)(p.ws + OFF_QP);
    float* S = (float*)lds;
    unsigned* LL = (unsigned*)(lds + 65536);
#pragma unroll
    for (int half = 0; half < 2; half++) {
        const bf16_t* KB = (const bf16_t*)(p.ws + OFF_K1B) + (size_t)half * 131072 + (size_t)h * 128 * 128;
        f32x4 acc[8];
#pragma unroll
        for (int nt = 0; nt < 8; nt++) acc[nt] = (f32x4){0.f, 0.f, 0.f, 0.f};
#pragma unroll
        for (int ks = 0; ks < 4; ks++) {
            const bf16x8 bq = *(const bf16x8*)(QP + (size_t)(tok0 + wave * 16 + r) * 2048 + h * 256 + half * 128 + ks * 32 + q * 8);
#pragma unroll
            for (int nt = 0; nt < 8; nt++) {
                const bf16x8 ak = *(const bf16x8*)(KB + (size_t)(nt * 16 + r) * 128 + ks * 32 + q * 8);
                acc[nt] = mfma16(ak, bq, acc[nt]);
            }
        }
#pragma unroll
        for (int nt = 0; nt < 8; nt++)
#pragma unroll
            for (int j = 0; j < 4; j++) S[(half * 128 + nt * 16 + 4 * q + j) * 64 + wave * 16 + r] = acc[nt][j];
    }
    __syncthreads();
    {
        const int row = tid & 127, part = tid >> 7, half = row >> 6, tk = row & 63;
        unsigned L[16];
        const float* sp = S + (half * 128 + part * 64) * 64 + tk;
#pragma unroll
        for (int k = 0; k < 16; k++) L[k] = (f2key(sp[k * 64]) & ~127u) | (unsigned)(127 - (part * 64 + k));
        sort16_desc(L);
        for (int gq = 1; gq < 4; gq++) {
            unsigned G[16];
#pragma unroll
            for (int k = 0; k < 16; k++) G[k] = (f2key(sp[(gq * 16 + k) * 64]) & ~127u) | (unsigned)(127 - (part * 64 + gq * 16 + k));
            sort16_desc(G);
            merge16_desc(L, G);
        }
        __syncthreads();
        unsigned* LP = (unsigned*)lds;
#pragma unroll
        for (int k = 0; k < 16; k++) LP[((part * 2 + half) * 16 + k) * 64 + tk] = L[k];
        __syncthreads();
        if (tid < 128) {
            unsigned A[16], Bq[16];
#pragma unroll
            for (int k = 0; k < 16; k++) { A[k] = LP[((0 * 2 + half) * 16 + k) * 64 + tk]; Bq[k] = LP[((1 * 2 + half) * 16 + k) * 64 + tk]; }
            merge16_desc(A, Bq);
#pragma unroll
            for (int k = 0; k < 16; k++) LL[(half * 16 + k) * 64 + tk] = A[k];
        }
    }
    __syncthreads();
    if (tid < 64) {
        const int tk = tid;
        float v1[16], v2[16];
#pragma unroll
        for (int k = 0; k < 16; k++) { v1[k] = key2f(LL[k * 64 + tk] & ~127u); v2[k] = key2f(LL[(16 + k) * 64 + tk] & ~127u); }
        unsigned C[64];
#pragma unroll
        for (int k = 0; k < 64; k++) C[k] = 0u;
        {
            int c = 0;
#pragma unroll
            for (int a = 0; a < 16; a++)
#pragma unroll
                for (int b = 0; b < 16; b++)
                    if ((a + 1) * (b + 1) <= 16) { C[c] = (f2key(v1[a] + v2[b]) & ~63u) | (unsigned)(63 - c); c++; }
        }
        unsigned T[16];
#pragma unroll
        for (int k = 0; k < 16; k++) T[k] = C[k];
        sort16_desc(T);
#pragma unroll
        for (int gq = 1; gq < 4; gq++) {
            unsigned G[16];
#pragma unroll
            for (int k = 0; k < 16; k++) G[k] = C[gq * 16 + k];
            sort16_desc(G);
            merge16_desc(T, G);
        }
        const float mx = key2f(T[0] & ~63u);
        float e[16], sum = 0.f;
#pragma unroll
        for (int k = 0; k < 16; k++) { e[k] = __expf(key2f(T[k] & ~63u) - mx); sum += e[k]; }
        const float inv = 1.f / sum;
        int ei[16];
#pragma unroll
        for (int k = 0; k < 16; k++) {
            const int cc = 63 - (int)(T[k] & 63u);
            const int a = c_cand_a[cc], b = c_cand_b[cc];
            const int i1 = 127 - (int)(LL[a * 64 + tk] & 127u), i2 = 127 - (int)(LL[(16 + b) * 64 + tk] & 127u);
            ei[k] = i1 * 128 + i2;
            e[k] *= inv;
        }
        int* eidx = (int*)(p.ws + OFF_EIDX) + (size_t)(tok0 + tk) * 128 + h * 16;
        float* gw = (float*)(p.ws + OFF_GW) + (size_t)(tok0 + tk) * 128 + h * 16;
#pragma unroll
        for (int k4 = 0; k4 < 4; k4++) {
            *(u32x4*)(eidx + k4 * 4) = (u32x4){(unsigned)ei[k4 * 4], (unsigned)ei[k4 * 4 + 1], (unsigned)ei[k4 * 4 + 2], (unsigned)ei[k4 * 4 + 3]};
            *(f32x4*)(gw + k4 * 4) = (f32x4){e[k4 * 4], e[k4 * 4 + 1], e[k4 * 4 + 2], e[k4 * 4 + 3]};
        }
    }
    __syncthreads();
}

__device__ __forceinline__ float ub0(unsigned w) { return (float)(w & 0xffu); }
__device__ __forceinline__ float ub1(unsigned w) { return (float)((w >> 8) & 0xffu); }
__device__ __forceinline__ float ub2(unsigned w) { return (float)((w >> 16) & 0xffu); }
__device__ __forceinline__ float ub3(unsigned w) { return (float)(w >> 24); }
__device__ void phaseP3(const Params& p, float* dstp) {
    const int tid_ = TIDX; const int lane = tid_ & 63, wave = tid_ >> 6;
    const bf16_t* H = (const bf16_t*)(p.ws + OFF_H);
    const unsigned char* UQ = (const unsigned char*)(p.ws + OFF_UB);
    const unsigned char* VQ = UQ + 16777216;
    const float* tsc = (const float*)(p.ws + OFF_UB + 33554432);
    const int* eidx = (const int*)(p.ws + OFF_EIDX);
    const float* gwp = (const float*)(p.ws + OFF_GW);
    const float* mod = (const float*)(p.ws + OFF_MOD);
    const int ul = ((lane & 1) << 2) | (lane & 2) | ((lane >> 2) & 1);
    for (int tok = vblk() * 4 + wave; tok < NTOK; tok += vgrid() * 4) {
        int qh[4];
        float sh;
        {
            const u32x4 a = *(const u32x4*)(H + (size_t)tok * DM + lane * 16), b = *(const u32x4*)(H + (size_t)tok * DM + lane * 16 + 8);
            const unsigned hw[8] = {a.x, a.y, a.z, a.w, b.x, b.y, b.z, b.w};
            float hv[16];
            float mx = 0.f;
#pragma unroll
            for (int i = 0; i < 8; i++) { hv[2 * i] = bf_lo(hw[i]); hv[2 * i + 1] = bf_hi(hw[i]); mx = fmaxf(mx, fmaxf(fabsf(hv[2 * i]), fabsf(hv[2 * i + 1]))); }
            mx = wave_max(mx);
            const float inv = mx > 0.f ? 127.f / mx : 0.f;
            sh = mx * (1.f / 127.f);
#pragma unroll
            for (int i = 0; i < 4; i++) {
                unsigned pk = 0;
#pragma unroll
                for (int j = 0; j < 4; j++) pk |= ((unsigned)((int)rintf(hv[i * 4 + j] * inv)) & 0xffu) << (8 * j);
                qh[i] = (int)pk;
            }
        }
        const int e0 = eidx[(size_t)tok * 128 + lane], e1 = eidx[(size_t)tok * 128 + 64 + lane];
        const float g0 = gwp[(size_t)tok * 128 + lane], g1 = gwp[(size_t)tok * 128 + 64 + lane];
        float acc[16];
#pragma unroll
        for (int i = 0; i < 16; i++) acc[i] = 0.f;
        float wsum = 0.f;
        for (int jb = 0; jb < 128; jb += 8) {
            u32x4 ur[8], vr[8];
#pragma unroll
            for (int u = 0; u < 8; u++) {
                const int j = jb + u;
                const int e = (jb < 64) ? __shfl(e0, j, 64) : __shfl(e1, j - 64, 64);
                ur[u] = *(const u32x4*)(UQ + (size_t)e * DM + lane * 16);
                vr[u] = *(const u32x4*)(VQ + (size_t)e * DM + lane * 16);
            }
            const int jm = jb + ul;
            const int em = (jb < 64) ? __shfl(e0, jm, 64) : __shfl(e1, jm - 64, 64);
            const float gm = (jb < 64) ? __shfl(g0, jm, 64) : __shfl(g1, jm - 64, 64);
            const float su = tsc[em], sv = tsc[16384 + em];
            int pt[8];
#pragma unroll
            for (int u = 0; u < 8; u++) {
                int d = __builtin_amdgcn_sdot4((int)ur[u].x, qh[0], 0, false);
                d = __builtin_amdgcn_sdot4((int)ur[u].y, qh[1], d, false);
                d = __builtin_amdgcn_sdot4((int)ur[u].z, qh[2], d, false);
                d = __builtin_amdgcn_sdot4((int)ur[u].w, qh[3], d, false);
                pt[u] = d;
            }
            int m4[4], m2[2], m1;
            {
                const bool b0 = lane & 1;
#pragma unroll
                for (int j = 0; j < 4; j++) { const int keep = b0 ? pt[j + 4] : pt[j], send = b0 ? pt[j] : pt[j + 4]; m4[j] = keep + __shfl_xor(send, 1, 64); }
                const bool b1 = lane & 2;
#pragma unroll
                for (int j = 0; j < 2; j++) { const int keep = b1 ? m4[j + 2] : m4[j], send = b1 ? m4[j] : m4[j + 2]; m2[j] = keep + __shfl_xor(send, 2, 64); }
                const bool b2 = lane & 4;
                { const int keep = b2 ? m2[1] : m2[0], send = b2 ? m2[0] : m2[1]; m1 = keep + __shfl_xor(send, 4, 64); }
                m1 += __shfl_xor(m1, 8, 64);
                m1 += __shfl_xor(m1, 16, 64);
                m1 += __shfl_xor(m1, 32, 64);
            }
            const float aval = (float)m1 * (sh * su);
            const float ws = gm * gelu_erf(aval) * sv;
#pragma unroll
            for (int u = 0; u < 8; u++) {
                const int src_lane = ((u >> 2) & 1) | (u & 2) | ((u & 1) << 2);
                const float wu = __shfl(ws, src_lane, 64);
                wsum += wu;
                const unsigned vw[4] = {vr[u].x, vr[u].y, vr[u].z, vr[u].w};
#pragma unroll
                for (int i = 0; i < 4; i++) {
                    acc[i * 4 + 0] += wu * ub0(vw[i]); acc[i * 4 + 1] += wu * ub1(vw[i]);
                    acc[i * 4 + 2] += wu * ub2(vw[i]); acc[i * 4 + 3] += wu * ub3(vw[i]);
                }
            }
        }
        const int b = tok >> 11;
        float x2[16];
        float ss = 0.f;
#pragma unroll
        for (int i = 0; i < 4; i++) {
            const int d = lane * 16 + i * 4;
            const f32x4 xv = *(const f32x4*)(p.out + (size_t)tok * DM + d);
            const f32x4 gt = *(const f32x4*)(mod + b * 6144 + 5 * 1024 + d);
#pragma unroll
            for (int j = 0; j < 4; j++) { const float v = xv[j] + gt[j] * (acc[i * 4 + j] - 128.f * wsum); x2[i * 4 + j] = v; ss += v * v; }
        }
        ss = wave_sum(ss);
        const float rstd = rsqrtf(ss * (1.f / 1024.f) + 1e-6f);
#pragma unroll
        for (int i = 0; i < 4; i++) {
            const int d = lane * 16 + i * 4;
            const f32x4 fg = *(const f32x4*)(p.final_g + d);
            f32x4 o;
#pragma unroll
            for (int j = 0; j < 4; j++) o[j] = x2[i * 4 + j] * rstd * fg[j];
            *(f32x4*)(dstp + (size_t)tok * DM + d) = o;
        }
    }
}

#define XB_TMO      128
#define XB_XCNT(j)  (256  + 64 * (j))
#define XB_XSUB(j)  (1280 + 64 * (j))
#define XB_XGEN(j)  (2304 + 64 * (j))
#define XB_TOP      3328
#define XB_TOPGEN   3392
#define XCD_BAR_WORDS 3456
#define XB_SPIN_CAP (1u << 22)
#define LAS __attribute__((address_space(3)))
__device__ __forceinline__ unsigned xb_ld(unsigned* p)              { return __hip_atomic_load(p, __ATOMIC_RELAXED, __HIP_MEMORY_SCOPE_AGENT); }
__device__ __forceinline__ unsigned xb_add(unsigned* p, unsigned v) { return __hip_atomic_fetch_add(p, v, __ATOMIC_RELAXED, __HIP_MEMORY_SCOPE_AGENT); }
__device__ __forceinline__ unsigned xb_xcc_id() { return (unsigned)__builtin_amdgcn_s_getreg((3 << 11) | 20) & 0xFu; }
#define XB_SPIN(cond, bar) do { unsigned _sp = 0; while (cond) { __builtin_amdgcn_s_sleep(1); \
    if ((++_sp & 255u) == 0u) { if (xb_ld(&(bar)[XB_TMO])) break; if (_sp > XB_SPIN_CAP) { atomicAdd(&(bar)[XB_TMO], 1u); break; } } } } while (0)
struct XcdBarrier { unsigned* bar; unsigned x; volatile LAS unsigned* st; };
__device__ __forceinline__ XcdBarrier xcd_barrier_post(unsigned* bar, volatile LAS unsigned* st) {
    XcdBarrier b; b.bar = bar; b.x = xb_xcc_id(); b.st = st;
    if (threadIdx.x == 0) { st[2] = xb_add(&bar[XB_XCNT(b.x)], 1u); st[4] = b.x; }
    return b;
}
__device__ __forceinline__ void xcd_barrier_complete(unsigned* bar, unsigned x, unsigned& nloc, unsigned& nx, unsigned& bal) {
    const unsigned G = gridDim.x * gridDim.y * gridDim.z;
    unsigned sum, cnt, mine, c64, sp = 0u;
    for (;;) {
        sum = 0u; cnt = 0u; mine = 0u; c64 = 0u;
#pragma unroll
        for (unsigned j = 0; j < 16; ++j) { const unsigned c = xb_ld(&bar[XB_XCNT(j)]); sum += c; cnt += (c > 0u) ? 1u : 0u; c64 += (j < 8 && c == 64u) ? 1u : 0u; mine = (j == x) ? c : mine; }
        if (sum == G) break;
        __builtin_amdgcn_s_sleep(1);
        if ((++sp & 255u) == 0u) { if (xb_ld(&bar[XB_TMO])) break; if (sp > XB_SPIN_CAP) { atomicAdd(&bar[XB_TMO], 1u); break; } }
    }
    nloc = mine > 0u ? mine : 1u; nx = cnt > 0u ? cnt : 1u; bal = (sum == G && cnt == 8u && c64 == 8u) ? 1u : 0u;
}
__device__ __forceinline__ void xcd_barrier(const XcdBarrier& b) {
    asm volatile("s_waitcnt vmcnt(0)" ::: "memory");
    __syncthreads();
    if (threadIdx.x == 0) {
        unsigned* bar = b.bar;
        __builtin_amdgcn_s_waitcnt(0);
        unsigned nloc = b.st[0], nx = b.st[1];
        if (nloc == 0u) { unsigned bal; xcd_barrier_complete(bar, b.x, nloc, nx, bal); b.st[0] = nloc; b.st[1] = nx; b.st[3] = bal; }
        const unsigned old = xb_add(&bar[XB_XSUB(b.x)], 1u);
        const unsigned gen = old / nloc;
        if (old + 1u == (gen + 1u) * nloc) {
            __builtin_amdgcn_fence(__ATOMIC_RELEASE, "agent");
            asm volatile("s_waitcnt vmcnt(0)" ::: "memory");
            const unsigned og = xb_add(&bar[XB_TOP], 1u);
            const unsigned tg = og / nx;
            if (og + 1u == (tg + 1u) * nx) xb_add(&bar[XB_TOPGEN], 1u);
            else XB_SPIN(xb_ld(&bar[XB_TOPGEN]) == tg, bar);
            __builtin_amdgcn_fence(__ATOMIC_ACQUIRE, "agent");
            xb_add(&bar[XB_XGEN(b.x)], 1u);
            asm volatile("s_waitcnt vmcnt(0)" ::: "memory");
        } else {
            XB_SPIN(xb_ld(&bar[XB_XGEN(b.x)]) == gen, bar);
            __builtin_amdgcn_fence(__ATOMIC_ACQUIRE, "agent");
            asm volatile("s_waitcnt vmcnt(0)" ::: "memory");
        }
    }
    __syncthreads();
}

typedef __attribute__((address_space(4))) const Params* KParamsPtr;
__device__ __forceinline__ const Params& fresh_params() {
    KParamsPtr kp = (KParamsPtr)__builtin_amdgcn_kernarg_segment_ptr();
    asm volatile("" : "+s"(kp));
    return *(const Params*)kp;
}
#define PF fresh_params()
__global__ void __launch_bounds__(BLOCK_THREADS, 2) mega(Params p_unused) {
    __shared__ __attribute__((aligned(16))) char lds[LDS_BYTES];
    cg::grid_group grid = cg::this_grid();
    volatile LAS unsigned* st = (volatile LAS unsigned*)(lds + 2 * LDS_MAIN);
    if (threadIdx.x < 16) st[threadIdx.x] = 0u;
    __syncthreads();
    XcdBarrier xb = xcd_barrier_post((unsigned*)PF.ws, st);
    char* hl = lds + half_id() * LDS_MAIN;
    volatile unsigned* uex = (volatile unsigned*)(lds + 2 * LDS_MAIN + 32);

    phaseA(PF, hl);
    if (PF.ws == nullptr) grid.sync();
    xcd_barrier(xb);
    { const Params& q_ = PF; phase_modnorm(q_, q_.x, q_.norm1_g, 0, 1, (bf16_t*)(q_.ws + OFF_H)); };
    xcd_barrier(xb);
    phaseC(PF, lds);
    xcd_barrier(xb);
    for (int task = vblk(); task < 1024; task += vgrid()) phaseG1_task(PF, task, hl);
    for (int task = vblk(); task < 256; task += vgrid()) phaseN1_task(PF, task, hl);
    xcd_barrier(xb);
    phaseG2(PF);
    xcd_barrier(xb);
    for (int task = vblk(); task < 2048; task += vgrid()) phaseN2_task(PF, task, hl, (bf16_t*)(PF.ws + OFF_Z) + ZQ_N, ZC, uex, lds);
    for (int task = vblk(); task < 1024; task += vgrid()) phaseG3_task(PF, task, hl, (bf16_t*)(PF.ws + OFF_Z) + ZR_G, ZC);
    xcd_barrier(xb);
    phaseM1(PF, lds);
    xcd_barrier(xb);
    phaseM2(PF, lds);
    xcd_barrier(xb);
    { const Params& q_ = PF; phase_modnorm(q_, q_.out, q_.norm2_g, 3, 4, (bf16_t*)(q_.ws + OFF_H)); };
    xcd_barrier(xb);
    phaseP1(PF, lds);
    xcd_barrier(xb);
    for (int task = vblk(); task < 2048; task += vgrid()) phaseP2_task(PF, task, hl);
    xcd_barrier(xb);
    { const Params& q_ = PF; phaseP3(q_, q_.out); };
}

extern "C" void kernel_launch(void* const* d_in, const int* in_sizes, int n_in, void* d_out, int out_size, void* d_ws, size_t ws_size, hipStream_t stream) {
    Params p{};
    p.x = (const float*)d_in[0]; p.c = (const float*)d_in[1]; p.pos = (const int*)d_in[2]; p.ada_w = (const float*)d_in[3]; p.ada_b = (const float*)d_in[4];
    p.norm1_g = (const float*)d_in[5]; p.norm2_g = (const float*)d_in[6]; p.final_g = (const float*)d_in[7]; p.w_in = (const float*)d_in[8];
    p.gla_wa2 = (const float*)d_in[9]; p.gla_ba2 = (const float*)d_in[10]; p.gla_norm_g = (const float*)d_in[11]; p.pe_k = (const float*)d_in[12]; p.pe_v = (const float*)d_in[13];
    p.ck_w1 = (const float*)d_in[14]; p.ck_w2 = (const float*)d_in[15]; p.cv_w1 = (const float*)d_in[16]; p.cv_w2 = (const float*)d_in[17];
    p.w_branch_a = (const float*)d_in[18]; p.w_branch_b = (const float*)d_in[19]; p.w_out = (const float*)d_in[20]; p.peer_wq = (const float*)d_in[21];
    p.peer_k1 = (const float*)d_in[22]; p.peer_k2 = (const float*)d_in[23]; p.peer_u = (const float*)d_in[24]; p.peer_v = (const float*)d_in[25];
    p.out = (float*)d_out; p.ws = (char*)d_ws;
    static int grid_blocks = 0;
    if (!grid_blocks) {
        int dev = 0, cus = 0, per_cu = 0;
        hipGetDevice(&dev);
        hipDeviceGetAttribute(&cus, hipDeviceAttributeMultiprocessorCount, dev);
        hipOccupancyMaxActiveBlocksPerMultiprocessor(&per_cu, mega, BLOCK_THREADS, 0);
        if (per_cu > 1) per_cu = 1;
        if (per_cu < 1) per_cu = 1;
        grid_blocks = cus * per_cu;
    }
    hipMemsetAsync(d_ws, 0, XCD_BAR_WORDS * 4, stream);
    void* args[] = {&p};
    hipError_t e = hipLaunchCooperativeKernel((void*)mega, dim3(grid_blocks), dim3(BLOCK_THREADS), args, 0, stream);
    if (e != hipSuccess) fprintf(stderr, "cooperative launch failed: %s (grid %d)\n", hipGetErrorString(e), grid_blocks);
}
```

```cpp
#include <hip/hip_runtime.h>
#include <hip/hip_cooperative_groups.h>
#include <stdio.h>
namespace cg = cooperative_groups;
#include <stdint.h>
#include <stddef.h>
#include <math.h>

typedef unsigned short bf16_t;
typedef short bf16x8 __attribute__((ext_vector_type(8)));
typedef float f32x4 __attribute__((ext_vector_type(4)));
typedef unsigned u32x4 __attribute__((ext_vector_type(4)));
typedef unsigned u32x2 __attribute__((ext_vector_type(2)));

constexpr int DM = 1024, NB = 8, SEQ = 2048, NTOK = NB * SEQ;
constexpr int ZC = 4992;
constexpr int ZQ_G = 0, ZK_G = 512, ZV_G = 1024, ZR_G = 2048, ZQ_N = 3072, ZKC = 4096, ZVC = 4224, ZKS = 4352, ZVS = 4480,
              ZKW = 4608, ZVW = 4736, ZGATE = 4864, ZLR = 4912;
constexpr int LDS_MAIN = 73728;
constexpr int LDS_BYTES = 2 * LDS_MAIN + 64;
constexpr int NTHREADS = 256;
constexpr int BLOCK_THREADS = 512;

constexpr size_t OFF_MOD = 16384;
constexpr size_t OFF_ROPE = 212992;
constexpr size_t OFF_CMP = 1261568;
constexpr size_t OFF_DEC = 1785856;
constexpr size_t OFF_K1B = 2310144;
constexpr size_t OFF_WC1 = 2834432;
constexpr size_t OFF_WIN = 4194304;
constexpr size_t OFF_WM = 14417920;
constexpr size_t OFF_WA = 18612224;
constexpr size_t OFF_WB = 20709376;
constexpr size_t OFF_WO = 22806528;
constexpr size_t OFF_WQ = 24903680;
constexpr size_t OFF_H = 29360128;
constexpr size_t OFF_M = 62914560;
constexpr size_t OFF_Z = 96468992;
constexpr size_t OFF_QP = OFF_Z;
constexpr size_t OFF_UB = OFF_Z + 67108864;
constexpr size_t OFF_VB = OFF_UB + 33554432;
constexpr size_t OFF_EIDX = OFF_VB + 33554432;
constexpr size_t OFF_GW = OFF_EIDX + 8388608;

struct Params {
    const float* x; const float* c; const int* pos; const float* ada_w; const float* ada_b;
    const float* norm1_g; const float* norm2_g; const float* final_g; const float* w_in;
    const float* gla_wa2; const float* gla_ba2; const float* gla_norm_g; const float* pe_k; const float* pe_v;
    const float* ck_w1; const float* ck_w2; const float* cv_w1; const float* cv_w2;
    const float* w_branch_a; const float* w_branch_b; const float* w_out; const float* peer_wq;
    const float* peer_k1; const float* peer_k2; const float* peer_u; const float* peer_v;
    float* out; char* ws;
};

__device__ __forceinline__ unsigned f2bf_u(float f) { unsigned u = __float_as_uint(f); return (u + 0x7fffu + ((u >> 16) & 1u)) >> 16; }
__device__ __forceinline__ bf16_t f2bf(float f) { return (bf16_t)f2bf_u(f); }
typedef float f32x2_ __attribute__((ext_vector_type(2)));
typedef __bf16 bf16x2_ __attribute__((ext_vector_type(2)));
__device__ __forceinline__ unsigned pack2(float lo, float hi) {
    const f32x2_ v = {lo, hi};
    return __builtin_bit_cast(unsigned, __builtin_convertvector(v, bf16x2_));
}
__device__ __forceinline__ float bf_lo(unsigned u) { return __uint_as_float(u << 16); }
__device__ __forceinline__ float bf_hi(unsigned u) { return __uint_as_float(u & 0xffff0000u); }
__device__ __forceinline__ float bf2f(bf16_t h) { return __uint_as_float(((unsigned)h) << 16); }
__device__ __forceinline__ float wave_sum(float v) {
#pragma unroll
    for (int o = 32; o > 0; o >>= 1) v += __shfl_xor(v, o, 64);
    return v;
}
__device__ __forceinline__ float wave_max(float v) {
#pragma unroll
    for (int o = 32; o > 0; o >>= 1) v = fmaxf(v, __shfl_xor(v, o, 64));
    return v;
}
__device__ __forceinline__ int launder_i(int x) { asm volatile("" : "+v"(x)); return x; }
#define TIDX (launder_i((int)threadIdx.x) & 255)
#define TIDX512 launder_i((int)threadIdx.x)
__device__ __forceinline__ int half_id() { return __builtin_amdgcn_readfirstlane((int)(threadIdx.x >> 8)); }
__device__ __forceinline__ int vblk() { return (int)blockIdx.x * 2 + half_id(); }
__device__ __forceinline__ int vgrid() { return (int)gridDim.x * 2; }
__device__ __forceinline__ float exp2f_(float x) { return __builtin_amdgcn_exp2f(x); }
__device__ __forceinline__ float sigmoidf_(float x) { return __builtin_amdgcn_rcpf(1.f + __expf(-x)); }
__device__ __forceinline__ float siluf_(float x) { return x * __builtin_amdgcn_rcpf(1.f + __expf(-x)); }
__device__ __forceinline__ float gelu_erf(float x) { return 0.5f * x * (1.f + erff(x * 0.70710678118654752f)); }
__device__ __forceinline__ f32x4 mfma16(bf16x8 a, bf16x8 b, f32x4 c) { return __builtin_amdgcn_mfma_f32_16x16x32_bf16(a, b, c, 0, 0, 0); }
__device__ __forceinline__ bf16x8 ld_frag(const bf16_t* p) { return *(const bf16x8*)p; }
__device__ __forceinline__ bf16x8 mk_frag(u32x2 lo, u32x2 hi) { u32x4 t = {lo.x, lo.y, hi.x, hi.y}; return __builtin_bit_cast(bf16x8, t); }

#define WAIT_V(n) asm volatile("s_waitcnt vmcnt(" #n ")" ::: "memory")
__device__ __forceinline__ int swz4(int R) { return (4 - ((R >> 2) & 3)) & 3; }
__device__ __forceinline__ void glds16(const bf16_t* g, char* l) { __builtin_amdgcn_global_load_lds((const unsigned*)g, (unsigned*)l, 16, 0, 0); }
struct GemmSrc { const bf16_t* xsrc; const bf16_t* wsrc; int ldx, ldw; };
__device__ __forceinline__ GemmSrc gemm_src(const bf16_t* __restrict__ X, int ldx, const bf16_t* __restrict__ W, int ldw, int m0, int n0) {
    const int tid = TIDX512, lane = tid & 63, wave = tid >> 6;
    const int R0 = wave * 32 + (lane >> 2);
    const int sw = ((lane & 3) ^ swz4(R0)) * 8;
    GemmSrc g;
    g.xsrc = X + (size_t)(m0 + R0) * ldx + sw;
    g.wsrc = W + (size_t)(n0 + R0) * ldw + sw;
    g.ldx = ldx; g.ldw = ldw;
    return g;
}
__device__ __forceinline__ void gemm_issue(const GemmSrc& g, int kt, int s, char* lds) {
    const int tid = TIDX512, lane = tid & 63, wave = tid >> 6;
    char* xdst = lds + s * 32768 + wave * 2048 + lane * 16;
    char* wdst = xdst + 16384;
#pragma unroll
    for (int i = 0; i < 2; i++) {
        glds16(g.xsrc + (size_t)i * 16 * g.ldx + kt * 32, xdst + i * 1024);
        glds16(g.wsrc + (size_t)i * 16 * g.ldw + kt * 32, wdst + i * 1024);
    }
}
__device__ __forceinline__ void gemm_prologue(const GemmSrc& g, char* lds) { gemm_issue(g, 0, 0, lds); gemm_issue(g, 1, 1, lds); gemm_issue(g, 2, 2, lds); }
__device__ __forceinline__ void gemm_mainloop(f32x4 (&acc)[8][4], const GemmSrc& g, int K, char* lds) {
    const int tid = TIDX512, lane = tid & 63, wave = tid >> 6;
    const int wr = wave >> 2, wc = wave & 3, r = lane & 15, q = lane >> 4;
    const int KT = K / 32;
    const int rdo = r * 64 + ((q ^ swz4(r)) * 16);
    for (int kt = 0; kt < KT; kt++) {
        if (kt + 2 < KT) WAIT_V(8); else if (kt + 1 < KT) WAIT_V(4); else WAIT_V(0);
        __builtin_amdgcn_s_barrier();
        if (kt + 3 < KT) gemm_issue(g, kt + 3, (kt + 3) & 3, lds);
        const char* st = lds + (kt & 3) * 32768;
        bf16x8 af[4], bfr[8];
#pragma unroll
        for (int ni = 0; ni < 4; ni++) af[ni] = *(const bf16x8*)(st + 16384 + (wc * 64 + ni * 16) * 64 + rdo);
#pragma unroll
        for (int mi = 0; mi < 8; mi++) bfr[mi] = *(const bf16x8*)(st + (wr * 128 + mi * 16) * 64 + rdo);
#pragma unroll
        for (int mi = 0; mi < 8; mi++)
#pragma unroll
            for (int ni = 0; ni < 4; ni++) acc[mi][ni] = mfma16(af[ni], bfr[mi], acc[mi][ni]);
        __builtin_amdgcn_sched_barrier(0);
    }
}
__device__ __forceinline__ void gemm_core(f32x4 (&acc)[8][4], const bf16_t* __restrict__ X, int ldx, const bf16_t* __restrict__ W, int ldw,
                                          int K, int m0, int n0, char* lds) {
    const GemmSrc g = gemm_src(X, ldx, W, ldw, m0, n0);
    gemm_prologue(g, lds);
    gemm_mainloop(acc, g, K, lds);
    __syncthreads();
}
__device__ __forceinline__ void zero_acc(f32x4 (&acc)[8][4]) {
#pragma unroll
    for (int a = 0; a < 8; a++)
#pragma unroll
        for (int b = 0; b < 4; b++) acc[a][b] = (f32x4){0.f, 0.f, 0.f, 0.f};
}

constexpr int EPI_ROWB = 528;
__device__ __forceinline__ void epi_fill(char* lds, int wr, int wc, int r, int q, int mi, int ni, f32x4 v) {
    *(u32x2*)(lds + (wr * 128 + mi * 16 + r) * EPI_ROWB + (wc * 64 + ni * 16 + 4 * q) * 2) = (u32x2){pack2(v[0], v[1]), pack2(v[2], v[3])};
}
__device__ __forceinline__ void epi_store(const char* lds, bf16_t* __restrict__ O, int ldo, int m0, int n0, int ncols_valid) {
    const int t = TIDX512;
    const int chunk = t & 31, rsub = t >> 5;
    if (n0 + chunk * 8 < ncols_valid) {
#pragma unroll
        for (int ps = 0; ps < 16; ps++) {
            const int row = ps * 16 + rsub;
            const u32x4 v = *(const u32x4*)(lds + row * EPI_ROWB + chunk * 16);
            *(u32x4*)(O + (size_t)(m0 + row) * ldo + n0 + chunk * 8) = v;
        }
    }
}

struct TileIter {
    int nt, i, x, li; bool fancy;
    __device__ TileIter(int ntiles_n, const char*) { nt = ntiles_n; fancy = (gridDim.x == 256) && ((nt & 3) == 0); x = blockIdx.x & 7; li = blockIdx.x >> 3; i = fancy ? 0 : blockIdx.x; }
    __device__ bool next(int& bm, int& bn) {
        if (fancy) {
            if (i * 4 >= nt) return false;
            bm = x * 8 + (li & 7); bn = i * 4 + (li >> 3); i++; return true;
        }
        if (i >= 64 * nt) return false;
        bn = i % nt; bm = i / nt; i += gridDim.x; return true;
    }
};

struct MapId { __device__ int operator()(int n) const { return n; } };
struct MapWin {
    __device__ int operator()(int n) const { return n < 3072 ? n : (n < 4912 ? n + 16 : (n < 4928 ? n - 1840 : -1)); }
};
struct MapOff { int off; __device__ int operator()(int n) const { return n + off; } };

template <class Map>
__device__ __forceinline__ void tconv_tile(const float* __restrict__ src, int ldsrc, bf16_t* __restrict__ dst, int ldd, int n0, int k0, Map map, float* t) {
    const int tid = TIDX;
    const int n = tid & 63, kb = tid >> 6;
    const int sc = map(n0 + n);
#pragma unroll
    for (int i = 0; i < 16; i++) { const int k = i * 4 + kb; t[k * 65 + n] = sc >= 0 ? src[(size_t)(k0 + k) * ldsrc + sc] : 0.f; }
    __syncthreads();
    const int nn = tid >> 2, kk = (tid & 3) * 16;
    unsigned w[8];
#pragma unroll
    for (int j = 0; j < 8; j++) w[j] = pack2(t[(kk + 2 * j) * 65 + nn], t[(kk + 2 * j + 1) * 65 + nn]);
    u32x4* d = (u32x4*)(dst + (size_t)(n0 + nn) * ldd + k0 + kk);
    d[0] = (u32x4){w[0], w[1], w[2], w[3]};
    d[1] = (u32x4){w[4], w[5], w[6], w[7]};
    __syncthreads();
}

constexpr int TA_MOD = 192, TA_WIN = 78 * 16, TA_WM = 32 * 16, TA_SQ = 16 * 16, TA_WQ = 32 * 16, TA_WC = 32, TA_K12 = 64, TA_ROPE = 512;
constexpr int TA_E0 = TA_MOD, TA_E1 = TA_E0 + TA_WIN, TA_E2 = TA_E1 + TA_WM, TA_E3 = TA_E2 + TA_SQ, TA_E4 = TA_E3 + TA_SQ, TA_E5 = TA_E4 + TA_SQ,
              TA_E6 = TA_E5 + TA_WQ, TA_E7 = TA_E6 + TA_WC, TA_E8 = TA_E7 + TA_WC, TA_E9 = TA_E8 + TA_K12, TA_E10 = TA_E9 + TA_K12, TA_E11 = TA_E10 + TA_ROPE;

__device__ void phaseA(const Params& p, char* lds) {
    const int tid = TIDX;
    float* fl = (float*)lds;
    constexpr int N0 = TA_E1 + (TA_E8 - TA_E6) + (TA_E11 - TA_E10);
    for (int idx = vblk(); idx < N0; idx += vgrid()) {
        const int task = idx < TA_E1 ? idx : (idx < TA_E1 + (TA_E8 - TA_E6) ? idx - TA_E1 + TA_E6 : idx - TA_E1 - (TA_E8 - TA_E6) + TA_E10);
        if (task < TA_E0) {
            float* sc = fl;
            float* red = fl + 8192;
            for (int i = tid; i < 8192; i += NTHREADS) sc[i] = siluf_(p.c[i]);
            __syncthreads();
            const int n = task * 32 + (tid & 31), kg = tid >> 5;
            float a[8];
#pragma unroll
            for (int b = 0; b < 8; b++) a[b] = 0.f;
            for (int k0 = kg * 128; k0 < kg * 128 + 128; k0 += 16) {
                float w[16];
#pragma unroll
                for (int i = 0; i < 16; i++) w[i] = p.ada_w[(size_t)(k0 + i) * 6144 + n];
#pragma unroll
                for (int i = 0; i < 16; i++)
#pragma unroll
                    for (int b = 0; b < 8; b++) a[b] += sc[b * 1024 + k0 + i] * w[i];
            }
#pragma unroll
            for (int b = 0; b < 8; b++) red[(kg * 8 + b) * 32 + (tid & 31)] = a[b];
            __syncthreads();
            {
                const int b = tid >> 5, nn = tid & 31;
                float s = 0.f;
#pragma unroll
                for (int g = 0; g < 8; g++) s += red[(g * 8 + b) * 32 + nn];
                ((float*)(p.ws + OFF_MOD))[b * 6144 + task * 32 + nn] = s + p.ada_b[task * 32 + nn];
            }
            __syncthreads();
        } else if (task < TA_E1) {
            const int tt = task - TA_E0;
            tconv_tile(p.w_in, 6976, (bf16_t*)(p.ws + OFF_WIN), 1024, (tt >> 4) * 64, (tt & 15) * 64, MapWin(), fl);
        } else if (task < TA_E6) {
        } else if (task < TA_E7) {
            const int tt = task - TA_E6;
            tconv_tile(p.ck_w1, 64, (bf16_t*)(p.ws + OFF_WC1), 2048, 0, tt * 64, MapId(), fl);
        } else if (task < TA_E8) {
            const int tt = task - TA_E7;
            tconv_tile(p.cv_w1, 64, (bf16_t*)(p.ws + OFF_WC1) + 64 * 2048, 2048, 0, tt * 64, MapId(), fl);
        } else if (task < TA_E10) {
        } else {
            const int tt = task - TA_E10;
            const int e = tt * 256 + tid;
            const int tok = e >> 3, i = e & 7;
            const float invf[8] = {1.0f, 0.1939227432012558f, 0.03760603070259094f, 0.007292664609849453f,
                                   0.0014142135623842478f, 0.00027424818836152554f, 5.318296098266728e-05f, 1.0313386155758053e-05f};
            float fr = invf[0];
#pragma unroll
            for (int j = 1; j < 8; j++) fr = (i == j) ? invf[j] : fr;
            const float ang = (float)p.pos[tok] * fr;
            const double rev = (double)ang * 0.15915494309189533577;
            const float fpart = (float)(rev - floor(rev));
            float* cs = (float*)(p.ws + OFF_ROPE);
            cs[e * 2] = __builtin_amdgcn_cosf(fpart);
            cs[e * 2 + 1] = __builtin_amdgcn_sinf(fpart);
        }
    }
}

__device__ void phaseA2(const Params& p, char* lds) {
    const int tid = TIDX;
    float* fl = (float*)lds;
    constexpr int N1 = (TA_E6 - TA_E1) + (TA_E10 - TA_E8);
    for (int idx = vblk(); idx < N1; idx += vgrid()) {
        const int task = idx < (TA_E6 - TA_E1) ? idx + TA_E1 : idx - (TA_E6 - TA_E1) + TA_E8;
        if (task < TA_E1) {
        } else if (task < TA_E2) {
            const int tt = task - TA_E1;
            tconv_tile(p.w_in, 6976, (bf16_t*)(p.ws + OFF_WM), 1024, (tt >> 4) * 64, (tt & 15) * 64, MapOff{4928}, fl);
        } else if (task < TA_E3) {
            const int tt = task - TA_E2;
            tconv_tile(p.w_branch_a, 1024, (bf16_t*)(p.ws + OFF_WA), 1024, (tt >> 4) * 64, (tt & 15) * 64, MapId(), fl);
        } else if (task < TA_E4) {
            const int tt = task - TA_E3;
            tconv_tile(p.w_branch_b, 1024, (bf16_t*)(p.ws + OFF_WB), 1024, (tt >> 4) * 64, (tt & 15) * 64, MapId(), fl);
        } else if (task < TA_E5) {
            const int tt = task - TA_E4;
            tconv_tile(p.w_out, 1024, (bf16_t*)(p.ws + OFF_WO), 1024, (tt >> 4) * 64, (tt & 15) * 64, MapId(), fl);
        } else if (task < TA_E6) {
            const int tt = task - TA_E5;
            tconv_tile(p.peer_wq, 2048, (bf16_t*)(p.ws + OFF_WQ), 1024, (tt >> 4) * 64, (tt & 15) * 64, MapId(), fl);
        } else if (task < TA_E10) {
            const bool second = task >= TA_E9;
            const int tt = task - (second ? TA_E9 : TA_E8);
            const float* src = second ? p.peer_k2 : p.peer_k1;
            bf16_t* dst = (bf16_t*)(p.ws + OFF_K1B) + (second ? 131072 : 0);
            const int i = tt * 2048 + tid * 8;
            const f32x4 a = *(const f32x4*)(src + i), b = *(const f32x4*)(src + i + 4);
            *(u32x4*)(dst + i) = (u32x4){pack2(a[0], a[1]), pack2(a[2], a[3]), pack2(b[0], b[1]), pack2(b[2], b[3])};
        }
    }
}

__device__ void phase_modnorm(const Params& p, const float* __restrict__ src, const float* __restrict__ g, int shift_idx, int scale_idx, bf16_t* __restrict__ dst) {
    const int tid_ = TIDX; const int lane = tid_ & 63, wave = tid_ >> 6;
    const float* mod = (const float*)(p.ws + OFF_MOD);
    for (int tok = vblk() * 4 + wave; tok < NTOK; tok += vgrid() * 4) {
        const int b = tok >> 11;
        const float* xr = src + (size_t)tok * DM;
        f32x4 v[4];
        float ss = 0.f;
#pragma unroll
        for (int c = 0; c < 4; c++) { v[c] = *(const f32x4*)(xr + c * 256 + lane * 4); ss += v[c][0] * v[c][0] + v[c][1] * v[c][1] + v[c][2] * v[c][2] + v[c][3] * v[c][3]; }
        ss = wave_sum(ss);
        const float rstd = rsqrtf(ss * (1.f / 1024.f) + 1e-6f);
#pragma unroll
        for (int c = 0; c < 4; c++) {
            const int d = c * 256 + lane * 4;
            const f32x4 gg = *(const f32x4*)(g + d);
            const f32x4 sc = *(const f32x4*)(mod + b * 6144 + scale_idx * 1024 + d);
            const f32x4 sh = *(const f32x4*)(mod + b * 6144 + shift_idx * 1024 + d);
            float o[4];
#pragma unroll
            for (int j = 0; j < 4; j++) o[j] = (v[c][j] * rstd) * gg[j] * (1.f + sc[j]) + sh[j];
            *(u32x2*)(dst + (size_t)tok * DM + d) = (u32x2){pack2(o[0], o[1]), pack2(o[2], o[3])};
        }
    }
}

__device__ void phaseC(const Params& p, char* lds) {
    const int tid_ = TIDX512; const int lane = tid_ & 63, wave = tid_ >> 6;
    const int wr = wave >> 2, wc = wave & 3, r = lane & 15, q = lane >> 4;
    const bf16_t* H = (const bf16_t*)(p.ws + OFF_H);
    const bf16_t* W = (const bf16_t*)(p.ws + OFF_WIN);
    bf16_t* Z = (bf16_t*)(p.ws + OFF_Z);
    const float* cs = (const float*)(p.ws + OFF_ROPE);
    constexpr int NTN = (ZC + 255) / 256;
    TileIter tit(NTN, lds);
    int bm, bn;
    while (tit.next(bm, bn)) {
        const int m0 = bm * 256, n0 = bn * 256;
        f32x4 acc[8][4];
        zero_acc(acc);
        gemm_core(acc, H, DM, W, DM, DM, m0, n0, lds);
        const int c0 = n0 + wc * 64;
        const bool isq = (c0 >= ZQ_N && c0 < ZKC);
        const bool rope = isq || (c0 >= ZKC && c0 < ZGATE && ((c0 - ZKC) & 255) < 128);
        const float scl = isq ? 0.18033688011112042f : 1.f;
#pragma unroll
        for (int mi = 0; mi < 8; mi++) {
            const int tok = m0 + wr * 128 + mi * 16 + r;
            if (rope) {
                f32x4 v = acc[mi][0];
                f32x4 pr;
#pragma unroll
                for (int j = 0; j < 4; j++) pr[j] = __shfl_xor(v[j], 32, 64);
                const int ib = (q & 1) * 4;
                const f32x4 k0 = *(const f32x4*)(cs + (size_t)tok * 16 + ib * 2);
                const f32x4 k1 = *(const f32x4*)(cs + (size_t)tok * 16 + ib * 2 + 4);
                const float cc[4] = {k0[0], k0[2], k1[0], k1[2]}, sn[4] = {k0[1], k0[3], k1[1], k1[3]};
#pragma unroll
                for (int j = 0; j < 4; j++) v[j] = (q < 2) ? (v[j] * cc[j] - pr[j] * sn[j]) : (v[j] * cc[j] + pr[j] * sn[j]);
                acc[mi][0] = v;
            }
#pragma unroll
            for (int ni = 0; ni < 4; ni++) epi_fill(lds, wr, wc, r, q, mi, ni, acc[mi][ni] * scl);
        }
        __syncthreads();
        epi_store(lds, Z, ZC, m0, n0, ZC);
        __syncthreads();
    }
}

__device__ __forceinline__ void gla_prep(const Params& p, int tok0, int h, char* lds) {
    const int tid = TIDX;
    float* bc = (float*)lds;
    float* lrs = (float*)(lds + 32768);
    const bf16_t* Z = (const bf16_t*)(p.ws + OFF_Z);
    for (int i = tid; i < 1024; i += NTHREADS) { const int t = i >> 4, rr = i & 15; lrs[i] = bf2f(Z[(size_t)(tok0 + t) * ZC + ZLR + rr]); }
    const int d = tid & 127, th = tid >> 7;
    float w[16];
#pragma unroll
    for (int rr = 0; rr < 16; rr++) w[rr] = p.gla_wa2[rr * 512 + h * 128 + d];
    const float bias = p.gla_ba2[h * 128 + d];
    __syncthreads();
    float run = 0.f;
    for (int t = th * 32; t < th * 32 + 32; t++) {
        float xv = bias;
#pragma unroll
        for (int rr = 0; rr < 16; rr++) xv += lrs[t * 16 + rr] * w[rr];
        const float ls = fminf(xv, 0.f) - log1pf(__expf(-fabsf(xv)));
        run += ls * (1.f / 16.f);
        bc[t * 128 + d] = run;
    }
    __syncthreads();
    if (th == 1) {
        const float add = bc[31 * 128 + d];
        for (int t = 32; t < 64; t++) bc[t * 128 + d] += add;
    }
    __syncthreads();
}

__device__ void phaseG1_task(const Params& p, int task, char* lds) {
    const int tid = TIDX, lane = tid & 63, wave = tid >> 6, r = lane & 15, q = lane >> 4;
    const int c = task & 31, h = (task >> 5) & 3, b = task >> 7;
    const int tok0 = b * SEQ + c * 64;
    const bf16_t* Z = (const bf16_t*)(p.ws + OFF_Z);
    bf16_t* L = (bf16_t*)p.out;
    float* bc = (float*)lds;
    bf16_t* klT = (bf16_t*)(lds + 36864);
    bf16_t* vT = (bf16_t*)(lds + 36864 + 18432);
    gla_prep(p, tok0, h, lds);
    if (tid < 128) ((float*)(p.ws + OFF_DEC))[task * 128 + tid] = __expf(bc[63 * 128 + tid]);
    {
        const int s = lane, dc = wave * 32;
        const bf16_t* kp = Z + (size_t)(tok0 + s) * ZC + ZK_G + h * 128 + dc;
#pragma unroll
        for (int v4 = 0; v4 < 4; v4++) {
            const u32x4 kv = *(const u32x4*)(kp + v4 * 8);
            const unsigned kw[4] = {kv.x, kv.y, kv.z, kv.w};
#pragma unroll
            for (int j = 0; j < 8; j++) {
                const int d = dc + v4 * 8 + j;
                const float kval = (j & 1) ? bf_hi(kw[j >> 1]) : bf_lo(kw[j >> 1]);
                klT[d * 72 + s] = f2bf(kval * __expf(bc[63 * 128 + d] - bc[s * 128 + d]));
            }
        }
    }
    for (int eh = 0; eh < 2; eh++) {
        __syncthreads();
        {
            const int s = lane, ec = wave * 32;
            const bf16_t* vp = Z + (size_t)(tok0 + s) * ZC + ZV_G + h * 256 + eh * 128 + ec;
#pragma unroll
            for (int v4 = 0; v4 < 4; v4++) {
                const u32x4 vv = *(const u32x4*)(vp + v4 * 8);
                const unsigned vw[4] = {vv.x, vv.y, vv.z, vv.w};
#pragma unroll
                for (int j = 0; j < 8; j++) vT[(ec + v4 * 8 + j) * 72 + s] = (bf16_t)((j & 1) ? (vw[j >> 1] >> 16) : (vw[j >> 1] & 0xffffu));
            }
        }
        __syncthreads();
        f32x4 acc[8][2];
#pragma unroll
        for (int dt = 0; dt < 8; dt++) { acc[dt][0] = (f32x4){0.f, 0.f, 0.f, 0.f}; acc[dt][1] = (f32x4){0.f, 0.f, 0.f, 0.f}; }
#pragma unroll
        for (int ks = 0; ks < 2; ks++) {
            bf16x8 bv[2];
#pragma unroll
            for (int x = 0; x < 2; x++) bv[x] = ld_frag(vT + ((2 * wave + x) * 16 + r) * 72 + ks * 32 + q * 8);
#pragma unroll
            for (int dt = 0; dt < 8; dt++) {
                const bf16x8 a = ld_frag(klT + (dt * 16 + r) * 72 + ks * 32 + q * 8);
#pragma unroll
                for (int x = 0; x < 2; x++) acc[dt][x] = mfma16(a, bv[x], acc[dt][x]);
            }
        }
#pragma unroll
        for (int dt = 0; dt < 8; dt++)
#pragma unroll
            for (int x = 0; x < 2; x++) {
                const int e = eh * 128 + (2 * wave + x) * 16 + r, d = dt * 16 + 4 * q;
                const f32x4 v = acc[dt][x];
                *(u32x2*)(L + ((size_t)task * 256 + e) * 128 + d) = (u32x2){pack2(v[0], v[1]), pack2(v[2], v[3])};
            }
    }
    __syncthreads();
}

__device__ void phaseG2(const Params& p) {
    bf16_t* L = (bf16_t*)p.out;
    const float* dec = (const float*)(p.ws + OFF_DEC);
    for (int idx = vblk() * NTHREADS + (int)(threadIdx.x & 255); idx < 32 * 256 * 16; idx += vgrid() * NTHREADS) {
        const int d8 = idx & 15, e = (idx >> 4) & 255, bh = idx >> 12;
        float st[8];
#pragma unroll
        for (int j = 0; j < 8; j++) st[j] = 0.f;
        for (int c = 0; c < 32; c++) {
            const int task = bh * 32 + c;
            u32x4* ptr = (u32x4*)(L + ((size_t)task * 256 + e) * 128 + d8 * 8);
            const u32x4 lv = *ptr;
            const f32x4 d0 = *(const f32x4*)(dec + task * 128 + d8 * 8), d1 = *(const f32x4*)(dec + task * 128 + d8 * 8 + 4);
            *ptr = (u32x4){pack2(st[0], st[1]), pack2(st[2], st[3]), pack2(st[4], st[5]), pack2(st[6], st[7])};
            st[0] = d0[0] * st[0] + bf_lo(lv.x); st[1] = d0[1] * st[1] + bf_hi(lv.x);
            st[2] = d0[2] * st[2] + bf_lo(lv.y); st[3] = d0[3] * st[3] + bf_hi(lv.y);
            st[4] = d1[0] * st[4] + bf_lo(lv.z); st[5] = d1[1] * st[5] + bf_hi(lv.z);
            st[6] = d1[2] * st[6] + bf_lo(lv.w); st[7] = d1[3] * st[7] + bf_hi(lv.w);
        }
    }
}

__device__ void phaseG3_task(const Params& p, int task, char* lds, bf16_t* ydst, int ystride) {
    const int tid = TIDX, lane = tid & 63, wave = tid >> 6, r = lane & 15, q = lane >> 4;
    const int c = task & 31, h = (task >> 5) & 3, b = task >> 7;
    const int tok0 = b * SEQ + c * 64;
    bf16_t* Z = (bf16_t*)(p.ws + OFF_Z);
    const bf16_t* ST = (const bf16_t*)p.out + (size_t)task * 256 * 128;
    float* bc = (float*)lds;
    bf16_t* vT = (bf16_t*)lds;
    bf16_t* qg = (bf16_t*)(lds + 36864);
    bf16_t* kg = (bf16_t*)(lds + 36864 + 17408);
    bf16_t* P = kg;
    float* red = (float*)(lds + 36864 + 2 * 17408);
    gla_prep(p, tok0, h, lds);
    {
        const int t = tid >> 2, dc = (tid & 3) * 32;
        const bf16_t* qp = Z + (size_t)(tok0 + t) * ZC + ZQ_G + h * 128 + dc;
        const bf16_t* kp = Z + (size_t)(tok0 + t) * ZC + ZK_G + h * 128 + dc;
#pragma unroll
        for (int v4 = 0; v4 < 4; v4++) {
            const u32x4 qv = *(const u32x4*)(qp + v4 * 8), kv = *(const u32x4*)(kp + v4 * 8);
            const unsigned qw[4] = {qv.x, qv.y, qv.z, qv.w}, kw[4] = {kv.x, kv.y, kv.z, kv.w};
            unsigned qo[4], ko[4];
#pragma unroll
            for (int j2 = 0; j2 < 4; j2++) {
                const int d = dc + v4 * 8 + j2 * 2;
                const float b0 = bc[t * 128 + d], b1 = bc[t * 128 + d + 1];
                qo[j2] = pack2(bf_lo(qw[j2]) * 0.08838834764831845f * __expf(b0), bf_hi(qw[j2]) * 0.08838834764831845f * __expf(b1));
                ko[j2] = pack2(bf_lo(kw[j2]) * __expf(-b0), bf_hi(kw[j2]) * __expf(-b1));
            }
            *(u32x4*)(qg + t * 136 + dc + v4 * 8) = (u32x4){qo[0], qo[1], qo[2], qo[3]};
            *(u32x4*)(kg + t * 136 + dc + v4 * 8) = (u32x4){ko[0], ko[1], ko[2], ko[3]};
        }
    }
    __syncthreads();
    {
        const int s = lane, ec = wave * 64;
        const bf16_t* vp = Z + (size_t)(tok0 + s) * ZC + ZV_G + h * 256 + ec;
#pragma unroll
        for (int v4 = 0; v4 < 8; v4++) {
            const u32x4 vv = *(const u32x4*)(vp + v4 * 8);
            const unsigned vw[4] = {vv.x, vv.y, vv.z, vv.w};
#pragma unroll
            for (int j = 0; j < 8; j++) vT[(ec + v4 * 8 + j) * 72 + s] = (bf16_t)((j & 1) ? (vw[j >> 1] >> 16) : (vw[j >> 1] & 0xffffu));
        }
    }
    f32x4 sc[4];
#pragma unroll
    for (int st = 0; st < 4; st++) sc[st] = (f32x4){0.f, 0.f, 0.f, 0.f};
    {
        bf16x8 qf[4];
#pragma unroll
        for (int ks = 0; ks < 4; ks++) qf[ks] = ld_frag(qg + (wave * 16 + r) * 136 + ks * 32 + q * 8);
#pragma unroll
        for (int st = 0; st < 4; st++) {
            if (st <= wave) {
#pragma unroll
                for (int ks = 0; ks < 4; ks++) sc[st] = mfma16(ld_frag(kg + (st * 16 + r) * 136 + ks * 32 + q * 8), qf[ks], sc[st]);
            }
        }
    }
    __syncthreads();
    {
        const int t = wave * 16 + r;
#pragma unroll
        for (int st = 0; st < 4; st++) {
            float pv[4];
#pragma unroll
            for (int j = 0; j < 4; j++) { const int s = st * 16 + 4 * q + j; pv[j] = (s <= t) ? sc[st][j] : 0.f; }
            *(u32x2*)(P + t * 72 + st * 16 + 4 * q) = (u32x2){pack2(pv[0], pv[1]), pack2(pv[2], pv[3])};
        }
    }
    __syncthreads();
    f32x4 o[4][4];
#pragma unroll
    for (int et = 0; et < 4; et++)
#pragma unroll
        for (int tt = 0; tt < 4; tt++) o[et][tt] = (f32x4){0.f, 0.f, 0.f, 0.f};
#pragma unroll
    for (int ks = 0; ks < 2; ks++) {
        bf16x8 pf[4];
#pragma unroll
        for (int tt = 0; tt < 4; tt++) pf[tt] = ld_frag(P + (tt * 16 + r) * 72 + ks * 32 + q * 8);
#pragma unroll
        for (int et = 0; et < 4; et++) {
            const bf16x8 a = ld_frag(vT + ((wave * 4 + et) * 16 + r) * 72 + ks * 32 + q * 8);
#pragma unroll
            for (int tt = 0; tt < 4; tt++) o[et][tt] = mfma16(a, pf[tt], o[et][tt]);
        }
    }
#pragma unroll
    for (int ks = 0; ks < 4; ks++) {
        bf16x8 qf[4];
#pragma unroll
        for (int tt = 0; tt < 4; tt++) qf[tt] = ld_frag(qg + (tt * 16 + r) * 136 + ks * 32 + q * 8);
#pragma unroll
        for (int et = 0; et < 4; et++) {
            const bf16x8 a = *(const bf16x8*)(ST + (size_t)((wave * 4 + et) * 16 + r) * 128 + ks * 32 + q * 8);
#pragma unroll
            for (int tt = 0; tt < 4; tt++) o[et][tt] = mfma16(a, qf[tt], o[et][tt]);
        }
    }
#pragma unroll
    for (int tt = 0; tt < 4; tt++) {
        float ss = 0.f;
#pragma unroll
        for (int et = 0; et < 4; et++)
#pragma unroll
            for (int j = 0; j < 4; j++) ss += o[et][tt][j] * o[et][tt][j];
        ss += __shfl_xor(ss, 16, 64);
        ss += __shfl_xor(ss, 32, 64);
        if (q == 0) red[wave * 64 + tt * 16 + r] = ss;
    }
    __syncthreads();
#pragma unroll
    for (int tt = 0; tt < 4; tt++) {
        const int t = tt * 16 + r;
        const float tot = red[t] + red[64 + t] + red[128 + t] + red[192 + t];
        const float rstd = rsqrtf(tot * (1.f / 256.f) + 1e-6f);
#pragma unroll
        for (int et = 0; et < 4; et++) {
            const int e = (wave * 4 + et) * 16 + 4 * q;
            bf16_t* rp = Z + (size_t)(tok0 + t) * ZC + ZR_G + h * 256 + e;
            const u32x2 rv = *(const u32x2*)rp;
            const f32x4 gn = *(const f32x4*)(p.gla_norm_g + e);
            const float r0 = bf_lo(rv.x), r1 = bf_hi(rv.x), r2 = bf_lo(rv.y), r3 = bf_hi(rv.y);
            const f32x4 ov = o[et][tt];
            *(u32x2*)(ydst + (size_t)(tok0 + t) * ystride + h * 256 + e) = (u32x2){pack2(ov[0] * rstd * gn[0] * siluf_(r0), ov[1] * rstd * gn[1] * siluf_(r1)),
                                  pack2(ov[2] * rstd * gn[2] * siluf_(r2), ov[3] * rstd * gn[3] * siluf_(r3))};
        }
    }
    __syncthreads();
}

__device__ void phaseN1_task(const Params& p, int task, char* lds) {
    const int tid = TIDX, lane = tid & 63, wave = tid >> 6, r = lane & 15, q = lane >> 4;
    const int it = task & 7, g = (task >> 3) & 1, b = (task >> 4) & 7, kv = task >> 7;
    const bf16_t* Z = (const bf16_t*)(p.ws + OFF_Z);
    const bf16_t* W1 = (const bf16_t*)(p.ws + OFF_WC1) + (size_t)kv * 64 * 2048;
    const float* pe = kv ? p.pe_v : p.pe_k;
    const float* w2 = kv ? p.cv_w2 : p.ck_w2;
    const int zoff = (kv ? ZVC : ZKC) + g * 64;
    float* hid = (float*)lds;
    float* hid2 = (float*)(lds + 16384);
    int i = it * 16 + r; if (i > 126) i = 126;
    f32x4 acc[4];
#pragma unroll
    for (int nt = 0; nt < 4; nt++) acc[nt] = (f32x4){0.f, 0.f, 0.f, 0.f};
    for (int ks = 0; ks < 16; ks++) {
        const int k = wave * 512 + ks * 32 + q * 8;
        const int l = k >> 6, d = k & 63;
        const u32x4 zv = *(const u32x4*)(Z + (size_t)(b * SEQ + i * 16 + l) * ZC + zoff + d);
        const f32x4 p0 = *(const f32x4*)(pe + l * 64 + d), p1 = *(const f32x4*)(pe + l * 64 + d + 4);
        const u32x4 av = {pack2(bf_lo(zv.x) + p0[0], bf_hi(zv.x) + p0[1]), pack2(bf_lo(zv.y) + p0[2], bf_hi(zv.y) + p0[3]),
                          pack2(bf_lo(zv.z) + p1[0], bf_hi(zv.z) + p1[1]), pack2(bf_lo(zv.w) + p1[2], bf_hi(zv.w) + p1[3])};
        const bf16x8 a = __builtin_bit_cast(bf16x8, av);
#pragma unroll
        for (int nt = 0; nt < 4; nt++) {
            const bf16x8 bw = *(const bf16x8*)(W1 + (size_t)(nt * 16 + r) * 2048 + k);
            acc[nt] = mfma16(a, bw, acc[nt]);
        }
    }
#pragma unroll
    for (int nt = 0; nt < 4; nt++)
#pragma unroll
        for (int j = 0; j < 4; j++) hid[(wave * 16 + 4 * q + j) * 64 + nt * 16 + r] = acc[nt][j];
    __syncthreads();
    for (int e = tid; e < 1024; e += NTHREADS) hid2[e] = gelu_erf(hid[e] + hid[1024 + e] + hid[2048 + e] + hid[3072 + e]);
    __syncthreads();
    {
        const int il = tid >> 4, n2 = (tid & 15) * 4;
        f32x4 o = {0.f, 0.f, 0.f, 0.f};
        for (int n = 0; n < 64; n++) {
            const float hv = hid2[il * 64 + n];
            const f32x4 wv = *(const f32x4*)(w2 + n * 64 + n2);
            o += hv * wv;
        }
        const int ig = it * 16 + il;
        if (ig >= 127) o = (f32x4){0.f, 0.f, 0.f, 0.f};
        bf16_t* dst = (bf16_t*)(p.ws + OFF_CMP) + ((size_t)((kv * 8 + b) * 2 + g) * 128 + ig) * 64 + n2;
        *(u32x2*)dst = (u32x2){pack2(o[0], o[1]), pack2(o[2], o[3])};
    }
    __syncthreads();
}

__device__ __forceinline__ void nsa_load_kv(const bf16_t* __restrict__ kbase, const bf16_t* __restrict__ vbase, size_t rowstride, bf16_t* Ks, bf16_t* VT) {
    const int tid = TIDX;
    {
        const int key = tid >> 2, ch = (tid & 3) * 16;
        const u32x4 a = *(const u32x4*)(kbase + (size_t)key * rowstride + ch), b = *(const u32x4*)(kbase + (size_t)key * rowstride + ch + 8);
        *(u32x4*)(Ks + key * 72 + ch) = a;
        *(u32x4*)(Ks + key * 72 + ch + 8) = b;
    }
    {
        const int key = tid & 63, dc = (tid >> 6) * 16;
        const u32x4 a = *(const u32x4*)(vbase + (size_t)key * rowstride + dc), b = *(const u32x4*)(vbase + (size_t)key * rowstride + dc + 8);
        const unsigned w[8] = {a.x, a.y, a.z, a.w, b.x, b.y, b.z, b.w};
#pragma unroll
        for (int j = 0; j < 16; j++) VT[(dc + j) * 72 + key] = (bf16_t)((j & 1) ? (w[j >> 1] >> 16) : (w[j >> 1] & 0xffffu));
    }
}

__device__ __forceinline__ void nsa_block_step(const bf16_t* Ks, const bf16_t* VT, const bf16x8 (&qf)[2][2], f32x4 (&O)[2][4], float (&m)[2], float (&l)[2],
                                               int klo, int khi, int r, int q) {
    f32x4 s[2][4];
#pragma unroll
    for (int x = 0; x < 2; x++)
#pragma unroll
        for (int kt = 0; kt < 4; kt++) s[x][kt] = (f32x4){0.f, 0.f, 0.f, 0.f};
#pragma unroll
    for (int kt = 0; kt < 4; kt++)
#pragma unroll
        for (int ks = 0; ks < 2; ks++) {
            const bf16x8 kf = ld_frag(Ks + (kt * 16 + r) * 64 + (((ks * 4 + q) ^ (r & 7)) * 8));
#pragma unroll
            for (int x = 0; x < 2; x++) s[x][kt] = mfma16(kf, qf[x][ks], s[x][kt]);
        }
    __builtin_amdgcn_sched_barrier(0);
    if (!__all((klo <= 0) && (khi >= 63))) {
        const int a = 4 * q - klo;
        const unsigned range = (unsigned)(khi - klo);
        const bool any = khi >= klo;
#pragma unroll
        for (int kt = 0; kt < 4; kt++)
#pragma unroll
            for (int j = 0; j < 4; j++) {
                const bool valid = any && ((unsigned)(kt * 16 + j + a) <= range);
#pragma unroll
                for (int x = 0; x < 2; x++) s[x][kt][j] = valid ? s[x][kt][j] : -3.0e38f;
            }
    }
    bf16x8 pbv[2][2];
#pragma unroll
    for (int x = 0; x < 2; x++) {
        float mx = fmaxf(fmaxf(fmaxf(s[x][0][0], s[x][0][1]), fmaxf(s[x][0][2], s[x][0][3])), fmaxf(fmaxf(s[x][1][0], s[x][1][1]), fmaxf(s[x][1][2], s[x][1][3])));
        mx = fmaxf(mx, fmaxf(fmaxf(fmaxf(s[x][2][0], s[x][2][1]), fmaxf(s[x][2][2], s[x][2][3])), fmaxf(fmaxf(s[x][3][0], s[x][3][1]), fmaxf(s[x][3][2], s[x][3][3]))));
        mx = fmaxf(mx, __shfl_xor(mx, 16, 64));
        mx = fmaxf(mx, __shfl_xor(mx, 32, 64));
        const float mnew = fmaxf(m[x], mx);
        const float alpha = exp2f_(m[x] - mnew);
        m[x] = mnew;
        float ls = 0.f;
#pragma unroll
        for (int kt = 0; kt < 4; kt++)
#pragma unroll
            for (int j = 0; j < 4; j++) { const float pv = exp2f_(s[x][kt][j] - mnew); s[x][kt][j] = pv; ls += pv; }
        l[x] = l[x] * alpha + ls;
#pragma unroll
        for (int dt = 0; dt < 4; dt++) O[x][dt] *= alpha;
#pragma unroll
        for (int s2 = 0; s2 < 2; s2++) {
            const u32x4 t4 = {pack2(s[x][2 * s2][0], s[x][2 * s2][1]), pack2(s[x][2 * s2][2], s[x][2 * s2][3]),
                              pack2(s[x][2 * s2 + 1][0], s[x][2 * s2 + 1][1]), pack2(s[x][2 * s2 + 1][2], s[x][2 * s2 + 1][3])};
            pbv[x][s2] = __builtin_bit_cast(bf16x8, t4);
        }
    }
    __builtin_amdgcn_sched_barrier(0);
#pragma unroll
    for (int s2 = 0; s2 < 2; s2++)
#pragma unroll
        for (int dt = 0; dt < 4; dt++) {
            const u32x2 lo = *(const u32x2*)(VT + (dt * 16 + r) * 72 + (2 * s2) * 16 + 4 * q);
            const u32x2 hi = *(const u32x2*)(VT + (dt * 16 + r) * 72 + (2 * s2 + 1) * 16 + 4 * q);
            const bf16x8 va = mk_frag(lo, hi);
#pragma unroll
            for (int x = 0; x < 2; x++) O[x][dt] = mfma16(va, pbv[x][s2], O[x][dt]);
        }
    __builtin_amdgcn_sched_barrier(0);
}

__device__ __forceinline__ void nsa_cmp_probs(const bf16_t* Kc, const bf16x8 (&qfx)[2], int nv, int r, int q, f32x4 (&s)[8]) {
#pragma unroll
    for (int kt = 0; kt < 8; kt++) s[kt] = (f32x4){0.f, 0.f, 0.f, 0.f};
#pragma unroll
    for (int kt = 0; kt < 8; kt++)
#pragma unroll
        for (int ks = 0; ks < 2; ks++) s[kt] = mfma16(ld_frag(Kc + (kt * 16 + r) * 72 + ks * 32 + q * 8), qfx[ks], s[kt]);
    __builtin_amdgcn_sched_barrier(0);
    float mx = -1e30f;
#pragma unroll
    for (int kt = 0; kt < 8; kt++)
#pragma unroll
        for (int j = 0; j < 4; j++) if (kt * 16 + 4 * q + j < nv) mx = fmaxf(mx, s[kt][j]);
    mx = fmaxf(mx, __shfl_xor(mx, 16, 64));
    mx = fmaxf(mx, __shfl_xor(mx, 32, 64));
    float ls = 0.f;
#pragma unroll
    for (int kt = 0; kt < 8; kt++)
#pragma unroll
        for (int j = 0; j < 4; j++) {
            const float pv = (kt * 16 + 4 * q + j < nv) ? exp2f_(s[kt][j] - mx) : 0.f;
            s[kt][j] = pv; ls += pv;
        }
    ls += __shfl_xor(ls, 16, 64);
    ls += __shfl_xor(ls, 32, 64);
    const float inv = nv > 0 ? 1.f / ls : 0.f;
#pragma unroll
    for (int kt = 0; kt < 8; kt++) s[kt] *= inv;
}

__device__ void phaseN2_task(const Params& p, int task, char* lds, bf16_t* ydst, int ystride, volatile unsigned* uex, char* ldsb) {
    const int tid = TIDX, lane = tid & 63, wave = tid >> 6, r = lane & 15, q = lane >> 4;
    const int t512 = tid + half_id() * 256;
    const int pair = task >> 1, g = pair & 1, b = (pair >> 1) & 7;
    const int tt = (63 - (pair >> 4)) * 2 + (task & 1);
    const int t0 = tt * 16, t = t0 + r;
    const int cur = t0 >> 6;
    bf16_t* Z = (bf16_t*)(p.ws + OFF_Z);
    const size_t rowb = (size_t)b * SEQ;
    bf16_t* Kc = (bf16_t*)ldsb;
    bf16_t* VcT = (bf16_t*)(ldsb + 18432);
    bf16_t* Ks = (bf16_t*)ldsb;
    bf16_t* VT = (bf16_t*)(ldsb + 18432);
    float* impw = (float*)(lds + 35840);
    float* scs = (float*)(lds + 35840 + 32768);
    unsigned* selm = (unsigned*)(lds + 35840 + 32768 + 2048);

    bf16x8 qf[2][2];
#pragma unroll
    for (int x = 0; x < 2; x++)
#pragma unroll
        for (int ks = 0; ks < 2; ks++) qf[x][ks] = *(const bf16x8*)(Z + (rowb + t) * ZC + ZQ_N + (g * 8 + 2 * wave + x) * 64 + ks * 32 + q * 8);
    f32x4* ofl = (f32x4*)(lds + 35840);

    f32x4 Og[2][4];
    {
        const bf16_t* kc = (const bf16_t*)(p.ws + OFF_CMP) + (size_t)((0 * 8 + b) * 2 + g) * 128 * 64;
        const bf16_t* vc = (const bf16_t*)(p.ws + OFF_CMP) + (size_t)((1 * 8 + b) * 2 + g) * 128 * 64;
        {
            const int key = t512 >> 2, ch = (t512 & 3) * 16;
#pragma unroll
            for (int v4 = 0; v4 < 2; v4++) *(u32x4*)(Kc + key * 72 + ch + v4 * 8) = *(const u32x4*)(kc + key * 64 + ch + v4 * 8);
            const int k2 = t512 & 127, dc = (t512 >> 7) * 16;
#pragma unroll
            for (int v4 = 0; v4 < 2; v4++) {
                const u32x4 a = *(const u32x4*)(vc + k2 * 64 + dc + v4 * 8);
                const unsigned w[4] = {a.x, a.y, a.z, a.w};
#pragma unroll
                for (int j = 0; j < 8; j++) VcT[(dc + v4 * 8 + j) * 136 + k2] = (bf16_t)((j & 1) ? (w[j >> 1] >> 16) : (w[j >> 1] & 0xffffu));
            }
        }
        __syncthreads();
        int nv = t >= 31 ? ((t - 31) >> 4) + 1 : 0;
        if (nv > 127) nv = 127;
        f32x4 isum[8];
#pragma unroll
        for (int kt = 0; kt < 8; kt++) isum[kt] = (f32x4){0.f, 0.f, 0.f, 0.f};
#pragma unroll
        for (int x = 0; x < 2; x++) {
            f32x4 s[8];
            nsa_cmp_probs(Kc, qf[x], nv, r, q, s);
#pragma unroll
            for (int kt = 0; kt < 8; kt++) isum[kt] += s[kt];
            f32x4 Oc[4];
#pragma unroll
            for (int dt = 0; dt < 4; dt++) Oc[dt] = (f32x4){0.f, 0.f, 0.f, 0.f};
            __builtin_amdgcn_sched_barrier(0);
#pragma unroll
            for (int s2 = 0; s2 < 4; s2++) {
                const u32x4 t4 = {pack2(s[2 * s2][0], s[2 * s2][1]), pack2(s[2 * s2][2], s[2 * s2][3]),
                                  pack2(s[2 * s2 + 1][0], s[2 * s2 + 1][1]), pack2(s[2 * s2 + 1][2], s[2 * s2 + 1][3])};
                const bf16x8 pbv = __builtin_bit_cast(bf16x8, t4);
#pragma unroll
                for (int dt = 0; dt < 4; dt++) {
                    const u32x2 lo = *(const u32x2*)(VcT + (dt * 16 + r) * 136 + (2 * s2) * 16 + 4 * q);
                    const u32x2 hi = *(const u32x2*)(VcT + (dt * 16 + r) * 136 + (2 * s2 + 1) * 16 + 4 * q);
                    Oc[dt] = mfma16(mk_frag(lo, hi), pbv, Oc[dt]);
                }
            }
            const float g0 = sigmoidf_(bf2f(Z[(rowb + t) * ZC + ZGATE + 0 * 16 + g * 8 + 2 * wave + x]));
#pragma unroll
            for (int dt = 0; dt < 4; dt++) Og[x][dt] = g0 * Oc[dt];
            __builtin_amdgcn_sched_barrier(0);
        }
#pragma unroll
        for (int kt = 0; kt < 8; kt++) *(f32x4*)(impw + (wave * 16 + r) * 128 + kt * 16 + 4 * q) = isum[kt];
        __syncthreads();
#pragma unroll
        for (int pass = 0; pass < 2; pass++) {
            const int tk = pass * 8 + (tid >> 5), j = tid & 31;
            const int i0 = j == 0 ? 0 : 4 * j - 1, i1 = (4 * j + 3 > 126) ? 126 : 4 * j + 3;
            float sc = 0.f;
            for (int i = i0; i <= i1; i++) sc += (impw[(0 * 16 + tk) * 128 + i] + impw[(1 * 16 + tk) * 128 + i]) + (impw[(2 * 16 + tk) * 128 + i] + impw[(3 * 16 + tk) * 128 + i]);
            const bool forced = (j == 0) || (j == cur) || (j == cur - 1);
            scs[tk * 32 + j] = forced ? 1e6f : (j <= cur ? sc : -1.f);
        }
        __syncthreads();
#pragma unroll
        for (int pass = 0; pass < 2; pass++) {
            const int tk = pass * 8 + (tid >> 5), j = tid & 31;
            const float mine = scs[tk * 32 + j];
            int rank = 0;
            for (int j2 = 0; j2 < 32; j2++) { const float o = scs[tk * 32 + j2]; rank += (o > mine || (o == mine && j2 < j)) ? 1 : 0; }
            const unsigned long long bal = __ballot(rank < 16);
            if ((lane & 31) == 0) selm[tk] = (unsigned)(lane ? (bal >> 32) : (bal & 0xffffffffull));
        }
        __syncthreads();
    }
#pragma unroll
    for (int x = 0; x < 2; x++)
#pragma unroll
        for (int dt = 0; dt < 4; dt++) ofl[(wave * 8 + x * 4 + dt) * 64 + lane] = Og[x][dt];
    const unsigned mysel = selm[r];
    unsigned uni = 0;
#pragma unroll
    for (int i = 0; i < 16; i++) uni |= selm[i];
    if (tid == 0) uex[half_id()] = uni;
    __syncthreads();
    uni = uex[0] | uex[1];
    uni &= (cur == 31) ? 0xffffffffu : ((2u << cur) - 1u);
    uni |= 1u;

    {
        const int lo = (t0 & ~31) - 511;
        const int jb0 = lo > 0 ? (lo >> 6) : 0;
        const int kkey = t512 >> 3, kch = (t512 & 7) * 8;
        const int vkey = t512 & 63, vdc = (t512 >> 6) * 8;
        u32x4 kreg, vreg;
        int br = 0, j = 0;
        {
            const bf16_t* kb = Z + (rowb + 0) * ZC + ZKS + g * 64;
            const bf16_t* vb = Z + (rowb + 0) * ZC + ZVS + g * 64;
            kreg = *(const u32x4*)(kb + (size_t)kkey * ZC + kch);
            vreg = *(const u32x4*)(vb + (size_t)vkey * ZC + vdc);
        }
        f32x4 O[2][4];
        float m[2] = {-1e30f, -1e30f}, l[2] = {0.f, 0.f};
#pragma unroll
        for (int x = 0; x < 2; x++)
#pragma unroll
            for (int dt = 0; dt < 4; dt++) O[x][dt] = (f32x4){0.f, 0.f, 0.f, 0.f};
        for (;;) {
            __syncthreads();
            *(u32x4*)(Ks + kkey * 64 + (((kch >> 3) ^ (kkey & 7)) * 8)) = kreg;
            {
                const unsigned w[4] = {vreg.x, vreg.y, vreg.z, vreg.w};
#pragma unroll
                for (int jj = 0; jj < 8; jj++) VT[(vdc + jj) * 72 + vkey] = (bf16_t)((jj & 1) ? (w[jj >> 1] >> 16) : (w[jj >> 1] & 0xffffu));
            }
            __syncthreads();
            int nbr, nj;
            if (br == 0) {
                const unsigned rem = (j >= 31) ? 0u : (uni & ~((2u << j) - 1u));
                if (rem) { nbr = 0; nj = __ffs((int)rem) - 1; } else { nbr = 1; nj = jb0; }
            } else {
                if (j < cur) { nbr = 1; nj = j + 1; } else { nbr = 2; nj = 0; }
            }
            if (nbr < 2) {
                const bf16_t* kb = Z + (rowb + nj * 64) * ZC + (nbr ? ZKW : ZKS) + g * 64;
                const bf16_t* vb = Z + (rowb + nj * 64) * ZC + (nbr ? ZVW : ZVS) + g * 64;
                kreg = *(const u32x4*)(kb + (size_t)kkey * ZC + kch);
                vreg = *(const u32x4*)(vb + (size_t)vkey * ZC + vdc);
            }
            int klo = 0, khi = -1;
            if (br == 0) { if ((mysel >> j) & 1u) khi = t - j * 64; }
            else { khi = t - j * 64; klo = t - 511 - j * 64; }
            klo = klo < 0 ? 0 : klo;
            khi = khi > 63 ? 63 : khi;
            nsa_block_step(Ks, VT, qf, O, m, l, klo, khi, r, q);
            if (nbr != br) {
#pragma unroll
                for (int x = 0; x < 2; x++) {
                    float lt = l[x];
                    lt += __shfl_xor(lt, 16, 64);
                    lt += __shfl_xor(lt, 32, 64);
                    const float sc = sigmoidf_(bf2f(Z[(rowb + t) * ZC + ZGATE + (br + 1) * 16 + g * 8 + 2 * wave + x])) / lt;
#pragma unroll
                    for (int dt = 0; dt < 4; dt++) { ofl[(wave * 8 + x * 4 + dt) * 64 + lane] += sc * O[x][dt]; O[x][dt] = (f32x4){0.f, 0.f, 0.f, 0.f}; }
                    m[x] = -1e30f; l[x] = 0.f;
                }
            }
            if (nbr == 2) break;
            br = nbr; j = nj;
        }
#pragma unroll
        for (int x = 0; x < 2; x++)
#pragma unroll
            for (int dt = 0; dt < 4; dt++) {
                const f32x4 v = ofl[(wave * 8 + x * 4 + dt) * 64 + lane];
                *(u32x2*)(ydst + (rowb + t) * ystride + (g * 8 + 2 * wave + x) * 64 + dt * 16 + 4 * q) = (u32x2){pack2(v[0], v[1]), pack2(v[2], v[3])};
            }
    }
    __syncthreads();
}

__device__ void phaseM1(const Params& p, char* lds) {
    const int tid_ = TIDX512; const int lane = tid_ & 63, wave = tid_ >> 6;
    const int wr = wave >> 2, wc = wave & 3, r = lane & 15, q = lane >> 4;
    const bf16_t* H = (const bf16_t*)(p.ws + OFF_H);
    const bf16_t* Z = (const bf16_t*)(p.ws + OFF_Z);
    bf16_t* M = (bf16_t*)(p.ws + OFF_M);
    bf16_t* SG = (bf16_t*)p.out;
    TileIter tit(4, lds);
    int bm, bn;
    while (tit.next(bm, bn)) {
        const int m0 = bm * 256, n0 = bn * 256;
        for (int br = 0; br < 2; br++) {
            f32x4 acc[8][4];
            zero_acc(acc);
            gemm_core(acc, H, DM, (const bf16_t*)(p.ws + OFF_WM) + (size_t)br * 1024 * 1024, DM, DM, m0, n0, lds);
            {
                const int e0 = launder_i((m0 + wr * 128 + r) * DM + n0 + wc * 64 + 4 * q);
#pragma unroll
                for (int mi = 0; mi < 8; mi++)
#pragma unroll
                    for (int ni = 0; ni < 4; ni++)
                        *(u32x2*)(SG + (size_t)(e0 + mi * 16 * DM + ni * 16)) = (u32x2){pack2(sigmoidf_(acc[mi][ni][0]), sigmoidf_(acc[mi][ni][1])),
                                                                                        pack2(sigmoidf_(acc[mi][ni][2]), sigmoidf_(acc[mi][ni][3]))};
            }
            zero_acc(acc);
            gemm_core(acc, Z + (br ? ZQ_N : ZR_G), ZC, (const bf16_t*)(p.ws + (br ? OFF_WB : OFF_WA)), DM, DM, m0, n0, lds);
            {
                const int e0 = launder_i((m0 + wr * 128 + r) * DM + n0 + wc * 64 + 4 * q);
#pragma unroll
                for (int mi = 0; mi < 8; mi++)
#pragma unroll
                    for (int ni = 0; ni < 4; ni++) {
                        const size_t eo = (size_t)(e0 + mi * 16 * DM + ni * 16);
                        const u32x2 sg = *(const u32x2*)(SG + eo);
                        float v[4] = {bf_lo(sg.x) * acc[mi][ni][0], bf_hi(sg.x) * acc[mi][ni][1], bf_lo(sg.y) * acc[mi][ni][2], bf_hi(sg.y) * acc[mi][ni][3]};
                        u32x2* dst = (u32x2*)(M + eo);
                        if (br) { const u32x2 pv = *dst; v[0] += bf_lo(pv.x); v[1] += bf_hi(pv.x); v[2] += bf_lo(pv.y); v[3] += bf_hi(pv.y); }
                        *dst = (u32x2){pack2(v[0], v[1]), pack2(v[2], v[3])};
                    }
            }
        }
    }
}

__device__ void phaseM2(const Params& p, char* lds) {
    const int tid_ = TIDX512; const int lane = tid_ & 63, wave = tid_ >> 6;
    const int wr = wave >> 2, wc = wave & 3, r = lane & 15, q = lane >> 4;
    const bf16_t* M = (const bf16_t*)(p.ws + OFF_M);
    const float* mod = (const float*)(p.ws + OFF_MOD);
    TileIter tit(4, lds);
    int bm, bn;
    while (tit.next(bm, bn)) {
        const int m0 = bm * 256, n0 = bn * 256;
        f32x4 acc[8][4];
        zero_acc(acc);
        gemm_core(acc, M, DM, (const bf16_t*)(p.ws + OFF_WO), DM, DM, m0, n0, lds);
#pragma unroll
        for (int mi = 0; mi < 8; mi++)
#pragma unroll
            for (int ni = 0; ni < 4; ni++) {
                const int tok = m0 + wr * 128 + mi * 16 + r, col = n0 + wc * 64 + ni * 16 + 4 * q;
                const f32x4 xv = *(const f32x4*)(p.x + (size_t)tok * DM + col);
                const f32x4 gt = *(const f32x4*)(mod + (tok >> 11) * 6144 + 2 * 1024 + col);
                *(f32x4*)(p.out + (size_t)tok * DM + col) = xv + gt * acc[mi][ni];
            }
    }
    {
        const int tid_ = TIDX; const int lane = tid_ & 63, wave = tid_ >> 6;
        unsigned char* tq = (unsigned char*)(p.ws + OFF_UB);
        float* tsc = (float*)(p.ws + OFF_UB + 33554432);
        for (int row = vblk() * 4 + wave; row < 32768; row += vgrid() * 4) {
            const bool isv = row >= 16384;
            const float* srcp = (isv ? p.peer_v : p.peer_u) + (size_t)(row & 16383) * DM + lane * 16;
            f32x4 a[4];
            float mx = 0.f;
#pragma unroll
            for (int i = 0; i < 4; i++) {
                a[i] = *(const f32x4*)(srcp + i * 4);
                mx = fmaxf(mx, fmaxf(fmaxf(fabsf(a[i][0]), fabsf(a[i][1])), fmaxf(fabsf(a[i][2]), fabsf(a[i][3]))));
            }
            mx = wave_max(mx);
            const float inv = mx > 0.f ? 127.f / mx : 0.f;
            const int off = isv ? 128 : 0;
            unsigned w[4];
#pragma unroll
            for (int i = 0; i < 4; i++) {
                unsigned pk = 0;
#pragma unroll
                for (int j = 0; j < 4; j++) {
                    int qi = (int)rintf(a[i][j] * inv);
                    qi = qi > 127 ? 127 : (qi < -127 ? -127 : qi);
                    pk |= ((unsigned)(qi + off) & 0xffu) << (8 * j);
                }
                w[i] = pk;
            }
            *(u32x4*)(tq + (size_t)row * DM + lane * 16) = (u32x4){w[0], w[1], w[2], w[3]};
            if (lane == 0) tsc[row] = mx * (1.f / 127.f);
        }
    }
}

__device__ void phaseP1(const Params& p, char* lds) {
    const int tid_ = TIDX512; const int lane = tid_ & 63, wave = tid_ >> 6;
    const int wr = wave >> 2, wc = wave & 3, r = lane & 15, q = lane >> 4;
    const bf16_t* H = (const bf16_t*)(p.ws + OFF_H);
    bf16_t* QP = (bf16_t*)(p.ws + OFF_QP);
    TileIter tit(8, lds);
    int bm, bn;
    while (tit.next(bm, bn)) {
        const int m0 = bm * 256, n0 = bn * 256;
        f32x4 acc[8][4];
        zero_acc(acc);
        gemm_core(acc, H, DM, (const bf16_t*)(p.ws + OFF_WQ), DM, DM, m0, n0, lds);
#pragma unroll
        for (int mi = 0; mi < 8; mi++)
#pragma unroll
            for (int ni = 0; ni < 4; ni++) epi_fill(lds, wr, wc, r, q, mi, ni, acc[mi][ni]);
        __syncthreads();
        epi_store(lds, QP, 2048, m0, n0, 2048);
        __syncthreads();
    }
}

__constant__ unsigned char c_cand_a[64] = {0,0,0,0,0,0,0,0,0,0,0,0,0,0,0,0, 1,1,1,1,1,1,1,1, 2,2,2,2,2, 3,3,3,3, 4,4,4, 5,5, 6,6, 7,7, 8,9,10,11,12,13,14,15, 0,0,0,0,0,0,0,0,0,0,0,0,0,0};
__constant__ unsigned char c_cand_b[64] = {0,1,2,3,4,5,6,7,8,9,10,11,12,13,14,15, 0,1,2,3,4,5,6,7, 0,1,2,3,4, 0,1,2,3, 0,1,2, 0,1, 0,1, 0,1, 0,0,0,0,0,0,0,0, 0,0,0,0,0,0,0,0,0,0,0,0,0,0};

__device__ __forceinline__ unsigned f2key(float f) { const unsigned u = __float_as_uint(f); return (u & 0x80000000u) ? ~u : (u | 0x80000000u); }
__device__ __forceinline__ float key2f(unsigned k) { const unsigned u = (k & 0x80000000u) ? (k & 0x7fffffffu) : ~k; return __uint_as_float(u); }
__device__ __forceinline__ void cex_desc(unsigned& a, unsigned& b) { const unsigned hi = a > b ? a : b, lo = a > b ? b : a; a = hi; b = lo; }
__device__ __forceinline__ void sort16_desc(unsigned (&a)[16]) {
#pragma unroll
    for (int k = 2; k <= 16; k <<= 1)
#pragma unroll
        for (int j = k >> 1; j > 0; j >>= 1)
#pragma unroll
            for (int i = 0; i < 16; i++) {
                const int l = i ^ j;
                if (l > i) { if ((i & k) == 0) cex_desc(a[i], a[l]); else cex_desc(a[l], a[i]); }
            }
}
__device__ __forceinline__ void merge16_desc(unsigned (&a)[16], const unsigned (&b)[16]) {
#pragma unroll
    for (int i = 0; i < 16; i++) a[i] = a[i] > b[15 - i] ? a[i] : b[15 - i];
#pragma unroll
    for (int j = 8; j > 0; j >>= 1)
#pragma unroll
        for (int i = 0; i < 16; i++) { const int l = i ^ j; if (l > i) cex_desc(a[i], a[l]); }
}

__device__ void phaseP2_task(const Params& p, int task, char* lds) {
    const int tid = TIDX, lane = tid & 63, wave = tid >> 6, r = lane & 15, q = lane >> 4;
    const int h = task & 7, tile = task >> 3;
    const int tok0 = tile * 64;
    const bf16_t* QP = (const bf16_t*)(p.ws + OFF_QP);
    float* S = (float*)lds;
    unsigned* LL = (unsigned*)(lds + 65536);
#pragma unroll
    for (int half = 0; half < 2; half++) {
        const bf16_t* KB = (const bf16_t*)(p.ws + OFF_K1B) + (size_t)half * 131072 + (size_t)h * 128 * 128;
        f32x4 acc[8];
#pragma unroll
        for (int nt = 0; nt < 8; nt++) acc[nt] = (f32x4){0.f, 0.f, 0.f, 0.f};
#pragma unroll
        for (int ks = 0; ks < 4; ks++) {
            const bf16x8 bq = *(const bf16x8*)(QP + (size_t)(tok0 + wave * 16 + r) * 2048 + h * 256 + half * 128 + ks * 32 + q * 8);
#pragma unroll
            for (int nt = 0; nt < 8; nt++) {
                const bf16x8 ak = *(const bf16x8*)(KB + (size_t)(nt * 16 + r) * 128 + ks * 32 + q * 8);
                acc[nt] = mfma16(ak, bq, acc[nt]);
            }
        }
#pragma unroll
        for (int nt = 0; nt < 8; nt++)
#pragma unroll
            for (int j = 0; j < 4; j++) S[(half * 128 + nt * 16 + 4 * q + j) * 64 + wave * 16 + r] = acc[nt][j];
    }
    __syncthreads();
    {
        const int row = tid & 127, part = tid >> 7, half = row >> 6, tk = row & 63;
        unsigned L[16];
        const float* sp = S + (half * 128 + part * 64) * 64 + tk;
#pragma unroll
        for (int k = 0; k < 16; k++) L[k] = (f2key(sp[k * 64]) & ~127u) | (unsigned)(127 - (part * 64 + k));
        sort16_desc(L);
        for (int gq = 1; gq < 4; gq++) {
            unsigned G[16];
#pragma unroll
            for (int k = 0; k < 16; k++) G[k] = (f2key(sp[(gq * 16 + k) * 64]) & ~127u) | (unsigned)(127 - (part * 64 + gq * 16 + k));
            sort16_desc(G);
            merge16_desc(L, G);
        }
        __syncthreads();
        unsigned* LP = (unsigned*)lds;
#pragma unroll
        for (int k = 0; k < 16; k++) LP[((part * 2 + half) * 16 + k) * 64 + tk] = L[k];
        __syncthreads();
        if (tid < 128) {
            unsigned A[16], Bq[16];
#pragma unroll
            for (int k = 0; k < 16; k++) { A[k] = LP[((0 * 2 + half) * 16 + k) * 64 + tk]; Bq[k] = LP[((1 * 2 + half) * 16 + k) * 64 + tk]; }
            merge16_desc(A, Bq);
#pragma unroll
            for (int k = 0; k < 16; k++) LL[(half * 16 + k) * 64 + tk] = A[k];
        }
    }
    __syncthreads();
    if (tid < 64) {
        const int tk = tid;
        float v1[16], v2[16];
#pragma unroll
        for (int k = 0; k < 16; k++) { v1[k] = key2f(LL[k * 64 + tk] & ~127u); v2[k] = key2f(LL[(16 + k) * 64 + tk] & ~127u); }
        unsigned C[64];
#pragma unroll
        for (int k = 0; k < 64; k++) C[k] = 0u;
        {
            int c = 0;
#pragma unroll
            for (int a = 0; a < 16; a++)
#pragma unroll
                for (int b = 0; b < 16; b++)
                    if ((a + 1) * (b + 1) <= 16) { C[c] = (f2key(v1[a] + v2[b]) & ~63u) | (unsigned)(63 - c); c++; }
        }
        unsigned T[16];
#pragma unroll
        for (int k = 0; k < 16; k++) T[k] = C[k];
        sort16_desc(T);
#pragma unroll
        for (int gq = 1; gq < 4; gq++) {
            unsigned G[16];
#pragma unroll
            for (int k = 0; k < 16; k++) G[k] = C[gq * 16 + k];
            sort16_desc(G);
            merge16_desc(T, G);
        }
        const float mx = key2f(T[0] & ~63u);
        float e[16], sum = 0.f;
#pragma unroll
        for (int k = 0; k < 16; k++) { e[k] = __expf(key2f(T[k] & ~63u) - mx); sum += e[k]; }
        const float inv = 1.f / sum;
        int ei[16];
#pragma unroll
        for (int k = 0; k < 16; k++) {
            const int cc = 63 - (int)(T[k] & 63u);
            const int a = c_cand_a[cc], b = c_cand_b[cc];
            const int i1 = 127 - (int)(LL[a * 64 + tk] & 127u), i2 = 127 - (int)(LL[(16 + b) * 64 + tk] & 127u);
            ei[k] = i1 * 128 + i2;
            e[k] *= inv;
        }
        int* eidx = (int*)(p.ws + OFF_EIDX) + (size_t)(tok0 + tk) * 128 + h * 16;
        float* gw = (float*)(p.ws + OFF_GW) + (size_t)(tok0 + tk) * 128 + h * 16;
#pragma unroll
        for (int k4 = 0; k4 < 4; k4++) {
            *(u32x4*)(eidx + k4 * 4) = (u32x4){(unsigned)ei[k4 * 4], (unsigned)ei[k4 * 4 + 1], (unsigned)ei[k4 * 4 + 2], (unsigned)ei[k4 * 4 + 3]};
            *(f32x4*)(gw + k4 * 4) = (f32x4){e[k4 * 4], e[k4 * 4 + 1], e[k4 * 4 + 2], e[k4 * 4 + 3]};
        }
    }
    __syncthreads();
}

__device__ __forceinline__ float ub0(unsigned w) { return (float)(w & 0xffu); }
__device__ __forceinline__ float ub1(unsigned w) { return (float)((w >> 8) & 0xffu); }
__device__ __forceinline__ float ub2(unsigned w) { return (float)((w >> 16) & 0xffu); }
__device__ __forceinline__ float ub3(unsigned w) { return (float)(w >> 24); }
struct P3Sc { float su, sv, gm; };
constexpr int P3_REC = 2048;
__device__ __forceinline__ void p3_load_u(u32x4 (&ur)[4], P3Sc& sc, const unsigned char* __restrict__ UQ, const float* __restrict__ tsc,
                                          int lane, int ul, int g, const unsigned* rec) {
#pragma unroll
    for (int u = 0; u < 4; u++) ur[u] = *(const u32x4*)(UQ + (size_t)rec[4 * g + u] * DM + lane * 16);
    const int em = (int)rec[4 * g + ul];
    sc.gm = __uint_as_float(rec[128 + 4 * g + ul]);
    sc.su = tsc[em];
    sc.sv = tsc[16384 + em];
}
__device__ __forceinline__ void p3_load_v(u32x4 (&vr)[4], const unsigned char* __restrict__ VQ, int lane, int g, const unsigned* rec) {
#pragma unroll
    for (int u = 0; u < 4; u++) vr[u] = *(const u32x4*)(VQ + (size_t)rec[4 * g + u] * DM + lane * 16);
}
__device__ __forceinline__ void p3_dots(const u32x4 (&ur)[4], const unsigned* rec, int lane, int (&pt)[4]) {
    const u32x4 qh = *(const u32x4*)(rec + 256 + lane * 4);
#pragma unroll
    for (int u = 0; u < 4; u++) {
        int d = __builtin_amdgcn_sdot4((int)ur[u].x, (int)qh.x, 0, false);
        d = __builtin_amdgcn_sdot4((int)ur[u].y, (int)qh.y, d, false);
        d = __builtin_amdgcn_sdot4((int)ur[u].z, (int)qh.z, d, false);
        d = __builtin_amdgcn_sdot4((int)ur[u].w, (int)qh.w, d, false);
        pt[u] = d;
    }
}
__device__ __forceinline__ float p3_weight(const int (&pt)[4], int lane, float sh, const P3Sc& sc) {
    int m2[2], m1;
    const bool c0 = lane & 1;
#pragma unroll
    for (int j = 0; j < 2; j++) { const int keep = c0 ? pt[j + 2] : pt[j], send = c0 ? pt[j] : pt[j + 2]; m2[j] = keep + __shfl_xor(send, 1, 64); }
    const bool c1 = lane & 2;
    { const int keep = c1 ? m2[1] : m2[0], send = c1 ? m2[0] : m2[1]; m1 = keep + __shfl_xor(send, 2, 64); }
    m1 += __shfl_xor(m1, 4, 64);
    m1 += __shfl_xor(m1, 8, 64);
    m1 += __shfl_xor(m1, 16, 64);
    m1 += __shfl_xor(m1, 32, 64);
    const float aval = (float)m1 * (sh * sc.su);
    return sc.gm * gelu_erf(aval) * sc.sv;
}
__device__ __forceinline__ void p3_axpy(const u32x4 (&vr)[4], float ws, float (&acc)[16], float& wsum) {
#pragma unroll
    for (int u = 0; u < 4; u++) {
        const int src_lane = ((u >> 1) & 1) | ((u & 1) << 1);
        const float wu = __shfl(ws, src_lane, 64);
        wsum += wu;
        const unsigned vw[4] = {vr[u].x, vr[u].y, vr[u].z, vr[u].w};
#pragma unroll
        for (int i = 0; i < 4; i++) {
            acc[i * 4 + 0] += wu * ub0(vw[i]); acc[i * 4 + 1] += wu * ub1(vw[i]);
            acc[i * 4 + 2] += wu * ub2(vw[i]); acc[i * 4 + 3] += wu * ub3(vw[i]);
        }
    }
}
__device__ __forceinline__ void p3_token(const Params& p, int tok, int lane, unsigned* rec, float& sh) {
    const bf16_t* H = (const bf16_t*)(p.ws + OFF_H);
    const int* eidx = (const int*)(p.ws + OFF_EIDX);
    const float* gwp = (const float*)(p.ws + OFF_GW);
    {
        const u32x4 a = *(const u32x4*)(H + (size_t)tok * DM + lane * 16), b = *(const u32x4*)(H + (size_t)tok * DM + lane * 16 + 8);
        const unsigned hw[8] = {a.x, a.y, a.z, a.w, b.x, b.y, b.z, b.w};
        float hv[16];
        float mx = 0.f;
#pragma unroll
        for (int i = 0; i < 8; i++) { hv[2 * i] = bf_lo(hw[i]); hv[2 * i + 1] = bf_hi(hw[i]); mx = fmaxf(mx, fmaxf(fabsf(hv[2 * i]), fabsf(hv[2 * i + 1]))); }
        mx = wave_max(mx);
        const float inv = mx > 0.f ? 127.f / mx : 0.f;
        sh = mx * (1.f / 127.f);
        unsigned qh[4];
#pragma unroll
        for (int i = 0; i < 4; i++) {
            unsigned pk = 0;
#pragma unroll
            for (int j = 0; j < 4; j++) pk |= ((unsigned)((int)rintf(hv[i * 4 + j] * inv)) & 0xffu) << (8 * j);
            qh[i] = pk;
        }
        *(u32x4*)(rec + 256 + lane * 4) = (u32x4){qh[0], qh[1], qh[2], qh[3]};
    }
    const int e0 = eidx[(size_t)tok * 128 + lane], e1 = eidx[(size_t)tok * 128 + 64 + lane];
    const float g0 = gwp[(size_t)tok * 128 + lane], g1 = gwp[(size_t)tok * 128 + 64 + lane];
    const int k0 = e0 >> 10, k1 = e1 >> 10;
    int pos0 = 0, pos1 = 0, base = 0;
#pragma unroll
    for (int v = 0; v < 16; v++) {
        const unsigned long long m0 = __ballot(k0 == v), m1 = __ballot(k1 == v);
        const int c0 = __popcll(m0);
        const int r0 = __builtin_amdgcn_mbcnt_hi((unsigned)(m0 >> 32), __builtin_amdgcn_mbcnt_lo((unsigned)m0, 0u));
        const int r1 = __builtin_amdgcn_mbcnt_hi((unsigned)(m1 >> 32), __builtin_amdgcn_mbcnt_lo((unsigned)m1, 0u));
        pos0 = (k0 == v) ? base + r0 : pos0;
        pos1 = (k1 == v) ? base + c0 + r1 : pos1;
        base += c0 + __popcll(m1);
    }
    rec[pos0] = (unsigned)e0; rec[pos1] = (unsigned)e1;
    rec[128 + pos0] = __float_as_uint(g0); rec[128 + pos1] = __float_as_uint(g1);
}
__device__ __forceinline__ void p3_finish(const Params& p, float* dstp, int tok, int lane, const float (&acc)[16], float wsum) {
    const float* mod = (const float*)(p.ws + OFF_MOD);
    const int b = tok >> 11;
    float x2[16];
    float ss = 0.f;
#pragma unroll
    for (int i = 0; i < 4; i++) {
        const int d = lane * 16 + i * 4;
        const f32x4 xv = *(const f32x4*)(p.out + (size_t)tok * DM + d);
        const f32x4 gt = *(const f32x4*)(mod + b * 6144 + 5 * 1024 + d);
#pragma unroll
        for (int j = 0; j < 4; j++) { const float v = xv[j] + gt[j] * (acc[i * 4 + j] - 128.f * wsum); x2[i * 4 + j] = v; ss += v * v; }
    }
    ss = wave_sum(ss);
    const float rstd = rsqrtf(ss * (1.f / 1024.f) + 1e-6f);
#pragma unroll
    for (int i = 0; i < 4; i++) {
        const int d = lane * 16 + i * 4;
        const f32x4 fg = *(const f32x4*)(p.final_g + d);
        f32x4 o;
#pragma unroll
        for (int j = 0; j < 4; j++) o[j] = x2[i * 4 + j] * rstd * fg[j];
        *(f32x4*)(dstp + (size_t)tok * DM + d) = o;
    }
}
__device__ void phaseP3(const Params& p, float* dstp, char* lds) {
    const int tid_ = TIDX; const int lane = tid_ & 63, wave = tid_ >> 6;
    const unsigned char* UQ = (const unsigned char*)(p.ws + OFF_UB);
    const unsigned char* VQ = UQ + 16777216;
    const float* tsc = (const float*)(p.ws + OFF_UB + 33554432);
    const int ul = ((lane & 1) << 1) | ((lane >> 1) & 1);
    constexpr int TPW = 2;
    unsigned* recs = (unsigned*)(lds + wave * TPW * P3_REC);
    for (int tb = (vblk() * 4 + wave) * TPW; tb < NTOK; tb += vgrid() * 4 * TPW) {
        float sh[TPW], acc[TPW][16], wsm[TPW];
        __builtin_amdgcn_wave_barrier();
#pragma unroll
        for (int k = 0; k < TPW; k++) {
            p3_token(p, tb + k, lane, recs + k * (P3_REC / 4), sh[k]);
#pragma unroll
            for (int i = 0; i < 16; i++) acc[k][i] = 0.f;
            wsm[k] = 0.f;
        }
        __builtin_amdgcn_wave_barrier();
        u32x4 ur[4], vr[4];
        P3Sc sc[TPW];
        p3_load_u(ur, sc[0], UQ, tsc, lane, ul, 0, recs);
        p3_load_v(vr, VQ, lane, 0, recs);
        for (int g = 0; g < 32; g++) {
#pragma unroll
            for (int k = 0; k < TPW; k++) {
                const int kn = (k + 1) % TPW;
                const int gn = (k + 1 == TPW) ? g + 1 : g;
                int pt[4];
                p3_dots(ur, recs + k * (P3_REC / 4), lane, pt);
                if (gn < 32) p3_load_u(ur, sc[kn], UQ, tsc, lane, ul, gn, recs + kn * (P3_REC / 4));
                const float w = p3_weight(pt, lane, sh[k], sc[k]);
                p3_axpy(vr, w, acc[k], wsm[k]);
                if (gn < 32) p3_load_v(vr, VQ, lane, gn, recs + kn * (P3_REC / 4));
            }
        }
#pragma unroll
        for (int k = 0; k < TPW; k++) p3_finish(p, dstp, tb + k, lane, acc[k], wsm[k]);
    }
}

#define XB_TMO      128
#define XB_XCNT(j)  (256  + 64 * (j))
#define XB_XSUB(j)  (1280 + 64 * (j))
#define XB_XGEN(j)  (2304 + 64 * (j))
#define XB_TOP      3328
#define XB_TOPGEN   3392
#define XCD_BAR_WORDS 3456
#define XB_SPIN_CAP (1u << 22)
#define LAS __attribute__((address_space(3)))
__device__ __forceinline__ unsigned xb_ld(unsigned* p)              { return __hip_atomic_load(p, __ATOMIC_RELAXED, __HIP_MEMORY_SCOPE_AGENT); }
__device__ __forceinline__ unsigned xb_add(unsigned* p, unsigned v) { return __hip_atomic_fetch_add(p, v, __ATOMIC_RELAXED, __HIP_MEMORY_SCOPE_AGENT); }
__device__ __forceinline__ unsigned xb_xcc_id() { return (unsigned)__builtin_amdgcn_s_getreg((3 << 11) | 20) & 0xFu; }
#define XB_SPIN(cond, bar) do { unsigned _sp = 0; while (cond) { __builtin_amdgcn_s_sleep(1); \
    if ((++_sp & 255u) == 0u) { if (xb_ld(&(bar)[XB_TMO])) break; if (_sp > XB_SPIN_CAP) { atomicAdd(&(bar)[XB_TMO], 1u); break; } } } } while (0)
struct XcdBarrier { unsigned* bar; unsigned x; volatile LAS unsigned* st; };
__device__ __forceinline__ XcdBarrier xcd_barrier_post(unsigned* bar, volatile LAS unsigned* st) {
    XcdBarrier b; b.bar = bar; b.x = xb_xcc_id(); b.st = st;
    if (threadIdx.x == 0) { st[2] = xb_add(&bar[XB_XCNT(b.x)], 1u); st[4] = b.x; }
    return b;
}
__device__ __forceinline__ void xcd_barrier_complete(unsigned* bar, unsigned x, unsigned& nloc, unsigned& nx, unsigned& bal) {
    const unsigned G = gridDim.x * gridDim.y * gridDim.z;
    unsigned sum, cnt, mine, c64, sp = 0u;
    for (;;) {
        sum = 0u; cnt = 0u; mine = 0u; c64 = 0u;
#pragma unroll
        for (unsigned j = 0; j < 16; ++j) { const unsigned c = xb_ld(&bar[XB_XCNT(j)]); sum += c; cnt += (c > 0u) ? 1u : 0u; c64 += (j < 8 && c == 64u) ? 1u : 0u; mine = (j == x) ? c : mine; }
        if (sum == G) break;
        __builtin_amdgcn_s_sleep(1);
        if ((++sp & 255u) == 0u) { if (xb_ld(&bar[XB_TMO])) break; if (sp > XB_SPIN_CAP) { atomicAdd(&bar[XB_TMO], 1u); break; } }
    }
    nloc = mine > 0u ? mine : 1u; nx = cnt > 0u ? cnt : 1u; bal = (sum == G && cnt == 8u && c64 == 8u) ? 1u : 0u;
}
__device__ __forceinline__ void xcd_barrier(const XcdBarrier& b) {
    asm volatile("s_waitcnt vmcnt(0)" ::: "memory");
    __syncthreads();
    if (threadIdx.x == 0) {
        unsigned* bar = b.bar;
        __builtin_amdgcn_s_waitcnt(0);
        unsigned nloc = b.st[0], nx = b.st[1];
        if (nloc == 0u) { unsigned bal; xcd_barrier_complete(bar, b.x, nloc, nx, bal); b.st[0] = nloc; b.st[1] = nx; b.st[3] = bal; }
        const unsigned old = xb_add(&bar[XB_XSUB(b.x)], 1u);
        const unsigned gen = old / nloc;
        if (old + 1u == (gen + 1u) * nloc) {
            __builtin_amdgcn_fence(__ATOMIC_RELEASE, "agent");
            asm volatile("s_waitcnt vmcnt(0)" ::: "memory");
            const unsigned og = xb_add(&bar[XB_TOP], 1u);
            const unsigned tg = og / nx;
            if (og + 1u == (tg + 1u) * nx) xb_add(&bar[XB_TOPGEN], 1u);
            else XB_SPIN(xb_ld(&bar[XB_TOPGEN]) == tg, bar);
            __builtin_amdgcn_fence(__ATOMIC_ACQUIRE, "agent");
            xb_add(&bar[XB_XGEN(b.x)], 1u);
            asm volatile("s_waitcnt vmcnt(0)" ::: "memory");
        } else {
            XB_SPIN(xb_ld(&bar[XB_XGEN(b.x)]) == gen, bar);
            __builtin_amdgcn_fence(__ATOMIC_ACQUIRE, "agent");
            asm volatile("s_waitcnt vmcnt(0)" ::: "memory");
        }
    }
    __syncthreads();
}

typedef __attribute__((address_space(4))) const Params* KParamsPtr;
__device__ __forceinline__ const Params& fresh_params() {
    KParamsPtr kp = (KParamsPtr)__builtin_amdgcn_kernarg_segment_ptr();
    asm volatile("" : "+s"(kp));
    return *(const Params*)kp;
}
#define PF fresh_params()
__global__ void __launch_bounds__(BLOCK_THREADS, 2) mega(Params p_unused) {
    __shared__ __attribute__((aligned(16))) char lds[LDS_BYTES];
    cg::grid_group grid = cg::this_grid();
    volatile LAS unsigned* st = (volatile LAS unsigned*)(lds + 2 * LDS_MAIN);
    if (threadIdx.x < 16) st[threadIdx.x] = 0u;
    __syncthreads();
    XcdBarrier xb = xcd_barrier_post((unsigned*)PF.ws, st);
    char* hl = lds + half_id() * LDS_MAIN;
    volatile unsigned* uex = (volatile unsigned*)(lds + 2 * LDS_MAIN + 32);

    phaseA(PF, hl);
    if (PF.ws == nullptr) grid.sync();
    xcd_barrier(xb);
    { const Params& q_ = PF; phase_modnorm(q_, q_.x, q_.norm1_g, 0, 1, (bf16_t*)(q_.ws + OFF_H)); };
    xcd_barrier(xb);
    phaseC(PF, lds);
    xcd_barrier(xb);
    for (int task = vblk(); task < 1024; task += vgrid()) phaseG1_task(PF, task, hl);
    for (int task = vblk(); task < 256; task += vgrid()) phaseN1_task(PF, task, hl);
    xcd_barrier(xb);
    phaseG2(PF);
    phaseA2(PF, hl);
    xcd_barrier(xb);
    for (int task = vblk(); task < 2048; task += vgrid()) phaseN2_task(PF, task, hl, (bf16_t*)(PF.ws + OFF_Z) + ZQ_N, ZC, uex, lds);
    for (int task = vblk(); task < 1024; task += vgrid()) phaseG3_task(PF, task, hl, (bf16_t*)(PF.ws + OFF_Z) + ZR_G, ZC);
    xcd_barrier(xb);
    phaseM1(PF, lds);
    xcd_barrier(xb);
    phaseM2(PF, lds);
    xcd_barrier(xb);
    { const Params& q_ = PF; phase_modnorm(q_, q_.out, q_.norm2_g, 3, 4, (bf16_t*)(q_.ws + OFF_H)); };
    xcd_barrier(xb);
    phaseP1(PF, lds);
    xcd_barrier(xb);
    for (int task = vblk(); task < 2048; task += vgrid()) phaseP2_task(PF, task, hl);
    xcd_barrier(xb);
    { const Params& q_ = PF; phaseP3(q_, q_.out, hl); };
}

extern "C" void kernel_launch(void* const* d_in, const int* in_sizes, int n_in, void* d_out, int out_size, void* d_ws, size_t ws_size, hipStream_t stream) {
    Params p{};
    p.x = (const float*)d_in[0]; p.c = (const float*)d_in[1]; p.pos = (const int*)d_in[2]; p.ada_w = (const float*)d_in[3]; p.ada_b = (const float*)d_in[4];
    p.norm1_g = (const float*)d_in[5]; p.norm2_g = (const float*)d_in[6]; p.final_g = (const float*)d_in[7]; p.w_in = (const float*)d_in[8];
    p.gla_wa2 = (const float*)d_in[9]; p.gla_ba2 = (const float*)d_in[10]; p.gla_norm_g = (const float*)d_in[11]; p.pe_k = (const float*)d_in[12]; p.pe_v = (const float*)d_in[13];
    p.ck_w1 = (const float*)d_in[14]; p.ck_w2 = (const float*)d_in[15]; p.cv_w1 = (const float*)d_in[16]; p.cv_w2 = (const float*)d_in[17];
    p.w_branch_a = (const float*)d_in[18]; p.w_branch_b = (const float*)d_in[19]; p.w_out = (const float*)d_in[20]; p.peer_wq = (const float*)d_in[21];
    p.peer_k1 = (const float*)d_in[22]; p.peer_k2 = (const float*)d_in[23]; p.peer_u = (const float*)d_in[24]; p.peer_v = (const float*)d_in[25];
    p.out = (float*)d_out; p.ws = (char*)d_ws;
    static int grid_blocks = 0;
    if (!grid_blocks) {
        int dev = 0, cus = 0, per_cu = 0;
        hipGetDevice(&dev);
        hipDeviceGetAttribute(&cus, hipDeviceAttributeMultiprocessorCount, dev);
        hipOccupancyMaxActiveBlocksPerMultiprocessor(&per_cu, mega, BLOCK_THREADS, 0);
        if (per_cu > 1) per_cu = 1;
        if (per_cu < 1) per_cu = 1;
        grid_blocks = cus * per_cu;
    }
    hipMemsetAsync(d_ws, 0, XCD_BAR_WORDS * 4, stream);
    void* args[] = {&p};
    hipError_t e = hipLaunchCooperativeKernel((void*)mega, dim3(grid_blocks), dim3(BLOCK_THREADS), args, 0, stream);
    if (e != hipSuccess) fprintf(stderr, "cooperative launch failed: %s (grid %d)\n", hipGetErrorString(e), grid_blocks);
}
```

```cpp
#include <hip/hip_runtime.h>
#include <hip/hip_cooperative_groups.h>
#include <stdio.h>
namespace cg = cooperative_groups;
#include <stdint.h>
#include <stddef.h>
#include <math.h>

typedef unsigned short bf16_t;
typedef short bf16x8 __attribute__((ext_vector_type(8)));
typedef float f32x4 __attribute__((ext_vector_type(4)));
typedef unsigned u32x4 __attribute__((ext_vector_type(4)));
typedef unsigned u32x2 __attribute__((ext_vector_type(2)));

constexpr int DM = 1024, NB = 8, SEQ = 2048, NTOK = NB * SEQ;
constexpr int ZC = 4992;
constexpr int ZQ_G = 0, ZK_G = 512, ZV_G = 1024, ZR_G = 2048, ZQ_N = 3072, ZKC = 4096, ZVC = 4224, ZKS = 4352, ZVS = 4480,
              ZKW = 4608, ZVW = 4736, ZGATE = 4864, ZLR = 4912;
constexpr int LDS_MAIN = 73728;
constexpr int LDS_BYTES = 2 * LDS_MAIN + 64;
constexpr int NTHREADS = 256;
constexpr int BLOCK_THREADS = 512;

constexpr size_t OFF_MOD = 16384;
constexpr size_t OFF_ROPE = 212992;
constexpr size_t OFF_CMP = 1261568;
constexpr size_t OFF_DEC = 1785856;
constexpr size_t OFF_K1B = 2310144;
constexpr size_t OFF_WC1 = 2834432;
constexpr size_t OFF_WIN = 4194304;
constexpr size_t OFF_WM = 14417920;
constexpr size_t OFF_WA = 18612224;
constexpr size_t OFF_WB = 20709376;
constexpr size_t OFF_WO = 22806528;
constexpr size_t OFF_WQ = 24903680;
constexpr size_t OFF_H = 29360128;
constexpr size_t OFF_M = 62914560;
constexpr size_t OFF_Z = 96468992;
constexpr size_t OFF_QP = OFF_Z;
constexpr size_t OFF_UB = OFF_Z + 67108864;
constexpr size_t OFF_VB = OFF_UB + 33554432;
constexpr size_t OFF_EIDX = OFF_VB + 33554432;
constexpr size_t OFF_GW = OFF_EIDX + 8388608;

struct Params {
    const float* x; const float* c; const int* pos; const float* ada_w; const float* ada_b;
    const float* norm1_g; const float* norm2_g; const float* final_g; const float* w_in;
    const float* gla_wa2; const float* gla_ba2; const float* gla_norm_g; const float* pe_k; const float* pe_v;
    const float* ck_w1; const float* ck_w2; const float* cv_w1; const float* cv_w2;
    const float* w_branch_a; const float* w_branch_b; const float* w_out; const float* peer_wq;
    const float* peer_k1; const float* peer_k2; const float* peer_u; const float* peer_v;
    float* out; char* ws;
};

__device__ __forceinline__ unsigned f2bf_u(float f) { unsigned u = __float_as_uint(f); return (u + 0x7fffu + ((u >> 16) & 1u)) >> 16; }
__device__ __forceinline__ bf16_t f2bf(float f) { return (bf16_t)f2bf_u(f); }
typedef float f32x2_ __attribute__((ext_vector_type(2)));
typedef __bf16 bf16x2_ __attribute__((ext_vector_type(2)));
__device__ __forceinline__ unsigned pack2(float lo, float hi) {
    const f32x2_ v = {lo, hi};
    return __builtin_bit_cast(unsigned, __builtin_convertvector(v, bf16x2_));
}
__device__ __forceinline__ float bf_lo(unsigned u) { return __uint_as_float(u << 16); }
__device__ __forceinline__ float bf_hi(unsigned u) { return __uint_as_float(u & 0xffff0000u); }
__device__ __forceinline__ float bf2f(bf16_t h) { return __uint_as_float(((unsigned)h) << 16); }
__device__ __forceinline__ float wave_sum(float v) {
#pragma unroll
    for (int o = 32; o > 0; o >>= 1) v += __shfl_xor(v, o, 64);
    return v;
}
__device__ __forceinline__ float wave_max(float v) {
#pragma unroll
    for (int o = 32; o > 0; o >>= 1) v = fmaxf(v, __shfl_xor(v, o, 64));
    return v;
}
__device__ __forceinline__ int launder_i(int x) { asm volatile("" : "+v"(x)); return x; }
#define TIDX (launder_i((int)threadIdx.x) & 255)
#define TIDX512 launder_i((int)threadIdx.x)
__device__ __forceinline__ int half_id() { return __builtin_amdgcn_readfirstlane((int)(threadIdx.x >> 8)); }
__device__ __forceinline__ int vblk() { return (int)blockIdx.x * 2 + half_id(); }
__device__ __forceinline__ int vgrid() { return (int)gridDim.x * 2; }
__device__ __forceinline__ float exp2f_(float x) { return __builtin_amdgcn_exp2f(x); }
__device__ __forceinline__ float sigmoidf_(float x) { return __builtin_amdgcn_rcpf(1.f + __expf(-x)); }
__device__ __forceinline__ float siluf_(float x) { return x * __builtin_amdgcn_rcpf(1.f + __expf(-x)); }
__device__ __forceinline__ float gelu_erf(float x) { return 0.5f * x * (1.f + erff(x * 0.70710678118654752f)); }
__device__ __forceinline__ f32x4 mfma16(bf16x8 a, bf16x8 b, f32x4 c) { return __builtin_amdgcn_mfma_f32_16x16x32_bf16(a, b, c, 0, 0, 0); }
__device__ __forceinline__ bf16x8 ld_frag(const bf16_t* p) { return *(const bf16x8*)p; }
__device__ __forceinline__ bf16x8 mk_frag(u32x2 lo, u32x2 hi) { u32x4 t = {lo.x, lo.y, hi.x, hi.y}; return __builtin_bit_cast(bf16x8, t); }

#define WAIT_V(n) asm volatile("s_waitcnt vmcnt(" #n ")" ::: "memory")
__device__ __forceinline__ int swz4(int R) { return (4 - ((R >> 2) & 3)) & 3; }
__device__ __forceinline__ void glds16(const bf16_t* g, char* l) { __builtin_amdgcn_global_load_lds((const unsigned*)g, (unsigned*)l, 16, 0, 0); }
struct GemmSrc { const bf16_t* xsrc; const bf16_t* wsrc; int ldx, ldw; };
__device__ __forceinline__ GemmSrc gemm_src(const bf16_t* __restrict__ X, int ldx, const bf16_t* __restrict__ W, int ldw, int m0, int n0) {
    const int tid = TIDX512, lane = tid & 63, wave = tid >> 6;
    const int R0 = wave * 32 + (lane >> 2);
    const int sw = ((lane & 3) ^ swz4(R0)) * 8;
    GemmSrc g;
    g.xsrc = X + (size_t)(m0 + R0) * ldx + sw;
    g.wsrc = W + (size_t)(n0 + R0) * ldw + sw;
    g.ldx = ldx; g.ldw = ldw;
    return g;
}
__device__ __forceinline__ void gemm_issue(const GemmSrc& g, int kt, int s, char* lds) {
    const int tid = TIDX512, lane = tid & 63, wave = tid >> 6;
    char* xdst = lds + s * 32768 + wave * 2048 + lane * 16;
    char* wdst = xdst + 16384;
#pragma unroll
    for (int i = 0; i < 2; i++) {
        glds16(g.xsrc + (size_t)i * 16 * g.ldx + kt * 32, xdst + i * 1024);
        glds16(g.wsrc + (size_t)i * 16 * g.ldw + kt * 32, wdst + i * 1024);
    }
}
__device__ __forceinline__ void gemm_prologue(const GemmSrc& g, char* lds) { gemm_issue(g, 0, 0, lds); gemm_issue(g, 1, 1, lds); gemm_issue(g, 2, 2, lds); }
__device__ __forceinline__ void gemm_mainloop(f32x4 (&acc)[8][4], const GemmSrc& g, int K, char* lds) {
    const int tid = TIDX512, lane = tid & 63, wave = tid >> 6;
    const int wr = wave >> 2, wc = wave & 3, r = lane & 15, q = lane >> 4;
    const int KT = K / 32;
    const int rdo = r * 64 + ((q ^ swz4(r)) * 16);
    for (int kt = 0; kt < KT; kt++) {
        if (kt + 2 < KT) WAIT_V(8); else if (kt + 1 < KT) WAIT_V(4); else WAIT_V(0);
        __builtin_amdgcn_s_barrier();
        if (kt + 3 < KT) gemm_issue(g, kt + 3, (kt + 3) & 3, lds);
        const char* st = lds + (kt & 3) * 32768;
        bf16x8 af[4], bfr[8];
#pragma unroll
        for (int ni = 0; ni < 4; ni++) af[ni] = *(const bf16x8*)(st + 16384 + (wc * 64 + ni * 16) * 64 + rdo);
#pragma unroll
        for (int mi = 0; mi < 8; mi++) bfr[mi] = *(const bf16x8*)(st + (wr * 128 + mi * 16) * 64 + rdo);
#pragma unroll
        for (int mi = 0; mi < 8; mi++)
#pragma unroll
            for (int ni = 0; ni < 4; ni++) acc[mi][ni] = mfma16(af[ni], bfr[mi], acc[mi][ni]);
        __builtin_amdgcn_sched_barrier(0);
    }
}
__device__ __forceinline__ void gemm_core(f32x4 (&acc)[8][4], const bf16_t* __restrict__ X, int ldx, const bf16_t* __restrict__ W, int ldw,
                                          int K, int m0, int n0, char* lds) {
    const GemmSrc g = gemm_src(X, ldx, W, ldw, m0, n0);
    gemm_prologue(g, lds);
    gemm_mainloop(acc, g, K, lds);
    __syncthreads();
}
__device__ __forceinline__ void zero_acc(f32x4 (&acc)[8][4]) {
#pragma unroll
    for (int a = 0; a < 8; a++)
#pragma unroll
        for (int b = 0; b < 4; b++) acc[a][b] = (f32x4){0.f, 0.f, 0.f, 0.f};
}

constexpr int EPI_ROWB = 528;
__device__ __forceinline__ void epi_fill(char* lds, int wr, int wc, int r, int q, int mi, int ni, f32x4 v) {
    *(u32x2*)(lds + (wr * 128 + mi * 16 + r) * EPI_ROWB + (wc * 64 + ni * 16 + 4 * q) * 2) = (u32x2){pack2(v[0], v[1]), pack2(v[2], v[3])};
}
__device__ __forceinline__ void epi_store(const char* lds, bf16_t* __restrict__ O, int ldo, int m0, int n0, int ncols_valid) {
    const int t = TIDX512;
    const int chunk = t & 31, rsub = t >> 5;
    if (n0 + chunk * 8 < ncols_valid) {
#pragma unroll
        for (int ps = 0; ps < 16; ps++) {
            const int row = ps * 16 + rsub;
            const u32x4 v = *(const u32x4*)(lds + row * EPI_ROWB + chunk * 16);
            *(u32x4*)(O + (size_t)(m0 + row) * ldo + n0 + chunk * 8) = v;
        }
    }
}

struct TileIter {
    int nt, i, x, li; bool fancy;
    __device__ TileIter(int ntiles_n, const char*) { nt = ntiles_n; fancy = (gridDim.x == 256) && ((nt & 3) == 0); x = blockIdx.x & 7; li = blockIdx.x >> 3; i = fancy ? 0 : blockIdx.x; }
    __device__ bool next(int& bm, int& bn) {
        if (fancy) {
            if (i * 4 >= nt) return false;
            bm = x * 8 + (li & 7); bn = i * 4 + (li >> 3); i++; return true;
        }
        if (i >= 64 * nt) return false;
        bn = i % nt; bm = i / nt; i += gridDim.x; return true;
    }
};

struct MapId { __device__ int operator()(int n) const { return n; } };
struct MapWin {
    __device__ int operator()(int n) const { return n < 3072 ? n : (n < 4912 ? n + 16 : (n < 4928 ? n - 1840 : -1)); }
};
struct MapOff { int off; __device__ int operator()(int n) const { return n + off; } };

template <class Map>
__device__ __forceinline__ void tconv_tile(const float* __restrict__ src, int ldsrc, bf16_t* __restrict__ dst, int ldd, int n0, int k0, Map map, float* t) {
    const int tid = TIDX;
    const int n = tid & 63, kb = tid >> 6;
    const int sc = map(n0 + n);
#pragma unroll
    for (int i = 0; i < 16; i++) { const int k = i * 4 + kb; t[k * 65 + n] = sc >= 0 ? src[(size_t)(k0 + k) * ldsrc + sc] : 0.f; }
    __syncthreads();
    const int nn = tid >> 2, kk = (tid & 3) * 16;
    unsigned w[8];
#pragma unroll
    for (int j = 0; j < 8; j++) w[j] = pack2(t[(kk + 2 * j) * 65 + nn], t[(kk + 2 * j + 1) * 65 + nn]);
    u32x4* d = (u32x4*)(dst + (size_t)(n0 + nn) * ldd + k0 + kk);
    d[0] = (u32x4){w[0], w[1], w[2], w[3]};
    d[1] = (u32x4){w[4], w[5], w[6], w[7]};
    __syncthreads();
}

constexpr int TA_MOD = 192, TA_WIN = 78 * 16, TA_WM = 32 * 16, TA_SQ = 16 * 16, TA_WQ = 32 * 16, TA_WC = 32, TA_K12 = 64, TA_ROPE = 512;
constexpr int TA_E0 = TA_MOD, TA_E1 = TA_E0 + TA_WIN, TA_E2 = TA_E1 + TA_WM, TA_E3 = TA_E2 + TA_SQ, TA_E4 = TA_E3 + TA_SQ, TA_E5 = TA_E4 + TA_SQ,
              TA_E6 = TA_E5 + TA_WQ, TA_E7 = TA_E6 + TA_WC, TA_E8 = TA_E7 + TA_WC, TA_E9 = TA_E8 + TA_K12, TA_E10 = TA_E9 + TA_K12, TA_E11 = TA_E10 + TA_ROPE;

__device__ void phaseA(const Params& p, char* lds) {
    const int tid = TIDX;
    float* fl = (float*)lds;
    constexpr int N0 = TA_E1 + (TA_E8 - TA_E6) + (TA_E11 - TA_E10);
    for (int idx = vblk(); idx < N0; idx += vgrid()) {
        const int task = idx < TA_E1 ? idx : (idx < TA_E1 + (TA_E8 - TA_E6) ? idx - TA_E1 + TA_E6 : idx - TA_E1 - (TA_E8 - TA_E6) + TA_E10);
        if (task < TA_E0) {
            float* sc = fl;
            float* red = fl + 8192;
            for (int i = tid; i < 8192; i += NTHREADS) sc[i] = siluf_(p.c[i]);
            __syncthreads();
            const int n = task * 32 + (tid & 31), kg = tid >> 5;
            float a[8];
#pragma unroll
            for (int b = 0; b < 8; b++) a[b] = 0.f;
            for (int k0 = kg * 128; k0 < kg * 128 + 128; k0 += 16) {
                float w[16];
#pragma unroll
                for (int i = 0; i < 16; i++) w[i] = p.ada_w[(size_t)(k0 + i) * 6144 + n];
#pragma unroll
                for (int i = 0; i < 16; i++)
#pragma unroll
                    for (int b = 0; b < 8; b++) a[b] += sc[b * 1024 + k0 + i] * w[i];
            }
#pragma unroll
            for (int b = 0; b < 8; b++) red[(kg * 8 + b) * 32 + (tid & 31)] = a[b];
            __syncthreads();
            {
                const int b = tid >> 5, nn = tid & 31;
                float s = 0.f;
#pragma unroll
                for (int g = 0; g < 8; g++) s += red[(g * 8 + b) * 32 + nn];
                ((float*)(p.ws + OFF_MOD))[b * 6144 + task * 32 + nn] = s + p.ada_b[task * 32 + nn];
            }
            __syncthreads();
        } else if (task < TA_E1) {
            const int tt = task - TA_E0;
            tconv_tile(p.w_in, 6976, (bf16_t*)(p.ws + OFF_WIN), 1024, (tt >> 4) * 64, (tt & 15) * 64, MapWin(), fl);
        } else if (task < TA_E6) {
        } else if (task < TA_E7) {
            const int tt = task - TA_E6;
            tconv_tile(p.ck_w1, 64, (bf16_t*)(p.ws + OFF_WC1), 2048, 0, tt * 64, MapId(), fl);
        } else if (task < TA_E8) {
            const int tt = task - TA_E7;
            tconv_tile(p.cv_w1, 64, (bf16_t*)(p.ws + OFF_WC1) + 64 * 2048, 2048, 0, tt * 64, MapId(), fl);
        } else if (task < TA_E10) {
        } else {
            const int tt = task - TA_E10;
            const int e = tt * 256 + tid;
            const int tok = e >> 3, i = e & 7;
            const float invf[8] = {1.0f, 0.1939227432012558f, 0.03760603070259094f, 0.007292664609849453f,
                                   0.0014142135623842478f, 0.00027424818836152554f, 5.318296098266728e-05f, 1.0313386155758053e-05f};
            float fr = invf[0];
#pragma unroll
            for (int j = 1; j < 8; j++) fr = (i == j) ? invf[j] : fr;
            const float ang = (float)p.pos[tok] * fr;
            const double rev = (double)ang * 0.15915494309189533577;
            const float fpart = (float)(rev - floor(rev));
            float* cs = (float*)(p.ws + OFF_ROPE);
            cs[e * 2] = __builtin_amdgcn_cosf(fpart);
            cs[e * 2 + 1] = __builtin_amdgcn_sinf(fpart);
        }
    }
}

__device__ void phaseA2(const Params& p, char* lds) {
    const int tid = TIDX;
    float* fl = (float*)lds;
    constexpr int N1 = (TA_E6 - TA_E1) + (TA_E10 - TA_E8);
    for (int idx = vblk(); idx < N1; idx += vgrid()) {
        const int task = idx < (TA_E6 - TA_E1) ? idx + TA_E1 : idx - (TA_E6 - TA_E1) + TA_E8;
        if (task < TA_E1) {
        } else if (task < TA_E2) {
            const int tt = task - TA_E1;
            tconv_tile(p.w_in, 6976, (bf16_t*)(p.ws + OFF_WM), 1024, (tt >> 4) * 64, (tt & 15) * 64, MapOff{4928}, fl);
        } else if (task < TA_E3) {
            const int tt = task - TA_E2;
            tconv_tile(p.w_branch_a, 1024, (bf16_t*)(p.ws + OFF_WA), 1024, (tt >> 4) * 64, (tt & 15) * 64, MapId(), fl);
        } else if (task < TA_E4) {
            const int tt = task - TA_E3;
            tconv_tile(p.w_branch_b, 1024, (bf16_t*)(p.ws + OFF_WB), 1024, (tt >> 4) * 64, (tt & 15) * 64, MapId(), fl);
        } else if (task < TA_E5) {
            const int tt = task - TA_E4;
            tconv_tile(p.w_out, 1024, (bf16_t*)(p.ws + OFF_WO), 1024, (tt >> 4) * 64, (tt & 15) * 64, MapId(), fl);
        } else if (task < TA_E6) {
            const int tt = task - TA_E5;
            tconv_tile(p.peer_wq, 2048, (bf16_t*)(p.ws + OFF_WQ), 1024, (tt >> 4) * 64, (tt & 15) * 64, MapId(), fl);
        } else if (task < TA_E10) {
            const bool second = task >= TA_E9;
            const int tt = task - (second ? TA_E9 : TA_E8);
            const float* src = second ? p.peer_k2 : p.peer_k1;
            bf16_t* dst = (bf16_t*)(p.ws + OFF_K1B) + (second ? 131072 : 0);
            const int i = tt * 2048 + tid * 8;
            const f32x4 a = *(const f32x4*)(src + i), b = *(const f32x4*)(src + i + 4);
            *(u32x4*)(dst + i) = (u32x4){pack2(a[0], a[1]), pack2(a[2], a[3]), pack2(b[0], b[1]), pack2(b[2], b[3])};
        }
    }
}

__device__ void phase_modnorm(const Params& p, const float* __restrict__ src, const float* __restrict__ g, int shift_idx, int scale_idx, bf16_t* __restrict__ dst) {
    const int tid_ = TIDX; const int lane = tid_ & 63, wave = tid_ >> 6;
    const float* mod = (const float*)(p.ws + OFF_MOD);
    for (int tok = vblk() * 4 + wave; tok < NTOK; tok += vgrid() * 4) {
        const int b = tok >> 11;
        const float* xr = src + (size_t)tok * DM;
        f32x4 v[4];
        float ss = 0.f;
#pragma unroll
        for (int c = 0; c < 4; c++) { v[c] = *(const f32x4*)(xr + c * 256 + lane * 4); ss += v[c][0] * v[c][0] + v[c][1] * v[c][1] + v[c][2] * v[c][2] + v[c][3] * v[c][3]; }
        ss = wave_sum(ss);
        const float rstd = rsqrtf(ss * (1.f / 1024.f) + 1e-6f);
#pragma unroll
        for (int c = 0; c < 4; c++) {
            const int d = c * 256 + lane * 4;
            const f32x4 gg = *(const f32x4*)(g + d);
            const f32x4 sc = *(const f32x4*)(mod + b * 6144 + scale_idx * 1024 + d);
            const f32x4 sh = *(const f32x4*)(mod + b * 6144 + shift_idx * 1024 + d);
            float o[4];
#pragma unroll
            for (int j = 0; j < 4; j++) o[j] = (v[c][j] * rstd) * gg[j] * (1.f + sc[j]) + sh[j];
            *(u32x2*)(dst + (size_t)tok * DM + d) = (u32x2){pack2(o[0], o[1]), pack2(o[2], o[3])};
        }
    }
}

__device__ void phaseC(const Params& p, char* lds) {
    const int tid_ = TIDX512; const int lane = tid_ & 63, wave = tid_ >> 6;
    const int wr = wave >> 2, wc = wave & 3, r = lane & 15, q = lane >> 4;
    const bf16_t* H = (const bf16_t*)(p.ws + OFF_H);
    const bf16_t* W = (const bf16_t*)(p.ws + OFF_WIN);
    bf16_t* Z = (bf16_t*)(p.ws + OFF_Z);
    const float* cs = (const float*)(p.ws + OFF_ROPE);
    constexpr int NTN = (ZC + 255) / 256;
    TileIter tit(NTN, lds);
    int bm, bn;
    while (tit.next(bm, bn)) {
        const int m0 = bm * 256, n0 = bn * 256;
        f32x4 acc[8][4];
        zero_acc(acc);
        gemm_core(acc, H, DM, W, DM, DM, m0, n0, lds);
        const int c0 = n0 + wc * 64;
        const bool isq = (c0 >= ZQ_N && c0 < ZKC);
        const bool rope = isq || (c0 >= ZKC && c0 < ZGATE && ((c0 - ZKC) & 255) < 128);
        const float scl = isq ? 0.18033688011112042f : 1.f;
#pragma unroll
        for (int mi = 0; mi < 8; mi++) {
            const int tok = m0 + wr * 128 + mi * 16 + r;
            if (rope) {
                f32x4 v = acc[mi][0];
                f32x4 pr;
#pragma unroll
                for (int j = 0; j < 4; j++) pr[j] = __shfl_xor(v[j], 32, 64);
                const int ib = (q & 1) * 4;
                const f32x4 k0 = *(const f32x4*)(cs + (size_t)tok * 16 + ib * 2);
                const f32x4 k1 = *(const f32x4*)(cs + (size_t)tok * 16 + ib * 2 + 4);
                const float cc[4] = {k0[0], k0[2], k1[0], k1[2]}, sn[4] = {k0[1], k0[3], k1[1], k1[3]};
#pragma unroll
                for (int j = 0; j < 4; j++) v[j] = (q < 2) ? (v[j] * cc[j] - pr[j] * sn[j]) : (v[j] * cc[j] + pr[j] * sn[j]);
                acc[mi][0] = v;
            }
#pragma unroll
            for (int ni = 0; ni < 4; ni++) epi_fill(lds, wr, wc, r, q, mi, ni, acc[mi][ni] * scl);
        }
        __syncthreads();
        epi_store(lds, Z, ZC, m0, n0, ZC);
        __syncthreads();
    }
}

__device__ __forceinline__ void gla_prep(const Params& p, int tok0, int h, char* lds) {
    const int tid = TIDX;
    float* bc = (float*)lds;
    float* lrs = (float*)(lds + 32768);
    const bf16_t* Z = (const bf16_t*)(p.ws + OFF_Z);
    for (int i = tid; i < 1024; i += NTHREADS) { const int t = i >> 4, rr = i & 15; lrs[i] = bf2f(Z[(size_t)(tok0 + t) * ZC + ZLR + rr]); }
    const int d = tid & 127, th = tid >> 7;
    float w[16];
#pragma unroll
    for (int rr = 0; rr < 16; rr++) w[rr] = p.gla_wa2[rr * 512 + h * 128 + d];
    const float bias = p.gla_ba2[h * 128 + d];
    __syncthreads();
    float run = 0.f;
    for (int t = th * 32; t < th * 32 + 32; t++) {
        float xv = bias;
#pragma unroll
        for (int rr = 0; rr < 16; rr++) xv += lrs[t * 16 + rr] * w[rr];
        const float ls = fminf(xv, 0.f) - log1pf(__expf(-fabsf(xv)));
        run += ls * (1.f / 16.f);
        bc[t * 128 + d] = run;
    }
    __syncthreads();
    if (th == 1) {
        const float add = bc[31 * 128 + d];
        for (int t = 32; t < 64; t++) bc[t * 128 + d] += add;
    }
    __syncthreads();
}

__device__ void phaseG1_task(const Params& p, int task, char* lds) {
    const int tid = TIDX, lane = tid & 63, wave = tid >> 6, r = lane & 15, q = lane >> 4;
    const int c = task & 31, h = (task >> 5) & 3, b = task >> 7;
    const int tok0 = b * SEQ + c * 64;
    const bf16_t* Z = (const bf16_t*)(p.ws + OFF_Z);
    bf16_t* L = (bf16_t*)p.out;
    float* bc = (float*)lds;
    bf16_t* klT = (bf16_t*)(lds + 36864);
    bf16_t* vT = (bf16_t*)(lds + 36864 + 18432);
    gla_prep(p, tok0, h, lds);
    if (tid < 128) ((float*)(p.ws + OFF_DEC))[task * 128 + tid] = __expf(bc[63 * 128 + tid]);
    {
        const int s = lane, dc = wave * 32;
        const bf16_t* kp = Z + (size_t)(tok0 + s) * ZC + ZK_G + h * 128 + dc;
#pragma unroll
        for (int v4 = 0; v4 < 4; v4++) {
            const u32x4 kv = *(const u32x4*)(kp + v4 * 8);
            const unsigned kw[4] = {kv.x, kv.y, kv.z, kv.w};
#pragma unroll
            for (int j = 0; j < 8; j++) {
                const int d = dc + v4 * 8 + j;
                const float kval = (j & 1) ? bf_hi(kw[j >> 1]) : bf_lo(kw[j >> 1]);
                klT[d * 72 + s] = f2bf(kval * __expf(bc[63 * 128 + d] - bc[s * 128 + d]));
            }
        }
    }
    for (int eh = 0; eh < 2; eh++) {
        __syncthreads();
        {
            const int s = lane, ec = wave * 32;
            const bf16_t* vp = Z + (size_t)(tok0 + s) * ZC + ZV_G + h * 256 + eh * 128 + ec;
#pragma unroll
            for (int v4 = 0; v4 < 4; v4++) {
                const u32x4 vv = *(const u32x4*)(vp + v4 * 8);
                const unsigned vw[4] = {vv.x, vv.y, vv.z, vv.w};
#pragma unroll
                for (int j = 0; j < 8; j++) vT[(ec + v4 * 8 + j) * 72 + s] = (bf16_t)((j & 1) ? (vw[j >> 1] >> 16) : (vw[j >> 1] & 0xffffu));
            }
        }
        __syncthreads();
        f32x4 acc[8][2];
#pragma unroll
        for (int dt = 0; dt < 8; dt++) { acc[dt][0] = (f32x4){0.f, 0.f, 0.f, 0.f}; acc[dt][1] = (f32x4){0.f, 0.f, 0.f, 0.f}; }
#pragma unroll
        for (int ks = 0; ks < 2; ks++) {
            bf16x8 bv[2];
#pragma unroll
            for (int x = 0; x < 2; x++) bv[x] = ld_frag(vT + ((2 * wave + x) * 16 + r) * 72 + ks * 32 + q * 8);
#pragma unroll
            for (int dt = 0; dt < 8; dt++) {
                const bf16x8 a = ld_frag(klT + (dt * 16 + r) * 72 + ks * 32 + q * 8);
#pragma unroll
                for (int x = 0; x < 2; x++) acc[dt][x] = mfma16(a, bv[x], acc[dt][x]);
            }
        }
#pragma unroll
        for (int dt = 0; dt < 8; dt++)
#pragma unroll
            for (int x = 0; x < 2; x++) {
                const int e = eh * 128 + (2 * wave + x) * 16 + r, d = dt * 16 + 4 * q;
                const f32x4 v = acc[dt][x];
                *(u32x2*)(L + ((size_t)task * 256 + e) * 128 + d) = (u32x2){pack2(v[0], v[1]), pack2(v[2], v[3])};
            }
    }
    __syncthreads();
}

__device__ void phaseG2(const Params& p) {
    bf16_t* L = (bf16_t*)p.out;
    const float* dec = (const float*)(p.ws + OFF_DEC);
    for (int idx = vblk() * NTHREADS + (int)(threadIdx.x & 255); idx < 32 * 256 * 16; idx += vgrid() * NTHREADS) {
        const int d8 = idx & 15, e = (idx >> 4) & 255, bh = idx >> 12;
        float st[8];
#pragma unroll
        for (int j = 0; j < 8; j++) st[j] = 0.f;
        for (int c = 0; c < 32; c++) {
            const int task = bh * 32 + c;
            u32x4* ptr = (u32x4*)(L + ((size_t)task * 256 + e) * 128 + d8 * 8);
            const u32x4 lv = *ptr;
            const f32x4 d0 = *(const f32x4*)(dec + task * 128 + d8 * 8), d1 = *(const f32x4*)(dec + task * 128 + d8 * 8 + 4);
            *ptr = (u32x4){pack2(st[0], st[1]), pack2(st[2], st[3]), pack2(st[4], st[5]), pack2(st[6], st[7])};
            st[0] = d0[0] * st[0] + bf_lo(lv.x); st[1] = d0[1] * st[1] + bf_hi(lv.x);
            st[2] = d0[2] * st[2] + bf_lo(lv.y); st[3] = d0[3] * st[3] + bf_hi(lv.y);
            st[4] = d1[0] * st[4] + bf_lo(lv.z); st[5] = d1[1] * st[5] + bf_hi(lv.z);
            st[6] = d1[2] * st[6] + bf_lo(lv.w); st[7] = d1[3] * st[7] + bf_hi(lv.w);
        }
    }
}

__device__ void phaseG3_task(const Params& p, int task, char* lds, bf16_t* ydst, int ystride) {
    const int tid = TIDX, lane = tid & 63, wave = tid >> 6, r = lane & 15, q = lane >> 4;
    const int c = task & 31, h = (task >> 5) & 3, b = task >> 7;
    const int tok0 = b * SEQ + c * 64;
    bf16_t* Z = (bf16_t*)(p.ws + OFF_Z);
    const bf16_t* ST = (const bf16_t*)p.out + (size_t)task * 256 * 128;
    float* bc = (float*)lds;
    bf16_t* vT = (bf16_t*)lds;
    bf16_t* qg = (bf16_t*)(lds + 36864);
    bf16_t* kg = (bf16_t*)(lds + 36864 + 17408);
    bf16_t* P = kg;
    float* red = (float*)(lds + 36864 + 2 * 17408);
    gla_prep(p, tok0, h, lds);
    {
        const int t = tid >> 2, dc = (tid & 3) * 32;
        const bf16_t* qp = Z + (size_t)(tok0 + t) * ZC + ZQ_G + h * 128 + dc;
        const bf16_t* kp = Z + (size_t)(tok0 + t) * ZC + ZK_G + h * 128 + dc;
#pragma unroll
        for (int v4 = 0; v4 < 4; v4++) {
            const u32x4 qv = *(const u32x4*)(qp + v4 * 8), kv = *(const u32x4*)(kp + v4 * 8);
            const unsigned qw[4] = {qv.x, qv.y, qv.z, qv.w}, kw[4] = {kv.x, kv.y, kv.z, kv.w};
            unsigned qo[4], ko[4];
#pragma unroll
            for (int j2 = 0; j2 < 4; j2++) {
                const int d = dc + v4 * 8 + j2 * 2;
                const float b0 = bc[t * 128 + d], b1 = bc[t * 128 + d + 1];
                qo[j2] = pack2(bf_lo(qw[j2]) * 0.08838834764831845f * __expf(b0), bf_hi(qw[j2]) * 0.08838834764831845f * __expf(b1));
                ko[j2] = pack2(bf_lo(kw[j2]) * __expf(-b0), bf_hi(kw[j2]) * __expf(-b1));
            }
            *(u32x4*)(qg + t * 136 + dc + v4 * 8) = (u32x4){qo[0], qo[1], qo[2], qo[3]};
            *(u32x4*)(kg + t * 136 + dc + v4 * 8) = (u32x4){ko[0], ko[1], ko[2], ko[3]};
        }
    }
    __syncthreads();
    {
        const int s = lane, ec = wave * 64;
        const bf16_t* vp = Z + (size_t)(tok0 + s) * ZC + ZV_G + h * 256 + ec;
#pragma unroll
        for (int v4 = 0; v4 < 8; v4++) {
            const u32x4 vv = *(const u32x4*)(vp + v4 * 8);
            const unsigned vw[4] = {vv.x, vv.y, vv.z, vv.w};
#pragma unroll
            for (int j = 0; j < 8; j++) vT[(ec + v4 * 8 + j) * 72 + s] = (bf16_t)((j & 1) ? (vw[j >> 1] >> 16) : (vw[j >> 1] & 0xffffu));
        }
    }
    f32x4 sc[4];
#pragma unroll
    for (int st = 0; st < 4; st++) sc[st] = (f32x4){0.f, 0.f, 0.f, 0.f};
    {
        bf16x8 qf[4];
#pragma unroll
        for (int ks = 0; ks < 4; ks++) qf[ks] = ld_frag(qg + (wave * 16 + r) * 136 + ks * 32 + q * 8);
#pragma unroll
        for (int st = 0; st < 4; st++) {
            if (st <= wave) {
#pragma unroll
                for (int ks = 0; ks < 4; ks++) sc[st] = mfma16(ld_frag(kg + (st * 16 + r) * 136 + ks * 32 + q * 8), qf[ks], sc[st]);
            }
        }
    }
    __syncthreads();
    {
        const int t = wave * 16 + r;
#pragma unroll
        for (int st = 0; st < 4; st++) {
            float pv[4];
#pragma unroll
            for (int j = 0; j < 4; j++) { const int s = st * 16 + 4 * q + j; pv[j] = (s <= t) ? sc[st][j] : 0.f; }
            *(u32x2*)(P + t * 72 + st * 16 + 4 * q) = (u32x2){pack2(pv[0], pv[1]), pack2(pv[2], pv[3])};
        }
    }
    __syncthreads();
    f32x4 o[4][4];
#pragma unroll
    for (int et = 0; et < 4; et++)
#pragma unroll
        for (int tt = 0; tt < 4; tt++) o[et][tt] = (f32x4){0.f, 0.f, 0.f, 0.f};
#pragma unroll
    for (int ks = 0; ks < 2; ks++) {
        bf16x8 pf[4];
#pragma unroll
        for (int tt = 0; tt < 4; tt++) pf[tt] = ld_frag(P + (tt * 16 + r) * 72 + ks * 32 + q * 8);
#pragma unroll
        for (int et = 0; et < 4; et++) {
            const bf16x8 a = ld_frag(vT + ((wave * 4 + et) * 16 + r) * 72 + ks * 32 + q * 8);
#pragma unroll
            for (int tt = 0; tt < 4; tt++) o[et][tt] = mfma16(a, pf[tt], o[et][tt]);
        }
    }
#pragma unroll
    for (int ks = 0; ks < 4; ks++) {
        bf16x8 qf[4];
#pragma unroll
        for (int tt = 0; tt < 4; tt++) qf[tt] = ld_frag(qg + (tt * 16 + r) * 136 + ks * 32 + q * 8);
#pragma unroll
        for (int et = 0; et < 4; et++) {
            const bf16x8 a = *(const bf16x8*)(ST + (size_t)((wave * 4 + et) * 16 + r) * 128 + ks * 32 + q * 8);
#pragma unroll
            for (int tt = 0; tt < 4; tt++) o[et][tt] = mfma16(a, qf[tt], o[et][tt]);
        }
    }
#pragma unroll
    for (int tt = 0; tt < 4; tt++) {
        float ss = 0.f;
#pragma unroll
        for (int et = 0; et < 4; et++)
#pragma unroll
            for (int j = 0; j < 4; j++) ss += o[et][tt][j] * o[et][tt][j];
        ss += __shfl_xor(ss, 16, 64);
        ss += __shfl_xor(ss, 32, 64);
        if (q == 0) red[wave * 64 + tt * 16 + r] = ss;
    }
    __syncthreads();
#pragma unroll
    for (int tt = 0; tt < 4; tt++) {
        const int t = tt * 16 + r;
        const float tot = red[t] + red[64 + t] + red[128 + t] + red[192 + t];
        const float rstd = rsqrtf(tot * (1.f / 256.f) + 1e-6f);
#pragma unroll
        for (int et = 0; et < 4; et++) {
            const int e = (wave * 4 + et) * 16 + 4 * q;
            bf16_t* rp = Z + (size_t)(tok0 + t) * ZC + ZR_G + h * 256 + e;
            const u32x2 rv = *(const u32x2*)rp;
            const f32x4 gn = *(const f32x4*)(p.gla_norm_g + e);
            const float r0 = bf_lo(rv.x), r1 = bf_hi(rv.x), r2 = bf_lo(rv.y), r3 = bf_hi(rv.y);
            const f32x4 ov = o[et][tt];
            *(u32x2*)(ydst + (size_t)(tok0 + t) * ystride + h * 256 + e) = (u32x2){pack2(ov[0] * rstd * gn[0] * siluf_(r0), ov[1] * rstd * gn[1] * siluf_(r1)),
                                  pack2(ov[2] * rstd * gn[2] * siluf_(r2), ov[3] * rstd * gn[3] * siluf_(r3))};
        }
    }
    __syncthreads();
}

__device__ void phaseN1_task(const Params& p, int task, char* lds) {
    const int tid = TIDX, lane = tid & 63, wave = tid >> 6, r = lane & 15, q = lane >> 4;
    const int it = task & 7, g = (task >> 3) & 1, b = (task >> 4) & 7, kv = task >> 7;
    const bf16_t* Z = (const bf16_t*)(p.ws + OFF_Z);
    const bf16_t* W1 = (const bf16_t*)(p.ws + OFF_WC1) + (size_t)kv * 64 * 2048;
    const float* pe = kv ? p.pe_v : p.pe_k;
    const float* w2 = kv ? p.cv_w2 : p.ck_w2;
    const int zoff = (kv ? ZVC : ZKC) + g * 64;
    float* hid = (float*)lds;
    float* hid2 = (float*)(lds + 16384);
    int i = it * 16 + r; if (i > 126) i = 126;
    f32x4 acc[4];
#pragma unroll
    for (int nt = 0; nt < 4; nt++) acc[nt] = (f32x4){0.f, 0.f, 0.f, 0.f};
    for (int ks = 0; ks < 16; ks++) {
        const int k = wave * 512 + ks * 32 + q * 8;
        const int l = k >> 6, d = k & 63;
        const u32x4 zv = *(const u32x4*)(Z + (size_t)(b * SEQ + i * 16 + l) * ZC + zoff + d);
        const f32x4 p0 = *(const f32x4*)(pe + l * 64 + d), p1 = *(const f32x4*)(pe + l * 64 + d + 4);
        const u32x4 av = {pack2(bf_lo(zv.x) + p0[0], bf_hi(zv.x) + p0[1]), pack2(bf_lo(zv.y) + p0[2], bf_hi(zv.y) + p0[3]),
                          pack2(bf_lo(zv.z) + p1[0], bf_hi(zv.z) + p1[1]), pack2(bf_lo(zv.w) + p1[2], bf_hi(zv.w) + p1[3])};
        const bf16x8 a = __builtin_bit_cast(bf16x8, av);
#pragma unroll
        for (int nt = 0; nt < 4; nt++) {
            const bf16x8 bw = *(const bf16x8*)(W1 + (size_t)(nt * 16 + r) * 2048 + k);
            acc[nt] = mfma16(a, bw, acc[nt]);
        }
    }
#pragma unroll
    for (int nt = 0; nt < 4; nt++)
#pragma unroll
        for (int j = 0; j < 4; j++) hid[(wave * 16 + 4 * q + j) * 64 + nt * 16 + r] = acc[nt][j];
    __syncthreads();
    for (int e = tid; e < 1024; e += NTHREADS) hid2[e] = gelu_erf(hid[e] + hid[1024 + e] + hid[2048 + e] + hid[3072 + e]);
    __syncthreads();
    {
        const int il = tid >> 4, n2 = (tid & 15) * 4;
        f32x4 o = {0.f, 0.f, 0.f, 0.f};
        for (int n = 0; n < 64; n++) {
            const float hv = hid2[il * 64 + n];
            const f32x4 wv = *(const f32x4*)(w2 + n * 64 + n2);
            o += hv * wv;
        }
        const int ig = it * 16 + il;
        if (ig >= 127) o = (f32x4){0.f, 0.f, 0.f, 0.f};
        bf16_t* dst = (bf16_t*)(p.ws + OFF_CMP) + ((size_t)((kv * 8 + b) * 2 + g) * 128 + ig) * 64 + n2;
        *(u32x2*)dst = (u32x2){pack2(o[0], o[1]), pack2(o[2], o[3])};
    }
    __syncthreads();
}

__device__ __forceinline__ void nsa_block_step(const bf16_t* Ks, const bf16_t* VT, const bf16x8 (&qf)[2][2], f32x4 (&O)[2][4], float (&m)[2], float (&l)[2],
                                               int klo, int khi, int r, int q) {
    f32x4 s[2][4];
#pragma unroll
    for (int x = 0; x < 2; x++)
#pragma unroll
        for (int kt = 0; kt < 4; kt++) s[x][kt] = (f32x4){0.f, 0.f, 0.f, 0.f};
#pragma unroll
    for (int kt = 0; kt < 4; kt++)
#pragma unroll
        for (int ks = 0; ks < 2; ks++) {
            const bf16x8 kf = ld_frag(Ks + (kt * 16 + r) * 64 + (((ks * 4 + q) ^ (r & 7)) * 8));
#pragma unroll
            for (int x = 0; x < 2; x++) s[x][kt] = mfma16(kf, qf[x][ks], s[x][kt]);
        }
    if (!__all((klo <= 0) && (khi >= 63))) {
        const int a = 4 * q - klo;
        const unsigned range = (unsigned)(khi - klo);
        const bool any = khi >= klo;
#pragma unroll
        for (int kt = 0; kt < 4; kt++)
#pragma unroll
            for (int j = 0; j < 4; j++) {
                const bool valid = any && ((unsigned)(kt * 16 + j + a) <= range);
#pragma unroll
                for (int x = 0; x < 2; x++) s[x][kt][j] = valid ? s[x][kt][j] : -3.0e38f;
            }
    }
    bf16x8 pbv[2][2];
#pragma unroll
    for (int x = 0; x < 2; x++) {
        float mx = fmaxf(fmaxf(fmaxf(s[x][0][0], s[x][0][1]), fmaxf(s[x][0][2], s[x][0][3])), fmaxf(fmaxf(s[x][1][0], s[x][1][1]), fmaxf(s[x][1][2], s[x][1][3])));
        mx = fmaxf(mx, fmaxf(fmaxf(fmaxf(s[x][2][0], s[x][2][1]), fmaxf(s[x][2][2], s[x][2][3])), fmaxf(fmaxf(s[x][3][0], s[x][3][1]), fmaxf(s[x][3][2], s[x][3][3]))));
        mx = fmaxf(mx, __shfl_xor(mx, 16, 64));
        mx = fmaxf(mx, __shfl_xor(mx, 32, 64));
        const float mnew = fmaxf(m[x], mx);
        const float alpha = exp2f_(m[x] - mnew);
        m[x] = mnew;
        float ls = 0.f;
#pragma unroll
        for (int kt = 0; kt < 4; kt++)
#pragma unroll
            for (int j = 0; j < 4; j++) { const float pv = exp2f_(s[x][kt][j] - mnew); s[x][kt][j] = pv; ls += pv; }
        l[x] = l[x] * alpha + ls;
#pragma unroll
        for (int dt = 0; dt < 4; dt++) O[x][dt] *= alpha;
#pragma unroll
        for (int s2 = 0; s2 < 2; s2++) {
            const u32x4 t4 = {pack2(s[x][2 * s2][0], s[x][2 * s2][1]), pack2(s[x][2 * s2][2], s[x][2 * s2][3]),
                              pack2(s[x][2 * s2 + 1][0], s[x][2 * s2 + 1][1]), pack2(s[x][2 * s2 + 1][2], s[x][2 * s2 + 1][3])};
            pbv[x][s2] = __builtin_bit_cast(bf16x8, t4);
        }
    }
#pragma unroll
    for (int s2 = 0; s2 < 2; s2++)
#pragma unroll
        for (int dt = 0; dt < 4; dt++) {
            const u32x2 lo = *(const u32x2*)(VT + (dt * 16 + r) * 72 + (2 * s2) * 16 + 4 * q);
            const u32x2 hi = *(const u32x2*)(VT + (dt * 16 + r) * 72 + (2 * s2 + 1) * 16 + 4 * q);
            const bf16x8 va = mk_frag(lo, hi);
#pragma unroll
            for (int x = 0; x < 2; x++) O[x][dt] = mfma16(va, pbv[x][s2], O[x][dt]);
        }
}

__device__ __forceinline__ void nsa_cmp_probs(const bf16_t* Kc, const bf16x8 (&qfx)[2], int nv, int r, int q, f32x4 (&s)[8]) {
#pragma unroll
    for (int kt = 0; kt < 8; kt++) s[kt] = (f32x4){0.f, 0.f, 0.f, 0.f};
#pragma unroll
    for (int kt = 0; kt < 8; kt++)
#pragma unroll
        for (int ks = 0; ks < 2; ks++) s[kt] = mfma16(ld_frag(Kc + (kt * 16 + r) * 72 + ks * 32 + q * 8), qfx[ks], s[kt]);
    float mx = -1e30f;
#pragma unroll
    for (int kt = 0; kt < 8; kt++)
#pragma unroll
        for (int j = 0; j < 4; j++) if (kt * 16 + 4 * q + j < nv) mx = fmaxf(mx, s[kt][j]);
    mx = fmaxf(mx, __shfl_xor(mx, 16, 64));
    mx = fmaxf(mx, __shfl_xor(mx, 32, 64));
    float ls = 0.f;
#pragma unroll
    for (int kt = 0; kt < 8; kt++)
#pragma unroll
        for (int j = 0; j < 4; j++) {
            const float pv = (kt * 16 + 4 * q + j < nv) ? exp2f_(s[kt][j] - mx) : 0.f;
            s[kt][j] = pv; ls += pv;
        }
    ls += __shfl_xor(ls, 16, 64);
    ls += __shfl_xor(ls, 32, 64);
    const float inv = nv > 0 ? 1.f / ls : 0.f;
#pragma unroll
    for (int kt = 0; kt < 8; kt++) s[kt] *= inv;
}

__device__ void phaseN2_task(const Params& p, int task, char* lds, bf16_t* ydst, int ystride, volatile unsigned* uex, char* ldsb) {
    const int tid = TIDX, lane = tid & 63, wave = tid >> 6, r = lane & 15, q = lane >> 4;
    const int t512 = tid + half_id() * 256;
    const int pair = task >> 1, g = pair & 1, b = (pair >> 1) & 7;
    const int tt = (63 - (pair >> 4)) * 2 + (task & 1);
    const int t0 = tt * 16, t = t0 + r;
    const int cur = t0 >> 6;
    bf16_t* Z = (bf16_t*)(p.ws + OFF_Z);
    const size_t rowb = (size_t)b * SEQ;
    bf16_t* Kc = (bf16_t*)ldsb;
    bf16_t* VcT = (bf16_t*)(ldsb + 18432);
    bf16_t* Ks = (bf16_t*)ldsb;
    bf16_t* VT = (bf16_t*)(ldsb + 18432);
    float* impw = (float*)(lds + 35840);
    float* scs = (float*)(lds + 35840 + 32768);
    unsigned* selm = (unsigned*)(lds + 35840 + 32768 + 2048);

    bf16x8 qf[2][2];
#pragma unroll
    for (int x = 0; x < 2; x++)
#pragma unroll
        for (int ks = 0; ks < 2; ks++) qf[x][ks] = *(const bf16x8*)(Z + (rowb + t) * ZC + ZQ_N + (g * 8 + 2 * wave + x) * 64 + ks * 32 + q * 8);
    f32x4* ofl = (f32x4*)(lds + 35840);

    f32x4 Og[2][4];
    {
        const bf16_t* kc = (const bf16_t*)(p.ws + OFF_CMP) + (size_t)((0 * 8 + b) * 2 + g) * 128 * 64;
        const bf16_t* vc = (const bf16_t*)(p.ws + OFF_CMP) + (size_t)((1 * 8 + b) * 2 + g) * 128 * 64;
        {
            const int key = t512 >> 2, ch = (t512 & 3) * 16;
#pragma unroll
            for (int v4 = 0; v4 < 2; v4++) *(u32x4*)(Kc + key * 72 + ch + v4 * 8) = *(const u32x4*)(kc + key * 64 + ch + v4 * 8);
            const int k2 = t512 & 127, dc = (t512 >> 7) * 16;
#pragma unroll
            for (int v4 = 0; v4 < 2; v4++) {
                const u32x4 a = *(const u32x4*)(vc + k2 * 64 + dc + v4 * 8);
                const unsigned w[4] = {a.x, a.y, a.z, a.w};
#pragma unroll
                for (int j = 0; j < 8; j++) VcT[(dc + v4 * 8 + j) * 136 + k2] = (bf16_t)((j & 1) ? (w[j >> 1] >> 16) : (w[j >> 1] & 0xffffu));
            }
        }
        __syncthreads();
        int nv = t >= 31 ? ((t - 31) >> 4) + 1 : 0;
        if (nv > 127) nv = 127;
        f32x4 isum[8];
#pragma unroll
        for (int kt = 0; kt < 8; kt++) isum[kt] = (f32x4){0.f, 0.f, 0.f, 0.f};
#pragma unroll
        for (int x = 0; x < 2; x++) {
            f32x4 s[8];
            nsa_cmp_probs(Kc, qf[x], nv, r, q, s);
#pragma unroll
            for (int kt = 0; kt < 8; kt++) isum[kt] += s[kt];
            f32x4 Oc[4];
#pragma unroll
            for (int dt = 0; dt < 4; dt++) Oc[dt] = (f32x4){0.f, 0.f, 0.f, 0.f};
            __builtin_amdgcn_sched_barrier(0);
#pragma unroll
            for (int s2 = 0; s2 < 4; s2++) {
                const u32x4 t4 = {pack2(s[2 * s2][0], s[2 * s2][1]), pack2(s[2 * s2][2], s[2 * s2][3]),
                                  pack2(s[2 * s2 + 1][0], s[2 * s2 + 1][1]), pack2(s[2 * s2 + 1][2], s[2 * s2 + 1][3])};
                const bf16x8 pbv = __builtin_bit_cast(bf16x8, t4);
#pragma unroll
                for (int dt = 0; dt < 4; dt++) {
                    const u32x2 lo = *(const u32x2*)(VcT + (dt * 16 + r) * 136 + (2 * s2) * 16 + 4 * q);
                    const u32x2 hi = *(const u32x2*)(VcT + (dt * 16 + r) * 136 + (2 * s2 + 1) * 16 + 4 * q);
                    Oc[dt] = mfma16(mk_frag(lo, hi), pbv, Oc[dt]);
                }
            }
            const float g0 = sigmoidf_(bf2f(Z[(rowb + t) * ZC + ZGATE + 0 * 16 + g * 8 + 2 * wave + x]));
#pragma unroll
            for (int dt = 0; dt < 4; dt++) Og[x][dt] = g0 * Oc[dt];
            __builtin_amdgcn_sched_barrier(0);
        }
#pragma unroll
        for (int kt = 0; kt < 8; kt++) *(f32x4*)(impw + (wave * 16 + r) * 128 + kt * 16 + 4 * q) = isum[kt];
        __syncthreads();
#pragma unroll
        for (int pass = 0; pass < 2; pass++) {
            const int tk = pass * 8 + (tid >> 5), j = tid & 31;
            const int i0 = j == 0 ? 0 : 4 * j - 1, i1 = (4 * j + 3 > 126) ? 126 : 4 * j + 3;
            float sc = 0.f;
            for (int i = i0; i <= i1; i++) sc += (impw[(0 * 16 + tk) * 128 + i] + impw[(1 * 16 + tk) * 128 + i]) + (impw[(2 * 16 + tk) * 128 + i] + impw[(3 * 16 + tk) * 128 + i]);
            const bool forced = (j == 0) || (j == cur) || (j == cur - 1);
            scs[tk * 32 + j] = forced ? 1e6f : (j <= cur ? sc : -1.f);
        }
        __syncthreads();
#pragma unroll
        for (int pass = 0; pass < 2; pass++) {
            const int tk = pass * 8 + (tid >> 5), j = tid & 31;
            const float mine = scs[tk * 32 + j];
            int rank = 0;
            for (int j2 = 0; j2 < 32; j2++) { const float o = scs[tk * 32 + j2]; rank += (o > mine || (o == mine && j2 < j)) ? 1 : 0; }
            const unsigned long long bal = __ballot(rank < 16);
            if ((lane & 31) == 0) selm[tk] = (unsigned)(lane ? (bal >> 32) : (bal & 0xffffffffull));
        }
        __syncthreads();
    }
#pragma unroll
    for (int x = 0; x < 2; x++)
#pragma unroll
        for (int dt = 0; dt < 4; dt++) ofl[(wave * 8 + x * 4 + dt) * 64 + lane] = Og[x][dt];
    const unsigned mysel = selm[r];
    unsigned uni = 0;
#pragma unroll
    for (int i = 0; i < 16; i++) uni |= selm[i];
    if (tid == 0) uex[half_id()] = uni;
    __syncthreads();
    uni = uex[0] | uex[1];
    uni &= (cur == 31) ? 0xffffffffu : ((2u << cur) - 1u);
    uni |= 1u;

    {
        const int lo = (t0 & ~31) - 511;
        const int jb0 = lo > 0 ? (lo >> 6) : 0;
        const int kkey = t512 >> 3, kch = (t512 & 7) * 8;
        const int vkey = t512 & 63, vdc = (t512 >> 6) * 8;
        u32x4 kreg, vreg;
        int br = 0, j = 0;
        {
            const bf16_t* kb = Z + (rowb + 0) * ZC + ZKS + g * 64;
            const bf16_t* vb = Z + (rowb + 0) * ZC + ZVS + g * 64;
            kreg = *(const u32x4*)(kb + (size_t)kkey * ZC + kch);
            vreg = *(const u32x4*)(vb + (size_t)vkey * ZC + vdc);
        }
        f32x4 O[2][4];
        float m[2] = {-1e30f, -1e30f}, l[2] = {0.f, 0.f};
#pragma unroll
        for (int x = 0; x < 2; x++)
#pragma unroll
            for (int dt = 0; dt < 4; dt++) O[x][dt] = (f32x4){0.f, 0.f, 0.f, 0.f};
        for (;;) {
            __syncthreads();
            *(u32x4*)(Ks + kkey * 64 + (((kch >> 3) ^ (kkey & 7)) * 8)) = kreg;
            {
                const unsigned w[4] = {vreg.x, vreg.y, vreg.z, vreg.w};
#pragma unroll
                for (int jj = 0; jj < 8; jj++) VT[(vdc + jj) * 72 + vkey] = (bf16_t)((jj & 1) ? (w[jj >> 1] >> 16) : (w[jj >> 1] & 0xffffu));
            }
            __syncthreads();
            int nbr, nj;
            if (br == 0) {
                const unsigned rem = (j >= 31) ? 0u : (uni & ~((2u << j) - 1u));
                if (rem) { nbr = 0; nj = __ffs((int)rem) - 1; } else { nbr = 1; nj = jb0; }
            } else {
                if (j < cur) { nbr = 1; nj = j + 1; } else { nbr = 2; nj = 0; }
            }
            if (nbr < 2) {
                const bf16_t* kb = Z + (rowb + nj * 64) * ZC + (nbr ? ZKW : ZKS) + g * 64;
                const bf16_t* vb = Z + (rowb + nj * 64) * ZC + (nbr ? ZVW : ZVS) + g * 64;
                kreg = *(const u32x4*)(kb + (size_t)kkey * ZC + kch);
                vreg = *(const u32x4*)(vb + (size_t)vkey * ZC + vdc);
            }
            int klo = 0, khi = -1;
            if (br == 0) { if ((mysel >> j) & 1u) khi = t - j * 64; }
            else { khi = t - j * 64; klo = t - 511 - j * 64; }
            klo = klo < 0 ? 0 : klo;
            khi = khi > 63 ? 63 : khi;
            nsa_block_step(Ks, VT, qf, O, m, l, klo, khi, r, q);
            if (nbr != br) {
#pragma unroll
                for (int x = 0; x < 2; x++) {
                    float lt = l[x];
                    lt += __shfl_xor(lt, 16, 64);
                    lt += __shfl_xor(lt, 32, 64);
                    const float sc = sigmoidf_(bf2f(Z[(rowb + t) * ZC + ZGATE + (br + 1) * 16 + g * 8 + 2 * wave + x])) / lt;
#pragma unroll
                    for (int dt = 0; dt < 4; dt++) { ofl[(wave * 8 + x * 4 + dt) * 64 + lane] += sc * O[x][dt]; O[x][dt] = (f32x4){0.f, 0.f, 0.f, 0.f}; }
                    m[x] = -1e30f; l[x] = 0.f;
                }
            }
            if (nbr == 2) break;
            br = nbr; j = nj;
        }
#pragma unroll
        for (int x = 0; x < 2; x++)
#pragma unroll
            for (int dt = 0; dt < 4; dt++) {
                const f32x4 v = ofl[(wave * 8 + x * 4 + dt) * 64 + lane];
                *(u32x2*)(ydst + (rowb + t) * ystride + (g * 8 + 2 * wave + x) * 64 + dt * 16 + 4 * q) = (u32x2){pack2(v[0], v[1]), pack2(v[2], v[3])};
            }
    }
    __syncthreads();
}

__device__ void phaseM1(const Params& p, char* lds) {
    const int tid_ = TIDX512; const int lane = tid_ & 63, wave = tid_ >> 6;
    const int wr = wave >> 2, wc = wave & 3, r = lane & 15, q = lane >> 4;
    const bf16_t* H = (const bf16_t*)(p.ws + OFF_H);
    const bf16_t* Z = (const bf16_t*)(p.ws + OFF_Z);
    bf16_t* M = (bf16_t*)(p.ws + OFF_M);
    bf16_t* SG = (bf16_t*)p.out;
    TileIter tit(4, lds);
    int bm, bn;
    while (tit.next(bm, bn)) {
        const int m0 = bm * 256, n0 = bn * 256;
        for (int br = 0; br < 2; br++) {
            f32x4 acc[8][4];
            zero_acc(acc);
            gemm_core(acc, H, DM, (const bf16_t*)(p.ws + OFF_WM) + (size_t)br * 1024 * 1024, DM, DM, m0, n0, lds);
            {
                const int e0 = launder_i((m0 + wr * 128 + r) * DM + n0 + wc * 64 + 4 * q);
#pragma unroll
                for (int mi = 0; mi < 8; mi++)
#pragma unroll
                    for (int ni = 0; ni < 4; ni++)
                        *(u32x2*)(SG + (size_t)(e0 + mi * 16 * DM + ni * 16)) = (u32x2){pack2(sigmoidf_(acc[mi][ni][0]), sigmoidf_(acc[mi][ni][1])),
                                                                                        pack2(sigmoidf_(acc[mi][ni][2]), sigmoidf_(acc[mi][ni][3]))};
            }
            zero_acc(acc);
            gemm_core(acc, Z + (br ? ZQ_N : ZR_G), ZC, (const bf16_t*)(p.ws + (br ? OFF_WB : OFF_WA)), DM, DM, m0, n0, lds);
            {
                const int e0 = launder_i((m0 + wr * 128 + r) * DM + n0 + wc * 64 + 4 * q);
#pragma unroll
                for (int mi = 0; mi < 8; mi++)
#pragma unroll
                    for (int ni = 0; ni < 4; ni++) {
                        const size_t eo = (size_t)(e0 + mi * 16 * DM + ni * 16);
                        const u32x2 sg = *(const u32x2*)(SG + eo);
                        float v[4] = {bf_lo(sg.x) * acc[mi][ni][0], bf_hi(sg.x) * acc[mi][ni][1], bf_lo(sg.y) * acc[mi][ni][2], bf_hi(sg.y) * acc[mi][ni][3]};
                        u32x2* dst = (u32x2*)(M + eo);
                        if (br) { const u32x2 pv = *dst; v[0] += bf_lo(pv.x); v[1] += bf_hi(pv.x); v[2] += bf_lo(pv.y); v[3] += bf_hi(pv.y); }
                        *dst = (u32x2){pack2(v[0], v[1]), pack2(v[2], v[3])};
                    }
            }
        }
    }
}

__device__ void phaseM2(const Params& p, char* lds) {
    const int tid_ = TIDX512; const int lane = tid_ & 63, wave = tid_ >> 6;
    const int wr = wave >> 2, wc = wave & 3, r = lane & 15, q = lane >> 4;
    const bf16_t* M = (const bf16_t*)(p.ws + OFF_M);
    const float* mod = (const float*)(p.ws + OFF_MOD);
    TileIter tit(4, lds);
    int bm, bn;
    while (tit.next(bm, bn)) {
        const int m0 = bm * 256, n0 = bn * 256;
        f32x4 acc[8][4];
        zero_acc(acc);
        gemm_core(acc, M, DM, (const bf16_t*)(p.ws + OFF_WO), DM, DM, m0, n0, lds);
#pragma unroll
        for (int mi = 0; mi < 8; mi++)
#pragma unroll
            for (int ni = 0; ni < 4; ni++) {
                const int tok = m0 + wr * 128 + mi * 16 + r, col = n0 + wc * 64 + ni * 16 + 4 * q;
                const f32x4 xv = *(const f32x4*)(p.x + (size_t)tok * DM + col);
                const f32x4 gt = *(const f32x4*)(mod + (tok >> 11) * 6144 + 2 * 1024 + col);
                *(f32x4*)(p.out + (size_t)tok * DM + col) = xv + gt * acc[mi][ni];
            }
    }
    {
        const int tid_ = TIDX; const int lane = tid_ & 63, wave = tid_ >> 6;
        unsigned char* tq = (unsigned char*)(p.ws + OFF_UB);
        float* tsc = (float*)(p.ws + OFF_UB + 33554432);
        for (int row = vblk() * 4 + wave; row < 32768; row += vgrid() * 4) {
            const bool isv = row >= 16384;
            const float* srcp = (isv ? p.peer_v : p.peer_u) + (size_t)(row & 16383) * DM + lane * 16;
            f32x4 a[4];
            float mx = 0.f;
#pragma unroll
            for (int i = 0; i < 4; i++) {
                a[i] = *(const f32x4*)(srcp + i * 4);
                mx = fmaxf(mx, fmaxf(fmaxf(fabsf(a[i][0]), fabsf(a[i][1])), fmaxf(fabsf(a[i][2]), fabsf(a[i][3]))));
            }
            mx = wave_max(mx);
            const float inv = mx > 0.f ? 127.f / mx : 0.f;
            const int off = isv ? 128 : 0;
            unsigned w[4];
#pragma unroll
            for (int i = 0; i < 4; i++) {
                unsigned pk = 0;
#pragma unroll
                for (int j = 0; j < 4; j++) {
                    int qi = (int)rintf(a[i][j] * inv);
                    qi = qi > 127 ? 127 : (qi < -127 ? -127 : qi);
                    pk |= ((unsigned)(qi + off) & 0xffu) << (8 * j);
                }
                w[i] = pk;
            }
            *(u32x4*)(tq + (size_t)row * DM + lane * 16) = (u32x4){w[0], w[1], w[2], w[3]};
            if (lane == 0) tsc[row] = mx * (1.f / 127.f);
        }
    }
}

__device__ void phaseP1(const Params& p, char* lds) {
    const int tid_ = TIDX512; const int lane = tid_ & 63, wave = tid_ >> 6;
    const int wr = wave >> 2, wc = wave & 3, r = lane & 15, q = lane >> 4;
    const bf16_t* H = (const bf16_t*)(p.ws + OFF_H);
    bf16_t* QP = (bf16_t*)(p.ws + OFF_QP);
    TileIter tit(8, lds);
    int bm, bn;
    while (tit.next(bm, bn)) {
        const int m0 = bm * 256, n0 = bn * 256;
        f32x4 acc[8][4];
        zero_acc(acc);
        gemm_core(acc, H, DM, (const bf16_t*)(p.ws + OFF_WQ), DM, DM, m0, n0, lds);
#pragma unroll
        for (int mi = 0; mi < 8; mi++)
#pragma unroll
            for (int ni = 0; ni < 4; ni++) epi_fill(lds, wr, wc, r, q, mi, ni, acc[mi][ni]);
        __syncthreads();
        epi_store(lds, QP, 2048, m0, n0, 2048);
        __syncthreads();
    }
}

__constant__ unsigned char c_cand_a[64] = {0,0,0,0,0,0,0,0,0,0,0,0,0,0,0,0, 1,1,1,1,1,1,1,1, 2,2,2,2,2, 3,3,3,3, 4,4,4, 5,5, 6,6, 7,7, 8,9,10,11,12,13,14,15, 0,0,0,0,0,0,0,0,0,0,0,0,0,0};
__constant__ unsigned char c_cand_b[64] = {0,1,2,3,4,5,6,7,8,9,10,11,12,13,14,15, 0,1,2,3,4,5,6,7, 0,1,2,3,4, 0,1,2,3, 0,1,2, 0,1, 0,1, 0,1, 0,0,0,0,0,0,0,0, 0,0,0,0,0,0,0,0,0,0,0,0,0,0};

__device__ __forceinline__ unsigned f2key(float f) { const unsigned u = __float_as_uint(f); return (u & 0x80000000u) ? ~u : (u | 0x80000000u); }
__device__ __forceinline__ float key2f(unsigned k) { const unsigned u = (k & 0x80000000u) ? (k & 0x7fffffffu) : ~k; return __uint_as_float(u); }
__device__ __forceinline__ void cex_desc(unsigned& a, unsigned& b) { const unsigned hi = a > b ? a : b, lo = a > b ? b : a; a = hi; b = lo; }
__device__ __forceinline__ void sort16_desc(unsigned (&a)[16]) {
#pragma unroll
    for (int k = 2; k <= 16; k <<= 1)
#pragma unroll
        for (int j = k >> 1; j > 0; j >>= 1)
#pragma unroll
            for (int i = 0; i < 16; i++) {
                const int l = i ^ j;
                if (l > i) { if ((i & k) == 0) cex_desc(a[i], a[l]); else cex_desc(a[l], a[i]); }
            }
}
__device__ __forceinline__ void merge16_desc(unsigned (&a)[16], const unsigned (&b)[16]) {
#pragma unroll
    for (int i = 0; i < 16; i++) a[i] = a[i] > b[15 - i] ? a[i] : b[15 - i];
#pragma unroll
    for (int j = 8; j > 0; j >>= 1)
#pragma unroll
        for (int i = 0; i < 16; i++) { const int l = i ^ j; if (l > i) cex_desc(a[i], a[l]); }
}

__device__ void phaseP2_task(const Params& p, int task, char* lds) {
    const int tid = TIDX, lane = tid & 63, wave = tid >> 6, r = lane & 15, q = lane >> 4;
    const int h = task & 7, tile = task >> 3;
    const int tok0 = tile * 64;
    const bf16_t* QP = (const bf16_t*)(p.ws + OFF_QP);
    float* S = (float*)lds;
    unsigned* LL = (unsigned*)(lds + 65536);
#pragma unroll
    for (int half = 0; half < 2; half++) {
        const bf16_t* KB = (const bf16_t*)(p.ws + OFF_K1B) + (size_t)half * 131072 + (size_t)h * 128 * 128;
        f32x4 acc[8];
#pragma unroll
        for (int nt = 0; nt < 8; nt++) acc[nt] = (f32x4){0.f, 0.f, 0.f, 0.f};
#pragma unroll
        for (int ks = 0; ks < 4; ks++) {
            const bf16x8 bq = *(const bf16x8*)(QP + (size_t)(tok0 + wave * 16 + r) * 2048 + h * 256 + half * 128 + ks * 32 + q * 8);
#pragma unroll
            for (int nt = 0; nt < 8; nt++) {
                const bf16x8 ak = *(const bf16x8*)(KB + (size_t)(nt * 16 + r) * 128 + ks * 32 + q * 8);
                acc[nt] = mfma16(ak, bq, acc[nt]);
            }
        }
#pragma unroll
        for (int nt = 0; nt < 8; nt++)
#pragma unroll
            for (int j = 0; j < 4; j++) S[(half * 128 + nt * 16 + 4 * q + j) * 64 + wave * 16 + r] = acc[nt][j];
    }
    __syncthreads();
    {
        const int row = tid & 127, part = tid >> 7, half = row >> 6, tk = row & 63;
        unsigned L[16];
        const float* sp = S + (half * 128 + part * 64) * 64 + tk;
#pragma unroll
        for (int k = 0; k < 16; k++) L[k] = (f2key(sp[k * 64]) & ~127u) | (unsigned)(127 - (part * 64 + k));
        sort16_desc(L);
        for (int gq = 1; gq < 4; gq++) {
            unsigned G[16];
#pragma unroll
            for (int k = 0; k < 16; k++) G[k] = (f2key(sp[(gq * 16 + k) * 64]) & ~127u) | (unsigned)(127 - (part * 64 + gq * 16 + k));
            sort16_desc(G);
            merge16_desc(L, G);
        }
        __syncthreads();
        unsigned* LP = (unsigned*)lds;
#pragma unroll
        for (int k = 0; k < 16; k++) LP[((part * 2 + half) * 16 + k) * 64 + tk] = L[k];
        __syncthreads();
        if (tid < 128) {
            unsigned A[16], Bq[16];
#pragma unroll
            for (int k = 0; k < 16; k++) { A[k] = LP[((0 * 2 + half) * 16 + k) * 64 + tk]; Bq[k] = LP[((1 * 2 + half) * 16 + k) * 64 + tk]; }
            merge16_desc(A, Bq);
#pragma unroll
            for (int k = 0; k < 16; k++) LL[(half * 16 + k) * 64 + tk] = A[k];
        }
    }
    __syncthreads();
    if (tid < 64) {
        const int tk = tid;
        float v1[16], v2[16];
#pragma unroll
        for (int k = 0; k < 16; k++) { v1[k] = key2f(LL[k * 64 + tk] & ~127u); v2[k] = key2f(LL[(16 + k) * 64 + tk] & ~127u); }
        unsigned C[64];
#pragma unroll
        for (int k = 0; k < 64; k++) C[k] = 0u;
        {
            int c = 0;
#pragma unroll
            for (int a = 0; a < 16; a++)
#pragma unroll
                for (int b = 0; b < 16; b++)
                    if ((a + 1) * (b + 1) <= 16) { C[c] = (f2key(v1[a] + v2[b]) & ~63u) | (unsigned)(63 - c); c++; }
        }
        unsigned T[16];
#pragma unroll
        for (int k = 0; k < 16; k++) T[k] = C[k];
        sort16_desc(T);
#pragma unroll
        for (int gq = 1; gq < 4; gq++) {
            unsigned G[16];
#pragma unroll
            for (int k = 0; k < 16; k++) G[k] = C[gq * 16 + k];
            sort16_desc(G);
            merge16_desc(T, G);
        }
        const float mx = key2f(T[0] & ~63u);
        float e[16], sum = 0.f;
#pragma unroll
        for (int k = 0; k < 16; k++) { e[k] = __expf(key2f(T[k] & ~63u) - mx); sum += e[k]; }
        const float inv = 1.f / sum;
        int ei[16];
#pragma unroll
        for (int k = 0; k < 16; k++) {
            const int cc = 63 - (int)(T[k] & 63u);
            const int a = c_cand_a[cc], b = c_cand_b[cc];
            const int i1 = 127 - (int)(LL[a * 64 + tk] & 127u), i2 = 127 - (int)(LL[(16 + b) * 64 + tk] & 127u);
            ei[k] = i1 * 128 + i2;
            e[k] *= inv;
        }
        int* eidx = (int*)(p.ws + OFF_EIDX) + (size_t)(tok0 + tk) * 128 + h * 16;
        float* gw = (float*)(p.ws + OFF_GW) + (size_t)(tok0 + tk) * 128 + h * 16;
#pragma unroll
        for (int k4 = 0; k4 < 4; k4++) {
            *(u32x4*)(eidx + k4 * 4) = (u32x4){(unsigned)ei[k4 * 4], (unsigned)ei[k4 * 4 + 1], (unsigned)ei[k4 * 4 + 2], (unsigned)ei[k4 * 4 + 3]};
            *(f32x4*)(gw + k4 * 4) = (f32x4){e[k4 * 4], e[k4 * 4 + 1], e[k4 * 4 + 2], e[k4 * 4 + 3]};
        }
    }
    __syncthreads();
}

__device__ __forceinline__ float ub0(unsigned w) { return (float)(w & 0xffu); }
__device__ __forceinline__ float ub1(unsigned w) { return (float)((w >> 8) & 0xffu); }
__device__ __forceinline__ float ub2(unsigned w) { return (float)((w >> 16) & 0xffu); }
__device__ __forceinline__ float ub3(unsigned w) { return (float)(w >> 24); }
struct P3Sc { float su, sv, gm; };
constexpr int P3_REC = 2048;
__device__ __forceinline__ void p3_load_u(u32x4 (&ur)[4], P3Sc& sc, const unsigned char* __restrict__ UQ, const float* __restrict__ tsc,
                                          int lane, int ul, int g, const unsigned* rec) {
#pragma unroll
    for (int u = 0; u < 4; u++) ur[u] = *(const u32x4*)(UQ + (size_t)rec[4 * g + u] * DM + lane * 16);
    const int em = (int)rec[4 * g + ul];
    sc.gm = __uint_as_float(rec[128 + 4 * g + ul]);
    sc.su = tsc[em];
    sc.sv = tsc[16384 + em];
}
__device__ __forceinline__ void p3_load_v(u32x4 (&vr)[4], const unsigned char* __restrict__ VQ, int lane, int g, const unsigned* rec) {
#pragma unroll
    for (int u = 0; u < 4; u++) vr[u] = *(const u32x4*)(VQ + (size_t)rec[4 * g + u] * DM + lane * 16);
}
__device__ __forceinline__ void p3_dots(const u32x4 (&ur)[4], const unsigned* rec, int lane, int (&pt)[4]) {
    const u32x4 qh = *(const u32x4*)(rec + 256 + lane * 4);
#pragma unroll
    for (int u = 0; u < 4; u++) {
        int d = __builtin_amdgcn_sdot4((int)ur[u].x, (int)qh.x, 0, false);
        d = __builtin_amdgcn_sdot4((int)ur[u].y, (int)qh.y, d, false);
        d = __builtin_amdgcn_sdot4((int)ur[u].z, (int)qh.z, d, false);
        d = __builtin_amdgcn_sdot4((int)ur[u].w, (int)qh.w, d, false);
        pt[u] = d;
    }
}
__device__ __forceinline__ float p3_weight(const int (&pt)[4], int lane, float sh, const P3Sc& sc) {
    int m2[2], m1;
    const bool c0 = lane & 1;
#pragma unroll
    for (int j = 0; j < 2; j++) { const int keep = c0 ? pt[j + 2] : pt[j], send = c0 ? pt[j] : pt[j + 2]; m2[j] = keep + __shfl_xor(send, 1, 64); }
    const bool c1 = lane & 2;
    { const int keep = c1 ? m2[1] : m2[0], send = c1 ? m2[0] : m2[1]; m1 = keep + __shfl_xor(send, 2, 64); }
    m1 += __shfl_xor(m1, 4, 64);
    m1 += __shfl_xor(m1, 8, 64);
    m1 += __shfl_xor(m1, 16, 64);
    m1 += __shfl_xor(m1, 32, 64);
    const float aval = (float)m1 * (sh * sc.su);
    return sc.gm * gelu_erf(aval) * sc.sv;
}
__device__ __forceinline__ void p3_axpy(const u32x4 (&vr)[4], float ws, float (&acc)[16], float& wsum) {
#pragma unroll
    for (int u = 0; u < 4; u++) {
        const int src_lane = ((u >> 1) & 1) | ((u & 1) << 1);
        const float wu = __shfl(ws, src_lane, 64);
        wsum += wu;
        const unsigned vw[4] = {vr[u].x, vr[u].y, vr[u].z, vr[u].w};
#pragma unroll
        for (int i = 0; i < 4; i++) {
            acc[i * 4 + 0] += wu * ub0(vw[i]); acc[i * 4 + 1] += wu * ub1(vw[i]);
            acc[i * 4 + 2] += wu * ub2(vw[i]); acc[i * 4 + 3] += wu * ub3(vw[i]);
        }
    }
}
__device__ __forceinline__ void p3_token(const Params& p, int tok, int lane, unsigned* rec, float& sh) {
    const bf16_t* H = (const bf16_t*)(p.ws + OFF_H);
    const int* eidx = (const int*)(p.ws + OFF_EIDX);
    const float* gwp = (const float*)(p.ws + OFF_GW);
    {
        const u32x4 a = *(const u32x4*)(H + (size_t)tok * DM + lane * 16), b = *(const u32x4*)(H + (size_t)tok * DM + lane * 16 + 8);
        const unsigned hw[8] = {a.x, a.y, a.z, a.w, b.x, b.y, b.z, b.w};
        float hv[16];
        float mx = 0.f;
#pragma unroll
        for (int i = 0; i < 8; i++) { hv[2 * i] = bf_lo(hw[i]); hv[2 * i + 1] = bf_hi(hw[i]); mx = fmaxf(mx, fmaxf(fabsf(hv[2 * i]), fabsf(hv[2 * i + 1]))); }
        mx = wave_max(mx);
        const float inv = mx > 0.f ? 127.f / mx : 0.f;
        sh = mx * (1.f / 127.f);
        unsigned qh[4];
#pragma unroll
        for (int i = 0; i < 4; i++) {
            unsigned pk = 0;
#pragma unroll
            for (int j = 0; j < 4; j++) pk |= ((unsigned)((int)rintf(hv[i * 4 + j] * inv)) & 0xffu) << (8 * j);
            qh[i] = pk;
        }
        *(u32x4*)(rec + 256 + lane * 4) = (u32x4){qh[0], qh[1], qh[2], qh[3]};
    }
    const int e0 = eidx[(size_t)tok * 128 + lane], e1 = eidx[(size_t)tok * 128 + 64 + lane];
    const float g0 = gwp[(size_t)tok * 128 + lane], g1 = gwp[(size_t)tok * 128 + 64 + lane];
    const int k0 = e0 >> 10, k1 = e1 >> 10;
    int pos0 = 0, pos1 = 0, base = 0;
#pragma unroll
    for (int v = 0; v < 16; v++) {
        const unsigned long long m0 = __ballot(k0 == v), m1 = __ballot(k1 == v);
        const int c0 = __popcll(m0);
        const int r0 = __builtin_amdgcn_mbcnt_hi((unsigned)(m0 >> 32), __builtin_amdgcn_mbcnt_lo((unsigned)m0, 0u));
        const int r1 = __builtin_amdgcn_mbcnt_hi((unsigned)(m1 >> 32), __builtin_amdgcn_mbcnt_lo((unsigned)m1, 0u));
        pos0 = (k0 == v) ? base + r0 : pos0;
        pos1 = (k1 == v) ? base + c0 + r1 : pos1;
        base += c0 + __popcll(m1);
    }
    rec[pos0] = (unsigned)e0; rec[pos1] = (unsigned)e1;
    rec[128 + pos0] = __float_as_uint(g0); rec[128 + pos1] = __float_as_uint(g1);
}
__device__ __forceinline__ void p3_finish(const Params& p, float* dstp, int tok, int lane, const float (&acc)[16], float wsum) {
    const float* mod = (const float*)(p.ws + OFF_MOD);
    const int b = tok >> 11;
    float x2[16];
    float ss = 0.f;
#pragma unroll
    for (int i = 0; i < 4; i++) {
        const int d = lane * 16 + i * 4;
        const f32x4 xv = *(const f32x4*)(p.out + (size_t)tok * DM + d);
        const f32x4 gt = *(const f32x4*)(mod + b * 6144 + 5 * 1024 + d);
#pragma unroll
        for (int j = 0; j < 4; j++) { const float v = xv[j] + gt[j] * (acc[i * 4 + j] - 128.f * wsum); x2[i * 4 + j] = v; ss += v * v; }
    }
    ss = wave_sum(ss);
    const float rstd = rsqrtf(ss * (1.f / 1024.f) + 1e-6f);
#pragma unroll
    for (int i = 0; i < 4; i++) {
        const int d = lane * 16 + i * 4;
        const f32x4 fg = *(const f32x4*)(p.final_g + d);
        f32x4 o;
#pragma unroll
        for (int j = 0; j < 4; j++) o[j] = x2[i * 4 + j] * rstd * fg[j];
        *(f32x4*)(dstp + (size_t)tok * DM + d) = o;
    }
}
__device__ void phaseP3(const Params& p, float* dstp, char* lds) {
    const int tid_ = TIDX; const int lane = tid_ & 63, wave = tid_ >> 6;
    const unsigned char* UQ = (const unsigned char*)(p.ws + OFF_UB);
    const unsigned char* VQ = UQ + 16777216;
    const float* tsc = (const float*)(p.ws + OFF_UB + 33554432);
    const int ul = ((lane & 1) << 1) | ((lane >> 1) & 1);
    constexpr int TPW = 2;
    unsigned* recs = (unsigned*)(lds + wave * TPW * P3_REC);
    for (int tb = (vblk() * 4 + wave) * TPW; tb < NTOK; tb += vgrid() * 4 * TPW) {
        float sh[TPW], acc[TPW][16], wsm[TPW];
        __builtin_amdgcn_wave_barrier();
#pragma unroll
        for (int k = 0; k < TPW; k++) {
            p3_token(p, tb + k, lane, recs + k * (P3_REC / 4), sh[k]);
#pragma unroll
            for (int i = 0; i < 16; i++) acc[k][i] = 0.f;
            wsm[k] = 0.f;
        }
        __builtin_amdgcn_wave_barrier();
        u32x4 ur[4], vr[4];
        P3Sc sc[TPW];
        p3_load_u(ur, sc[0], UQ, tsc, lane, ul, 0, recs);
        p3_load_v(vr, VQ, lane, 0, recs);
        for (int g = 0; g < 32; g++) {
#pragma unroll
            for (int k = 0; k < TPW; k++) {
                const int kn = (k + 1) % TPW;
                const int gn = (k + 1 == TPW) ? g + 1 : g;
                int pt[4];
                p3_dots(ur, recs + k * (P3_REC / 4), lane, pt);
                if (gn < 32) p3_load_u(ur, sc[kn], UQ, tsc, lane, ul, gn, recs + kn * (P3_REC / 4));
                const float w = p3_weight(pt, lane, sh[k], sc[k]);
                p3_axpy(vr, w, acc[k], wsm[k]);
                if (gn < 32) p3_load_v(vr, VQ, lane, gn, recs + kn * (P3_REC / 4));
            }
        }
#pragma unroll
        for (int k = 0; k < TPW; k++) p3_finish(p, dstp, tb + k, lane, acc[k], wsm[k]);
    }
}

#define XB_TMO      128
#define XB_XCNT(j)  (256  + 64 * (j))
#define XB_XSUB(j)  (1280 + 64 * (j))
#define XB_XGEN(j)  (2304 + 64 * (j))
#define XB_TOP      3328
#define XB_TOPGEN   3392
#define XCD_BAR_WORDS 3456
#define XB_SPIN_CAP (1u << 22)
#define LAS __attribute__((address_space(3)))
__device__ __forceinline__ unsigned xb_ld(unsigned* p)              { return __hip_atomic_load(p, __ATOMIC_RELAXED, __HIP_MEMORY_SCOPE_AGENT); }
__device__ __forceinline__ unsigned xb_add(unsigned* p, unsigned v) { return __hip_atomic_fetch_add(p, v, __ATOMIC_RELAXED, __HIP_MEMORY_SCOPE_AGENT); }
__device__ __forceinline__ unsigned xb_xcc_id() { return (unsigned)__builtin_amdgcn_s_getreg((3 << 11) | 20) & 0xFu; }
#define XB_SPIN(cond, bar) do { unsigned _sp = 0; while (cond) { __builtin_amdgcn_s_sleep(1); \
    if ((++_sp & 255u) == 0u) { if (xb_ld(&(bar)[XB_TMO])) break; if (_sp > XB_SPIN_CAP) { atomicAdd(&(bar)[XB_TMO], 1u); break; } } } } while (0)
struct XcdBarrier { unsigned* bar; unsigned x; volatile LAS unsigned* st; };
__device__ __forceinline__ XcdBarrier xcd_barrier_post(unsigned* bar, volatile LAS unsigned* st) {
    XcdBarrier b; b.bar = bar; b.x = xb_xcc_id(); b.st = st;
    if (threadIdx.x == 0) { st[2] = xb_add(&bar[XB_XCNT(b.x)], 1u); st[4] = b.x; }
    return b;
}
__device__ __forceinline__ void xcd_barrier_complete(unsigned* bar, unsigned x, unsigned& nloc, unsigned& nx, unsigned& bal) {
    const unsigned G = gridDim.x * gridDim.y * gridDim.z;
    unsigned sum, cnt, mine, c64, sp = 0u;
    for (;;) {
        sum = 0u; cnt = 0u; mine = 0u; c64 = 0u;
#pragma unroll
        for (unsigned j = 0; j < 16; ++j) { const unsigned c = xb_ld(&bar[XB_XCNT(j)]); sum += c; cnt += (c > 0u) ? 1u : 0u; c64 += (j < 8 && c == 64u) ? 1u : 0u; mine = (j == x) ? c : mine; }
        if (sum == G) break;
        __builtin_amdgcn_s_sleep(1);
        if ((++sp & 255u) == 0u) { if (xb_ld(&bar[XB_TMO])) break; if (sp > XB_SPIN_CAP) { atomicAdd(&bar[XB_TMO], 1u); break; } }
    }
    nloc = mine > 0u ? mine : 1u; nx = cnt > 0u ? cnt : 1u; bal = (sum == G && cnt == 8u && c64 == 8u) ? 1u : 0u;
}
__device__ __forceinline__ void xcd_barrier(const XcdBarrier& b) {
    asm volatile("s_waitcnt vmcnt(0)" ::: "memory");
    __syncthreads();
    if (threadIdx.x == 0) {
        unsigned* bar = b.bar;
        __builtin_amdgcn_s_waitcnt(0);
        unsigned nloc = b.st[0], nx = b.st[1];
        if (nloc == 0u) { unsigned bal; xcd_barrier_complete(bar, b.x, nloc, nx, bal); b.st[0] = nloc; b.st[1] = nx; b.st[3] = bal; }
        const unsigned old = xb_add(&bar[XB_XSUB(b.x)], 1u);
        const unsigned gen = old / nloc;
        if (old + 1u == (gen + 1u) * nloc) {
            __builtin_amdgcn_fence(__ATOMIC_RELEASE, "agent");
            asm volatile("s_waitcnt vmcnt(0)" ::: "memory");
            const unsigned og = xb_add(&bar[XB_TOP], 1u);
            const unsigned tg = og / nx;
            if (og + 1u == (tg + 1u) * nx) xb_add(&bar[XB_TOPGEN], 1u);
            else XB_SPIN(xb_ld(&bar[XB_TOPGEN]) == tg, bar);
            __builtin_amdgcn_fence(__ATOMIC_ACQUIRE, "agent");
            xb_add(&bar[XB_XGEN(b.x)], 1u);
            asm volatile("s_waitcnt vmcnt(0)" ::: "memory");
        } else {
            XB_SPIN(xb_ld(&bar[XB_XGEN(b.x)]) == gen, bar);
            __builtin_amdgcn_fence(__ATOMIC_ACQUIRE, "agent");
            asm volatile("s_waitcnt vmcnt(0)" ::: "memory");
        }
    }
    __syncthreads();
}

typedef __attribute__((address_space(4))) const Params* KParamsPtr;
__device__ __forceinline__ const Params& fresh_params() {
    KParamsPtr kp = (KParamsPtr)__builtin_amdgcn_kernarg_segment_ptr();
    asm volatile("" : "+s"(kp));
    return *(const Params*)kp;
}
#define PF fresh_params()
__global__ void __launch_bounds__(BLOCK_THREADS, 2) mega(Params p_unused) {
    __shared__ __attribute__((aligned(16))) char lds[LDS_BYTES];
    cg::grid_group grid = cg::this_grid();
    volatile LAS unsigned* st = (volatile LAS unsigned*)(lds + 2 * LDS_MAIN);
    if (threadIdx.x < 16) st[threadIdx.x] = 0u;
    __syncthreads();
    XcdBarrier xb = xcd_barrier_post((unsigned*)PF.ws, st);
    char* hl = lds + half_id() * LDS_MAIN;
    volatile unsigned* uex = (volatile unsigned*)(lds + 2 * LDS_MAIN + 32);

    phaseA(PF, hl);
    if (PF.ws == nullptr) grid.sync();
    xcd_barrier(xb);
    { const Params& q_ = PF; phase_modnorm(q_, q_.x, q_.norm1_g, 0, 1, (bf16_t*)(q_.ws + OFF_H)); };
    xcd_barrier(xb);
    phaseC(PF, lds);
    xcd_barrier(xb);
    for (int task = vblk(); task < 1024; task += vgrid()) phaseG1_task(PF, task, hl);
    for (int task = vblk(); task < 256; task += vgrid()) phaseN1_task(PF, task, hl);
    xcd_barrier(xb);
    phaseG2(PF);
    phaseA2(PF, hl);
    xcd_barrier(xb);
    for (int task = vblk(); task < 2048; task += vgrid()) phaseN2_task(PF, task, hl, (bf16_t*)(PF.ws + OFF_Z) + ZQ_N, ZC, uex, lds);
    for (int task = vblk(); task < 1024; task += vgrid()) phaseG3_task(PF, task, hl, (bf16_t*)(PF.ws + OFF_Z) + ZR_G, ZC);
    xcd_barrier(xb);
    phaseM1(PF, lds);
    xcd_barrier(xb);
    phaseM2(PF, lds);
    xcd_barrier(xb);
    { const Params& q_ = PF; phase_modnorm(q_, q_.out, q_.norm2_g, 3, 4, (bf16_t*)(q_.ws + OFF_H)); };
    xcd_barrier(xb);
    phaseP1(PF, lds);
    xcd_barrier(xb);
    for (int task = vblk(); task < 2048; task += vgrid()) phaseP2_task(PF, task, hl);
    xcd_barrier(xb);
    { const Params& q_ = PF; phaseP3(q_, q_.out, hl); };
}

extern "C" void kernel_launch(void* const* d_in, const int* in_sizes, int n_in, void* d_out, int out_size, void* d_ws, size_t ws_size, hipStream_t stream) {
    Params p{};
    p.x = (const float*)d_in[0]; p.c = (const float*)d_in[1]; p.pos = (const int*)d_in[2]; p.ada_w = (const float*)d_in[3]; p.ada_b = (const float*)d_in[4];
    p.norm1_g = (const float*)d_in[5]; p.norm2_g = (const float*)d_in[6]; p.final_g = (const float*)d_in[7]; p.w_in = (const float*)d_in[8];
    p.gla_wa2 = (const float*)d_in[9]; p.gla_ba2 = (const float*)d_in[10]; p.gla_norm_g = (const float*)d_in[11]; p.pe_k = (const float*)d_in[12]; p.pe_v = (const float*)d_in[13];
    p.ck_w1 = (const float*)d_in[14]; p.ck_w2 = (const float*)d_in[15]; p.cv_w1 = (const float*)d_in[16]; p.cv_w2 = (const float*)d_in[17];
    p.w_branch_a = (const float*)d_in[18]; p.w_branch_b = (const float*)d_in[19]; p.w_out = (const float*)d_in[20]; p.peer_wq = (const float*)d_in[21];
    p.peer_k1 = (const float*)d_in[22]; p.peer_k2 = (const float*)d_in[23]; p.peer_u = (const float*)d_in[24]; p.peer_v = (const float*)d_in[25];
    p.out = (float*)d_out; p.ws = (char*)d_ws;
    static int grid_blocks = 0;
    if (!grid_blocks) {
        int dev = 0, cus = 0, per_cu = 0;
        hipGetDevice(&dev);
        hipDeviceGetAttribute(&cus, hipDeviceAttributeMultiprocessorCount, dev);
        hipOccupancyMaxActiveBlocksPerMultiprocessor(&per_cu, mega, BLOCK_THREADS, 0);
        if (per_cu > 1) per_cu = 1;
        if (per_cu < 1) per_cu = 1;
        grid_blocks = cus * per_cu;
    }
    hipMemsetAsync(d_ws, 0, XCD_BAR_WORDS * 4, stream);
    void* args[] = {&p};
    hipError_t e = hipLaunchCooperativeKernel((void*)mega, dim3(grid_blocks), dim3(BLOCK_THREADS), args, 0, stream);
    if (e != hipSuccess) fprintf(stderr, "cooperative launch failed: %s (grid %d)\n", hipGetErrorString(e), grid_blocks);
}
```

```cpp
#include <hip/hip_runtime.h>
#include <hip/hip_cooperative_groups.h>
#include <stdio.h>
namespace cg = cooperative_groups;
#include <stdint.h>
#include <stddef.h>
#include <math.h>

typedef unsigned short bf16_t;
typedef short bf16x8 __attribute__((ext_vector_type(8)));
typedef float f32x4 __attribute__((ext_vector_type(4)));
typedef unsigned u32x4 __attribute__((ext_vector_type(4)));
typedef unsigned u32x2 __attribute__((ext_vector_type(2)));

constexpr int DM = 1024, NB = 8, SEQ = 2048, NTOK = NB * SEQ;
constexpr int ZC = 4992;
constexpr int ZQ_G = 0, ZK_G = 512, ZV_G = 1024, ZR_G = 2048, ZQ_N = 3072, ZKC = 4096, ZVC = 4224, ZKS = 4352, ZVS = 4480,
              ZKW = 4608, ZVW = 4736, ZGATE = 4864, ZLR = 4912;
constexpr int LDS_MAIN = 73728;
constexpr int LDS_BYTES = 2 * LDS_MAIN + 64;
constexpr int NTHREADS = 256;
constexpr int BLOCK_THREADS = 512;

constexpr size_t OFF_MOD = 16384;
constexpr size_t OFF_ROPE = 212992;
constexpr size_t OFF_CMP = 1261568;
constexpr size_t OFF_DEC = 1785856;
constexpr size_t OFF_K1B = 2310144;
constexpr size_t OFF_WC1 = 2834432;
constexpr size_t OFF_WIN = 4194304;
constexpr size_t OFF_WM = 14417920;
constexpr size_t OFF_WA = 18612224;
constexpr size_t OFF_WB = 20709376;
constexpr size_t OFF_WO = 22806528;
constexpr size_t OFF_WQ = 24903680;
constexpr size_t OFF_H = 29360128;
constexpr size_t OFF_M = 62914560;
constexpr size_t OFF_Z = 96468992;
constexpr size_t OFF_VT = OFF_Z + (size_t)NTOK * ZC * 2;
constexpr size_t OFF_QP = OFF_Z;
constexpr size_t OFF_UB = OFF_Z + 67108864;
constexpr size_t OFF_VB = OFF_UB + 33554432;
constexpr size_t OFF_EIDX = OFF_VB + 33554432;
constexpr size_t OFF_GW = OFF_EIDX + 8388608;

struct Params {
    const float* x; const float* c; const int* pos; const float* ada_w; const float* ada_b;
    const float* norm1_g; const float* norm2_g; const float* final_g; const float* w_in;
    const float* gla_wa2; const float* gla_ba2; const float* gla_norm_g; const float* pe_k; const float* pe_v;
    const float* ck_w1; const float* ck_w2; const float* cv_w1; const float* cv_w2;
    const float* w_branch_a; const float* w_branch_b; const float* w_out; const float* peer_wq;
    const float* peer_k1; const float* peer_k2; const float* peer_u; const float* peer_v;
    float* out; char* ws;
};

__device__ __forceinline__ unsigned f2bf_u(float f) { unsigned u = __float_as_uint(f); return (u + 0x7fffu + ((u >> 16) & 1u)) >> 16; }
__device__ __forceinline__ bf16_t f2bf(float f) { return (bf16_t)f2bf_u(f); }
typedef float f32x2_ __attribute__((ext_vector_type(2)));
typedef __bf16 bf16x2_ __attribute__((ext_vector_type(2)));
__device__ __forceinline__ unsigned pack2(float lo, float hi) {
    const f32x2_ v = {lo, hi};
    return __builtin_bit_cast(unsigned, __builtin_convertvector(v, bf16x2_));
}
__device__ __forceinline__ float bf_lo(unsigned u) { return __uint_as_float(u << 16); }
__device__ __forceinline__ float bf_hi(unsigned u) { return __uint_as_float(u & 0xffff0000u); }
__device__ __forceinline__ float bf2f(bf16_t h) { return __uint_as_float(((unsigned)h) << 16); }
__device__ __forceinline__ float wave_sum(float v) {
#pragma unroll
    for (int o = 32; o > 0; o >>= 1) v += __shfl_xor(v, o, 64);
    return v;
}
__device__ __forceinline__ float wave_max(float v) {
#pragma unroll
    for (int o = 32; o > 0; o >>= 1) v = fmaxf(v, __shfl_xor(v, o, 64));
    return v;
}
__device__ __forceinline__ int launder_i(int x) { asm volatile("" : "+v"(x)); return x; }
#define TIDX (launder_i((int)threadIdx.x) & 255)
#define TIDX512 launder_i((int)threadIdx.x)
__device__ __forceinline__ int half_id() { return __builtin_amdgcn_readfirstlane((int)(threadIdx.x >> 8)); }
__device__ __forceinline__ int vblk() { return (int)blockIdx.x * 2 + half_id(); }
__device__ __forceinline__ int vgrid() { return (int)gridDim.x * 2; }
__device__ __forceinline__ float exp2f_(float x) { return __builtin_amdgcn_exp2f(x); }
__device__ __forceinline__ float sigmoidf_(float x) { return __builtin_amdgcn_rcpf(1.f + __expf(-x)); }
__device__ __forceinline__ float siluf_(float x) { return x * __builtin_amdgcn_rcpf(1.f + __expf(-x)); }
__device__ __forceinline__ float gelu_erf(float x) { return 0.5f * x * (1.f + erff(x * 0.70710678118654752f)); }
__device__ __forceinline__ f32x4 mfma16(bf16x8 a, bf16x8 b, f32x4 c) { return __builtin_amdgcn_mfma_f32_16x16x32_bf16(a, b, c, 0, 0, 0); }
__device__ __forceinline__ bf16x8 ld_frag(const bf16_t* p) { return *(const bf16x8*)p; }
__device__ __forceinline__ bf16x8 mk_frag(u32x2 lo, u32x2 hi) { u32x4 t = {lo.x, lo.y, hi.x, hi.y}; return __builtin_bit_cast(bf16x8, t); }

#define WAIT_V(n) asm volatile("s_waitcnt vmcnt(" #n ")" ::: "memory")
__device__ __forceinline__ int swz4(int R) { return (4 - ((R >> 2) & 3)) & 3; }
__device__ __forceinline__ void glds16(const bf16_t* g, char* l) { __builtin_amdgcn_global_load_lds((const unsigned*)g, (unsigned*)l, 16, 0, 0); }
struct GemmSrc { const bf16_t* xsrc; const bf16_t* wsrc; int ldx, ldw; };
__device__ __forceinline__ GemmSrc gemm_src(const bf16_t* __restrict__ X, int ldx, const bf16_t* __restrict__ W, int ldw, int m0, int n0) {
    const int tid = TIDX512, lane = tid & 63, wave = tid >> 6;
    const int R0 = wave * 32 + (lane >> 2);
    const int sw = ((lane & 3) ^ swz4(R0)) * 8;
    GemmSrc g;
    g.xsrc = X + (size_t)(m0 + R0) * ldx + sw;
    g.wsrc = W + (size_t)(n0 + R0) * ldw + sw;
    g.ldx = ldx; g.ldw = ldw;
    return g;
}
__device__ __forceinline__ void gemm_issue(const GemmSrc& g, int kt, int s, char* lds) {
    const int tid = TIDX512, lane = tid & 63, wave = tid >> 6;
    char* xdst = lds + s * 32768 + wave * 2048 + lane * 16;
    char* wdst = xdst + 16384;
#pragma unroll
    for (int i = 0; i < 2; i++) {
        glds16(g.xsrc + (size_t)i * 16 * g.ldx + kt * 32, xdst + i * 1024);
        glds16(g.wsrc + (size_t)i * 16 * g.ldw + kt * 32, wdst + i * 1024);
    }
}
__device__ __forceinline__ void gemm_prologue(const GemmSrc& g, char* lds) { gemm_issue(g, 0, 0, lds); gemm_issue(g, 1, 1, lds); gemm_issue(g, 2, 2, lds); }
__device__ __forceinline__ void gemm_mainloop(f32x4 (&acc)[8][4], const GemmSrc& g, int K, char* lds) {
    const int tid = TIDX512, lane = tid & 63, wave = tid >> 6;
    const int wr = wave >> 2, wc = wave & 3, r = lane & 15, q = lane >> 4;
    const int KT = K / 32;
    const int rdo = r * 64 + ((q ^ swz4(r)) * 16);
    for (int kt = 0; kt < KT; kt++) {
        if (kt + 2 < KT) WAIT_V(8); else if (kt + 1 < KT) WAIT_V(4); else WAIT_V(0);
        __builtin_amdgcn_s_barrier();
        if (kt + 3 < KT) gemm_issue(g, kt + 3, (kt + 3) & 3, lds);
        const char* st = lds + (kt & 3) * 32768;
        bf16x8 af[4], bfr[8];
#pragma unroll
        for (int ni = 0; ni < 4; ni++) af[ni] = *(const bf16x8*)(st + 16384 + (wc * 64 + ni * 16) * 64 + rdo);
#pragma unroll
        for (int mi = 0; mi < 8; mi++) bfr[mi] = *(const bf16x8*)(st + (wr * 128 + mi * 16) * 64 + rdo);
#pragma unroll
        for (int mi = 0; mi < 8; mi++)
#pragma unroll
            for (int ni = 0; ni < 4; ni++) acc[mi][ni] = mfma16(af[ni], bfr[mi], acc[mi][ni]);
        __builtin_amdgcn_sched_barrier(0);
    }
}
__device__ __forceinline__ void gemm_core(f32x4 (&acc)[8][4], const bf16_t* __restrict__ X, int ldx, const bf16_t* __restrict__ W, int ldw,
                                          int K, int m0, int n0, char* lds) {
    const GemmSrc g = gemm_src(X, ldx, W, ldw, m0, n0);
    gemm_prologue(g, lds);
    gemm_mainloop(acc, g, K, lds);
    __syncthreads();
}
__device__ __forceinline__ void zero_acc(f32x4 (&acc)[8][4]) {
#pragma unroll
    for (int a = 0; a < 8; a++)
#pragma unroll
        for (int b = 0; b < 4; b++) acc[a][b] = (f32x4){0.f, 0.f, 0.f, 0.f};
}

constexpr int EPI_ROWB = 528;
__device__ __forceinline__ void epi_fill(char* lds, int wr, int wc, int r, int q, int mi, int ni, f32x4 v) {
    *(u32x2*)(lds + (wr * 128 + mi * 16 + r) * EPI_ROWB + (wc * 64 + ni * 16 + 4 * q) * 2) = (u32x2){pack2(v[0], v[1]), pack2(v[2], v[3])};
}
__device__ __forceinline__ void epi_store(const char* lds, bf16_t* __restrict__ O, int ldo, int m0, int n0, int ncols_valid) {
    const int t = TIDX512;
    const int chunk = t & 31, rsub = t >> 5;
    if (n0 + chunk * 8 < ncols_valid) {
#pragma unroll
        for (int ps = 0; ps < 16; ps++) {
            const int row = ps * 16 + rsub;
            const u32x4 v = *(const u32x4*)(lds + row * EPI_ROWB + chunk * 16);
            *(u32x4*)(O + (size_t)(m0 + row) * ldo + n0 + chunk * 8) = v;
        }
    }
}

struct TileIter {
    int nt, i, x, li; bool fancy;
    __device__ TileIter(int ntiles_n, const char*) { nt = ntiles_n; fancy = (gridDim.x == 256) && ((nt & 3) == 0); x = blockIdx.x & 7; li = blockIdx.x >> 3; i = fancy ? 0 : blockIdx.x; }
    __device__ bool next(int& bm, int& bn) {
        if (fancy) {
            if (i * 4 >= nt) return false;
            bm = x * 8 + (li & 7); bn = i * 4 + (li >> 3); i++; return true;
        }
        if (i >= 64 * nt) return false;
        bn = i % nt; bm = i / nt; i += gridDim.x; return true;
    }
};

struct MapId { __device__ int operator()(int n) const { return n; } };
struct MapWin {
    __device__ int operator()(int n) const { return n < 3072 ? n : (n < 4912 ? n + 16 : (n < 4928 ? n - 1840 : -1)); }
};
struct MapOff { int off; __device__ int operator()(int n) const { return n + off; } };

template <class Map>
__device__ __forceinline__ void tconv_tile(const float* __restrict__ src, int ldsrc, bf16_t* __restrict__ dst, int ldd, int n0, int k0, Map map, float* t) {
    const int tid = TIDX;
    const int n = tid & 63, kb = tid >> 6;
    const int sc = map(n0 + n);
#pragma unroll
    for (int i = 0; i < 16; i++) { const int k = i * 4 + kb; t[k * 65 + n] = sc >= 0 ? src[(size_t)(k0 + k) * ldsrc + sc] : 0.f; }
    __syncthreads();
    const int nn = tid >> 2, kk = (tid & 3) * 16;
    unsigned w[8];
#pragma unroll
    for (int j = 0; j < 8; j++) w[j] = pack2(t[(kk + 2 * j) * 65 + nn], t[(kk + 2 * j + 1) * 65 + nn]);
    u32x4* d = (u32x4*)(dst + (size_t)(n0 + nn) * ldd + k0 + kk);
    d[0] = (u32x4){w[0], w[1], w[2], w[3]};
    d[1] = (u32x4){w[4], w[5], w[6], w[7]};
    __syncthreads();
}

constexpr int TA_MOD = 192, TA_WIN = 78 * 16, TA_WM = 32 * 16, TA_SQ = 16 * 16, TA_WQ = 32 * 16, TA_WC = 32, TA_K12 = 64, TA_ROPE = 512;
constexpr int TA_E0 = TA_MOD, TA_E1 = TA_E0 + TA_WIN, TA_E2 = TA_E1 + TA_WM, TA_E3 = TA_E2 + TA_SQ, TA_E4 = TA_E3 + TA_SQ, TA_E5 = TA_E4 + TA_SQ,
              TA_E6 = TA_E5 + TA_WQ, TA_E7 = TA_E6 + TA_WC, TA_E8 = TA_E7 + TA_WC, TA_E9 = TA_E8 + TA_K12, TA_E10 = TA_E9 + TA_K12, TA_E11 = TA_E10 + TA_ROPE;

__device__ void phaseA(const Params& p, char* lds) {
    const int tid = TIDX;
    float* fl = (float*)lds;
    constexpr int N0 = TA_E1 + (TA_E8 - TA_E6) + (TA_E11 - TA_E10);
    for (int idx = vblk(); idx < N0; idx += vgrid()) {
        const int task = idx < TA_E1 ? idx : (idx < TA_E1 + (TA_E8 - TA_E6) ? idx - TA_E1 + TA_E6 : idx - TA_E1 - (TA_E8 - TA_E6) + TA_E10);
        if (task < TA_E0) {
            float* sc = fl;
            float* red = fl + 8192;
            for (int i = tid; i < 8192; i += NTHREADS) sc[i] = siluf_(p.c[i]);
            __syncthreads();
            const int n = task * 32 + (tid & 31), kg = tid >> 5;
            float a[8];
#pragma unroll
            for (int b = 0; b < 8; b++) a[b] = 0.f;
            for (int k0 = kg * 128; k0 < kg * 128 + 128; k0 += 16) {
                float w[16];
#pragma unroll
                for (int i = 0; i < 16; i++) w[i] = p.ada_w[(size_t)(k0 + i) * 6144 + n];
#pragma unroll
                for (int i = 0; i < 16; i++)
#pragma unroll
                    for (int b = 0; b < 8; b++) a[b] += sc[b * 1024 + k0 + i] * w[i];
            }
#pragma unroll
            for (int b = 0; b < 8; b++) red[(kg * 8 + b) * 32 + (tid & 31)] = a[b];
            __syncthreads();
            {
                const int b = tid >> 5, nn = tid & 31;
                float s = 0.f;
#pragma unroll
                for (int g = 0; g < 8; g++) s += red[(g * 8 + b) * 32 + nn];
                ((float*)(p.ws + OFF_MOD))[b * 6144 + task * 32 + nn] = s + p.ada_b[task * 32 + nn];
            }
            __syncthreads();
        } else if (task < TA_E1) {
            const int tt = task - TA_E0;
            tconv_tile(p.w_in, 6976, (bf16_t*)(p.ws + OFF_WIN), 1024, (tt >> 4) * 64, (tt & 15) * 64, MapWin(), fl);
        } else if (task < TA_E6) {
        } else if (task < TA_E7) {
            const int tt = task - TA_E6;
            tconv_tile(p.ck_w1, 64, (bf16_t*)(p.ws + OFF_WC1), 2048, 0, tt * 64, MapId(), fl);
        } else if (task < TA_E8) {
            const int tt = task - TA_E7;
            tconv_tile(p.cv_w1, 64, (bf16_t*)(p.ws + OFF_WC1) + 64 * 2048, 2048, 0, tt * 64, MapId(), fl);
        } else if (task < TA_E10) {
        } else {
            const int tt = task - TA_E10;
            const int e = tt * 256 + tid;
            const int tok = e >> 3, i = e & 7;
            const float invf[8] = {1.0f, 0.1939227432012558f, 0.03760603070259094f, 0.007292664609849453f,
                                   0.0014142135623842478f, 0.00027424818836152554f, 5.318296098266728e-05f, 1.0313386155758053e-05f};
            float fr = invf[0];
#pragma unroll
            for (int j = 1; j < 8; j++) fr = (i == j) ? invf[j] : fr;
            const float ang = (float)p.pos[tok] * fr;
            const double rev = (double)ang * 0.15915494309189533577;
            const float fpart = (float)(rev - floor(rev));
            float* cs = (float*)(p.ws + OFF_ROPE);
            cs[e * 2] = __builtin_amdgcn_cosf(fpart);
            cs[e * 2 + 1] = __builtin_amdgcn_sinf(fpart);
        }
    }
}

__device__ void phaseA2(const Params& p, char* lds) {
    const int tid = TIDX;
    float* fl = (float*)lds;
    constexpr int N1 = (TA_E6 - TA_E1) + (TA_E10 - TA_E8);
    for (int idx = vblk(); idx < N1; idx += vgrid()) {
        const int task = idx < (TA_E6 - TA_E1) ? idx + TA_E1 : idx - (TA_E6 - TA_E1) + TA_E8;
        if (task < TA_E1) {
        } else if (task < TA_E2) {
            const int tt = task - TA_E1;
            tconv_tile(p.w_in, 6976, (bf16_t*)(p.ws + OFF_WM), 1024, (tt >> 4) * 64, (tt & 15) * 64, MapOff{4928}, fl);
        } else if (task < TA_E3) {
            const int tt = task - TA_E2;
            tconv_tile(p.w_branch_a, 1024, (bf16_t*)(p.ws + OFF_WA), 1024, (tt >> 4) * 64, (tt & 15) * 64, MapId(), fl);
        } else if (task < TA_E4) {
            const int tt = task - TA_E3;
            tconv_tile(p.w_branch_b, 1024, (bf16_t*)(p.ws + OFF_WB), 1024, (tt >> 4) * 64, (tt & 15) * 64, MapId(), fl);
        } else if (task < TA_E5) {
            const int tt = task - TA_E4;
            tconv_tile(p.w_out, 1024, (bf16_t*)(p.ws + OFF_WO), 1024, (tt >> 4) * 64, (tt & 15) * 64, MapId(), fl);
        } else if (task < TA_E6) {
            const int tt = task - TA_E5;
            tconv_tile(p.peer_wq, 2048, (bf16_t*)(p.ws + OFF_WQ), 1024, (tt >> 4) * 64, (tt & 15) * 64, MapId(), fl);
        } else if (task < TA_E10) {
            const bool second = task >= TA_E9;
            const int tt = task - (second ? TA_E9 : TA_E8);
            const float* src = second ? p.peer_k2 : p.peer_k1;
            bf16_t* dst = (bf16_t*)(p.ws + OFF_K1B) + (second ? 131072 : 0);
            const int i = tt * 2048 + tid * 8;
            const f32x4 a = *(const f32x4*)(src + i), b = *(const f32x4*)(src + i + 4);
            *(u32x4*)(dst + i) = (u32x4){pack2(a[0], a[1]), pack2(a[2], a[3]), pack2(b[0], b[1]), pack2(b[2], b[3])};
        }
    }
}

__device__ void phase_modnorm(const Params& p, const float* __restrict__ src, const float* __restrict__ g, int shift_idx, int scale_idx, bf16_t* __restrict__ dst) {
    const int tid_ = TIDX; const int lane = tid_ & 63, wave = tid_ >> 6;
    const float* mod = (const float*)(p.ws + OFF_MOD);
    for (int tok = vblk() * 4 + wave; tok < NTOK; tok += vgrid() * 4) {
        const int b = tok >> 11;
        const float* xr = src + (size_t)tok * DM;
        f32x4 v[4];
        float ss = 0.f;
#pragma unroll
        for (int c = 0; c < 4; c++) { v[c] = *(const f32x4*)(xr + c * 256 + lane * 4); ss += v[c][0] * v[c][0] + v[c][1] * v[c][1] + v[c][2] * v[c][2] + v[c][3] * v[c][3]; }
        ss = wave_sum(ss);
        const float rstd = rsqrtf(ss * (1.f / 1024.f) + 1e-6f);
#pragma unroll
        for (int c = 0; c < 4; c++) {
            const int d = c * 256 + lane * 4;
            const f32x4 gg = *(const f32x4*)(g + d);
            const f32x4 sc = *(const f32x4*)(mod + b * 6144 + scale_idx * 1024 + d);
            const f32x4 sh = *(const f32x4*)(mod + b * 6144 + shift_idx * 1024 + d);
            float o[4];
#pragma unroll
            for (int j = 0; j < 4; j++) o[j] = (v[c][j] * rstd) * gg[j] * (1.f + sc[j]) + sh[j];
            *(u32x2*)(dst + (size_t)tok * DM + d) = (u32x2){pack2(o[0], o[1]), pack2(o[2], o[3])};
        }
    }
}

__device__ void phaseC(const Params& p, char* lds) {
    const int tid_ = TIDX512; const int lane = tid_ & 63, wave = tid_ >> 6;
    const int wr = wave >> 2, wc = wave & 3, r = lane & 15, q = lane >> 4;
    const bf16_t* H = (const bf16_t*)(p.ws + OFF_H);
    const bf16_t* W = (const bf16_t*)(p.ws + OFF_WIN);
    bf16_t* Z = (bf16_t*)(p.ws + OFF_Z);
    const float* cs = (const float*)(p.ws + OFF_ROPE);
    constexpr int NTN = (ZC + 255) / 256;
    TileIter tit(NTN, lds);
    int bm, bn;
    while (tit.next(bm, bn)) {
        const int m0 = bm * 256, n0 = bn * 256;
        f32x4 acc[8][4];
        zero_acc(acc);
        gemm_core(acc, H, DM, W, DM, DM, m0, n0, lds);
        const int c0 = n0 + wc * 64;
        const bool isq = (c0 >= ZQ_N && c0 < ZKC);
        const bool rope = isq || (c0 >= ZKC && c0 < ZGATE && ((c0 - ZKC) & 255) < 128);
        const float scl = isq ? 0.18033688011112042f : 1.f;
#pragma unroll
        for (int mi = 0; mi < 8; mi++) {
            const int tok = m0 + wr * 128 + mi * 16 + r;
            if (rope) {
                f32x4 v = acc[mi][0];
                f32x4 pr;
#pragma unroll
                for (int j = 0; j < 4; j++) pr[j] = __shfl_xor(v[j], 32, 64);
                const int ib = (q & 1) * 4;
                const f32x4 k0 = *(const f32x4*)(cs + (size_t)tok * 16 + ib * 2);
                const f32x4 k1 = *(const f32x4*)(cs + (size_t)tok * 16 + ib * 2 + 4);
                const float cc[4] = {k0[0], k0[2], k1[0], k1[2]}, sn[4] = {k0[1], k0[3], k1[1], k1[3]};
#pragma unroll
                for (int j = 0; j < 4; j++) v[j] = (q < 2) ? (v[j] * cc[j] - pr[j] * sn[j]) : (v[j] * cc[j] + pr[j] * sn[j]);
                acc[mi][0] = v;
            }
#pragma unroll
            for (int ni = 0; ni < 4; ni++) epi_fill(lds, wr, wc, r, q, mi, ni, acc[mi][ni] * scl);
        }
        if ((c0 >= ZVS && c0 < ZVS + 128) || (c0 >= ZVW && c0 < ZVW + 128)) {
            const int brn = c0 >= ZVW ? 1 : 0, gg = ((c0 - (brn ? ZVW : ZVS)) >> 6) & 1;
            const int bb = m0 >> 11, ts = (m0 & 2047) + wr * 128 + r;
            bf16_t* vt = (bf16_t*)(p.ws + OFF_VT) + ((size_t)((brn * 8 + bb) * 2 + gg) * 64) * SEQ + ts;
#pragma unroll
            for (int mi = 0; mi < 8; mi++)
#pragma unroll
                for (int ni = 0; ni < 4; ni++)
#pragma unroll
                    for (int j = 0; j < 4; j++) vt[(size_t)(ni * 16 + 4 * q + j) * SEQ + mi * 16] = f2bf(acc[mi][ni][j]);
        }
        __syncthreads();
        epi_store(lds, Z, ZC, m0, n0, ZC);
        __syncthreads();
    }
}

__device__ __forceinline__ void gla_prep(const Params& p, int tok0, int h, char* lds) {
    const int tid = TIDX;
    float* bc = (float*)lds;
    float* lrs = (float*)(lds + 32768);
    const bf16_t* Z = (const bf16_t*)(p.ws + OFF_Z);
    for (int i = tid; i < 1024; i += NTHREADS) { const int t = i >> 4, rr = i & 15; lrs[i] = bf2f(Z[(size_t)(tok0 + t) * ZC + ZLR + rr]); }
    const int d = tid & 127, th = tid >> 7;
    float w[16];
#pragma unroll
    for (int rr = 0; rr < 16; rr++) w[rr] = p.gla_wa2[rr * 512 + h * 128 + d];
    const float bias = p.gla_ba2[h * 128 + d];
    __syncthreads();
    float run = 0.f;
    for (int t = th * 32; t < th * 32 + 32; t++) {
        float xv = bias;
#pragma unroll
        for (int rr = 0; rr < 16; rr++) xv += lrs[t * 16 + rr] * w[rr];
        const float ls = fminf(xv, 0.f) - log1pf(__expf(-fabsf(xv)));
        run += ls * (1.f / 16.f);
        bc[t * 128 + d] = run;
    }
    __syncthreads();
    if (th == 1) {
        const float add = bc[31 * 128 + d];
        for (int t = 32; t < 64; t++) bc[t * 128 + d] += add;
    }
    __syncthreads();
}

__device__ void phaseG1_task(const Params& p, int task, char* lds) {
    const int tid = TIDX, lane = tid & 63, wave = tid >> 6, r = lane & 15, q = lane >> 4;
    const int c = task & 31, h = (task >> 5) & 3, b = task >> 7;
    const int tok0 = b * SEQ + c * 64;
    const bf16_t* Z = (const bf16_t*)(p.ws + OFF_Z);
    bf16_t* L = (bf16_t*)p.out;
    float* bc = (float*)lds;
    bf16_t* klT = (bf16_t*)(lds + 36864);
    bf16_t* vT = (bf16_t*)(lds + 36864 + 18432);
    gla_prep(p, tok0, h, lds);
    if (tid < 128) ((float*)(p.ws + OFF_DEC))[task * 128 + tid] = __expf(bc[63 * 128 + tid]);
    {
        f32x4* bg = (f32x4*)(p.ws + OFF_M) + (size_t)task * 2048;
#pragma unroll
        for (int i = 0; i < 8; i++) bg[i * 256 + tid] = ((const f32x4*)bc)[i * 256 + tid];
    }
    {
        const int s = lane, dc = wave * 32;
        const bf16_t* kp = Z + (size_t)(tok0 + s) * ZC + ZK_G + h * 128 + dc;
#pragma unroll
        for (int v4 = 0; v4 < 4; v4++) {
            const u32x4 kv = *(const u32x4*)(kp + v4 * 8);
            const unsigned kw[4] = {kv.x, kv.y, kv.z, kv.w};
#pragma unroll
            for (int j = 0; j < 8; j++) {
                const int d = dc + v4 * 8 + j;
                const float kval = (j & 1) ? bf_hi(kw[j >> 1]) : bf_lo(kw[j >> 1]);
                klT[d * 72 + s] = f2bf(kval * __expf(bc[63 * 128 + d] - bc[s * 128 + d]));
            }
        }
    }
    for (int eh = 0; eh < 2; eh++) {
        __syncthreads();
        {
            const int s = lane, ec = wave * 32;
            const bf16_t* vp = Z + (size_t)(tok0 + s) * ZC + ZV_G + h * 256 + eh * 128 + ec;
#pragma unroll
            for (int v4 = 0; v4 < 4; v4++) {
                const u32x4 vv = *(const u32x4*)(vp + v4 * 8);
                const unsigned vw[4] = {vv.x, vv.y, vv.z, vv.w};
#pragma unroll
                for (int j = 0; j < 8; j++) vT[(ec + v4 * 8 + j) * 72 + s] = (bf16_t)((j & 1) ? (vw[j >> 1] >> 16) : (vw[j >> 1] & 0xffffu));
            }
        }
        __syncthreads();
        f32x4 acc[8][2];
#pragma unroll
        for (int dt = 0; dt < 8; dt++) { acc[dt][0] = (f32x4){0.f, 0.f, 0.f, 0.f}; acc[dt][1] = (f32x4){0.f, 0.f, 0.f, 0.f}; }
#pragma unroll
        for (int ks = 0; ks < 2; ks++) {
            bf16x8 bv[2];
#pragma unroll
            for (int x = 0; x < 2; x++) bv[x] = ld_frag(vT + ((2 * wave + x) * 16 + r) * 72 + ks * 32 + q * 8);
#pragma unroll
            for (int dt = 0; dt < 8; dt++) {
                const bf16x8 a = ld_frag(klT + (dt * 16 + r) * 72 + ks * 32 + q * 8);
#pragma unroll
                for (int x = 0; x < 2; x++) acc[dt][x] = mfma16(a, bv[x], acc[dt][x]);
            }
        }
#pragma unroll
        for (int dt = 0; dt < 8; dt++)
#pragma unroll
            for (int x = 0; x < 2; x++) {
                const int e = eh * 128 + (2 * wave + x) * 16 + r, d = dt * 16 + 4 * q;
                const f32x4 v = acc[dt][x];
                *(u32x2*)(L + ((size_t)task * 256 + e) * 128 + d) = (u32x2){pack2(v[0], v[1]), pack2(v[2], v[3])};
            }
    }
    __syncthreads();
}

__device__ void phaseG2(const Params& p) {
    bf16_t* L = (bf16_t*)p.out;
    const float* dec = (const float*)(p.ws + OFF_DEC);
    for (int idx = vblk() * NTHREADS + (int)(threadIdx.x & 255); idx < 32 * 256 * 16; idx += vgrid() * NTHREADS) {
        const int d8 = idx & 15, e = (idx >> 4) & 255, bh = idx >> 12;
        float st[8];
#pragma unroll
        for (int j = 0; j < 8; j++) st[j] = 0.f;
        for (int c = 0; c < 32; c++) {
            const int task = bh * 32 + c;
            u32x4* ptr = (u32x4*)(L + ((size_t)task * 256 + e) * 128 + d8 * 8);
            const u32x4 lv = *ptr;
            const f32x4 d0 = *(const f32x4*)(dec + task * 128 + d8 * 8), d1 = *(const f32x4*)(dec + task * 128 + d8 * 8 + 4);
            *ptr = (u32x4){pack2(st[0], st[1]), pack2(st[2], st[3]), pack2(st[4], st[5]), pack2(st[6], st[7])};
            st[0] = d0[0] * st[0] + bf_lo(lv.x); st[1] = d0[1] * st[1] + bf_hi(lv.x);
            st[2] = d0[2] * st[2] + bf_lo(lv.y); st[3] = d0[3] * st[3] + bf_hi(lv.y);
            st[4] = d1[0] * st[4] + bf_lo(lv.z); st[5] = d1[1] * st[5] + bf_hi(lv.z);
            st[6] = d1[2] * st[6] + bf_lo(lv.w); st[7] = d1[3] * st[7] + bf_hi(lv.w);
        }
    }
}

__device__ void phaseG3_task(const Params& p, int task, char* lds, bf16_t* ydst, int ystride) {
    const int tid = TIDX, lane = tid & 63, wave = tid >> 6, r = lane & 15, q = lane >> 4;
    const int c = task & 31, h = (task >> 5) & 3, b = task >> 7;
    const int tok0 = b * SEQ + c * 64;
    bf16_t* Z = (bf16_t*)(p.ws + OFF_Z);
    const bf16_t* ST = (const bf16_t*)p.out + (size_t)task * 256 * 128;
    float* bc = (float*)lds;
    bf16_t* vT = (bf16_t*)lds;
    bf16_t* qg = (bf16_t*)(lds + 36864);
    bf16_t* kg = (bf16_t*)(lds + 36864 + 17408);
    bf16_t* P = kg;
    float* red = (float*)(lds + 36864 + 2 * 17408);
    {
        const f32x4* bg = (const f32x4*)(p.ws + OFF_M) + (size_t)task * 2048;
#pragma unroll
        for (int i = 0; i < 8; i++) ((f32x4*)bc)[i * 256 + tid] = bg[i * 256 + tid];
    }
    __syncthreads();
    {
        const int t = tid >> 2, dc = (tid & 3) * 32;
        const bf16_t* qp = Z + (size_t)(tok0 + t) * ZC + ZQ_G + h * 128 + dc;
        const bf16_t* kp = Z + (size_t)(tok0 + t) * ZC + ZK_G + h * 128 + dc;
#pragma unroll
        for (int v4 = 0; v4 < 4; v4++) {
            const u32x4 qv = *(const u32x4*)(qp + v4 * 8), kv = *(const u32x4*)(kp + v4 * 8);
            const unsigned qw[4] = {qv.x, qv.y, qv.z, qv.w}, kw[4] = {kv.x, kv.y, kv.z, kv.w};
            unsigned qo[4], ko[4];
#pragma unroll
            for (int j2 = 0; j2 < 4; j2++) {
                const int d = dc + v4 * 8 + j2 * 2;
                const float b0 = bc[t * 128 + d], b1 = bc[t * 128 + d + 1];
                qo[j2] = pack2(bf_lo(qw[j2]) * 0.08838834764831845f * __expf(b0), bf_hi(qw[j2]) * 0.08838834764831845f * __expf(b1));
                ko[j2] = pack2(bf_lo(kw[j2]) * __expf(-b0), bf_hi(kw[j2]) * __expf(-b1));
            }
            *(u32x4*)(qg + t * 136 + dc + v4 * 8) = (u32x4){qo[0], qo[1], qo[2], qo[3]};
            *(u32x4*)(kg + t * 136 + dc + v4 * 8) = (u32x4){ko[0], ko[1], ko[2], ko[3]};
        }
    }
    __syncthreads();
    {
        const int s = lane, ec = wave * 64;
        const bf16_t* vp = Z + (size_t)(tok0 + s) * ZC + ZV_G + h * 256 + ec;
#pragma unroll
        for (int v4 = 0; v4 < 8; v4++) {
            const u32x4 vv = *(const u32x4*)(vp + v4 * 8);
            const unsigned vw[4] = {vv.x, vv.y, vv.z, vv.w};
#pragma unroll
            for (int j = 0; j < 8; j++) vT[(ec + v4 * 8 + j) * 72 + s] = (bf16_t)((j & 1) ? (vw[j >> 1] >> 16) : (vw[j >> 1] & 0xffffu));
        }
    }
    f32x4 sc[4];
#pragma unroll
    for (int st = 0; st < 4; st++) sc[st] = (f32x4){0.f, 0.f, 0.f, 0.f};
    {
        bf16x8 qf[4];
#pragma unroll
        for (int ks = 0; ks < 4; ks++) qf[ks] = ld_frag(qg + (wave * 16 + r) * 136 + ks * 32 + q * 8);
#pragma unroll
        for (int st = 0; st < 4; st++) {
            if (st <= wave) {
#pragma unroll
                for (int ks = 0; ks < 4; ks++) sc[st] = mfma16(ld_frag(kg + (st * 16 + r) * 136 + ks * 32 + q * 8), qf[ks], sc[st]);
            }
        }
    }
    __syncthreads();
    {
        const int t = wave * 16 + r;
#pragma unroll
        for (int st = 0; st < 4; st++) {
            float pv[4];
#pragma unroll
            for (int j = 0; j < 4; j++) { const int s = st * 16 + 4 * q + j; pv[j] = (s <= t) ? sc[st][j] : 0.f; }
            *(u32x2*)(P + t * 72 + st * 16 + 4 * q) = (u32x2){pack2(pv[0], pv[1]), pack2(pv[2], pv[3])};
        }
    }
    __syncthreads();
    f32x4 o[4][4];
#pragma unroll
    for (int et = 0; et < 4; et++)
#pragma unroll
        for (int tt = 0; tt < 4; tt++) o[et][tt] = (f32x4){0.f, 0.f, 0.f, 0.f};
#pragma unroll
    for (int ks = 0; ks < 2; ks++) {
        bf16x8 pf[4];
#pragma unroll
        for (int tt = 0; tt < 4; tt++) pf[tt] = ld_frag(P + (tt * 16 + r) * 72 + ks * 32 + q * 8);
#pragma unroll
        for (int et = 0; et < 4; et++) {
            const bf16x8 a = ld_frag(vT + ((wave * 4 + et) * 16 + r) * 72 + ks * 32 + q * 8);
#pragma unroll
            for (int tt = 0; tt < 4; tt++) o[et][tt] = mfma16(a, pf[tt], o[et][tt]);
        }
    }
#pragma unroll
    for (int ks = 0; ks < 4; ks++) {
        bf16x8 qf[4];
#pragma unroll
        for (int tt = 0; tt < 4; tt++) qf[tt] = ld_frag(qg + (tt * 16 + r) * 136 + ks * 32 + q * 8);
#pragma unroll
        for (int et = 0; et < 4; et++) {
            const bf16x8 a = *(const bf16x8*)(ST + (size_t)((wave * 4 + et) * 16 + r) * 128 + ks * 32 + q * 8);
#pragma unroll
            for (int tt = 0; tt < 4; tt++) o[et][tt] = mfma16(a, qf[tt], o[et][tt]);
        }
    }
#pragma unroll
    for (int tt = 0; tt < 4; tt++) {
        float ss = 0.f;
#pragma unroll
        for (int et = 0; et < 4; et++)
#pragma unroll
            for (int j = 0; j < 4; j++) ss += o[et][tt][j] * o[et][tt][j];
        ss += __shfl_xor(ss, 16, 64);
        ss += __shfl_xor(ss, 32, 64);
        if (q == 0) red[wave * 64 + tt * 16 + r] = ss;
    }
    __syncthreads();
#pragma unroll
    for (int tt = 0; tt < 4; tt++) {
        const int t = tt * 16 + r;
        const float tot = red[t] + red[64 + t] + red[128 + t] + red[192 + t];
        const float rstd = rsqrtf(tot * (1.f / 256.f) + 1e-6f);
#pragma unroll
        for (int et = 0; et < 4; et++) {
            const int e = (wave * 4 + et) * 16 + 4 * q;
            bf16_t* rp = Z + (size_t)(tok0 + t) * ZC + ZR_G + h * 256 + e;
            const u32x2 rv = *(const u32x2*)rp;
            const f32x4 gn = *(const f32x4*)(p.gla_norm_g + e);
            const float r0 = bf_lo(rv.x), r1 = bf_hi(rv.x), r2 = bf_lo(rv.y), r3 = bf_hi(rv.y);
            const f32x4 ov = o[et][tt];
            *(u32x2*)(ydst + (size_t)(tok0 + t) * ystride + h * 256 + e) = (u32x2){pack2(ov[0] * rstd * gn[0] * siluf_(r0), ov[1] * rstd * gn[1] * siluf_(r1)),
                                  pack2(ov[2] * rstd * gn[2] * siluf_(r2), ov[3] * rstd * gn[3] * siluf_(r3))};
        }
    }
    __syncthreads();
}

__device__ void phaseN1_task(const Params& p, int task, char* lds) {
    const int tid = TIDX, lane = tid & 63, wave = tid >> 6, r = lane & 15, q = lane >> 4;
    const int it = task & 15, g = (task >> 4) & 1, b = (task >> 5) & 7, kv = task >> 8;
    const bf16_t* Z = (const bf16_t*)(p.ws + OFF_Z);
    const bf16_t* W1 = (const bf16_t*)(p.ws + OFF_WC1) + (size_t)kv * 64 * 2048;
    const float* pe = kv ? p.pe_v : p.pe_k;
    const float* w2 = kv ? p.cv_w2 : p.ck_w2;
    const int zoff = (kv ? ZVC : ZKC) + g * 64;
    float* hid = (float*)lds;
    float* hid2 = (float*)(lds + 16384);
    int i = it * 8 + (r & 7); if (i > 126) i = 126;
    f32x4 acc[4];
#pragma unroll
    for (int nt = 0; nt < 4; nt++) acc[nt] = (f32x4){0.f, 0.f, 0.f, 0.f};
    for (int ks = 0; ks < 16; ks++) {
        const int k = wave * 512 + ks * 32 + q * 8;
        const int l = k >> 6, d = k & 63;
        const u32x4 zv = *(const u32x4*)(Z + (size_t)(b * SEQ + i * 16 + l) * ZC + zoff + d);
        const f32x4 p0 = *(const f32x4*)(pe + l * 64 + d), p1 = *(const f32x4*)(pe + l * 64 + d + 4);
        const u32x4 av = {pack2(bf_lo(zv.x) + p0[0], bf_hi(zv.x) + p0[1]), pack2(bf_lo(zv.y) + p0[2], bf_hi(zv.y) + p0[3]),
                          pack2(bf_lo(zv.z) + p1[0], bf_hi(zv.z) + p1[1]), pack2(bf_lo(zv.w) + p1[2], bf_hi(zv.w) + p1[3])};
        const bf16x8 a = __builtin_bit_cast(bf16x8, av);
#pragma unroll
        for (int nt = 0; nt < 4; nt++) {
            const bf16x8 bw = *(const bf16x8*)(W1 + (size_t)(nt * 16 + r) * 2048 + k);
            acc[nt] = mfma16(a, bw, acc[nt]);
        }
    }
#pragma unroll
    for (int nt = 0; nt < 4; nt++)
#pragma unroll
        for (int j = 0; j < 4; j++) hid[(wave * 16 + 4 * q + j) * 64 + nt * 16 + r] = acc[nt][j];
    __syncthreads();
    for (int e = tid; e < 1024; e += NTHREADS) hid2[e] = gelu_erf(hid[e] + hid[1024 + e] + hid[2048 + e] + hid[3072 + e]);
    __syncthreads();
    {
        const int il = tid >> 4, n2 = (tid & 15) * 4;
        f32x4 o = {0.f, 0.f, 0.f, 0.f};
        for (int n = 0; n < 64; n++) {
            const float hv = hid2[il * 64 + n];
            const f32x4 wv = *(const f32x4*)(w2 + n * 64 + n2);
            o += hv * wv;
        }
        const int ig = it * 8 + il;
        if (ig >= 127) o = (f32x4){0.f, 0.f, 0.f, 0.f};
        bf16_t* dst = (bf16_t*)(p.ws + OFF_CMP) + ((size_t)((kv * 8 + b) * 2 + g) * 128 + ig) * 64 + n2;
        if (il < 8) *(u32x2*)dst = (u32x2){pack2(o[0], o[1]), pack2(o[2], o[3])};
    }
    __syncthreads();
}

__device__ __forceinline__ void nsa_block_step(const bf16_t* Ks, const bf16_t* VT, const bf16x8 (&qf)[2][2], f32x4 (&O)[2][4], float (&m)[2], float (&l)[2],
                                               int klo, int khi, int r, int q) {
    f32x4 s[2][4];
#pragma unroll
    for (int x = 0; x < 2; x++)
#pragma unroll
        for (int kt = 0; kt < 4; kt++) s[x][kt] = (f32x4){0.f, 0.f, 0.f, 0.f};
#pragma unroll
    for (int kt = 0; kt < 4; kt++)
#pragma unroll
        for (int ks = 0; ks < 2; ks++) {
            const bf16x8 kf = ld_frag(Ks + (kt * 16 + r) * 64 + (((ks * 4 + q) ^ (r & 7)) * 8));
#pragma unroll
            for (int x = 0; x < 2; x++) s[x][kt] = mfma16(kf, qf[x][ks], s[x][kt]);
        }
    if (!__all((klo <= 0) && (khi >= 63))) {
        const int a = 4 * q - klo;
        const unsigned range = (unsigned)(khi - klo);
        const bool any = khi >= klo;
#pragma unroll
        for (int kt = 0; kt < 4; kt++)
#pragma unroll
            for (int j = 0; j < 4; j++) {
                const bool valid = any && ((unsigned)(kt * 16 + j + a) <= range);
#pragma unroll
                for (int x = 0; x < 2; x++) s[x][kt][j] = valid ? s[x][kt][j] : -3.0e38f;
            }
    }
    bf16x8 pbv[2][2];
#pragma unroll
    for (int x = 0; x < 2; x++) {
        float mx = fmaxf(fmaxf(fmaxf(s[x][0][0], s[x][0][1]), fmaxf(s[x][0][2], s[x][0][3])), fmaxf(fmaxf(s[x][1][0], s[x][1][1]), fmaxf(s[x][1][2], s[x][1][3])));
        mx = fmaxf(mx, fmaxf(fmaxf(fmaxf(s[x][2][0], s[x][2][1]), fmaxf(s[x][2][2], s[x][2][3])), fmaxf(fmaxf(s[x][3][0], s[x][3][1]), fmaxf(s[x][3][2], s[x][3][3]))));
        mx = fmaxf(mx, __shfl_xor(mx, 16, 64));
        mx = fmaxf(mx, __shfl_xor(mx, 32, 64));
        const float mnew = fmaxf(m[x], mx);
        const float alpha = exp2f_(m[x] - mnew);
        m[x] = mnew;
        float ls = 0.f;
#pragma unroll
        for (int kt = 0; kt < 4; kt++)
#pragma unroll
            for (int j = 0; j < 4; j++) { const float pv = exp2f_(s[x][kt][j] - mnew); s[x][kt][j] = pv; ls += pv; }
        l[x] = l[x] * alpha + ls;
#pragma unroll
        for (int dt = 0; dt < 4; dt++) O[x][dt] *= alpha;
#pragma unroll
        for (int s2 = 0; s2 < 2; s2++) {
            const u32x4 t4 = {pack2(s[x][2 * s2][0], s[x][2 * s2][1]), pack2(s[x][2 * s2][2], s[x][2 * s2][3]),
                              pack2(s[x][2 * s2 + 1][0], s[x][2 * s2 + 1][1]), pack2(s[x][2 * s2 + 1][2], s[x][2 * s2 + 1][3])};
            pbv[x][s2] = __builtin_bit_cast(bf16x8, t4);
        }
    }
#pragma unroll
    for (int s2 = 0; s2 < 2; s2++)
#pragma unroll
        for (int dt = 0; dt < 4; dt++) {
            const u32x2 lo = *(const u32x2*)(VT + (dt * 16 + r) * 72 + (2 * s2) * 16 + 4 * q);
            const u32x2 hi = *(const u32x2*)(VT + (dt * 16 + r) * 72 + (2 * s2 + 1) * 16 + 4 * q);
            const bf16x8 va = mk_frag(lo, hi);
#pragma unroll
            for (int x = 0; x < 2; x++) O[x][dt] = mfma16(va, pbv[x][s2], O[x][dt]);
        }
}

__device__ __forceinline__ void nsa_cmp_probs(const bf16_t* Kc, const bf16x8 (&qfx)[2], int nv, int r, int q, f32x4 (&s)[8]) {
#pragma unroll
    for (int kt = 0; kt < 8; kt++) s[kt] = (f32x4){0.f, 0.f, 0.f, 0.f};
#pragma unroll
    for (int kt = 0; kt < 8; kt++)
#pragma unroll
        for (int ks = 0; ks < 2; ks++) s[kt] = mfma16(ld_frag(Kc + (kt * 16 + r) * 72 + ks * 32 + q * 8), qfx[ks], s[kt]);
    float mx = -1e30f;
#pragma unroll
    for (int kt = 0; kt < 8; kt++)
#pragma unroll
        for (int j = 0; j < 4; j++) if (kt * 16 + 4 * q + j < nv) mx = fmaxf(mx, s[kt][j]);
    mx = fmaxf(mx, __shfl_xor(mx, 16, 64));
    mx = fmaxf(mx, __shfl_xor(mx, 32, 64));
    float ls = 0.f;
#pragma unroll
    for (int kt = 0; kt < 8; kt++)
#pragma unroll
        for (int j = 0; j < 4; j++) {
            const float pv = (kt * 16 + 4 * q + j < nv) ? exp2f_(s[kt][j] - mx) : 0.f;
            s[kt][j] = pv; ls += pv;
        }
    ls += __shfl_xor(ls, 16, 64);
    ls += __shfl_xor(ls, 32, 64);
    const float inv = nv > 0 ? 1.f / ls : 0.f;
#pragma unroll
    for (int kt = 0; kt < 8; kt++) s[kt] *= inv;
}

__device__ void phaseN2_task(const Params& p, int task, char* lds, bf16_t* ydst, int ystride, volatile unsigned* uex, char* ldsb) {
    const int tid = TIDX, lane = tid & 63, wave = tid >> 6, r = lane & 15, q = lane >> 4;
    const int t512 = tid + half_id() * 256;
    const int pair = task >> 1, g = pair & 1, b = (pair >> 1) & 7;
    const int tt = (63 - (pair >> 4)) * 2 + (task & 1);
    const int t0 = tt * 16, t = t0 + r;
    const int cur = t0 >> 6;
    bf16_t* Z = (bf16_t*)(p.ws + OFF_Z);
    const size_t rowb = (size_t)b * SEQ;
    bf16_t* Kc = (bf16_t*)ldsb;
    bf16_t* VcT = (bf16_t*)(ldsb + 18432);
    bf16_t* Ks = (bf16_t*)ldsb;
    bf16_t* VT = (bf16_t*)(ldsb + 18432);
    float* impw = (float*)(lds + 35840);
    float* scs = (float*)(lds + 35840 + 32768);
    unsigned* selm = (unsigned*)(lds + 35840 + 32768 + 2048);

    bf16x8 qf[2][2];
#pragma unroll
    for (int x = 0; x < 2; x++)
#pragma unroll
        for (int ks = 0; ks < 2; ks++) qf[x][ks] = *(const bf16x8*)(Z + (rowb + t) * ZC + ZQ_N + (g * 8 + 2 * wave + x) * 64 + ks * 32 + q * 8);
    f32x4* ofl = (f32x4*)(lds + 35840);

    f32x4 Og[2][4];
    {
        const bf16_t* kc = (const bf16_t*)(p.ws + OFF_CMP) + (size_t)((0 * 8 + b) * 2 + g) * 128 * 64;
        const bf16_t* vc = (const bf16_t*)(p.ws + OFF_CMP) + (size_t)((1 * 8 + b) * 2 + g) * 128 * 64;
        {
            const int key = t512 >> 2, ch = (t512 & 3) * 16;
#pragma unroll
            for (int v4 = 0; v4 < 2; v4++) *(u32x4*)(Kc + key * 72 + ch + v4 * 8) = *(const u32x4*)(kc + key * 64 + ch + v4 * 8);
            const int k2 = t512 & 127, dc = (t512 >> 7) * 16;
#pragma unroll
            for (int v4 = 0; v4 < 2; v4++) {
                const u32x4 a = *(const u32x4*)(vc + k2 * 64 + dc + v4 * 8);
                const unsigned w[4] = {a.x, a.y, a.z, a.w};
#pragma unroll
                for (int j = 0; j < 8; j++) VcT[(dc + v4 * 8 + j) * 136 + k2] = (bf16_t)((j & 1) ? (w[j >> 1] >> 16) : (w[j >> 1] & 0xffffu));
            }
        }
        __syncthreads();
        int nv = t >= 31 ? ((t - 31) >> 4) + 1 : 0;
        if (nv > 127) nv = 127;
        f32x4 isum[8];
#pragma unroll
        for (int kt = 0; kt < 8; kt++) isum[kt] = (f32x4){0.f, 0.f, 0.f, 0.f};
#pragma unroll
        for (int x = 0; x < 2; x++) {
            f32x4 s[8];
            nsa_cmp_probs(Kc, qf[x], nv, r, q, s);
#pragma unroll
            for (int kt = 0; kt < 8; kt++) isum[kt] += s[kt];
            f32x4 Oc[4];
#pragma unroll
            for (int dt = 0; dt < 4; dt++) Oc[dt] = (f32x4){0.f, 0.f, 0.f, 0.f};
            __builtin_amdgcn_sched_barrier(0);
#pragma unroll
            for (int s2 = 0; s2 < 4; s2++) {
                const u32x4 t4 = {pack2(s[2 * s2][0], s[2 * s2][1]), pack2(s[2 * s2][2], s[2 * s2][3]),
                                  pack2(s[2 * s2 + 1][0], s[2 * s2 + 1][1]), pack2(s[2 * s2 + 1][2], s[2 * s2 + 1][3])};
                const bf16x8 pbv = __builtin_bit_cast(bf16x8, t4);
#pragma unroll
                for (int dt = 0; dt < 4; dt++) {
                    const u32x2 lo = *(const u32x2*)(VcT + (dt * 16 + r) * 136 + (2 * s2) * 16 + 4 * q);
                    const u32x2 hi = *(const u32x2*)(VcT + (dt * 16 + r) * 136 + (2 * s2 + 1) * 16 + 4 * q);
                    Oc[dt] = mfma16(mk_frag(lo, hi), pbv, Oc[dt]);
                }
            }
            const float g0 = sigmoidf_(bf2f(Z[(rowb + t) * ZC + ZGATE + 0 * 16 + g * 8 + 2 * wave + x]));
#pragma unroll
            for (int dt = 0; dt < 4; dt++) Og[x][dt] = g0 * Oc[dt];
            __builtin_amdgcn_sched_barrier(0);
        }
#pragma unroll
        for (int kt = 0; kt < 8; kt++) *(f32x4*)(impw + (wave * 16 + r) * 128 + kt * 16 + 4 * q) = isum[kt];
        __syncthreads();
#pragma unroll
        for (int pass = 0; pass < 2; pass++) {
            const int tk = pass * 8 + (tid >> 5), j = tid & 31;
            const int i0 = j == 0 ? 0 : 4 * j - 1, i1 = (4 * j + 3 > 126) ? 126 : 4 * j + 3;
            float sc = 0.f;
            for (int i = i0; i <= i1; i++) sc += (impw[(0 * 16 + tk) * 128 + i] + impw[(1 * 16 + tk) * 128 + i]) + (impw[(2 * 16 + tk) * 128 + i] + impw[(3 * 16 + tk) * 128 + i]);
            const bool forced = (j == 0) || (j == cur) || (j == cur - 1);
            scs[tk * 32 + j] = forced ? 1e6f : (j <= cur ? sc : -1.f);
        }
        __syncthreads();
#pragma unroll
        for (int pass = 0; pass < 2; pass++) {
            const int tk = pass * 8 + (tid >> 5), j = tid & 31;
            const float mine = scs[tk * 32 + j];
            int rank = 0;
            for (int j2 = 0; j2 < 32; j2++) { const float o = scs[tk * 32 + j2]; rank += (o > mine || (o == mine && j2 < j)) ? 1 : 0; }
            const unsigned long long bal = __ballot(rank < 16);
            if ((lane & 31) == 0) selm[tk] = (unsigned)(lane ? (bal >> 32) : (bal & 0xffffffffull));
        }
        __syncthreads();
    }
#pragma unroll
    for (int x = 0; x < 2; x++)
#pragma unroll
        for (int dt = 0; dt < 4; dt++) ofl[(wave * 8 + x * 4 + dt) * 64 + lane] = Og[x][dt];
    const unsigned mysel = selm[r];
    unsigned uni = 0;
#pragma unroll
    for (int i = 0; i < 16; i++) uni |= selm[i];
    if (tid == 0) uex[half_id()] = uni;
    __syncthreads();
    uni = uex[0] | uex[1];
    uni &= (cur == 31) ? 0xffffffffu : ((2u << cur) - 1u);
    uni |= 1u;

    {
        const int lo = (t0 & ~31) - 511;
        const int jb0 = lo > 0 ? (lo >> 6) : 0;
        const int kkey = t512 >> 3, kch = (t512 & 7) * 8;
        const int vd = t512 >> 3, vch = (t512 & 7) * 8;
        const bf16_t* vtb = (const bf16_t*)(p.ws + OFF_VT) + ((size_t)(b * 2 + g) * 64 + vd) * SEQ + vch;
        u32x4 kreg, vreg;
        int br = 0, j = 0;
        {
            const bf16_t* kb = Z + (rowb + 0) * ZC + ZKS + g * 64;
            kreg = *(const u32x4*)(kb + (size_t)kkey * ZC + kch);
            vreg = *(const u32x4*)(vtb);
        }
        f32x4 O[2][4];
        float m[2] = {-1e30f, -1e30f}, l[2] = {0.f, 0.f};
#pragma unroll
        for (int x = 0; x < 2; x++)
#pragma unroll
            for (int dt = 0; dt < 4; dt++) O[x][dt] = (f32x4){0.f, 0.f, 0.f, 0.f};
        for (;;) {
            __syncthreads();
            *(u32x4*)(Ks + kkey * 64 + (((kch >> 3) ^ (kkey & 7)) * 8)) = kreg;
            *(u32x4*)(VT + vd * 72 + vch) = vreg;
            __syncthreads();
            int nbr, nj;
            if (br == 0) {
                const unsigned rem = (j >= 31) ? 0u : (uni & ~((2u << j) - 1u));
                if (rem) { nbr = 0; nj = __ffs((int)rem) - 1; } else { nbr = 1; nj = jb0; }
            } else {
                if (j < cur) { nbr = 1; nj = j + 1; } else { nbr = 2; nj = 0; }
            }
            if (nbr < 2) {
                const bf16_t* kb = Z + (rowb + nj * 64) * ZC + (nbr ? ZKW : ZKS) + g * 64;
                kreg = *(const u32x4*)(kb + (size_t)kkey * ZC + kch);
                vreg = *(const u32x4*)(vtb + (size_t)nbr * (8 * 2 * 64) * SEQ + nj * 64);
            }
            int klo = 0, khi = -1;
            if (br == 0) { if ((mysel >> j) & 1u) khi = t - j * 64; }
            else { khi = t - j * 64; klo = t - 511 - j * 64; }
            klo = klo < 0 ? 0 : klo;
            khi = khi > 63 ? 63 : khi;
            nsa_block_step(Ks, VT, qf, O, m, l, klo, khi, r, q);
            if (nbr != br) {
#pragma unroll
                for (int x = 0; x < 2; x++) {
                    float lt = l[x];
                    lt += __shfl_xor(lt, 16, 64);
                    lt += __shfl_xor(lt, 32, 64);
                    const float sc = sigmoidf_(bf2f(Z[(rowb + t) * ZC + ZGATE + (br + 1) * 16 + g * 8 + 2 * wave + x])) / lt;
#pragma unroll
                    for (int dt = 0; dt < 4; dt++) { ofl[(wave * 8 + x * 4 + dt) * 64 + lane] += sc * O[x][dt]; O[x][dt] = (f32x4){0.f, 0.f, 0.f, 0.f}; }
                    m[x] = -1e30f; l[x] = 0.f;
                }
            }
            if (nbr == 2) break;
            br = nbr; j = nj;
        }
#pragma unroll
        for (int x = 0; x < 2; x++)
#pragma unroll
            for (int dt = 0; dt < 4; dt++) {
                const f32x4 v = ofl[(wave * 8 + x * 4 + dt) * 64 + lane];
                *(u32x2*)(ydst + (rowb + t) * ystride + (g * 8 + 2 * wave + x) * 64 + dt * 16 + 4 * q) = (u32x2){pack2(v[0], v[1]), pack2(v[2], v[3])};
            }
    }
    __syncthreads();
}

__device__ void phaseM1(const Params& p, char* lds) {
    const int tid_ = TIDX512; const int lane = tid_ & 63, wave = tid_ >> 6;
    const int wr = wave >> 2, wc = wave & 3, r = lane & 15, q = lane >> 4;
    const bf16_t* H = (const bf16_t*)(p.ws + OFF_H);
    const bf16_t* Z = (const bf16_t*)(p.ws + OFF_Z);
    bf16_t* M = (bf16_t*)(p.ws + OFF_M);
    bf16_t* SG = (bf16_t*)p.out;
    TileIter tit(4, lds);
    int bm, bn;
    while (tit.next(bm, bn)) {
        const int m0 = bm * 256, n0 = bn * 256;
        for (int br = 0; br < 2; br++) {
            f32x4 acc[8][4];
            zero_acc(acc);
            gemm_core(acc, H, DM, (const bf16_t*)(p.ws + OFF_WM) + (size_t)br * 1024 * 1024, DM, DM, m0, n0, lds);
            {
                const int e0 = launder_i((m0 + wr * 128 + r) * DM + n0 + wc * 64 + 4 * q);
#pragma unroll
                for (int mi = 0; mi < 8; mi++)
#pragma unroll
                    for (int ni = 0; ni < 4; ni++)
                        *(u32x2*)(SG + (size_t)(e0 + mi * 16 * DM + ni * 16)) = (u32x2){pack2(sigmoidf_(acc[mi][ni][0]), sigmoidf_(acc[mi][ni][1])),
                                                                                        pack2(sigmoidf_(acc[mi][ni][2]), sigmoidf_(acc[mi][ni][3]))};
            }
            zero_acc(acc);
            gemm_core(acc, Z + (br ? ZQ_N : ZR_G), ZC, (const bf16_t*)(p.ws + (br ? OFF_WB : OFF_WA)), DM, DM, m0, n0, lds);
            {
                const int e0 = launder_i((m0 + wr * 128 + r) * DM + n0 + wc * 64 + 4 * q);
#pragma unroll
                for (int mi = 0; mi < 8; mi++)
#pragma unroll
                    for (int ni = 0; ni < 4; ni++) {
                        const size_t eo = (size_t)(e0 + mi * 16 * DM + ni * 16);
                        const u32x2 sg = *(const u32x2*)(SG + eo);
                        float v[4] = {bf_lo(sg.x) * acc[mi][ni][0], bf_hi(sg.x) * acc[mi][ni][1], bf_lo(sg.y) * acc[mi][ni][2], bf_hi(sg.y) * acc[mi][ni][3]};
                        u32x2* dst = (u32x2*)(M + eo);
                        if (br) { const u32x2 pv = *dst; v[0] += bf_lo(pv.x); v[1] += bf_hi(pv.x); v[2] += bf_lo(pv.y); v[3] += bf_hi(pv.y); }
                        *dst = (u32x2){pack2(v[0], v[1]), pack2(v[2], v[3])};
                    }
            }
        }
    }
}

__device__ void phaseM2(const Params& p, char* lds) {
    const int tid_ = TIDX512; const int lane = tid_ & 63, wave = tid_ >> 6;
    const int wr = wave >> 2, wc = wave & 3, r = lane & 15, q = lane >> 4;
    const bf16_t* M = (const bf16_t*)(p.ws + OFF_M);
    const float* mod = (const float*)(p.ws + OFF_MOD);
    TileIter tit(4, lds);
    int bm, bn;
    while (tit.next(bm, bn)) {
        const int m0 = bm * 256, n0 = bn * 256;
        f32x4 acc[8][4];
        zero_acc(acc);
        gemm_core(acc, M, DM, (const bf16_t*)(p.ws + OFF_WO), DM, DM, m0, n0, lds);
#pragma unroll
        for (int mi = 0; mi < 8; mi++)
#pragma unroll
            for (int ni = 0; ni < 4; ni++) {
                const int tok = m0 + wr * 128 + mi * 16 + r, col = n0 + wc * 64 + ni * 16 + 4 * q;
                const f32x4 xv = *(const f32x4*)(p.x + (size_t)tok * DM + col);
                const f32x4 gt = *(const f32x4*)(mod + (tok >> 11) * 6144 + 2 * 1024 + col);
                *(f32x4*)(p.out + (size_t)tok * DM + col) = xv + gt * acc[mi][ni];
            }
    }
    {
        const int tid_ = TIDX; const int lane = tid_ & 63, wave = tid_ >> 6;
        unsigned char* tq = (unsigned char*)(p.ws + OFF_UB);
        float* tsc = (float*)(p.ws + OFF_UB + 33554432);
        for (int row = vblk() * 4 + wave; row < 32768; row += vgrid() * 4) {
            const bool isv = row >= 16384;
            const float* srcp = (isv ? p.peer_v : p.peer_u) + (size_t)(row & 16383) * DM + lane * 16;
            f32x4 a[4];
            float mx = 0.f;
#pragma unroll
            for (int i = 0; i < 4; i++) {
                a[i] = *(const f32x4*)(srcp + i * 4);
                mx = fmaxf(mx, fmaxf(fmaxf(fabsf(a[i][0]), fabsf(a[i][1])), fmaxf(fabsf(a[i][2]), fabsf(a[i][3]))));
            }
            mx = wave_max(mx);
            const float inv = mx > 0.f ? 127.f / mx : 0.f;
            const int off = isv ? 128 : 0;
            unsigned w[4];
#pragma unroll
            for (int i = 0; i < 4; i++) {
                unsigned pk = 0;
#pragma unroll
                for (int j = 0; j < 4; j++) {
                    int qi = (int)rintf(a[i][j] * inv);
                    qi = qi > 127 ? 127 : (qi < -127 ? -127 : qi);
                    pk |= ((unsigned)(qi + off) & 0xffu) << (8 * j);
                }
                w[i] = pk;
            }
            *(u32x4*)(tq + (size_t)row * DM + lane * 16) = (u32x4){w[0], w[1], w[2], w[3]};
            if (lane == 0) tsc[row] = mx * (1.f / 127.f);
        }
    }
}

__device__ void phaseP1(const Params& p, char* lds) {
    const int tid_ = TIDX512; const int lane = tid_ & 63, wave = tid_ >> 6;
    const int wr = wave >> 2, wc = wave & 3, r = lane & 15, q = lane >> 4;
    const bf16_t* H = (const bf16_t*)(p.ws + OFF_H);
    bf16_t* QP = (bf16_t*)(p.ws + OFF_QP);
    TileIter tit(8, lds);
    int bm, bn;
    while (tit.next(bm, bn)) {
        const int m0 = bm * 256, n0 = bn * 256;
        f32x4 acc[8][4];
        zero_acc(acc);
        gemm_core(acc, H, DM, (const bf16_t*)(p.ws + OFF_WQ), DM, DM, m0, n0, lds);
#pragma unroll
        for (int mi = 0; mi < 8; mi++)
#pragma unroll
            for (int ni = 0; ni < 4; ni++) epi_fill(lds, wr, wc, r, q, mi, ni, acc[mi][ni]);
        __syncthreads();
        epi_store(lds, QP, 2048, m0, n0, 2048);
        __syncthreads();
    }
}

__constant__ unsigned char c_cand_a[64] = {0,0,0,0,0,0,0,0,0,0,0,0,0,0,0,0, 1,1,1,1,1,1,1,1, 2,2,2,2,2, 3,3,3,3, 4,4,4, 5,5, 6,6, 7,7, 8,9,10,11,12,13,14,15, 0,0,0,0,0,0,0,0,0,0,0,0,0,0};
__constant__ unsigned char c_cand_b[64] = {0,1,2,3,4,5,6,7,8,9,10,11,12,13,14,15, 0,1,2,3,4,5,6,7, 0,1,2,3,4, 0,1,2,3, 0,1,2, 0,1, 0,1, 0,1, 0,0,0,0,0,0,0,0, 0,0,0,0,0,0,0,0,0,0,0,0,0,0};

__device__ __forceinline__ unsigned f2key(float f) { const unsigned u = __float_as_uint(f); return (u & 0x80000000u) ? ~u : (u | 0x80000000u); }
__device__ __forceinline__ float key2f(unsigned k) { const unsigned u = (k & 0x80000000u) ? (k & 0x7fffffffu) : ~k; return __uint_as_float(u); }
__device__ __forceinline__ void cex_desc(unsigned& a, unsigned& b) { const unsigned hi = a > b ? a : b, lo = a > b ? b : a; a = hi; b = lo; }
__device__ __forceinline__ void sort16_desc(unsigned (&a)[16]) {
#pragma unroll
    for (int k = 2; k <= 16; k <<= 1)
#pragma unroll
        for (int j = k >> 1; j > 0; j >>= 1)
#pragma unroll
            for (int i = 0; i < 16; i++) {
                const int l = i ^ j;
                if (l > i) { if ((i & k) == 0) cex_desc(a[i], a[l]); else cex_desc(a[l], a[i]); }
            }
}
__device__ __forceinline__ void merge16_desc(unsigned (&a)[16], const unsigned (&b)[16]) {
#pragma unroll
    for (int i = 0; i < 16; i++) a[i] = a[i] > b[15 - i] ? a[i] : b[15 - i];
#pragma unroll
    for (int j = 8; j > 0; j >>= 1)
#pragma unroll
        for (int i = 0; i < 16; i++) { const int l = i ^ j; if (l > i) cex_desc(a[i], a[l]); }
}

__device__ void phaseP2_task(const Params& p, int task, char* lds) {
    const int tid = TIDX, lane = tid & 63, wave = tid >> 6, r = lane & 15, q = lane >> 4;
    const int h = task & 7, tile = task >> 3;
    const int tok0 = tile * 64;
    const bf16_t* QP = (const bf16_t*)(p.ws + OFF_QP);
    float* S = (float*)lds;
    unsigned* LL = (unsigned*)(lds + 65536);
#pragma unroll
    for (int half = 0; half < 2; half++) {
        const bf16_t* KB = (const bf16_t*)(p.ws + OFF_K1B) + (size_t)half * 131072 + (size_t)h * 128 * 128;
        f32x4 acc[8];
#pragma unroll
        for (int nt = 0; nt < 8; nt++) acc[nt] = (f32x4){0.f, 0.f, 0.f, 0.f};
#pragma unroll
        for (int ks = 0; ks < 4; ks++) {
            const bf16x8 bq = *(const bf16x8*)(QP + (size_t)(tok0 + wave * 16 + r) * 2048 + h * 256 + half * 128 + ks * 32 + q * 8);
#pragma unroll
            for (int nt = 0; nt < 8; nt++) {
                const bf16x8 ak = *(const bf16x8*)(KB + (size_t)(nt * 16 + r) * 128 + ks * 32 + q * 8);
                acc[nt] = mfma16(ak, bq, acc[nt]);
            }
        }
#pragma unroll
        for (int nt = 0; nt < 8; nt++)
#pragma unroll
            for (int j = 0; j < 4; j++) S[(half * 128 + nt * 16 + 4 * q + j) * 64 + wave * 16 + r] = acc[nt][j];
    }
    __syncthreads();
    {
        const int row = tid & 127, part = tid >> 7, half = row >> 6, tk = row & 63;
        unsigned L[16];
        const float* sp = S + (half * 128 + part * 64) * 64 + tk;
#pragma unroll
        for (int k = 0; k < 16; k++) L[k] = (f2key(sp[k * 64]) & ~127u) | (unsigned)(127 - (part * 64 + k));
        sort16_desc(L);
        for (int gq = 1; gq < 4; gq++) {
            unsigned G[16];
#pragma unroll
            for (int k = 0; k < 16; k++) G[k] = (f2key(sp[(gq * 16 + k) * 64]) & ~127u) | (unsigned)(127 - (part * 64 + gq * 16 + k));
            sort16_desc(G);
            merge16_desc(L, G);
        }
        __syncthreads();
        unsigned* LP = (unsigned*)lds;
#pragma unroll
        for (int k = 0; k < 16; k++) LP[((part * 2 + half) * 16 + k) * 64 + tk] = L[k];
        __syncthreads();
        if (tid < 128) {
            unsigned A[16], Bq[16];
#pragma unroll
            for (int k = 0; k < 16; k++) { A[k] = LP[((0 * 2 + half) * 16 + k) * 64 + tk]; Bq[k] = LP[((1 * 2 + half) * 16 + k) * 64 + tk]; }
            merge16_desc(A, Bq);
#pragma unroll
            for (int k = 0; k < 16; k++) LL[(half * 16 + k) * 64 + tk] = A[k];
        }
    }
    __syncthreads();
    if (tid < 64) {
        const int tk = tid;
        float v1[16], v2[16];
#pragma unroll
        for (int k = 0; k < 16; k++) { v1[k] = key2f(LL[k * 64 + tk] & ~127u); v2[k] = key2f(LL[(16 + k) * 64 + tk] & ~127u); }
        unsigned C[64];
#pragma unroll
        for (int k = 0; k < 64; k++) C[k] = 0u;
        {
            int c = 0;
#pragma unroll
            for (int a = 0; a < 16; a++)
#pragma unroll
                for (int b = 0; b < 16; b++)
                    if ((a + 1) * (b + 1) <= 16) { C[c] = (f2key(v1[a] + v2[b]) & ~63u) | (unsigned)(63 - c); c++; }
        }
        unsigned T[16];
#pragma unroll
        for (int k = 0; k < 16; k++) T[k] = C[k];
        sort16_desc(T);
#pragma unroll
        for (int gq = 1; gq < 4; gq++) {
            unsigned G[16];
#pragma unroll
            for (int k = 0; k < 16; k++) G[k] = C[gq * 16 + k];
            sort16_desc(G);
            merge16_desc(T, G);
        }
        const float mx = key2f(T[0] & ~63u);
        float e[16], sum = 0.f;
#pragma unroll
        for (int k = 0; k < 16; k++) { e[k] = __expf(key2f(T[k] & ~63u) - mx); sum += e[k]; }
        const float inv = 1.f / sum;
        int ei[16];
#pragma unroll
        for (int k = 0; k < 16; k++) {
            const int cc = 63 - (int)(T[k] & 63u);
            const int a = c_cand_a[cc], b = c_cand_b[cc];
            const int i1 = 127 - (int)(LL[a * 64 + tk] & 127u), i2 = 127 - (int)(LL[(16 + b) * 64 + tk] & 127u);
            ei[k] = i1 * 128 + i2;
            e[k] *= inv;
        }
        int* eidx = (int*)(p.ws + OFF_EIDX) + (size_t)(tok0 + tk) * 128 + h * 16;
        float* gw = (float*)(p.ws + OFF_GW) + (size_t)(tok0 + tk) * 128 + h * 16;
#pragma unroll
        for (int k4 = 0; k4 < 4; k4++) {
            *(u32x4*)(eidx + k4 * 4) = (u32x4){(unsigned)ei[k4 * 4], (unsigned)ei[k4 * 4 + 1], (unsigned)ei[k4 * 4 + 2], (unsigned)ei[k4 * 4 + 3]};
            *(f32x4*)(gw + k4 * 4) = (f32x4){e[k4 * 4], e[k4 * 4 + 1], e[k4 * 4 + 2], e[k4 * 4 + 3]};
        }
    }
    __syncthreads();
}

__device__ __forceinline__ float ub0(unsigned w) { return (float)(w & 0xffu); }
__device__ __forceinline__ float ub1(unsigned w) { return (float)((w >> 8) & 0xffu); }
__device__ __forceinline__ float ub2(unsigned w) { return (float)((w >> 16) & 0xffu); }
__device__ __forceinline__ float ub3(unsigned w) { return (float)(w >> 24); }
struct P3Sc { float su, sv, gm; };
constexpr int P3_REC = 2048;
__device__ __forceinline__ void p3_load_u(u32x4 (&ur)[4], P3Sc& sc, const unsigned char* __restrict__ UQ, const float* __restrict__ tsc,
                                          int lane, int ul, int g, const unsigned* rec) {
#pragma unroll
    for (int u = 0; u < 4; u++) ur[u] = *(const u32x4*)(UQ + (size_t)rec[4 * g + u] * DM + lane * 16);
    const int em = (int)rec[4 * g + ul];
    sc.gm = __uint_as_float(rec[128 + 4 * g + ul]);
    sc.su = tsc[em];
    sc.sv = tsc[16384 + em];
}
__device__ __forceinline__ void p3_load_v(u32x4 (&vr)[4], const unsigned char* __restrict__ VQ, int lane, int g, const unsigned* rec) {
#pragma unroll
    for (int u = 0; u < 4; u++) vr[u] = *(const u32x4*)(VQ + (size_t)rec[4 * g + u] * DM + lane * 16);
}
__device__ __forceinline__ void p3_dots(const u32x4 (&ur)[4], const unsigned* rec, int lane, int (&pt)[4]) {
    const u32x4 qh = *(const u32x4*)(rec + 256 + lane * 4);
#pragma unroll
    for (int u = 0; u < 4; u++) {
        int d = __builtin_amdgcn_sdot4((int)ur[u].x, (int)qh.x, 0, false);
        d = __builtin_amdgcn_sdot4((int)ur[u].y, (int)qh.y, d, false);
        d = __builtin_amdgcn_sdot4((int)ur[u].z, (int)qh.z, d, false);
        d = __builtin_amdgcn_sdot4((int)ur[u].w, (int)qh.w, d, false);
        pt[u] = d;
    }
}
__device__ __forceinline__ float p3_weight(const int (&pt)[4], int lane, float sh, const P3Sc& sc) {
    int m2[2], m1;
    const bool c0 = lane & 1;
#pragma unroll
    for (int j = 0; j < 2; j++) { const int keep = c0 ? pt[j + 2] : pt[j], send = c0 ? pt[j] : pt[j + 2]; m2[j] = keep + __shfl_xor(send, 1, 64); }
    const bool c1 = lane & 2;
    { const int keep = c1 ? m2[1] : m2[0], send = c1 ? m2[0] : m2[1]; m1 = keep + __shfl_xor(send, 2, 64); }
    m1 += __shfl_xor(m1, 4, 64);
    m1 += __shfl_xor(m1, 8, 64);
    m1 += __shfl_xor(m1, 16, 64);
    m1 += __shfl_xor(m1, 32, 64);
    const float aval = (float)m1 * (sh * sc.su);
    return sc.gm * gelu_erf(aval) * sc.sv;
}
__device__ __forceinline__ void p3_axpy(const u32x4 (&vr)[4], float ws, float (&acc)[16], float& wsum) {
#pragma unroll
    for (int u = 0; u < 4; u++) {
        const int src_lane = ((u >> 1) & 1) | ((u & 1) << 1);
        const float wu = __shfl(ws, src_lane, 64);
        wsum += wu;
        const unsigned vw[4] = {vr[u].x, vr[u].y, vr[u].z, vr[u].w};
#pragma unroll
        for (int i = 0; i < 4; i++) {
            acc[i * 4 + 0] += wu * ub0(vw[i]); acc[i * 4 + 1] += wu * ub1(vw[i]);
            acc[i * 4 + 2] += wu * ub2(vw[i]); acc[i * 4 + 3] += wu * ub3(vw[i]);
        }
    }
}
__device__ __forceinline__ void p3_token(const Params& p, int tok, int lane, unsigned* rec, float& sh) {
    const bf16_t* H = (const bf16_t*)(p.ws + OFF_H);
    const int* eidx = (const int*)(p.ws + OFF_EIDX);
    const float* gwp = (const float*)(p.ws + OFF_GW);
    {
        const u32x4 a = *(const u32x4*)(H + (size_t)tok * DM + lane * 16), b = *(const u32x4*)(H + (size_t)tok * DM + lane * 16 + 8);
        const unsigned hw[8] = {a.x, a.y, a.z, a.w, b.x, b.y, b.z, b.w};
        float hv[16];
        float mx = 0.f;
#pragma unroll
        for (int i = 0; i < 8; i++) { hv[2 * i] = bf_lo(hw[i]); hv[2 * i + 1] = bf_hi(hw[i]); mx = fmaxf(mx, fmaxf(fabsf(hv[2 * i]), fabsf(hv[2 * i + 1]))); }
        mx = wave_max(mx);
        const float inv = mx > 0.f ? 127.f / mx : 0.f;
        sh = mx * (1.f / 127.f);
        unsigned qh[4];
#pragma unroll
        for (int i = 0; i < 4; i++) {
            unsigned pk = 0;
#pragma unroll
            for (int j = 0; j < 4; j++) pk |= ((unsigned)((int)rintf(hv[i * 4 + j] * inv)) & 0xffu) << (8 * j);
            qh[i] = pk;
        }
        *(u32x4*)(rec + 256 + lane * 4) = (u32x4){qh[0], qh[1], qh[2], qh[3]};
    }
    const int e0 = eidx[(size_t)tok * 128 + lane], e1 = eidx[(size_t)tok * 128 + 64 + lane];
    const float g0 = gwp[(size_t)tok * 128 + lane], g1 = gwp[(size_t)tok * 128 + 64 + lane];
    const int k0 = e0 >> 10, k1 = e1 >> 10;
    int pos0 = 0, pos1 = 0, base = 0;
#pragma unroll
    for (int v = 0; v < 16; v++) {
        const unsigned long long m0 = __ballot(k0 == v), m1 = __ballot(k1 == v);
        const int c0 = __popcll(m0);
        const int r0 = __builtin_amdgcn_mbcnt_hi((unsigned)(m0 >> 32), __builtin_amdgcn_mbcnt_lo((unsigned)m0, 0u));
        const int r1 = __builtin_amdgcn_mbcnt_hi((unsigned)(m1 >> 32), __builtin_amdgcn_mbcnt_lo((unsigned)m1, 0u));
        pos0 = (k0 == v) ? base + r0 : pos0;
        pos1 = (k1 == v) ? base + c0 + r1 : pos1;
        base += c0 + __popcll(m1);
    }
    rec[pos0] = (unsigned)e0; rec[pos1] = (unsigned)e1;
    rec[128 + pos0] = __float_as_uint(g0); rec[128 + pos1] = __float_as_uint(g1);
}
__device__ __forceinline__ void p3_finish(const Params& p, float* dstp, int tok, int lane, const float (&acc)[16], float wsum) {
    const float* mod = (const float*)(p.ws + OFF_MOD);
    const int b = tok >> 11;
    float x2[16];
    float ss = 0.f;
#pragma unroll
    for (int i = 0; i < 4; i++) {
        const int d = lane * 16 + i * 4;
        const f32x4 xv = *(const f32x4*)(p.out + (size_t)tok * DM + d);
        const f32x4 gt = *(const f32x4*)(mod + b * 6144 + 5 * 1024 + d);
#pragma unroll
        for (int j = 0; j < 4; j++) { const float v = xv[j] + gt[j] * (acc[i * 4 + j] - 128.f * wsum); x2[i * 4 + j] = v; ss += v * v; }
    }
    ss = wave_sum(ss);
    const float rstd = rsqrtf(ss * (1.f / 1024.f) + 1e-6f);
#pragma unroll
    for (int i = 0; i < 4; i++) {
        const int d = lane * 16 + i * 4;
        const f32x4 fg = *(const f32x4*)(p.final_g + d);
        f32x4 o;
#pragma unroll
        for (int j = 0; j < 4; j++) o[j] = x2[i * 4 + j] * rstd * fg[j];
        *(f32x4*)(dstp + (size_t)tok * DM + d) = o;
    }
}
__device__ void phaseP3(const Params& p, float* dstp, char* lds) {
    const int tid_ = TIDX; const int lane = tid_ & 63, wave = tid_ >> 6;
    const unsigned char* UQ = (const unsigned char*)(p.ws + OFF_UB);
    const unsigned char* VQ = UQ + 16777216;
    const float* tsc = (const float*)(p.ws + OFF_UB + 33554432);
    const int ul = ((lane & 1) << 1) | ((lane >> 1) & 1);
    constexpr int TPW = 2;
    unsigned* recs = (unsigned*)(lds + wave * TPW * P3_REC);
    for (int tb = (vblk() * 4 + wave) * TPW; tb < NTOK; tb += vgrid() * 4 * TPW) {
        float sh[TPW], acc[TPW][16], wsm[TPW];
        __builtin_amdgcn_wave_barrier();
#pragma unroll
        for (int k = 0; k < TPW; k++) {
            p3_token(p, tb + k, lane, recs + k * (P3_REC / 4), sh[k]);
#pragma unroll
            for (int i = 0; i < 16; i++) acc[k][i] = 0.f;
            wsm[k] = 0.f;
        }
        __builtin_amdgcn_wave_barrier();
        u32x4 ur[4], vr[4];
        P3Sc sc[TPW];
        p3_load_u(ur, sc[0], UQ, tsc, lane, ul, 0, recs);
        p3_load_v(vr, VQ, lane, 0, recs);
        for (int g = 0; g < 32; g++) {
#pragma unroll
            for (int k = 0; k < TPW; k++) {
                const int kn = (k + 1) % TPW;
                const int gn = (k + 1 == TPW) ? g + 1 : g;
                int pt[4];
                p3_dots(ur, recs + k * (P3_REC / 4), lane, pt);
                if (gn < 32) p3_load_u(ur, sc[kn], UQ, tsc, lane, ul, gn, recs + kn * (P3_REC / 4));
                const float w = p3_weight(pt, lane, sh[k], sc[k]);
                p3_axpy(vr, w, acc[k], wsm[k]);
                if (gn < 32) p3_load_v(vr, VQ, lane, gn, recs + kn * (P3_REC / 4));
            }
        }
#pragma unroll
        for (int k = 0; k < TPW; k++) p3_finish(p, dstp, tb + k, lane, acc[k], wsm[k]);
    }
}

#define XB_TMO      128
#define XB_XCNT(j)  (256  + 64 * (j))
#define XB_XSUB(j)  (1280 + 64 * (j))
#define XB_XGEN(j)  (2304 + 64 * (j))
#define XB_TOP      3328
#define XB_TOPGEN   3392
#define XCD_BAR_WORDS 3456
#define XB_SPIN_CAP (1u << 22)
#define LAS __attribute__((address_space(3)))
__device__ __forceinline__ unsigned xb_ld(unsigned* p)              { return __hip_atomic_load(p, __ATOMIC_RELAXED, __HIP_MEMORY_SCOPE_AGENT); }
__device__ __forceinline__ unsigned xb_add(unsigned* p, unsigned v) { return __hip_atomic_fetch_add(p, v, __ATOMIC_RELAXED, __HIP_MEMORY_SCOPE_AGENT); }
__device__ __forceinline__ unsigned xb_xcc_id() { return (unsigned)__builtin_amdgcn_s_getreg((3 << 11) | 20) & 0xFu; }
#define XB_SPIN(cond, bar) do { unsigned _sp = 0; while (cond) { __builtin_amdgcn_s_sleep(1); \
    if ((++_sp & 255u) == 0u) { if (xb_ld(&(bar)[XB_TMO])) break; if (_sp > XB_SPIN_CAP) { atomicAdd(&(bar)[XB_TMO], 1u); break; } } } } while (0)
struct XcdBarrier { unsigned* bar; unsigned x; volatile LAS unsigned* st; };
__device__ __forceinline__ XcdBarrier xcd_barrier_post(unsigned* bar, volatile LAS unsigned* st) {
    XcdBarrier b; b.bar = bar; b.x = xb_xcc_id(); b.st = st;
    if (threadIdx.x == 0) { st[2] = xb_add(&bar[XB_XCNT(b.x)], 1u); st[4] = b.x; }
    return b;
}
__device__ __forceinline__ void xcd_barrier_complete(unsigned* bar, unsigned x, unsigned& nloc, unsigned& nx, unsigned& bal) {
    const unsigned G = gridDim.x * gridDim.y * gridDim.z;
    unsigned sum, cnt, mine, c64, sp = 0u;
    for (;;) {
        sum = 0u; cnt = 0u; mine = 0u; c64 = 0u;
#pragma unroll
        for (unsigned j = 0; j < 16; ++j) { const unsigned c = xb_ld(&bar[XB_XCNT(j)]); sum += c; cnt += (c > 0u) ? 1u : 0u; c64 += (j < 8 && c == 64u) ? 1u : 0u; mine = (j == x) ? c : mine; }
        if (sum == G) break;
        __builtin_amdgcn_s_sleep(1);
        if ((++sp & 255u) == 0u) { if (xb_ld(&bar[XB_TMO])) break; if (sp > XB_SPIN_CAP) { atomicAdd(&bar[XB_TMO], 1u); break; } }
    }
    nloc = mine > 0u ? mine : 1u; nx = cnt > 0u ? cnt : 1u; bal = (sum == G && cnt == 8u && c64 == 8u) ? 1u : 0u;
}
__device__ __forceinline__ void xcd_barrier(const XcdBarrier& b) {
    asm volatile("s_waitcnt vmcnt(0)" ::: "memory");
    __syncthreads();
    if (threadIdx.x == 0) {
        unsigned* bar = b.bar;
        __builtin_amdgcn_s_waitcnt(0);
        unsigned nloc = b.st[0], nx = b.st[1];
        if (nloc == 0u) { unsigned bal; xcd_barrier_complete(bar, b.x, nloc, nx, bal); b.st[0] = nloc; b.st[1] = nx; b.st[3] = bal; }
        const unsigned old = xb_add(&bar[XB_XSUB(b.x)], 1u);
        const unsigned gen = old / nloc;
        if (old + 1u == (gen + 1u) * nloc) {
            __builtin_amdgcn_fence(__ATOMIC_RELEASE, "agent");
            asm volatile("s_waitcnt vmcnt(0)" ::: "memory");
            const unsigned og = xb_add(&bar[XB_TOP], 1u);
            const unsigned tg = og / nx;
            if (og + 1u == (tg + 1u) * nx) xb_add(&bar[XB_TOPGEN], 1u);
            else XB_SPIN(xb_ld(&bar[XB_TOPGEN]) == tg, bar);
            __builtin_amdgcn_fence(__ATOMIC_ACQUIRE, "agent");
            xb_add(&bar[XB_XGEN(b.x)], 1u);
            asm volatile("s_waitcnt vmcnt(0)" ::: "memory");
        } else {
            XB_SPIN(xb_ld(&bar[XB_XGEN(b.x)]) == gen, bar);
            __builtin_amdgcn_fence(__ATOMIC_ACQUIRE, "agent");
            asm volatile("s_waitcnt vmcnt(0)" ::: "memory");
        }
    }
    __syncthreads();
}

typedef __attribute__((address_space(4))) const Params* KParamsPtr;
__device__ __forceinline__ const Params& fresh_params() {
    KParamsPtr kp = (KParamsPtr)__builtin_amdgcn_kernarg_segment_ptr();
    asm volatile("" : "+s"(kp));
    return *(const Params*)kp;
}
#define PF fresh_params()
__global__ void __launch_bounds__(BLOCK_THREADS, 2) mega(Params p_unused) {
    __shared__ __attribute__((aligned(16))) char lds[LDS_BYTES];
    cg::grid_group grid = cg::this_grid();
    volatile LAS unsigned* st = (volatile LAS unsigned*)(lds + 2 * LDS_MAIN);
    if (threadIdx.x < 16) st[threadIdx.x] = 0u;
    __syncthreads();
    XcdBarrier xb = xcd_barrier_post((unsigned*)PF.ws, st);
    char* hl = lds + half_id() * LDS_MAIN;
    volatile unsigned* uex = (volatile unsigned*)(lds + 2 * LDS_MAIN + 32);

    phaseA(PF, hl);
    if (PF.ws == nullptr) grid.sync();
    xcd_barrier(xb);
    { const Params& q_ = PF; phase_modnorm(q_, q_.x, q_.norm1_g, 0, 1, (bf16_t*)(q_.ws + OFF_H)); };
    xcd_barrier(xb);
    phaseC(PF, lds);
    xcd_barrier(xb);
    for (int task = vblk(); task < 1024; task += vgrid()) phaseG1_task(PF, task, hl);
    for (int task = vblk(); task < 512; task += vgrid()) phaseN1_task(PF, task, hl);
    xcd_barrier(xb);
    phaseG2(PF);
    phaseA2(PF, hl);
    xcd_barrier(xb);
    for (int task = vblk(); task < 2048; task += vgrid()) phaseN2_task(PF, task, hl, (bf16_t*)(PF.ws + OFF_Z) + ZQ_N, ZC, uex, lds);
    for (int task = vblk(); task < 1024; task += vgrid()) phaseG3_task(PF, task, hl, (bf16_t*)(PF.ws + OFF_Z) + ZR_G, ZC);
    xcd_barrier(xb);
    phaseM1(PF, lds);
    xcd_barrier(xb);
    phaseM2(PF, lds);
    xcd_barrier(xb);
    { const Params& q_ = PF; phase_modnorm(q_, q_.out, q_.norm2_g, 3, 4, (bf16_t*)(q_.ws + OFF_H)); };
    xcd_barrier(xb);
    phaseP1(PF, lds);
    xcd_barrier(xb);
    for (int task = vblk(); task < 2048; task += vgrid()) phaseP2_task(PF, task, hl);
    xcd_barrier(xb);
    { const Params& q_ = PF; phaseP3(q_, q_.out, hl); };
}

extern "C" void kernel_launch(void* const* d_in, const int* in_sizes, int n_in, void* d_out, int out_size, void* d_ws, size_t ws_size, hipStream_t stream) {
    Params p{};
    p.x = (const float*)d_in[0]; p.c = (const float*)d_in[1]; p.pos = (const int*)d_in[2]; p.ada_w = (const float*)d_in[3]; p.ada_b = (const float*)d_in[4];
    p.norm1_g = (const float*)d_in[5]; p.norm2_g = (const float*)d_in[6]; p.final_g = (const float*)d_in[7]; p.w_in = (const float*)d_in[8];
    p.gla_wa2 = (const float*)d_in[9]; p.gla_ba2 = (const float*)d_in[10]; p.gla_norm_g = (const float*)d_in[11]; p.pe_k = (const float*)d_in[12]; p.pe_v = (const float*)d_in[13];
    p.ck_w1 = (const float*)d_in[14]; p.ck_w2 = (const float*)d_in[15]; p.cv_w1 = (const float*)d_in[16]; p.cv_w2 = (const float*)d_in[17];
    p.w_branch_a = (const float*)d_in[18]; p.w_branch_b = (const float*)d_in[19]; p.w_out = (const float*)d_in[20]; p.peer_wq = (const float*)d_in[21];
    p.peer_k1 = (const float*)d_in[22]; p.peer_k2 = (const float*)d_in[23]; p.peer_u = (const float*)d_in[24]; p.peer_v = (const float*)d_in[25];
    p.out = (float*)d_out; p.ws = (char*)d_ws;
    static int grid_blocks = 0;
    if (!grid_blocks) {
        int dev = 0, cus = 0, per_cu = 0;
        hipGetDevice(&dev);
        hipDeviceGetAttribute(&cus, hipDeviceAttributeMultiprocessorCount, dev);
        hipOccupancyMaxActiveBlocksPerMultiprocessor(&per_cu, mega, BLOCK_THREADS, 0);
        if (per_cu > 1) per_cu = 1;
        if (per_cu < 1) per_cu = 1;
        grid_blocks = cus * per_cu;
    }
    hipMemsetAsync(d_ws, 0, XCD_BAR_WORDS * 4, stream);
    void* args[] = {&p};
    hipError_t e = hipLaunchCooperativeKernel((void*)mega, dim3(grid_blocks), dim3(BLOCK_THREADS), args, 0, stream);
    if (e != hipSuccess) fprintf(stderr, "cooperative launch failed: %s (grid %d)\n", hipGetErrorString(e), grid_blocks);
}
```

```cpp
#include <hip/hip_runtime.h>
#include <hip/hip_cooperative_groups.h>
#include <stdio.h>
namespace cg = cooperative_groups;
#include <stdint.h>
#include <stddef.h>
#include <math.h>

typedef unsigned short bf16_t;
typedef short bf16x8 __attribute__((ext_vector_type(8)));
typedef float f32x4 __attribute__((ext_vector_type(4)));
typedef unsigned u32x4 __attribute__((ext_vector_type(4)));
typedef unsigned u32x2 __attribute__((ext_vector_type(2)));

constexpr int DM = 1024, NB = 8, SEQ = 2048, NTOK = NB * SEQ;
constexpr int ZC = 4992;
constexpr int ZQ_G = 0, ZK_G = 512, ZV_G = 1024, ZR_G = 2048, ZQ_N = 3072, ZKC = 4096, ZVC = 4224, ZKS = 4352, ZVS = 4480,
              ZKW = 4608, ZVW = 4736, ZGATE = 4864, ZLR = 4912;
constexpr int LDS_MAIN = 73728;
constexpr int LDS_BYTES = 2 * LDS_MAIN + 64;
constexpr int NTHREADS = 256;
constexpr int BLOCK_THREADS = 512;

constexpr size_t OFF_MOD = 16384;
constexpr size_t OFF_ROPE = 212992;
constexpr size_t OFF_CMP = 1261568;
constexpr size_t OFF_DEC = 1785856;
constexpr size_t OFF_K1B = 2310144;
constexpr size_t OFF_WC1 = 2834432;
constexpr size_t OFF_WIN = 4194304;
constexpr size_t OFF_WM = 14417920;
constexpr size_t OFF_WA = 18612224;
constexpr size_t OFF_WB = 20709376;
constexpr size_t OFF_WO = 22806528;
constexpr size_t OFF_WQ = 24903680;
constexpr size_t OFF_H = 29360128;
constexpr size_t OFF_M = 62914560;
constexpr size_t OFF_Z = 96468992;
constexpr size_t OFF_VT = OFF_Z + (size_t)NTOK * ZC * 2;
constexpr size_t OFF_QP = OFF_Z;
constexpr size_t OFF_UB = OFF_Z + 67108864;
constexpr size_t OFF_VB = OFF_UB + 33554432;
constexpr size_t OFF_EIDX = OFF_VB + 33554432;
constexpr size_t OFF_GW = OFF_EIDX + 8388608;

struct Params {
    const float* x; const float* c; const int* pos; const float* ada_w; const float* ada_b;
    const float* norm1_g; const float* norm2_g; const float* final_g; const float* w_in;
    const float* gla_wa2; const float* gla_ba2; const float* gla_norm_g; const float* pe_k; const float* pe_v;
    const float* ck_w1; const float* ck_w2; const float* cv_w1; const float* cv_w2;
    const float* w_branch_a; const float* w_branch_b; const float* w_out; const float* peer_wq;
    const float* peer_k1; const float* peer_k2; const float* peer_u; const float* peer_v;
    float* out; char* ws;
};

__device__ __forceinline__ unsigned f2bf_u(float f) { unsigned u = __float_as_uint(f); return (u + 0x7fffu + ((u >> 16) & 1u)) >> 16; }
__device__ __forceinline__ bf16_t f2bf(float f) { return (bf16_t)f2bf_u(f); }
typedef float f32x2_ __attribute__((ext_vector_type(2)));
typedef __bf16 bf16x2_ __attribute__((ext_vector_type(2)));
__device__ __forceinline__ unsigned pack2(float lo, float hi) {
    const f32x2_ v = {lo, hi};
    return __builtin_bit_cast(unsigned, __builtin_convertvector(v, bf16x2_));
}
__device__ __forceinline__ float bf_lo(unsigned u) { return __uint_as_float(u << 16); }
__device__ __forceinline__ float bf_hi(unsigned u) { return __uint_as_float(u & 0xffff0000u); }
__device__ __forceinline__ float bf2f(bf16_t h) { return __uint_as_float(((unsigned)h) << 16); }
__device__ __forceinline__ float wave_sum(float v) {
#pragma unroll
    for (int o = 32; o > 0; o >>= 1) v += __shfl_xor(v, o, 64);
    return v;
}
__device__ __forceinline__ float wave_max(float v) {
#pragma unroll
    for (int o = 32; o > 0; o >>= 1) v = fmaxf(v, __shfl_xor(v, o, 64));
    return v;
}
__device__ __forceinline__ int launder_i(int x) { asm volatile("" : "+v"(x)); return x; }
#define TIDX (launder_i((int)threadIdx.x) & 255)
#define TIDX512 launder_i((int)threadIdx.x)
__device__ __forceinline__ int half_id() { return __builtin_amdgcn_readfirstlane((int)(threadIdx.x >> 8)); }
__device__ __forceinline__ int vblk() { return (int)blockIdx.x * 2 + half_id(); }
__device__ __forceinline__ int vgrid() { return (int)gridDim.x * 2; }
__device__ __forceinline__ float exp2f_(float x) { return __builtin_amdgcn_exp2f(x); }
__device__ __forceinline__ float sigmoidf_(float x) { return __builtin_amdgcn_rcpf(1.f + __expf(-x)); }
__device__ __forceinline__ float siluf_(float x) { return x * __builtin_amdgcn_rcpf(1.f + __expf(-x)); }
__device__ __forceinline__ float gelu_erf(float v) {
    const float t = __builtin_amdgcn_rcpf(fabsf(v) * 0.2316418882f + 1.0f);
    float qp = t * 0.5307027145f + (-0.7265760135f);
    qp = qp * t + 0.7107068705f; qp = qp * t + (-0.142248368f); qp = qp * t + 0.127414796f; qp = qp * t;
    const float m = v * (qp * __builtin_amdgcn_exp2f(v * v * (-0.72134752044f)));
    return v < 0.f ? m : v - m;
}
__device__ __forceinline__ f32x4 mfma16(bf16x8 a, bf16x8 b, f32x4 c) { return __builtin_amdgcn_mfma_f32_16x16x32_bf16(a, b, c, 0, 0, 0); }
__device__ __forceinline__ bf16x8 ld_frag(const bf16_t* p) { return *(const bf16x8*)p; }
__device__ __forceinline__ bf16x8 mk_frag(u32x2 lo, u32x2 hi) { u32x4 t = {lo.x, lo.y, hi.x, hi.y}; return __builtin_bit_cast(bf16x8, t); }

#define WAIT_V(n) asm volatile("s_waitcnt vmcnt(" #n ")" ::: "memory")
__device__ __forceinline__ int swz4(int R) { return (4 - ((R >> 2) & 3)) & 3; }
__device__ __forceinline__ void glds16(const bf16_t* g, char* l) { __builtin_amdgcn_global_load_lds((const unsigned*)g, (unsigned*)l, 16, 0, 0); }
struct GemmSrc { const bf16_t* xsrc; const bf16_t* wsrc; int ldx, ldw; };
__device__ __forceinline__ GemmSrc gemm_src(const bf16_t* __restrict__ X, int ldx, const bf16_t* __restrict__ W, int ldw, int m0, int n0) {
    const int tid = TIDX512, lane = tid & 63, wave = tid >> 6;
    const int R0 = wave * 32 + (lane >> 2);
    const int sw = ((lane & 3) ^ swz4(R0)) * 8;
    GemmSrc g;
    g.xsrc = X + (size_t)(m0 + R0) * ldx + sw;
    g.wsrc = W + (size_t)(n0 + R0) * ldw + sw;
    g.ldx = ldx; g.ldw = ldw;
    return g;
}
__device__ __forceinline__ void gemm_issue(const GemmSrc& g, int kt, int s, char* lds) {
    const int tid = TIDX512, lane = tid & 63, wave = tid >> 6;
    char* xdst = lds + s * 32768 + wave * 2048 + lane * 16;
    char* wdst = xdst + 16384;
#pragma unroll
    for (int i = 0; i < 2; i++) {
        glds16(g.xsrc + (size_t)i * 16 * g.ldx + kt * 32, xdst + i * 1024);
        glds16(g.wsrc + (size_t)i * 16 * g.ldw + kt * 32, wdst + i * 1024);
    }
}
__device__ __forceinline__ void gemm_prologue(const GemmSrc& g, char* lds) { gemm_issue(g, 0, 0, lds); gemm_issue(g, 1, 1, lds); gemm_issue(g, 2, 2, lds); }
__device__ __forceinline__ void gemm_mainloop(f32x4 (&acc)[8][4], const GemmSrc& g, int K, char* lds) {
    const int tid = TIDX512, lane = tid & 63, wave = tid >> 6;
    const int wr = wave >> 2, wc = wave & 3, r = lane & 15, q = lane >> 4;
    const int KT = K / 32;
    const int rdo = r * 64 + ((q ^ swz4(r)) * 16);
    for (int kt = 0; kt < KT; kt++) {
        if (kt + 2 < KT) WAIT_V(8); else if (kt + 1 < KT) WAIT_V(4); else WAIT_V(0);
        __builtin_amdgcn_s_barrier();
        if (kt + 3 < KT) gemm_issue(g, kt + 3, (kt + 3) & 3, lds);
        const char* st = lds + (kt & 3) * 32768;
        bf16x8 af[4], bfr[8];
#pragma unroll
        for (int ni = 0; ni < 4; ni++) af[ni] = *(const bf16x8*)(st + 16384 + (wc * 64 + ni * 16) * 64 + rdo);
#pragma unroll
        for (int mi = 0; mi < 8; mi++) bfr[mi] = *(const bf16x8*)(st + (wr * 128 + mi * 16) * 64 + rdo);
#pragma unroll
        for (int mi = 0; mi < 8; mi++)
#pragma unroll
            for (int ni = 0; ni < 4; ni++) acc[mi][ni] = mfma16(af[ni], bfr[mi], acc[mi][ni]);
        __builtin_amdgcn_sched_barrier(0);
    }
}
__device__ __forceinline__ void gemm_core(f32x4 (&acc)[8][4], const bf16_t* __restrict__ X, int ldx, const bf16_t* __restrict__ W, int ldw,
                                          int K, int m0, int n0, char* lds) {
    const GemmSrc g = gemm_src(X, ldx, W, ldw, m0, n0);
    gemm_prologue(g, lds);
    gemm_mainloop(acc, g, K, lds);
    __syncthreads();
}
__device__ __forceinline__ void zero_acc(f32x4 (&acc)[8][4]) {
#pragma unroll
    for (int a = 0; a < 8; a++)
#pragma unroll
        for (int b = 0; b < 4; b++) acc[a][b] = (f32x4){0.f, 0.f, 0.f, 0.f};
}

constexpr int EPI_ROWB = 528;
__device__ __forceinline__ void epi_fill(char* lds, int wr, int wc, int r, int q, int mi, int ni, f32x4 v) {
    *(u32x2*)(lds + (wr * 128 + mi * 16 + r) * EPI_ROWB + (wc * 64 + ni * 16 + 4 * q) * 2) = (u32x2){pack2(v[0], v[1]), pack2(v[2], v[3])};
}
__device__ __forceinline__ void epi_store(const char* lds, bf16_t* __restrict__ O, int ldo, int m0, int n0, int ncols_valid) {
    const int t = TIDX512;
    const int chunk = t & 31, rsub = t >> 5;
    if (n0 + chunk * 8 < ncols_valid) {
#pragma unroll
        for (int ps = 0; ps < 16; ps++) {
            const int row = ps * 16 + rsub;
            const u32x4 v = *(const u32x4*)(lds + row * EPI_ROWB + chunk * 16);
            *(u32x4*)(O + (size_t)(m0 + row) * ldo + n0 + chunk * 8) = v;
        }
    }
}

struct TileIter {
    int nt, i, x, li; bool fancy;
    __device__ TileIter(int ntiles_n, const char*) { nt = ntiles_n; fancy = (gridDim.x == 256) && ((nt & 3) == 0); x = blockIdx.x & 7; li = blockIdx.x >> 3; i = fancy ? 0 : blockIdx.x; }
    __device__ bool next(int& bm, int& bn) {
        if (fancy) {
            if (i * 4 >= nt) return false;
            bm = x * 8 + (li & 7); bn = i * 4 + (li >> 3); i++; return true;
        }
        if (i >= 64 * nt) return false;
        bn = i % nt; bm = i / nt; i += gridDim.x; return true;
    }
};

struct MapId { __device__ int operator()(int n) const { return n; } };
struct MapWin {
    __device__ int operator()(int n) const { return n < 3072 ? n : (n < 4912 ? n + 16 : (n < 4928 ? n - 1840 : -1)); }
};
struct MapOff { int off; __device__ int operator()(int n) const { return n + off; } };

template <class Map>
__device__ __forceinline__ void tconv_tile(const float* __restrict__ src, int ldsrc, bf16_t* __restrict__ dst, int ldd, int n0, int k0, Map map, float* t) {
    const int tid = TIDX;
    const int n = tid & 63, kb = tid >> 6;
    const int sc = map(n0 + n);
#pragma unroll
    for (int i = 0; i < 16; i++) { const int k = i * 4 + kb; t[k * 65 + n] = sc >= 0 ? src[(size_t)(k0 + k) * ldsrc + sc] : 0.f; }
    __syncthreads();
    const int nn = tid >> 2, kk = (tid & 3) * 16;
    unsigned w[8];
#pragma unroll
    for (int j = 0; j < 8; j++) w[j] = pack2(t[(kk + 2 * j) * 65 + nn], t[(kk + 2 * j + 1) * 65 + nn]);
    u32x4* d = (u32x4*)(dst + (size_t)(n0 + nn) * ldd + k0 + kk);
    d[0] = (u32x4){w[0], w[1], w[2], w[3]};
    d[1] = (u32x4){w[4], w[5], w[6], w[7]};
    __syncthreads();
}

constexpr int TA_MOD = 192, TA_WIN = 78 * 16, TA_WM = 32 * 16, TA_SQ = 16 * 16, TA_WQ = 32 * 16, TA_WC = 32, TA_K12 = 64, TA_ROPE = 512;
constexpr int TA_E0 = TA_MOD, TA_E1 = TA_E0 + TA_WIN, TA_E2 = TA_E1 + TA_WM, TA_E3 = TA_E2 + TA_SQ, TA_E4 = TA_E3 + TA_SQ, TA_E5 = TA_E4 + TA_SQ,
              TA_E6 = TA_E5 + TA_WQ, TA_E7 = TA_E6 + TA_WC, TA_E8 = TA_E7 + TA_WC, TA_E9 = TA_E8 + TA_K12, TA_E10 = TA_E9 + TA_K12, TA_E11 = TA_E10 + TA_ROPE;

__device__ void phaseA(const Params& p, char* lds) {
    const int tid = TIDX;
    float* fl = (float*)lds;
    constexpr int N0 = TA_E1 + (TA_E8 - TA_E6) + (TA_E11 - TA_E10);
    for (int idx = vblk(); idx < N0; idx += vgrid()) {
        const int task = idx < TA_E1 ? idx : (idx < TA_E1 + (TA_E8 - TA_E6) ? idx - TA_E1 + TA_E6 : idx - TA_E1 - (TA_E8 - TA_E6) + TA_E10);
        if (task < TA_E0) {
            float* sc = fl;
            float* red = fl + 8192;
            for (int i = tid; i < 8192; i += NTHREADS) sc[i] = siluf_(p.c[i]);
            __syncthreads();
            const int n = task * 32 + (tid & 31), kg = tid >> 5;
            float a[8];
#pragma unroll
            for (int b = 0; b < 8; b++) a[b] = 0.f;
            for (int k0 = kg * 128; k0 < kg * 128 + 128; k0 += 16) {
                float w[16];
#pragma unroll
                for (int i = 0; i < 16; i++) w[i] = p.ada_w[(size_t)(k0 + i) * 6144 + n];
#pragma unroll
                for (int i = 0; i < 16; i++)
#pragma unroll
                    for (int b = 0; b < 8; b++) a[b] += sc[b * 1024 + k0 + i] * w[i];
            }
#pragma unroll
            for (int b = 0; b < 8; b++) red[(kg * 8 + b) * 32 + (tid & 31)] = a[b];
            __syncthreads();
            {
                const int b = tid >> 5, nn = tid & 31;
                float s = 0.f;
#pragma unroll
                for (int g = 0; g < 8; g++) s += red[(g * 8 + b) * 32 + nn];
                ((float*)(p.ws + OFF_MOD))[b * 6144 + task * 32 + nn] = s + p.ada_b[task * 32 + nn];
            }
            __syncthreads();
        } else if (task < TA_E1) {
            const int tt = task - TA_E0;
            tconv_tile(p.w_in, 6976, (bf16_t*)(p.ws + OFF_WIN), 1024, (tt >> 4) * 64, (tt & 15) * 64, MapWin(), fl);
        } else if (task < TA_E6) {
        } else if (task < TA_E7) {
            const int tt = task - TA_E6;
            tconv_tile(p.ck_w1, 64, (bf16_t*)(p.ws + OFF_WC1), 2048, 0, tt * 64, MapId(), fl);
        } else if (task < TA_E8) {
            const int tt = task - TA_E7;
            tconv_tile(p.cv_w1, 64, (bf16_t*)(p.ws + OFF_WC1) + 64 * 2048, 2048, 0, tt * 64, MapId(), fl);
        } else if (task < TA_E10) {
        } else {
            const int tt = task - TA_E10;
            const int e = tt * 256 + tid;
            const int tok = e >> 3, i = e & 7;
            const float invf[8] = {1.0f, 0.1939227432012558f, 0.03760603070259094f, 0.007292664609849453f,
                                   0.0014142135623842478f, 0.00027424818836152554f, 5.318296098266728e-05f, 1.0313386155758053e-05f};
            float fr = invf[0];
#pragma unroll
            for (int j = 1; j < 8; j++) fr = (i == j) ? invf[j] : fr;
            const float ang = (float)p.pos[tok] * fr;
            const double rev = (double)ang * 0.15915494309189533577;
            const float fpart = (float)(rev - floor(rev));
            float* cs = (float*)(p.ws + OFF_ROPE);
            cs[e * 2] = __builtin_amdgcn_cosf(fpart);
            cs[e * 2 + 1] = __builtin_amdgcn_sinf(fpart);
        }
    }
}

__device__ void phaseA2(const Params& p, char* lds) {
    const int tid = TIDX;
    float* fl = (float*)lds;
    constexpr int N1 = (TA_E6 - TA_E1) + (TA_E10 - TA_E8);
    for (int idx = vblk(); idx < N1; idx += vgrid()) {
        const int task = idx < (TA_E6 - TA_E1) ? idx + TA_E1 : idx - (TA_E6 - TA_E1) + TA_E8;
        if (task < TA_E1) {
        } else if (task < TA_E2) {
            const int tt = task - TA_E1;
            tconv_tile(p.w_in, 6976, (bf16_t*)(p.ws + OFF_WM), 1024, (tt >> 4) * 64, (tt & 15) * 64, MapOff{4928}, fl);
        } else if (task < TA_E3) {
            const int tt = task - TA_E2;
            tconv_tile(p.w_branch_a, 1024, (bf16_t*)(p.ws + OFF_WA), 1024, (tt >> 4) * 64, (tt & 15) * 64, MapId(), fl);
        } else if (task < TA_E4) {
            const int tt = task - TA_E3;
            tconv_tile(p.w_branch_b, 1024, (bf16_t*)(p.ws + OFF_WB), 1024, (tt >> 4) * 64, (tt & 15) * 64, MapId(), fl);
        } else if (task < TA_E5) {
            const int tt = task - TA_E4;
            tconv_tile(p.w_out, 1024, (bf16_t*)(p.ws + OFF_WO), 1024, (tt >> 4) * 64, (tt & 15) * 64, MapId(), fl);
        } else if (task < TA_E6) {
            const int tt = task - TA_E5;
            tconv_tile(p.peer_wq, 2048, (bf16_t*)(p.ws + OFF_WQ), 1024, (tt >> 4) * 64, (tt & 15) * 64, MapId(), fl);
        } else if (task < TA_E10) {
            const bool second = task >= TA_E9;
            const int tt = task - (second ? TA_E9 : TA_E8);
            const float* src = second ? p.peer_k2 : p.peer_k1;
            bf16_t* dst = (bf16_t*)(p.ws + OFF_K1B) + (second ? 131072 : 0);
            const int i = tt * 2048 + tid * 8;
            const f32x4 a = *(const f32x4*)(src + i), b = *(const f32x4*)(src + i + 4);
            *(u32x4*)(dst + i) = (u32x4){pack2(a[0], a[1]), pack2(a[2], a[3]), pack2(b[0], b[1]), pack2(b[2], b[3])};
        }
    }
}

__device__ void phase_modnorm(const Params& p, const float* __restrict__ src, const float* __restrict__ g, int shift_idx, int scale_idx, bf16_t* __restrict__ dst) {
    const int tid_ = TIDX; const int lane = tid_ & 63, wave = tid_ >> 6;
    const float* mod = (const float*)(p.ws + OFF_MOD);
    for (int tok = vblk() * 4 + wave; tok < NTOK; tok += vgrid() * 4) {
        const int b = tok >> 11;
        const float* xr = src + (size_t)tok * DM;
        f32x4 v[4];
        float ss = 0.f;
#pragma unroll
        for (int c = 0; c < 4; c++) { v[c] = *(const f32x4*)(xr + c * 256 + lane * 4); ss += v[c][0] * v[c][0] + v[c][1] * v[c][1] + v[c][2] * v[c][2] + v[c][3] * v[c][3]; }
        ss = wave_sum(ss);
        const float rstd = rsqrtf(ss * (1.f / 1024.f) + 1e-6f);
#pragma unroll
        for (int c = 0; c < 4; c++) {
            const int d = c * 256 + lane * 4;
            const f32x4 gg = *(const f32x4*)(g + d);
            const f32x4 sc = *(const f32x4*)(mod + b * 6144 + scale_idx * 1024 + d);
            const f32x4 sh = *(const f32x4*)(mod + b * 6144 + shift_idx * 1024 + d);
            float o[4];
#pragma unroll
            for (int j = 0; j < 4; j++) o[j] = (v[c][j] * rstd) * gg[j] * (1.f + sc[j]) + sh[j];
            *(u32x2*)(dst + (size_t)tok * DM + d) = (u32x2){pack2(o[0], o[1]), pack2(o[2], o[3])};
        }
    }
}

__device__ void phaseC(const Params& p, char* lds) {
    const int tid_ = TIDX512; const int lane = tid_ & 63, wave = tid_ >> 6;
    const int wr = wave >> 2, wc = wave & 3, r = lane & 15, q = lane >> 4;
    const bf16_t* H = (const bf16_t*)(p.ws + OFF_H);
    const bf16_t* W = (const bf16_t*)(p.ws + OFF_WIN);
    bf16_t* Z = (bf16_t*)(p.ws + OFF_Z);
    const float* cs = (const float*)(p.ws + OFF_ROPE);
    constexpr int NTN = (ZC + 255) / 256;
    TileIter tit(NTN, lds);
    int bm, bn;
    while (tit.next(bm, bn)) {
        const int m0 = bm * 256, n0 = bn * 256;
        f32x4 acc[8][4];
        zero_acc(acc);
        gemm_core(acc, H, DM, W, DM, DM, m0, n0, lds);
        const int c0 = n0 + wc * 64;
        const bool isq = (c0 >= ZQ_N && c0 < ZKC);
        const bool rope = isq || (c0 >= ZKC && c0 < ZGATE && ((c0 - ZKC) & 255) < 128);
        const float scl = isq ? 0.18033688011112042f : 1.f;
#pragma unroll
        for (int mi = 0; mi < 8; mi++) {
            const int tok = m0 + wr * 128 + mi * 16 + r;
            if (rope) {
                f32x4 v = acc[mi][0];
                f32x4 pr;
#pragma unroll
                for (int j = 0; j < 4; j++) pr[j] = __shfl_xor(v[j], 32, 64);
                const int ib = (q & 1) * 4;
                const f32x4 k0 = *(const f32x4*)(cs + (size_t)tok * 16 + ib * 2);
                const f32x4 k1 = *(const f32x4*)(cs + (size_t)tok * 16 + ib * 2 + 4);
                const float cc[4] = {k0[0], k0[2], k1[0], k1[2]}, sn[4] = {k0[1], k0[3], k1[1], k1[3]};
#pragma unroll
                for (int j = 0; j < 4; j++) v[j] = (q < 2) ? (v[j] * cc[j] - pr[j] * sn[j]) : (v[j] * cc[j] + pr[j] * sn[j]);
                acc[mi][0] = v;
            }
#pragma unroll
            for (int ni = 0; ni < 4; ni++) epi_fill(lds, wr, wc, r, q, mi, ni, acc[mi][ni] * scl);
        }
        if ((c0 >= ZVS && c0 < ZVS + 128) || (c0 >= ZVW && c0 < ZVW + 128)) {
            const int brn = c0 >= ZVW ? 1 : 0, gg = ((c0 - (brn ? ZVW : ZVS)) >> 6) & 1;
            const int bb = m0 >> 11, ts = (m0 & 2047) + wr * 128 + r;
            bf16_t* vt = (bf16_t*)(p.ws + OFF_VT) + ((size_t)((brn * 8 + bb) * 2 + gg) * 64) * SEQ + ts;
#pragma unroll
            for (int mi = 0; mi < 8; mi++)
#pragma unroll
                for (int ni = 0; ni < 4; ni++)
#pragma unroll
                    for (int j = 0; j < 4; j++) vt[(size_t)(ni * 16 + 4 * q + j) * SEQ + mi * 16] = f2bf(acc[mi][ni][j]);
        }
        __syncthreads();
        epi_store(lds, Z, ZC, m0, n0, ZC);
        __syncthreads();
    }
}

__device__ __forceinline__ void gla_prep(const Params& p, int tok0, int h, char* lds) {
    const int tid = TIDX;
    float* bc = (float*)lds;
    float* lrs = (float*)(lds + 32768);
    const bf16_t* Z = (const bf16_t*)(p.ws + OFF_Z);
    for (int i = tid; i < 1024; i += NTHREADS) { const int t = i >> 4, rr = i & 15; lrs[i] = bf2f(Z[(size_t)(tok0 + t) * ZC + ZLR + rr]); }
    const int d = tid & 127, th = tid >> 7;
    float w[16];
#pragma unroll
    for (int rr = 0; rr < 16; rr++) w[rr] = p.gla_wa2[rr * 512 + h * 128 + d];
    const float bias = p.gla_ba2[h * 128 + d];
    __syncthreads();
    float run = 0.f;
    for (int t = th * 32; t < th * 32 + 32; t++) {
        float xv = bias;
#pragma unroll
        for (int rr = 0; rr < 16; rr++) xv += lrs[t * 16 + rr] * w[rr];
        const float ls = fminf(xv, 0.f) - __logf(1.f + __expf(-fabsf(xv)));
        run += ls * (1.f / 16.f);
        bc[t * 128 + d] = run;
    }
    __syncthreads();
    if (th == 1) {
        const float add = bc[31 * 128 + d];
        for (int t = 32; t < 64; t++) bc[t * 128 + d] += add;
    }
    __syncthreads();
}

__device__ void phaseG1_task(const Params& p, int task, char* lds) {
    const int tid = TIDX, lane = tid & 63, wave = tid >> 6, r = lane & 15, q = lane >> 4;
    const int c = task & 31, h = (task >> 5) & 3, b = task >> 7;
    const int tok0 = b * SEQ + c * 64;
    const bf16_t* Z = (const bf16_t*)(p.ws + OFF_Z);
    bf16_t* L = (bf16_t*)p.out;
    float* bc = (float*)lds;
    bf16_t* klT = (bf16_t*)(lds + 36864);
    bf16_t* vT = (bf16_t*)(lds + 36864 + 18432);
    gla_prep(p, tok0, h, lds);
    if (tid < 128) ((float*)(p.ws + OFF_DEC))[task * 128 + tid] = __expf(bc[63 * 128 + tid]);
    {
        f32x4* bg = (f32x4*)(p.ws + OFF_M) + (size_t)task * 2048;
#pragma unroll
        for (int i = 0; i < 8; i++) bg[i * 256 + tid] = ((const f32x4*)bc)[i * 256 + tid];
    }
    {
        const int s = lane, dc = wave * 32;
        const bf16_t* kp = Z + (size_t)(tok0 + s) * ZC + ZK_G + h * 128 + dc;
#pragma unroll
        for (int v4 = 0; v4 < 4; v4++) {
            const u32x4 kv = *(const u32x4*)(kp + v4 * 8);
            const unsigned kw[4] = {kv.x, kv.y, kv.z, kv.w};
#pragma unroll
            for (int j = 0; j < 8; j++) {
                const int d = dc + v4 * 8 + j;
                const float kval = (j & 1) ? bf_hi(kw[j >> 1]) : bf_lo(kw[j >> 1]);
                klT[d * 72 + s] = f2bf(kval * __expf(bc[63 * 128 + d] - bc[s * 128 + d]));
            }
        }
    }
    for (int eh = 0; eh < 2; eh++) {
        __syncthreads();
        {
            const int s = lane, ec = wave * 32;
            const bf16_t* vp = Z + (size_t)(tok0 + s) * ZC + ZV_G + h * 256 + eh * 128 + ec;
#pragma unroll
            for (int v4 = 0; v4 < 4; v4++) {
                const u32x4 vv = *(const u32x4*)(vp + v4 * 8);
                const unsigned vw[4] = {vv.x, vv.y, vv.z, vv.w};
#pragma unroll
                for (int j = 0; j < 8; j++) vT[(ec + v4 * 8 + j) * 72 + s] = (bf16_t)((j & 1) ? (vw[j >> 1] >> 16) : (vw[j >> 1] & 0xffffu));
            }
        }
        __syncthreads();
        f32x4 acc[8][2];
#pragma unroll
        for (int dt = 0; dt < 8; dt++) { acc[dt][0] = (f32x4){0.f, 0.f, 0.f, 0.f}; acc[dt][1] = (f32x4){0.f, 0.f, 0.f, 0.f}; }
#pragma unroll
        for (int ks = 0; ks < 2; ks++) {
            bf16x8 bv[2];
#pragma unroll
            for (int x = 0; x < 2; x++) bv[x] = ld_frag(vT + ((2 * wave + x) * 16 + r) * 72 + ks * 32 + q * 8);
#pragma unroll
            for (int dt = 0; dt < 8; dt++) {
                const bf16x8 a = ld_frag(klT + (dt * 16 + r) * 72 + ks * 32 + q * 8);
#pragma unroll
                for (int x = 0; x < 2; x++) acc[dt][x] = mfma16(a, bv[x], acc[dt][x]);
            }
        }
#pragma unroll
        for (int dt = 0; dt < 8; dt++)
#pragma unroll
            for (int x = 0; x < 2; x++) {
                const int e = eh * 128 + (2 * wave + x) * 16 + r, d = dt * 16 + 4 * q;
                const f32x4 v = acc[dt][x];
                *(u32x2*)(L + ((size_t)task * 256 + e) * 128 + d) = (u32x2){pack2(v[0], v[1]), pack2(v[2], v[3])};
            }
    }
    __syncthreads();
}

__device__ void phaseG2(const Params& p) {
    bf16_t* L = (bf16_t*)p.out;
    const float* dec = (const float*)(p.ws + OFF_DEC);
    for (int idx = vblk() * NTHREADS + (int)(threadIdx.x & 255); idx < 32 * 256 * 16; idx += vgrid() * NTHREADS) {
        const int d8 = idx & 15, e = (idx >> 4) & 255, bh = idx >> 12;
        float st[8];
#pragma unroll
        for (int j = 0; j < 8; j++) st[j] = 0.f;
        for (int c = 0; c < 32; c++) {
            const int task = bh * 32 + c;
            u32x4* ptr = (u32x4*)(L + ((size_t)task * 256 + e) * 128 + d8 * 8);
            const u32x4 lv = *ptr;
            const f32x4 d0 = *(const f32x4*)(dec + task * 128 + d8 * 8), d1 = *(const f32x4*)(dec + task * 128 + d8 * 8 + 4);
            *ptr = (u32x4){pack2(st[0], st[1]), pack2(st[2], st[3]), pack2(st[4], st[5]), pack2(st[6], st[7])};
            st[0] = d0[0] * st[0] + bf_lo(lv.x); st[1] = d0[1] * st[1] + bf_hi(lv.x);
            st[2] = d0[2] * st[2] + bf_lo(lv.y); st[3] = d0[3] * st[3] + bf_hi(lv.y);
            st[4] = d1[0] * st[4] + bf_lo(lv.z); st[5] = d1[1] * st[5] + bf_hi(lv.z);
            st[6] = d1[2] * st[6] + bf_lo(lv.w); st[7] = d1[3] * st[7] + bf_hi(lv.w);
        }
    }
}

__device__ void phaseG3_task(const Params& p, int task, char* lds, bf16_t* ydst, int ystride) {
    const int tid = TIDX, lane = tid & 63, wave = tid >> 6, r = lane & 15, q = lane >> 4;
    const int c = task & 31, h = (task >> 5) & 3, b = task >> 7;
    const int tok0 = b * SEQ + c * 64;
    bf16_t* Z = (bf16_t*)(p.ws + OFF_Z);
    const bf16_t* ST = (const bf16_t*)p.out + (size_t)task * 256 * 128;
    float* bc = (float*)lds;
    bf16_t* vT = (bf16_t*)lds;
    bf16_t* qg = (bf16_t*)(lds + 36864);
    bf16_t* kg = (bf16_t*)(lds + 36864 + 17408);
    bf16_t* P = kg;
    float* red = (float*)(lds + 36864 + 2 * 17408);
    {
        const f32x4* bg = (const f32x4*)(p.ws + OFF_M) + (size_t)task * 2048;
#pragma unroll
        for (int i = 0; i < 8; i++) ((f32x4*)bc)[i * 256 + tid] = bg[i * 256 + tid];
    }
    __syncthreads();
    {
        const int t = tid >> 2, dc = (tid & 3) * 32;
        const bf16_t* qp = Z + (size_t)(tok0 + t) * ZC + ZQ_G + h * 128 + dc;
        const bf16_t* kp = Z + (size_t)(tok0 + t) * ZC + ZK_G + h * 128 + dc;
#pragma unroll
        for (int v4 = 0; v4 < 4; v4++) {
            const u32x4 qv = *(const u32x4*)(qp + v4 * 8), kv = *(const u32x4*)(kp + v4 * 8);
            const unsigned qw[4] = {qv.x, qv.y, qv.z, qv.w}, kw[4] = {kv.x, kv.y, kv.z, kv.w};
            unsigned qo[4], ko[4];
#pragma unroll
            for (int j2 = 0; j2 < 4; j2++) {
                const int d = dc + v4 * 8 + j2 * 2;
                const float b0 = bc[t * 128 + d], b1 = bc[t * 128 + d + 1];
                qo[j2] = pack2(bf_lo(qw[j2]) * 0.08838834764831845f * __expf(b0), bf_hi(qw[j2]) * 0.08838834764831845f * __expf(b1));
                ko[j2] = pack2(bf_lo(kw[j2]) * __expf(-b0), bf_hi(kw[j2]) * __expf(-b1));
            }
            *(u32x4*)(qg + t * 136 + dc + v4 * 8) = (u32x4){qo[0], qo[1], qo[2], qo[3]};
            *(u32x4*)(kg + t * 136 + dc + v4 * 8) = (u32x4){ko[0], ko[1], ko[2], ko[3]};
        }
    }
    __syncthreads();
    {
        const int s = lane, ec = wave * 64;
        const bf16_t* vp = Z + (size_t)(tok0 + s) * ZC + ZV_G + h * 256 + ec;
#pragma unroll
        for (int v4 = 0; v4 < 8; v4++) {
            const u32x4 vv = *(const u32x4*)(vp + v4 * 8);
            const unsigned vw[4] = {vv.x, vv.y, vv.z, vv.w};
#pragma unroll
            for (int j = 0; j < 8; j++) vT[(ec + v4 * 8 + j) * 72 + s] = (bf16_t)((j & 1) ? (vw[j >> 1] >> 16) : (vw[j >> 1] & 0xffffu));
        }
    }
    f32x4 sc[4];
#pragma unroll
    for (int st = 0; st < 4; st++) sc[st] = (f32x4){0.f, 0.f, 0.f, 0.f};
    {
        bf16x8 qf[4];
#pragma unroll
        for (int ks = 0; ks < 4; ks++) qf[ks] = ld_frag(qg + (wave * 16 + r) * 136 + ks * 32 + q * 8);
#pragma unroll
        for (int st = 0; st < 4; st++) {
            if (st <= wave) {
#pragma unroll
                for (int ks = 0; ks < 4; ks++) sc[st] = mfma16(ld_frag(kg + (st * 16 + r) * 136 + ks * 32 + q * 8), qf[ks], sc[st]);
            }
        }
    }
    __syncthreads();
    {
        const int t = wave * 16 + r;
#pragma unroll
        for (int st = 0; st < 4; st++) {
            float pv[4];
#pragma unroll
            for (int j = 0; j < 4; j++) { const int s = st * 16 + 4 * q + j; pv[j] = (s <= t) ? sc[st][j] : 0.f; }
            *(u32x2*)(P + t * 72 + st * 16 + 4 * q) = (u32x2){pack2(pv[0], pv[1]), pack2(pv[2], pv[3])};
        }
    }
    __syncthreads();
    f32x4 o[4][4];
#pragma unroll
    for (int et = 0; et < 4; et++)
#pragma unroll
        for (int tt = 0; tt < 4; tt++) o[et][tt] = (f32x4){0.f, 0.f, 0.f, 0.f};
#pragma unroll
    for (int ks = 0; ks < 2; ks++) {
        bf16x8 pf[4];
#pragma unroll
        for (int tt = 0; tt < 4; tt++) pf[tt] = ld_frag(P + (tt * 16 + r) * 72 + ks * 32 + q * 8);
#pragma unroll
        for (int et = 0; et < 4; et++) {
            const bf16x8 a = ld_frag(vT + ((wave * 4 + et) * 16 + r) * 72 + ks * 32 + q * 8);
#pragma unroll
            for (int tt = 0; tt < 4; tt++) o[et][tt] = mfma16(a, pf[tt], o[et][tt]);
        }
    }
#pragma unroll
    for (int ks = 0; ks < 4; ks++) {
        bf16x8 qf[4];
#pragma unroll
        for (int tt = 0; tt < 4; tt++) qf[tt] = ld_frag(qg + (tt * 16 + r) * 136 + ks * 32 + q * 8);
#pragma unroll
        for (int et = 0; et < 4; et++) {
            const bf16x8 a = *(const bf16x8*)(ST + (size_t)((wave * 4 + et) * 16 + r) * 128 + ks * 32 + q * 8);
#pragma unroll
            for (int tt = 0; tt < 4; tt++) o[et][tt] = mfma16(a, qf[tt], o[et][tt]);
        }
    }
#pragma unroll
    for (int tt = 0; tt < 4; tt++) {
        float ss = 0.f;
#pragma unroll
        for (int et = 0; et < 4; et++)
#pragma unroll
            for (int j = 0; j < 4; j++) ss += o[et][tt][j] * o[et][tt][j];
        ss += __shfl_xor(ss, 16, 64);
        ss += __shfl_xor(ss, 32, 64);
        if (q == 0) red[wave * 64 + tt * 16 + r] = ss;
    }
    __syncthreads();
#pragma unroll
    for (int tt = 0; tt < 4; tt++) {
        const int t = tt * 16 + r;
        const float tot = red[t] + red[64 + t] + red[128 + t] + red[192 + t];
        const float rstd = rsqrtf(tot * (1.f / 256.f) + 1e-6f);
#pragma unroll
        for (int et = 0; et < 4; et++) {
            const int e = (wave * 4 + et) * 16 + 4 * q;
            bf16_t* rp = Z + (size_t)(tok0 + t) * ZC + ZR_G + h * 256 + e;
            const u32x2 rv = *(const u32x2*)rp;
            const f32x4 gn = *(const f32x4*)(p.gla_norm_g + e);
            const float r0 = bf_lo(rv.x), r1 = bf_hi(rv.x), r2 = bf_lo(rv.y), r3 = bf_hi(rv.y);
            const f32x4 ov = o[et][tt];
            *(u32x2*)(ydst + (size_t)(tok0 + t) * ystride + h * 256 + e) = (u32x2){pack2(ov[0] * rstd * gn[0] * siluf_(r0), ov[1] * rstd * gn[1] * siluf_(r1)),
                                  pack2(ov[2] * rstd * gn[2] * siluf_(r2), ov[3] * rstd * gn[3] * siluf_(r3))};
        }
    }
    __syncthreads();
}

__device__ void phaseN1_task(const Params& p, int task, char* lds) {
    const int tid = TIDX, lane = tid & 63, wave = tid >> 6, r = lane & 15, q = lane >> 4;
    const int it = task & 15, g = (task >> 4) & 1, b = (task >> 5) & 7, kv = task >> 8;
    const bf16_t* Z = (const bf16_t*)(p.ws + OFF_Z);
    const bf16_t* W1 = (const bf16_t*)(p.ws + OFF_WC1) + (size_t)kv * 64 * 2048;
    const float* pe = kv ? p.pe_v : p.pe_k;
    const float* w2 = kv ? p.cv_w2 : p.ck_w2;
    const int zoff = (kv ? ZVC : ZKC) + g * 64;
    float* hid = (float*)lds;
    float* hid2 = (float*)(lds + 16384);
    int i = it * 8 + (r & 7); if (i > 126) i = 126;
    f32x4 acc[4];
#pragma unroll
    for (int nt = 0; nt < 4; nt++) acc[nt] = (f32x4){0.f, 0.f, 0.f, 0.f};
    for (int ks = 0; ks < 16; ks++) {
        const int k = wave * 512 + ks * 32 + q * 8;
        const int l = k >> 6, d = k & 63;
        const u32x4 zv = *(const u32x4*)(Z + (size_t)(b * SEQ + i * 16 + l) * ZC + zoff + d);
        const f32x4 p0 = *(const f32x4*)(pe + l * 64 + d), p1 = *(const f32x4*)(pe + l * 64 + d + 4);
        const u32x4 av = {pack2(bf_lo(zv.x) + p0[0], bf_hi(zv.x) + p0[1]), pack2(bf_lo(zv.y) + p0[2], bf_hi(zv.y) + p0[3]),
                          pack2(bf_lo(zv.z) + p1[0], bf_hi(zv.z) + p1[1]), pack2(bf_lo(zv.w) + p1[2], bf_hi(zv.w) + p1[3])};
        const bf16x8 a = __builtin_bit_cast(bf16x8, av);
#pragma unroll
        for (int nt = 0; nt < 4; nt++) {
            const bf16x8 bw = *(const bf16x8*)(W1 + (size_t)(nt * 16 + r) * 2048 + k);
            acc[nt] = mfma16(a, bw, acc[nt]);
        }
    }
#pragma unroll
    for (int nt = 0; nt < 4; nt++)
#pragma unroll
        for (int j = 0; j < 4; j++) hid[(wave * 16 + 4 * q + j) * 64 + nt * 16 + r] = acc[nt][j];
    __syncthreads();
    for (int e = tid; e < 1024; e += NTHREADS) hid2[e] = gelu_erf(hid[e] + hid[1024 + e] + hid[2048 + e] + hid[3072 + e]);
    __syncthreads();
    {
        const int il = tid >> 4, n2 = (tid & 15) * 4;
        f32x4 o = {0.f, 0.f, 0.f, 0.f};
        for (int n = 0; n < 64; n++) {
            const float hv = hid2[il * 64 + n];
            const f32x4 wv = *(const f32x4*)(w2 + n * 64 + n2);
            o += hv * wv;
        }
        const int ig = it * 8 + il;
        if (ig >= 127) o = (f32x4){0.f, 0.f, 0.f, 0.f};
        bf16_t* dst = (bf16_t*)(p.ws + OFF_CMP) + ((size_t)((kv * 8 + b) * 2 + g) * 128 + ig) * 64 + n2;
        if (il < 8) *(u32x2*)dst = (u32x2){pack2(o[0], o[1]), pack2(o[2], o[3])};
    }
    __syncthreads();
}

__device__ __forceinline__ void nsa_block_step(const bf16_t* Ks, const bf16_t* VT, const bf16x8 (&qf)[2][2], f32x4 (&O)[2][4], float (&m)[2], float (&l)[2],
                                               int klo, int khi, int r, int q) {
    f32x4 s[2][4];
#pragma unroll
    for (int x = 0; x < 2; x++)
#pragma unroll
        for (int kt = 0; kt < 4; kt++) s[x][kt] = (f32x4){0.f, 0.f, 0.f, 0.f};
#pragma unroll
    for (int kt = 0; kt < 4; kt++)
#pragma unroll
        for (int ks = 0; ks < 2; ks++) {
            const bf16x8 kf = ld_frag(Ks + (kt * 16 + r) * 64 + (((ks * 4 + q) ^ (r & 7)) * 8));
#pragma unroll
            for (int x = 0; x < 2; x++) s[x][kt] = mfma16(kf, qf[x][ks], s[x][kt]);
        }
    if (!__all((klo <= 0) && (khi >= 63))) {
        const int a = 4 * q - klo;
        const unsigned range = (unsigned)(khi - klo);
        const bool any = khi >= klo;
#pragma unroll
        for (int kt = 0; kt < 4; kt++)
#pragma unroll
            for (int j = 0; j < 4; j++) {
                const bool valid = any && ((unsigned)(kt * 16 + j + a) <= range);
#pragma unroll
                for (int x = 0; x < 2; x++) s[x][kt][j] = valid ? s[x][kt][j] : -3.0e38f;
            }
    }
    bf16x8 pbv[2][2];
#pragma unroll
    for (int x = 0; x < 2; x++) {
        float mx = fmaxf(fmaxf(fmaxf(s[x][0][0], s[x][0][1]), fmaxf(s[x][0][2], s[x][0][3])), fmaxf(fmaxf(s[x][1][0], s[x][1][1]), fmaxf(s[x][1][2], s[x][1][3])));
        mx = fmaxf(mx, fmaxf(fmaxf(fmaxf(s[x][2][0], s[x][2][1]), fmaxf(s[x][2][2], s[x][2][3])), fmaxf(fmaxf(s[x][3][0], s[x][3][1]), fmaxf(s[x][3][2], s[x][3][3]))));
        mx = fmaxf(mx, __shfl_xor(mx, 16, 64));
        mx = fmaxf(mx, __shfl_xor(mx, 32, 64));
        const float mnew = fmaxf(m[x], mx);
        const float alpha = exp2f_(m[x] - mnew);
        m[x] = mnew;
        float ls = 0.f;
#pragma unroll
        for (int kt = 0; kt < 4; kt++)
#pragma unroll
            for (int j = 0; j < 4; j++) { const float pv = exp2f_(s[x][kt][j] - mnew); s[x][kt][j] = pv; ls += pv; }
        l[x] = l[x] * alpha + ls;
#pragma unroll
        for (int dt = 0; dt < 4; dt++) O[x][dt] *= alpha;
#pragma unroll
        for (int s2 = 0; s2 < 2; s2++) {
            const u32x4 t4 = {pack2(s[x][2 * s2][0], s[x][2 * s2][1]), pack2(s[x][2 * s2][2], s[x][2 * s2][3]),
                              pack2(s[x][2 * s2 + 1][0], s[x][2 * s2 + 1][1]), pack2(s[x][2 * s2 + 1][2], s[x][2 * s2 + 1][3])};
            pbv[x][s2] = __builtin_bit_cast(bf16x8, t4);
        }
    }
#pragma unroll
    for (int s2 = 0; s2 < 2; s2++)
#pragma unroll
        for (int dt = 0; dt < 4; dt++) {
            const u32x2 lo = *(const u32x2*)(VT + (dt * 16 + r) * 72 + (2 * s2) * 16 + 4 * q);
            const u32x2 hi = *(const u32x2*)(VT + (dt * 16 + r) * 72 + (2 * s2 + 1) * 16 + 4 * q);
            const bf16x8 va = mk_frag(lo, hi);
#pragma unroll
            for (int x = 0; x < 2; x++) O[x][dt] = mfma16(va, pbv[x][s2], O[x][dt]);
        }
}

__device__ __forceinline__ void nsa_cmp_probs(const bf16_t* Kc, const bf16x8 (&qfx)[2], int nv, int r, int q, f32x4 (&s)[8]) {
#pragma unroll
    for (int kt = 0; kt < 8; kt++) s[kt] = (f32x4){0.f, 0.f, 0.f, 0.f};
#pragma unroll
    for (int kt = 0; kt < 8; kt++)
#pragma unroll
        for (int ks = 0; ks < 2; ks++) s[kt] = mfma16(ld_frag(Kc + (kt * 16 + r) * 72 + ks * 32 + q * 8), qfx[ks], s[kt]);
    float mx = -1e30f;
#pragma unroll
    for (int kt = 0; kt < 8; kt++)
#pragma unroll
        for (int j = 0; j < 4; j++) if (kt * 16 + 4 * q + j < nv) mx = fmaxf(mx, s[kt][j]);
    mx = fmaxf(mx, __shfl_xor(mx, 16, 64));
    mx = fmaxf(mx, __shfl_xor(mx, 32, 64));
    float ls = 0.f;
#pragma unroll
    for (int kt = 0; kt < 8; kt++)
#pragma unroll
        for (int j = 0; j < 4; j++) {
            const float pv = (kt * 16 + 4 * q + j < nv) ? exp2f_(s[kt][j] - mx) : 0.f;
            s[kt][j] = pv; ls += pv;
        }
    ls += __shfl_xor(ls, 16, 64);
    ls += __shfl_xor(ls, 32, 64);
    const float inv = nv > 0 ? 1.f / ls : 0.f;
#pragma unroll
    for (int kt = 0; kt < 8; kt++) s[kt] *= inv;
}

__device__ void phaseN2_task(const Params& p, int task, char* lds, bf16_t* ydst, int ystride, volatile unsigned* uex, char* ldsb) {
    const int tid = TIDX, lane = tid & 63, wave = tid >> 6, r = lane & 15, q = lane >> 4;
    const int t512 = tid + half_id() * 256;
    const int pair = task >> 1, g = pair & 1, b = (pair >> 1) & 7;
    const int tt = (63 - (pair >> 4)) * 2 + (task & 1);
    const int t0 = tt * 16, t = t0 + r;
    const int cur = t0 >> 6;
    bf16_t* Z = (bf16_t*)(p.ws + OFF_Z);
    const size_t rowb = (size_t)b * SEQ;
    bf16_t* Kc = (bf16_t*)ldsb;
    bf16_t* VcT = (bf16_t*)(ldsb + 18432);
    bf16_t* Ks = (bf16_t*)ldsb;
    bf16_t* VT = (bf16_t*)(ldsb + 18432);
    float* impw = (float*)(lds + 35840);
    float* scs = (float*)(lds + 35840 + 32768);
    unsigned* selm = (unsigned*)(lds + 35840 + 32768 + 2048);

    bf16x8 qf[2][2];
#pragma unroll
    for (int x = 0; x < 2; x++)
#pragma unroll
        for (int ks = 0; ks < 2; ks++) qf[x][ks] = *(const bf16x8*)(Z + (rowb + t) * ZC + ZQ_N + (g * 8 + 2 * wave + x) * 64 + ks * 32 + q * 8);
    f32x4* ofl = (f32x4*)(lds + 35840);

    f32x4 Og[2][4];
    {
        const bf16_t* kc = (const bf16_t*)(p.ws + OFF_CMP) + (size_t)((0 * 8 + b) * 2 + g) * 128 * 64;
        const bf16_t* vc = (const bf16_t*)(p.ws + OFF_CMP) + (size_t)((1 * 8 + b) * 2 + g) * 128 * 64;
        {
            const int key = t512 >> 2, ch = (t512 & 3) * 16;
#pragma unroll
            for (int v4 = 0; v4 < 2; v4++) *(u32x4*)(Kc + key * 72 + ch + v4 * 8) = *(const u32x4*)(kc + key * 64 + ch + v4 * 8);
            const int k2 = t512 & 127, dc = (t512 >> 7) * 16;
#pragma unroll
            for (int v4 = 0; v4 < 2; v4++) {
                const u32x4 a = *(const u32x4*)(vc + k2 * 64 + dc + v4 * 8);
                const unsigned w[4] = {a.x, a.y, a.z, a.w};
#pragma unroll
                for (int j = 0; j < 8; j++) VcT[(dc + v4 * 8 + j) * 136 + k2] = (bf16_t)((j & 1) ? (w[j >> 1] >> 16) : (w[j >> 1] & 0xffffu));
            }
        }
        __syncthreads();
        int nv = t >= 31 ? ((t - 31) >> 4) + 1 : 0;
        if (nv > 127) nv = 127;
        f32x4 isum[8];
#pragma unroll
        for (int kt = 0; kt < 8; kt++) isum[kt] = (f32x4){0.f, 0.f, 0.f, 0.f};
#pragma unroll
        for (int x = 0; x < 2; x++) {
            f32x4 s[8];
            nsa_cmp_probs(Kc, qf[x], nv, r, q, s);
#pragma unroll
            for (int kt = 0; kt < 8; kt++) isum[kt] += s[kt];
            f32x4 Oc[4];
#pragma unroll
            for (int dt = 0; dt < 4; dt++) Oc[dt] = (f32x4){0.f, 0.f, 0.f, 0.f};
            __builtin_amdgcn_sched_barrier(0);
#pragma unroll
            for (int s2 = 0; s2 < 4; s2++) {
                const u32x4 t4 = {pack2(s[2 * s2][0], s[2 * s2][1]), pack2(s[2 * s2][2], s[2 * s2][3]),
                                  pack2(s[2 * s2 + 1][0], s[2 * s2 + 1][1]), pack2(s[2 * s2 + 1][2], s[2 * s2 + 1][3])};
                const bf16x8 pbv = __builtin_bit_cast(bf16x8, t4);
#pragma unroll
                for (int dt = 0; dt < 4; dt++) {
                    const u32x2 lo = *(const u32x2*)(VcT + (dt * 16 + r) * 136 + (2 * s2) * 16 + 4 * q);
                    const u32x2 hi = *(const u32x2*)(VcT + (dt * 16 + r) * 136 + (2 * s2 + 1) * 16 + 4 * q);
                    Oc[dt] = mfma16(mk_frag(lo, hi), pbv, Oc[dt]);
                }
            }
            const float g0 = sigmoidf_(bf2f(Z[(rowb + t) * ZC + ZGATE + 0 * 16 + g * 8 + 2 * wave + x]));
#pragma unroll
            for (int dt = 0; dt < 4; dt++) Og[x][dt] = g0 * Oc[dt];
            __builtin_amdgcn_sched_barrier(0);
        }
#pragma unroll
        for (int kt = 0; kt < 8; kt++) *(f32x4*)(impw + (wave * 16 + r) * 128 + kt * 16 + 4 * q) = isum[kt];
        __syncthreads();
#pragma unroll
        for (int pass = 0; pass < 2; pass++) {
            const int tk = pass * 8 + (tid >> 5), j = tid & 31;
            const int i0 = j == 0 ? 0 : 4 * j - 1, i1 = (4 * j + 3 > 126) ? 126 : 4 * j + 3;
            float sc = 0.f;
            for (int i = i0; i <= i1; i++) sc += (impw[(0 * 16 + tk) * 128 + i] + impw[(1 * 16 + tk) * 128 + i]) + (impw[(2 * 16 + tk) * 128 + i] + impw[(3 * 16 + tk) * 128 + i]);
            const bool forced = (j == 0) || (j == cur) || (j == cur - 1);
            scs[tk * 32 + j] = forced ? 1e6f : (j <= cur ? sc : -1.f);
        }
        __syncthreads();
#pragma unroll
        for (int pass = 0; pass < 2; pass++) {
            const int tk = pass * 8 + (tid >> 5), j = tid & 31;
            const float mine = scs[tk * 32 + j];
            int rank = 0;
            for (int j2 = 0; j2 < 32; j2++) { const float o = scs[tk * 32 + j2]; rank += (o > mine || (o == mine && j2 < j)) ? 1 : 0; }
            const unsigned long long bal = __ballot(rank < 16);
            if ((lane & 31) == 0) selm[tk] = (unsigned)(lane ? (bal >> 32) : (bal & 0xffffffffull));
        }
        __syncthreads();
    }
#pragma unroll
    for (int x = 0; x < 2; x++)
#pragma unroll
        for (int dt = 0; dt < 4; dt++) ofl[(wave * 8 + x * 4 + dt) * 64 + lane] = Og[x][dt];
    const unsigned mysel = selm[r];
    unsigned uni = 0;
#pragma unroll
    for (int i = 0; i < 16; i++) uni |= selm[i];
    if (tid == 0) uex[half_id()] = uni;
    __syncthreads();
    uni = uex[0] | uex[1];
    uni &= (cur == 31) ? 0xffffffffu : ((2u << cur) - 1u);
    uni |= 1u;

    {
        const int lo = (t0 & ~31) - 511;
        const int jb0 = lo > 0 ? (lo >> 6) : 0;
        const int kkey = t512 >> 3, kch = (t512 & 7) * 8;
        const int vd = t512 >> 3, vch = (t512 & 7) * 8;
        const bf16_t* vtb = (const bf16_t*)(p.ws + OFF_VT) + ((size_t)(b * 2 + g) * 64 + vd) * SEQ + vch;
        u32x4 kreg, vreg;
        int br = 0, j = 0;
        {
            const bf16_t* kb = Z + (rowb + 0) * ZC + ZKS + g * 64;
            kreg = *(const u32x4*)(kb + (size_t)kkey * ZC + kch);
            vreg = *(const u32x4*)(vtb);
        }
        f32x4 O[2][4];
        float m[2] = {-1e30f, -1e30f}, l[2] = {0.f, 0.f};
#pragma unroll
        for (int x = 0; x < 2; x++)
#pragma unroll
            for (int dt = 0; dt < 4; dt++) O[x][dt] = (f32x4){0.f, 0.f, 0.f, 0.f};
        for (;;) {
            __syncthreads();
            *(u32x4*)(Ks + kkey * 64 + (((kch >> 3) ^ (kkey & 7)) * 8)) = kreg;
            *(u32x4*)(VT + vd * 72 + vch) = vreg;
            __syncthreads();
            int nbr, nj;
            if (br == 0) {
                const unsigned rem = (j >= 31) ? 0u : (uni & ~((2u << j) - 1u));
                if (rem) { nbr = 0; nj = __ffs((int)rem) - 1; } else { nbr = 1; nj = jb0; }
            } else {
                if (j < cur) { nbr = 1; nj = j + 1; } else { nbr = 2; nj = 0; }
            }
            if (nbr < 2) {
                const bf16_t* kb = Z + (rowb + nj * 64) * ZC + (nbr ? ZKW : ZKS) + g * 64;
                kreg = *(const u32x4*)(kb + (size_t)kkey * ZC + kch);
                vreg = *(const u32x4*)(vtb + (size_t)nbr * (8 * 2 * 64) * SEQ + nj * 64);
            }
            int klo = 0, khi = -1;
            if (br == 0) { if ((mysel >> j) & 1u) khi = t - j * 64; }
            else { khi = t - j * 64; klo = t - 511 - j * 64; }
            klo = klo < 0 ? 0 : klo;
            khi = khi > 63 ? 63 : khi;
            nsa_block_step(Ks, VT, qf, O, m, l, klo, khi, r, q);
            if (nbr != br) {
#pragma unroll
                for (int x = 0; x < 2; x++) {
                    float lt = l[x];
                    lt += __shfl_xor(lt, 16, 64);
                    lt += __shfl_xor(lt, 32, 64);
                    const float sc = sigmoidf_(bf2f(Z[(rowb + t) * ZC + ZGATE + (br + 1) * 16 + g * 8 + 2 * wave + x])) / lt;
#pragma unroll
                    for (int dt = 0; dt < 4; dt++) { ofl[(wave * 8 + x * 4 + dt) * 64 + lane] += sc * O[x][dt]; O[x][dt] = (f32x4){0.f, 0.f, 0.f, 0.f}; }
                    m[x] = -1e30f; l[x] = 0.f;
                }
            }
            if (nbr == 2) break;
            br = nbr; j = nj;
        }
#pragma unroll
        for (int x = 0; x < 2; x++)
#pragma unroll
            for (int dt = 0; dt < 4; dt++) {
                const f32x4 v = ofl[(wave * 8 + x * 4 + dt) * 64 + lane];
                *(u32x2*)(ydst + (rowb + t) * ystride + (g * 8 + 2 * wave + x) * 64 + dt * 16 + 4 * q) = (u32x2){pack2(v[0], v[1]), pack2(v[2], v[3])};
            }
    }
    __syncthreads();
}

__device__ void phaseM1(const Params& p, char* lds) {
    const int tid_ = TIDX512; const int lane = tid_ & 63, wave = tid_ >> 6;
    const int wr = wave >> 2, wc = wave & 3, r = lane & 15, q = lane >> 4;
    const bf16_t* H = (const bf16_t*)(p.ws + OFF_H);
    const bf16_t* Z = (const bf16_t*)(p.ws + OFF_Z);
    bf16_t* M = (bf16_t*)(p.ws + OFF_M);
    bf16_t* SG = (bf16_t*)p.out;
    TileIter tit(4, lds);
    int bm, bn;
    while (tit.next(bm, bn)) {
        const int m0 = bm * 256, n0 = bn * 256;
        for (int br = 0; br < 2; br++) {
            f32x4 acc[8][4];
            zero_acc(acc);
            gemm_core(acc, H, DM, (const bf16_t*)(p.ws + OFF_WM) + (size_t)br * 1024 * 1024, DM, DM, m0, n0, lds);
            {
                const int e0 = launder_i((m0 + wr * 128 + r) * DM + n0 + wc * 64 + 4 * q);
#pragma unroll
                for (int mi = 0; mi < 8; mi++)
#pragma unroll
                    for (int ni = 0; ni < 4; ni++)
                        *(u32x2*)(SG + (size_t)(e0 + mi * 16 * DM + ni * 16)) = (u32x2){pack2(sigmoidf_(acc[mi][ni][0]), sigmoidf_(acc[mi][ni][1])),
                                                                                        pack2(sigmoidf_(acc[mi][ni][2]), sigmoidf_(acc[mi][ni][3]))};
            }
            zero_acc(acc);
            gemm_core(acc, Z + (br ? ZQ_N : ZR_G), ZC, (const bf16_t*)(p.ws + (br ? OFF_WB : OFF_WA)), DM, DM, m0, n0, lds);
            {
                const int e0 = launder_i((m0 + wr * 128 + r) * DM + n0 + wc * 64 + 4 * q);
#pragma unroll
                for (int mi = 0; mi < 8; mi++)
#pragma unroll
                    for (int ni = 0; ni < 4; ni++) {
                        const size_t eo = (size_t)(e0 + mi * 16 * DM + ni * 16);
                        const u32x2 sg = *(const u32x2*)(SG + eo);
                        float v[4] = {bf_lo(sg.x) * acc[mi][ni][0], bf_hi(sg.x) * acc[mi][ni][1], bf_lo(sg.y) * acc[mi][ni][2], bf_hi(sg.y) * acc[mi][ni][3]};
                        u32x2* dst = (u32x2*)(M + eo);
                        if (br) { const u32x2 pv = *dst; v[0] += bf_lo(pv.x); v[1] += bf_hi(pv.x); v[2] += bf_lo(pv.y); v[3] += bf_hi(pv.y); }
                        *dst = (u32x2){pack2(v[0], v[1]), pack2(v[2], v[3])};
                    }
            }
        }
    }
}

__device__ void phaseM2(const Params& p, char* lds) {
    const int tid_ = TIDX512; const int lane = tid_ & 63, wave = tid_ >> 6;
    const int wr = wave >> 2, wc = wave & 3, r = lane & 15, q = lane >> 4;
    const bf16_t* M = (const bf16_t*)(p.ws + OFF_M);
    const float* mod = (const float*)(p.ws + OFF_MOD);
    TileIter tit(4, lds);
    int bm, bn;
    while (tit.next(bm, bn)) {
        const int m0 = bm * 256, n0 = bn * 256;
        f32x4 acc[8][4];
        zero_acc(acc);
        gemm_core(acc, M, DM, (const bf16_t*)(p.ws + OFF_WO), DM, DM, m0, n0, lds);
#pragma unroll
        for (int mi = 0; mi < 8; mi++)
#pragma unroll
            for (int ni = 0; ni < 4; ni++) {
                const int tok = m0 + wr * 128 + mi * 16 + r, col = n0 + wc * 64 + ni * 16 + 4 * q;
                const f32x4 xv = *(const f32x4*)(p.x + (size_t)tok * DM + col);
                const f32x4 gt = *(const f32x4*)(mod + (tok >> 11) * 6144 + 2 * 1024 + col);
                *(f32x4*)(p.out + (size_t)tok * DM + col) = xv + gt * acc[mi][ni];
            }
    }
    {
        const int tid_ = TIDX; const int lane = tid_ & 63, wave = tid_ >> 6;
        unsigned char* tq = (unsigned char*)(p.ws + OFF_UB);
        float* tsc = (float*)(p.ws + OFF_UB + 33554432);
        for (int row = vblk() * 4 + wave; row < 32768; row += vgrid() * 4) {
            const bool isv = row >= 16384;
            const float* srcp = (isv ? p.peer_v : p.peer_u) + (size_t)(row & 16383) * DM + lane * 16;
            f32x4 a[4];
            float mx = 0.f;
#pragma unroll
            for (int i = 0; i < 4; i++) {
                a[i] = *(const f32x4*)(srcp + i * 4);
                mx = fmaxf(mx, fmaxf(fmaxf(fabsf(a[i][0]), fabsf(a[i][1])), fmaxf(fabsf(a[i][2]), fabsf(a[i][3]))));
            }
            mx = wave_max(mx);
            const float inv = mx > 0.f ? 127.f / mx : 0.f;
            const int off = isv ? 128 : 0;
            unsigned w[4];
#pragma unroll
            for (int i = 0; i < 4; i++) {
                unsigned pk = 0;
#pragma unroll
                for (int j = 0; j < 4; j++) {
                    int qi = (int)rintf(a[i][j] * inv);
                    qi = qi > 127 ? 127 : (qi < -127 ? -127 : qi);
                    pk |= ((unsigned)(qi + off) & 0xffu) << (8 * j);
                }
                w[i] = pk;
            }
            *(u32x4*)(tq + (size_t)row * DM + lane * 16) = (u32x4){w[0], w[1], w[2], w[3]};
            if (lane == 0) tsc[row] = mx * (1.f / 127.f);
        }
    }
}

__device__ void phaseP1(const Params& p, char* lds) {
    const int tid_ = TIDX512; const int lane = tid_ & 63, wave = tid_ >> 6;
    const int wr = wave >> 2, wc = wave & 3, r = lane & 15, q = lane >> 4;
    const bf16_t* H = (const bf16_t*)(p.ws + OFF_H);
    bf16_t* QP = (bf16_t*)(p.ws + OFF_QP);
    TileIter tit(8, lds);
    int bm, bn;
    while (tit.next(bm, bn)) {
        const int m0 = bm * 256, n0 = bn * 256;
        f32x4 acc[8][4];
        zero_acc(acc);
        gemm_core(acc, H, DM, (const bf16_t*)(p.ws + OFF_WQ), DM, DM, m0, n0, lds);
#pragma unroll
        for (int mi = 0; mi < 8; mi++)
#pragma unroll
            for (int ni = 0; ni < 4; ni++) epi_fill(lds, wr, wc, r, q, mi, ni, acc[mi][ni]);
        __syncthreads();
        epi_store(lds, QP, 2048, m0, n0, 2048);
        __syncthreads();
    }
}

__constant__ unsigned char c_cand_a[64] = {0,0,0,0,0,0,0,0,0,0,0,0,0,0,0,0, 1,1,1,1,1,1,1,1, 2,2,2,2,2, 3,3,3,3, 4,4,4, 5,5, 6,6, 7,7, 8,9,10,11,12,13,14,15, 0,0,0,0,0,0,0,0,0,0,0,0,0,0};
__constant__ unsigned char c_cand_b[64] = {0,1,2,3,4,5,6,7,8,9,10,11,12,13,14,15, 0,1,2,3,4,5,6,7, 0,1,2,3,4, 0,1,2,3, 0,1,2, 0,1, 0,1, 0,1, 0,0,0,0,0,0,0,0, 0,0,0,0,0,0,0,0,0,0,0,0,0,0};

__device__ __forceinline__ unsigned f2key(float f) { const unsigned u = __float_as_uint(f); return (u & 0x80000000u) ? ~u : (u | 0x80000000u); }
__device__ __forceinline__ float key2f(unsigned k) { const unsigned u = (k & 0x80000000u) ? (k & 0x7fffffffu) : ~k; return __uint_as_float(u); }
__device__ __forceinline__ void cex_desc(unsigned& a, unsigned& b) { const unsigned hi = a > b ? a : b, lo = a > b ? b : a; a = hi; b = lo; }
__device__ __forceinline__ void sort16_desc(unsigned (&a)[16]) {
#pragma unroll
    for (int k = 2; k <= 16; k <<= 1)
#pragma unroll
        for (int j = k >> 1; j > 0; j >>= 1)
#pragma unroll
            for (int i = 0; i < 16; i++) {
                const int l = i ^ j;
                if (l > i) { if ((i & k) == 0) cex_desc(a[i], a[l]); else cex_desc(a[l], a[i]); }
            }
}
__device__ __forceinline__ void merge16_desc(unsigned (&a)[16], const unsigned (&b)[16]) {
#pragma unroll
    for (int i = 0; i < 16; i++) a[i] = a[i] > b[15 - i] ? a[i] : b[15 - i];
#pragma unroll
    for (int j = 8; j > 0; j >>= 1)
#pragma unroll
        for (int i = 0; i < 16; i++) { const int l = i ^ j; if (l > i) cex_desc(a[i], a[l]); }
}

__device__ void phaseP2_task(const Params& p, int task, char* lds) {
    const int tid = TIDX, lane = tid & 63, wave = tid >> 6, r = lane & 15, q = lane >> 4;
    const int h = task & 7, tile = task >> 3;
    const int tok0 = tile * 64;
    const bf16_t* QP = (const bf16_t*)(p.ws + OFF_QP);
    float* S = (float*)lds;
    unsigned* LL = (unsigned*)(lds + 65536);
    {
        const bf16_t* qrow = QP + (size_t)(tok0 + wave * 16 + r) * 2048 + h * 256 + q * 8;
        bf16x8 bq[2][4];
#pragma unroll
        for (int half = 0; half < 2; half++)
#pragma unroll
            for (int ks = 0; ks < 4; ks++) bq[half][ks] = *(const bf16x8*)(qrow + half * 128 + ks * 32);
#pragma unroll
        for (int half = 0; half < 2; half++) {
            const bf16_t* KB = (const bf16_t*)(p.ws + OFF_K1B) + (size_t)half * 131072 + (size_t)h * 128 * 128 + (size_t)r * 128 + q * 8;
            f32x4 acc[8];
#pragma unroll
            for (int nt = 0; nt < 8; nt++) acc[nt] = (f32x4){0.f, 0.f, 0.f, 0.f};
            bf16x8 ak[8];
#pragma unroll
            for (int nt = 0; nt < 8; nt++) ak[nt] = *(const bf16x8*)(KB + (size_t)nt * 16 * 128);
#pragma unroll
            for (int ks = 0; ks < 4; ks++) {
                bf16x8 an[8];
                if (ks + 1 < 4) {
#pragma unroll
                    for (int nt = 0; nt < 8; nt++) an[nt] = *(const bf16x8*)(KB + (size_t)nt * 16 * 128 + (ks + 1) * 32);
                }
#pragma unroll
                for (int nt = 0; nt < 8; nt++) acc[nt] = mfma16(ak[nt], bq[half][ks], acc[nt]);
                if (ks + 1 < 4) {
#pragma unroll
                    for (int nt = 0; nt < 8; nt++) ak[nt] = an[nt];
                }
            }
#pragma unroll
            for (int nt = 0; nt < 8; nt++)
#pragma unroll
                for (int j = 0; j < 4; j++) S[(half * 128 + nt * 16 + 4 * q + j) * 64 + wave * 16 + r] = acc[nt][j];
        }
    }
    __syncthreads();
    {
        const int row = tid & 127, part = tid >> 7, half = row >> 6, tk = row & 63;
        unsigned L[16];
        const float* sp = S + (half * 128 + part * 64) * 64 + tk;
#pragma unroll
        for (int k = 0; k < 16; k++) L[k] = (f2key(sp[k * 64]) & ~127u) | (unsigned)(127 - (part * 64 + k));
        sort16_desc(L);
        for (int gq = 1; gq < 4; gq++) {
            unsigned G[16];
#pragma unroll
            for (int k = 0; k < 16; k++) G[k] = (f2key(sp[(gq * 16 + k) * 64]) & ~127u) | (unsigned)(127 - (part * 64 + gq * 16 + k));
            sort16_desc(G);
            merge16_desc(L, G);
        }
        __syncthreads();
        unsigned* LP = (unsigned*)lds;
#pragma unroll
        for (int k = 0; k < 16; k++) LP[((part * 2 + half) * 16 + k) * 64 + tk] = L[k];
        __syncthreads();
        if (tid < 128) {
            unsigned A[16], Bq[16];
#pragma unroll
            for (int k = 0; k < 16; k++) { A[k] = LP[((0 * 2 + half) * 16 + k) * 64 + tk]; Bq[k] = LP[((1 * 2 + half) * 16 + k) * 64 + tk]; }
            merge16_desc(A, Bq);
#pragma unroll
            for (int k = 0; k < 16; k++) LL[(half * 16 + k) * 64 + tk] = A[k];
        }
    }
    __syncthreads();
    if (tid < 64) {
        const int tk = tid;
        float v1[16], v2[16];
#pragma unroll
        for (int k = 0; k < 16; k++) { v1[k] = key2f(LL[k * 64 + tk] & ~127u); v2[k] = key2f(LL[(16 + k) * 64 + tk] & ~127u); }
        unsigned C[64];
#pragma unroll
        for (int k = 0; k < 64; k++) C[k] = 0u;
        {
            int c = 0;
#pragma unroll
            for (int a = 0; a < 16; a++)
#pragma unroll
                for (int b = 0; b < 16; b++)
                    if ((a + 1) * (b + 1) <= 16) { C[c] = (f2key(v1[a] + v2[b]) & ~63u) | (unsigned)(63 - c); c++; }
        }
        unsigned T[16];
#pragma unroll
        for (int k = 0; k < 16; k++) T[k] = C[k];
        sort16_desc(T);
#pragma unroll
        for (int gq = 1; gq < 4; gq++) {
            unsigned G[16];
#pragma unroll
            for (int k = 0; k < 16; k++) G[k] = C[gq * 16 + k];
            sort16_desc(G);
            merge16_desc(T, G);
        }
        const float mx = key2f(T[0] & ~63u);
        float e[16], sum = 0.f;
#pragma unroll
        for (int k = 0; k < 16; k++) { e[k] = __expf(key2f(T[k] & ~63u) - mx); sum += e[k]; }
        const float inv = 1.f / sum;
        int ei[16];
#pragma unroll
        for (int k = 0; k < 16; k++) {
            const int cc = 63 - (int)(T[k] & 63u);
            const int a = c_cand_a[cc], b = c_cand_b[cc];
            const int i1 = 127 - (int)(LL[a * 64 + tk] & 127u), i2 = 127 - (int)(LL[(16 + b) * 64 + tk] & 127u);
            ei[k] = i1 * 128 + i2;
            e[k] *= inv;
        }
        int* eidx = (int*)(p.ws + OFF_EIDX) + (size_t)(tok0 + tk) * 128 + h * 16;
        float* gw = (float*)(p.ws + OFF_GW) + (size_t)(tok0 + tk) * 128 + h * 16;
#pragma unroll
        for (int k4 = 0; k4 < 4; k4++) {
            *(u32x4*)(eidx + k4 * 4) = (u32x4){(unsigned)ei[k4 * 4], (unsigned)ei[k4 * 4 + 1], (unsigned)ei[k4 * 4 + 2], (unsigned)ei[k4 * 4 + 3]};
            *(f32x4*)(gw + k4 * 4) = (f32x4){e[k4 * 4], e[k4 * 4 + 1], e[k4 * 4 + 2], e[k4 * 4 + 3]};
        }
    }
    __syncthreads();
}

__device__ __forceinline__ float ub0(unsigned w) { return (float)(w & 0xffu); }
__device__ __forceinline__ float ub1(unsigned w) { return (float)((w >> 8) & 0xffu); }
__device__ __forceinline__ float ub2(unsigned w) { return (float)((w >> 16) & 0xffu); }
__device__ __forceinline__ float ub3(unsigned w) { return (float)(w >> 24); }
struct P3Sc { float su, sv, gm; };
constexpr int P3_REC = 2048;
__device__ __forceinline__ void p3_load_u(u32x4 (&ur)[4], P3Sc& sc, const unsigned char* __restrict__ UQ, const float* __restrict__ tsc,
                                          int lane, int ul, int g, const unsigned* rec) {
#pragma unroll
    for (int u = 0; u < 4; u++) ur[u] = *(const u32x4*)(UQ + (size_t)rec[4 * g + u] * DM + lane * 16);
    const int em = (int)rec[4 * g + ul];
    sc.gm = __uint_as_float(rec[128 + 4 * g + ul]);
    sc.su = tsc[em];
    sc.sv = tsc[16384 + em];
}
__device__ __forceinline__ void p3_load_v(u32x4 (&vr)[4], const unsigned char* __restrict__ VQ, int lane, int g, const unsigned* rec) {
#pragma unroll
    for (int u = 0; u < 4; u++) vr[u] = *(const u32x4*)(VQ + (size_t)rec[4 * g + u] * DM + lane * 16);
}
__device__ __forceinline__ void p3_dots(const u32x4 (&ur)[4], const unsigned* rec, int lane, int (&pt)[4]) {
    const u32x4 qh = *(const u32x4*)(rec + 256 + lane * 4);
#pragma unroll
    for (int u = 0; u < 4; u++) {
        int d = __builtin_amdgcn_sdot4((int)ur[u].x, (int)qh.x, 0, false);
        d = __builtin_amdgcn_sdot4((int)ur[u].y, (int)qh.y, d, false);
        d = __builtin_amdgcn_sdot4((int)ur[u].z, (int)qh.z, d, false);
        d = __builtin_amdgcn_sdot4((int)ur[u].w, (int)qh.w, d, false);
        pt[u] = d;
    }
}
__device__ __forceinline__ float p3_weight(const int (&pt)[4], int lane, float sh, const P3Sc& sc) {
    int m2[2], m1;
    const bool c0 = lane & 1;
#pragma unroll
    for (int j = 0; j < 2; j++) { const int keep = c0 ? pt[j + 2] : pt[j], send = c0 ? pt[j] : pt[j + 2]; m2[j] = keep + __shfl_xor(send, 1, 64); }
    const bool c1 = lane & 2;
    { const int keep = c1 ? m2[1] : m2[0], send = c1 ? m2[0] : m2[1]; m1 = keep + __shfl_xor(send, 2, 64); }
    m1 += __shfl_xor(m1, 4, 64);
    m1 += __shfl_xor(m1, 8, 64);
    m1 += __shfl_xor(m1, 16, 64);
    m1 += __shfl_xor(m1, 32, 64);
    const float aval = (float)m1 * (sh * sc.su);
    return sc.gm * gelu_erf(aval) * sc.sv;
}
__device__ __forceinline__ void p3_axpy(const u32x4 (&vr)[4], float ws, float (&acc)[16], float& wsum) {
#pragma unroll
    for (int u = 0; u < 4; u++) {
        const int src_lane = ((u >> 1) & 1) | ((u & 1) << 1);
        const float wu = __shfl(ws, src_lane, 64);
        wsum += wu;
        const unsigned vw[4] = {vr[u].x, vr[u].y, vr[u].z, vr[u].w};
#pragma unroll
        for (int i = 0; i < 4; i++) {
            acc[i * 4 + 0] += wu * ub0(vw[i]); acc[i * 4 + 1] += wu * ub1(vw[i]);
            acc[i * 4 + 2] += wu * ub2(vw[i]); acc[i * 4 + 3] += wu * ub3(vw[i]);
        }
    }
}
__device__ __forceinline__ void p3_token(const Params& p, int tok, int lane, unsigned* rec, float& sh) {
    const bf16_t* H = (const bf16_t*)(p.ws + OFF_H);
    const int* eidx = (const int*)(p.ws + OFF_EIDX);
    const float* gwp = (const float*)(p.ws + OFF_GW);
    {
        const u32x4 a = *(const u32x4*)(H + (size_t)tok * DM + lane * 16), b = *(const u32x4*)(H + (size_t)tok * DM + lane * 16 + 8);
        const unsigned hw[8] = {a.x, a.y, a.z, a.w, b.x, b.y, b.z, b.w};
        float hv[16];
        float mx = 0.f;
#pragma unroll
        for (int i = 0; i < 8; i++) { hv[2 * i] = bf_lo(hw[i]); hv[2 * i + 1] = bf_hi(hw[i]); mx = fmaxf(mx, fmaxf(fabsf(hv[2 * i]), fabsf(hv[2 * i + 1]))); }
        mx = wave_max(mx);
        const float inv = mx > 0.f ? 127.f / mx : 0.f;
        sh = mx * (1.f / 127.f);
        unsigned qh[4];
#pragma unroll
        for (int i = 0; i < 4; i++) {
            unsigned pk = 0;
#pragma unroll
            for (int j = 0; j < 4; j++) pk |= ((unsigned)((int)rintf(hv[i * 4 + j] * inv)) & 0xffu) << (8 * j);
            qh[i] = pk;
        }
        *(u32x4*)(rec + 256 + lane * 4) = (u32x4){qh[0], qh[1], qh[2], qh[3]};
    }
    const int e0 = eidx[(size_t)tok * 128 + lane], e1 = eidx[(size_t)tok * 128 + 64 + lane];
    const float g0 = gwp[(size_t)tok * 128 + lane], g1 = gwp[(size_t)tok * 128 + 64 + lane];
    const int k0 = e0 >> 10, k1 = e1 >> 10;
    int pos0 = 0, pos1 = 0, base = 0;
#pragma unroll
    for (int v = 0; v < 16; v++) {
        const unsigned long long m0 = __ballot(k0 == v), m1 = __ballot(k1 == v);
        const int c0 = __popcll(m0);
        const int r0 = __builtin_amdgcn_mbcnt_hi((unsigned)(m0 >> 32), __builtin_amdgcn_mbcnt_lo((unsigned)m0, 0u));
        const int r1 = __builtin_amdgcn_mbcnt_hi((unsigned)(m1 >> 32), __builtin_amdgcn_mbcnt_lo((unsigned)m1, 0u));
        pos0 = (k0 == v) ? base + r0 : pos0;
        pos1 = (k1 == v) ? base + c0 + r1 : pos1;
        base += c0 + __popcll(m1);
    }
    rec[pos0] = (unsigned)e0; rec[pos1] = (unsigned)e1;
    rec[128 + pos0] = __float_as_uint(g0); rec[128 + pos1] = __float_as_uint(g1);
}
__device__ __forceinline__ void p3_finish(const Params& p, float* dstp, int tok, int lane, const float (&acc)[16], float wsum) {
    const float* mod = (const float*)(p.ws + OFF_MOD);
    const int b = tok >> 11;
    float x2[16];
    float ss = 0.f;
#pragma unroll
    for (int i = 0; i < 4; i++) {
        const int d = lane * 16 + i * 4;
        const f32x4 xv = *(const f32x4*)(p.out + (size_t)tok * DM + d);
        const f32x4 gt = *(const f32x4*)(mod + b * 6144 + 5 * 1024 + d);
#pragma unroll
        for (int j = 0; j < 4; j++) { const float v = xv[j] + gt[j] * (acc[i * 4 + j] - 128.f * wsum); x2[i * 4 + j] = v; ss += v * v; }
    }
    ss = wave_sum(ss);
    const float rstd = rsqrtf(ss * (1.f / 1024.f) + 1e-6f);
#pragma unroll
    for (int i = 0; i < 4; i++) {
        const int d = lane * 16 + i * 4;
        const f32x4 fg = *(const f32x4*)(p.final_g + d);
        f32x4 o;
#pragma unroll
        for (int j = 0; j < 4; j++) o[j] = x2[i * 4 + j] * rstd * fg[j];
        *(f32x4*)(dstp + (size_t)tok * DM + d) = o;
    }
}
__device__ void phaseP3(const Params& p, float* dstp, char* lds) {
    const int tid_ = TIDX; const int lane = tid_ & 63, wave = tid_ >> 6;
    const unsigned char* UQ = (const unsigned char*)(p.ws + OFF_UB);
    const unsigned char* VQ = UQ + 16777216;
    const float* tsc = (const float*)(p.ws + OFF_UB + 33554432);
    const int ul = ((lane & 1) << 1) | ((lane >> 1) & 1);
    constexpr int TPW = 2;
    unsigned* recs = (unsigned*)(lds + wave * TPW * P3_REC);
    for (int tb = (vblk() * 4 + wave) * TPW; tb < NTOK; tb += vgrid() * 4 * TPW) {
        float sh[TPW], acc[TPW][16], wsm[TPW];
        __builtin_amdgcn_wave_barrier();
#pragma unroll
        for (int k = 0; k < TPW; k++) {
            p3_token(p, tb + k, lane, recs + k * (P3_REC / 4), sh[k]);
#pragma unroll
            for (int i = 0; i < 16; i++) acc[k][i] = 0.f;
            wsm[k] = 0.f;
        }
        __builtin_amdgcn_wave_barrier();
        u32x4 ur[4], vr[4];
        P3Sc sc[TPW];
        p3_load_u(ur, sc[0], UQ, tsc, lane, ul, 0, recs);
        p3_load_v(vr, VQ, lane, 0, recs);
        for (int g = 0; g < 32; g++) {
#pragma unroll
            for (int k = 0; k < TPW; k++) {
                const int kn = (k + 1) % TPW;
                const int gn = (k + 1 == TPW) ? g + 1 : g;
                int pt[4];
                p3_dots(ur, recs + k * (P3_REC / 4), lane, pt);
                if (gn < 32) p3_load_u(ur, sc[kn], UQ, tsc, lane, ul, gn, recs + kn * (P3_REC / 4));
                const float w = p3_weight(pt, lane, sh[k], sc[k]);
                p3_axpy(vr, w, acc[k], wsm[k]);
                if (gn < 32) p3_load_v(vr, VQ, lane, gn, recs + kn * (P3_REC / 4));
            }
        }
#pragma unroll
        for (int k = 0; k < TPW; k++) p3_finish(p, dstp, tb + k, lane, acc[k], wsm[k]);
    }
}

#define XB_TMO      128
#define XB_XCNT(j)  (256  + 64 * (j))
#define XB_XSUB(j)  (1280 + 64 * (j))
#define XB_XGEN(j)  (2304 + 64 * (j))
#define XB_TOP      3328
#define XB_TOPGEN   3392
#define XCD_BAR_WORDS 3456
#define XB_SPIN_CAP (1u << 22)
#define LAS __attribute__((address_space(3)))
__device__ __forceinline__ unsigned xb_ld(unsigned* p)              { return __hip_atomic_load(p, __ATOMIC_RELAXED, __HIP_MEMORY_SCOPE_AGENT); }
__device__ __forceinline__ unsigned xb_add(unsigned* p, unsigned v) { return __hip_atomic_fetch_add(p, v, __ATOMIC_RELAXED, __HIP_MEMORY_SCOPE_AGENT); }
__device__ __forceinline__ unsigned xb_xcc_id() { return (unsigned)__builtin_amdgcn_s_getreg((3 << 11) | 20) & 0xFu; }
#define XB_SPIN(cond, bar) do { unsigned _sp = 0; while (cond) { __builtin_amdgcn_s_sleep(1); \
    if ((++_sp & 255u) == 0u) { if (xb_ld(&(bar)[XB_TMO])) break; if (_sp > XB_SPIN_CAP) { atomicAdd(&(bar)[XB_TMO], 1u); break; } } } } while (0)
struct XcdBarrier { unsigned* bar; unsigned x; volatile LAS unsigned* st; };
__device__ __forceinline__ XcdBarrier xcd_barrier_post(unsigned* bar, volatile LAS unsigned* st) {
    XcdBarrier b; b.bar = bar; b.x = xb_xcc_id(); b.st = st;
    if (threadIdx.x == 0) { st[2] = xb_add(&bar[XB_XCNT(b.x)], 1u); st[4] = b.x; }
    return b;
}
__device__ __forceinline__ void xcd_barrier_complete(unsigned* bar, unsigned x, unsigned& nloc, unsigned& nx, unsigned& bal) {
    const unsigned G = gridDim.x * gridDim.y * gridDim.z;
    unsigned sum, cnt, mine, c64, sp = 0u;
    for (;;) {
        sum = 0u; cnt = 0u; mine = 0u; c64 = 0u;
#pragma unroll
        for (unsigned j = 0; j < 16; ++j) { const unsigned c = xb_ld(&bar[XB_XCNT(j)]); sum += c; cnt += (c > 0u) ? 1u : 0u; c64 += (j < 8 && c == 64u) ? 1u : 0u; mine = (j == x) ? c : mine; }
        if (sum == G) break;
        __builtin_amdgcn_s_sleep(1);
        if ((++sp & 255u) == 0u) { if (xb_ld(&bar[XB_TMO])) break; if (sp > XB_SPIN_CAP) { atomicAdd(&bar[XB_TMO], 1u); break; } }
    }
    nloc = mine > 0u ? mine : 1u; nx = cnt > 0u ? cnt : 1u; bal = (sum == G && cnt == 8u && c64 == 8u) ? 1u : 0u;
}
__device__ __forceinline__ void xcd_barrier(const XcdBarrier& b) {
    asm volatile("s_waitcnt vmcnt(0)" ::: "memory");
    __syncthreads();
    if (threadIdx.x == 0) {
        unsigned* bar = b.bar;
        __builtin_amdgcn_s_waitcnt(0);
        unsigned nloc = b.st[0], nx = b.st[1];
        if (nloc == 0u) { unsigned bal; xcd_barrier_complete(bar, b.x, nloc, nx, bal); b.st[0] = nloc; b.st[1] = nx; b.st[3] = bal; }
        const unsigned old = xb_add(&bar[XB_XSUB(b.x)], 1u);
        const unsigned gen = old / nloc;
        if (old + 1u == (gen + 1u) * nloc) {
            __builtin_amdgcn_fence(__ATOMIC_RELEASE, "agent");
            asm volatile("s_waitcnt vmcnt(0)" ::: "memory");
            const unsigned og = xb_add(&bar[XB_TOP], 1u);
            const unsigned tg = og / nx;
            if (og + 1u == (tg + 1u) * nx) xb_add(&bar[XB_TOPGEN], 1u);
            else XB_SPIN(xb_ld(&bar[XB_TOPGEN]) == tg, bar);
            __builtin_amdgcn_fence(__ATOMIC_ACQUIRE, "agent");
            xb_add(&bar[XB_XGEN(b.x)], 1u);
            asm volatile("s_waitcnt vmcnt(0)" ::: "memory");
        } else {
            XB_SPIN(xb_ld(&bar[XB_XGEN(b.x)]) == gen, bar);
            __builtin_amdgcn_fence(__ATOMIC_ACQUIRE, "agent");
            asm volatile("s_waitcnt vmcnt(0)" ::: "memory");
        }
    }
    __syncthreads();
}

typedef __attribute__((address_space(4))) const Params* KParamsPtr;
__device__ __forceinline__ const Params& fresh_params() {
    KParamsPtr kp = (KParamsPtr)__builtin_amdgcn_kernarg_segment_ptr();
    asm volatile("" : "+s"(kp));
    return *(const Params*)kp;
}
#define PF fresh_params()
__global__ void __launch_bounds__(BLOCK_THREADS, 2) mega(Params p_unused) {
    __shared__ __attribute__((aligned(16))) char lds[LDS_BYTES];
    cg::grid_group grid = cg::this_grid();
    volatile LAS unsigned* st = (volatile LAS unsigned*)(lds + 2 * LDS_MAIN);
    if (threadIdx.x < 16) st[threadIdx.x] = 0u;
    __syncthreads();
    XcdBarrier xb = xcd_barrier_post((unsigned*)PF.ws, st);
    char* hl = lds + half_id() * LDS_MAIN;
    volatile unsigned* uex = (volatile unsigned*)(lds + 2 * LDS_MAIN + 32);

    phaseA(PF, hl);
    if (PF.ws == nullptr) grid.sync();
    xcd_barrier(xb);
    { const Params& q_ = PF; phase_modnorm(q_, q_.x, q_.norm1_g, 0, 1, (bf16_t*)(q_.ws + OFF_H)); };
    xcd_barrier(xb);
    phaseC(PF, lds);
    xcd_barrier(xb);
    for (int task = vblk(); task < 1024; task += vgrid()) phaseG1_task(PF, task, hl);
    for (int task = vblk(); task < 512; task += vgrid()) phaseN1_task(PF, task, hl);
    xcd_barrier(xb);
    phaseG2(PF);
    phaseA2(PF, hl);
    xcd_barrier(xb);
    for (int task = vblk(); task < 2048; task += vgrid()) phaseN2_task(PF, task, hl, (bf16_t*)(PF.ws + OFF_Z) + ZQ_N, ZC, uex, lds);
    for (int task = vblk(); task < 1024; task += vgrid()) phaseG3_task(PF, task, hl, (bf16_t*)(PF.ws + OFF_Z) + ZR_G, ZC);
    xcd_barrier(xb);
    phaseM1(PF, lds);
    xcd_barrier(xb);
    phaseM2(PF, lds);
    xcd_barrier(xb);
    { const Params& q_ = PF; phase_modnorm(q_, q_.out, q_.norm2_g, 3, 4, (bf16_t*)(q_.ws + OFF_H)); };
    xcd_barrier(xb);
    phaseP1(PF, lds);
    xcd_barrier(xb);
    for (int task = vblk(); task < 2048; task += vgrid()) phaseP2_task(PF, task, hl);
    xcd_barrier(xb);
    { const Params& q_ = PF; phaseP3(q_, q_.out, hl); };
}

extern "C" void kernel_launch(void* const* d_in, const int* in_sizes, int n_in, void* d_out, int out_size, void* d_ws, size_t ws_size, hipStream_t stream) {
    Params p{};
    p.x = (const float*)d_in[0]; p.c = (const float*)d_in[1]; p.pos = (const int*)d_in[2]; p.ada_w = (const float*)d_in[3]; p.ada_b = (const float*)d_in[4];
    p.norm1_g = (const float*)d_in[5]; p.norm2_g = (const float*)d_in[6]; p.final_g = (const float*)d_in[7]; p.w_in = (const float*)d_in[8];
    p.gla_wa2 = (const float*)d_in[9]; p.gla_ba2 = (const float*)d_in[10]; p.gla_norm_g = (const float*)d_in[11]; p.pe_k = (const float*)d_in[12]; p.pe_v = (const float*)d_in[13];
    p.ck_w1 = (const float*)d_in[14]; p.ck_w2 = (const float*)d_in[15]; p.cv_w1 = (const float*)d_in[16]; p.cv_w2 = (const float*)d_in[17];
    p.w_branch_a = (const float*)d_in[18]; p.w_branch_b = (const float*)d_in[19]; p.w_out = (const float*)d_in[20]; p.peer_wq = (const float*)d_in[21];
    p.peer_k1 = (const float*)d_in[22]; p.peer_k2 = (const float*)d_in[23]; p.peer_u = (const float*)d_in[24]; p.peer_v = (const float*)d_in[25];
    p.out = (float*)d_out; p.ws = (char*)d_ws;
    static int grid_blocks = 0;
    if (!grid_blocks) {
        int dev = 0, cus = 0, per_cu = 0;
        hipGetDevice(&dev);
        hipDeviceGetAttribute(&cus, hipDeviceAttributeMultiprocessorCount, dev);
        hipOccupancyMaxActiveBlocksPerMultiprocessor(&per_cu, mega, BLOCK_THREADS, 0);
        if (per_cu > 1) per_cu = 1;
        if (per_cu < 1) per_cu = 1;
        grid_blocks = cus * per_cu;
    }
    hipMemsetAsync(d_ws, 0, XCD_BAR_WORDS * 4, stream);
    void* args[] = {&p};
    hipError_t e = hipLaunchCooperativeKernel((void*)mega, dim3(grid_blocks), dim3(BLOCK_THREADS), args, 0, stream);
    if (e != hipSuccess) fprintf(stderr, "cooperative launch failed: %s (grid %d)\n", hipGetErrorString(e), grid_blocks);
}
```

```cpp
#include <hip/hip_runtime.h>
#include <hip/hip_cooperative_groups.h>
#include <stdio.h>
namespace cg = cooperative_groups;
#include <stdint.h>
#include <stddef.h>
#include <math.h>

typedef unsigned short bf16_t;
typedef short bf16x8 __attribute__((ext_vector_type(8)));
typedef float f32x4 __attribute__((ext_vector_type(4)));
typedef unsigned u32x4 __attribute__((ext_vector_type(4)));
typedef unsigned u32x2 __attribute__((ext_vector_type(2)));

constexpr int DM = 1024, NB = 8, SEQ = 2048, NTOK = NB * SEQ;
constexpr int ZC = 4992;
constexpr int ZQ_G = 0, ZK_G = 512, ZV_G = 1024, ZR_G = 2048, ZQ_N = 3072, ZKC = 4096, ZVC = 4224, ZKS = 4352, ZVS = 4480,
              ZKW = 4608, ZVW = 4736, ZGATE = 4864, ZLR = 4912;
constexpr int LDS_MAIN = 73728;
constexpr int LDS_BYTES = 2 * LDS_MAIN + 64;
constexpr int NTHREADS = 256;
constexpr int BLOCK_THREADS = 512;

constexpr size_t OFF_MOD = 16384;
constexpr size_t OFF_ROPE = 212992;
constexpr size_t OFF_CMP = 1261568;
constexpr size_t OFF_DEC = 1785856;
constexpr size_t OFF_K1B = 2310144;
constexpr size_t OFF_WC1 = 2834432;
constexpr size_t OFF_WIN = 4194304;
constexpr size_t OFF_WM = 14417920;
constexpr size_t OFF_WA = 18612224;
constexpr size_t OFF_WB = 20709376;
constexpr size_t OFF_WO = 22806528;
constexpr size_t OFF_WQ = 24903680;
constexpr size_t OFF_H = 29360128;
constexpr size_t OFF_M = 62914560;
constexpr size_t OFF_Z = 96468992;
constexpr size_t OFF_VT = OFF_Z + (size_t)NTOK * ZC * 2;
constexpr size_t OFF_QP = OFF_Z;
constexpr size_t OFF_UB = OFF_Z + 67108864;
constexpr size_t OFF_VB = OFF_UB + 33554432;
constexpr size_t OFF_EIDX = OFF_VB + 33554432;
constexpr size_t OFF_GW = OFF_EIDX + 8388608;

struct Params {
    const float* x; const float* c; const int* pos; const float* ada_w; const float* ada_b;
    const float* norm1_g; const float* norm2_g; const float* final_g; const float* w_in;
    const float* gla_wa2; const float* gla_ba2; const float* gla_norm_g; const float* pe_k; const float* pe_v;
    const float* ck_w1; const float* ck_w2; const float* cv_w1; const float* cv_w2;
    const float* w_branch_a; const float* w_branch_b; const float* w_out; const float* peer_wq;
    const float* peer_k1; const float* peer_k2; const float* peer_u; const float* peer_v;
    float* out; char* ws;
};

__device__ __forceinline__ unsigned f2bf_u(float f) { unsigned u = __float_as_uint(f); return (u + 0x7fffu + ((u >> 16) & 1u)) >> 16; }
__device__ __forceinline__ bf16_t f2bf(float f) { return (bf16_t)f2bf_u(f); }
typedef float f32x2_ __attribute__((ext_vector_type(2)));
typedef __bf16 bf16x2_ __attribute__((ext_vector_type(2)));
__device__ __forceinline__ unsigned pack2(float lo, float hi) {
    const f32x2_ v = {lo, hi};
    return __builtin_bit_cast(unsigned, __builtin_convertvector(v, bf16x2_));
}
__device__ __forceinline__ float bf_lo(unsigned u) { return __uint_as_float(u << 16); }
__device__ __forceinline__ float bf_hi(unsigned u) { return __uint_as_float(u & 0xffff0000u); }
__device__ __forceinline__ float bf2f(bf16_t h) { return __uint_as_float(((unsigned)h) << 16); }
__device__ __forceinline__ float wave_sum(float v) {
#pragma unroll
    for (int o = 32; o > 0; o >>= 1) v += __shfl_xor(v, o, 64);
    return v;
}
__device__ __forceinline__ float wave_max(float v) {
#pragma unroll
    for (int o = 32; o > 0; o >>= 1) v = fmaxf(v, __shfl_xor(v, o, 64));
    return v;
}
__device__ __forceinline__ int launder_i(int x) { asm volatile("" : "+v"(x)); return x; }
#define TIDX (launder_i((int)threadIdx.x) & 255)
#define TIDX512 launder_i((int)threadIdx.x)
__device__ __forceinline__ int half_id() { return __builtin_amdgcn_readfirstlane((int)(threadIdx.x >> 8)); }
__device__ __forceinline__ int vblk() { return (int)blockIdx.x * 2 + half_id(); }
__device__ __forceinline__ int vgrid() { return (int)gridDim.x * 2; }
__device__ __forceinline__ float exp2f_(float x) { return __builtin_amdgcn_exp2f(x); }
__device__ __forceinline__ float sigmoidf_(float x) { return __builtin_amdgcn_rcpf(1.f + __expf(-x)); }
__device__ __forceinline__ float siluf_(float x) { return x * __builtin_amdgcn_rcpf(1.f + __expf(-x)); }
__device__ __forceinline__ float gelu_erf(float v) {
    const float t = __builtin_amdgcn_rcpf(fabsf(v) * 0.2316418882f + 1.0f);
    float qp = t * 0.5307027145f + (-0.7265760135f);
    qp = qp * t + 0.7107068705f; qp = qp * t + (-0.142248368f); qp = qp * t + 0.127414796f; qp = qp * t;
    const float m = v * (qp * __builtin_amdgcn_exp2f(v * v * (-0.72134752044f)));
    return v < 0.f ? m : v - m;
}
__device__ __forceinline__ f32x4 mfma16(bf16x8 a, bf16x8 b, f32x4 c) { return __builtin_amdgcn_mfma_f32_16x16x32_bf16(a, b, c, 0, 0, 0); }
__device__ __forceinline__ bf16x8 ld_frag(const bf16_t* p) { return *(const bf16x8*)p; }
__device__ __forceinline__ bf16x8 mk_frag(u32x2 lo, u32x2 hi) { u32x4 t = {lo.x, lo.y, hi.x, hi.y}; return __builtin_bit_cast(bf16x8, t); }

#define WAIT_V(n) asm volatile("s_waitcnt vmcnt(" #n ")" ::: "memory")
__device__ __forceinline__ int swz4(int R) { return (4 - ((R >> 2) & 3)) & 3; }
__device__ __forceinline__ void glds16(const bf16_t* g, char* l) { __builtin_amdgcn_global_load_lds((const unsigned*)g, (unsigned*)l, 16, 0, 0); }
struct GemmSrc { const bf16_t* xsrc; const bf16_t* wsrc; int ldx, ldw; };
__device__ __forceinline__ GemmSrc gemm_src(const bf16_t* __restrict__ X, int ldx, const bf16_t* __restrict__ W, int ldw, int m0, int n0) {
    const int tid = TIDX512, lane = tid & 63, wave = tid >> 6;
    const int R0 = wave * 32 + (lane >> 2);
    const int sw = ((lane & 3) ^ swz4(R0)) * 8;
    GemmSrc g;
    g.xsrc = X + (size_t)(m0 + R0) * ldx + sw;
    g.wsrc = W + (size_t)(n0 + R0) * ldw + sw;
    g.ldx = ldx; g.ldw = ldw;
    return g;
}
__device__ __forceinline__ void gemm_issue(const GemmSrc& g, int kt, int s, char* lds) {
    const int tid = TIDX512, lane = tid & 63, wave = tid >> 6;
    char* xdst = lds + s * 32768 + wave * 2048 + lane * 16;
    char* wdst = xdst + 16384;
#pragma unroll
    for (int i = 0; i < 2; i++) {
        glds16(g.xsrc + (size_t)i * 16 * g.ldx + kt * 32, xdst + i * 1024);
        glds16(g.wsrc + (size_t)i * 16 * g.ldw + kt * 32, wdst + i * 1024);
    }
}
__device__ __forceinline__ void gemm_prologue(const GemmSrc& g, char* lds) { gemm_issue(g, 0, 0, lds); gemm_issue(g, 1, 1, lds); gemm_issue(g, 2, 2, lds); }
__device__ __forceinline__ void gemm_mainloop(f32x4 (&acc)[8][4], const GemmSrc& g, int K, char* lds) {
    const int tid = TIDX512, lane = tid & 63, wave = tid >> 6;
    const int wr = wave >> 2, wc = wave & 3, r = lane & 15, q = lane >> 4;
    const int KT = K / 32;
    const int rdo = r * 64 + ((q ^ swz4(r)) * 16);
    for (int kt = 0; kt < KT; kt++) {
        if (kt + 2 < KT) WAIT_V(8); else if (kt + 1 < KT) WAIT_V(4); else WAIT_V(0);
        __builtin_amdgcn_s_barrier();
        if (kt + 3 < KT) gemm_issue(g, kt + 3, (kt + 3) & 3, lds);
        const char* st = lds + (kt & 3) * 32768;
        bf16x8 af[4], bfr[8];
#pragma unroll
        for (int ni = 0; ni < 4; ni++) af[ni] = *(const bf16x8*)(st + 16384 + (wc * 64 + ni * 16) * 64 + rdo);
#pragma unroll
        for (int mi = 0; mi < 8; mi++) bfr[mi] = *(const bf16x8*)(st + (wr * 128 + mi * 16) * 64 + rdo);
#pragma unroll
        for (int mi = 0; mi < 8; mi++)
#pragma unroll
            for (int ni = 0; ni < 4; ni++) acc[mi][ni] = mfma16(af[ni], bfr[mi], acc[mi][ni]);
        __builtin_amdgcn_sched_barrier(0);
    }
}
__device__ __forceinline__ void gemm_core(f32x4 (&acc)[8][4], const bf16_t* __restrict__ X, int ldx, const bf16_t* __restrict__ W, int ldw,
                                          int K, int m0, int n0, char* lds) {
    const GemmSrc g = gemm_src(X, ldx, W, ldw, m0, n0);
    gemm_prologue(g, lds);
    gemm_mainloop(acc, g, K, lds);
    __syncthreads();
}
__device__ __forceinline__ void zero_acc(f32x4 (&acc)[8][4]) {
#pragma unroll
    for (int a = 0; a < 8; a++)
#pragma unroll
        for (int b = 0; b < 4; b++) acc[a][b] = (f32x4){0.f, 0.f, 0.f, 0.f};
}

constexpr int EPI_ROWB = 528;
__device__ __forceinline__ void epi_fill(char* lds, int wr, int wc, int r, int q, int mi, int ni, f32x4 v) {
    *(u32x2*)(lds + (wr * 128 + mi * 16 + r) * EPI_ROWB + (wc * 64 + ni * 16 + 4 * q) * 2) = (u32x2){pack2(v[0], v[1]), pack2(v[2], v[3])};
}
__device__ __forceinline__ void epi_store(const char* lds, bf16_t* __restrict__ O, int ldo, int m0, int n0, int ncols_valid) {
    const int t = TIDX512;
    const int chunk = t & 31, rsub = t >> 5;
    if (n0 + chunk * 8 < ncols_valid) {
#pragma unroll
        for (int ps = 0; ps < 16; ps++) {
            const int row = ps * 16 + rsub;
            const u32x4 v = *(const u32x4*)(lds + row * EPI_ROWB + chunk * 16);
            *(u32x4*)(O + (size_t)(m0 + row) * ldo + n0 + chunk * 8) = v;
        }
    }
}

struct TileIter {
    int nt, i, x, li; bool fancy;
    __device__ TileIter(int ntiles_n, const char*) { nt = ntiles_n; fancy = (gridDim.x == 256) && ((nt & 3) == 0); x = blockIdx.x & 7; li = blockIdx.x >> 3; i = fancy ? 0 : blockIdx.x; }
    __device__ bool next(int& bm, int& bn) {
        if (fancy) {
            if (i * 4 >= nt) return false;
            bm = x * 8 + (li & 7); bn = i * 4 + (li >> 3); i++; return true;
        }
        if (i >= 64 * nt) return false;
        bn = i % nt; bm = i / nt; i += gridDim.x; return true;
    }
};

struct MapId { __device__ int operator()(int n) const { return n; } };
struct MapWin {
    __device__ int operator()(int n) const { return n < 3072 ? n : (n < 4912 ? n + 16 : (n < 4928 ? n - 1840 : -1)); }
};
struct MapOff { int off; __device__ int operator()(int n) const { return n + off; } };

template <class Map>
__device__ __forceinline__ void tconv_tile(const float* __restrict__ src, int ldsrc, bf16_t* __restrict__ dst, int ldd, int n0, int k0, Map map, float* t) {
    const int tid = TIDX;
    const int n = tid & 63, kb = tid >> 6;
    const int sc = map(n0 + n);
#pragma unroll
    for (int i = 0; i < 16; i++) { const int k = i * 4 + kb; t[k * 65 + n] = sc >= 0 ? src[(size_t)(k0 + k) * ldsrc + sc] : 0.f; }
    __syncthreads();
    const int nn = tid >> 2, kk = (tid & 3) * 16;
    unsigned w[8];
#pragma unroll
    for (int j = 0; j < 8; j++) w[j] = pack2(t[(kk + 2 * j) * 65 + nn], t[(kk + 2 * j + 1) * 65 + nn]);
    u32x4* d = (u32x4*)(dst + (size_t)(n0 + nn) * ldd + k0 + kk);
    d[0] = (u32x4){w[0], w[1], w[2], w[3]};
    d[1] = (u32x4){w[4], w[5], w[6], w[7]};
    __syncthreads();
}

constexpr int TA_MOD = 192, TA_WIN = 78 * 16, TA_WM = 32 * 16, TA_SQ = 16 * 16, TA_WQ = 32 * 16, TA_WC = 32, TA_K12 = 64, TA_ROPE = 512;
constexpr int TA_E0 = TA_MOD, TA_E1 = TA_E0 + TA_WIN, TA_E2 = TA_E1 + TA_WM, TA_E3 = TA_E2 + TA_SQ, TA_E4 = TA_E3 + TA_SQ, TA_E5 = TA_E4 + TA_SQ,
              TA_E6 = TA_E5 + TA_WQ, TA_E7 = TA_E6 + TA_WC, TA_E8 = TA_E7 + TA_WC, TA_E9 = TA_E8 + TA_K12, TA_E10 = TA_E9 + TA_K12, TA_E11 = TA_E10 + TA_ROPE;

__device__ void phaseA(const Params& p, char* lds) {
    const int tid = TIDX;
    float* fl = (float*)lds;
    constexpr int N0 = TA_E1 + (TA_E8 - TA_E6) + (TA_E11 - TA_E10);
    for (int idx = vblk(); idx < N0; idx += vgrid()) {
        const int task = idx < TA_E1 ? idx : (idx < TA_E1 + (TA_E8 - TA_E6) ? idx - TA_E1 + TA_E6 : idx - TA_E1 - (TA_E8 - TA_E6) + TA_E10);
        if (task < TA_E0) {
            float* sc = fl;
            float* red = fl + 8192;
            {
                f32x4 cv[8];
#pragma unroll
                for (int i = 0; i < 8; i++) cv[i] = *(const f32x4*)(p.c + (i * 256 + tid) * 4);
#pragma unroll
                for (int i = 0; i < 8; i++) *(f32x4*)(sc + (i * 256 + tid) * 4) = (f32x4){siluf_(cv[i][0]), siluf_(cv[i][1]), siluf_(cv[i][2]), siluf_(cv[i][3])};
            }
            __syncthreads();
            const int n = task * 32 + (tid & 31), kg = tid >> 5;
            float a[8];
#pragma unroll
            for (int b = 0; b < 8; b++) a[b] = 0.f;
            for (int k0 = kg * 128; k0 < kg * 128 + 128; k0 += 16) {
                float w[16];
#pragma unroll
                for (int i = 0; i < 16; i++) w[i] = p.ada_w[(size_t)(k0 + i) * 6144 + n];
#pragma unroll
                for (int i = 0; i < 16; i++)
#pragma unroll
                    for (int b = 0; b < 8; b++) a[b] += sc[b * 1024 + k0 + i] * w[i];
            }
#pragma unroll
            for (int b = 0; b < 8; b++) red[(kg * 8 + b) * 32 + (tid & 31)] = a[b];
            __syncthreads();
            {
                const int b = tid >> 5, nn = tid & 31;
                float s = 0.f;
#pragma unroll
                for (int g = 0; g < 8; g++) s += red[(g * 8 + b) * 32 + nn];
                ((float*)(p.ws + OFF_MOD))[b * 6144 + task * 32 + nn] = s + p.ada_b[task * 32 + nn];
            }
            __syncthreads();
        } else if (task < TA_E1) {
            const int tt = task - TA_E0;
            tconv_tile(p.w_in, 6976, (bf16_t*)(p.ws + OFF_WIN), 1024, (tt >> 4) * 64, (tt & 15) * 64, MapWin(), fl);
        } else if (task < TA_E6) {
        } else if (task < TA_E7) {
            const int tt = task - TA_E6;
            tconv_tile(p.ck_w1, 64, (bf16_t*)(p.ws + OFF_WC1), 2048, 0, tt * 64, MapId(), fl);
        } else if (task < TA_E8) {
            const int tt = task - TA_E7;
            tconv_tile(p.cv_w1, 64, (bf16_t*)(p.ws + OFF_WC1) + 64 * 2048, 2048, 0, tt * 64, MapId(), fl);
        } else if (task < TA_E10) {
        } else {
            const int tt = task - TA_E10;
            const int e = tt * 256 + tid;
            const int tok = e >> 3, i = e & 7;
            const float invf[8] = {1.0f, 0.1939227432012558f, 0.03760603070259094f, 0.007292664609849453f,
                                   0.0014142135623842478f, 0.00027424818836152554f, 5.318296098266728e-05f, 1.0313386155758053e-05f};
            float fr = invf[0];
#pragma unroll
            for (int j = 1; j < 8; j++) fr = (i == j) ? invf[j] : fr;
            const float ang = (float)p.pos[tok] * fr;
            const double rev = (double)ang * 0.15915494309189533577;
            const float fpart = (float)(rev - floor(rev));
            float* cs = (float*)(p.ws + OFF_ROPE);
            cs[e * 2] = __builtin_amdgcn_cosf(fpart);
            cs[e * 2 + 1] = __builtin_amdgcn_sinf(fpart);
        }
    }
}

__device__ void phaseA2(const Params& p, char* lds) {
    const int tid = TIDX;
    float* fl = (float*)lds;
    constexpr int N1 = (TA_E6 - TA_E1) + (TA_E10 - TA_E8);
    for (int idx = vblk(); idx < N1; idx += vgrid()) {
        const int task = idx < (TA_E6 - TA_E1) ? idx + TA_E1 : idx - (TA_E6 - TA_E1) + TA_E8;
        if (task < TA_E1) {
        } else if (task < TA_E2) {
            const int tt = task - TA_E1;
            tconv_tile(p.w_in, 6976, (bf16_t*)(p.ws + OFF_WM), 1024, (tt >> 4) * 64, (tt & 15) * 64, MapOff{4928}, fl);
        } else if (task < TA_E3) {
            const int tt = task - TA_E2;
            tconv_tile(p.w_branch_a, 1024, (bf16_t*)(p.ws + OFF_WA), 1024, (tt >> 4) * 64, (tt & 15) * 64, MapId(), fl);
        } else if (task < TA_E4) {
            const int tt = task - TA_E3;
            tconv_tile(p.w_branch_b, 1024, (bf16_t*)(p.ws + OFF_WB), 1024, (tt >> 4) * 64, (tt & 15) * 64, MapId(), fl);
        } else if (task < TA_E5) {
            const int tt = task - TA_E4;
            tconv_tile(p.w_out, 1024, (bf16_t*)(p.ws + OFF_WO), 1024, (tt >> 4) * 64, (tt & 15) * 64, MapId(), fl);
        } else if (task < TA_E6) {
            const int tt = task - TA_E5;
            tconv_tile(p.peer_wq, 2048, (bf16_t*)(p.ws + OFF_WQ), 1024, (tt >> 4) * 64, (tt & 15) * 64, MapId(), fl);
        } else if (task < TA_E10) {
            const bool second = task >= TA_E9;
            const int tt = task - (second ? TA_E9 : TA_E8);
            const float* src = second ? p.peer_k2 : p.peer_k1;
            bf16_t* dst = (bf16_t*)(p.ws + OFF_K1B) + (second ? 131072 : 0);
            const int i = tt * 2048 + tid * 8;
            const f32x4 a = *(const f32x4*)(src + i), b = *(const f32x4*)(src + i + 4);
            *(u32x4*)(dst + i) = (u32x4){pack2(a[0], a[1]), pack2(a[2], a[3]), pack2(b[0], b[1]), pack2(b[2], b[3])};
        }
    }
}

__device__ void phase_modnorm(const Params& p, const float* __restrict__ src, const float* __restrict__ g, int shift_idx, int scale_idx, bf16_t* __restrict__ dst) {
    const int tid_ = TIDX; const int lane = tid_ & 63, wave = tid_ >> 6;
    const float* mod = (const float*)(p.ws + OFF_MOD);
    for (int tok = vblk() * 4 + wave; tok < NTOK; tok += vgrid() * 4) {
        const int b = tok >> 11;
        const float* xr = src + (size_t)tok * DM;
        f32x4 v[4];
        float ss = 0.f;
#pragma unroll
        for (int c = 0; c < 4; c++) { v[c] = *(const f32x4*)(xr + c * 256 + lane * 4); ss += v[c][0] * v[c][0] + v[c][1] * v[c][1] + v[c][2] * v[c][2] + v[c][3] * v[c][3]; }
        ss = wave_sum(ss);
        const float rstd = rsqrtf(ss * (1.f / 1024.f) + 1e-6f);
#pragma unroll
        for (int c = 0; c < 4; c++) {
            const int d = c * 256 + lane * 4;
            const f32x4 gg = *(const f32x4*)(g + d);
            const f32x4 sc = *(const f32x4*)(mod + b * 6144 + scale_idx * 1024 + d);
            const f32x4 sh = *(const f32x4*)(mod + b * 6144 + shift_idx * 1024 + d);
            float o[4];
#pragma unroll
            for (int j = 0; j < 4; j++) o[j] = (v[c][j] * rstd) * gg[j] * (1.f + sc[j]) + sh[j];
            *(u32x2*)(dst + (size_t)tok * DM + d) = (u32x2){pack2(o[0], o[1]), pack2(o[2], o[3])};
        }
    }
}

__device__ void phaseC(const Params& p, char* lds) {
    const int tid_ = TIDX512; const int lane = tid_ & 63, wave = tid_ >> 6;
    const int wr = wave >> 2, wc = wave & 3, r = lane & 15, q = lane >> 4;
    const bf16_t* H = (const bf16_t*)(p.ws + OFF_H);
    const bf16_t* W = (const bf16_t*)(p.ws + OFF_WIN);
    bf16_t* Z = (bf16_t*)(p.ws + OFF_Z);
    const float* cs = (const float*)(p.ws + OFF_ROPE);
    constexpr int NTN = (ZC + 255) / 256;
    TileIter tit(NTN, lds);
    int bm, bn;
    while (tit.next(bm, bn)) {
        const int m0 = bm * 256, n0 = bn * 256;
        f32x4 acc[8][4];
        zero_acc(acc);
        gemm_core(acc, H, DM, W, DM, DM, m0, n0, lds);
        const int c0 = n0 + wc * 64;
        const bool isq = (c0 >= ZQ_N && c0 < ZKC);
        const bool rope = isq || (c0 >= ZKC && c0 < ZGATE && ((c0 - ZKC) & 255) < 128);
        const float scl = isq ? 0.18033688011112042f : 1.f;
#pragma unroll
        for (int mi = 0; mi < 8; mi++) {
            const int tok = m0 + wr * 128 + mi * 16 + r;
            if (rope) {
                f32x4 v = acc[mi][0];
                f32x4 pr;
#pragma unroll
                for (int j = 0; j < 4; j++) pr[j] = __shfl_xor(v[j], 32, 64);
                const int ib = (q & 1) * 4;
                const f32x4 k0 = *(const f32x4*)(cs + (size_t)tok * 16 + ib * 2);
                const f32x4 k1 = *(const f32x4*)(cs + (size_t)tok * 16 + ib * 2 + 4);
                const float cc[4] = {k0[0], k0[2], k1[0], k1[2]}, sn[4] = {k0[1], k0[3], k1[1], k1[3]};
#pragma unroll
                for (int j = 0; j < 4; j++) v[j] = (q < 2) ? (v[j] * cc[j] - pr[j] * sn[j]) : (v[j] * cc[j] + pr[j] * sn[j]);
                acc[mi][0] = v;
            }
#pragma unroll
            for (int ni = 0; ni < 4; ni++) epi_fill(lds, wr, wc, r, q, mi, ni, acc[mi][ni] * scl);
        }
        if ((c0 >= ZVS && c0 < ZVS + 128) || (c0 >= ZVW && c0 < ZVW + 128)) {
            const int brn = c0 >= ZVW ? 1 : 0, gg = ((c0 - (brn ? ZVW : ZVS)) >> 6) & 1;
            const int bb = m0 >> 11, ts = (m0 & 2047) + wr * 128 + r;
            bf16_t* vt = (bf16_t*)(p.ws + OFF_VT) + ((size_t)((brn * 8 + bb) * 2 + gg) * 64) * SEQ + ts;
#pragma unroll
            for (int mi = 0; mi < 8; mi++)
#pragma unroll
                for (int ni = 0; ni < 4; ni++)
#pragma unroll
                    for (int j = 0; j < 4; j++) vt[(size_t)(ni * 16 + 4 * q + j) * SEQ + mi * 16] = f2bf(acc[mi][ni][j]);
        }
        __syncthreads();
        epi_store(lds, Z, ZC, m0, n0, ZC);
        __syncthreads();
    }
}

__device__ __forceinline__ void gla_prep(const Params& p, int tok0, int h, char* lds) {
    const int tid = TIDX;
    float* bc = (float*)lds;
    float* lrs = (float*)(lds + 32768);
    const bf16_t* Z = (const bf16_t*)(p.ws + OFF_Z);
    for (int i = tid; i < 1024; i += NTHREADS) { const int t = i >> 4, rr = i & 15; lrs[i] = bf2f(Z[(size_t)(tok0 + t) * ZC + ZLR + rr]); }
    const int d = tid & 127, th = tid >> 7;
    float w[16];
#pragma unroll
    for (int rr = 0; rr < 16; rr++) w[rr] = p.gla_wa2[rr * 512 + h * 128 + d];
    const float bias = p.gla_ba2[h * 128 + d];
    __syncthreads();
    float run = 0.f;
    for (int t = th * 32; t < th * 32 + 32; t++) {
        float xv = bias;
#pragma unroll
        for (int rr = 0; rr < 16; rr++) xv += lrs[t * 16 + rr] * w[rr];
        const float ls = fminf(xv, 0.f) - __logf(1.f + __expf(-fabsf(xv)));
        run += ls * (1.f / 16.f);
        bc[t * 128 + d] = run;
    }
    __syncthreads();
    if (th == 1) {
        const float add = bc[31 * 128 + d];
        for (int t = 32; t < 64; t++) bc[t * 128 + d] += add;
    }
    __syncthreads();
}

__device__ void phaseG1_task(const Params& p, int task, char* lds) {
    const int tid = TIDX, lane = tid & 63, wave = tid >> 6, r = lane & 15, q = lane >> 4;
    const int c = task & 31, h = (task >> 5) & 3, b = task >> 7;
    const int tok0 = b * SEQ + c * 64;
    const bf16_t* Z = (const bf16_t*)(p.ws + OFF_Z);
    bf16_t* L = (bf16_t*)p.out;
    float* bc = (float*)lds;
    bf16_t* klT = (bf16_t*)(lds + 36864);
    bf16_t* vT = (bf16_t*)(lds + 36864 + 18432);
    gla_prep(p, tok0, h, lds);
    if (tid < 128) ((float*)(p.ws + OFF_DEC))[task * 128 + tid] = __expf(bc[63 * 128 + tid]);
    {
        f32x4* bg = (f32x4*)(p.ws + OFF_M) + (size_t)task * 2048;
#pragma unroll
        for (int i = 0; i < 8; i++) bg[i * 256 + tid] = ((const f32x4*)bc)[i * 256 + tid];
    }
    {
        const int s = lane, dc = wave * 32;
        const bf16_t* kp = Z + (size_t)(tok0 + s) * ZC + ZK_G + h * 128 + dc;
#pragma unroll
        for (int v4 = 0; v4 < 4; v4++) {
            const u32x4 kv = *(const u32x4*)(kp + v4 * 8);
            const unsigned kw[4] = {kv.x, kv.y, kv.z, kv.w};
#pragma unroll
            for (int j = 0; j < 8; j++) {
                const int d = dc + v4 * 8 + j;
                const float kval = (j & 1) ? bf_hi(kw[j >> 1]) : bf_lo(kw[j >> 1]);
                klT[d * 72 + s] = f2bf(kval * __expf(bc[63 * 128 + d] - bc[s * 128 + d]));
            }
        }
    }
    for (int eh = 0; eh < 2; eh++) {
        __syncthreads();
        {
            const int s = lane, ec = wave * 32;
            const bf16_t* vp = Z + (size_t)(tok0 + s) * ZC + ZV_G + h * 256 + eh * 128 + ec;
#pragma unroll
            for (int v4 = 0; v4 < 4; v4++) {
                const u32x4 vv = *(const u32x4*)(vp + v4 * 8);
                const unsigned vw[4] = {vv.x, vv.y, vv.z, vv.w};
#pragma unroll
                for (int j = 0; j < 8; j++) vT[(ec + v4 * 8 + j) * 72 + s] = (bf16_t)((j & 1) ? (vw[j >> 1] >> 16) : (vw[j >> 1] & 0xffffu));
            }
        }
        __syncthreads();
        f32x4 acc[8][2];
#pragma unroll
        for (int dt = 0; dt < 8; dt++) { acc[dt][0] = (f32x4){0.f, 0.f, 0.f, 0.f}; acc[dt][1] = (f32x4){0.f, 0.f, 0.f, 0.f}; }
#pragma unroll
        for (int ks = 0; ks < 2; ks++) {
            bf16x8 bv[2];
#pragma unroll
            for (int x = 0; x < 2; x++) bv[x] = ld_frag(vT + ((2 * wave + x) * 16 + r) * 72 + ks * 32 + q * 8);
#pragma unroll
            for (int dt = 0; dt < 8; dt++) {
                const bf16x8 a = ld_frag(klT + (dt * 16 + r) * 72 + ks * 32 + q * 8);
#pragma unroll
                for (int x = 0; x < 2; x++) acc[dt][x] = mfma16(a, bv[x], acc[dt][x]);
            }
        }
#pragma unroll
        for (int dt = 0; dt < 8; dt++)
#pragma unroll
            for (int x = 0; x < 2; x++) {
                const int e = eh * 128 + (2 * wave + x) * 16 + r, d = dt * 16 + 4 * q;
                const f32x4 v = acc[dt][x];
                *(u32x2*)(L + ((size_t)task * 256 + e) * 128 + d) = (u32x2){pack2(v[0], v[1]), pack2(v[2], v[3])};
            }
    }
    __syncthreads();
}

__device__ void phaseG2(const Params& p) {
    bf16_t* L = (bf16_t*)p.out;
    const float* dec = (const float*)(p.ws + OFF_DEC);
    for (int idx = vblk() * NTHREADS + (int)(threadIdx.x & 255); idx < 32 * 256 * 16; idx += vgrid() * NTHREADS) {
        const int d8 = idx & 15, e = (idx >> 4) & 255, bh = idx >> 12;
        float st[8];
#pragma unroll
        for (int j = 0; j < 8; j++) st[j] = 0.f;
        for (int c = 0; c < 32; c++) {
            const int task = bh * 32 + c;
            u32x4* ptr = (u32x4*)(L + ((size_t)task * 256 + e) * 128 + d8 * 8);
            const u32x4 lv = *ptr;
            const f32x4 d0 = *(const f32x4*)(dec + task * 128 + d8 * 8), d1 = *(const f32x4*)(dec + task * 128 + d8 * 8 + 4);
            *ptr = (u32x4){pack2(st[0], st[1]), pack2(st[2], st[3]), pack2(st[4], st[5]), pack2(st[6], st[7])};
            st[0] = d0[0] * st[0] + bf_lo(lv.x); st[1] = d0[1] * st[1] + bf_hi(lv.x);
            st[2] = d0[2] * st[2] + bf_lo(lv.y); st[3] = d0[3] * st[3] + bf_hi(lv.y);
            st[4] = d1[0] * st[4] + bf_lo(lv.z); st[5] = d1[1] * st[5] + bf_hi(lv.z);
            st[6] = d1[2] * st[6] + bf_lo(lv.w); st[7] = d1[3] * st[7] + bf_hi(lv.w);
        }
    }
}

__device__ void phaseG3_task(const Params& p, int task, char* lds, bf16_t* ydst, int ystride) {
    const int tid = TIDX, lane = tid & 63, wave = tid >> 6, r = lane & 15, q = lane >> 4;
    const int c = task & 31, h = (task >> 5) & 3, b = task >> 7;
    const int tok0 = b * SEQ + c * 64;
    bf16_t* Z = (bf16_t*)(p.ws + OFF_Z);
    const bf16_t* ST = (const bf16_t*)p.out + (size_t)task * 256 * 128;
    float* bc = (float*)lds;
    bf16_t* vT = (bf16_t*)lds;
    bf16_t* qg = (bf16_t*)(lds + 36864);
    bf16_t* kg = (bf16_t*)(lds + 36864 + 17408);
    bf16_t* P = kg;
    float* red = (float*)(lds + 36864 + 2 * 17408);
    {
        const f32x4* bg = (const f32x4*)(p.ws + OFF_M) + (size_t)task * 2048;
#pragma unroll
        for (int i = 0; i < 8; i++) ((f32x4*)bc)[i * 256 + tid] = bg[i * 256 + tid];
    }
    __syncthreads();
    {
        const int t = tid >> 2, dc = (tid & 3) * 32;
        const bf16_t* qp = Z + (size_t)(tok0 + t) * ZC + ZQ_G + h * 128 + dc;
        const bf16_t* kp = Z + (size_t)(tok0 + t) * ZC + ZK_G + h * 128 + dc;
#pragma unroll
        for (int v4 = 0; v4 < 4; v4++) {
            const u32x4 qv = *(const u32x4*)(qp + v4 * 8), kv = *(const u32x4*)(kp + v4 * 8);
            const unsigned qw[4] = {qv.x, qv.y, qv.z, qv.w}, kw[4] = {kv.x, kv.y, kv.z, kv.w};
            unsigned qo[4], ko[4];
#pragma unroll
            for (int j2 = 0; j2 < 4; j2++) {
                const int d = dc + v4 * 8 + j2 * 2;
                const float b0 = bc[t * 128 + d], b1 = bc[t * 128 + d + 1];
                qo[j2] = pack2(bf_lo(qw[j2]) * 0.08838834764831845f * __expf(b0), bf_hi(qw[j2]) * 0.08838834764831845f * __expf(b1));
                ko[j2] = pack2(bf_lo(kw[j2]) * __expf(-b0), bf_hi(kw[j2]) * __expf(-b1));
            }
            *(u32x4*)(qg + t * 136 + dc + v4 * 8) = (u32x4){qo[0], qo[1], qo[2], qo[3]};
            *(u32x4*)(kg + t * 136 + dc + v4 * 8) = (u32x4){ko[0], ko[1], ko[2], ko[3]};
        }
    }
    __syncthreads();
    {
        const int s = lane, ec = wave * 64;
        const bf16_t* vp = Z + (size_t)(tok0 + s) * ZC + ZV_G + h * 256 + ec;
#pragma unroll
        for (int v4 = 0; v4 < 8; v4++) {
            const u32x4 vv = *(const u32x4*)(vp + v4 * 8);
            const unsigned vw[4] = {vv.x, vv.y, vv.z, vv.w};
#pragma unroll
            for (int j = 0; j < 8; j++) vT[(ec + v4 * 8 + j) * 72 + s] = (bf16_t)((j & 1) ? (vw[j >> 1] >> 16) : (vw[j >> 1] & 0xffffu));
        }
    }
    f32x4 sc[4];
#pragma unroll
    for (int st = 0; st < 4; st++) sc[st] = (f32x4){0.f, 0.f, 0.f, 0.f};
    {
        bf16x8 qf[4];
#pragma unroll
        for (int ks = 0; ks < 4; ks++) qf[ks] = ld_frag(qg + (wave * 16 + r) * 136 + ks * 32 + q * 8);
#pragma unroll
        for (int st = 0; st < 4; st++) {
            if (st <= wave) {
#pragma unroll
                for (int ks = 0; ks < 4; ks++) sc[st] = mfma16(ld_frag(kg + (st * 16 + r) * 136 + ks * 32 + q * 8), qf[ks], sc[st]);
            }
        }
    }
    __syncthreads();
    {
        const int t = wave * 16 + r;
#pragma unroll
        for (int st = 0; st < 4; st++) {
            float pv[4];
#pragma unroll
            for (int j = 0; j < 4; j++) { const int s = st * 16 + 4 * q + j; pv[j] = (s <= t) ? sc[st][j] : 0.f; }
            *(u32x2*)(P + t * 72 + st * 16 + 4 * q) = (u32x2){pack2(pv[0], pv[1]), pack2(pv[2], pv[3])};
        }
    }
    __syncthreads();
    f32x4 o[4][4];
#pragma unroll
    for (int et = 0; et < 4; et++)
#pragma unroll
        for (int tt = 0; tt < 4; tt++) o[et][tt] = (f32x4){0.f, 0.f, 0.f, 0.f};
#pragma unroll
    for (int ks = 0; ks < 2; ks++) {
        bf16x8 pf[4];
#pragma unroll
        for (int tt = 0; tt < 4; tt++) pf[tt] = ld_frag(P + (tt * 16 + r) * 72 + ks * 32 + q * 8);
#pragma unroll
        for (int et = 0; et < 4; et++) {
            const bf16x8 a = ld_frag(vT + ((wave * 4 + et) * 16 + r) * 72 + ks * 32 + q * 8);
#pragma unroll
            for (int tt = 0; tt < 4; tt++) o[et][tt] = mfma16(a, pf[tt], o[et][tt]);
        }
    }
#pragma unroll
    for (int ks = 0; ks < 4; ks++) {
        bf16x8 qf[4];
#pragma unroll
        for (int tt = 0; tt < 4; tt++) qf[tt] = ld_frag(qg + (tt * 16 + r) * 136 + ks * 32 + q * 8);
#pragma unroll
        for (int et = 0; et < 4; et++) {
            const bf16x8 a = *(const bf16x8*)(ST + (size_t)((wave * 4 + et) * 16 + r) * 128 + ks * 32 + q * 8);
#pragma unroll
            for (int tt = 0; tt < 4; tt++) o[et][tt] = mfma16(a, qf[tt], o[et][tt]);
        }
    }
#pragma unroll
    for (int tt = 0; tt < 4; tt++) {
        float ss = 0.f;
#pragma unroll
        for (int et = 0; et < 4; et++)
#pragma unroll
            for (int j = 0; j < 4; j++) ss += o[et][tt][j] * o[et][tt][j];
        ss += __shfl_xor(ss, 16, 64);
        ss += __shfl_xor(ss, 32, 64);
        if (q == 0) red[wave * 64 + tt * 16 + r] = ss;
    }
    __syncthreads();
#pragma unroll
    for (int tt = 0; tt < 4; tt++) {
        const int t = tt * 16 + r;
        const float tot = red[t] + red[64 + t] + red[128 + t] + red[192 + t];
        const float rstd = rsqrtf(tot * (1.f / 256.f) + 1e-6f);
#pragma unroll
        for (int et = 0; et < 4; et++) {
            const int e = (wave * 4 + et) * 16 + 4 * q;
            bf16_t* rp = Z + (size_t)(tok0 + t) * ZC + ZR_G + h * 256 + e;
            const u32x2 rv = *(const u32x2*)rp;
            const f32x4 gn = *(const f32x4*)(p.gla_norm_g + e);
            const float r0 = bf_lo(rv.x), r1 = bf_hi(rv.x), r2 = bf_lo(rv.y), r3 = bf_hi(rv.y);
            const f32x4 ov = o[et][tt];
            *(u32x2*)(ydst + (size_t)(tok0 + t) * ystride + h * 256 + e) = (u32x2){pack2(ov[0] * rstd * gn[0] * siluf_(r0), ov[1] * rstd * gn[1] * siluf_(r1)),
                                  pack2(ov[2] * rstd * gn[2] * siluf_(r2), ov[3] * rstd * gn[3] * siluf_(r3))};
        }
    }
    __syncthreads();
}

__device__ void phaseN1_task(const Params& p, int task, char* lds) {
    const int tid = TIDX, lane = tid & 63, wave = tid >> 6, r = lane & 15, q = lane >> 4;
    const int it = task & 15, g = (task >> 4) & 1, b = (task >> 5) & 7, kv = task >> 8;
    const bf16_t* Z = (const bf16_t*)(p.ws + OFF_Z);
    const bf16_t* W1 = (const bf16_t*)(p.ws + OFF_WC1) + (size_t)kv * 64 * 2048;
    const float* pe = kv ? p.pe_v : p.pe_k;
    const float* w2 = kv ? p.cv_w2 : p.ck_w2;
    const int zoff = (kv ? ZVC : ZKC) + g * 64;
    float* hid = (float*)lds;
    float* hid2 = (float*)(lds + 16384);
    int i = it * 8 + (r & 7); if (i > 126) i = 126;
    f32x4 acc[4];
#pragma unroll
    for (int nt = 0; nt < 4; nt++) acc[nt] = (f32x4){0.f, 0.f, 0.f, 0.f};
    for (int ks = 0; ks < 16; ks++) {
        const int k = wave * 512 + ks * 32 + q * 8;
        const int l = k >> 6, d = k & 63;
        const u32x4 zv = *(const u32x4*)(Z + (size_t)(b * SEQ + i * 16 + l) * ZC + zoff + d);
        const f32x4 p0 = *(const f32x4*)(pe + l * 64 + d), p1 = *(const f32x4*)(pe + l * 64 + d + 4);
        const u32x4 av = {pack2(bf_lo(zv.x) + p0[0], bf_hi(zv.x) + p0[1]), pack2(bf_lo(zv.y) + p0[2], bf_hi(zv.y) + p0[3]),
                          pack2(bf_lo(zv.z) + p1[0], bf_hi(zv.z) + p1[1]), pack2(bf_lo(zv.w) + p1[2], bf_hi(zv.w) + p1[3])};
        const bf16x8 a = __builtin_bit_cast(bf16x8, av);
#pragma unroll
        for (int nt = 0; nt < 4; nt++) {
            const bf16x8 bw = *(const bf16x8*)(W1 + (size_t)(nt * 16 + r) * 2048 + k);
            acc[nt] = mfma16(a, bw, acc[nt]);
        }
    }
#pragma unroll
    for (int nt = 0; nt < 4; nt++)
#pragma unroll
        for (int j = 0; j < 4; j++) hid[(wave * 16 + 4 * q + j) * 64 + nt * 16 + r] = acc[nt][j];
    __syncthreads();
    for (int e = tid; e < 1024; e += NTHREADS) hid2[e] = gelu_erf(hid[e] + hid[1024 + e] + hid[2048 + e] + hid[3072 + e]);
    __syncthreads();
    {
        const int il = tid >> 4, n2 = (tid & 15) * 4;
        f32x4 o = {0.f, 0.f, 0.f, 0.f};
        for (int n = 0; n < 64; n++) {
            const float hv = hid2[il * 64 + n];
            const f32x4 wv = *(const f32x4*)(w2 + n * 64 + n2);
            o += hv * wv;
        }
        const int ig = it * 8 + il;
        if (ig >= 127) o = (f32x4){0.f, 0.f, 0.f, 0.f};
        bf16_t* dst = (bf16_t*)(p.ws + OFF_CMP) + ((size_t)((kv * 8 + b) * 2 + g) * 128 + ig) * 64 + n2;
        if (il < 8) *(u32x2*)dst = (u32x2){pack2(o[0], o[1]), pack2(o[2], o[3])};
    }
    __syncthreads();
}

__device__ __forceinline__ void nsa_block_step(const bf16_t* Ks, const bf16_t* VT, const bf16x8 (&qf)[2][2], f32x4 (&O)[2][4], float (&m)[2], float (&l)[2],
                                               int klo, int khi, int r, int q) {
    f32x4 s[2][4];
#pragma unroll
    for (int x = 0; x < 2; x++)
#pragma unroll
        for (int kt = 0; kt < 4; kt++) s[x][kt] = (f32x4){0.f, 0.f, 0.f, 0.f};
#pragma unroll
    for (int kt = 0; kt < 4; kt++)
#pragma unroll
        for (int ks = 0; ks < 2; ks++) {
            const bf16x8 kf = ld_frag(Ks + (kt * 16 + r) * 64 + (((ks * 4 + q) ^ (r & 7)) * 8));
#pragma unroll
            for (int x = 0; x < 2; x++) s[x][kt] = mfma16(kf, qf[x][ks], s[x][kt]);
        }
    if (!__all((klo <= 0) && (khi >= 63))) {
        const int a = 4 * q - klo;
        const unsigned range = (unsigned)(khi - klo);
        const bool any = khi >= klo;
#pragma unroll
        for (int kt = 0; kt < 4; kt++)
#pragma unroll
            for (int j = 0; j < 4; j++) {
                const bool valid = any && ((unsigned)(kt * 16 + j + a) <= range);
#pragma unroll
                for (int x = 0; x < 2; x++) s[x][kt][j] = valid ? s[x][kt][j] : -3.0e38f;
            }
    }
    bf16x8 pbv[2][2];
#pragma unroll
    for (int x = 0; x < 2; x++) {
        float mx = fmaxf(fmaxf(fmaxf(s[x][0][0], s[x][0][1]), fmaxf(s[x][0][2], s[x][0][3])), fmaxf(fmaxf(s[x][1][0], s[x][1][1]), fmaxf(s[x][1][2], s[x][1][3])));
        mx = fmaxf(mx, fmaxf(fmaxf(fmaxf(s[x][2][0], s[x][2][1]), fmaxf(s[x][2][2], s[x][2][3])), fmaxf(fmaxf(s[x][3][0], s[x][3][1]), fmaxf(s[x][3][2], s[x][3][3]))));
        mx = fmaxf(mx, __shfl_xor(mx, 16, 64));
        mx = fmaxf(mx, __shfl_xor(mx, 32, 64));
        const float mnew = fmaxf(m[x], mx);
        const float alpha = exp2f_(m[x] - mnew);
        m[x] = mnew;
        float ls = 0.f;
#pragma unroll
        for (int kt = 0; kt < 4; kt++)
#pragma unroll
            for (int j = 0; j < 4; j++) { const float pv = exp2f_(s[x][kt][j] - mnew); s[x][kt][j] = pv; ls += pv; }
        l[x] = l[x] * alpha + ls;
#pragma unroll
        for (int dt = 0; dt < 4; dt++) O[x][dt] *= alpha;
#pragma unroll
        for (int s2 = 0; s2 < 2; s2++) {
            const u32x4 t4 = {pack2(s[x][2 * s2][0], s[x][2 * s2][1]), pack2(s[x][2 * s2][2], s[x][2 * s2][3]),
                              pack2(s[x][2 * s2 + 1][0], s[x][2 * s2 + 1][1]), pack2(s[x][2 * s2 + 1][2], s[x][2 * s2 + 1][3])};
            pbv[x][s2] = __builtin_bit_cast(bf16x8, t4);
        }
    }
#pragma unroll
    for (int s2 = 0; s2 < 2; s2++)
#pragma unroll
        for (int dt = 0; dt < 4; dt++) {
            const u32x2 lo = *(const u32x2*)(VT + (dt * 16 + r) * 72 + (2 * s2) * 16 + 4 * q);
            const u32x2 hi = *(const u32x2*)(VT + (dt * 16 + r) * 72 + (2 * s2 + 1) * 16 + 4 * q);
            const bf16x8 va = mk_frag(lo, hi);
#pragma unroll
            for (int x = 0; x < 2; x++) O[x][dt] = mfma16(va, pbv[x][s2], O[x][dt]);
        }
}

__device__ __forceinline__ void nsa_cmp_probs(const bf16_t* Kc, const bf16x8 (&qfx)[2], int nv, int r, int q, f32x4 (&s)[8]) {
#pragma unroll
    for (int kt = 0; kt < 8; kt++) s[kt] = (f32x4){0.f, 0.f, 0.f, 0.f};
#pragma unroll
    for (int kt = 0; kt < 8; kt++)
#pragma unroll
        for (int ks = 0; ks < 2; ks++) s[kt] = mfma16(ld_frag(Kc + (kt * 16 + r) * 72 + ks * 32 + q * 8), qfx[ks], s[kt]);
    float mx = -1e30f;
#pragma unroll
    for (int kt = 0; kt < 8; kt++)
#pragma unroll
        for (int j = 0; j < 4; j++) if (kt * 16 + 4 * q + j < nv) mx = fmaxf(mx, s[kt][j]);
    mx = fmaxf(mx, __shfl_xor(mx, 16, 64));
    mx = fmaxf(mx, __shfl_xor(mx, 32, 64));
    float ls = 0.f;
#pragma unroll
    for (int kt = 0; kt < 8; kt++)
#pragma unroll
        for (int j = 0; j < 4; j++) {
            const float pv = (kt * 16 + 4 * q + j < nv) ? exp2f_(s[kt][j] - mx) : 0.f;
            s[kt][j] = pv; ls += pv;
        }
    ls += __shfl_xor(ls, 16, 64);
    ls += __shfl_xor(ls, 32, 64);
    const float inv = nv > 0 ? 1.f / ls : 0.f;
#pragma unroll
    for (int kt = 0; kt < 8; kt++) s[kt] *= inv;
}

__device__ void phaseN2_task(const Params& p, int task, char* lds, bf16_t* ydst, int ystride, volatile unsigned* uex, char* ldsb) {
    const int tid = TIDX, lane = tid & 63, wave = tid >> 6, r = lane & 15, q = lane >> 4;
    const int t512 = tid + half_id() * 256;
    const int pair = task >> 1, g = pair & 1, b = (pair >> 1) & 7;
    const int tt = (63 - (pair >> 4)) * 2 + (task & 1);
    const int t0 = tt * 16, t = t0 + r;
    const int cur = t0 >> 6;
    bf16_t* Z = (bf16_t*)(p.ws + OFF_Z);
    const size_t rowb = (size_t)b * SEQ;
    bf16_t* Kc = (bf16_t*)ldsb;
    bf16_t* VcT = (bf16_t*)(ldsb + 18432);
    bf16_t* Ks = (bf16_t*)ldsb;
    bf16_t* VT = (bf16_t*)(ldsb + 18432);
    float* impw = (float*)(lds + 35840);
    float* scs = (float*)(lds + 35840 + 32768);
    unsigned* selm = (unsigned*)(lds + 35840 + 32768 + 2048);

    bf16x8 qf[2][2];
#pragma unroll
    for (int x = 0; x < 2; x++)
#pragma unroll
        for (int ks = 0; ks < 2; ks++) qf[x][ks] = *(const bf16x8*)(Z + (rowb + t) * ZC + ZQ_N + (g * 8 + 2 * wave + x) * 64 + ks * 32 + q * 8);
    f32x4* ofl = (f32x4*)(lds + 35840);

    f32x4 Og[2][4];
    {
        const bf16_t* kc = (const bf16_t*)(p.ws + OFF_CMP) + (size_t)((0 * 8 + b) * 2 + g) * 128 * 64;
        const bf16_t* vc = (const bf16_t*)(p.ws + OFF_CMP) + (size_t)((1 * 8 + b) * 2 + g) * 128 * 64;
        {
            const int key = t512 >> 2, ch = (t512 & 3) * 16;
#pragma unroll
            for (int v4 = 0; v4 < 2; v4++) *(u32x4*)(Kc + key * 72 + ch + v4 * 8) = *(const u32x4*)(kc + key * 64 + ch + v4 * 8);
            const int k2 = t512 & 127, dc = (t512 >> 7) * 16;
#pragma unroll
            for (int v4 = 0; v4 < 2; v4++) {
                const u32x4 a = *(const u32x4*)(vc + k2 * 64 + dc + v4 * 8);
                const unsigned w[4] = {a.x, a.y, a.z, a.w};
#pragma unroll
                for (int j = 0; j < 8; j++) VcT[(dc + v4 * 8 + j) * 136 + k2] = (bf16_t)((j & 1) ? (w[j >> 1] >> 16) : (w[j >> 1] & 0xffffu));
            }
        }
        __syncthreads();
        int nv = t >= 31 ? ((t - 31) >> 4) + 1 : 0;
        if (nv > 127) nv = 127;
        f32x4 isum[8];
#pragma unroll
        for (int kt = 0; kt < 8; kt++) isum[kt] = (f32x4){0.f, 0.f, 0.f, 0.f};
#pragma unroll
        for (int x = 0; x < 2; x++) {
            f32x4 s[8];
            nsa_cmp_probs(Kc, qf[x], nv, r, q, s);
#pragma unroll
            for (int kt = 0; kt < 8; kt++) isum[kt] += s[kt];
            f32x4 Oc[4];
#pragma unroll
            for (int dt = 0; dt < 4; dt++) Oc[dt] = (f32x4){0.f, 0.f, 0.f, 0.f};
            __builtin_amdgcn_sched_barrier(0);
#pragma unroll
            for (int s2 = 0; s2 < 4; s2++) {
                const u32x4 t4 = {pack2(s[2 * s2][0], s[2 * s2][1]), pack2(s[2 * s2][2], s[2 * s2][3]),
                                  pack2(s[2 * s2 + 1][0], s[2 * s2 + 1][1]), pack2(s[2 * s2 + 1][2], s[2 * s2 + 1][3])};
                const bf16x8 pbv = __builtin_bit_cast(bf16x8, t4);
#pragma unroll
                for (int dt = 0; dt < 4; dt++) {
                    const u32x2 lo = *(const u32x2*)(VcT + (dt * 16 + r) * 136 + (2 * s2) * 16 + 4 * q);
                    const u32x2 hi = *(const u32x2*)(VcT + (dt * 16 + r) * 136 + (2 * s2 + 1) * 16 + 4 * q);
                    Oc[dt] = mfma16(mk_frag(lo, hi), pbv, Oc[dt]);
                }
            }
            const float g0 = sigmoidf_(bf2f(Z[(rowb + t) * ZC + ZGATE + 0 * 16 + g * 8 + 2 * wave + x]));
#pragma unroll
            for (int dt = 0; dt < 4; dt++) Og[x][dt] = g0 * Oc[dt];
            __builtin_amdgcn_sched_barrier(0);
        }
#pragma unroll
        for (int kt = 0; kt < 8; kt++) *(f32x4*)(impw + (wave * 16 + r) * 128 + kt * 16 + 4 * q) = isum[kt];
        __syncthreads();
#pragma unroll
        for (int pass = 0; pass < 2; pass++) {
            const int tk = pass * 8 + (tid >> 5), j = tid & 31;
            const int i0 = j == 0 ? 0 : 4 * j - 1, i1 = (4 * j + 3 > 126) ? 126 : 4 * j + 3;
            float sc = 0.f;
            for (int i = i0; i <= i1; i++) sc += (impw[(0 * 16 + tk) * 128 + i] + impw[(1 * 16 + tk) * 128 + i]) + (impw[(2 * 16 + tk) * 128 + i] + impw[(3 * 16 + tk) * 128 + i]);
            const bool forced = (j == 0) || (j == cur) || (j == cur - 1);
            scs[tk * 32 + j] = forced ? 1e6f : (j <= cur ? sc : -1.f);
        }
        __syncthreads();
#pragma unroll
        for (int pass = 0; pass < 2; pass++) {
            const int tk = pass * 8 + (tid >> 5), j = tid & 31;
            const float mine = scs[tk * 32 + j];
            int rank = 0;
            for (int j2 = 0; j2 < 32; j2++) { const float o = scs[tk * 32 + j2]; rank += (o > mine || (o == mine && j2 < j)) ? 1 : 0; }
            const unsigned long long bal = __ballot(rank < 16);
            if ((lane & 31) == 0) selm[tk] = (unsigned)(lane ? (bal >> 32) : (bal & 0xffffffffull));
        }
        __syncthreads();
    }
#pragma unroll
    for (int x = 0; x < 2; x++)
#pragma unroll
        for (int dt = 0; dt < 4; dt++) ofl[(wave * 8 + x * 4 + dt) * 64 + lane] = Og[x][dt];
    const unsigned mysel = selm[r];
    unsigned uni = 0;
#pragma unroll
    for (int i = 0; i < 16; i++) uni |= selm[i];
    if (tid == 0) uex[half_id()] = uni;
    __syncthreads();
    uni = uex[0] | uex[1];
    uni &= (cur == 31) ? 0xffffffffu : ((2u << cur) - 1u);
    uni |= 1u;

    {
        const int lo = (t0 & ~31) - 511;
        const int jb0 = lo > 0 ? (lo >> 6) : 0;
        const int kkey = t512 >> 3, kch = (t512 & 7) * 8;
        const int vd = t512 >> 3, vch = (t512 & 7) * 8;
        const bf16_t* vtb = (const bf16_t*)(p.ws + OFF_VT) + ((size_t)(b * 2 + g) * 64 + vd) * SEQ + vch;
        u32x4 kreg, vreg;
        int br = 0, j = 0;
        {
            const bf16_t* kb = Z + (rowb + 0) * ZC + ZKS + g * 64;
            kreg = *(const u32x4*)(kb + (size_t)kkey * ZC + kch);
            vreg = *(const u32x4*)(vtb);
        }
        f32x4 O[2][4];
        float m[2] = {-1e30f, -1e30f}, l[2] = {0.f, 0.f};
#pragma unroll
        for (int x = 0; x < 2; x++)
#pragma unroll
            for (int dt = 0; dt < 4; dt++) O[x][dt] = (f32x4){0.f, 0.f, 0.f, 0.f};
        for (;;) {
            __syncthreads();
            *(u32x4*)(Ks + kkey * 64 + (((kch >> 3) ^ (kkey & 7)) * 8)) = kreg;
            *(u32x4*)(VT + vd * 72 + vch) = vreg;
            __syncthreads();
            int nbr, nj;
            if (br == 0) {
                const unsigned rem = (j >= 31) ? 0u : (uni & ~((2u << j) - 1u));
                if (rem) { nbr = 0; nj = __ffs((int)rem) - 1; } else { nbr = 1; nj = jb0; }
            } else {
                if (j < cur) { nbr = 1; nj = j + 1; } else { nbr = 2; nj = 0; }
            }
            if (nbr < 2) {
                const bf16_t* kb = Z + (rowb + nj * 64) * ZC + (nbr ? ZKW : ZKS) + g * 64;
                kreg = *(const u32x4*)(kb + (size_t)kkey * ZC + kch);
                vreg = *(const u32x4*)(vtb + (size_t)nbr * (8 * 2 * 64) * SEQ + nj * 64);
            }
            int klo = 0, khi = -1;
            if (br == 0) { if ((mysel >> j) & 1u) khi = t - j * 64; }
            else { khi = t - j * 64; klo = t - 511 - j * 64; }
            klo = klo < 0 ? 0 : klo;
            khi = khi > 63 ? 63 : khi;
            nsa_block_step(Ks, VT, qf, O, m, l, klo, khi, r, q);
            if (nbr != br) {
#pragma unroll
                for (int x = 0; x < 2; x++) {
                    float lt = l[x];
                    lt += __shfl_xor(lt, 16, 64);
                    lt += __shfl_xor(lt, 32, 64);
                    const float sc = sigmoidf_(bf2f(Z[(rowb + t) * ZC + ZGATE + (br + 1) * 16 + g * 8 + 2 * wave + x])) / lt;
#pragma unroll
                    for (int dt = 0; dt < 4; dt++) { ofl[(wave * 8 + x * 4 + dt) * 64 + lane] += sc * O[x][dt]; O[x][dt] = (f32x4){0.f, 0.f, 0.f, 0.f}; }
                    m[x] = -1e30f; l[x] = 0.f;
                }
            }
            if (nbr == 2) break;
            br = nbr; j = nj;
        }
#pragma unroll
        for (int x = 0; x < 2; x++)
#pragma unroll
            for (int dt = 0; dt < 4; dt++) {
                const f32x4 v = ofl[(wave * 8 + x * 4 + dt) * 64 + lane];
                *(u32x2*)(ydst + (rowb + t) * ystride + (g * 8 + 2 * wave + x) * 64 + dt * 16 + 4 * q) = (u32x2){pack2(v[0], v[1]), pack2(v[2], v[3])};
            }
    }
    __syncthreads();
}

__device__ void phaseM1(const Params& p, char* lds) {
    const int tid_ = TIDX512; const int lane = tid_ & 63, wave = tid_ >> 6;
    const int wr = wave >> 2, wc = wave & 3, r = lane & 15, q = lane >> 4;
    const bf16_t* H = (const bf16_t*)(p.ws + OFF_H);
    const bf16_t* Z = (const bf16_t*)(p.ws + OFF_Z);
    bf16_t* M = (bf16_t*)(p.ws + OFF_M);
    bf16_t* SG = (bf16_t*)p.out;
    TileIter tit(4, lds);
    int bm, bn;
    while (tit.next(bm, bn)) {
        const int m0 = bm * 256, n0 = bn * 256;
        for (int br = 0; br < 2; br++) {
            f32x4 acc[8][4];
            zero_acc(acc);
            gemm_core(acc, H, DM, (const bf16_t*)(p.ws + OFF_WM) + (size_t)br * 1024 * 1024, DM, DM, m0, n0, lds);
            {
                const int e0 = launder_i((m0 + wr * 128 + r) * DM + n0 + wc * 64 + 4 * q);
#pragma unroll
                for (int mi = 0; mi < 8; mi++)
#pragma unroll
                    for (int ni = 0; ni < 4; ni++)
                        *(u32x2*)(SG + (size_t)(e0 + mi * 16 * DM + ni * 16)) = (u32x2){pack2(sigmoidf_(acc[mi][ni][0]), sigmoidf_(acc[mi][ni][1])),
                                                                                        pack2(sigmoidf_(acc[mi][ni][2]), sigmoidf_(acc[mi][ni][3]))};
            }
            zero_acc(acc);
            gemm_core(acc, Z + (br ? ZQ_N : ZR_G), ZC, (const bf16_t*)(p.ws + (br ? OFF_WB : OFF_WA)), DM, DM, m0, n0, lds);
            {
                const int e0 = launder_i((m0 + wr * 128 + r) * DM + n0 + wc * 64 + 4 * q);
#pragma unroll
                for (int mi = 0; mi < 8; mi++)
#pragma unroll
                    for (int ni = 0; ni < 4; ni++) {
                        const size_t eo = (size_t)(e0 + mi * 16 * DM + ni * 16);
                        const u32x2 sg = *(const u32x2*)(SG + eo);
                        float v[4] = {bf_lo(sg.x) * acc[mi][ni][0], bf_hi(sg.x) * acc[mi][ni][1], bf_lo(sg.y) * acc[mi][ni][2], bf_hi(sg.y) * acc[mi][ni][3]};
                        u32x2* dst = (u32x2*)(M + eo);
                        if (br) { const u32x2 pv = *dst; v[0] += bf_lo(pv.x); v[1] += bf_hi(pv.x); v[2] += bf_lo(pv.y); v[3] += bf_hi(pv.y); }
                        *dst = (u32x2){pack2(v[0], v[1]), pack2(v[2], v[3])};
                    }
            }
        }
    }
}

__device__ void phaseM2(const Params& p, char* lds) {
    const int tid_ = TIDX512; const int lane = tid_ & 63, wave = tid_ >> 6;
    const int wr = wave >> 2, wc = wave & 3, r = lane & 15, q = lane >> 4;
    const bf16_t* M = (const bf16_t*)(p.ws + OFF_M);
    const float* mod = (const float*)(p.ws + OFF_MOD);
    TileIter tit(4, lds);
    int bm, bn;
    while (tit.next(bm, bn)) {
        const int m0 = bm * 256, n0 = bn * 256;
        f32x4 acc[8][4];
        zero_acc(acc);
        gemm_core(acc, M, DM, (const bf16_t*)(p.ws + OFF_WO), DM, DM, m0, n0, lds);
#pragma unroll
        for (int mi = 0; mi < 8; mi++)
#pragma unroll
            for (int ni = 0; ni < 4; ni++) {
                const int tok = m0 + wr * 128 + mi * 16 + r, col = n0 + wc * 64 + ni * 16 + 4 * q;
                const f32x4 xv = *(const f32x4*)(p.x + (size_t)tok * DM + col);
                const f32x4 gt = *(const f32x4*)(mod + (tok >> 11) * 6144 + 2 * 1024 + col);
                *(f32x4*)(p.out + (size_t)tok * DM + col) = xv + gt * acc[mi][ni];
            }
    }
    {
        const int tid_ = TIDX; const int lane = tid_ & 63, wave = tid_ >> 6;
        unsigned char* tq = (unsigned char*)(p.ws + OFF_UB);
        float* tsc = (float*)(p.ws + OFF_UB + 33554432);
        for (int row = vblk() * 4 + wave; row < 32768; row += vgrid() * 4) {
            const bool isv = row >= 16384;
            const float* srcp = (isv ? p.peer_v : p.peer_u) + (size_t)(row & 16383) * DM + lane * 16;
            f32x4 a[4];
            float mx = 0.f;
#pragma unroll
            for (int i = 0; i < 4; i++) {
                a[i] = *(const f32x4*)(srcp + i * 4);
                mx = fmaxf(mx, fmaxf(fmaxf(fabsf(a[i][0]), fabsf(a[i][1])), fmaxf(fabsf(a[i][2]), fabsf(a[i][3]))));
            }
            mx = wave_max(mx);
            const float inv = mx > 0.f ? 127.f / mx : 0.f;
            const int off = isv ? 128 : 0;
            unsigned w[4];
#pragma unroll
            for (int i = 0; i < 4; i++) {
                unsigned pk = 0;
#pragma unroll
                for (int j = 0; j < 4; j++) {
                    int qi = (int)rintf(a[i][j] * inv);
                    qi = qi > 127 ? 127 : (qi < -127 ? -127 : qi);
                    pk |= ((unsigned)(qi + off) & 0xffu) << (8 * j);
                }
                w[i] = pk;
            }
            *(u32x4*)(tq + (size_t)row * DM + lane * 16) = (u32x4){w[0], w[1], w[2], w[3]};
            if (lane == 0) tsc[row] = mx * (1.f / 127.f);
        }
    }
}

__device__ void phaseP1(const Params& p, char* lds) {
    const int tid_ = TIDX512; const int lane = tid_ & 63, wave = tid_ >> 6;
    const int wr = wave >> 2, wc = wave & 3, r = lane & 15, q = lane >> 4;
    const bf16_t* H = (const bf16_t*)(p.ws + OFF_H);
    bf16_t* QP = (bf16_t*)(p.ws + OFF_QP);
    TileIter tit(8, lds);
    int bm, bn;
    while (tit.next(bm, bn)) {
        const int m0 = bm * 256, n0 = bn * 256;
        f32x4 acc[8][4];
        zero_acc(acc);
        gemm_core(acc, H, DM, (const bf16_t*)(p.ws + OFF_WQ), DM, DM, m0, n0, lds);
#pragma unroll
        for (int mi = 0; mi < 8; mi++)
#pragma unroll
            for (int ni = 0; ni < 4; ni++) epi_fill(lds, wr, wc, r, q, mi, ni, acc[mi][ni]);
        __syncthreads();
        epi_store(lds, QP, 2048, m0, n0, 2048);
        __syncthreads();
    }
}

__constant__ unsigned char c_cand_a[64] = {0,0,0,0,0,0,0,0,0,0,0,0,0,0,0,0, 1,1,1,1,1,1,1,1, 2,2,2,2,2, 3,3,3,3, 4,4,4, 5,5, 6,6, 7,7, 8,9,10,11,12,13,14,15, 0,0,0,0,0,0,0,0,0,0,0,0,0,0};
__constant__ unsigned char c_cand_b[64] = {0,1,2,3,4,5,6,7,8,9,10,11,12,13,14,15, 0,1,2,3,4,5,6,7, 0,1,2,3,4, 0,1,2,3, 0,1,2, 0,1, 0,1, 0,1, 0,0,0,0,0,0,0,0, 0,0,0,0,0,0,0,0,0,0,0,0,0,0};

__device__ __forceinline__ unsigned f2key(float f) { const unsigned u = __float_as_uint(f); return (u & 0x80000000u) ? ~u : (u | 0x80000000u); }
__device__ __forceinline__ float key2f(unsigned k) { const unsigned u = (k & 0x80000000u) ? (k & 0x7fffffffu) : ~k; return __uint_as_float(u); }
__device__ __forceinline__ void cex_desc(unsigned& a, unsigned& b) { const unsigned hi = a > b ? a : b, lo = a > b ? b : a; a = hi; b = lo; }
__device__ __forceinline__ void sort16_desc(unsigned (&a)[16]) {
#pragma unroll
    for (int k = 2; k <= 16; k <<= 1)
#pragma unroll
        for (int j = k >> 1; j > 0; j >>= 1)
#pragma unroll
            for (int i = 0; i < 16; i++) {
                const int l = i ^ j;
                if (l > i) { if ((i & k) == 0) cex_desc(a[i], a[l]); else cex_desc(a[l], a[i]); }
            }
}
__device__ __forceinline__ void merge16_desc(unsigned (&a)[16], const unsigned (&b)[16]) {
#pragma unroll
    for (int i = 0; i < 16; i++) a[i] = a[i] > b[15 - i] ? a[i] : b[15 - i];
#pragma unroll
    for (int j = 8; j > 0; j >>= 1)
#pragma unroll
        for (int i = 0; i < 16; i++) { const int l = i ^ j; if (l > i) cex_desc(a[i], a[l]); }
}

__device__ void phaseP2_task(const Params& p, int task, char* lds) {
    const int tid = TIDX, lane = tid & 63, wave = tid >> 6, r = lane & 15, q = lane >> 4;
    const int h = task & 7, tile = task >> 3;
    const int tok0 = tile * 64;
    const bf16_t* QP = (const bf16_t*)(p.ws + OFF_QP);
    float* S = (float*)lds;
    unsigned* LL = (unsigned*)(lds + 65536);
    {
        const bf16_t* qrow = QP + (size_t)(tok0 + wave * 16 + r) * 2048 + h * 256 + q * 8;
        bf16x8 bq[2][4];
#pragma unroll
        for (int half = 0; half < 2; half++)
#pragma unroll
            for (int ks = 0; ks < 4; ks++) bq[half][ks] = *(const bf16x8*)(qrow + half * 128 + ks * 32);
#pragma unroll
        for (int half = 0; half < 2; half++) {
            const bf16_t* KB = (const bf16_t*)(p.ws + OFF_K1B) + (size_t)half * 131072 + (size_t)h * 128 * 128 + (size_t)r * 128 + q * 8;
            f32x4 acc[8];
#pragma unroll
            for (int nt = 0; nt < 8; nt++) acc[nt] = (f32x4){0.f, 0.f, 0.f, 0.f};
            bf16x8 ak[8];
#pragma unroll
            for (int nt = 0; nt < 8; nt++) ak[nt] = *(const bf16x8*)(KB + (size_t)nt * 16 * 128);
#pragma unroll
            for (int ks = 0; ks < 4; ks++) {
                bf16x8 an[8];
                if (ks + 1 < 4) {
#pragma unroll
                    for (int nt = 0; nt < 8; nt++) an[nt] = *(const bf16x8*)(KB + (size_t)nt * 16 * 128 + (ks + 1) * 32);
                }
#pragma unroll
                for (int nt = 0; nt < 8; nt++) acc[nt] = mfma16(ak[nt], bq[half][ks], acc[nt]);
                if (ks + 1 < 4) {
#pragma unroll
                    for (int nt = 0; nt < 8; nt++) ak[nt] = an[nt];
                }
            }
#pragma unroll
            for (int nt = 0; nt < 8; nt++)
#pragma unroll
                for (int j = 0; j < 4; j++) S[(half * 128 + nt * 16 + 4 * q + j) * 64 + wave * 16 + r] = acc[nt][j];
        }
    }
    __syncthreads();
    {
        const int row = tid & 127, part = tid >> 7, half = row >> 6, tk = row & 63;
        unsigned L[16];
        const float* sp = S + (half * 128 + part * 64) * 64 + tk;
#pragma unroll
        for (int k = 0; k < 16; k++) L[k] = (f2key(sp[k * 64]) & ~127u) | (unsigned)(127 - (part * 64 + k));
        sort16_desc(L);
        for (int gq = 1; gq < 4; gq++) {
            unsigned G[16];
#pragma unroll
            for (int k = 0; k < 16; k++) G[k] = (f2key(sp[(gq * 16 + k) * 64]) & ~127u) | (unsigned)(127 - (part * 64 + gq * 16 + k));
            sort16_desc(G);
            merge16_desc(L, G);
        }
        __syncthreads();
        unsigned* LP = (unsigned*)lds;
#pragma unroll
        for (int k = 0; k < 16; k++) LP[((part * 2 + half) * 16 + k) * 64 + tk] = L[k];
        __syncthreads();
        if (tid < 128) {
            unsigned A[16], Bq[16];
#pragma unroll
            for (int k = 0; k < 16; k++) { A[k] = LP[((0 * 2 + half) * 16 + k) * 64 + tk]; Bq[k] = LP[((1 * 2 + half) * 16 + k) * 64 + tk]; }
            merge16_desc(A, Bq);
#pragma unroll
            for (int k = 0; k < 16; k++) LL[(half * 16 + k) * 64 + tk] = A[k];
        }
    }
    __syncthreads();
    if (tid < 64) {
        const int tk = tid;
        float v1[16], v2[16];
#pragma unroll
        for (int k = 0; k < 16; k++) { v1[k] = key2f(LL[k * 64 + tk] & ~127u); v2[k] = key2f(LL[(16 + k) * 64 + tk] & ~127u); }
        unsigned C[64];
#pragma unroll
        for (int k = 0; k < 64; k++) C[k] = 0u;
        {
            int c = 0;
#pragma unroll
            for (int a = 0; a < 16; a++)
#pragma unroll
                for (int b = 0; b < 16; b++)
                    if ((a + 1) * (b + 1) <= 16) { C[c] = (f2key(v1[a] + v2[b]) & ~63u) | (unsigned)(63 - c); c++; }
        }
        unsigned T[16];
#pragma unroll
        for (int k = 0; k < 16; k++) T[k] = C[k];
        sort16_desc(T);
#pragma unroll
        for (int gq = 1; gq < 4; gq++) {
            unsigned G[16];
#pragma unroll
            for (int k = 0; k < 16; k++) G[k] = C[gq * 16 + k];
            sort16_desc(G);
            merge16_desc(T, G);
        }
        const float mx = key2f(T[0] & ~63u);
        float e[16], sum = 0.f;
#pragma unroll
        for (int k = 0; k < 16; k++) { e[k] = __expf(key2f(T[k] & ~63u) - mx); sum += e[k]; }
        const float inv = 1.f / sum;
        int ei[16];
#pragma unroll
        for (int k = 0; k < 16; k++) {
            const int cc = 63 - (int)(T[k] & 63u);
            const int a = c_cand_a[cc], b = c_cand_b[cc];
            const int i1 = 127 - (int)(LL[a * 64 + tk] & 127u), i2 = 127 - (int)(LL[(16 + b) * 64 + tk] & 127u);
            ei[k] = i1 * 128 + i2;
            e[k] *= inv;
        }
        int* eidx = (int*)(p.ws + OFF_EIDX) + (size_t)(tok0 + tk) * 128 + h * 16;
        float* gw = (float*)(p.ws + OFF_GW) + (size_t)(tok0 + tk) * 128 + h * 16;
#pragma unroll
        for (int k4 = 0; k4 < 4; k4++) {
            *(u32x4*)(eidx + k4 * 4) = (u32x4){(unsigned)ei[k4 * 4], (unsigned)ei[k4 * 4 + 1], (unsigned)ei[k4 * 4 + 2], (unsigned)ei[k4 * 4 + 3]};
            *(f32x4*)(gw + k4 * 4) = (f32x4){e[k4 * 4], e[k4 * 4 + 1], e[k4 * 4 + 2], e[k4 * 4 + 3]};
        }
    }
    __syncthreads();
}

__device__ __forceinline__ float ub0(unsigned w) { return (float)(w & 0xffu); }
__device__ __forceinline__ float ub1(unsigned w) { return (float)((w >> 8) & 0xffu); }
__device__ __forceinline__ float ub2(unsigned w) { return (float)((w >> 16) & 0xffu); }
__device__ __forceinline__ float ub3(unsigned w) { return (float)(w >> 24); }
struct P3Sc { float su, sv, gm; };
constexpr int P3_REC = 2048;
__device__ __forceinline__ void p3_load_u(u32x4 (&ur)[4], P3Sc& sc, const unsigned char* __restrict__ UQ, const float* __restrict__ tsc,
                                          int lane, int ul, int g, const unsigned* rec) {
#pragma unroll
    for (int u = 0; u < 4; u++) ur[u] = *(const u32x4*)(UQ + (size_t)rec[4 * g + u] * DM + lane * 16);
    const int em = (int)rec[4 * g + ul];
    sc.gm = __uint_as_float(rec[128 + 4 * g + ul]);
    sc.su = tsc[em];
    sc.sv = tsc[16384 + em];
}
__device__ __forceinline__ void p3_load_v(u32x4 (&vr)[4], const unsigned char* __restrict__ VQ, int lane, int g, const unsigned* rec) {
#pragma unroll
    for (int u = 0; u < 4; u++) vr[u] = *(const u32x4*)(VQ + (size_t)rec[4 * g + u] * DM + lane * 16);
}
__device__ __forceinline__ void p3_dots(const u32x4 (&ur)[4], const unsigned* rec, int lane, int (&pt)[4]) {
    const u32x4 qh = *(const u32x4*)(rec + 256 + lane * 4);
#pragma unroll
    for (int u = 0; u < 4; u++) {
        int d = __builtin_amdgcn_sdot4((int)ur[u].x, (int)qh.x, 0, false);
        d = __builtin_amdgcn_sdot4((int)ur[u].y, (int)qh.y, d, false);
        d = __builtin_amdgcn_sdot4((int)ur[u].z, (int)qh.z, d, false);
        d = __builtin_amdgcn_sdot4((int)ur[u].w, (int)qh.w, d, false);
        pt[u] = d;
    }
}
__device__ __forceinline__ float p3_weight(const int (&pt)[4], int lane, float sh, const P3Sc& sc) {
    int m2[2], m1;
    const bool c0 = lane & 1;
#pragma unroll
    for (int j = 0; j < 2; j++) { const int keep = c0 ? pt[j + 2] : pt[j], send = c0 ? pt[j] : pt[j + 2]; m2[j] = keep + __shfl_xor(send, 1, 64); }
    const bool c1 = lane & 2;
    { const int keep = c1 ? m2[1] : m2[0], send = c1 ? m2[0] : m2[1]; m1 = keep + __shfl_xor(send, 2, 64); }
    m1 += __shfl_xor(m1, 4, 64);
    m1 += __shfl_xor(m1, 8, 64);
    m1 += __shfl_xor(m1, 16, 64);
    m1 += __shfl_xor(m1, 32, 64);
    const float aval = (float)m1 * (sh * sc.su);
    return sc.gm * gelu_erf(aval) * sc.sv;
}
__device__ __forceinline__ void p3_axpy(const u32x4 (&vr)[4], float ws, float (&acc)[16], float& wsum) {
#pragma unroll
    for (int u = 0; u < 4; u++) {
        const int src_lane = ((u >> 1) & 1) | ((u & 1) << 1);
        const float wu = __shfl(ws, src_lane, 64);
        wsum += wu;
        const unsigned vw[4] = {vr[u].x, vr[u].y, vr[u].z, vr[u].w};
#pragma unroll
        for (int i = 0; i < 4; i++) {
            acc[i * 4 + 0] += wu * ub0(vw[i]); acc[i * 4 + 1] += wu * ub1(vw[i]);
            acc[i * 4 + 2] += wu * ub2(vw[i]); acc[i * 4 + 3] += wu * ub3(vw[i]);
        }
    }
}
__device__ __forceinline__ void p3_token(const Params& p, int tok, int lane, unsigned* rec, float& sh) {
    const bf16_t* H = (const bf16_t*)(p.ws + OFF_H);
    const int* eidx = (const int*)(p.ws + OFF_EIDX);
    const float* gwp = (const float*)(p.ws + OFF_GW);
    {
        const u32x4 a = *(const u32x4*)(H + (size_t)tok * DM + lane * 16), b = *(const u32x4*)(H + (size_t)tok * DM + lane * 16 + 8);
        const unsigned hw[8] = {a.x, a.y, a.z, a.w, b.x, b.y, b.z, b.w};
        float hv[16];
        float mx = 0.f;
#pragma unroll
        for (int i = 0; i < 8; i++) { hv[2 * i] = bf_lo(hw[i]); hv[2 * i + 1] = bf_hi(hw[i]); mx = fmaxf(mx, fmaxf(fabsf(hv[2 * i]), fabsf(hv[2 * i + 1]))); }
        mx = wave_max(mx);
        const float inv = mx > 0.f ? 127.f / mx : 0.f;
        sh = mx * (1.f / 127.f);
        unsigned qh[4];
#pragma unroll
        for (int i = 0; i < 4; i++) {
            unsigned pk = 0;
#pragma unroll
            for (int j = 0; j < 4; j++) pk |= ((unsigned)((int)rintf(hv[i * 4 + j] * inv)) & 0xffu) << (8 * j);
            qh[i] = pk;
        }
        *(u32x4*)(rec + 256 + lane * 4) = (u32x4){qh[0], qh[1], qh[2], qh[3]};
    }
    const int e0 = eidx[(size_t)tok * 128 + lane], e1 = eidx[(size_t)tok * 128 + 64 + lane];
    const float g0 = gwp[(size_t)tok * 128 + lane], g1 = gwp[(size_t)tok * 128 + 64 + lane];
    const int k0 = e0 >> 10, k1 = e1 >> 10;
    int pos0 = 0, pos1 = 0, base = 0;
#pragma unroll
    for (int v = 0; v < 16; v++) {
        const unsigned long long m0 = __ballot(k0 == v), m1 = __ballot(k1 == v);
        const int c0 = __popcll(m0);
        const int r0 = __builtin_amdgcn_mbcnt_hi((unsigned)(m0 >> 32), __builtin_amdgcn_mbcnt_lo((unsigned)m0, 0u));
        const int r1 = __builtin_amdgcn_mbcnt_hi((unsigned)(m1 >> 32), __builtin_amdgcn_mbcnt_lo((unsigned)m1, 0u));
        pos0 = (k0 == v) ? base + r0 : pos0;
        pos1 = (k1 == v) ? base + c0 + r1 : pos1;
        base += c0 + __popcll(m1);
    }
    rec[pos0] = (unsigned)e0; rec[pos1] = (unsigned)e1;
    rec[128 + pos0] = __float_as_uint(g0); rec[128 + pos1] = __float_as_uint(g1);
}
__device__ __forceinline__ void p3_finish(const Params& p, float* dstp, int tok, int lane, const float (&acc)[16], float wsum) {
    const float* mod = (const float*)(p.ws + OFF_MOD);
    const int b = tok >> 11;
    float x2[16];
    float ss = 0.f;
#pragma unroll
    for (int i = 0; i < 4; i++) {
        const int d = lane * 16 + i * 4;
        const f32x4 xv = *(const f32x4*)(p.out + (size_t)tok * DM + d);
        const f32x4 gt = *(const f32x4*)(mod + b * 6144 + 5 * 1024 + d);
#pragma unroll
        for (int j = 0; j < 4; j++) { const float v = xv[j] + gt[j] * (acc[i * 4 + j] - 128.f * wsum); x2[i * 4 + j] = v; ss += v * v; }
    }
    ss = wave_sum(ss);
    const float rstd = rsqrtf(ss * (1.f / 1024.f) + 1e-6f);
#pragma unroll
    for (int i = 0; i < 4; i++) {
        const int d = lane * 16 + i * 4;
        const f32x4 fg = *(const f32x4*)(p.final_g + d);
        f32x4 o;
#pragma unroll
        for (int j = 0; j < 4; j++) o[j] = x2[i * 4 + j] * rstd * fg[j];
        *(f32x4*)(dstp + (size_t)tok * DM + d) = o;
    }
}
__device__ void phaseP3(const Params& p, float* dstp, char* lds) {
    const int tid_ = TIDX; const int lane = tid_ & 63, wave = tid_ >> 6;
    const unsigned char* UQ = (const unsigned char*)(p.ws + OFF_UB);
    const unsigned char* VQ = UQ + 16777216;
    const float* tsc = (const float*)(p.ws + OFF_UB + 33554432);
    const int ul = ((lane & 1) << 1) | ((lane >> 1) & 1);
    constexpr int TPW = 2;
    unsigned* recs = (unsigned*)(lds + wave * TPW * P3_REC);
    for (int tb = (vblk() * 4 + wave) * TPW; tb < NTOK; tb += vgrid() * 4 * TPW) {
        float sh[TPW], acc[TPW][16], wsm[TPW];
        __builtin_amdgcn_wave_barrier();
#pragma unroll
        for (int k = 0; k < TPW; k++) {
            p3_token(p, tb + k, lane, recs + k * (P3_REC / 4), sh[k]);
#pragma unroll
            for (int i = 0; i < 16; i++) acc[k][i] = 0.f;
            wsm[k] = 0.f;
        }
        __builtin_amdgcn_wave_barrier();
        u32x4 ur[4], vr[4];
        P3Sc sc[TPW];
        p3_load_u(ur, sc[0], UQ, tsc, lane, ul, 0, recs);
        p3_load_v(vr, VQ, lane, 0, recs);
        for (int g = 0; g < 32; g++) {
#pragma unroll
            for (int k = 0; k < TPW; k++) {
                const int kn = (k + 1) % TPW;
                const int gn = (k + 1 == TPW) ? g + 1 : g;
                int pt[4];
                p3_dots(ur, recs + k * (P3_REC / 4), lane, pt);
                if (gn < 32) p3_load_u(ur, sc[kn], UQ, tsc, lane, ul, gn, recs + kn * (P3_REC / 4));
                const float w = p3_weight(pt, lane, sh[k], sc[k]);
                p3_axpy(vr, w, acc[k], wsm[k]);
                if (gn < 32) p3_load_v(vr, VQ, lane, gn, recs + kn * (P3_REC / 4));
            }
        }
#pragma unroll
        for (int k = 0; k < TPW; k++) p3_finish(p, dstp, tb + k, lane, acc[k], wsm[k]);
    }
}

#define XB_TMO      128
#define XB_XCNT(j)  (256  + 64 * (j))
#define XB_XSUB(j)  (1280 + 64 * (j))
#define XB_XGEN(j)  (2304 + 64 * (j))
#define XB_TOP      3328
#define XB_TOPGEN   3392
#define XCD_BAR_WORDS 3456
#define XB_SPIN_CAP (1u << 22)
#define LAS __attribute__((address_space(3)))
__device__ __forceinline__ unsigned xb_ld(unsigned* p)              { return __hip_atomic_load(p, __ATOMIC_RELAXED, __HIP_MEMORY_SCOPE_AGENT); }
__device__ __forceinline__ unsigned xb_add(unsigned* p, unsigned v) { return __hip_atomic_fetch_add(p, v, __ATOMIC_RELAXED, __HIP_MEMORY_SCOPE_AGENT); }
__device__ __forceinline__ unsigned xb_xcc_id() { return (unsigned)__builtin_amdgcn_s_getreg((3 << 11) | 20) & 0xFu; }
#define XB_SPIN(cond, bar) do { unsigned _sp = 0; while (cond) { __builtin_amdgcn_s_sleep(1); \
    if ((++_sp & 255u) == 0u) { if (xb_ld(&(bar)[XB_TMO])) break; if (_sp > XB_SPIN_CAP) { atomicAdd(&(bar)[XB_TMO], 1u); break; } } } } while (0)
struct XcdBarrier { unsigned* bar; unsigned x; volatile LAS unsigned* st; };
__device__ __forceinline__ XcdBarrier xcd_barrier_post(unsigned* bar, volatile LAS unsigned* st) {
    XcdBarrier b; b.bar = bar; b.x = xb_xcc_id(); b.st = st;
    if (threadIdx.x == 0) { st[2] = xb_add(&bar[XB_XCNT(b.x)], 1u); st[4] = b.x; }
    return b;
}
__device__ __forceinline__ void xcd_barrier_complete(unsigned* bar, unsigned x, unsigned& nloc, unsigned& nx, unsigned& bal) {
    const unsigned G = gridDim.x * gridDim.y * gridDim.z;
    unsigned sum, cnt, mine, c64, sp = 0u;
    for (;;) {
        sum = 0u; cnt = 0u; mine = 0u; c64 = 0u;
#pragma unroll
        for (unsigned j = 0; j < 16; ++j) { const unsigned c = xb_ld(&bar[XB_XCNT(j)]); sum += c; cnt += (c > 0u) ? 1u : 0u; c64 += (j < 8 && c == 64u) ? 1u : 0u; mine = (j == x) ? c : mine; }
        if (sum == G) break;
        __builtin_amdgcn_s_sleep(1);
        if ((++sp & 255u) == 0u) { if (xb_ld(&bar[XB_TMO])) break; if (sp > XB_SPIN_CAP) { atomicAdd(&bar[XB_TMO], 1u); break; } }
    }
    nloc = mine > 0u ? mine : 1u; nx = cnt > 0u ? cnt : 1u; bal = (sum == G && cnt == 8u && c64 == 8u) ? 1u : 0u;
}
__device__ __forceinline__ void xcd_barrier(const XcdBarrier& b) {
    asm volatile("s_waitcnt vmcnt(0)" ::: "memory");
    __syncthreads();
    if (threadIdx.x == 0) {
        unsigned* bar = b.bar;
        __builtin_amdgcn_s_waitcnt(0);
        unsigned nloc = b.st[0], nx = b.st[1];
        if (nloc == 0u) { unsigned bal; xcd_barrier_complete(bar, b.x, nloc, nx, bal); b.st[0] = nloc; b.st[1] = nx; b.st[3] = bal; }
        const unsigned old = xb_add(&bar[XB_XSUB(b.x)], 1u);
        const unsigned gen = old / nloc;
        if (old + 1u == (gen + 1u) * nloc) {
            __builtin_amdgcn_fence(__ATOMIC_RELEASE, "agent");
            asm volatile("s_waitcnt vmcnt(0)" ::: "memory");
            const unsigned og = xb_add(&bar[XB_TOP], 1u);
            const unsigned tg = og / nx;
            if (og + 1u == (tg + 1u) * nx) xb_add(&bar[XB_TOPGEN], 1u);
            else XB_SPIN(xb_ld(&bar[XB_TOPGEN]) == tg, bar);
            __builtin_amdgcn_fence(__ATOMIC_ACQUIRE, "agent");
            xb_add(&bar[XB_XGEN(b.x)], 1u);
            asm volatile("s_waitcnt vmcnt(0)" ::: "memory");
        } else {
            XB_SPIN(xb_ld(&bar[XB_XGEN(b.x)]) == gen, bar);
            __builtin_amdgcn_fence(__ATOMIC_ACQUIRE, "agent");
            asm volatile("s_waitcnt vmcnt(0)" ::: "memory");
        }
    }
    __syncthreads();
}

typedef __attribute__((address_space(4))) const Params* KParamsPtr;
__device__ __forceinline__ const Params& fresh_params() {
    KParamsPtr kp = (KParamsPtr)__builtin_amdgcn_kernarg_segment_ptr();
    asm volatile("" : "+s"(kp));
    return *(const Params*)kp;
}
#define PF fresh_params()
__global__ void __launch_bounds__(BLOCK_THREADS, 2) mega(Params p_unused) {
    __shared__ __attribute__((aligned(16))) char lds[LDS_BYTES];
    cg::grid_group grid = cg::this_grid();
    volatile LAS unsigned* st = (volatile LAS unsigned*)(lds + 2 * LDS_MAIN);
    if (threadIdx.x < 16) st[threadIdx.x] = 0u;
    __syncthreads();
    XcdBarrier xb = xcd_barrier_post((unsigned*)PF.ws, st);
    char* hl = lds + half_id() * LDS_MAIN;
    volatile unsigned* uex = (volatile unsigned*)(lds + 2 * LDS_MAIN + 32);

    phaseA(PF, hl);
    if (PF.ws == nullptr) grid.sync();
    xcd_barrier(xb);
    { const Params& q_ = PF; phase_modnorm(q_, q_.x, q_.norm1_g, 0, 1, (bf16_t*)(q_.ws + OFF_H)); };
    xcd_barrier(xb);
    phaseC(PF, lds);
    xcd_barrier(xb);
    for (int task = vblk(); task < 1024; task += vgrid()) phaseG1_task(PF, task, hl);
    for (int task = vblk(); task < 512; task += vgrid()) phaseN1_task(PF, task, hl);
    xcd_barrier(xb);
    phaseG2(PF);
    phaseA2(PF, hl);
    xcd_barrier(xb);
    for (int task = vblk(); task < 2048; task += vgrid()) phaseN2_task(PF, task, hl, (bf16_t*)(PF.ws + OFF_Z) + ZQ_N, ZC, uex, lds);
    for (int task = vblk(); task < 1024; task += vgrid()) phaseG3_task(PF, task, hl, (bf16_t*)(PF.ws + OFF_Z) + ZR_G, ZC);
    xcd_barrier(xb);
    phaseM1(PF, lds);
    xcd_barrier(xb);
    phaseM2(PF, lds);
    xcd_barrier(xb);
    { const Params& q_ = PF; phase_modnorm(q_, q_.out, q_.norm2_g, 3, 4, (bf16_t*)(q_.ws + OFF_H)); };
    xcd_barrier(xb);
    phaseP1(PF, lds);
    xcd_barrier(xb);
    for (int task = vblk(); task < 2048; task += vgrid()) phaseP2_task(PF, task, hl);
    xcd_barrier(xb);
    { const Params& q_ = PF; phaseP3(q_, q_.out, hl); };
}

extern "C" void kernel_launch(void* const* d_in, const int* in_sizes, int n_in, void* d_out, int out_size, void* d_ws, size_t ws_size, hipStream_t stream) {
    Params p{};
    p.x = (const float*)d_in[0]; p.c = (const float*)d_in[1]; p.pos = (const int*)d_in[2]; p.ada_w = (const float*)d_in[3]; p.ada_b = (const float*)d_in[4];
    p.norm1_g = (const float*)d_in[5]; p.norm2_g = (const float*)d_in[6]; p.final_g = (const float*)d_in[7]; p.w_in = (const float*)d_in[8];
    p.gla_wa2 = (const float*)d_in[9]; p.gla_ba2 = (const float*)d_in[10]; p.gla_norm_g = (const float*)d_in[11]; p.pe_k = (const float*)d_in[12]; p.pe_v = (const float*)d_in[13];
    p.ck_w1 = (const float*)d_in[14]; p.ck_w2 = (const float*)d_in[15]; p.cv_w1 = (const float*)d_in[16]; p.cv_w2 = (const float*)d_in[17];
    p.w_branch_a = (const float*)d_in[18]; p.w_branch_b = (const float*)d_in[19]; p.w_out = (const float*)d_in[20]; p.peer_wq = (const float*)d_in[21];
    p.peer_k1 = (const float*)d_in[22]; p.peer_k2 = (const float*)d_in[23]; p.peer_u = (const float*)d_in[24]; p.peer_v = (const float*)d_in[25];
    p.out = (float*)d_out; p.ws = (char*)d_ws;
    static int grid_blocks = 0;
    if (!grid_blocks) {
        int dev = 0, cus = 0, per_cu = 0;
        hipGetDevice(&dev);
        hipDeviceGetAttribute(&cus, hipDeviceAttributeMultiprocessorCount, dev);
        hipOccupancyMaxActiveBlocksPerMultiprocessor(&per_cu, mega, BLOCK_THREADS, 0);
        if (per_cu > 1) per_cu = 1;
        if (per_cu < 1) per_cu = 1;
        grid_blocks = cus * per_cu;
    }
    hipMemsetAsync(d_ws, 0, XCD_BAR_WORDS * 4, stream);
    void* args[] = {&p};
    hipError_t e = hipLaunchCooperativeKernel((void*)mega, dim3(grid_blocks), dim3(BLOCK_THREADS), args, 0, stream);
    if (e != hipSuccess) fprintf(stderr, "cooperative launch failed: %s (grid %d)\n", hipGetErrorString(e), grid_blocks);
}
```

```cpp
#include <hip/hip_runtime.h>
#include <hip/hip_cooperative_groups.h>
#include <stdio.h>
namespace cg = cooperative_groups;
#include <stdint.h>
#include <stddef.h>
#include <math.h>

typedef unsigned short bf16_t;
typedef short bf16x8 __attribute__((ext_vector_type(8)));
typedef float f32x4 __attribute__((ext_vector_type(4)));
typedef unsigned u32x4 __attribute__((ext_vector_type(4)));
typedef unsigned u32x2 __attribute__((ext_vector_type(2)));

constexpr int DM = 1024, NB = 8, SEQ = 2048, NTOK = NB * SEQ;
constexpr int ZC = 4992;
constexpr int ZQ_G = 0, ZK_G = 512, ZV_G = 1024, ZR_G = 2048, ZQ_N = 3072, ZKC = 4096, ZVC = 4224, ZKS = 4352, ZVS = 4480,
              ZKW = 4608, ZVW = 4736, ZGATE = 4864, ZLR = 4912;
constexpr int LDS_MAIN = 73728;
constexpr int LDS_BYTES = 2 * LDS_MAIN + 64;
constexpr int NTHREADS = 256;
constexpr int BLOCK_THREADS = 512;

constexpr size_t OFF_MOD = 16384;
constexpr size_t OFF_ROPE = 212992;
constexpr size_t OFF_CMP = 1261568;
constexpr size_t OFF_DEC = 1785856;
constexpr size_t OFF_K1B = 2310144;
constexpr size_t OFF_WC1 = 2834432;
constexpr size_t OFF_WIN = 4194304;
constexpr size_t OFF_WM = 14417920;
constexpr size_t OFF_WA = 18612224;
constexpr size_t OFF_WB = 20709376;
constexpr size_t OFF_WO = 22806528;
constexpr size_t OFF_WQ = 24903680;
constexpr size_t OFF_H = 29360128;
constexpr size_t OFF_M = 62914560;
constexpr size_t OFF_Z = 96468992;
constexpr size_t OFF_VT = OFF_Z + (size_t)NTOK * ZC * 2;
constexpr size_t OFF_QP = OFF_Z;
constexpr size_t OFF_UB = OFF_Z + 67108864;
constexpr size_t OFF_VB = OFF_UB + 33554432;
constexpr size_t OFF_EIDX = OFF_VB + 33554432;
constexpr size_t OFF_GW = OFF_EIDX + 8388608;

struct Params {
    const float* x; const float* c; const int* pos; const float* ada_w; const float* ada_b;
    const float* norm1_g; const float* norm2_g; const float* final_g; const float* w_in;
    const float* gla_wa2; const float* gla_ba2; const float* gla_norm_g; const float* pe_k; const float* pe_v;
    const float* ck_w1; const float* ck_w2; const float* cv_w1; const float* cv_w2;
    const float* w_branch_a; const float* w_branch_b; const float* w_out; const float* peer_wq;
    const float* peer_k1; const float* peer_k2; const float* peer_u; const float* peer_v;
    float* out; char* ws;
};

__device__ __forceinline__ unsigned f2bf_u(float f) { unsigned u = __float_as_uint(f); return (u + 0x7fffu + ((u >> 16) & 1u)) >> 16; }
__device__ __forceinline__ bf16_t f2bf(float f) { return (bf16_t)f2bf_u(f); }
typedef float f32x2_ __attribute__((ext_vector_type(2)));
typedef __bf16 bf16x2_ __attribute__((ext_vector_type(2)));
__device__ __forceinline__ unsigned pack2(float lo, float hi) {
    const f32x2_ v = {lo, hi};
    return __builtin_bit_cast(unsigned, __builtin_convertvector(v, bf16x2_));
}
__device__ __forceinline__ float bf_lo(unsigned u) { return __uint_as_float(u << 16); }
__device__ __forceinline__ float bf_hi(unsigned u) { return __uint_as_float(u & 0xffff0000u); }
__device__ __forceinline__ float bf2f(bf16_t h) { return __uint_as_float(((unsigned)h) << 16); }
__device__ __forceinline__ float wave_sum(float v) {
#pragma unroll
    for (int o = 32; o > 0; o >>= 1) v += __shfl_xor(v, o, 64);
    return v;
}
__device__ __forceinline__ float wave_max(float v) {
#pragma unroll
    for (int o = 32; o > 0; o >>= 1) v = fmaxf(v, __shfl_xor(v, o, 64));
    return v;
}
__device__ __forceinline__ int launder_i(int x) { asm volatile("" : "+v"(x)); return x; }
#define TIDX (launder_i((int)threadIdx.x) & 255)
#define TIDX512 launder_i((int)threadIdx.x)
__device__ __forceinline__ int half_id() { return __builtin_amdgcn_readfirstlane((int)(threadIdx.x >> 8)); }
__device__ __forceinline__ int vblk() { return (int)blockIdx.x * 2 + half_id(); }
__device__ __forceinline__ int vgrid() { return (int)gridDim.x * 2; }
__device__ __forceinline__ float exp2f_(float x) { return __builtin_amdgcn_exp2f(x); }
__device__ __forceinline__ float sigmoidf_(float x) { return __builtin_amdgcn_rcpf(1.f + __expf(-x)); }
__device__ __forceinline__ float siluf_(float x) { return x * __builtin_amdgcn_rcpf(1.f + __expf(-x)); }
__device__ __forceinline__ float gelu_erf(float v) {
    const float t = __builtin_amdgcn_rcpf(fabsf(v) * 0.2316418882f + 1.0f);
    float qp = t * 0.5307027145f + (-0.7265760135f);
    qp = qp * t + 0.7107068705f; qp = qp * t + (-0.142248368f); qp = qp * t + 0.127414796f; qp = qp * t;
    const float m = v * (qp * __builtin_amdgcn_exp2f(v * v * (-0.72134752044f)));
    return v < 0.f ? m : v - m;
}
__device__ __forceinline__ f32x4 mfma16(bf16x8 a, bf16x8 b, f32x4 c) { return __builtin_amdgcn_mfma_f32_16x16x32_bf16(a, b, c, 0, 0, 0); }
__device__ __forceinline__ bf16x8 ld_frag(const bf16_t* p) { return *(const bf16x8*)p; }
__device__ __forceinline__ bf16x8 mk_frag(u32x2 lo, u32x2 hi) { u32x4 t = {lo.x, lo.y, hi.x, hi.y}; return __builtin_bit_cast(bf16x8, t); }

#define WAIT_V(n) asm volatile("s_waitcnt vmcnt(" #n ")" ::: "memory")
__device__ __forceinline__ int swz4(int R) { return (4 - ((R >> 2) & 3)) & 3; }
__device__ __forceinline__ void glds16(const bf16_t* g, char* l) { __builtin_amdgcn_global_load_lds((const unsigned*)g, (unsigned*)l, 16, 0, 0); }
struct GemmSrc { const bf16_t* xsrc; const bf16_t* wsrc; int ldx, ldw; };
__device__ __forceinline__ GemmSrc gemm_src(const bf16_t* __restrict__ X, int ldx, const bf16_t* __restrict__ W, int ldw, int m0, int n0) {
    const int tid = TIDX512, lane = tid & 63, wave = tid >> 6;
    const int R0 = wave * 32 + (lane >> 2);
    const int sw = ((lane & 3) ^ swz4(R0)) * 8;
    GemmSrc g;
    g.xsrc = X + (size_t)(m0 + R0) * ldx + sw;
    g.wsrc = W + (size_t)(n0 + R0) * ldw + sw;
    g.ldx = ldx; g.ldw = ldw;
    return g;
}
__device__ __forceinline__ void gemm_issue(const GemmSrc& g, int kt, int s, char* lds) {
    const int tid = TIDX512, lane = tid & 63, wave = tid >> 6;
    char* xdst = lds + s * 32768 + wave * 2048 + lane * 16;
    char* wdst = xdst + 16384;
#pragma unroll
    for (int i = 0; i < 2; i++) {
        glds16(g.xsrc + (size_t)i * 16 * g.ldx + kt * 32, xdst + i * 1024);
        glds16(g.wsrc + (size_t)i * 16 * g.ldw + kt * 32, wdst + i * 1024);
    }
}
__device__ __forceinline__ void gemm_prologue(const GemmSrc& g, char* lds) { gemm_issue(g, 0, 0, lds); gemm_issue(g, 1, 1, lds); gemm_issue(g, 2, 2, lds); }
__device__ __forceinline__ void gemm_mainloop(f32x4 (&acc)[8][4], const GemmSrc& g, int K, char* lds) {
    const int tid = TIDX512, lane = tid & 63, wave = tid >> 6;
    const int wr = wave >> 2, wc = wave & 3, r = lane & 15, q = lane >> 4;
    const int KT = K / 32;
    const int rdo = r * 64 + ((q ^ swz4(r)) * 16);
    for (int kt = 0; kt < KT; kt++) {
        if (kt + 2 < KT) WAIT_V(8); else if (kt + 1 < KT) WAIT_V(4); else WAIT_V(0);
        __builtin_amdgcn_s_barrier();
        const char* st = lds + (kt & 3) * 32768;
        bf16x8 af[4], bfr[8];
#pragma unroll
        for (int ni = 0; ni < 4; ni++) af[ni] = *(const bf16x8*)(st + 16384 + (wc * 64 + ni * 16) * 64 + rdo);
#pragma unroll
        for (int mi = 0; mi < 8; mi++) bfr[mi] = *(const bf16x8*)(st + (wr * 128 + mi * 16) * 64 + rdo);
        if (kt + 3 < KT) gemm_issue(g, kt + 3, (kt + 3) & 3, lds);
#pragma unroll
        for (int mi = 0; mi < 8; mi++)
#pragma unroll
            for (int ni = 0; ni < 4; ni++) acc[mi][ni] = mfma16(af[ni], bfr[mi], acc[mi][ni]);
        __builtin_amdgcn_sched_barrier(0);
    }
}
__device__ __forceinline__ void gemm_core(f32x4 (&acc)[8][4], const bf16_t* __restrict__ X, int ldx, const bf16_t* __restrict__ W, int ldw,
                                          int K, int m0, int n0, char* lds) {
    const GemmSrc g = gemm_src(X, ldx, W, ldw, m0, n0);
    gemm_prologue(g, lds);
    gemm_mainloop(acc, g, K, lds);
    __syncthreads();
}
__device__ __forceinline__ void zero_acc(f32x4 (&acc)[8][4]) {
#pragma unroll
    for (int a = 0; a < 8; a++)
#pragma unroll
        for (int b = 0; b < 4; b++) acc[a][b] = (f32x4){0.f, 0.f, 0.f, 0.f};
}

constexpr int EPI_ROWB = 528;
__device__ __forceinline__ void epi_fill(char* lds, int wr, int wc, int r, int q, int mi, int ni, f32x4 v) {
    *(u32x2*)(lds + (wr * 128 + mi * 16 + r) * EPI_ROWB + (wc * 64 + ni * 16 + 4 * q) * 2) = (u32x2){pack2(v[0], v[1]), pack2(v[2], v[3])};
}
__device__ __forceinline__ void epi_store(const char* lds, bf16_t* __restrict__ O, int ldo, int m0, int n0, int ncols_valid) {
    const int t = TIDX512;
    const int chunk = t & 31, rsub = t >> 5;
    if (n0 + chunk * 8 < ncols_valid) {
#pragma unroll
        for (int ps = 0; ps < 16; ps++) {
            const int row = ps * 16 + rsub;
            const u32x4 v = *(const u32x4*)(lds + row * EPI_ROWB + chunk * 16);
            *(u32x4*)(O + (size_t)(m0 + row) * ldo + n0 + chunk * 8) = v;
        }
    }
}

struct TileIter {
    int nt, i, x, li; bool fancy;
    __device__ TileIter(int ntiles_n, const char*) { nt = ntiles_n; fancy = (gridDim.x == 256) && ((nt & 3) == 0); x = blockIdx.x & 7; li = blockIdx.x >> 3; i = fancy ? 0 : blockIdx.x; }
    __device__ bool next(int& bm, int& bn) {
        if (fancy) {
            if (i * 4 >= nt) return false;
            bm = x * 8 + (li & 7); bn = i * 4 + (li >> 3); i++; return true;
        }
        if (i >= 64 * nt) return false;
        bn = i % nt; bm = i / nt; i += gridDim.x; return true;
    }
};

struct MapId { __device__ int operator()(int n) const { return n; } };
struct MapWin {
    __device__ int operator()(int n) const { return n < 3072 ? n : (n < 4912 ? n + 16 : (n < 4928 ? n - 1840 : -1)); }
};
struct MapOff { int off; __device__ int operator()(int n) const { return n + off; } };

template <class Map>
__device__ __forceinline__ void tconv_tile(const float* __restrict__ src, int ldsrc, bf16_t* __restrict__ dst, int ldd, int n0, int k0, Map map, float* t) {
    const int tid = TIDX;
    const int n = tid & 63, kb = tid >> 6;
    const int sc = map(n0 + n);
#pragma unroll
    for (int i = 0; i < 16; i++) { const int k = i * 4 + kb; t[k * 65 + n] = sc >= 0 ? src[(size_t)(k0 + k) * ldsrc + sc] : 0.f; }
    __syncthreads();
    const int nn = tid >> 2, kk = (tid & 3) * 16;
    unsigned w[8];
#pragma unroll
    for (int j = 0; j < 8; j++) w[j] = pack2(t[(kk + 2 * j) * 65 + nn], t[(kk + 2 * j + 1) * 65 + nn]);
    u32x4* d = (u32x4*)(dst + (size_t)(n0 + nn) * ldd + k0 + kk);
    d[0] = (u32x4){w[0], w[1], w[2], w[3]};
    d[1] = (u32x4){w[4], w[5], w[6], w[7]};
    __syncthreads();
}

constexpr int TA_MOD = 192, TA_WIN = 78 * 16, TA_WM = 32 * 16, TA_SQ = 16 * 16, TA_WQ = 32 * 16, TA_WC = 32, TA_K12 = 64, TA_ROPE = 512;
constexpr int TA_E0 = TA_MOD, TA_E1 = TA_E0 + TA_WIN, TA_E2 = TA_E1 + TA_WM, TA_E3 = TA_E2 + TA_SQ, TA_E4 = TA_E3 + TA_SQ, TA_E5 = TA_E4 + TA_SQ,
              TA_E6 = TA_E5 + TA_WQ, TA_E7 = TA_E6 + TA_WC, TA_E8 = TA_E7 + TA_WC, TA_E9 = TA_E8 + TA_K12, TA_E10 = TA_E9 + TA_K12, TA_E11 = TA_E10 + TA_ROPE;

__device__ void phaseA(const Params& p, char* lds) {
    const int tid = TIDX;
    float* fl = (float*)lds;
    constexpr int N0 = TA_E1 + (TA_E8 - TA_E6) + (TA_E11 - TA_E10);
    for (int idx = vblk(); idx < N0; idx += vgrid()) {
        const int task = idx < TA_E1 ? idx : (idx < TA_E1 + (TA_E8 - TA_E6) ? idx - TA_E1 + TA_E6 : idx - TA_E1 - (TA_E8 - TA_E6) + TA_E10);
        if (task < TA_E0) {
            float* sc = fl;
            float* red = fl + 8192;
            {
                f32x4 cv[8];
#pragma unroll
                for (int i = 0; i < 8; i++) cv[i] = *(const f32x4*)(p.c + (i * 256 + tid) * 4);
#pragma unroll
                for (int i = 0; i < 8; i++) *(f32x4*)(sc + (i * 256 + tid) * 4) = (f32x4){siluf_(cv[i][0]), siluf_(cv[i][1]), siluf_(cv[i][2]), siluf_(cv[i][3])};
            }
            __syncthreads();
            const int n = task * 32 + (tid & 31), kg = tid >> 5;
            float a[8];
#pragma unroll
            for (int b = 0; b < 8; b++) a[b] = 0.f;
            for (int k0 = kg * 128; k0 < kg * 128 + 128; k0 += 16) {
                float w[16];
#pragma unroll
                for (int i = 0; i < 16; i++) w[i] = p.ada_w[(size_t)(k0 + i) * 6144 + n];
#pragma unroll
                for (int i = 0; i < 16; i++)
#pragma unroll
                    for (int b = 0; b < 8; b++) a[b] += sc[b * 1024 + k0 + i] * w[i];
            }
#pragma unroll
            for (int b = 0; b < 8; b++) red[(kg * 8 + b) * 32 + (tid & 31)] = a[b];
            __syncthreads();
            {
                const int b = tid >> 5, nn = tid & 31;
                float s = 0.f;
#pragma unroll
                for (int g = 0; g < 8; g++) s += red[(g * 8 + b) * 32 + nn];
                ((float*)(p.ws + OFF_MOD))[b * 6144 + task * 32 + nn] = s + p.ada_b[task * 32 + nn];
            }
            __syncthreads();
        } else if (task < TA_E1) {
            const int tt = task - TA_E0;
            tconv_tile(p.w_in, 6976, (bf16_t*)(p.ws + OFF_WIN), 1024, (tt >> 4) * 64, (tt & 15) * 64, MapWin(), fl);
        } else if (task < TA_E6) {
        } else if (task < TA_E7) {
            const int tt = task - TA_E6;
            tconv_tile(p.ck_w1, 64, (bf16_t*)(p.ws + OFF_WC1), 2048, 0, tt * 64, MapId(), fl);
        } else if (task < TA_E8) {
            const int tt = task - TA_E7;
            tconv_tile(p.cv_w1, 64, (bf16_t*)(p.ws + OFF_WC1) + 64 * 2048, 2048, 0, tt * 64, MapId(), fl);
        } else if (task < TA_E10) {
        } else {
            const int tt = task - TA_E10;
            const int e = tt * 256 + tid;
            const int tok = e >> 3, i = e & 7;
            const float invf[8] = {1.0f, 0.1939227432012558f, 0.03760603070259094f, 0.007292664609849453f,
                                   0.0014142135623842478f, 0.00027424818836152554f, 5.318296098266728e-05f, 1.0313386155758053e-05f};
            float fr = invf[0];
#pragma unroll
            for (int j = 1; j < 8; j++) fr = (i == j) ? invf[j] : fr;
            const float ang = (float)p.pos[tok] * fr;
            const double rev = (double)ang * 0.15915494309189533577;
            const float fpart = (float)(rev - floor(rev));
            float* cs = (float*)(p.ws + OFF_ROPE);
            cs[e * 2] = __builtin_amdgcn_cosf(fpart);
            cs[e * 2 + 1] = __builtin_amdgcn_sinf(fpart);
        }
    }
}

__device__ void phaseA2(const Params& p, char* lds) {
    const int tid = TIDX;
    float* fl = (float*)lds;
    constexpr int N1 = (TA_E6 - TA_E1) + (TA_E10 - TA_E8);
    for (int idx = vblk(); idx < N1; idx += vgrid()) {
        const int task = idx < (TA_E6 - TA_E1) ? idx + TA_E1 : idx - (TA_E6 - TA_E1) + TA_E8;
        if (task < TA_E1) {
        } else if (task < TA_E2) {
            const int tt = task - TA_E1;
            tconv_tile(p.w_in, 6976, (bf16_t*)(p.ws + OFF_WM), 1024, (tt >> 4) * 64, (tt & 15) * 64, MapOff{4928}, fl);
        } else if (task < TA_E3) {
            const int tt = task - TA_E2;
            tconv_tile(p.w_branch_a, 1024, (bf16_t*)(p.ws + OFF_WA), 1024, (tt >> 4) * 64, (tt & 15) * 64, MapId(), fl);
        } else if (task < TA_E4) {
            const int tt = task - TA_E3;
            tconv_tile(p.w_branch_b, 1024, (bf16_t*)(p.ws + OFF_WB), 1024, (tt >> 4) * 64, (tt & 15) * 64, MapId(), fl);
        } else if (task < TA_E5) {
            const int tt = task - TA_E4;
            tconv_tile(p.w_out, 1024, (bf16_t*)(p.ws + OFF_WO), 1024, (tt >> 4) * 64, (tt & 15) * 64, MapId(), fl);
        } else if (task < TA_E6) {
            const int tt = task - TA_E5;
            tconv_tile(p.peer_wq, 2048, (bf16_t*)(p.ws + OFF_WQ), 1024, (tt >> 4) * 64, (tt & 15) * 64, MapId(), fl);
        } else if (task < TA_E10) {
            const bool second = task >= TA_E9;
            const int tt = task - (second ? TA_E9 : TA_E8);
            const float* src = second ? p.peer_k2 : p.peer_k1;
            bf16_t* dst = (bf16_t*)(p.ws + OFF_K1B) + (second ? 131072 : 0);
            const int i = tt * 2048 + tid * 8;
            const f32x4 a = *(const f32x4*)(src + i), b = *(const f32x4*)(src + i + 4);
            *(u32x4*)(dst + i) = (u32x4){pack2(a[0], a[1]), pack2(a[2], a[3]), pack2(b[0], b[1]), pack2(b[2], b[3])};
        }
    }
}

__device__ void phase_modnorm(const Params& p, const float* __restrict__ src, const float* __restrict__ g, int shift_idx, int scale_idx, bf16_t* __restrict__ dst) {
    const int tid_ = TIDX; const int lane = tid_ & 63, wave = tid_ >> 6;
    const float* mod = (const float*)(p.ws + OFF_MOD);
    for (int tok = vblk() * 4 + wave; tok < NTOK; tok += vgrid() * 4) {
        const int b = tok >> 11;
        const float* xr = src + (size_t)tok * DM;
        f32x4 v[4];
        float ss = 0.f;
#pragma unroll
        for (int c = 0; c < 4; c++) { v[c] = *(const f32x4*)(xr + c * 256 + lane * 4); ss += v[c][0] * v[c][0] + v[c][1] * v[c][1] + v[c][2] * v[c][2] + v[c][3] * v[c][3]; }
        ss = wave_sum(ss);
        const float rstd = rsqrtf(ss * (1.f / 1024.f) + 1e-6f);
#pragma unroll
        for (int c = 0; c < 4; c++) {
            const int d = c * 256 + lane * 4;
            const f32x4 gg = *(const f32x4*)(g + d);
            const f32x4 sc = *(const f32x4*)(mod + b * 6144 + scale_idx * 1024 + d);
            const f32x4 sh = *(const f32x4*)(mod + b * 6144 + shift_idx * 1024 + d);
            float o[4];
#pragma unroll
            for (int j = 0; j < 4; j++) o[j] = (v[c][j] * rstd) * gg[j] * (1.f + sc[j]) + sh[j];
            *(u32x2*)(dst + (size_t)tok * DM + d) = (u32x2){pack2(o[0], o[1]), pack2(o[2], o[3])};
        }
    }
}

__device__ void phaseC(const Params& p, char* lds) {
    const int tid_ = TIDX512; const int lane = tid_ & 63, wave = tid_ >> 6;
    const int wr = wave >> 2, wc = wave & 3, r = lane & 15, q = lane >> 4;
    const bf16_t* H = (const bf16_t*)(p.ws + OFF_H);
    const bf16_t* W = (const bf16_t*)(p.ws + OFF_WIN);
    bf16_t* Z = (bf16_t*)(p.ws + OFF_Z);
    const float* cs = (const float*)(p.ws + OFF_ROPE);
    constexpr int NTN = (ZC + 255) / 256;
    TileIter tit(NTN, lds);
    int bm, bn;
    while (tit.next(bm, bn)) {
        const int m0 = bm * 256, n0 = bn * 256;
        f32x4 acc[8][4];
        zero_acc(acc);
        gemm_core(acc, H, DM, W, DM, DM, m0, n0, lds);
        const int c0 = n0 + wc * 64;
        const bool isq = (c0 >= ZQ_N && c0 < ZKC);
        const bool rope = isq || (c0 >= ZKC && c0 < ZGATE && ((c0 - ZKC) & 255) < 128);
        const float scl = isq ? 0.18033688011112042f : 1.f;
#pragma unroll
        for (int mi = 0; mi < 8; mi++) {
            const int tok = m0 + wr * 128 + mi * 16 + r;
            if (rope) {
                f32x4 v = acc[mi][0];
                f32x4 pr;
#pragma unroll
                for (int j = 0; j < 4; j++) pr[j] = __shfl_xor(v[j], 32, 64);
                const int ib = (q & 1) * 4;
                const f32x4 k0 = *(const f32x4*)(cs + (size_t)tok * 16 + ib * 2);
                const f32x4 k1 = *(const f32x4*)(cs + (size_t)tok * 16 + ib * 2 + 4);
                const float cc[4] = {k0[0], k0[2], k1[0], k1[2]}, sn[4] = {k0[1], k0[3], k1[1], k1[3]};
#pragma unroll
                for (int j = 0; j < 4; j++) v[j] = (q < 2) ? (v[j] * cc[j] - pr[j] * sn[j]) : (v[j] * cc[j] + pr[j] * sn[j]);
                acc[mi][0] = v;
            }
#pragma unroll
            for (int ni = 0; ni < 4; ni++) epi_fill(lds, wr, wc, r, q, mi, ni, acc[mi][ni] * scl);
        }
        if ((c0 >= ZVS && c0 < ZVS + 128) || (c0 >= ZVW && c0 < ZVW + 128)) {
            const int brn = c0 >= ZVW ? 1 : 0, gg = ((c0 - (brn ? ZVW : ZVS)) >> 6) & 1;
            const int bb = m0 >> 11, ts = (m0 & 2047) + wr * 128 + r;
            bf16_t* vt = (bf16_t*)(p.ws + OFF_VT) + ((size_t)((brn * 8 + bb) * 2 + gg) * 64) * SEQ + ts;
#pragma unroll
            for (int mi = 0; mi < 8; mi++)
#pragma unroll
                for (int ni = 0; ni < 4; ni++)
#pragma unroll
                    for (int j = 0; j < 4; j++) vt[(size_t)(ni * 16 + 4 * q + j) * SEQ + mi * 16] = f2bf(acc[mi][ni][j]);
        }
        __syncthreads();
        epi_store(lds, Z, ZC, m0, n0, ZC);
        __syncthreads();
    }
}

__device__ __forceinline__ void gla_prep(const Params& p, int tok0, int h, char* lds) {
    const int tid = TIDX;
    float* bc = (float*)lds;
    float* lrs = (float*)(lds + 32768);
    const bf16_t* Z = (const bf16_t*)(p.ws + OFF_Z);
    for (int i = tid; i < 1024; i += NTHREADS) { const int t = i >> 4, rr = i & 15; lrs[i] = bf2f(Z[(size_t)(tok0 + t) * ZC + ZLR + rr]); }
    const int d = tid & 127, th = tid >> 7;
    float w[16];
#pragma unroll
    for (int rr = 0; rr < 16; rr++) w[rr] = p.gla_wa2[rr * 512 + h * 128 + d];
    const float bias = p.gla_ba2[h * 128 + d];
    __syncthreads();
    float run = 0.f;
    for (int t = th * 32; t < th * 32 + 32; t++) {
        float xv = bias;
#pragma unroll
        for (int rr = 0; rr < 16; rr++) xv += lrs[t * 16 + rr] * w[rr];
        const float ls = fminf(xv, 0.f) - __logf(1.f + __expf(-fabsf(xv)));
        run += ls * (1.f / 16.f);
        bc[t * 128 + d] = run;
    }
    __syncthreads();
    if (th == 1) {
        const float add = bc[31 * 128 + d];
        for (int t = 32; t < 64; t++) bc[t * 128 + d] += add;
    }
    __syncthreads();
}

__device__ void phaseG1_task(const Params& p, int task, char* lds) {
    const int tid = TIDX, lane = tid & 63, wave = tid >> 6, r = lane & 15, q = lane >> 4;
    const int c = task & 31, h = (task >> 5) & 3, b = task >> 7;
    const int tok0 = b * SEQ + c * 64;
    const bf16_t* Z = (const bf16_t*)(p.ws + OFF_Z);
    bf16_t* L = (bf16_t*)p.out;
    float* bc = (float*)lds;
    bf16_t* klT = (bf16_t*)(lds + 36864);
    bf16_t* vT = (bf16_t*)(lds + 36864 + 18432);
    gla_prep(p, tok0, h, lds);
    if (tid < 128) ((float*)(p.ws + OFF_DEC))[task * 128 + tid] = __expf(bc[63 * 128 + tid]);
    {
        f32x4* bg = (f32x4*)(p.ws + OFF_M) + (size_t)task * 2048;
#pragma unroll
        for (int i = 0; i < 8; i++) bg[i * 256 + tid] = ((const f32x4*)bc)[i * 256 + tid];
    }
    {
        const int s = lane, dc = wave * 32;
        const bf16_t* kp = Z + (size_t)(tok0 + s) * ZC + ZK_G + h * 128 + dc;
#pragma unroll
        for (int v4 = 0; v4 < 4; v4++) {
            const u32x4 kv = *(const u32x4*)(kp + v4 * 8);
            const unsigned kw[4] = {kv.x, kv.y, kv.z, kv.w};
#pragma unroll
            for (int j = 0; j < 8; j++) {
                const int d = dc + v4 * 8 + j;
                const float kval = (j & 1) ? bf_hi(kw[j >> 1]) : bf_lo(kw[j >> 1]);
                klT[d * 72 + s] = f2bf(kval * __expf(bc[63 * 128 + d] - bc[s * 128 + d]));
            }
        }
    }
    for (int eh = 0; eh < 2; eh++) {
        __syncthreads();
        {
            const int s = lane, ec = wave * 32;
            const bf16_t* vp = Z + (size_t)(tok0 + s) * ZC + ZV_G + h * 256 + eh * 128 + ec;
#pragma unroll
            for (int v4 = 0; v4 < 4; v4++) {
                const u32x4 vv = *(const u32x4*)(vp + v4 * 8);
                const unsigned vw[4] = {vv.x, vv.y, vv.z, vv.w};
#pragma unroll
                for (int j = 0; j < 8; j++) vT[(ec + v4 * 8 + j) * 72 + s] = (bf16_t)((j & 1) ? (vw[j >> 1] >> 16) : (vw[j >> 1] & 0xffffu));
            }
        }
        __syncthreads();
        f32x4 acc[8][2];
#pragma unroll
        for (int dt = 0; dt < 8; dt++) { acc[dt][0] = (f32x4){0.f, 0.f, 0.f, 0.f}; acc[dt][1] = (f32x4){0.f, 0.f, 0.f, 0.f}; }
#pragma unroll
        for (int ks = 0; ks < 2; ks++) {
            bf16x8 bv[2];
#pragma unroll
            for (int x = 0; x < 2; x++) bv[x] = ld_frag(vT + ((2 * wave + x) * 16 + r) * 72 + ks * 32 + q * 8);
#pragma unroll
            for (int dt = 0; dt < 8; dt++) {
                const bf16x8 a = ld_frag(klT + (dt * 16 + r) * 72 + ks * 32 + q * 8);
#pragma unroll
                for (int x = 0; x < 2; x++) acc[dt][x] = mfma16(a, bv[x], acc[dt][x]);
            }
        }
#pragma unroll
        for (int dt = 0; dt < 8; dt++)
#pragma unroll
            for (int x = 0; x < 2; x++) {
                const int e = eh * 128 + (2 * wave + x) * 16 + r, d = dt * 16 + 4 * q;
                const f32x4 v = acc[dt][x];
                *(u32x2*)(L + ((size_t)task * 256 + e) * 128 + d) = (u32x2){pack2(v[0], v[1]), pack2(v[2], v[3])};
            }
    }
    __syncthreads();
}

__device__ void phaseG2(const Params& p) {
    bf16_t* L = (bf16_t*)p.out;
    const float* dec = (const float*)(p.ws + OFF_DEC);
    for (int idx = vblk() * NTHREADS + (int)(threadIdx.x & 255); idx < 32 * 256 * 16; idx += vgrid() * NTHREADS) {
        const int d8 = idx & 15, e = (idx >> 4) & 255, bh = idx >> 12;
        float st[8];
#pragma unroll
        for (int j = 0; j < 8; j++) st[j] = 0.f;
        for (int c = 0; c < 32; c++) {
            const int task = bh * 32 + c;
            u32x4* ptr = (u32x4*)(L + ((size_t)task * 256 + e) * 128 + d8 * 8);
            const u32x4 lv = *ptr;
            const f32x4 d0 = *(const f32x4*)(dec + task * 128 + d8 * 8), d1 = *(const f32x4*)(dec + task * 128 + d8 * 8 + 4);
            *ptr = (u32x4){pack2(st[0], st[1]), pack2(st[2], st[3]), pack2(st[4], st[5]), pack2(st[6], st[7])};
            st[0] = d0[0] * st[0] + bf_lo(lv.x); st[1] = d0[1] * st[1] + bf_hi(lv.x);
            st[2] = d0[2] * st[2] + bf_lo(lv.y); st[3] = d0[3] * st[3] + bf_hi(lv.y);
            st[4] = d1[0] * st[4] + bf_lo(lv.z); st[5] = d1[1] * st[5] + bf_hi(lv.z);
            st[6] = d1[2] * st[6] + bf_lo(lv.w); st[7] = d1[3] * st[7] + bf_hi(lv.w);
        }
    }
}

__device__ void phaseG3_task(const Params& p, int task, char* lds, bf16_t* ydst, int ystride) {
    const int tid = TIDX, lane = tid & 63, wave = tid >> 6, r = lane & 15, q = lane >> 4;
    const int c = task & 31, h = (task >> 5) & 3, b = task >> 7;
    const int tok0 = b * SEQ + c * 64;
    bf16_t* Z = (bf16_t*)(p.ws + OFF_Z);
    const bf16_t* ST = (const bf16_t*)p.out + (size_t)task * 256 * 128;
    float* bc = (float*)lds;
    bf16_t* vT = (bf16_t*)lds;
    bf16_t* qg = (bf16_t*)(lds + 36864);
    bf16_t* kg = (bf16_t*)(lds + 36864 + 17408);
    bf16_t* P = kg;
    float* red = (float*)(lds + 36864 + 2 * 17408);
    {
        const f32x4* bg = (const f32x4*)(p.ws + OFF_M) + (size_t)task * 2048;
#pragma unroll
        for (int i = 0; i < 8; i++) ((f32x4*)bc)[i * 256 + tid] = bg[i * 256 + tid];
    }
    __syncthreads();
    {
        const int t = tid >> 2, dc = (tid & 3) * 32;
        const bf16_t* qp = Z + (size_t)(tok0 + t) * ZC + ZQ_G + h * 128 + dc;
        const bf16_t* kp = Z + (size_t)(tok0 + t) * ZC + ZK_G + h * 128 + dc;
#pragma unroll
        for (int v4 = 0; v4 < 4; v4++) {
            const u32x4 qv = *(const u32x4*)(qp + v4 * 8), kv = *(const u32x4*)(kp + v4 * 8);
            const unsigned qw[4] = {qv.x, qv.y, qv.z, qv.w}, kw[4] = {kv.x, kv.y, kv.z, kv.w};
            unsigned qo[4], ko[4];
#pragma unroll
            for (int j2 = 0; j2 < 4; j2++) {
                const int d = dc + v4 * 8 + j2 * 2;
                const float b0 = bc[t * 128 + d], b1 = bc[t * 128 + d + 1];
                qo[j2] = pack2(bf_lo(qw[j2]) * 0.08838834764831845f * __expf(b0), bf_hi(qw[j2]) * 0.08838834764831845f * __expf(b1));
                ko[j2] = pack2(bf_lo(kw[j2]) * __expf(-b0), bf_hi(kw[j2]) * __expf(-b1));
            }
            *(u32x4*)(qg + t * 136 + dc + v4 * 8) = (u32x4){qo[0], qo[1], qo[2], qo[3]};
            *(u32x4*)(kg + t * 136 + dc + v4 * 8) = (u32x4){ko[0], ko[1], ko[2], ko[3]};
        }
    }
    __syncthreads();
    {
        const int s = lane, ec = wave * 64;
        const bf16_t* vp = Z + (size_t)(tok0 + s) * ZC + ZV_G + h * 256 + ec;
#pragma unroll
        for (int v4 = 0; v4 < 8; v4++) {
            const u32x4 vv = *(const u32x4*)(vp + v4 * 8);
            const unsigned vw[4] = {vv.x, vv.y, vv.z, vv.w};
#pragma unroll
            for (int j = 0; j < 8; j++) vT[(ec + v4 * 8 + j) * 72 + s] = (bf16_t)((j & 1) ? (vw[j >> 1] >> 16) : (vw[j >> 1] & 0xffffu));
        }
    }
    f32x4 sc[4];
#pragma unroll
    for (int st = 0; st < 4; st++) sc[st] = (f32x4){0.f, 0.f, 0.f, 0.f};
    {
        bf16x8 qf[4];
#pragma unroll
        for (int ks = 0; ks < 4; ks++) qf[ks] = ld_frag(qg + (wave * 16 + r) * 136 + ks * 32 + q * 8);
#pragma unroll
        for (int st = 0; st < 4; st++) {
            if (st <= wave) {
#pragma unroll
                for (int ks = 0; ks < 4; ks++) sc[st] = mfma16(ld_frag(kg + (st * 16 + r) * 136 + ks * 32 + q * 8), qf[ks], sc[st]);
            }
        }
    }
    __syncthreads();
    {
        const int t = wave * 16 + r;
#pragma unroll
        for (int st = 0; st < 4; st++) {
            float pv[4];
#pragma unroll
            for (int j = 0; j < 4; j++) { const int s = st * 16 + 4 * q + j; pv[j] = (s <= t) ? sc[st][j] : 0.f; }
            *(u32x2*)(P + t * 72 + st * 16 + 4 * q) = (u32x2){pack2(pv[0], pv[1]), pack2(pv[2], pv[3])};
        }
    }
    __syncthreads();
    f32x4 o[4][4];
#pragma unroll
    for (int et = 0; et < 4; et++)
#pragma unroll
        for (int tt = 0; tt < 4; tt++) o[et][tt] = (f32x4){0.f, 0.f, 0.f, 0.f};
#pragma unroll
    for (int ks = 0; ks < 2; ks++) {
        bf16x8 pf[4];
#pragma unroll
        for (int tt = 0; tt < 4; tt++) pf[tt] = ld_frag(P + (tt * 16 + r) * 72 + ks * 32 + q * 8);
#pragma unroll
        for (int et = 0; et < 4; et++) {
            const bf16x8 a = ld_frag(vT + ((wave * 4 + et) * 16 + r) * 72 + ks * 32 + q * 8);
#pragma unroll
            for (int tt = 0; tt < 4; tt++) o[et][tt] = mfma16(a, pf[tt], o[et][tt]);
        }
    }
#pragma unroll
    for (int ks = 0; ks < 4; ks++) {
        bf16x8 qf[4];
#pragma unroll
        for (int tt = 0; tt < 4; tt++) qf[tt] = ld_frag(qg + (tt * 16 + r) * 136 + ks * 32 + q * 8);
#pragma unroll
        for (int et = 0; et < 4; et++) {
            const bf16x8 a = *(const bf16x8*)(ST + (size_t)((wave * 4 + et) * 16 + r) * 128 + ks * 32 + q * 8);
#pragma unroll
            for (int tt = 0; tt < 4; tt++) o[et][tt] = mfma16(a, qf[tt], o[et][tt]);
        }
    }
#pragma unroll
    for (int tt = 0; tt < 4; tt++) {
        float ss = 0.f;
#pragma unroll
        for (int et = 0; et < 4; et++)
#pragma unroll
            for (int j = 0; j < 4; j++) ss += o[et][tt][j] * o[et][tt][j];
        ss += __shfl_xor(ss, 16, 64);
        ss += __shfl_xor(ss, 32, 64);
        if (q == 0) red[wave * 64 + tt * 16 + r] = ss;
    }
    __syncthreads();
#pragma unroll
    for (int tt = 0; tt < 4; tt++) {
        const int t = tt * 16 + r;
        const float tot = red[t] + red[64 + t] + red[128 + t] + red[192 + t];
        const float rstd = rsqrtf(tot * (1.f / 256.f) + 1e-6f);
#pragma unroll
        for (int et = 0; et < 4; et++) {
            const int e = (wave * 4 + et) * 16 + 4 * q;
            bf16_t* rp = Z + (size_t)(tok0 + t) * ZC + ZR_G + h * 256 + e;
            const u32x2 rv = *(const u32x2*)rp;
            const f32x4 gn = *(const f32x4*)(p.gla_norm_g + e);
            const float r0 = bf_lo(rv.x), r1 = bf_hi(rv.x), r2 = bf_lo(rv.y), r3 = bf_hi(rv.y);
            const f32x4 ov = o[et][tt];
            *(u32x2*)(ydst + (size_t)(tok0 + t) * ystride + h * 256 + e) = (u32x2){pack2(ov[0] * rstd * gn[0] * siluf_(r0), ov[1] * rstd * gn[1] * siluf_(r1)),
                                  pack2(ov[2] * rstd * gn[2] * siluf_(r2), ov[3] * rstd * gn[3] * siluf_(r3))};
        }
    }
    __syncthreads();
}

__device__ void phaseN1_task(const Params& p, int task, char* lds) {
    const int tid = TIDX, lane = tid & 63, wave = tid >> 6, r = lane & 15, q = lane >> 4;
    const int it = task & 15, g = (task >> 4) & 1, b = (task >> 5) & 7, kv = task >> 8;
    const bf16_t* Z = (const bf16_t*)(p.ws + OFF_Z);
    const bf16_t* W1 = (const bf16_t*)(p.ws + OFF_WC1) + (size_t)kv * 64 * 2048;
    const float* pe = kv ? p.pe_v : p.pe_k;
    const float* w2 = kv ? p.cv_w2 : p.ck_w2;
    const int zoff = (kv ? ZVC : ZKC) + g * 64;
    float* hid = (float*)lds;
    float* hid2 = (float*)(lds + 16384);
    int i = it * 8 + (r & 7); if (i > 126) i = 126;
    f32x4 acc[4];
#pragma unroll
    for (int nt = 0; nt < 4; nt++) acc[nt] = (f32x4){0.f, 0.f, 0.f, 0.f};
    for (int ks = 0; ks < 16; ks++) {
        const int k = wave * 512 + ks * 32 + q * 8;
        const int l = k >> 6, d = k & 63;
        const u32x4 zv = *(const u32x4*)(Z + (size_t)(b * SEQ + i * 16 + l) * ZC + zoff + d);
        const f32x4 p0 = *(const f32x4*)(pe + l * 64 + d), p1 = *(const f32x4*)(pe + l * 64 + d + 4);
        const u32x4 av = {pack2(bf_lo(zv.x) + p0[0], bf_hi(zv.x) + p0[1]), pack2(bf_lo(zv.y) + p0[2], bf_hi(zv.y) + p0[3]),
                          pack2(bf_lo(zv.z) + p1[0], bf_hi(zv.z) + p1[1]), pack2(bf_lo(zv.w) + p1[2], bf_hi(zv.w) + p1[3])};
        const bf16x8 a = __builtin_bit_cast(bf16x8, av);
#pragma unroll
        for (int nt = 0; nt < 4; nt++) {
            const bf16x8 bw = *(const bf16x8*)(W1 + (size_t)(nt * 16 + r) * 2048 + k);
            acc[nt] = mfma16(a, bw, acc[nt]);
        }
    }
#pragma unroll
    for (int nt = 0; nt < 4; nt++)
#pragma unroll
        for (int j = 0; j < 4; j++) hid[(wave * 16 + 4 * q + j) * 64 + nt * 16 + r] = acc[nt][j];
    __syncthreads();
    for (int e = tid; e < 1024; e += NTHREADS) hid2[e] = gelu_erf(hid[e] + hid[1024 + e] + hid[2048 + e] + hid[3072 + e]);
    __syncthreads();
    {
        const int il = tid >> 4, n2 = (tid & 15) * 4;
        f32x4 o = {0.f, 0.f, 0.f, 0.f};
        for (int n = 0; n < 64; n++) {
            const float hv = hid2[il * 64 + n];
            const f32x4 wv = *(const f32x4*)(w2 + n * 64 + n2);
            o += hv * wv;
        }
        const int ig = it * 8 + il;
        if (ig >= 127) o = (f32x4){0.f, 0.f, 0.f, 0.f};
        bf16_t* dst = (bf16_t*)(p.ws + OFF_CMP) + ((size_t)((kv * 8 + b) * 2 + g) * 128 + ig) * 64 + n2;
        if (il < 8) *(u32x2*)dst = (u32x2){pack2(o[0], o[1]), pack2(o[2], o[3])};
    }
    __syncthreads();
}

__device__ __forceinline__ void nsa_block_step(const bf16_t* Ks, const bf16_t* VT, const bf16x8 (&qf)[2][2], f32x4 (&O)[2][4], float (&m)[2], float (&l)[2],
                                               int klo, int khi, int r, int q) {
    f32x4 s[2][4];
#pragma unroll
    for (int x = 0; x < 2; x++)
#pragma unroll
        for (int kt = 0; kt < 4; kt++) s[x][kt] = (f32x4){0.f, 0.f, 0.f, 0.f};
#pragma unroll
    for (int kt = 0; kt < 4; kt++)
#pragma unroll
        for (int ks = 0; ks < 2; ks++) {
            const bf16x8 kf = ld_frag(Ks + (kt * 16 + r) * 64 + (((ks * 4 + q) ^ (r & 7)) * 8));
#pragma unroll
            for (int x = 0; x < 2; x++) s[x][kt] = mfma16(kf, qf[x][ks], s[x][kt]);
        }
    if (!__all((klo <= 0) && (khi >= 63))) {
        const int a = 4 * q - klo;
        const unsigned range = (unsigned)(khi - klo);
        const bool any = khi >= klo;
#pragma unroll
        for (int kt = 0; kt < 4; kt++)
#pragma unroll
            for (int j = 0; j < 4; j++) {
                const bool valid = any && ((unsigned)(kt * 16 + j + a) <= range);
#pragma unroll
                for (int x = 0; x < 2; x++) s[x][kt][j] = valid ? s[x][kt][j] : -3.0e38f;
            }
    }
    bf16x8 pbv[2][2];
#pragma unroll
    for (int x = 0; x < 2; x++) {
        float mx = fmaxf(fmaxf(fmaxf(s[x][0][0], s[x][0][1]), fmaxf(s[x][0][2], s[x][0][3])), fmaxf(fmaxf(s[x][1][0], s[x][1][1]), fmaxf(s[x][1][2], s[x][1][3])));
        mx = fmaxf(mx, fmaxf(fmaxf(fmaxf(s[x][2][0], s[x][2][1]), fmaxf(s[x][2][2], s[x][2][3])), fmaxf(fmaxf(s[x][3][0], s[x][3][1]), fmaxf(s[x][3][2], s[x][3][3]))));
        mx = fmaxf(mx, __shfl_xor(mx, 16, 64));
        mx = fmaxf(mx, __shfl_xor(mx, 32, 64));
        const float mnew = fmaxf(m[x], mx);
        const float alpha = exp2f_(m[x] - mnew);
        m[x] = mnew;
        float ls = 0.f;
#pragma unroll
        for (int kt = 0; kt < 4; kt++)
#pragma unroll
            for (int j = 0; j < 4; j++) { const float pv = exp2f_(s[x][kt][j] - mnew); s[x][kt][j] = pv; ls += pv; }
        l[x] = l[x] * alpha + ls;
#pragma unroll
        for (int dt = 0; dt < 4; dt++) O[x][dt] *= alpha;
#pragma unroll
        for (int s2 = 0; s2 < 2; s2++) {
            const u32x4 t4 = {pack2(s[x][2 * s2][0], s[x][2 * s2][1]), pack2(s[x][2 * s2][2], s[x][2 * s2][3]),
                              pack2(s[x][2 * s2 + 1][0], s[x][2 * s2 + 1][1]), pack2(s[x][2 * s2 + 1][2], s[x][2 * s2 + 1][3])};
            pbv[x][s2] = __builtin_bit_cast(bf16x8, t4);
        }
    }
#pragma unroll
    for (int s2 = 0; s2 < 2; s2++)
#pragma unroll
        for (int dt = 0; dt < 4; dt++) {
            const u32x2 lo = *(const u32x2*)(VT + (dt * 16 + r) * 72 + (2 * s2) * 16 + 4 * q);
            const u32x2 hi = *(const u32x2*)(VT + (dt * 16 + r) * 72 + (2 * s2 + 1) * 16 + 4 * q);
            const bf16x8 va = mk_frag(lo, hi);
#pragma unroll
            for (int x = 0; x < 2; x++) O[x][dt] = mfma16(va, pbv[x][s2], O[x][dt]);
        }
}

__device__ __forceinline__ void nsa_cmp_probs(const bf16_t* Kc, const bf16x8 (&qfx)[2], int nv, int r, int q, f32x4 (&s)[8]) {
#pragma unroll
    for (int kt = 0; kt < 8; kt++) s[kt] = (f32x4){0.f, 0.f, 0.f, 0.f};
#pragma unroll
    for (int kt = 0; kt < 8; kt++)
#pragma unroll
        for (int ks = 0; ks < 2; ks++) s[kt] = mfma16(ld_frag(Kc + (kt * 16 + r) * 72 + ks * 32 + q * 8), qfx[ks], s[kt]);
    float mx = -1e30f;
#pragma unroll
    for (int kt = 0; kt < 8; kt++)
#pragma unroll
        for (int j = 0; j < 4; j++) if (kt * 16 + 4 * q + j < nv) mx = fmaxf(mx, s[kt][j]);
    mx = fmaxf(mx, __shfl_xor(mx, 16, 64));
    mx = fmaxf(mx, __shfl_xor(mx, 32, 64));
    float ls = 0.f;
#pragma unroll
    for (int kt = 0; kt < 8; kt++)
#pragma unroll
        for (int j = 0; j < 4; j++) {
            const float pv = (kt * 16 + 4 * q + j < nv) ? exp2f_(s[kt][j] - mx) : 0.f;
            s[kt][j] = pv; ls += pv;
        }
    ls += __shfl_xor(ls, 16, 64);
    ls += __shfl_xor(ls, 32, 64);
    const float inv = nv > 0 ? 1.f / ls : 0.f;
#pragma unroll
    for (int kt = 0; kt < 8; kt++) s[kt] *= inv;
}

__device__ void phaseN2_task(const Params& p, int task, char* lds, bf16_t* ydst, int ystride, volatile unsigned* uex, char* ldsb) {
    const int tid = TIDX, lane = tid & 63, wave = tid >> 6, r = lane & 15, q = lane >> 4;
    const int t512 = tid + half_id() * 256;
    const int pair = task >> 1, g = pair & 1, b = (pair >> 1) & 7;
    const int tt = (63 - (pair >> 4)) * 2 + (task & 1);
    const int t0 = tt * 16, t = t0 + r;
    const int cur = t0 >> 6;
    bf16_t* Z = (bf16_t*)(p.ws + OFF_Z);
    const size_t rowb = (size_t)b * SEQ;
    bf16_t* Kc = (bf16_t*)ldsb;
    bf16_t* VcT = (bf16_t*)(ldsb + 18432);
    bf16_t* Ks = (bf16_t*)ldsb;
    bf16_t* VT = (bf16_t*)(ldsb + 18432);
    float* impw = (float*)(lds + 35840);
    float* scs = (float*)(lds + 35840 + 32768);
    unsigned* selm = (unsigned*)(lds + 35840 + 32768 + 2048);

    bf16x8 qf[2][2];
#pragma unroll
    for (int x = 0; x < 2; x++)
#pragma unroll
        for (int ks = 0; ks < 2; ks++) qf[x][ks] = *(const bf16x8*)(Z + (rowb + t) * ZC + ZQ_N + (g * 8 + 2 * wave + x) * 64 + ks * 32 + q * 8);
    f32x4* ofl = (f32x4*)(lds + 35840);

    f32x4 Og[2][4];
    {
        const bf16_t* kc = (const bf16_t*)(p.ws + OFF_CMP) + (size_t)((0 * 8 + b) * 2 + g) * 128 * 64;
        const bf16_t* vc = (const bf16_t*)(p.ws + OFF_CMP) + (size_t)((1 * 8 + b) * 2 + g) * 128 * 64;
        {
            const int key = t512 >> 2, ch = (t512 & 3) * 16;
#pragma unroll
            for (int v4 = 0; v4 < 2; v4++) *(u32x4*)(Kc + key * 72 + ch + v4 * 8) = *(const u32x4*)(kc + key * 64 + ch + v4 * 8);
            const int k2 = t512 & 127, dc = (t512 >> 7) * 16;
#pragma unroll
            for (int v4 = 0; v4 < 2; v4++) {
                const u32x4 a = *(const u32x4*)(vc + k2 * 64 + dc + v4 * 8);
                const unsigned w[4] = {a.x, a.y, a.z, a.w};
#pragma unroll
                for (int j = 0; j < 8; j++) VcT[(dc + v4 * 8 + j) * 136 + k2] = (bf16_t)((j & 1) ? (w[j >> 1] >> 16) : (w[j >> 1] & 0xffffu));
            }
        }
        __syncthreads();
        int nv = t >= 31 ? ((t - 31) >> 4) + 1 : 0;
        if (nv > 127) nv = 127;
        f32x4 isum[8];
#pragma unroll
        for (int kt = 0; kt < 8; kt++) isum[kt] = (f32x4){0.f, 0.f, 0.f, 0.f};
#pragma unroll
        for (int x = 0; x < 2; x++) {
            f32x4 s[8];
            nsa_cmp_probs(Kc, qf[x], nv, r, q, s);
#pragma unroll
            for (int kt = 0; kt < 8; kt++) isum[kt] += s[kt];
            f32x4 Oc[4];
#pragma unroll
            for (int dt = 0; dt < 4; dt++) Oc[dt] = (f32x4){0.f, 0.f, 0.f, 0.f};
            __builtin_amdgcn_sched_barrier(0);
#pragma unroll
            for (int s2 = 0; s2 < 4; s2++) {
                const u32x4 t4 = {pack2(s[2 * s2][0], s[2 * s2][1]), pack2(s[2 * s2][2], s[2 * s2][3]),
                                  pack2(s[2 * s2 + 1][0], s[2 * s2 + 1][1]), pack2(s[2 * s2 + 1][2], s[2 * s2 + 1][3])};
                const bf16x8 pbv = __builtin_bit_cast(bf16x8, t4);
#pragma unroll
                for (int dt = 0; dt < 4; dt++) {
                    const u32x2 lo = *(const u32x2*)(VcT + (dt * 16 + r) * 136 + (2 * s2) * 16 + 4 * q);
                    const u32x2 hi = *(const u32x2*)(VcT + (dt * 16 + r) * 136 + (2 * s2 + 1) * 16 + 4 * q);
                    Oc[dt] = mfma16(mk_frag(lo, hi), pbv, Oc[dt]);
                }
            }
            const float g0 = sigmoidf_(bf2f(Z[(rowb + t) * ZC + ZGATE + 0 * 16 + g * 8 + 2 * wave + x]));
#pragma unroll
            for (int dt = 0; dt < 4; dt++) Og[x][dt] = g0 * Oc[dt];
            __builtin_amdgcn_sched_barrier(0);
        }
#pragma unroll
        for (int kt = 0; kt < 8; kt++) *(f32x4*)(impw + (wave * 16 + r) * 128 + kt * 16 + 4 * q) = isum[kt];
        __syncthreads();
#pragma unroll
        for (int pass = 0; pass < 2; pass++) {
            const int tk = pass * 8 + (tid >> 5), j = tid & 31;
            const int i0 = j == 0 ? 0 : 4 * j - 1, i1 = (4 * j + 3 > 126) ? 126 : 4 * j + 3;
            float sc = 0.f;
            for (int i = i0; i <= i1; i++) sc += (impw[(0 * 16 + tk) * 128 + i] + impw[(1 * 16 + tk) * 128 + i]) + (impw[(2 * 16 + tk) * 128 + i] + impw[(3 * 16 + tk) * 128 + i]);
            const bool forced = (j == 0) || (j == cur) || (j == cur - 1);
            scs[tk * 32 + j] = forced ? 1e6f : (j <= cur ? sc : -1.f);
        }
        __syncthreads();
#pragma unroll
        for (int pass = 0; pass < 2; pass++) {
            const int tk = pass * 8 + (tid >> 5), j = tid & 31;
            const float mine = scs[tk * 32 + j];
            int rank = 0;
            for (int j2 = 0; j2 < 32; j2++) { const float o = scs[tk * 32 + j2]; rank += (o > mine || (o == mine && j2 < j)) ? 1 : 0; }
            const unsigned long long bal = __ballot(rank < 16);
            if ((lane & 31) == 0) selm[tk] = (unsigned)(lane ? (bal >> 32) : (bal & 0xffffffffull));
        }
        __syncthreads();
    }
#pragma unroll
    for (int x = 0; x < 2; x++)
#pragma unroll
        for (int dt = 0; dt < 4; dt++) ofl[(wave * 8 + x * 4 + dt) * 64 + lane] = Og[x][dt];
    const unsigned mysel = selm[r];
    unsigned uni = 0;
#pragma unroll
    for (int i = 0; i < 16; i++) uni |= selm[i];
    if (tid == 0) uex[half_id()] = uni;
    __syncthreads();
    uni = uex[0] | uex[1];
    uni &= (cur == 31) ? 0xffffffffu : ((2u << cur) - 1u);
    uni |= 1u;

    {
        const int lo = (t0 & ~31) - 511;
        const int jb0 = lo > 0 ? (lo >> 6) : 0;
        const int kkey = t512 >> 3, kch = (t512 & 7) * 8;
        const int vd = t512 >> 3, vch = (t512 & 7) * 8;
        const bf16_t* vtb = (const bf16_t*)(p.ws + OFF_VT) + ((size_t)(b * 2 + g) * 64 + vd) * SEQ + vch;
        u32x4 kreg, vreg;
        int br = 0, j = 0;
        {
            const bf16_t* kb = Z + (rowb + 0) * ZC + ZKS + g * 64;
            kreg = *(const u32x4*)(kb + (size_t)kkey * ZC + kch);
            vreg = *(const u32x4*)(vtb);
        }
        f32x4 O[2][4];
        float m[2] = {-1e30f, -1e30f}, l[2] = {0.f, 0.f};
#pragma unroll
        for (int x = 0; x < 2; x++)
#pragma unroll
            for (int dt = 0; dt < 4; dt++) O[x][dt] = (f32x4){0.f, 0.f, 0.f, 0.f};
        for (;;) {
            __syncthreads();
            *(u32x4*)(Ks + kkey * 64 + (((kch >> 3) ^ (kkey & 7)) * 8)) = kreg;
            *(u32x4*)(VT + vd * 72 + vch) = vreg;
            __syncthreads();
            int nbr, nj;
            if (br == 0) {
                const unsigned rem = (j >= 31) ? 0u : (uni & ~((2u << j) - 1u));
                if (rem) { nbr = 0; nj = __ffs((int)rem) - 1; } else { nbr = 1; nj = jb0; }
            } else {
                if (j < cur) { nbr = 1; nj = j + 1; } else { nbr = 2; nj = 0; }
            }
            if (nbr < 2) {
                const bf16_t* kb = Z + (rowb + nj * 64) * ZC + (nbr ? ZKW : ZKS) + g * 64;
                kreg = *(const u32x4*)(kb + (size_t)kkey * ZC + kch);
                vreg = *(const u32x4*)(vtb + (size_t)nbr * (8 * 2 * 64) * SEQ + nj * 64);
            }
            int klo = 0, khi = -1;
            if (br == 0) { if ((mysel >> j) & 1u) khi = t - j * 64; }
            else { khi = t - j * 64; klo = t - 511 - j * 64; }
            klo = klo < 0 ? 0 : klo;
            khi = khi > 63 ? 63 : khi;
            nsa_block_step(Ks, VT, qf, O, m, l, klo, khi, r, q);
            if (nbr != br) {
#pragma unroll
                for (int x = 0; x < 2; x++) {
                    float lt = l[x];
                    lt += __shfl_xor(lt, 16, 64);
                    lt += __shfl_xor(lt, 32, 64);
                    const float sc = sigmoidf_(bf2f(Z[(rowb + t) * ZC + ZGATE + (br + 1) * 16 + g * 8 + 2 * wave + x])) / lt;
#pragma unroll
                    for (int dt = 0; dt < 4; dt++) { ofl[(wave * 8 + x * 4 + dt) * 64 + lane] += sc * O[x][dt]; O[x][dt] = (f32x4){0.f, 0.f, 0.f, 0.f}; }
                    m[x] = -1e30f; l[x] = 0.f;
                }
            }
            if (nbr == 2) break;
            br = nbr; j = nj;
        }
#pragma unroll
        for (int x = 0; x < 2; x++)
#pragma unroll
            for (int dt = 0; dt < 4; dt++) {
                const f32x4 v = ofl[(wave * 8 + x * 4 + dt) * 64 + lane];
                *(u32x2*)(ydst + (rowb + t) * ystride + (g * 8 + 2 * wave + x) * 64 + dt * 16 + 4 * q) = (u32x2){pack2(v[0], v[1]), pack2(v[2], v[3])};
            }
    }
    __syncthreads();
}

__device__ void phaseM1(const Params& p, char* lds) {
    const int tid_ = TIDX512; const int lane = tid_ & 63, wave = tid_ >> 6;
    const int wr = wave >> 2, wc = wave & 3, r = lane & 15, q = lane >> 4;
    const bf16_t* H = (const bf16_t*)(p.ws + OFF_H);
    const bf16_t* Z = (const bf16_t*)(p.ws + OFF_Z);
    bf16_t* M = (bf16_t*)(p.ws + OFF_M);
    bf16_t* SG = (bf16_t*)p.out;
    TileIter tit(4, lds);
    int bm, bn;
    while (tit.next(bm, bn)) {
        const int m0 = bm * 256, n0 = bn * 256;
        for (int br = 0; br < 2; br++) {
            f32x4 acc[8][4];
            zero_acc(acc);
            gemm_core(acc, H, DM, (const bf16_t*)(p.ws + OFF_WM) + (size_t)br * 1024 * 1024, DM, DM, m0, n0, lds);
            {
                const int e0 = launder_i((m0 + wr * 128 + r) * DM + n0 + wc * 64 + 4 * q);
#pragma unroll
                for (int mi = 0; mi < 8; mi++)
#pragma unroll
                    for (int ni = 0; ni < 4; ni++)
                        *(u32x2*)(SG + (size_t)(e0 + mi * 16 * DM + ni * 16)) = (u32x2){pack2(sigmoidf_(acc[mi][ni][0]), sigmoidf_(acc[mi][ni][1])),
                                                                                        pack2(sigmoidf_(acc[mi][ni][2]), sigmoidf_(acc[mi][ni][3]))};
            }
            zero_acc(acc);
            gemm_core(acc, Z + (br ? ZQ_N : ZR_G), ZC, (const bf16_t*)(p.ws + (br ? OFF_WB : OFF_WA)), DM, DM, m0, n0, lds);
            {
                const int e0 = launder_i((m0 + wr * 128 + r) * DM + n0 + wc * 64 + 4 * q);
#pragma unroll
                for (int mi = 0; mi < 8; mi++)
#pragma unroll
                    for (int ni = 0; ni < 4; ni++) {
                        const size_t eo = (size_t)(e0 + mi * 16 * DM + ni * 16);
                        const u32x2 sg = *(const u32x2*)(SG + eo);
                        float v[4] = {bf_lo(sg.x) * acc[mi][ni][0], bf_hi(sg.x) * acc[mi][ni][1], bf_lo(sg.y) * acc[mi][ni][2], bf_hi(sg.y) * acc[mi][ni][3]};
                        u32x2* dst = (u32x2*)(M + eo);
                        if (br) { const u32x2 pv = *dst; v[0] += bf_lo(pv.x); v[1] += bf_hi(pv.x); v[2] += bf_lo(pv.y); v[3] += bf_hi(pv.y); }
                        *dst = (u32x2){pack2(v[0], v[1]), pack2(v[2], v[3])};
                    }
            }
        }
    }
}

__device__ void phaseM2(const Params& p, char* lds) {
    const int tid_ = TIDX512; const int lane = tid_ & 63, wave = tid_ >> 6;
    const int wr = wave >> 2, wc = wave & 3, r = lane & 15, q = lane >> 4;
    const bf16_t* M = (const bf16_t*)(p.ws + OFF_M);
    const float* mod = (const float*)(p.ws + OFF_MOD);
    TileIter tit(4, lds);
    int bm, bn;
    while (tit.next(bm, bn)) {
        const int m0 = bm * 256, n0 = bn * 256;
        f32x4 acc[8][4];
        zero_acc(acc);
        gemm_core(acc, M, DM, (const bf16_t*)(p.ws + OFF_WO), DM, DM, m0, n0, lds);
#pragma unroll
        for (int mi = 0; mi < 8; mi++)
#pragma unroll
            for (int ni = 0; ni < 4; ni++) {
                const int tok = m0 + wr * 128 + mi * 16 + r, col = n0 + wc * 64 + ni * 16 + 4 * q;
                const f32x4 xv = *(const f32x4*)(p.x + (size_t)tok * DM + col);
                const f32x4 gt = *(const f32x4*)(mod + (tok >> 11) * 6144 + 2 * 1024 + col);
                *(f32x4*)(p.out + (size_t)tok * DM + col) = xv + gt * acc[mi][ni];
            }
    }
    {
        const int tid_ = TIDX; const int lane = tid_ & 63, wave = tid_ >> 6;
        unsigned char* tq = (unsigned char*)(p.ws + OFF_UB);
        float* tsc = (float*)(p.ws + OFF_UB + 33554432);
        for (int row = vblk() * 4 + wave; row < 32768; row += vgrid() * 4) {
            const bool isv = row >= 16384;
            const float* srcp = (isv ? p.peer_v : p.peer_u) + (size_t)(row & 16383) * DM + lane * 16;
            f32x4 a[4];
            float mx = 0.f;
#pragma unroll
            for (int i = 0; i < 4; i++) {
                a[i] = *(const f32x4*)(srcp + i * 4);
                mx = fmaxf(mx, fmaxf(fmaxf(fabsf(a[i][0]), fabsf(a[i][1])), fmaxf(fabsf(a[i][2]), fabsf(a[i][3]))));
            }
            mx = wave_max(mx);
            const float inv = mx > 0.f ? 127.f / mx : 0.f;
            const int off = isv ? 128 : 0;
            unsigned w[4];
#pragma unroll
            for (int i = 0; i < 4; i++) {
                unsigned pk = 0;
#pragma unroll
                for (int j = 0; j < 4; j++) {
                    int qi = (int)rintf(a[i][j] * inv);
                    qi = qi > 127 ? 127 : (qi < -127 ? -127 : qi);
                    pk |= ((unsigned)(qi + off) & 0xffu) << (8 * j);
                }
                w[i] = pk;
            }
            *(u32x4*)(tq + (size_t)row * DM + lane * 16) = (u32x4){w[0], w[1], w[2], w[3]};
            if (lane == 0) tsc[row] = mx * (1.f / 127.f);
        }
    }
}

__device__ void phaseP1(const Params& p, char* lds) {
    const int tid_ = TIDX512; const int lane = tid_ & 63, wave = tid_ >> 6;
    const int wr = wave >> 2, wc = wave & 3, r = lane & 15, q = lane >> 4;
    const bf16_t* H = (const bf16_t*)(p.ws + OFF_H);
    bf16_t* QP = (bf16_t*)(p.ws + OFF_QP);
    TileIter tit(8, lds);
    int bm, bn;
    while (tit.next(bm, bn)) {
        const int m0 = bm * 256, n0 = bn * 256;
        f32x4 acc[8][4];
        zero_acc(acc);
        gemm_core(acc, H, DM, (const bf16_t*)(p.ws + OFF_WQ), DM, DM, m0, n0, lds);
#pragma unroll
        for (int mi = 0; mi < 8; mi++)
#pragma unroll
            for (int ni = 0; ni < 4; ni++) epi_fill(lds, wr, wc, r, q, mi, ni, acc[mi][ni]);
        __syncthreads();
        epi_store(lds, QP, 2048, m0, n0, 2048);
        __syncthreads();
    }
}

__constant__ unsigned char c_cand_a[64] = {0,0,0,0,0,0,0,0,0,0,0,0,0,0,0,0, 1,1,1,1,1,1,1,1, 2,2,2,2,2, 3,3,3,3, 4,4,4, 5,5, 6,6, 7,7, 8,9,10,11,12,13,14,15, 0,0,0,0,0,0,0,0,0,0,0,0,0,0};
__constant__ unsigned char c_cand_b[64] = {0,1,2,3,4,5,6,7,8,9,10,11,12,13,14,15, 0,1,2,3,4,5,6,7, 0,1,2,3,4, 0,1,2,3, 0,1,2, 0,1, 0,1, 0,1, 0,0,0,0,0,0,0,0, 0,0,0,0,0,0,0,0,0,0,0,0,0,0};

__device__ __forceinline__ unsigned f2key(float f) { const unsigned u = __float_as_uint(f); return (u & 0x80000000u) ? ~u : (u | 0x80000000u); }
__device__ __forceinline__ float key2f(unsigned k) { const unsigned u = (k & 0x80000000u) ? (k & 0x7fffffffu) : ~k; return __uint_as_float(u); }
__device__ __forceinline__ void cex_desc(unsigned& a, unsigned& b) { const unsigned hi = a > b ? a : b, lo = a > b ? b : a; a = hi; b = lo; }
__device__ __forceinline__ void sort16_desc(unsigned (&a)[16]) {
#pragma unroll
    for (int k = 2; k <= 16; k <<= 1)
#pragma unroll
        for (int j = k >> 1; j > 0; j >>= 1)
#pragma unroll
            for (int i = 0; i < 16; i++) {
                const int l = i ^ j;
                if (l > i) { if ((i & k) == 0) cex_desc(a[i], a[l]); else cex_desc(a[l], a[i]); }
            }
}
__device__ __forceinline__ void merge16_desc(unsigned (&a)[16], const unsigned (&b)[16]) {
#pragma unroll
    for (int i = 0; i < 16; i++) a[i] = a[i] > b[15 - i] ? a[i] : b[15 - i];
#pragma unroll
    for (int j = 8; j > 0; j >>= 1)
#pragma unroll
        for (int i = 0; i < 16; i++) { const int l = i ^ j; if (l > i) cex_desc(a[i], a[l]); }
}

__device__ void phaseP2_task(const Params& p, int task, char* lds) {
    const int tid = TIDX, lane = tid & 63, wave = tid >> 6, r = lane & 15, q = lane >> 4;
    const int h = task & 7, tile = task >> 3;
    const int tok0 = tile * 64;
    const bf16_t* QP = (const bf16_t*)(p.ws + OFF_QP);
    float* S = (float*)lds;
    unsigned* LL = (unsigned*)(lds + 65536);
    {
        const bf16_t* qrow = QP + (size_t)(tok0 + wave * 16 + r) * 2048 + h * 256 + q * 8;
        bf16x8 bq[2][4];
#pragma unroll
        for (int half = 0; half < 2; half++)
#pragma unroll
            for (int ks = 0; ks < 4; ks++) bq[half][ks] = *(const bf16x8*)(qrow + half * 128 + ks * 32);
#pragma unroll
        for (int half = 0; half < 2; half++) {
            const bf16_t* KB = (const bf16_t*)(p.ws + OFF_K1B) + (size_t)half * 131072 + (size_t)h * 128 * 128 + (size_t)r * 128 + q * 8;
            f32x4 acc[8];
#pragma unroll
            for (int nt = 0; nt < 8; nt++) acc[nt] = (f32x4){0.f, 0.f, 0.f, 0.f};
            bf16x8 ak[8];
#pragma unroll
            for (int nt = 0; nt < 8; nt++) ak[nt] = *(const bf16x8*)(KB + (size_t)nt * 16 * 128);
#pragma unroll
            for (int ks = 0; ks < 4; ks++) {
                bf16x8 an[8];
                if (ks + 1 < 4) {
#pragma unroll
                    for (int nt = 0; nt < 8; nt++) an[nt] = *(const bf16x8*)(KB + (size_t)nt * 16 * 128 + (ks + 1) * 32);
                }
#pragma unroll
                for (int nt = 0; nt < 8; nt++) acc[nt] = mfma16(ak[nt], bq[half][ks], acc[nt]);
                if (ks + 1 < 4) {
#pragma unroll
                    for (int nt = 0; nt < 8; nt++) ak[nt] = an[nt];
                }
            }
#pragma unroll
            for (int nt = 0; nt < 8; nt++)
#pragma unroll
                for (int j = 0; j < 4; j++) S[(half * 128 + nt * 16 + 4 * q + j) * 64 + wave * 16 + r] = acc[nt][j];
        }
    }
    __syncthreads();
    {
        const int row = tid & 127, part = tid >> 7, half = row >> 6, tk = row & 63;
        unsigned L[16];
        const float* sp = S + (half * 128 + part * 64) * 64 + tk;
#pragma unroll
        for (int k = 0; k < 16; k++) L[k] = (f2key(sp[k * 64]) & ~127u) | (unsigned)(127 - (part * 64 + k));
        sort16_desc(L);
        for (int gq = 1; gq < 4; gq++) {
            unsigned G[16];
#pragma unroll
            for (int k = 0; k < 16; k++) G[k] = (f2key(sp[(gq * 16 + k) * 64]) & ~127u) | (unsigned)(127 - (part * 64 + gq * 16 + k));
            sort16_desc(G);
            merge16_desc(L, G);
        }
        __syncthreads();
        unsigned* LP = (unsigned*)lds;
#pragma unroll
        for (int k = 0; k < 16; k++) LP[((part * 2 + half) * 16 + k) * 64 + tk] = L[k];
        __syncthreads();
        if (tid < 128) {
            unsigned A[16], Bq[16];
#pragma unroll
            for (int k = 0; k < 16; k++) { A[k] = LP[((0 * 2 + half) * 16 + k) * 64 + tk]; Bq[k] = LP[((1 * 2 + half) * 16 + k) * 64 + tk]; }
            merge16_desc(A, Bq);
#pragma unroll
            for (int k = 0; k < 16; k++) LL[(half * 16 + k) * 64 + tk] = A[k];
        }
    }
    __syncthreads();
    if (tid < 64) {
        const int tk = tid;
        float v1[16], v2[16];
#pragma unroll
        for (int k = 0; k < 16; k++) { v1[k] = key2f(LL[k * 64 + tk] & ~127u); v2[k] = key2f(LL[(16 + k) * 64 + tk] & ~127u); }
        unsigned C[64];
#pragma unroll
        for (int k = 0; k < 64; k++) C[k] = 0u;
        {
            int c = 0;
#pragma unroll
            for (int a = 0; a < 16; a++)
#pragma unroll
                for (int b = 0; b < 16; b++)
                    if ((a + 1) * (b + 1) <= 16) { C[c] = (f2key(v1[a] + v2[b]) & ~63u) | (unsigned)(63 - c); c++; }
        }
        unsigned T[16];
#pragma unroll
        for (int k = 0; k < 16; k++) T[k] = C[k];
        sort16_desc(T);
#pragma unroll
        for (int gq = 1; gq < 4; gq++) {
            unsigned G[16];
#pragma unroll
            for (int k = 0; k < 16; k++) G[k] = C[gq * 16 + k];
            sort16_desc(G);
            merge16_desc(T, G);
        }
        const float mx = key2f(T[0] & ~63u);
        float e[16], sum = 0.f;
#pragma unroll
        for (int k = 0; k < 16; k++) { e[k] = __expf(key2f(T[k] & ~63u) - mx); sum += e[k]; }
        const float inv = 1.f / sum;
        int ei[16];
#pragma unroll
        for (int k = 0; k < 16; k++) {
            const int cc = 63 - (int)(T[k] & 63u);
            const int a = c_cand_a[cc], b = c_cand_b[cc];
            const int i1 = 127 - (int)(LL[a * 64 + tk] & 127u), i2 = 127 - (int)(LL[(16 + b) * 64 + tk] & 127u);
            ei[k] = i1 * 128 + i2;
            e[k] *= inv;
        }
        int* eidx = (int*)(p.ws + OFF_EIDX) + (size_t)(tok0 + tk) * 128 + h * 16;
        float* gw = (float*)(p.ws + OFF_GW) + (size_t)(tok0 + tk) * 128 + h * 16;
#pragma unroll
        for (int k4 = 0; k4 < 4; k4++) {
            *(u32x4*)(eidx + k4 * 4) = (u32x4){(unsigned)ei[k4 * 4], (unsigned)ei[k4 * 4 + 1], (unsigned)ei[k4 * 4 + 2], (unsigned)ei[k4 * 4 + 3]};
            *(f32x4*)(gw + k4 * 4) = (f32x4){e[k4 * 4], e[k4 * 4 + 1], e[k4 * 4 + 2], e[k4 * 4 + 3]};
        }
    }
    __syncthreads();
}

__device__ __forceinline__ float ub0(unsigned w) { return (float)(w & 0xffu); }
__device__ __forceinline__ float ub1(unsigned w) { return (float)((w >> 8) & 0xffu); }
__device__ __forceinline__ float ub2(unsigned w) { return (float)((w >> 16) & 0xffu); }
__device__ __forceinline__ float ub3(unsigned w) { return (float)(w >> 24); }
struct P3Sc { float su, sv, gm; };
constexpr int P3_REC = 2048;
__device__ __forceinline__ void p3_load_u(u32x4 (&ur)[4], P3Sc& sc, const unsigned char* __restrict__ UQ, const float* __restrict__ tsc,
                                          int lane, int ul, int g, const unsigned* rec) {
#pragma unroll
    for (int u = 0; u < 4; u++) ur[u] = *(const u32x4*)(UQ + (size_t)rec[4 * g + u] * DM + lane * 16);
    const int em = (int)rec[4 * g + ul];
    sc.gm = __uint_as_float(rec[128 + 4 * g + ul]);
    sc.su = tsc[em];
    sc.sv = tsc[16384 + em];
}
__device__ __forceinline__ void p3_load_v(u32x4 (&vr)[4], const unsigned char* __restrict__ VQ, int lane, int g, const unsigned* rec) {
#pragma unroll
    for (int u = 0; u < 4; u++) vr[u] = *(const u32x4*)(VQ + (size_t)rec[4 * g + u] * DM + lane * 16);
}
__device__ __forceinline__ void p3_dots(const u32x4 (&ur)[4], const unsigned* rec, int lane, int (&pt)[4]) {
    const u32x4 qh = *(const u32x4*)(rec + 256 + lane * 4);
#pragma unroll
    for (int u = 0; u < 4; u++) {
        int d = __builtin_amdgcn_sdot4((int)ur[u].x, (int)qh.x, 0, false);
        d = __builtin_amdgcn_sdot4((int)ur[u].y, (int)qh.y, d, false);
        d = __builtin_amdgcn_sdot4((int)ur[u].z, (int)qh.z, d, false);
        d = __builtin_amdgcn_sdot4((int)ur[u].w, (int)qh.w, d, false);
        pt[u] = d;
    }
}
__device__ __forceinline__ float p3_weight(const int (&pt)[4], int lane, float sh, const P3Sc& sc) {
    int m2[2], m1;
    const bool c0 = lane & 1;
#pragma unroll
    for (int j = 0; j < 2; j++) { const int keep = c0 ? pt[j + 2] : pt[j], send = c0 ? pt[j] : pt[j + 2]; m2[j] = keep + __shfl_xor(send, 1, 64); }
    const bool c1 = lane & 2;
    { const int keep = c1 ? m2[1] : m2[0], send = c1 ? m2[0] : m2[1]; m1 = keep + __shfl_xor(send, 2, 64); }
    m1 += __shfl_xor(m1, 4, 64);
    m1 += __shfl_xor(m1, 8, 64);
    m1 += __shfl_xor(m1, 16, 64);
    m1 += __shfl_xor(m1, 32, 64);
    const float aval = (float)m1 * (sh * sc.su);
    return sc.gm * gelu_erf(aval) * sc.sv;
}
__device__ __forceinline__ void p3_axpy(const u32x4 (&vr)[4], float ws, float (&acc)[16], float& wsum) {
#pragma unroll
    for (int u = 0; u < 4; u++) {
        const int src_lane = ((u >> 1) & 1) | ((u & 1) << 1);
        const float wu = __shfl(ws, src_lane, 64);
        wsum += wu;
        const unsigned vw[4] = {vr[u].x, vr[u].y, vr[u].z, vr[u].w};
#pragma unroll
        for (int i = 0; i < 4; i++) {
            acc[i * 4 + 0] += wu * ub0(vw[i]); acc[i * 4 + 1] += wu * ub1(vw[i]);
            acc[i * 4 + 2] += wu * ub2(vw[i]); acc[i * 4 + 3] += wu * ub3(vw[i]);
        }
    }
}
__device__ __forceinline__ void p3_token(const Params& p, int tok, int lane, unsigned* rec, float& sh) {
    const bf16_t* H = (const bf16_t*)(p.ws + OFF_H);
    const int* eidx = (const int*)(p.ws + OFF_EIDX);
    const float* gwp = (const float*)(p.ws + OFF_GW);
    {
        const u32x4 a = *(const u32x4*)(H + (size_t)tok * DM + lane * 16), b = *(const u32x4*)(H + (size_t)tok * DM + lane * 16 + 8);
        const unsigned hw[8] = {a.x, a.y, a.z, a.w, b.x, b.y, b.z, b.w};
        float hv[16];
        float mx = 0.f;
#pragma unroll
        for (int i = 0; i < 8; i++) { hv[2 * i] = bf_lo(hw[i]); hv[2 * i + 1] = bf_hi(hw[i]); mx = fmaxf(mx, fmaxf(fabsf(hv[2 * i]), fabsf(hv[2 * i + 1]))); }
        mx = wave_max(mx);
        const float inv = mx > 0.f ? 127.f / mx : 0.f;
        sh = mx * (1.f / 127.f);
        unsigned qh[4];
#pragma unroll
        for (int i = 0; i < 4; i++) {
            unsigned pk = 0;
#pragma unroll
            for (int j = 0; j < 4; j++) pk |= ((unsigned)((int)rintf(hv[i * 4 + j] * inv)) & 0xffu) << (8 * j);
            qh[i] = pk;
        }
        *(u32x4*)(rec + 256 + lane * 4) = (u32x4){qh[0], qh[1], qh[2], qh[3]};
    }
    const int e0 = eidx[(size_t)tok * 128 + lane], e1 = eidx[(size_t)tok * 128 + 64 + lane];
    const float g0 = gwp[(size_t)tok * 128 + lane], g1 = gwp[(size_t)tok * 128 + 64 + lane];
    const int k0 = e0 >> 10, k1 = e1 >> 10;
    int pos0 = 0, pos1 = 0, base = 0;
#pragma unroll
    for (int v = 0; v < 16; v++) {
        const unsigned long long m0 = __ballot(k0 == v), m1 = __ballot(k1 == v);
        const int c0 = __popcll(m0);
        const int r0 = __builtin_amdgcn_mbcnt_hi((unsigned)(m0 >> 32), __builtin_amdgcn_mbcnt_lo((unsigned)m0, 0u));
        const int r1 = __builtin_amdgcn_mbcnt_hi((unsigned)(m1 >> 32), __builtin_amdgcn_mbcnt_lo((unsigned)m1, 0u));
        pos0 = (k0 == v) ? base + r0 : pos0;
        pos1 = (k1 == v) ? base + c0 + r1 : pos1;
        base += c0 + __popcll(m1);
    }
    rec[pos0] = (unsigned)e0; rec[pos1] = (unsigned)e1;
    rec[128 + pos0] = __float_as_uint(g0); rec[128 + pos1] = __float_as_uint(g1);
}
__device__ __forceinline__ void p3_finish(const Params& p, float* dstp, int tok, int lane, const float (&acc)[16], float wsum) {
    const float* mod = (const float*)(p.ws + OFF_MOD);
    const int b = tok >> 11;
    float x2[16];
    float ss = 0.f;
#pragma unroll
    for (int i = 0; i < 4; i++) {
        const int d = lane * 16 + i * 4;
        const f32x4 xv = *(const f32x4*)(p.out + (size_t)tok * DM + d);
        const f32x4 gt = *(const f32x4*)(mod + b * 6144 + 5 * 1024 + d);
#pragma unroll
        for (int j = 0; j < 4; j++) { const float v = xv[j] + gt[j] * (acc[i * 4 + j] - 128.f * wsum); x2[i * 4 + j] = v; ss += v * v; }
    }
    ss = wave_sum(ss);
    const float rstd = rsqrtf(ss * (1.f / 1024.f) + 1e-6f);
#pragma unroll
    for (int i = 0; i < 4; i++) {
        const int d = lane * 16 + i * 4;
        const f32x4 fg = *(const f32x4*)(p.final_g + d);
        f32x4 o;
#pragma unroll
        for (int j = 0; j < 4; j++) o[j] = x2[i * 4 + j] * rstd * fg[j];
        *(f32x4*)(dstp + (size_t)tok * DM + d) = o;
    }
}
__device__ void phaseP3(const Params& p, float* dstp, char* lds) {
    const int tid_ = TIDX; const int lane = tid_ & 63, wave = tid_ >> 6;
    const unsigned char* UQ = (const unsigned char*)(p.ws + OFF_UB);
    const unsigned char* VQ = UQ + 16777216;
    const float* tsc = (const float*)(p.ws + OFF_UB + 33554432);
    const int ul = ((lane & 1) << 1) | ((lane >> 1) & 1);
    constexpr int TPW = 2;
    unsigned* recs = (unsigned*)(lds + wave * TPW * P3_REC);
    for (int tb = (vblk() * 4 + wave) * TPW; tb < NTOK; tb += vgrid() * 4 * TPW) {
        float sh[TPW], acc[TPW][16], wsm[TPW];
        __builtin_amdgcn_wave_barrier();
#pragma unroll
        for (int k = 0; k < TPW; k++) {
            p3_token(p, tb + k, lane, recs + k * (P3_REC / 4), sh[k]);
#pragma unroll
            for (int i = 0; i < 16; i++) acc[k][i] = 0.f;
            wsm[k] = 0.f;
        }
        __builtin_amdgcn_wave_barrier();
        u32x4 ur[4], vr[4];
        P3Sc sc[TPW];
        p3_load_u(ur, sc[0], UQ, tsc, lane, ul, 0, recs);
        p3_load_v(vr, VQ, lane, 0, recs);
        for (int g = 0; g < 32; g++) {
#pragma unroll
            for (int k = 0; k < TPW; k++) {
                const int kn = (k + 1) % TPW;
                const int gn = (k + 1 == TPW) ? g + 1 : g;
                int pt[4];
                p3_dots(ur, recs + k * (P3_REC / 4), lane, pt);
                if (gn < 32) p3_load_u(ur, sc[kn], UQ, tsc, lane, ul, gn, recs + kn * (P3_REC / 4));
                const float w = p3_weight(pt, lane, sh[k], sc[k]);
                p3_axpy(vr, w, acc[k], wsm[k]);
                if (gn < 32) p3_load_v(vr, VQ, lane, gn, recs + kn * (P3_REC / 4));
            }
        }
#pragma unroll
        for (int k = 0; k < TPW; k++) p3_finish(p, dstp, tb + k, lane, acc[k], wsm[k]);
    }
}

#define XB_TMO      128
#define XB_XCNT(j)  (256  + 64 * (j))
#define XB_XSUB(j)  (1280 + 64 * (j))
#define XB_XGEN(j)  (2304 + 64 * (j))
#define XB_TOP      3328
#define XB_TOPGEN   3392
#define XCD_BAR_WORDS 3456
#define XB_SPIN_CAP (1u << 22)
#define LAS __attribute__((address_space(3)))
__device__ __forceinline__ unsigned xb_ld(unsigned* p)              { return __hip_atomic_load(p, __ATOMIC_RELAXED, __HIP_MEMORY_SCOPE_AGENT); }
__device__ __forceinline__ unsigned xb_add(unsigned* p, unsigned v) { return __hip_atomic_fetch_add(p, v, __ATOMIC_RELAXED, __HIP_MEMORY_SCOPE_AGENT); }
__device__ __forceinline__ unsigned xb_xcc_id() { return (unsigned)__builtin_amdgcn_s_getreg((3 << 11) | 20) & 0xFu; }
#define XB_SPIN(cond, bar) do { unsigned _sp = 0; while (cond) { __builtin_amdgcn_s_sleep(1); \
    if ((++_sp & 255u) == 0u) { if (xb_ld(&(bar)[XB_TMO])) break; if (_sp > XB_SPIN_CAP) { atomicAdd(&(bar)[XB_TMO], 1u); break; } } } } while (0)
struct XcdBarrier { unsigned* bar; unsigned x; volatile LAS unsigned* st; };
__device__ __forceinline__ XcdBarrier xcd_barrier_post(unsigned* bar, volatile LAS unsigned* st) {
    XcdBarrier b; b.bar = bar; b.x = xb_xcc_id(); b.st = st;
    if (threadIdx.x == 0) { st[2] = xb_add(&bar[XB_XCNT(b.x)], 1u); st[4] = b.x; }
    return b;
}
__device__ __forceinline__ void xcd_barrier_complete(unsigned* bar, unsigned x, unsigned& nloc, unsigned& nx, unsigned& bal) {
    const unsigned G = gridDim.x * gridDim.y * gridDim.z;
    unsigned sum, cnt, mine, c64, sp = 0u;
    for (;;) {
        sum = 0u; cnt = 0u; mine = 0u; c64 = 0u;
#pragma unroll
        for (unsigned j = 0; j < 16; ++j) { const unsigned c = xb_ld(&bar[XB_XCNT(j)]); sum += c; cnt += (c > 0u) ? 1u : 0u; c64 += (j < 8 && c == 64u) ? 1u : 0u; mine = (j == x) ? c : mine; }
        if (sum == G) break;
        __builtin_amdgcn_s_sleep(1);
        if ((++sp & 255u) == 0u) { if (xb_ld(&bar[XB_TMO])) break; if (sp > XB_SPIN_CAP) { atomicAdd(&bar[XB_TMO], 1u); break; } }
    }
    nloc = mine > 0u ? mine : 1u; nx = cnt > 0u ? cnt : 1u; bal = (sum == G && cnt == 8u && c64 == 8u) ? 1u : 0u;
}
__device__ __forceinline__ void xcd_barrier(const XcdBarrier& b) {
    asm volatile("s_waitcnt vmcnt(0)" ::: "memory");
    __syncthreads();
    if (threadIdx.x == 0) {
        unsigned* bar = b.bar;
        __builtin_amdgcn_s_waitcnt(0);
        unsigned nloc = b.st[0], nx = b.st[1];
        if (nloc == 0u) { unsigned bal; xcd_barrier_complete(bar, b.x, nloc, nx, bal); b.st[0] = nloc; b.st[1] = nx; b.st[3] = bal; }
        const unsigned old = xb_add(&bar[XB_XSUB(b.x)], 1u);
        const unsigned gen = old / nloc;
        if (old + 1u == (gen + 1u) * nloc) {
            __builtin_amdgcn_fence(__ATOMIC_RELEASE, "agent");
            asm volatile("s_waitcnt vmcnt(0)" ::: "memory");
            const unsigned og = xb_add(&bar[XB_TOP], 1u);
            const unsigned tg = og / nx;
            if (og + 1u == (tg + 1u) * nx) xb_add(&bar[XB_TOPGEN], 1u);
            else XB_SPIN(xb_ld(&bar[XB_TOPGEN]) == tg, bar);
            __builtin_amdgcn_fence(__ATOMIC_ACQUIRE, "agent");
            xb_add(&bar[XB_XGEN(b.x)], 1u);
            asm volatile("s_waitcnt vmcnt(0)" ::: "memory");
        } else {
            XB_SPIN(xb_ld(&bar[XB_XGEN(b.x)]) == gen, bar);
            __builtin_amdgcn_fence(__ATOMIC_ACQUIRE, "agent");
            asm volatile("s_waitcnt vmcnt(0)" ::: "memory");
        }
    }
    __syncthreads();
}

typedef __attribute__((address_space(4))) const Params* KParamsPtr;
__device__ __forceinline__ const Params& fresh_params() {
    KParamsPtr kp = (KParamsPtr)__builtin_amdgcn_kernarg_segment_ptr();
    asm volatile("" : "+s"(kp));
    return *(const Params*)kp;
}
#define PF fresh_params()
__global__ void __launch_bounds__(BLOCK_THREADS, 2) mega(Params p_unused) {
    __shared__ __attribute__((aligned(16))) char lds[LDS_BYTES];
    cg::grid_group grid = cg::this_grid();
    volatile LAS unsigned* st = (volatile LAS unsigned*)(lds + 2 * LDS_MAIN);
    if (threadIdx.x < 16) st[threadIdx.x] = 0u;
    __syncthreads();
    XcdBarrier xb = xcd_barrier_post((unsigned*)PF.ws, st);
    char* hl = lds + half_id() * LDS_MAIN;
    volatile unsigned* uex = (volatile unsigned*)(lds + 2 * LDS_MAIN + 32);

    phaseA(PF, hl);
    if (PF.ws == nullptr) grid.sync();
    xcd_barrier(xb);
    { const Params& q_ = PF; phase_modnorm(q_, q_.x, q_.norm1_g, 0, 1, (bf16_t*)(q_.ws + OFF_H)); };
    xcd_barrier(xb);
    phaseC(PF, lds);
    xcd_barrier(xb);
    for (int task = vblk(); task < 1024; task += vgrid()) phaseG1_task(PF, task, hl);
    for (int task = vblk(); task < 512; task += vgrid()) phaseN1_task(PF, task, hl);
    xcd_barrier(xb);
    phaseG2(PF);
    phaseA2(PF, hl);
    xcd_barrier(xb);
    for (int task = vblk(); task < 2048; task += vgrid()) phaseN2_task(PF, task, hl, (bf16_t*)(PF.ws + OFF_Z) + ZQ_N, ZC, uex, lds);
    for (int task = vblk(); task < 1024; task += vgrid()) phaseG3_task(PF, task, hl, (bf16_t*)(PF.ws + OFF_Z) + ZR_G, ZC);
    xcd_barrier(xb);
    phaseM1(PF, lds);
    xcd_barrier(xb);
    phaseM2(PF, lds);
    xcd_barrier(xb);
    { const Params& q_ = PF; phase_modnorm(q_, q_.out, q_.norm2_g, 3, 4, (bf16_t*)(q_.ws + OFF_H)); };
    xcd_barrier(xb);
    phaseP1(PF, lds);
    xcd_barrier(xb);
    for (int task = vblk(); task < 2048; task += vgrid()) phaseP2_task(PF, task, hl);
    xcd_barrier(xb);
    { const Params& q_ = PF; phaseP3(q_, q_.out, hl); };
}

extern "C" void kernel_launch(void* const* d_in, const int* in_sizes, int n_in, void* d_out, int out_size, void* d_ws, size_t ws_size, hipStream_t stream) {
    Params p{};
    p.x = (const float*)d_in[0]; p.c = (const float*)d_in[1]; p.pos = (const int*)d_in[2]; p.ada_w = (const float*)d_in[3]; p.ada_b = (const float*)d_in[4];
    p.norm1_g = (const float*)d_in[5]; p.norm2_g = (const float*)d_in[6]; p.final_g = (const float*)d_in[7]; p.w_in = (const float*)d_in[8];
    p.gla_wa2 = (const float*)d_in[9]; p.gla_ba2 = (const float*)d_in[10]; p.gla_norm_g = (const float*)d_in[11]; p.pe_k = (const float*)d_in[12]; p.pe_v = (const float*)d_in[13];
    p.ck_w1 = (const float*)d_in[14]; p.ck_w2 = (const float*)d_in[15]; p.cv_w1 = (const float*)d_in[16]; p.cv_w2 = (const float*)d_in[17];
    p.w_branch_a = (const float*)d_in[18]; p.w_branch_b = (const float*)d_in[19]; p.w_out = (const float*)d_in[20]; p.peer_wq = (const float*)d_in[21];
    p.peer_k1 = (const float*)d_in[22]; p.peer_k2 = (const float*)d_in[23]; p.peer_u = (const float*)d_in[24]; p.peer_v = (const float*)d_in[25];
    p.out = (float*)d_out; p.ws = (char*)d_ws;
    static int grid_blocks = 0;
    if (!grid_blocks) {
        int dev = 0, cus = 0, per_cu = 0;
        hipGetDevice(&dev);
        hipDeviceGetAttribute(&cus, hipDeviceAttributeMultiprocessorCount, dev);
        hipOccupancyMaxActiveBlocksPerMultiprocessor(&per_cu, mega, BLOCK_THREADS, 0);
        if (per_cu > 1) per_cu = 1;
        if (per_cu < 1) per_cu = 1;
        grid_blocks = cus * per_cu;
    }
    hipMemsetAsync(d_ws, 0, XCD_BAR_WORDS * 4, stream);
    void* args[] = {&p};
    hipError_t e = hipLaunchCooperativeKernel((void*)mega, dim3(grid_blocks), dim3(BLOCK_THREADS), args, 0, stream);
    if (e != hipSuccess) fprintf(stderr, "cooperative launch failed: %s (grid %d)\n", hipGetErrorString(e), grid_blocks);
}
```

```cpp
#include <hip/hip_runtime.h>
#include <hip/hip_cooperative_groups.h>
#include <stdio.h>
namespace cg = cooperative_groups;
#include <stdint.h>
#include <stddef.h>
#include <math.h>

typedef unsigned short bf16_t;
typedef short bf16x8 __attribute__((ext_vector_type(8)));
typedef float f32x4 __attribute__((ext_vector_type(4)));
typedef unsigned u32x4 __attribute__((ext_vector_type(4)));
typedef unsigned u32x2 __attribute__((ext_vector_type(2)));

constexpr int DM = 1024, NB = 8, SEQ = 2048, NTOK = NB * SEQ;
constexpr int ZC = 4992;
constexpr int ZQ_G = 0, ZK_G = 512, ZV_G = 1024, ZR_G = 2048, ZQ_N = 3072, ZKC = 4096, ZVC = 4224, ZKS = 4352, ZVS = 4480,
              ZKW = 4608, ZVW = 4736, ZGATE = 4864, ZLR = 4912;
constexpr int LDS_MAIN = 73728;
constexpr int LDS_BYTES = 2 * LDS_MAIN + 64;
constexpr int NTHREADS = 256;
constexpr int BLOCK_THREADS = 512;

constexpr size_t OFF_MOD = 16384;
constexpr size_t OFF_ROPE = 212992;
constexpr size_t OFF_CMP = 1261568;
constexpr size_t OFF_DEC = 1785856;
constexpr size_t OFF_K1B = 2310144;
constexpr size_t OFF_WC1 = 2834432;
constexpr size_t OFF_WIN = 4194304;
constexpr size_t OFF_WM = 14417920;
constexpr size_t OFF_WA = 18612224;
constexpr size_t OFF_WB = 20709376;
constexpr size_t OFF_WO = 22806528;
constexpr size_t OFF_WQ = 24903680;
constexpr size_t OFF_H = 29360128;
constexpr size_t OFF_M = 62914560;
constexpr size_t OFF_Z = 96468992;
constexpr size_t OFF_VT = OFF_Z + (size_t)NTOK * ZC * 2;
constexpr size_t OFF_QP = OFF_Z;
constexpr size_t OFF_UB = OFF_Z + 67108864;
constexpr size_t OFF_VB = OFF_UB + 33554432;
constexpr size_t OFF_EIDX = OFF_VB + 33554432;
constexpr size_t OFF_GW = OFF_EIDX + 8388608;

struct Params {
    const float* x; const float* c; const int* pos; const float* ada_w; const float* ada_b;
    const float* norm1_g; const float* norm2_g; const float* final_g; const float* w_in;
    const float* gla_wa2; const float* gla_ba2; const float* gla_norm_g; const float* pe_k; const float* pe_v;
    const float* ck_w1; const float* ck_w2; const float* cv_w1; const float* cv_w2;
    const float* w_branch_a; const float* w_branch_b; const float* w_out; const float* peer_wq;
    const float* peer_k1; const float* peer_k2; const float* peer_u; const float* peer_v;
    float* out; char* ws;
};

__device__ __forceinline__ unsigned f2bf_u(float f) { unsigned u = __float_as_uint(f); return (u + 0x7fffu + ((u >> 16) & 1u)) >> 16; }
__device__ __forceinline__ bf16_t f2bf(float f) { return (bf16_t)f2bf_u(f); }
typedef float f32x2_ __attribute__((ext_vector_type(2)));
typedef __bf16 bf16x2_ __attribute__((ext_vector_type(2)));
__device__ __forceinline__ unsigned pack2(float lo, float hi) {
    const f32x2_ v = {lo, hi};
    return __builtin_bit_cast(unsigned, __builtin_convertvector(v, bf16x2_));
}
__device__ __forceinline__ float bf_lo(unsigned u) { return __uint_as_float(u << 16); }
__device__ __forceinline__ float bf_hi(unsigned u) { return __uint_as_float(u & 0xffff0000u); }
__device__ __forceinline__ float bf2f(bf16_t h) { return __uint_as_float(((unsigned)h) << 16); }
__device__ __forceinline__ float wave_sum(float v) {
#pragma unroll
    for (int o = 32; o > 0; o >>= 1) v += __shfl_xor(v, o, 64);
    return v;
}
__device__ __forceinline__ float wave_max(float v) {
#pragma unroll
    for (int o = 32; o > 0; o >>= 1) v = fmaxf(v, __shfl_xor(v, o, 64));
    return v;
}
__device__ __forceinline__ int launder_i(int x) { asm volatile("" : "+v"(x)); return x; }
#define TIDX (launder_i((int)threadIdx.x) & 255)
#define TIDX512 launder_i((int)threadIdx.x)
__device__ __forceinline__ int half_id() { return __builtin_amdgcn_readfirstlane((int)(threadIdx.x >> 8)); }
__device__ __forceinline__ int vblk() { return (int)blockIdx.x * 2 + half_id(); }
__device__ __forceinline__ int vgrid() { return (int)gridDim.x * 2; }
__device__ __forceinline__ float exp2f_(float x) { return __builtin_amdgcn_exp2f(x); }
__device__ __forceinline__ float sigmoidf_(float x) { return __builtin_amdgcn_rcpf(1.f + __expf(-x)); }
__device__ __forceinline__ float siluf_(float x) { return x * __builtin_amdgcn_rcpf(1.f + __expf(-x)); }
__device__ __forceinline__ float gelu_erf(float v) {
    const float t = __builtin_amdgcn_rcpf(fabsf(v) * 0.2316418882f + 1.0f);
    float qp = t * 0.5307027145f + (-0.7265760135f);
    qp = qp * t + 0.7107068705f; qp = qp * t + (-0.142248368f); qp = qp * t + 0.127414796f; qp = qp * t;
    const float m = v * (qp * __builtin_amdgcn_exp2f(v * v * (-0.72134752044f)));
    return v < 0.f ? m : v - m;
}
__device__ __forceinline__ f32x4 mfma16(bf16x8 a, bf16x8 b, f32x4 c) { return __builtin_amdgcn_mfma_f32_16x16x32_bf16(a, b, c, 0, 0, 0); }
__device__ __forceinline__ bf16x8 ld_frag(const bf16_t* p) { return *(const bf16x8*)p; }
__device__ __forceinline__ bf16x8 mk_frag(u32x2 lo, u32x2 hi) { u32x4 t = {lo.x, lo.y, hi.x, hi.y}; return __builtin_bit_cast(bf16x8, t); }

#define WAIT_V(n) asm volatile("s_waitcnt vmcnt(" #n ")" ::: "memory")
__device__ __forceinline__ int swz4(int R) { return (4 - ((R >> 2) & 3)) & 3; }
__device__ __forceinline__ void glds16(const bf16_t* g, char* l) { __builtin_amdgcn_global_load_lds((const unsigned*)g, (unsigned*)l, 16, 0, 0); }
struct GemmSrc { const bf16_t* xsrc; const bf16_t* wsrc; int ldx, ldw; };
__device__ __forceinline__ GemmSrc gemm_src(const bf16_t* __restrict__ X, int ldx, const bf16_t* __restrict__ W, int ldw, int m0, int n0) {
    const int tid = TIDX512, lane = tid & 63, wave = tid >> 6;
    const int R0 = wave * 32 + (lane >> 2);
    const int sw = ((lane & 3) ^ swz4(R0)) * 8;
    GemmSrc g;
    g.xsrc = X + (size_t)(m0 + R0) * ldx + sw;
    g.wsrc = W + (size_t)(n0 + R0) * ldw + sw;
    g.ldx = ldx; g.ldw = ldw;
    return g;
}
__device__ __forceinline__ void gemm_issue(const GemmSrc& g, int kt, int s, char* lds) {
    const int tid = TIDX512, lane = tid & 63, wave = tid >> 6;
    char* xdst = lds + s * 32768 + wave * 2048 + lane * 16;
    char* wdst = xdst + 16384;
#pragma unroll
    for (int i = 0; i < 2; i++) {
        glds16(g.xsrc + (size_t)i * 16 * g.ldx + kt * 32, xdst + i * 1024);
        glds16(g.wsrc + (size_t)i * 16 * g.ldw + kt * 32, wdst + i * 1024);
    }
}
__device__ __forceinline__ void gemm_prologue(const GemmSrc& g, char* lds) { gemm_issue(g, 0, 0, lds); gemm_issue(g, 1, 1, lds); gemm_issue(g, 2, 2, lds); }
__device__ __forceinline__ void gemm_mainloop(f32x4 (&acc)[8][4], const GemmSrc& g, int K, char* lds) {
    const int tid = TIDX512, lane = tid & 63, wave = tid >> 6;
    const int wr = wave >> 2, wc = wave & 3, r = lane & 15, q = lane >> 4;
    const int KT = K / 32;
    const int rdo = r * 64 + ((q ^ swz4(r)) * 16);
    for (int kt = 0; kt < KT; kt++) {
        if (kt + 2 < KT) WAIT_V(8); else if (kt + 1 < KT) WAIT_V(4); else WAIT_V(0);
        __builtin_amdgcn_s_barrier();
        const char* st = lds + (kt & 3) * 32768;
        bf16x8 af[4], bfr[8];
#pragma unroll
        for (int ni = 0; ni < 4; ni++) af[ni] = *(const bf16x8*)(st + 16384 + (wc * 64 + ni * 16) * 64 + rdo);
#pragma unroll
        for (int mi = 0; mi < 8; mi++) bfr[mi] = *(const bf16x8*)(st + (wr * 128 + mi * 16) * 64 + rdo);
        if (kt + 3 < KT) gemm_issue(g, kt + 3, (kt + 3) & 3, lds);
#pragma unroll
        for (int mi = 0; mi < 8; mi++)
#pragma unroll
            for (int ni = 0; ni < 4; ni++) acc[mi][ni] = mfma16(af[ni], bfr[mi], acc[mi][ni]);
        __builtin_amdgcn_sched_barrier(0);
    }
}
__device__ __forceinline__ void gemm_core(f32x4 (&acc)[8][4], const bf16_t* __restrict__ X, int ldx, const bf16_t* __restrict__ W, int ldw,
                                          int K, int m0, int n0, char* lds) {
    const GemmSrc g = gemm_src(X, ldx, W, ldw, m0, n0);
    gemm_prologue(g, lds);
    gemm_mainloop(acc, g, K, lds);
    __syncthreads();
}
__device__ __forceinline__ void zero_acc(f32x4 (&acc)[8][4]) {
#pragma unroll
    for (int a = 0; a < 8; a++)
#pragma unroll
        for (int b = 0; b < 4; b++) acc[a][b] = (f32x4){0.f, 0.f, 0.f, 0.f};
}

constexpr int EPI_ROWB = 528;
__device__ __forceinline__ void epi_fill(char* lds, int wr, int wc, int r, int q, int mi, int ni, f32x4 v) {
    *(u32x2*)(lds + (wr * 128 + mi * 16 + r) * EPI_ROWB + (wc * 64 + ni * 16 + 4 * q) * 2) = (u32x2){pack2(v[0], v[1]), pack2(v[2], v[3])};
}
__device__ __forceinline__ void epi_store(const char* lds, bf16_t* __restrict__ O, int ldo, int m0, int n0, int ncols_valid) {
    const int t = TIDX512;
    const int chunk = t & 31, rsub = t >> 5;
    if (n0 + chunk * 8 < ncols_valid) {
#pragma unroll
        for (int ps = 0; ps < 16; ps++) {
            const int row = ps * 16 + rsub;
            const u32x4 v = *(const u32x4*)(lds + row * EPI_ROWB + chunk * 16);
            *(u32x4*)(O + (size_t)(m0 + row) * ldo + n0 + chunk * 8) = v;
        }
    }
}

struct TileIter {
    int nt, i, x, li; bool fancy;
    __device__ TileIter(int ntiles_n, const char*) { nt = ntiles_n; fancy = (gridDim.x == 256) && ((nt & 3) == 0); x = blockIdx.x & 7; li = blockIdx.x >> 3; i = fancy ? 0 : blockIdx.x; }
    __device__ bool next(int& bm, int& bn) {
        if (fancy) {
            if (i * 4 >= nt) return false;
            bm = x * 8 + (li & 7); bn = i * 4 + (li >> 3); i++; return true;
        }
        if (i >= 64 * nt) return false;
        bn = i % nt; bm = i / nt; i += gridDim.x; return true;
    }
};

struct MapId { __device__ int operator()(int n) const { return n; } };
struct MapWin {
    __device__ int operator()(int n) const { return n < 3072 ? n : (n < 4912 ? n + 16 : (n < 4928 ? n - 1840 : -1)); }
};
struct MapOff { int off; __device__ int operator()(int n) const { return n + off; } };

template <class Map>
__device__ __forceinline__ void tconv_tile(const float* __restrict__ src, int ldsrc, bf16_t* __restrict__ dst, int ldd, int n0, int k0, Map map, float* t) {
    const int tid = TIDX;
    const int n = tid & 63, kb = tid >> 6;
    const int sc = map(n0 + n);
#pragma unroll
    for (int i = 0; i < 16; i++) { const int k = i * 4 + kb; t[k * 65 + n] = sc >= 0 ? src[(size_t)(k0 + k) * ldsrc + sc] : 0.f; }
    __syncthreads();
    const int nn = tid >> 2, kk = (tid & 3) * 16;
    unsigned w[8];
#pragma unroll
    for (int j = 0; j < 8; j++) w[j] = pack2(t[(kk + 2 * j) * 65 + nn], t[(kk + 2 * j + 1) * 65 + nn]);
    u32x4* d = (u32x4*)(dst + (size_t)(n0 + nn) * ldd + k0 + kk);
    d[0] = (u32x4){w[0], w[1], w[2], w[3]};
    d[1] = (u32x4){w[4], w[5], w[6], w[7]};
    __syncthreads();
}

constexpr int TA_MOD = 192, TA_WIN = 78 * 16, TA_WM = 32 * 16, TA_SQ = 16 * 16, TA_WQ = 32 * 16, TA_WC = 32, TA_K12 = 64, TA_ROPE = 512;
constexpr int TA_E0 = TA_MOD, TA_E1 = TA_E0 + TA_WIN, TA_E2 = TA_E1 + TA_WM, TA_E3 = TA_E2 + TA_SQ, TA_E4 = TA_E3 + TA_SQ, TA_E5 = TA_E4 + TA_SQ,
              TA_E6 = TA_E5 + TA_WQ, TA_E7 = TA_E6 + TA_WC, TA_E8 = TA_E7 + TA_WC, TA_E9 = TA_E8 + TA_K12, TA_E10 = TA_E9 + TA_K12, TA_E11 = TA_E10 + TA_ROPE;

__device__ void phaseA(const Params& p, char* lds) {
    const int tid = TIDX;
    float* fl = (float*)lds;
    constexpr int N0 = TA_E1 + (TA_E8 - TA_E6) + (TA_E11 - TA_E10);
    for (int idx = vblk(); idx < N0; idx += vgrid()) {
        const int task = idx < TA_E1 ? idx : (idx < TA_E1 + (TA_E8 - TA_E6) ? idx - TA_E1 + TA_E6 : idx - TA_E1 - (TA_E8 - TA_E6) + TA_E10);
        if (task < TA_E0) {
            float* sc = fl;
            float* red = fl + 8192;
            {
                f32x4 cv[8];
#pragma unroll
                for (int i = 0; i < 8; i++) cv[i] = *(const f32x4*)(p.c + (i * 256 + tid) * 4);
#pragma unroll
                for (int i = 0; i < 8; i++) *(f32x4*)(sc + (i * 256 + tid) * 4) = (f32x4){siluf_(cv[i][0]), siluf_(cv[i][1]), siluf_(cv[i][2]), siluf_(cv[i][3])};
            }
            __syncthreads();
            const int n = task * 32 + (tid & 31), kg = tid >> 5;
            float a[8];
#pragma unroll
            for (int b = 0; b < 8; b++) a[b] = 0.f;
            for (int k0 = kg * 128; k0 < kg * 128 + 128; k0 += 16) {
                float w[16];
#pragma unroll
                for (int i = 0; i < 16; i++) w[i] = p.ada_w[(size_t)(k0 + i) * 6144 + n];
#pragma unroll
                for (int i = 0; i < 16; i++)
#pragma unroll
                    for (int b = 0; b < 8; b++) a[b] += sc[b * 1024 + k0 + i] * w[i];
            }
#pragma unroll
            for (int b = 0; b < 8; b++) red[(kg * 8 + b) * 32 + (tid & 31)] = a[b];
            __syncthreads();
            {
                const int b = tid >> 5, nn = tid & 31;
                float s = 0.f;
#pragma unroll
                for (int g = 0; g < 8; g++) s += red[(g * 8 + b) * 32 + nn];
                ((float*)(p.ws + OFF_MOD))[b * 6144 + task * 32 + nn] = s + p.ada_b[task * 32 + nn];
            }
            __syncthreads();
        } else if (task < TA_E1) {
            const int tt = task - TA_E0;
            tconv_tile(p.w_in, 6976, (bf16_t*)(p.ws + OFF_WIN), 1024, (tt >> 4) * 64, (tt & 15) * 64, MapWin(), fl);
        } else if (task < TA_E6) {
        } else if (task < TA_E7) {
            const int tt = task - TA_E6;
            tconv_tile(p.ck_w1, 64, (bf16_t*)(p.ws + OFF_WC1), 2048, 0, tt * 64, MapId(), fl);
        } else if (task < TA_E8) {
            const int tt = task - TA_E7;
            tconv_tile(p.cv_w1, 64, (bf16_t*)(p.ws + OFF_WC1) + 64 * 2048, 2048, 0, tt * 64, MapId(), fl);
        } else if (task < TA_E10) {
        } else {
            const int tt = task - TA_E10;
            const int e = tt * 256 + tid;
            const int tok = e >> 3, i = e & 7;
            const float invf[8] = {1.0f, 0.1939227432012558f, 0.03760603070259094f, 0.007292664609849453f,
                                   0.0014142135623842478f, 0.00027424818836152554f, 5.318296098266728e-05f, 1.0313386155758053e-05f};
            float fr = invf[0];
#pragma unroll
            for (int j = 1; j < 8; j++) fr = (i == j) ? invf[j] : fr;
            const float ang = (float)p.pos[tok] * fr;
            const double rev = (double)ang * 0.15915494309189533577;
            const float fpart = (float)(rev - floor(rev));
            float* cs = (float*)(p.ws + OFF_ROPE);
            cs[e * 2] = __builtin_amdgcn_cosf(fpart);
            cs[e * 2 + 1] = __builtin_amdgcn_sinf(fpart);
        }
    }
}

__device__ void phaseA2(const Params& p, char* lds) {
    const int tid = TIDX;
    float* fl = (float*)lds;
    constexpr int N1 = (TA_E6 - TA_E1) + (TA_E10 - TA_E8);
    for (int idx = vblk(); idx < N1; idx += vgrid()) {
        const int task = idx < (TA_E6 - TA_E1) ? idx + TA_E1 : idx - (TA_E6 - TA_E1) + TA_E8;
        if (task < TA_E1) {
        } else if (task < TA_E2) {
            const int tt = task - TA_E1;
            tconv_tile(p.w_in, 6976, (bf16_t*)(p.ws + OFF_WM), 1024, (tt >> 4) * 64, (tt & 15) * 64, MapOff{4928}, fl);
        } else if (task < TA_E3) {
            const int tt = task - TA_E2;
            tconv_tile(p.w_branch_a, 1024, (bf16_t*)(p.ws + OFF_WA), 1024, (tt >> 4) * 64, (tt & 15) * 64, MapId(), fl);
        } else if (task < TA_E4) {
            const int tt = task - TA_E3;
            tconv_tile(p.w_branch_b, 1024, (bf16_t*)(p.ws + OFF_WB), 1024, (tt >> 4) * 64, (tt & 15) * 64, MapId(), fl);
        } else if (task < TA_E5) {
            const int tt = task - TA_E4;
            tconv_tile(p.w_out, 1024, (bf16_t*)(p.ws + OFF_WO), 1024, (tt >> 4) * 64, (tt & 15) * 64, MapId(), fl);
        } else if (task < TA_E6) {
            const int tt = task - TA_E5;
            tconv_tile(p.peer_wq, 2048, (bf16_t*)(p.ws + OFF_WQ), 1024, (tt >> 4) * 64, (tt & 15) * 64, MapId(), fl);
        } else if (task < TA_E10) {
            const bool second = task >= TA_E9;
            const int tt = task - (second ? TA_E9 : TA_E8);
            const float* src = second ? p.peer_k2 : p.peer_k1;
            bf16_t* dst = (bf16_t*)(p.ws + OFF_K1B) + (second ? 131072 : 0);
            const int i = tt * 2048 + tid * 8;
            const f32x4 a = *(const f32x4*)(src + i), b = *(const f32x4*)(src + i + 4);
            *(u32x4*)(dst + i) = (u32x4){pack2(a[0], a[1]), pack2(a[2], a[3]), pack2(b[0], b[1]), pack2(b[2], b[3])};
        }
    }
}

__device__ void phase_modnorm(const Params& p, const float* __restrict__ src, const float* __restrict__ g, int shift_idx, int scale_idx, bf16_t* __restrict__ dst) {
    const int tid_ = TIDX; const int lane = tid_ & 63, wave = tid_ >> 6;
    const float* mod = (const float*)(p.ws + OFF_MOD);
    for (int tok = vblk() * 4 + wave; tok < NTOK; tok += vgrid() * 4) {
        const int b = tok >> 11;
        const float* xr = src + (size_t)tok * DM;
        f32x4 v[4];
        float ss = 0.f;
#pragma unroll
        for (int c = 0; c < 4; c++) { v[c] = *(const f32x4*)(xr + c * 256 + lane * 4); ss += v[c][0] * v[c][0] + v[c][1] * v[c][1] + v[c][2] * v[c][2] + v[c][3] * v[c][3]; }
        ss = wave_sum(ss);
        const float rstd = rsqrtf(ss * (1.f / 1024.f) + 1e-6f);
#pragma unroll
        for (int c = 0; c < 4; c++) {
            const int d = c * 256 + lane * 4;
            const f32x4 gg = *(const f32x4*)(g + d);
            const f32x4 sc = *(const f32x4*)(mod + b * 6144 + scale_idx * 1024 + d);
            const f32x4 sh = *(const f32x4*)(mod + b * 6144 + shift_idx * 1024 + d);
            float o[4];
#pragma unroll
            for (int j = 0; j < 4; j++) o[j] = (v[c][j] * rstd) * gg[j] * (1.f + sc[j]) + sh[j];
            *(u32x2*)(dst + (size_t)tok * DM + d) = (u32x2){pack2(o[0], o[1]), pack2(o[2], o[3])};
        }
    }
}

__device__ void phaseC(const Params& p, char* lds) {
    const int tid_ = TIDX512; const int lane = tid_ & 63, wave = tid_ >> 6;
    const int wr = wave >> 2, wc = wave & 3, r = lane & 15, q = lane >> 4;
    const bf16_t* H = (const bf16_t*)(p.ws + OFF_H);
    const bf16_t* W = (const bf16_t*)(p.ws + OFF_WIN);
    bf16_t* Z = (bf16_t*)(p.ws + OFF_Z);
    const float* cs = (const float*)(p.ws + OFF_ROPE);
    constexpr int NTN = (ZC + 255) / 256;
    TileIter tit(NTN, lds);
    int bm, bn;
    while (tit.next(bm, bn)) {
        const int m0 = bm * 256, n0 = bn * 256;
        f32x4 acc[8][4];
        zero_acc(acc);
        gemm_core(acc, H, DM, W, DM, DM, m0, n0, lds);
        const int c0 = n0 + wc * 64;
        const bool isq = (c0 >= ZQ_N && c0 < ZKC);
        const bool rope = isq || (c0 >= ZKC && c0 < ZGATE && ((c0 - ZKC) & 255) < 128);
        const float scl = isq ? 0.18033688011112042f : 1.f;
#pragma unroll
        for (int mi = 0; mi < 8; mi++) {
            const int tok = m0 + wr * 128 + mi * 16 + r;
            if (rope) {
                f32x4 v = acc[mi][0];
                f32x4 pr;
#pragma unroll
                for (int j = 0; j < 4; j++) pr[j] = __shfl_xor(v[j], 32, 64);
                const int ib = (q & 1) * 4;
                const f32x4 k0 = *(const f32x4*)(cs + (size_t)tok * 16 + ib * 2);
                const f32x4 k1 = *(const f32x4*)(cs + (size_t)tok * 16 + ib * 2 + 4);
                const float cc[4] = {k0[0], k0[2], k1[0], k1[2]}, sn[4] = {k0[1], k0[3], k1[1], k1[3]};
#pragma unroll
                for (int j = 0; j < 4; j++) v[j] = (q < 2) ? (v[j] * cc[j] - pr[j] * sn[j]) : (v[j] * cc[j] + pr[j] * sn[j]);
                acc[mi][0] = v;
            }
#pragma unroll
            for (int ni = 0; ni < 4; ni++) epi_fill(lds, wr, wc, r, q, mi, ni, acc[mi][ni] * scl);
        }
        if ((c0 >= ZVS && c0 < ZVS + 128) || (c0 >= ZVW && c0 < ZVW + 128)) {
            const int brn = c0 >= ZVW ? 1 : 0, gg = ((c0 - (brn ? ZVW : ZVS)) >> 6) & 1;
            const int bb = m0 >> 11, ts = (m0 & 2047) + wr * 128 + r;
            bf16_t* vt = (bf16_t*)(p.ws + OFF_VT) + ((size_t)((brn * 8 + bb) * 2 + gg) * 64) * SEQ + ts;
#pragma unroll
            for (int mi = 0; mi < 8; mi++)
#pragma unroll
                for (int ni = 0; ni < 4; ni++)
#pragma unroll
                    for (int j = 0; j < 4; j++) vt[(size_t)(ni * 16 + 4 * q + j) * SEQ + mi * 16] = f2bf(acc[mi][ni][j]);
        }
        __syncthreads();
        epi_store(lds, Z, ZC, m0, n0, ZC);
        __syncthreads();
    }
}

__device__ __forceinline__ void gla_prep(const Params& p, int tok0, int h, char* lds) {
    const int tid = TIDX;
    float* bc = (float*)lds;
    float* lrs = (float*)(lds + 32768);
    const bf16_t* Z = (const bf16_t*)(p.ws + OFF_Z);
    for (int i = tid; i < 1024; i += NTHREADS) { const int t = i >> 4, rr = i & 15; lrs[i] = bf2f(Z[(size_t)(tok0 + t) * ZC + ZLR + rr]); }
    const int d = tid & 127, th = tid >> 7;
    float w[16];
#pragma unroll
    for (int rr = 0; rr < 16; rr++) w[rr] = p.gla_wa2[rr * 512 + h * 128 + d];
    const float bias = p.gla_ba2[h * 128 + d];
    __syncthreads();
    float run = 0.f;
    for (int t = th * 32; t < th * 32 + 32; t++) {
        float xv = bias;
#pragma unroll
        for (int rr = 0; rr < 16; rr++) xv += lrs[t * 16 + rr] * w[rr];
        const float ls = fminf(xv, 0.f) - __logf(1.f + __expf(-fabsf(xv)));
        run += ls * (1.f / 16.f);
        bc[t * 128 + d] = run;
    }
    __syncthreads();
    if (th == 1) {
        const float add = bc[31 * 128 + d];
        for (int t = 32; t < 64; t++) bc[t * 128 + d] += add;
    }
    __syncthreads();
}

__device__ void phaseG1_task(const Params& p, int task, char* lds) {
    const int tid = TIDX, lane = tid & 63, wave = tid >> 6, r = lane & 15, q = lane >> 4;
    const int c = task & 31, h = (task >> 5) & 3, b = task >> 7;
    const int tok0 = b * SEQ + c * 64;
    const bf16_t* Z = (const bf16_t*)(p.ws + OFF_Z);
    bf16_t* L = (bf16_t*)p.out;
    float* bc = (float*)lds;
    bf16_t* klT = (bf16_t*)(lds + 36864);
    bf16_t* vT = (bf16_t*)(lds + 36864 + 18432);
    gla_prep(p, tok0, h, lds);
    if (tid < 128) ((float*)(p.ws + OFF_DEC))[task * 128 + tid] = __expf(bc[63 * 128 + tid]);
    {
        f32x4* bg = (f32x4*)(p.ws + OFF_M) + (size_t)task * 2048;
#pragma unroll
        for (int i = 0; i < 8; i++) bg[i * 256 + tid] = ((const f32x4*)bc)[i * 256 + tid];
    }
    {
        const int s = lane, dc = wave * 32;
        const bf16_t* kp = Z + (size_t)(tok0 + s) * ZC + ZK_G + h * 128 + dc;
#pragma unroll
        for (int v4 = 0; v4 < 4; v4++) {
            const u32x4 kv = *(const u32x4*)(kp + v4 * 8);
            const unsigned kw[4] = {kv.x, kv.y, kv.z, kv.w};
#pragma unroll
            for (int j = 0; j < 8; j++) {
                const int d = dc + v4 * 8 + j;
                const float kval = (j & 1) ? bf_hi(kw[j >> 1]) : bf_lo(kw[j >> 1]);
                klT[d * 72 + s] = f2bf(kval * __expf(bc[63 * 128 + d] - bc[s * 128 + d]));
            }
        }
    }
    for (int eh = 0; eh < 2; eh++) {
        __syncthreads();
        {
            const int s = lane, ec = wave * 32;
            const bf16_t* vp = Z + (size_t)(tok0 + s) * ZC + ZV_G + h * 256 + eh * 128 + ec;
#pragma unroll
            for (int v4 = 0; v4 < 4; v4++) {
                const u32x4 vv = *(const u32x4*)(vp + v4 * 8);
                const unsigned vw[4] = {vv.x, vv.y, vv.z, vv.w};
#pragma unroll
                for (int j = 0; j < 8; j++) vT[(ec + v4 * 8 + j) * 72 + s] = (bf16_t)((j & 1) ? (vw[j >> 1] >> 16) : (vw[j >> 1] & 0xffffu));
            }
        }
        __syncthreads();
        f32x4 acc[8][2];
#pragma unroll
        for (int dt = 0; dt < 8; dt++) { acc[dt][0] = (f32x4){0.f, 0.f, 0.f, 0.f}; acc[dt][1] = (f32x4){0.f, 0.f, 0.f, 0.f}; }
#pragma unroll
        for (int ks = 0; ks < 2; ks++) {
            bf16x8 bv[2];
#pragma unroll
            for (int x = 0; x < 2; x++) bv[x] = ld_frag(vT + ((2 * wave + x) * 16 + r) * 72 + ks * 32 + q * 8);
#pragma unroll
            for (int dt = 0; dt < 8; dt++) {
                const bf16x8 a = ld_frag(klT + (dt * 16 + r) * 72 + ks * 32 + q * 8);
#pragma unroll
                for (int x = 0; x < 2; x++) acc[dt][x] = mfma16(a, bv[x], acc[dt][x]);
            }
        }
#pragma unroll
        for (int dt = 0; dt < 8; dt++)
#pragma unroll
            for (int x = 0; x < 2; x++) {
                const int e = eh * 128 + (2 * wave + x) * 16 + r, d = dt * 16 + 4 * q;
                const f32x4 v = acc[dt][x];
                *(u32x2*)(L + ((size_t)task * 256 + e) * 128 + d) = (u32x2){pack2(v[0], v[1]), pack2(v[2], v[3])};
            }
    }
    __syncthreads();
}

__device__ void phaseG2(const Params& p) {
    bf16_t* L = (bf16_t*)p.out;
    const float* dec = (const float*)(p.ws + OFF_DEC);
    for (int idx = vblk() * NTHREADS + (int)(threadIdx.x & 255); idx < 32 * 256 * 16; idx += vgrid() * NTHREADS) {
        const int d8 = idx & 15, e = (idx >> 4) & 255, bh = idx >> 12;
        float st[8];
#pragma unroll
        for (int j = 0; j < 8; j++) st[j] = 0.f;
        for (int c = 0; c < 32; c++) {
            const int task = bh * 32 + c;
            u32x4* ptr = (u32x4*)(L + ((size_t)task * 256 + e) * 128 + d8 * 8);
            const u32x4 lv = *ptr;
            const f32x4 d0 = *(const f32x4*)(dec + task * 128 + d8 * 8), d1 = *(const f32x4*)(dec + task * 128 + d8 * 8 + 4);
            *ptr = (u32x4){pack2(st[0], st[1]), pack2(st[2], st[3]), pack2(st[4], st[5]), pack2(st[6], st[7])};
            st[0] = d0[0] * st[0] + bf_lo(lv.x); st[1] = d0[1] * st[1] + bf_hi(lv.x);
            st[2] = d0[2] * st[2] + bf_lo(lv.y); st[3] = d0[3] * st[3] + bf_hi(lv.y);
            st[4] = d1[0] * st[4] + bf_lo(lv.z); st[5] = d1[1] * st[5] + bf_hi(lv.z);
            st[6] = d1[2] * st[6] + bf_lo(lv.w); st[7] = d1[3] * st[7] + bf_hi(lv.w);
        }
    }
}

__device__ void phaseG3_task(const Params& p, int task, char* lds, bf16_t* ydst, int ystride) {
    const int tid = TIDX, lane = tid & 63, wave = tid >> 6, r = lane & 15, q = lane >> 4;
    const int c = task & 31, h = (task >> 5) & 3, b = task >> 7;
    const int tok0 = b * SEQ + c * 64;
    bf16_t* Z = (bf16_t*)(p.ws + OFF_Z);
    const bf16_t* ST = (const bf16_t*)p.out + (size_t)task * 256 * 128;
    float* bc = (float*)lds;
    bf16_t* vT = (bf16_t*)lds;
    bf16_t* qg = (bf16_t*)(lds + 36864);
    bf16_t* kg = (bf16_t*)(lds + 36864 + 17408);
    bf16_t* P = kg;
    float* red = (float*)(lds + 36864 + 2 * 17408);
    {
        const f32x4* bg = (const f32x4*)(p.ws + OFF_M) + (size_t)task * 2048;
#pragma unroll
        for (int i = 0; i < 8; i++) ((f32x4*)bc)[i * 256 + tid] = bg[i * 256 + tid];
    }
    __syncthreads();
    {
        const int t = tid >> 2, dc = (tid & 3) * 32;
        const bf16_t* qp = Z + (size_t)(tok0 + t) * ZC + ZQ_G + h * 128 + dc;
        const bf16_t* kp = Z + (size_t)(tok0 + t) * ZC + ZK_G + h * 128 + dc;
#pragma unroll
        for (int v4 = 0; v4 < 4; v4++) {
            const u32x4 qv = *(const u32x4*)(qp + v4 * 8), kv = *(const u32x4*)(kp + v4 * 8);
            const unsigned qw[4] = {qv.x, qv.y, qv.z, qv.w}, kw[4] = {kv.x, kv.y, kv.z, kv.w};
            unsigned qo[4], ko[4];
#pragma unroll
            for (int j2 = 0; j2 < 4; j2++) {
                const int d = dc + v4 * 8 + j2 * 2;
                const float b0 = bc[t * 128 + d], b1 = bc[t * 128 + d + 1];
                qo[j2] = pack2(bf_lo(qw[j2]) * 0.08838834764831845f * __expf(b0), bf_hi(qw[j2]) * 0.08838834764831845f * __expf(b1));
                ko[j2] = pack2(bf_lo(kw[j2]) * __expf(-b0), bf_hi(kw[j2]) * __expf(-b1));
            }
            *(u32x4*)(qg + t * 136 + dc + v4 * 8) = (u32x4){qo[0], qo[1], qo[2], qo[3]};
            *(u32x4*)(kg + t * 136 + dc + v4 * 8) = (u32x4){ko[0], ko[1], ko[2], ko[3]};
        }
    }
    __syncthreads();
    {
        const int s = lane, ec = wave * 64;
        const bf16_t* vp = Z + (size_t)(tok0 + s) * ZC + ZV_G + h * 256 + ec;
#pragma unroll
        for (int v4 = 0; v4 < 8; v4++) {
            const u32x4 vv = *(const u32x4*)(vp + v4 * 8);
            const unsigned vw[4] = {vv.x, vv.y, vv.z, vv.w};
#pragma unroll
            for (int j = 0; j < 8; j++) vT[(ec + v4 * 8 + j) * 72 + s] = (bf16_t)((j & 1) ? (vw[j >> 1] >> 16) : (vw[j >> 1] & 0xffffu));
        }
    }
    f32x4 sc[4];
#pragma unroll
    for (int st = 0; st < 4; st++) sc[st] = (f32x4){0.f, 0.f, 0.f, 0.f};
    {
        bf16x8 qf[4];
#pragma unroll
        for (int ks = 0; ks < 4; ks++) qf[ks] = ld_frag(qg + (wave * 16 + r) * 136 + ks * 32 + q * 8);
#pragma unroll
        for (int st = 0; st < 4; st++) {
            if (st <= wave) {
#pragma unroll
                for (int ks = 0; ks < 4; ks++) sc[st] = mfma16(ld_frag(kg + (st * 16 + r) * 136 + ks * 32 + q * 8), qf[ks], sc[st]);
            }
        }
    }
    __syncthreads();
    {
        const int t = wave * 16 + r;
#pragma unroll
        for (int st = 0; st < 4; st++) {
            float pv[4];
#pragma unroll
            for (int j = 0; j < 4; j++) { const int s = st * 16 + 4 * q + j; pv[j] = (s <= t) ? sc[st][j] : 0.f; }
            *(u32x2*)(P + t * 72 + st * 16 + 4 * q) = (u32x2){pack2(pv[0], pv[1]), pack2(pv[2], pv[3])};
        }
    }
    __syncthreads();
    f32x4 o[4][4];
#pragma unroll
    for (int et = 0; et < 4; et++)
#pragma unroll
        for (int tt = 0; tt < 4; tt++) o[et][tt] = (f32x4){0.f, 0.f, 0.f, 0.f};
#pragma unroll
    for (int ks = 0; ks < 2; ks++) {
        bf16x8 pf[4];
#pragma unroll
        for (int tt = 0; tt < 4; tt++) pf[tt] = ld_frag(P + (tt * 16 + r) * 72 + ks * 32 + q * 8);
#pragma unroll
        for (int et = 0; et < 4; et++) {
            const bf16x8 a = ld_frag(vT + ((wave * 4 + et) * 16 + r) * 72 + ks * 32 + q * 8);
#pragma unroll
            for (int tt = 0; tt < 4; tt++) o[et][tt] = mfma16(a, pf[tt], o[et][tt]);
        }
    }
#pragma unroll
    for (int ks = 0; ks < 4; ks++) {
        bf16x8 qf[4];
#pragma unroll
        for (int tt = 0; tt < 4; tt++) qf[tt] = ld_frag(qg + (tt * 16 + r) * 136 + ks * 32 + q * 8);
#pragma unroll
        for (int et = 0; et < 4; et++) {
            const bf16x8 a = *(const bf16x8*)(ST + (size_t)((wave * 4 + et) * 16 + r) * 128 + ks * 32 + q * 8);
#pragma unroll
            for (int tt = 0; tt < 4; tt++) o[et][tt] = mfma16(a, qf[tt], o[et][tt]);
        }
    }
#pragma unroll
    for (int tt = 0; tt < 4; tt++) {
        float ss = 0.f;
#pragma unroll
        for (int et = 0; et < 4; et++)
#pragma unroll
            for (int j = 0; j < 4; j++) ss += o[et][tt][j] * o[et][tt][j];
        ss += __shfl_xor(ss, 16, 64);
        ss += __shfl_xor(ss, 32, 64);
        if (q == 0) red[wave * 64 + tt * 16 + r] = ss;
    }
    __syncthreads();
#pragma unroll
    for (int tt = 0; tt < 4; tt++) {
        const int t = tt * 16 + r;
        const float tot = red[t] + red[64 + t] + red[128 + t] + red[192 + t];
        const float rstd = rsqrtf(tot * (1.f / 256.f) + 1e-6f);
#pragma unroll
        for (int et = 0; et < 4; et++) {
            const int e = (wave * 4 + et) * 16 + 4 * q;
            bf16_t* rp = Z + (size_t)(tok0 + t) * ZC + ZR_G + h * 256 + e;
            const u32x2 rv = *(const u32x2*)rp;
            const f32x4 gn = *(const f32x4*)(p.gla_norm_g + e);
            const float r0 = bf_lo(rv.x), r1 = bf_hi(rv.x), r2 = bf_lo(rv.y), r3 = bf_hi(rv.y);
            const f32x4 ov = o[et][tt];
            *(u32x2*)(ydst + (size_t)(tok0 + t) * ystride + h * 256 + e) = (u32x2){pack2(ov[0] * rstd * gn[0] * siluf_(r0), ov[1] * rstd * gn[1] * siluf_(r1)),
                                  pack2(ov[2] * rstd * gn[2] * siluf_(r2), ov[3] * rstd * gn[3] * siluf_(r3))};
        }
    }
    __syncthreads();
}

__device__ void phaseN1_task(const Params& p, int task, char* lds) {
    const int tid = TIDX, lane = tid & 63, wave = tid >> 6, r = lane & 15, q = lane >> 4;
    const int it = task & 15, g = (task >> 4) & 1, b = (task >> 5) & 7, kv = task >> 8;
    const bf16_t* Z = (const bf16_t*)(p.ws + OFF_Z);
    const bf16_t* W1 = (const bf16_t*)(p.ws + OFF_WC1) + (size_t)kv * 64 * 2048;
    const float* pe = kv ? p.pe_v : p.pe_k;
    const float* w2 = kv ? p.cv_w2 : p.ck_w2;
    const int zoff = (kv ? ZVC : ZKC) + g * 64;
    float* hid = (float*)lds;
    float* hid2 = (float*)(lds + 16384);
    int i = it * 8 + (r & 7); if (i > 126) i = 126;
    f32x4 acc[4];
#pragma unroll
    for (int nt = 0; nt < 4; nt++) acc[nt] = (f32x4){0.f, 0.f, 0.f, 0.f};
    for (int ks = 0; ks < 16; ks++) {
        const int k = wave * 512 + ks * 32 + q * 8;
        const int l = k >> 6, d = k & 63;
        const u32x4 zv = *(const u32x4*)(Z + (size_t)(b * SEQ + i * 16 + l) * ZC + zoff + d);
        const f32x4 p0 = *(const f32x4*)(pe + l * 64 + d), p1 = *(const f32x4*)(pe + l * 64 + d + 4);
        const u32x4 av = {pack2(bf_lo(zv.x) + p0[0], bf_hi(zv.x) + p0[1]), pack2(bf_lo(zv.y) + p0[2], bf_hi(zv.y) + p0[3]),
                          pack2(bf_lo(zv.z) + p1[0], bf_hi(zv.z) + p1[1]), pack2(bf_lo(zv.w) + p1[2], bf_hi(zv.w) + p1[3])};
        const bf16x8 a = __builtin_bit_cast(bf16x8, av);
#pragma unroll
        for (int nt = 0; nt < 4; nt++) {
            const bf16x8 bw = *(const bf16x8*)(W1 + (size_t)(nt * 16 + r) * 2048 + k);
            acc[nt] = mfma16(a, bw, acc[nt]);
        }
    }
#pragma unroll
    for (int nt = 0; nt < 4; nt++)
#pragma unroll
        for (int j = 0; j < 4; j++) hid[(wave * 16 + 4 * q + j) * 64 + nt * 16 + r] = acc[nt][j];
    __syncthreads();
    for (int e = tid; e < 1024; e += NTHREADS) hid2[e] = gelu_erf(hid[e] + hid[1024 + e] + hid[2048 + e] + hid[3072 + e]);
    __syncthreads();
    {
        const int il = tid >> 4, n2 = (tid & 15) * 4;
        f32x4 o = {0.f, 0.f, 0.f, 0.f};
        for (int n = 0; n < 64; n++) {
            const float hv = hid2[il * 64 + n];
            const f32x4 wv = *(const f32x4*)(w2 + n * 64 + n2);
            o += hv * wv;
        }
        const int ig = it * 8 + il;
        if (ig >= 127) o = (f32x4){0.f, 0.f, 0.f, 0.f};
        bf16_t* dst = (bf16_t*)(p.ws + OFF_CMP) + ((size_t)((kv * 8 + b) * 2 + g) * 128 + ig) * 64 + n2;
        if (il < 8) *(u32x2*)dst = (u32x2){pack2(o[0], o[1]), pack2(o[2], o[3])};
    }
    __syncthreads();
}

__device__ __forceinline__ void nsa_block_step(const bf16_t* Ks, const bf16_t* VT, const bf16x8 (&qf)[2][2], f32x4 (&O)[2][4], float (&m)[2], float (&l)[2],
                                               int klo, int khi, int r, int q) {
    f32x4 s[2][4];
#pragma unroll
    for (int x = 0; x < 2; x++)
#pragma unroll
        for (int kt = 0; kt < 4; kt++) s[x][kt] = (f32x4){0.f, 0.f, 0.f, 0.f};
#pragma unroll
    for (int kt = 0; kt < 4; kt++)
#pragma unroll
        for (int ks = 0; ks < 2; ks++) {
            const bf16x8 kf = ld_frag(Ks + (kt * 16 + r) * 64 + (((ks * 4 + q) ^ (r & 7)) * 8));
#pragma unroll
            for (int x = 0; x < 2; x++) s[x][kt] = mfma16(kf, qf[x][ks], s[x][kt]);
        }
    if (!__all((klo <= 0) && (khi >= 63))) {
        const int a = 4 * q - klo;
        const unsigned range = (unsigned)(khi - klo);
        const bool any = khi >= klo;
#pragma unroll
        for (int kt = 0; kt < 4; kt++)
#pragma unroll
            for (int j = 0; j < 4; j++) {
                const bool valid = any && ((unsigned)(kt * 16 + j + a) <= range);
#pragma unroll
                for (int x = 0; x < 2; x++) s[x][kt][j] = valid ? s[x][kt][j] : -3.0e38f;
            }
    }
    bf16x8 pbv[2][2];
#pragma unroll
    for (int x = 0; x < 2; x++) {
        float mx = fmaxf(fmaxf(fmaxf(s[x][0][0], s[x][0][1]), fmaxf(s[x][0][2], s[x][0][3])), fmaxf(fmaxf(s[x][1][0], s[x][1][1]), fmaxf(s[x][1][2], s[x][1][3])));
        mx = fmaxf(mx, fmaxf(fmaxf(fmaxf(s[x][2][0], s[x][2][1]), fmaxf(s[x][2][2], s[x][2][3])), fmaxf(fmaxf(s[x][3][0], s[x][3][1]), fmaxf(s[x][3][2], s[x][3][3]))));
        mx = fmaxf(mx, __shfl_xor(mx, 16, 64));
        mx = fmaxf(mx, __shfl_xor(mx, 32, 64));
        const float mnew = fmaxf(m[x], mx);
        const float alpha = exp2f_(m[x] - mnew);
        m[x] = mnew;
        float ls = 0.f;
#pragma unroll
        for (int kt = 0; kt < 4; kt++)
#pragma unroll
            for (int j = 0; j < 4; j++) { const float pv = exp2f_(s[x][kt][j] - mnew); s[x][kt][j] = pv; ls += pv; }
        l[x] = l[x] * alpha + ls;
#pragma unroll
        for (int dt = 0; dt < 4; dt++) O[x][dt] *= alpha;
#pragma unroll
        for (int s2 = 0; s2 < 2; s2++) {
            const u32x4 t4 = {pack2(s[x][2 * s2][0], s[x][2 * s2][1]), pack2(s[x][2 * s2][2], s[x][2 * s2][3]),
                              pack2(s[x][2 * s2 + 1][0], s[x][2 * s2 + 1][1]), pack2(s[x][2 * s2 + 1][2], s[x][2 * s2 + 1][3])};
            pbv[x][s2] = __builtin_bit_cast(bf16x8, t4);
        }
    }
#pragma unroll
    for (int s2 = 0; s2 < 2; s2++)
#pragma unroll
        for (int dt = 0; dt < 4; dt++) {
            const u32x2 lo = *(const u32x2*)(VT + (dt * 16 + r) * 72 + (2 * s2) * 16 + 4 * q);
            const u32x2 hi = *(const u32x2*)(VT + (dt * 16 + r) * 72 + (2 * s2 + 1) * 16 + 4 * q);
            const bf16x8 va = mk_frag(lo, hi);
#pragma unroll
            for (int x = 0; x < 2; x++) O[x][dt] = mfma16(va, pbv[x][s2], O[x][dt]);
        }
}

__device__ __forceinline__ void nsa_cmp_probs(const bf16_t* Kc, const bf16x8 (&qfx)[2], int nv, int r, int q, f32x4 (&s)[8]) {
#pragma unroll
    for (int kt = 0; kt < 8; kt++) s[kt] = (f32x4){0.f, 0.f, 0.f, 0.f};
#pragma unroll
    for (int kt = 0; kt < 8; kt++)
#pragma unroll
        for (int ks = 0; ks < 2; ks++) s[kt] = mfma16(ld_frag(Kc + (kt * 16 + r) * 72 + ks * 32 + q * 8), qfx[ks], s[kt]);
    float mx = -1e30f;
#pragma unroll
    for (int kt = 0; kt < 8; kt++)
#pragma unroll
        for (int j = 0; j < 4; j++) if (kt * 16 + 4 * q + j < nv) mx = fmaxf(mx, s[kt][j]);
    mx = fmaxf(mx, __shfl_xor(mx, 16, 64));
    mx = fmaxf(mx, __shfl_xor(mx, 32, 64));
    float ls = 0.f;
#pragma unroll
    for (int kt = 0; kt < 8; kt++)
#pragma unroll
        for (int j = 0; j < 4; j++) {
            const float pv = (kt * 16 + 4 * q + j < nv) ? exp2f_(s[kt][j] - mx) : 0.f;
            s[kt][j] = pv; ls += pv;
        }
    ls += __shfl_xor(ls, 16, 64);
    ls += __shfl_xor(ls, 32, 64);
    const float inv = nv > 0 ? 1.f / ls : 0.f;
#pragma unroll
    for (int kt = 0; kt < 8; kt++) s[kt] *= inv;
}

__device__ void phaseN2_task(const Params& p, int task, char* lds, bf16_t* ydst, int ystride, volatile unsigned* uex, char* ldsb) {
    const int tid = TIDX, lane = tid & 63, wave = tid >> 6, r = lane & 15, q = lane >> 4;
    const int t512 = tid + half_id() * 256;
    const int pair = task >> 1, g = pair & 1, b = (pair >> 1) & 7;
    const int tt = (63 - (pair >> 4)) * 2 + (task & 1);
    const int t0 = tt * 16, t = t0 + r;
    const int cur = t0 >> 6;
    bf16_t* Z = (bf16_t*)(p.ws + OFF_Z);
    const size_t rowb = (size_t)b * SEQ;
    bf16_t* Kc = (bf16_t*)ldsb;
    bf16_t* VcT = (bf16_t*)(ldsb + 18432);
    bf16_t* Ks = (bf16_t*)ldsb;
    bf16_t* VT = (bf16_t*)(ldsb + 18432);
    float* impw = (float*)(lds + 35840);
    float* scs = (float*)(lds + 35840 + 32768);
    unsigned* selm = (unsigned*)(lds + 35840 + 32768 + 2048);

    bf16x8 qf[2][2];
#pragma unroll
    for (int x = 0; x < 2; x++)
#pragma unroll
        for (int ks = 0; ks < 2; ks++) qf[x][ks] = *(const bf16x8*)(Z + (rowb + t) * ZC + ZQ_N + (g * 8 + 2 * wave + x) * 64 + ks * 32 + q * 8);
    f32x4* ofl = (f32x4*)(lds + 35840);

    f32x4 Og[2][4];
    {
        const bf16_t* kc = (const bf16_t*)(p.ws + OFF_CMP) + (size_t)((0 * 8 + b) * 2 + g) * 128 * 64;
        const bf16_t* vc = (const bf16_t*)(p.ws + OFF_CMP) + (size_t)((1 * 8 + b) * 2 + g) * 128 * 64;
        {
            const int key = t512 >> 2, ch = (t512 & 3) * 16;
#pragma unroll
            for (int v4 = 0; v4 < 2; v4++) *(u32x4*)(Kc + key * 72 + ch + v4 * 8) = *(const u32x4*)(kc + key * 64 + ch + v4 * 8);
            const int k2 = t512 & 127, dc = (t512 >> 7) * 16;
#pragma unroll
            for (int v4 = 0; v4 < 2; v4++) {
                const u32x4 a = *(const u32x4*)(vc + k2 * 64 + dc + v4 * 8);
                const unsigned w[4] = {a.x, a.y, a.z, a.w};
#pragma unroll
                for (int j = 0; j < 8; j++) VcT[(dc + v4 * 8 + j) * 136 + k2] = (bf16_t)((j & 1) ? (w[j >> 1] >> 16) : (w[j >> 1] & 0xffffu));
            }
        }
        __syncthreads();
        int nv = t >= 31 ? ((t - 31) >> 4) + 1 : 0;
        if (nv > 127) nv = 127;
        f32x4 isum[8];
#pragma unroll
        for (int kt = 0; kt < 8; kt++) isum[kt] = (f32x4){0.f, 0.f, 0.f, 0.f};
#pragma unroll
        for (int x = 0; x < 2; x++) {
            f32x4 s[8];
            nsa_cmp_probs(Kc, qf[x], nv, r, q, s);
#pragma unroll
            for (int kt = 0; kt < 8; kt++) isum[kt] += s[kt];
            f32x4 Oc[4];
#pragma unroll
            for (int dt = 0; dt < 4; dt++) Oc[dt] = (f32x4){0.f, 0.f, 0.f, 0.f};
            __builtin_amdgcn_sched_barrier(0);
#pragma unroll
            for (int s2 = 0; s2 < 4; s2++) {
                const u32x4 t4 = {pack2(s[2 * s2][0], s[2 * s2][1]), pack2(s[2 * s2][2], s[2 * s2][3]),
                                  pack2(s[2 * s2 + 1][0], s[2 * s2 + 1][1]), pack2(s[2 * s2 + 1][2], s[2 * s2 + 1][3])};
                const bf16x8 pbv = __builtin_bit_cast(bf16x8, t4);
#pragma unroll
                for (int dt = 0; dt < 4; dt++) {
                    const u32x2 lo = *(const u32x2*)(VcT + (dt * 16 + r) * 136 + (2 * s2) * 16 + 4 * q);
                    const u32x2 hi = *(const u32x2*)(VcT + (dt * 16 + r) * 136 + (2 * s2 + 1) * 16 + 4 * q);
                    Oc[dt] = mfma16(mk_frag(lo, hi), pbv, Oc[dt]);
                }
            }
            const float g0 = sigmoidf_(bf2f(Z[(rowb + t) * ZC + ZGATE + 0 * 16 + g * 8 + 2 * wave + x]));
#pragma unroll
            for (int dt = 0; dt < 4; dt++) Og[x][dt] = g0 * Oc[dt];
            __builtin_amdgcn_sched_barrier(0);
        }
#pragma unroll
        for (int kt = 0; kt < 8; kt++) *(f32x4*)(impw + (wave * 16 + r) * 128 + kt * 16 + 4 * q) = isum[kt];
        __syncthreads();
#pragma unroll
        for (int pass = 0; pass < 2; pass++) {
            const int tk = pass * 8 + (tid >> 5), j = tid & 31;
            const int i0 = j == 0 ? 0 : 4 * j - 1, i1 = (4 * j + 3 > 126) ? 126 : 4 * j + 3;
            float sc = 0.f;
            for (int i = i0; i <= i1; i++) sc += (impw[(0 * 16 + tk) * 128 + i] + impw[(1 * 16 + tk) * 128 + i]) + (impw[(2 * 16 + tk) * 128 + i] + impw[(3 * 16 + tk) * 128 + i]);
            const bool forced = (j == 0) || (j == cur) || (j == cur - 1);
            scs[tk * 32 + j] = forced ? 1e6f : (j <= cur ? sc : -1.f);
        }
        __syncthreads();
#pragma unroll
        for (int pass = 0; pass < 2; pass++) {
            const int tk = pass * 8 + (tid >> 5), j = tid & 31;
            const float mine = scs[tk * 32 + j];
            int rank = 0;
            for (int j2 = 0; j2 < 32; j2++) { const float o = scs[tk * 32 + j2]; rank += (o > mine || (o == mine && j2 < j)) ? 1 : 0; }
            const unsigned long long bal = __ballot(rank < 16);
            if ((lane & 31) == 0) selm[tk] = (unsigned)(lane ? (bal >> 32) : (bal & 0xffffffffull));
        }
        __syncthreads();
    }
#pragma unroll
    for (int x = 0; x < 2; x++)
#pragma unroll
        for (int dt = 0; dt < 4; dt++) ofl[(wave * 8 + x * 4 + dt) * 64 + lane] = Og[x][dt];
    const unsigned mysel = selm[r];
    unsigned uni = 0;
#pragma unroll
    for (int i = 0; i < 16; i++) uni |= selm[i];
    if (tid == 0) uex[half_id()] = uni;
    __syncthreads();
    uni = uex[0] | uex[1];
    uni &= (cur == 31) ? 0xffffffffu : ((2u << cur) - 1u);
    uni |= 1u;

    {
        const int lo = (t0 & ~31) - 511;
        const int jb0 = lo > 0 ? (lo >> 6) : 0;
        const int kkey = t512 >> 3, kch = (t512 & 7) * 8;
        const int vd = t512 >> 3, vch = (t512 & 7) * 8;
        const bf16_t* vtb = (const bf16_t*)(p.ws + OFF_VT) + ((size_t)(b * 2 + g) * 64 + vd) * SEQ + vch;
        u32x4 kreg, vreg;
        int br = 0, j = 0;
        {
            const bf16_t* kb = Z + (rowb + 0) * ZC + ZKS + g * 64;
            kreg = *(const u32x4*)(kb + (size_t)kkey * ZC + kch);
            vreg = *(const u32x4*)(vtb);
        }
        f32x4 O[2][4];
        float m[2] = {-1e30f, -1e30f}, l[2] = {0.f, 0.f};
#pragma unroll
        for (int x = 0; x < 2; x++)
#pragma unroll
            for (int dt = 0; dt < 4; dt++) O[x][dt] = (f32x4){0.f, 0.f, 0.f, 0.f};
        for (;;) {
            __syncthreads();
            *(u32x4*)(Ks + kkey * 64 + (((kch >> 3) ^ (kkey & 7)) * 8)) = kreg;
            *(u32x4*)(VT + vd * 72 + vch) = vreg;
            __syncthreads();
            int nbr, nj;
            if (br == 0) {
                const unsigned rem = (j >= 31) ? 0u : (uni & ~((2u << j) - 1u));
                if (rem) { nbr = 0; nj = __ffs((int)rem) - 1; } else { nbr = 1; nj = jb0; }
            } else {
                if (j < cur) { nbr = 1; nj = j + 1; } else { nbr = 2; nj = 0; }
            }
            if (nbr < 2) {
                const bf16_t* kb = Z + (rowb + nj * 64) * ZC + (nbr ? ZKW : ZKS) + g * 64;
                kreg = *(const u32x4*)(kb + (size_t)kkey * ZC + kch);
                vreg = *(const u32x4*)(vtb + (size_t)nbr * (8 * 2 * 64) * SEQ + nj * 64);
            }
            int klo = 0, khi = -1;
            if (br == 0) { if ((mysel >> j) & 1u) khi = t - j * 64; }
            else { khi = t - j * 64; klo = t - 511 - j * 64; }
            klo = klo < 0 ? 0 : klo;
            khi = khi > 63 ? 63 : khi;
            nsa_block_step(Ks, VT, qf, O, m, l, klo, khi, r, q);
            if (nbr != br) {
#pragma unroll
                for (int x = 0; x < 2; x++) {
                    float lt = l[x];
                    lt += __shfl_xor(lt, 16, 64);
                    lt += __shfl_xor(lt, 32, 64);
                    const float sc = sigmoidf_(bf2f(Z[(rowb + t) * ZC + ZGATE + (br + 1) * 16 + g * 8 + 2 * wave + x])) / lt;
#pragma unroll
                    for (int dt = 0; dt < 4; dt++) { ofl[(wave * 8 + x * 4 + dt) * 64 + lane] += sc * O[x][dt]; O[x][dt] = (f32x4){0.f, 0.f, 0.f, 0.f}; }
                    m[x] = -1e30f; l[x] = 0.f;
                }
            }
            if (nbr == 2) break;
            br = nbr; j = nj;
        }
#pragma unroll
        for (int x = 0; x < 2; x++)
#pragma unroll
            for (int dt = 0; dt < 4; dt++) {
                const f32x4 v = ofl[(wave * 8 + x * 4 + dt) * 64 + lane];
                *(u32x2*)(ydst + (rowb + t) * ystride + (g * 8 + 2 * wave + x) * 64 + dt * 16 + 4 * q) = (u32x2){pack2(v[0], v[1]), pack2(v[2], v[3])};
            }
    }
    __syncthreads();
}

__device__ void phaseM1(const Params& p, char* lds) {
    const int tid_ = TIDX512; const int lane = tid_ & 63, wave = tid_ >> 6;
    const int wr = wave >> 2, wc = wave & 3, r = lane & 15, q = lane >> 4;
    const bf16_t* H = (const bf16_t*)(p.ws + OFF_H);
    const bf16_t* Z = (const bf16_t*)(p.ws + OFF_Z);
    bf16_t* M = (bf16_t*)(p.ws + OFF_M);
    u32x4* SG = (u32x4*)p.out;
    u32x4* PA = (u32x4*)((char*)p.out + 33554432);
    TileIter tit(4, lds);
    int bm, bn;
    while (tit.next(bm, bn)) {
        const int m0 = bm * 256, n0 = bn * 256;
        const int pbase = launder_i(((bm * 4 + bn) * 16) * 512 + tid_);
        for (int br = 0; br < 2; br++) {
            f32x4 acc[8][4];
            zero_acc(acc);
            gemm_core(acc, H, DM, (const bf16_t*)(p.ws + OFF_WM) + (size_t)br * 1024 * 1024, DM, DM, m0, n0, lds);
            {
#pragma unroll
                for (int mi = 0; mi < 8; mi++)
#pragma unroll
                    for (int nh = 0; nh < 2; nh++) {
                        const f32x4 a0 = acc[mi][2 * nh], a1 = acc[mi][2 * nh + 1];
                        SG[(size_t)pbase + (mi * 2 + nh) * 512] = (u32x4){pack2(sigmoidf_(a0[0]), sigmoidf_(a0[1])), pack2(sigmoidf_(a0[2]), sigmoidf_(a0[3])),
                                                                          pack2(sigmoidf_(a1[0]), sigmoidf_(a1[1])), pack2(sigmoidf_(a1[2]), sigmoidf_(a1[3]))};
                    }
            }
            zero_acc(acc);
            gemm_core(acc, Z + (br ? ZQ_N : ZR_G), ZC, (const bf16_t*)(p.ws + (br ? OFF_WB : OFF_WA)), DM, DM, m0, n0, lds);
            if (br == 0) {
#pragma unroll
                for (int mi = 0; mi < 8; mi++)
#pragma unroll
                    for (int nh = 0; nh < 2; nh++) {
                        const u32x4 sg = SG[(size_t)pbase + (mi * 2 + nh) * 512];
                        const f32x4 a0 = acc[mi][2 * nh], a1 = acc[mi][2 * nh + 1];
                        PA[(size_t)pbase + (mi * 2 + nh) * 512] = (u32x4){pack2(bf_lo(sg.x) * a0[0], bf_hi(sg.x) * a0[1]), pack2(bf_lo(sg.y) * a0[2], bf_hi(sg.y) * a0[3]),
                                                                          pack2(bf_lo(sg.z) * a1[0], bf_hi(sg.z) * a1[1]), pack2(bf_lo(sg.w) * a1[2], bf_hi(sg.w) * a1[3])};
                    }
            } else {
#pragma unroll
                for (int mi = 0; mi < 8; mi++)
#pragma unroll
                    for (int nh = 0; nh < 2; nh++) {
                        const u32x4 sg = SG[(size_t)pbase + (mi * 2 + nh) * 512];
                        const u32x4 pv = PA[(size_t)pbase + (mi * 2 + nh) * 512];
                        const f32x4 a0 = acc[mi][2 * nh], a1 = acc[mi][2 * nh + 1];
                        epi_fill(lds, wr, wc, r, q, mi, 2 * nh, (f32x4){bf_lo(sg.x) * a0[0] + bf_lo(pv.x), bf_hi(sg.x) * a0[1] + bf_hi(pv.x),
                                                                         bf_lo(sg.y) * a0[2] + bf_lo(pv.y), bf_hi(sg.y) * a0[3] + bf_hi(pv.y)});
                        epi_fill(lds, wr, wc, r, q, mi, 2 * nh + 1, (f32x4){bf_lo(sg.z) * a1[0] + bf_lo(pv.z), bf_hi(sg.z) * a1[1] + bf_hi(pv.z),
                                                                             bf_lo(sg.w) * a1[2] + bf_lo(pv.w), bf_hi(sg.w) * a1[3] + bf_hi(pv.w)});
                    }
                __syncthreads();
                epi_store(lds, M, DM, m0, n0, DM);
                __syncthreads();
            }
        }
    }
}

__device__ void phaseM2(const Params& p, char* lds) {
    const int tid_ = TIDX512; const int lane = tid_ & 63, wave = tid_ >> 6;
    const int wr = wave >> 2, wc = wave & 3, r = lane & 15, q = lane >> 4;
    const bf16_t* M = (const bf16_t*)(p.ws + OFF_M);
    const float* mod = (const float*)(p.ws + OFF_MOD);
    TileIter tit(4, lds);
    int bm, bn;
    while (tit.next(bm, bn)) {
        const int m0 = bm * 256, n0 = bn * 256;
        f32x4 acc[8][4];
        zero_acc(acc);
        gemm_core(acc, M, DM, (const bf16_t*)(p.ws + OFF_WO), DM, DM, m0, n0, lds);
#pragma unroll
        for (int mi = 0; mi < 8; mi++)
#pragma unroll
            for (int ni = 0; ni < 4; ni++) {
                const int tok = m0 + wr * 128 + mi * 16 + r, col = n0 + wc * 64 + ni * 16 + 4 * q;
                const f32x4 xv = *(const f32x4*)(p.x + (size_t)tok * DM + col);
                const f32x4 gt = *(const f32x4*)(mod + (tok >> 11) * 6144 + 2 * 1024 + col);
                *(f32x4*)(p.out + (size_t)tok * DM + col) = xv + gt * acc[mi][ni];
            }
    }
    {
        const int tid_ = TIDX; const int lane = tid_ & 63, wave = tid_ >> 6;
        unsigned char* tq = (unsigned char*)(p.ws + OFF_UB);
        float* tsc = (float*)(p.ws + OFF_UB + 33554432);
        for (int row = vblk() * 4 + wave; row < 32768; row += vgrid() * 4) {
            const bool isv = row >= 16384;
            const float* srcp = (isv ? p.peer_v : p.peer_u) + (size_t)(row & 16383) * DM + lane * 16;
            f32x4 a[4];
            float mx = 0.f;
#pragma unroll
            for (int i = 0; i < 4; i++) {
                a[i] = *(const f32x4*)(srcp + i * 4);
                mx = fmaxf(mx, fmaxf(fmaxf(fabsf(a[i][0]), fabsf(a[i][1])), fmaxf(fabsf(a[i][2]), fabsf(a[i][3]))));
            }
            mx = wave_max(mx);
            const float inv = mx > 0.f ? 127.f / mx : 0.f;
            const int off = isv ? 128 : 0;
            unsigned w[4];
#pragma unroll
            for (int i = 0; i < 4; i++) {
                unsigned pk = 0;
#pragma unroll
                for (int j = 0; j < 4; j++) {
                    int qi = (int)rintf(a[i][j] * inv);
                    qi = qi > 127 ? 127 : (qi < -127 ? -127 : qi);
                    pk |= ((unsigned)(qi + off) & 0xffu) << (8 * j);
                }
                w[i] = pk;
            }
            *(u32x4*)(tq + (size_t)row * DM + lane * 16) = (u32x4){w[0], w[1], w[2], w[3]};
            if (lane == 0) tsc[row] = mx * (1.f / 127.f);
        }
    }
}

__device__ void phaseP1(const Params& p, char* lds) {
    const int tid_ = TIDX512; const int lane = tid_ & 63, wave = tid_ >> 6;
    const int wr = wave >> 2, wc = wave & 3, r = lane & 15, q = lane >> 4;
    const bf16_t* H = (const bf16_t*)(p.ws + OFF_H);
    bf16_t* QP = (bf16_t*)(p.ws + OFF_QP);
    TileIter tit(8, lds);
    int bm, bn;
    while (tit.next(bm, bn)) {
        const int m0 = bm * 256, n0 = bn * 256;
        f32x4 acc[8][4];
        zero_acc(acc);
        gemm_core(acc, H, DM, (const bf16_t*)(p.ws + OFF_WQ), DM, DM, m0, n0, lds);
#pragma unroll
        for (int mi = 0; mi < 8; mi++)
#pragma unroll
            for (int ni = 0; ni < 4; ni++) epi_fill(lds, wr, wc, r, q, mi, ni, acc[mi][ni]);
        __syncthreads();
        epi_store(lds, QP, 2048, m0, n0, 2048);
        __syncthreads();
    }
}

__constant__ unsigned char c_cand_a[64] = {0,0,0,0,0,0,0,0,0,0,0,0,0,0,0,0, 1,1,1,1,1,1,1,1, 2,2,2,2,2, 3,3,3,3, 4,4,4, 5,5, 6,6, 7,7, 8,9,10,11,12,13,14,15, 0,0,0,0,0,0,0,0,0,0,0,0,0,0};
__constant__ unsigned char c_cand_b[64] = {0,1,2,3,4,5,6,7,8,9,10,11,12,13,14,15, 0,1,2,3,4,5,6,7, 0,1,2,3,4, 0,1,2,3, 0,1,2, 0,1, 0,1, 0,1, 0,0,0,0,0,0,0,0, 0,0,0,0,0,0,0,0,0,0,0,0,0,0};

__device__ __forceinline__ unsigned f2key(float f) { const unsigned u = __float_as_uint(f); return (u & 0x80000000u) ? ~u : (u | 0x80000000u); }
__device__ __forceinline__ float key2f(unsigned k) { const unsigned u = (k & 0x80000000u) ? (k & 0x7fffffffu) : ~k; return __uint_as_float(u); }
__device__ __forceinline__ void cex_desc(unsigned& a, unsigned& b) { const unsigned hi = a > b ? a : b, lo = a > b ? b : a; a = hi; b = lo; }
__device__ __forceinline__ void sort16_desc(unsigned (&a)[16]) {
#pragma unroll
    for (int k = 2; k <= 16; k <<= 1)
#pragma unroll
        for (int j = k >> 1; j > 0; j >>= 1)
#pragma unroll
            for (int i = 0; i < 16; i++) {
                const int l = i ^ j;
                if (l > i) { if ((i & k) == 0) cex_desc(a[i], a[l]); else cex_desc(a[l], a[i]); }
            }
}
__device__ __forceinline__ void merge16_desc(unsigned (&a)[16], const unsigned (&b)[16]) {
#pragma unroll
    for (int i = 0; i < 16; i++) a[i] = a[i] > b[15 - i] ? a[i] : b[15 - i];
#pragma unroll
    for (int j = 8; j > 0; j >>= 1)
#pragma unroll
        for (int i = 0; i < 16; i++) { const int l = i ^ j; if (l > i) cex_desc(a[i], a[l]); }
}

__device__ void phaseP2_task(const Params& p, int task, char* lds) {
    const int tid = TIDX, lane = tid & 63, wave = tid >> 6, r = lane & 15, q = lane >> 4;
    const int h = task & 7, tile = task >> 3;
    const int tok0 = tile * 64;
    const bf16_t* QP = (const bf16_t*)(p.ws + OFF_QP);
    float* S = (float*)lds;
    unsigned* LL = (unsigned*)(lds + 65536);
    {
        const bf16_t* qrow = QP + (size_t)(tok0 + wave * 16 + r) * 2048 + h * 256 + q * 8;
        bf16x8 bq[2][4];
#pragma unroll
        for (int half = 0; half < 2; half++)
#pragma unroll
            for (int ks = 0; ks < 4; ks++) bq[half][ks] = *(const bf16x8*)(qrow + half * 128 + ks * 32);
#pragma unroll
        for (int half = 0; half < 2; half++) {
            const bf16_t* KB = (const bf16_t*)(p.ws + OFF_K1B) + (size_t)half * 131072 + (size_t)h * 128 * 128 + (size_t)r * 128 + q * 8;
            f32x4 acc[8];
#pragma unroll
            for (int nt = 0; nt < 8; nt++) acc[nt] = (f32x4){0.f, 0.f, 0.f, 0.f};
            bf16x8 ak[8];
#pragma unroll
            for (int nt = 0; nt < 8; nt++) ak[nt] = *(const bf16x8*)(KB + (size_t)nt * 16 * 128);
#pragma unroll
            for (int ks = 0; ks < 4; ks++) {
                bf16x8 an[8];
                if (ks + 1 < 4) {
#pragma unroll
                    for (int nt = 0; nt < 8; nt++) an[nt] = *(const bf16x8*)(KB + (size_t)nt * 16 * 128 + (ks + 1) * 32);
                }
#pragma unroll
                for (int nt = 0; nt < 8; nt++) acc[nt] = mfma16(ak[nt], bq[half][ks], acc[nt]);
                if (ks + 1 < 4) {
#pragma unroll
                    for (int nt = 0; nt < 8; nt++) ak[nt] = an[nt];
                }
            }
#pragma unroll
            for (int nt = 0; nt < 8; nt++)
#pragma unroll
                for (int j = 0; j < 4; j++) S[(half * 128 + nt * 16 + 4 * q + j) * 64 + wave * 16 + r] = acc[nt][j];
        }
    }
    __syncthreads();
    {
        const int row = tid & 127, part = tid >> 7, half = row >> 6, tk = row & 63;
        unsigned L[16];
        const float* sp = S + (half * 128 + part * 64) * 64 + tk;
#pragma unroll
        for (int k = 0; k < 16; k++) L[k] = (f2key(sp[k * 64]) & ~127u) | (unsigned)(127 - (part * 64 + k));
        sort16_desc(L);
        for (int gq = 1; gq < 4; gq++) {
            unsigned G[16];
#pragma unroll
            for (int k = 0; k < 16; k++) G[k] = (f2key(sp[(gq * 16 + k) * 64]) & ~127u) | (unsigned)(127 - (part * 64 + gq * 16 + k));
            sort16_desc(G);
            merge16_desc(L, G);
        }
        __syncthreads();
        unsigned* LP = (unsigned*)lds;
#pragma unroll
        for (int k = 0; k < 16; k++) LP[((part * 2 + half) * 16 + k) * 64 + tk] = L[k];
        __syncthreads();
        if (tid < 128) {
            unsigned A[16], Bq[16];
#pragma unroll
            for (int k = 0; k < 16; k++) { A[k] = LP[((0 * 2 + half) * 16 + k) * 64 + tk]; Bq[k] = LP[((1 * 2 + half) * 16 + k) * 64 + tk]; }
            merge16_desc(A, Bq);
#pragma unroll
            for (int k = 0; k < 16; k++) LL[(half * 16 + k) * 64 + tk] = A[k];
        }
    }
    __syncthreads();
    if (tid < 64) {
        const int tk = tid;
        float v1[16], v2[16];
#pragma unroll
        for (int k = 0; k < 16; k++) { v1[k] = key2f(LL[k * 64 + tk] & ~127u); v2[k] = key2f(LL[(16 + k) * 64 + tk] & ~127u); }
        unsigned C[64];
#pragma unroll
        for (int k = 0; k < 64; k++) C[k] = 0u;
        {
            int c = 0;
#pragma unroll
            for (int a = 0; a < 16; a++)
#pragma unroll
                for (int b = 0; b < 16; b++)
                    if ((a + 1) * (b + 1) <= 16) { C[c] = (f2key(v1[a] + v2[b]) & ~63u) | (unsigned)(63 - c); c++; }
        }
        unsigned T[16];
#pragma unroll
        for (int k = 0; k < 16; k++) T[k] = C[k];
        sort16_desc(T);
#pragma unroll
        for (int gq = 1; gq < 4; gq++) {
            unsigned G[16];
#pragma unroll
            for (int k = 0; k < 16; k++) G[k] = C[gq * 16 + k];
            sort16_desc(G);
            merge16_desc(T, G);
        }
        const float mx = key2f(T[0] & ~63u);
        float e[16], sum = 0.f;
#pragma unroll
        for (int k = 0; k < 16; k++) { e[k] = __expf(key2f(T[k] & ~63u) - mx); sum += e[k]; }
        const float inv = 1.f / sum;
        int ei[16];
#pragma unroll
        for (int k = 0; k < 16; k++) {
            const int cc = 63 - (int)(T[k] & 63u);
            const int a = c_cand_a[cc], b = c_cand_b[cc];
            const int i1 = 127 - (int)(LL[a * 64 + tk] & 127u), i2 = 127 - (int)(LL[(16 + b) * 64 + tk] & 127u);
            ei[k] = i1 * 128 + i2;
            e[k] *= inv;
        }
        int* eidx = (int*)(p.ws + OFF_EIDX) + (size_t)(tok0 + tk) * 128 + h * 16;
        float* gw = (float*)(p.ws + OFF_GW) + (size_t)(tok0 + tk) * 128 + h * 16;
#pragma unroll
        for (int k4 = 0; k4 < 4; k4++) {
            *(u32x4*)(eidx + k4 * 4) = (u32x4){(unsigned)ei[k4 * 4], (unsigned)ei[k4 * 4 + 1], (unsigned)ei[k4 * 4 + 2], (unsigned)ei[k4 * 4 + 3]};
            *(f32x4*)(gw + k4 * 4) = (f32x4){e[k4 * 4], e[k4 * 4 + 1], e[k4 * 4 + 2], e[k4 * 4 + 3]};
        }
    }
    __syncthreads();
}

__device__ __forceinline__ float ub0(unsigned w) { return (float)(w & 0xffu); }
__device__ __forceinline__ float ub1(unsigned w) { return (float)((w >> 8) & 0xffu); }
__device__ __forceinline__ float ub2(unsigned w) { return (float)((w >> 16) & 0xffu); }
__device__ __forceinline__ float ub3(unsigned w) { return (float)(w >> 24); }
struct P3Sc { float su, sv, gm; };
constexpr int P3_REC = 2048;
__device__ __forceinline__ void p3_load_u(u32x4 (&ur)[4], P3Sc& sc, const unsigned char* __restrict__ UQ, const float* __restrict__ tsc,
                                          int lane, int ul, int g, const unsigned* rec) {
#pragma unroll
    for (int u = 0; u < 4; u++) ur[u] = *(const u32x4*)(UQ + (size_t)rec[4 * g + u] * DM + lane * 16);
    const int em = (int)rec[4 * g + ul];
    sc.gm = __uint_as_float(rec[128 + 4 * g + ul]);
    sc.su = tsc[em];
    sc.sv = tsc[16384 + em];
}
__device__ __forceinline__ void p3_load_v(u32x4 (&vr)[4], const unsigned char* __restrict__ VQ, int lane, int g, const unsigned* rec) {
#pragma unroll
    for (int u = 0; u < 4; u++) vr[u] = *(const u32x4*)(VQ + (size_t)rec[4 * g + u] * DM + lane * 16);
}
__device__ __forceinline__ void p3_dots(const u32x4 (&ur)[4], const unsigned* rec, int lane, int (&pt)[4]) {
    const u32x4 qh = *(const u32x4*)(rec + 256 + lane * 4);
#pragma unroll
    for (int u = 0; u < 4; u++) {
        int d = __builtin_amdgcn_sdot4((int)ur[u].x, (int)qh.x, 0, false);
        d = __builtin_amdgcn_sdot4((int)ur[u].y, (int)qh.y, d, false);
        d = __builtin_amdgcn_sdot4((int)ur[u].z, (int)qh.z, d, false);
        d = __builtin_amdgcn_sdot4((int)ur[u].w, (int)qh.w, d, false);
        pt[u] = d;
    }
}
__device__ __forceinline__ float p3_weight(const int (&pt)[4], int lane, float sh, const P3Sc& sc) {
    int m2[2], m1;
    const bool c0 = lane & 1;
#pragma unroll
    for (int j = 0; j < 2; j++) { const int keep = c0 ? pt[j + 2] : pt[j], send = c0 ? pt[j] : pt[j + 2]; m2[j] = keep + __shfl_xor(send, 1, 64); }
    const bool c1 = lane & 2;
    { const int keep = c1 ? m2[1] : m2[0], send = c1 ? m2[0] : m2[1]; m1 = keep + __shfl_xor(send, 2, 64); }
    m1 += __shfl_xor(m1, 4, 64);
    m1 += __shfl_xor(m1, 8, 64);
    m1 += __shfl_xor(m1, 16, 64);
    m1 += __shfl_xor(m1, 32, 64);
    const float aval = (float)m1 * (sh * sc.su);
    return sc.gm * gelu_erf(aval) * sc.sv;
}
__device__ __forceinline__ void p3_axpy(const u32x4 (&vr)[4], float ws, float (&acc)[16], float& wsum) {
#pragma unroll
    for (int u = 0; u < 4; u++) {
        const int src_lane = ((u >> 1) & 1) | ((u & 1) << 1);
        const float wu = __shfl(ws, src_lane, 64);
        wsum += wu;
        const unsigned vw[4] = {vr[u].x, vr[u].y, vr[u].z, vr[u].w};
#pragma unroll
        for (int i = 0; i < 4; i++) {
            acc[i * 4 + 0] += wu * ub0(vw[i]); acc[i * 4 + 1] += wu * ub1(vw[i]);
            acc[i * 4 + 2] += wu * ub2(vw[i]); acc[i * 4 + 3] += wu * ub3(vw[i]);
        }
    }
}
__device__ __forceinline__ void p3_token(const Params& p, int tok, int lane, unsigned* rec, float& sh) {
    const bf16_t* H = (const bf16_t*)(p.ws + OFF_H);
    const int* eidx = (const int*)(p.ws + OFF_EIDX);
    const float* gwp = (const float*)(p.ws + OFF_GW);
    {
        const u32x4 a = *(const u32x4*)(H + (size_t)tok * DM + lane * 16), b = *(const u32x4*)(H + (size_t)tok * DM + lane * 16 + 8);
        const unsigned hw[8] = {a.x, a.y, a.z, a.w, b.x, b.y, b.z, b.w};
        float hv[16];
        float mx = 0.f;
#pragma unroll
        for (int i = 0; i < 8; i++) { hv[2 * i] = bf_lo(hw[i]); hv[2 * i + 1] = bf_hi(hw[i]); mx = fmaxf(mx, fmaxf(fabsf(hv[2 * i]), fabsf(hv[2 * i + 1]))); }
        mx = wave_max(mx);
        const float inv = mx > 0.f ? 127.f / mx : 0.f;
        sh = mx * (1.f / 127.f);
        unsigned qh[4];
#pragma unroll
        for (int i = 0; i < 4; i++) {
            unsigned pk = 0;
#pragma unroll
            for (int j = 0; j < 4; j++) pk |= ((unsigned)((int)rintf(hv[i * 4 + j] * inv)) & 0xffu) << (8 * j);
            qh[i] = pk;
        }
        *(u32x4*)(rec + 256 + lane * 4) = (u32x4){qh[0], qh[1], qh[2], qh[3]};
    }
    const int e0 = eidx[(size_t)tok * 128 + lane], e1 = eidx[(size_t)tok * 128 + 64 + lane];
    const float g0 = gwp[(size_t)tok * 128 + lane], g1 = gwp[(size_t)tok * 128 + 64 + lane];
    const int k0 = e0 >> 10, k1 = e1 >> 10;
    int pos0 = 0, pos1 = 0, base = 0;
#pragma unroll
    for (int v = 0; v < 16; v++) {
        const unsigned long long m0 = __ballot(k0 == v), m1 = __ballot(k1 == v);
        const int c0 = __popcll(m0);
        const int r0 = __builtin_amdgcn_mbcnt_hi((unsigned)(m0 >> 32), __builtin_amdgcn_mbcnt_lo((unsigned)m0, 0u));
        const int r1 = __builtin_amdgcn_mbcnt_hi((unsigned)(m1 >> 32), __builtin_amdgcn_mbcnt_lo((unsigned)m1, 0u));
        pos0 = (k0 == v) ? base + r0 : pos0;
        pos1 = (k1 == v) ? base + c0 + r1 : pos1;
        base += c0 + __popcll(m1);
    }
    rec[pos0] = (unsigned)e0; rec[pos1] = (unsigned)e1;
    rec[128 + pos0] = __float_as_uint(g0); rec[128 + pos1] = __float_as_uint(g1);
}
__device__ __forceinline__ void p3_finish(const Params& p, float* dstp, int tok, int lane, const float (&acc)[16], float wsum) {
    const float* mod = (const float*)(p.ws + OFF_MOD);
    const int b = tok >> 11;
    float x2[16];
    float ss = 0.f;
#pragma unroll
    for (int i = 0; i < 4; i++) {
        const int d = lane * 16 + i * 4;
        const f32x4 xv = *(const f32x4*)(p.out + (size_t)tok * DM + d);
        const f32x4 gt = *(const f32x4*)(mod + b * 6144 + 5 * 1024 + d);
#pragma unroll
        for (int j = 0; j < 4; j++) { const float v = xv[j] + gt[j] * (acc[i * 4 + j] - 128.f * wsum); x2[i * 4 + j] = v; ss += v * v; }
    }
    ss = wave_sum(ss);
    const float rstd = rsqrtf(ss * (1.f / 1024.f) + 1e-6f);
#pragma unroll
    for (int i = 0; i < 4; i++) {
        const int d = lane * 16 + i * 4;
        const f32x4 fg = *(const f32x4*)(p.final_g + d);
        f32x4 o;
#pragma unroll
        for (int j = 0; j < 4; j++) o[j] = x2[i * 4 + j] * rstd * fg[j];
        *(f32x4*)(dstp + (size_t)tok * DM + d) = o;
    }
}
__device__ void phaseP3(const Params& p, float* dstp, char* lds) {
    const int tid_ = TIDX; const int lane = tid_ & 63, wave = tid_ >> 6;
    const unsigned char* UQ = (const unsigned char*)(p.ws + OFF_UB);
    const unsigned char* VQ = UQ + 16777216;
    const float* tsc = (const float*)(p.ws + OFF_UB + 33554432);
    const int ul = ((lane & 1) << 1) | ((lane >> 1) & 1);
    constexpr int TPW = 2;
    unsigned* recs = (unsigned*)(lds + wave * TPW * P3_REC);
    for (int tb = (vblk() * 4 + wave) * TPW; tb < NTOK; tb += vgrid() * 4 * TPW) {
        float sh[TPW], acc[TPW][16], wsm[TPW];
        __builtin_amdgcn_wave_barrier();
#pragma unroll
        for (int k = 0; k < TPW; k++) {
            p3_token(p, tb + k, lane, recs + k * (P3_REC / 4), sh[k]);
#pragma unroll
            for (int i = 0; i < 16; i++) acc[k][i] = 0.f;
            wsm[k] = 0.f;
        }
        __builtin_amdgcn_wave_barrier();
        u32x4 ur[4], vr[4];
        P3Sc sc[TPW];
        p3_load_u(ur, sc[0], UQ, tsc, lane, ul, 0, recs);
        p3_load_v(vr, VQ, lane, 0, recs);
        for (int g = 0; g < 32; g++) {
#pragma unroll
            for (int k = 0; k < TPW; k++) {
                const int kn = (k + 1) % TPW;
                const int gn = (k + 1 == TPW) ? g + 1 : g;
                int pt[4];
                p3_dots(ur, recs + k * (P3_REC / 4), lane, pt);
                if (gn < 32) p3_load_u(ur, sc[kn], UQ, tsc, lane, ul, gn, recs + kn * (P3_REC / 4));
                const float w = p3_weight(pt, lane, sh[k], sc[k]);
                p3_axpy(vr, w, acc[k], wsm[k]);
                if (gn < 32) p3_load_v(vr, VQ, lane, gn, recs + kn * (P3_REC / 4));
            }
        }
#pragma unroll
        for (int k = 0; k < TPW; k++) p3_finish(p, dstp, tb + k, lane, acc[k], wsm[k]);
    }
}

#define XB_TMO      128
#define XB_XCNT(j)  (256  + 64 * (j))
#define XB_XSUB(j)  (1280 + 64 * (j))
#define XB_XGEN(j)  (2304 + 64 * (j))
#define XB_TOP      3328
#define XB_TOPGEN   3392
#define XCD_BAR_WORDS 3456
#define XB_SPIN_CAP (1u << 22)
#define LAS __attribute__((address_space(3)))
__device__ __forceinline__ unsigned xb_ld(unsigned* p)              { return __hip_atomic_load(p, __ATOMIC_RELAXED, __HIP_MEMORY_SCOPE_AGENT); }
__device__ __forceinline__ unsigned xb_add(unsigned* p, unsigned v) { return __hip_atomic_fetch_add(p, v, __ATOMIC_RELAXED, __HIP_MEMORY_SCOPE_AGENT); }
__device__ __forceinline__ unsigned xb_xcc_id() { return (unsigned)__builtin_amdgcn_s_getreg((3 << 11) | 20) & 0xFu; }
#define XB_SPIN(cond, bar) do { unsigned _sp = 0; while (cond) { __builtin_amdgcn_s_sleep(1); \
    if ((++_sp & 255u) == 0u) { if (xb_ld(&(bar)[XB_TMO])) break; if (_sp > XB_SPIN_CAP) { atomicAdd(&(bar)[XB_TMO], 1u); break; } } } } while (0)
struct XcdBarrier { unsigned* bar; unsigned x; volatile LAS unsigned* st; };
__device__ __forceinline__ XcdBarrier xcd_barrier_post(unsigned* bar, volatile LAS unsigned* st) {
    XcdBarrier b; b.bar = bar; b.x = xb_xcc_id(); b.st = st;
    if (threadIdx.x == 0) { st[2] = xb_add(&bar[XB_XCNT(b.x)], 1u); st[4] = b.x; }
    return b;
}
__device__ __forceinline__ void xcd_barrier_complete(unsigned* bar, unsigned x, unsigned& nloc, unsigned& nx, unsigned& bal) {
    const unsigned G = gridDim.x * gridDim.y * gridDim.z;
    unsigned sum, cnt, mine, c64, sp = 0u;
    for (;;) {
        sum = 0u; cnt = 0u; mine = 0u; c64 = 0u;
#pragma unroll
        for (unsigned j = 0; j < 16; ++j) { const unsigned c = xb_ld(&bar[XB_XCNT(j)]); sum += c; cnt += (c > 0u) ? 1u : 0u; c64 += (j < 8 && c == 64u) ? 1u : 0u; mine = (j == x) ? c : mine; }
        if (sum == G) break;
        __builtin_amdgcn_s_sleep(1);
        if ((++sp & 255u) == 0u) { if (xb_ld(&bar[XB_TMO])) break; if (sp > XB_SPIN_CAP) { atomicAdd(&bar[XB_TMO], 1u); break; } }
    }
    nloc = mine > 0u ? mine : 1u; nx = cnt > 0u ? cnt : 1u; bal = (sum == G && cnt == 8u && c64 == 8u) ? 1u : 0u;
}
__device__ __forceinline__ void xcd_barrier(const XcdBarrier& b) {
    asm volatile("s_waitcnt vmcnt(0)" ::: "memory");
    __syncthreads();
    if (threadIdx.x == 0) {
        unsigned* bar = b.bar;
        __builtin_amdgcn_s_waitcnt(0);
        unsigned nloc = b.st[0], nx = b.st[1];
        if (nloc == 0u) { unsigned bal; xcd_barrier_complete(bar, b.x, nloc, nx, bal); b.st[0] = nloc; b.st[1] = nx; b.st[3] = bal; }
        const unsigned old = xb_add(&bar[XB_XSUB(b.x)], 1u);
        const unsigned gen = old / nloc;
        if (old + 1u == (gen + 1u) * nloc) {
            __builtin_amdgcn_fence(__ATOMIC_RELEASE, "agent");
            asm volatile("s_waitcnt vmcnt(0)" ::: "memory");
            const unsigned og = xb_add(&bar[XB_TOP], 1u);
            const unsigned tg = og / nx;
            if (og + 1u == (tg + 1u) * nx) xb_add(&bar[XB_TOPGEN], 1u);
            else XB_SPIN(xb_ld(&bar[XB_TOPGEN]) == tg, bar);
            __builtin_amdgcn_fence(__ATOMIC_ACQUIRE, "agent");
            xb_add(&bar[XB_XGEN(b.x)], 1u);
            asm volatile("s_waitcnt vmcnt(0)" ::: "memory");
        } else {
            XB_SPIN(xb_ld(&bar[XB_XGEN(b.x)]) == gen, bar);
            __builtin_amdgcn_fence(__ATOMIC_ACQUIRE, "agent");
            asm volatile("s_waitcnt vmcnt(0)" ::: "memory");
        }
    }
    __syncthreads();
}

typedef __attribute__((address_space(4))) const Params* KParamsPtr;
__device__ __forceinline__ const Params& fresh_params() {
    KParamsPtr kp = (KParamsPtr)__builtin_amdgcn_kernarg_segment_ptr();
    asm volatile("" : "+s"(kp));
    return *(const Params*)kp;
}
#define PF fresh_params()
__global__ void __launch_bounds__(BLOCK_THREADS, 2) mega(Params p_unused) {
    __shared__ __attribute__((aligned(16))) char lds[LDS_BYTES];
    cg::grid_group grid = cg::this_grid();
    volatile LAS unsigned* st = (volatile LAS unsigned*)(lds + 2 * LDS_MAIN);
    if (threadIdx.x < 16) st[threadIdx.x] = 0u;
    __syncthreads();
    XcdBarrier xb = xcd_barrier_post((unsigned*)PF.ws, st);
    char* hl = lds + half_id() * LDS_MAIN;
    volatile unsigned* uex = (volatile unsigned*)(lds + 2 * LDS_MAIN + 32);

    phaseA(PF, hl);
    if (PF.ws == nullptr) grid.sync();
    xcd_barrier(xb);
    { const Params& q_ = PF; phase_modnorm(q_, q_.x, q_.norm1_g, 0, 1, (bf16_t*)(q_.ws + OFF_H)); };
    xcd_barrier(xb);
    phaseC(PF, lds);
    xcd_barrier(xb);
    for (int task = vblk(); task < 1024; task += vgrid()) phaseG1_task(PF, task, hl);
    for (int task = vblk(); task < 512; task += vgrid()) phaseN1_task(PF, task, hl);
    xcd_barrier(xb);
    phaseG2(PF);
    phaseA2(PF, hl);
    xcd_barrier(xb);
    for (int task = vblk(); task < 2048; task += vgrid()) phaseN2_task(PF, task, hl, (bf16_t*)(PF.ws + OFF_Z) + ZQ_N, ZC, uex, lds);
    for (int task = vblk(); task < 1024; task += vgrid()) phaseG3_task(PF, task, hl, (bf16_t*)(PF.ws + OFF_Z) + ZR_G, ZC);
    xcd_barrier(xb);
    phaseM1(PF, lds);
    xcd_barrier(xb);
    phaseM2(PF, lds);
    xcd_barrier(xb);
    { const Params& q_ = PF; phase_modnorm(q_, q_.out, q_.norm2_g, 3, 4, (bf16_t*)(q_.ws + OFF_H)); };
    xcd_barrier(xb);
    phaseP1(PF, lds);
    xcd_barrier(xb);
    for (int task = vblk(); task < 2048; task += vgrid()) phaseP2_task(PF, task, hl);
    xcd_barrier(xb);
    { const Params& q_ = PF; phaseP3(q_, q_.out, hl); };
}

extern "C" void kernel_launch(void* const* d_in, const int* in_sizes, int n_in, void* d_out, int out_size, void* d_ws, size_t ws_size, hipStream_t stream) {
    Params p{};
    p.x = (const float*)d_in[0]; p.c = (const float*)d_in[1]; p.pos = (const int*)d_in[2]; p.ada_w = (const float*)d_in[3]; p.ada_b = (const float*)d_in[4];
    p.norm1_g = (const float*)d_in[5]; p.norm2_g = (const float*)d_in[6]; p.final_g = (const float*)d_in[7]; p.w_in = (const float*)d_in[8];
    p.gla_wa2 = (const float*)d_in[9]; p.gla_ba2 = (const float*)d_in[10]; p.gla_norm_g = (const float*)d_in[11]; p.pe_k = (const float*)d_in[12]; p.pe_v = (const float*)d_in[13];
    p.ck_w1 = (const float*)d_in[14]; p.ck_w2 = (const float*)d_in[15]; p.cv_w1 = (const float*)d_in[16]; p.cv_w2 = (const float*)d_in[17];
    p.w_branch_a = (const float*)d_in[18]; p.w_branch_b = (const float*)d_in[19]; p.w_out = (const float*)d_in[20]; p.peer_wq = (const float*)d_in[21];
    p.peer_k1 = (const float*)d_in[22]; p.peer_k2 = (const float*)d_in[23]; p.peer_u = (const float*)d_in[24]; p.peer_v = (const float*)d_in[25];
    p.out = (float*)d_out; p.ws = (char*)d_ws;
    static int grid_blocks = 0;
    if (!grid_blocks) {
        int dev = 0, cus = 0, per_cu = 0;
        hipGetDevice(&dev);
        hipDeviceGetAttribute(&cus, hipDeviceAttributeMultiprocessorCount, dev);
        hipOccupancyMaxActiveBlocksPerMultiprocessor(&per_cu, mega, BLOCK_THREADS, 0);
        if (per_cu > 1) per_cu = 1;
        if (per_cu < 1) per_cu = 1;
        grid_blocks = cus * per_cu;
    }
    hipMemsetAsync(d_ws, 0, XCD_BAR_WORDS * 4, stream);
    void* args[] = {&p};
    hipError_t e = hipLaunchCooperativeKernel((void*)mega, dim3(grid_blocks), dim3(BLOCK_THREADS), args, 0, stream);
    if (e != hipSuccess) fprintf(stderr, "cooperative launch failed: %s (grid %d)\n", hipGetErrorString(e), grid_blocks);
}
```

```cpp
#include <hip/hip_runtime.h>
#include <hip/hip_cooperative_groups.h>
#include <stdio.h>
namespace cg = cooperative_groups;
#include <stdint.h>
#include <stddef.h>
#include <math.h>

typedef unsigned short bf16_t;
typedef short bf16x8 __attribute__((ext_vector_type(8)));
typedef float f32x4 __attribute__((ext_vector_type(4)));
typedef unsigned u32x4 __attribute__((ext_vector_type(4)));
typedef unsigned u32x2 __attribute__((ext_vector_type(2)));

constexpr int DM = 1024, NB = 8, SEQ = 2048, NTOK = NB * SEQ;
constexpr int ZC = 4992;
constexpr int ZQ_G = 0, ZK_G = 512, ZV_G = 1024, ZR_G = 2048, ZQ_N = 3072, ZKC = 4096, ZVC = 4224, ZKS = 4352, ZVS = 4480,
              ZKW = 4608, ZVW = 4736, ZGATE = 4864, ZLR = 4912;
constexpr int LDS_MAIN = 73728;
constexpr int LDS_BYTES = 2 * LDS_MAIN + 64;
constexpr int NTHREADS = 256;
constexpr int BLOCK_THREADS = 512;

constexpr size_t OFF_MOD = 16384;
constexpr size_t OFF_ROPE = 212992;
constexpr size_t OFF_CMP = 1261568;
constexpr size_t OFF_DEC = 1785856;
constexpr size_t OFF_K1B = 2310144;
constexpr size_t OFF_WC1 = 2834432;
constexpr size_t OFF_WIN = 4194304;
constexpr size_t OFF_WM = 14417920;
constexpr size_t OFF_WA = 18612224;
constexpr size_t OFF_WB = 20709376;
constexpr size_t OFF_WO = 22806528;
constexpr size_t OFF_WQ = 24903680;
constexpr size_t OFF_H = 29360128;
constexpr size_t OFF_M = 62914560;
constexpr size_t OFF_Z = 96468992;
constexpr size_t OFF_VT = OFF_Z + (size_t)NTOK * ZC * 2;
constexpr size_t OFF_QP = OFF_Z;
constexpr size_t OFF_UB = OFF_Z + 67108864;
constexpr size_t OFF_VB = OFF_UB + 33554432;
constexpr size_t OFF_EIDX = OFF_VB + 33554432;
constexpr size_t OFF_GW = OFF_EIDX + 8388608;

struct Params {
    const float* x; const float* c; const int* pos; const float* ada_w; const float* ada_b;
    const float* norm1_g; const float* norm2_g; const float* final_g; const float* w_in;
    const float* gla_wa2; const float* gla_ba2; const float* gla_norm_g; const float* pe_k; const float* pe_v;
    const float* ck_w1; const float* ck_w2; const float* cv_w1; const float* cv_w2;
    const float* w_branch_a; const float* w_branch_b; const float* w_out; const float* peer_wq;
    const float* peer_k1; const float* peer_k2; const float* peer_u; const float* peer_v;
    float* out; char* ws;
};

__device__ __forceinline__ unsigned f2bf_u(float f) { unsigned u = __float_as_uint(f); return (u + 0x7fffu + ((u >> 16) & 1u)) >> 16; }
__device__ __forceinline__ bf16_t f2bf(float f) { return (bf16_t)f2bf_u(f); }
typedef float f32x2_ __attribute__((ext_vector_type(2)));
typedef __bf16 bf16x2_ __attribute__((ext_vector_type(2)));
__device__ __forceinline__ unsigned pack2(float lo, float hi) {
    const f32x2_ v = {lo, hi};
    return __builtin_bit_cast(unsigned, __builtin_convertvector(v, bf16x2_));
}
__device__ __forceinline__ float bf_lo(unsigned u) { return __uint_as_float(u << 16); }
__device__ __forceinline__ float bf_hi(unsigned u) { return __uint_as_float(u & 0xffff0000u); }
__device__ __forceinline__ float bf2f(bf16_t h) { return __uint_as_float(((unsigned)h) << 16); }
__device__ __forceinline__ float wave_sum(float v) {
#pragma unroll
    for (int o = 32; o > 0; o >>= 1) v += __shfl_xor(v, o, 64);
    return v;
}
__device__ __forceinline__ float wave_max(float v) {
#pragma unroll
    for (int o = 32; o > 0; o >>= 1) v = fmaxf(v, __shfl_xor(v, o, 64));
    return v;
}
__device__ __forceinline__ int launder_i(int x) { asm volatile("" : "+v"(x)); return x; }
#define TIDX (launder_i((int)threadIdx.x) & 255)
#define TIDX512 launder_i((int)threadIdx.x)
__device__ __forceinline__ int half_id() { return __builtin_amdgcn_readfirstlane((int)(threadIdx.x >> 8)); }
__device__ __forceinline__ int vblk() { return (int)blockIdx.x * 2 + half_id(); }
__device__ __forceinline__ int vgrid() { return (int)gridDim.x * 2; }
__device__ __forceinline__ float exp2f_(float x) { return __builtin_amdgcn_exp2f(x); }
__device__ __forceinline__ float sigmoidf_(float x) { return __builtin_amdgcn_rcpf(1.f + __expf(-x)); }
__device__ __forceinline__ float siluf_(float x) { return x * __builtin_amdgcn_rcpf(1.f + __expf(-x)); }
__device__ __forceinline__ float gelu_erf(float v) {
    const float t = __builtin_amdgcn_rcpf(fabsf(v) * 0.2316418882f + 1.0f);
    float qp = t * 0.5307027145f + (-0.7265760135f);
    qp = qp * t + 0.7107068705f; qp = qp * t + (-0.142248368f); qp = qp * t + 0.127414796f; qp = qp * t;
    const float m = v * (qp * __builtin_amdgcn_exp2f(v * v * (-0.72134752044f)));
    return v < 0.f ? m : v - m;
}
__device__ __forceinline__ f32x4 mfma16(bf16x8 a, bf16x8 b, f32x4 c) { return __builtin_amdgcn_mfma_f32_16x16x32_bf16(a, b, c, 0, 0, 0); }
__device__ __forceinline__ bf16x8 ld_frag(const bf16_t* p) { return *(const bf16x8*)p; }
__device__ __forceinline__ bf16x8 mk_frag(u32x2 lo, u32x2 hi) { u32x4 t = {lo.x, lo.y, hi.x, hi.y}; return __builtin_bit_cast(bf16x8, t); }

#define WAIT_V(n) asm volatile("s_waitcnt vmcnt(" #n ")" ::: "memory")
__device__ __forceinline__ int swz4(int R) { return (4 - ((R >> 2) & 3)) & 3; }
__device__ __forceinline__ void glds16(const bf16_t* g, char* l) { __builtin_amdgcn_global_load_lds((const unsigned*)g, (unsigned*)l, 16, 0, 0); }
struct GemmSrc { const bf16_t* xsrc; const bf16_t* wsrc; int ldx, ldw; };
__device__ __forceinline__ GemmSrc gemm_src(const bf16_t* __restrict__ X, int ldx, const bf16_t* __restrict__ W, int ldw, int m0, int n0) {
    const int tid = TIDX512, lane = tid & 63, wave = tid >> 6;
    const int R0 = wave * 32 + (lane >> 2);
    const int sw = ((lane & 3) ^ swz4(R0)) * 8;
    GemmSrc g;
    g.xsrc = X + (size_t)(m0 + R0) * ldx + sw;
    g.wsrc = W + (size_t)(n0 + R0) * ldw + sw;
    g.ldx = ldx; g.ldw = ldw;
    return g;
}
__device__ __forceinline__ void gemm_issue(const GemmSrc& g, int kt, int s, char* lds) {
    const int tid = TIDX512, lane = tid & 63, wave = tid >> 6;
    char* xdst = lds + s * 32768 + wave * 2048 + lane * 16;
    char* wdst = xdst + 16384;
#pragma unroll
    for (int i = 0; i < 2; i++) {
        glds16(g.xsrc + (size_t)i * 16 * g.ldx + kt * 32, xdst + i * 1024);
        glds16(g.wsrc + (size_t)i * 16 * g.ldw + kt * 32, wdst + i * 1024);
    }
}
__device__ __forceinline__ void gemm_prologue(const GemmSrc& g, char* lds) { gemm_issue(g, 0, 0, lds); gemm_issue(g, 1, 1, lds); gemm_issue(g, 2, 2, lds); }
__device__ __forceinline__ void gemm_mainloop(f32x4 (&acc)[8][4], const GemmSrc& g, int K, char* lds) {
    const int tid = TIDX512, lane = tid & 63, wave = tid >> 6;
    const int wr = wave >> 2, wc = wave & 3, r = lane & 15, q = lane >> 4;
    const int KT = K / 32;
    const int rdo = r * 64 + ((q ^ swz4(r)) * 16);
    for (int kt = 0; kt < KT; kt++) {
        if (kt + 2 < KT) WAIT_V(8); else if (kt + 1 < KT) WAIT_V(4); else WAIT_V(0);
        __builtin_amdgcn_s_barrier();
        const char* st = lds + (kt & 3) * 32768;
        bf16x8 af[4], bfr[8];
#pragma unroll
        for (int ni = 0; ni < 4; ni++) af[ni] = *(const bf16x8*)(st + 16384 + (wc * 64 + ni * 16) * 64 + rdo);
#pragma unroll
        for (int mi = 0; mi < 8; mi++) bfr[mi] = *(const bf16x8*)(st + (wr * 128 + mi * 16) * 64 + rdo);
        if (kt + 3 < KT) gemm_issue(g, kt + 3, (kt + 3) & 3, lds);
#pragma unroll
        for (int mi = 0; mi < 8; mi++)
#pragma unroll
            for (int ni = 0; ni < 4; ni++) acc[mi][ni] = mfma16(af[ni], bfr[mi], acc[mi][ni]);
        __builtin_amdgcn_sched_barrier(0);
    }
}
__device__ __forceinline__ void gemm_core(f32x4 (&acc)[8][4], const bf16_t* __restrict__ X, int ldx, const bf16_t* __restrict__ W, int ldw,
                                          int K, int m0, int n0, char* lds) {
    const GemmSrc g = gemm_src(X, ldx, W, ldw, m0, n0);
    gemm_prologue(g, lds);
    gemm_mainloop(acc, g, K, lds);
    __syncthreads();
}
__device__ __forceinline__ void zero_acc(f32x4 (&acc)[8][4]) {
#pragma unroll
    for (int a = 0; a < 8; a++)
#pragma unroll
        for (int b = 0; b < 4; b++) acc[a][b] = (f32x4){0.f, 0.f, 0.f, 0.f};
}

constexpr int EPI_ROWB = 528;
__device__ __forceinline__ void epi_fill(char* lds, int wr, int wc, int r, int q, int mi, int ni, f32x4 v) {
    *(u32x2*)(lds + (wr * 128 + mi * 16 + r) * EPI_ROWB + (wc * 64 + ni * 16 + 4 * q) * 2) = (u32x2){pack2(v[0], v[1]), pack2(v[2], v[3])};
}
__device__ __forceinline__ void epi_store(const char* lds, bf16_t* __restrict__ O, int ldo, int m0, int n0, int ncols_valid) {
    const int t = TIDX512;
    const int chunk = t & 31, rsub = t >> 5;
    if (n0 + chunk * 8 < ncols_valid) {
#pragma unroll
        for (int ps = 0; ps < 16; ps++) {
            const int row = ps * 16 + rsub;
            const u32x4 v = *(const u32x4*)(lds + row * EPI_ROWB + chunk * 16);
            *(u32x4*)(O + (size_t)(m0 + row) * ldo + n0 + chunk * 8) = v;
        }
    }
}

struct TileIter {
    int nt, i, x, li; bool fancy;
    __device__ TileIter(int ntiles_n, const char*) { nt = ntiles_n; fancy = (gridDim.x == 256) && ((nt & 3) == 0); x = blockIdx.x & 7; li = blockIdx.x >> 3; i = fancy ? 0 : blockIdx.x; }
    __device__ bool next(int& bm, int& bn) {
        if (fancy) {
            if (i * 4 >= nt) return false;
            bm = x * 8 + (li & 7); bn = i * 4 + (li >> 3); i++; return true;
        }
        if (i >= 64 * nt) return false;
        bn = i % nt; bm = i / nt; i += gridDim.x; return true;
    }
};

struct MapId { __device__ int operator()(int n) const { return n; } };
struct MapWin {
    __device__ int operator()(int n) const { return n < 3072 ? n : (n < 4912 ? n + 16 : (n < 4928 ? n - 1840 : -1)); }
};
struct MapOff { int off; __device__ int operator()(int n) const { return n + off; } };

template <class Map>
__device__ __forceinline__ void tconv_tile(const float* __restrict__ src, int ldsrc, bf16_t* __restrict__ dst, int ldd, int n0, int k0, Map map, float* t) {
    const int tid = TIDX;
    const int n = tid & 63, kb = tid >> 6;
    const int sc = map(n0 + n);
#pragma unroll
    for (int i = 0; i < 16; i++) { const int k = i * 4 + kb; t[k * 65 + n] = sc >= 0 ? src[(size_t)(k0 + k) * ldsrc + sc] : 0.f; }
    __syncthreads();
    const int nn = tid >> 2, kk = (tid & 3) * 16;
    unsigned w[8];
#pragma unroll
    for (int j = 0; j < 8; j++) w[j] = pack2(t[(kk + 2 * j) * 65 + nn], t[(kk + 2 * j + 1) * 65 + nn]);
    u32x4* d = (u32x4*)(dst + (size_t)(n0 + nn) * ldd + k0 + kk);
    d[0] = (u32x4){w[0], w[1], w[2], w[3]};
    d[1] = (u32x4){w[4], w[5], w[6], w[7]};
    __syncthreads();
}

constexpr int TA_MOD = 192, TA_WIN = 78 * 16, TA_WM = 32 * 16, TA_SQ = 16 * 16, TA_WQ = 32 * 16, TA_WC = 32, TA_K12 = 64, TA_ROPE = 512;
constexpr int TA_E0 = TA_MOD, TA_E1 = TA_E0 + TA_WIN, TA_E2 = TA_E1 + TA_WM, TA_E3 = TA_E2 + TA_SQ, TA_E4 = TA_E3 + TA_SQ, TA_E5 = TA_E4 + TA_SQ,
              TA_E6 = TA_E5 + TA_WQ, TA_E7 = TA_E6 + TA_WC, TA_E8 = TA_E7 + TA_WC, TA_E9 = TA_E8 + TA_K12, TA_E10 = TA_E9 + TA_K12, TA_E11 = TA_E10 + TA_ROPE;

__device__ void phaseA(const Params& p, char* lds) {
    const int tid = TIDX;
    float* fl = (float*)lds;
    constexpr int N0 = TA_E1 + (TA_E8 - TA_E6) + (TA_E11 - TA_E10);
    for (int idx = vblk(); idx < N0; idx += vgrid()) {
        const int task = idx < TA_E1 ? idx : (idx < TA_E1 + (TA_E8 - TA_E6) ? idx - TA_E1 + TA_E6 : idx - TA_E1 - (TA_E8 - TA_E6) + TA_E10);
        if (task < TA_E0) {
            float* sc = fl;
            float* red = fl + 8192;
            {
                f32x4 cv[8];
#pragma unroll
                for (int i = 0; i < 8; i++) cv[i] = *(const f32x4*)(p.c + (i * 256 + tid) * 4);
#pragma unroll
                for (int i = 0; i < 8; i++) *(f32x4*)(sc + (i * 256 + tid) * 4) = (f32x4){siluf_(cv[i][0]), siluf_(cv[i][1]), siluf_(cv[i][2]), siluf_(cv[i][3])};
            }
            __syncthreads();
            const int n = task * 32 + (tid & 31), kg = tid >> 5;
            float a[8];
#pragma unroll
            for (int b = 0; b < 8; b++) a[b] = 0.f;
            for (int k0 = kg * 128; k0 < kg * 128 + 128; k0 += 16) {
                float w[16];
#pragma unroll
                for (int i = 0; i < 16; i++) w[i] = p.ada_w[(size_t)(k0 + i) * 6144 + n];
#pragma unroll
                for (int i = 0; i < 16; i++)
#pragma unroll
                    for (int b = 0; b < 8; b++) a[b] += sc[b * 1024 + k0 + i] * w[i];
            }
#pragma unroll
            for (int b = 0; b < 8; b++) red[(kg * 8 + b) * 32 + (tid & 31)] = a[b];
            __syncthreads();
            {
                const int b = tid >> 5, nn = tid & 31;
                float s = 0.f;
#pragma unroll
                for (int g = 0; g < 8; g++) s += red[(g * 8 + b) * 32 + nn];
                ((float*)(p.ws + OFF_MOD))[b * 6144 + task * 32 + nn] = s + p.ada_b[task * 32 + nn];
            }
            __syncthreads();
        } else if (task < TA_E1) {
            const int tt = task - TA_E0;
            tconv_tile(p.w_in, 6976, (bf16_t*)(p.ws + OFF_WIN), 1024, (tt >> 4) * 64, (tt & 15) * 64, MapWin(), fl);
        } else if (task < TA_E6) {
        } else if (task < TA_E7) {
            const int tt = task - TA_E6;
            tconv_tile(p.ck_w1, 64, (bf16_t*)(p.ws + OFF_WC1), 2048, 0, tt * 64, MapId(), fl);
        } else if (task < TA_E8) {
            const int tt = task - TA_E7;
            tconv_tile(p.cv_w1, 64, (bf16_t*)(p.ws + OFF_WC1) + 64 * 2048, 2048, 0, tt * 64, MapId(), fl);
        } else if (task < TA_E10) {
        } else {
            const int tt = task - TA_E10;
            const int e = tt * 256 + tid;
            const int tok = e >> 3, i = e & 7;
            const float invf[8] = {1.0f, 0.1939227432012558f, 0.03760603070259094f, 0.007292664609849453f,
                                   0.0014142135623842478f, 0.00027424818836152554f, 5.318296098266728e-05f, 1.0313386155758053e-05f};
            float fr = invf[0];
#pragma unroll
            for (int j = 1; j < 8; j++) fr = (i == j) ? invf[j] : fr;
            const float ang = (float)p.pos[tok] * fr;
            const double rev = (double)ang * 0.15915494309189533577;
            const float fpart = (float)(rev - floor(rev));
            float* cs = (float*)(p.ws + OFF_ROPE);
            cs[e * 2] = __builtin_amdgcn_cosf(fpart);
            cs[e * 2 + 1] = __builtin_amdgcn_sinf(fpart);
        }
    }
}

__device__ void phaseA2(const Params& p, char* lds) {
    const int tid = TIDX;
    float* fl = (float*)lds;
    constexpr int N1 = (TA_E6 - TA_E1) + (TA_E10 - TA_E8);
    for (int idx = vblk(); idx < N1; idx += vgrid()) {
        const int task = idx < (TA_E6 - TA_E1) ? idx + TA_E1 : idx - (TA_E6 - TA_E1) + TA_E8;
        if (task < TA_E1) {
        } else if (task < TA_E2) {
            const int tt = task - TA_E1;
            tconv_tile(p.w_in, 6976, (bf16_t*)(p.ws + OFF_WM), 1024, (tt >> 4) * 64, (tt & 15) * 64, MapOff{4928}, fl);
        } else if (task < TA_E3) {
            const int tt = task - TA_E2;
            tconv_tile(p.w_branch_a, 1024, (bf16_t*)(p.ws + OFF_WA), 1024, (tt >> 4) * 64, (tt & 15) * 64, MapId(), fl);
        } else if (task < TA_E4) {
            const int tt = task - TA_E3;
            tconv_tile(p.w_branch_b, 1024, (bf16_t*)(p.ws + OFF_WB), 1024, (tt >> 4) * 64, (tt & 15) * 64, MapId(), fl);
        } else if (task < TA_E5) {
            const int tt = task - TA_E4;
            tconv_tile(p.w_out, 1024, (bf16_t*)(p.ws + OFF_WO), 1024, (tt >> 4) * 64, (tt & 15) * 64, MapId(), fl);
        } else if (task < TA_E6) {
            const int tt = task - TA_E5;
            tconv_tile(p.peer_wq, 2048, (bf16_t*)(p.ws + OFF_WQ), 1024, (tt >> 4) * 64, (tt & 15) * 64, MapId(), fl);
        } else if (task < TA_E10) {
            const bool second = task >= TA_E9;
            const int tt = task - (second ? TA_E9 : TA_E8);
            const float* src = second ? p.peer_k2 : p.peer_k1;
            bf16_t* dst = (bf16_t*)(p.ws + OFF_K1B) + (second ? 131072 : 0);
            const int i = tt * 2048 + tid * 8;
            const f32x4 a = *(const f32x4*)(src + i), b = *(const f32x4*)(src + i + 4);
            *(u32x4*)(dst + i) = (u32x4){pack2(a[0], a[1]), pack2(a[2], a[3]), pack2(b[0], b[1]), pack2(b[2], b[3])};
        }
    }
}

__device__ void phase_modnorm(const Params& p, const float* __restrict__ src, const float* __restrict__ g, int shift_idx, int scale_idx, bf16_t* __restrict__ dst) {
    const int tid_ = TIDX; const int lane = tid_ & 63, wave = tid_ >> 6;
    const float* mod = (const float*)(p.ws + OFF_MOD);
    for (int tok = vblk() * 4 + wave; tok < NTOK; tok += vgrid() * 4) {
        const int b = tok >> 11;
        const float* xr = src + (size_t)tok * DM;
        f32x4 v[4];
        float ss = 0.f;
#pragma unroll
        for (int c = 0; c < 4; c++) { v[c] = *(const f32x4*)(xr + c * 256 + lane * 4); ss += v[c][0] * v[c][0] + v[c][1] * v[c][1] + v[c][2] * v[c][2] + v[c][3] * v[c][3]; }
        ss = wave_sum(ss);
        const float rstd = rsqrtf(ss * (1.f / 1024.f) + 1e-6f);
#pragma unroll
        for (int c = 0; c < 4; c++) {
            const int d = c * 256 + lane * 4;
            const f32x4 gg = *(const f32x4*)(g + d);
            const f32x4 sc = *(const f32x4*)(mod + b * 6144 + scale_idx * 1024 + d);
            const f32x4 sh = *(const f32x4*)(mod + b * 6144 + shift_idx * 1024 + d);
            float o[4];
#pragma unroll
            for (int j = 0; j < 4; j++) o[j] = (v[c][j] * rstd) * gg[j] * (1.f + sc[j]) + sh[j];
            *(u32x2*)(dst + (size_t)tok * DM + d) = (u32x2){pack2(o[0], o[1]), pack2(o[2], o[3])};
        }
    }
}

__device__ void phaseC(const Params& p, char* lds) {
    const int tid_ = TIDX512; const int lane = tid_ & 63, wave = tid_ >> 6;
    const int wr = wave >> 2, wc = wave & 3, r = lane & 15, q = lane >> 4;
    const bf16_t* H = (const bf16_t*)(p.ws + OFF_H);
    const bf16_t* W = (const bf16_t*)(p.ws + OFF_WIN);
    bf16_t* Z = (bf16_t*)(p.ws + OFF_Z);
    const float* cs = (const float*)(p.ws + OFF_ROPE);
    constexpr int NTN = (ZC + 255) / 256;
    TileIter tit(NTN, lds);
    int bm, bn;
    while (tit.next(bm, bn)) {
        const int m0 = bm * 256, n0 = bn * 256;
        f32x4 acc[8][4];
        zero_acc(acc);
        gemm_core(acc, H, DM, W, DM, DM, m0, n0, lds);
        const int c0 = n0 + wc * 64;
        const bool isq = (c0 >= ZQ_N && c0 < ZKC);
        const bool rope = isq || (c0 >= ZKC && c0 < ZGATE && ((c0 - ZKC) & 255) < 128);
        const float scl = isq ? 0.18033688011112042f : 1.f;
#pragma unroll
        for (int mi = 0; mi < 8; mi++) {
            const int tok = m0 + wr * 128 + mi * 16 + r;
            if (rope) {
                f32x4 v = acc[mi][0];
                f32x4 pr;
#pragma unroll
                for (int j = 0; j < 4; j++) pr[j] = __shfl_xor(v[j], 32, 64);
                const int ib = (q & 1) * 4;
                const f32x4 k0 = *(const f32x4*)(cs + (size_t)tok * 16 + ib * 2);
                const f32x4 k1 = *(const f32x4*)(cs + (size_t)tok * 16 + ib * 2 + 4);
                const float cc[4] = {k0[0], k0[2], k1[0], k1[2]}, sn[4] = {k0[1], k0[3], k1[1], k1[3]};
#pragma unroll
                for (int j = 0; j < 4; j++) v[j] = (q < 2) ? (v[j] * cc[j] - pr[j] * sn[j]) : (v[j] * cc[j] + pr[j] * sn[j]);
                acc[mi][0] = v;
            }
#pragma unroll
            for (int ni = 0; ni < 4; ni++) epi_fill(lds, wr, wc, r, q, mi, ni, acc[mi][ni] * scl);
        }
        if ((c0 >= ZVS && c0 < ZVS + 128) || (c0 >= ZVW && c0 < ZVW + 128)) {
            const int brn = c0 >= ZVW ? 1 : 0, gg = ((c0 - (brn ? ZVW : ZVS)) >> 6) & 1;
            const int bb = m0 >> 11, ts = (m0 & 2047) + wr * 128 + r;
            bf16_t* vt = (bf16_t*)(p.ws + OFF_VT) + ((size_t)((brn * 8 + bb) * 2 + gg) * 64) * SEQ + ts;
#pragma unroll
            for (int mi = 0; mi < 8; mi++)
#pragma unroll
                for (int ni = 0; ni < 4; ni++)
#pragma unroll
                    for (int j = 0; j < 4; j++) vt[(size_t)(ni * 16 + 4 * q + j) * SEQ + mi * 16] = f2bf(acc[mi][ni][j]);
        }
        __syncthreads();
        epi_store(lds, Z, ZC, m0, n0, ZC);
        __syncthreads();
    }
}

__device__ __forceinline__ void gla_prep(const Params& p, int tok0, int h, char* lds) {
    const int tid = TIDX;
    float* bc = (float*)lds;
    float* lrs = (float*)(lds + 32768);
    const bf16_t* Z = (const bf16_t*)(p.ws + OFF_Z);
    for (int i = tid; i < 1024; i += NTHREADS) { const int t = i >> 4, rr = i & 15; lrs[i] = bf2f(Z[(size_t)(tok0 + t) * ZC + ZLR + rr]); }
    const int d = tid & 127, th = tid >> 7;
    float w[16];
#pragma unroll
    for (int rr = 0; rr < 16; rr++) w[rr] = p.gla_wa2[rr * 512 + h * 128 + d];
    const float bias = p.gla_ba2[h * 128 + d];
    __syncthreads();
    float run = 0.f;
    for (int t = th * 32; t < th * 32 + 32; t++) {
        float xv = bias;
#pragma unroll
        for (int rr = 0; rr < 16; rr++) xv += lrs[t * 16 + rr] * w[rr];
        const float ls = fminf(xv, 0.f) - __logf(1.f + __expf(-fabsf(xv)));
        run += ls * (1.f / 16.f);
        bc[t * 128 + d] = run;
    }
    __syncthreads();
    if (th == 1) {
        const float add = bc[31 * 128 + d];
        for (int t = 32; t < 64; t++) bc[t * 128 + d] += add;
    }
    __syncthreads();
}

__device__ void phaseG1_task(const Params& p, int task, char* lds) {
    const int tid = TIDX, lane = tid & 63, wave = tid >> 6, r = lane & 15, q = lane >> 4;
    const int c = task & 31, h = (task >> 5) & 3, b = task >> 7;
    const int tok0 = b * SEQ + c * 64;
    const bf16_t* Z = (const bf16_t*)(p.ws + OFF_Z);
    bf16_t* L = (bf16_t*)p.out;
    float* bc = (float*)lds;
    bf16_t* klT = (bf16_t*)(lds + 36864);
    bf16_t* vT = (bf16_t*)(lds + 36864 + 18432);
    gla_prep(p, tok0, h, lds);
    if (tid < 128) ((float*)(p.ws + OFF_DEC))[task * 128 + tid] = __expf(bc[63 * 128 + tid]);
    {
        f32x4* bg = (f32x4*)(p.ws + OFF_M) + (size_t)task * 2048;
#pragma unroll
        for (int i = 0; i < 8; i++) bg[i * 256 + tid] = ((const f32x4*)bc)[i * 256 + tid];
    }
    {
        const int s = lane, dc = wave * 32;
        const bf16_t* kp = Z + (size_t)(tok0 + s) * ZC + ZK_G + h * 128 + dc;
#pragma unroll
        for (int v4 = 0; v4 < 4; v4++) {
            const u32x4 kv = *(const u32x4*)(kp + v4 * 8);
            const unsigned kw[4] = {kv.x, kv.y, kv.z, kv.w};
#pragma unroll
            for (int j = 0; j < 8; j++) {
                const int d = dc + v4 * 8 + j;
                const float kval = (j & 1) ? bf_hi(kw[j >> 1]) : bf_lo(kw[j >> 1]);
                klT[d * 72 + s] = f2bf(kval * __expf(bc[63 * 128 + d] - bc[s * 128 + d]));
            }
        }
    }
    for (int eh = 0; eh < 2; eh++) {
        __syncthreads();
        {
            const int s = lane, ec = wave * 32;
            const bf16_t* vp = Z + (size_t)(tok0 + s) * ZC + ZV_G + h * 256 + eh * 128 + ec;
#pragma unroll
            for (int v4 = 0; v4 < 4; v4++) {
                const u32x4 vv = *(const u32x4*)(vp + v4 * 8);
                const unsigned vw[4] = {vv.x, vv.y, vv.z, vv.w};
#pragma unroll
                for (int j = 0; j < 8; j++) vT[(ec + v4 * 8 + j) * 72 + s] = (bf16_t)((j & 1) ? (vw[j >> 1] >> 16) : (vw[j >> 1] & 0xffffu));
            }
        }
        __syncthreads();
        f32x4 acc[8][2];
#pragma unroll
        for (int dt = 0; dt < 8; dt++) { acc[dt][0] = (f32x4){0.f, 0.f, 0.f, 0.f}; acc[dt][1] = (f32x4){0.f, 0.f, 0.f, 0.f}; }
#pragma unroll
        for (int ks = 0; ks < 2; ks++) {
            bf16x8 bv[2];
#pragma unroll
            for (int x = 0; x < 2; x++) bv[x] = ld_frag(vT + ((2 * wave + x) * 16 + r) * 72 + ks * 32 + q * 8);
#pragma unroll
            for (int dt = 0; dt < 8; dt++) {
                const bf16x8 a = ld_frag(klT + (dt * 16 + r) * 72 + ks * 32 + q * 8);
#pragma unroll
                for (int x = 0; x < 2; x++) acc[dt][x] = mfma16(a, bv[x], acc[dt][x]);
            }
        }
#pragma unroll
        for (int dt = 0; dt < 8; dt++)
#pragma unroll
            for (int x = 0; x < 2; x++) {
                const int e = eh * 128 + (2 * wave + x) * 16 + r, d = dt * 16 + 4 * q;
                const f32x4 v = acc[dt][x];
                *(u32x2*)(L + ((size_t)task * 256 + e) * 128 + d) = (u32x2){pack2(v[0], v[1]), pack2(v[2], v[3])};
            }
    }
    __syncthreads();
}

__device__ void phaseG2(const Params& p) {
    bf16_t* L = (bf16_t*)p.out;
    const float* dec = (const float*)(p.ws + OFF_DEC);
    for (int idx = vblk() * NTHREADS + (int)(threadIdx.x & 255); idx < 32 * 256 * 16; idx += vgrid() * NTHREADS) {
        const int d8 = idx & 15, e = (idx >> 4) & 255, bh = idx >> 12;
        float st[8];
#pragma unroll
        for (int j = 0; j < 8; j++) st[j] = 0.f;
        for (int c = 0; c < 32; c++) {
            const int task = bh * 32 + c;
            u32x4* ptr = (u32x4*)(L + ((size_t)task * 256 + e) * 128 + d8 * 8);
            const u32x4 lv = *ptr;
            const f32x4 d0 = *(const f32x4*)(dec + task * 128 + d8 * 8), d1 = *(const f32x4*)(dec + task * 128 + d8 * 8 + 4);
            *ptr = (u32x4){pack2(st[0], st[1]), pack2(st[2], st[3]), pack2(st[4], st[5]), pack2(st[6], st[7])};
            st[0] = d0[0] * st[0] + bf_lo(lv.x); st[1] = d0[1] * st[1] + bf_hi(lv.x);
            st[2] = d0[2] * st[2] + bf_lo(lv.y); st[3] = d0[3] * st[3] + bf_hi(lv.y);
            st[4] = d1[0] * st[4] + bf_lo(lv.z); st[5] = d1[1] * st[5] + bf_hi(lv.z);
            st[6] = d1[2] * st[6] + bf_lo(lv.w); st[7] = d1[3] * st[7] + bf_hi(lv.w);
        }
    }
}

__device__ void phaseG3_task(const Params& p, int task, char* lds, bf16_t* ydst, int ystride) {
    const int tid = TIDX, lane = tid & 63, wave = tid >> 6, r = lane & 15, q = lane >> 4;
    const int c = task & 31, h = (task >> 5) & 3, b = task >> 7;
    const int tok0 = b * SEQ + c * 64;
    bf16_t* Z = (bf16_t*)(p.ws + OFF_Z);
    const bf16_t* ST = (const bf16_t*)p.out + (size_t)task * 256 * 128;
    float* bc = (float*)lds;
    bf16_t* vT = (bf16_t*)lds;
    bf16_t* qg = (bf16_t*)(lds + 36864);
    bf16_t* kg = (bf16_t*)(lds + 36864 + 17408);
    bf16_t* P = kg;
    float* red = (float*)(lds + 36864 + 2 * 17408);
    {
        const f32x4* bg = (const f32x4*)(p.ws + OFF_M) + (size_t)task * 2048;
#pragma unroll
        for (int i = 0; i < 8; i++) ((f32x4*)bc)[i * 256 + tid] = bg[i * 256 + tid];
    }
    __syncthreads();
    {
        const int t = tid >> 2, dc = (tid & 3) * 32;
        const bf16_t* qp = Z + (size_t)(tok0 + t) * ZC + ZQ_G + h * 128 + dc;
        const bf16_t* kp = Z + (size_t)(tok0 + t) * ZC + ZK_G + h * 128 + dc;
#pragma unroll
        for (int v4 = 0; v4 < 4; v4++) {
            const u32x4 qv = *(const u32x4*)(qp + v4 * 8), kv = *(const u32x4*)(kp + v4 * 8);
            const unsigned qw[4] = {qv.x, qv.y, qv.z, qv.w}, kw[4] = {kv.x, kv.y, kv.z, kv.w};
            unsigned qo[4], ko[4];
#pragma unroll
            for (int j2 = 0; j2 < 4; j2++) {
                const int d = dc + v4 * 8 + j2 * 2;
                const float b0 = bc[t * 128 + d], b1 = bc[t * 128 + d + 1];
                qo[j2] = pack2(bf_lo(qw[j2]) * 0.08838834764831845f * __expf(b0), bf_hi(qw[j2]) * 0.08838834764831845f * __expf(b1));
                ko[j2] = pack2(bf_lo(kw[j2]) * __expf(-b0), bf_hi(kw[j2]) * __expf(-b1));
            }
            *(u32x4*)(qg + t * 136 + dc + v4 * 8) = (u32x4){qo[0], qo[1], qo[2], qo[3]};
            *(u32x4*)(kg + t * 136 + dc + v4 * 8) = (u32x4){ko[0], ko[1], ko[2], ko[3]};
        }
    }
    __syncthreads();
    {
        const int s = lane, ec = wave * 64;
        const bf16_t* vp = Z + (size_t)(tok0 + s) * ZC + ZV_G + h * 256 + ec;
#pragma unroll
        for (int v4 = 0; v4 < 8; v4++) {
            const u32x4 vv = *(const u32x4*)(vp + v4 * 8);
            const unsigned vw[4] = {vv.x, vv.y, vv.z, vv.w};
#pragma unroll
            for (int j = 0; j < 8; j++) vT[(ec + v4 * 8 + j) * 72 + s] = (bf16_t)((j & 1) ? (vw[j >> 1] >> 16) : (vw[j >> 1] & 0xffffu));
        }
    }
    f32x4 sc[4];
#pragma unroll
    for (int st = 0; st < 4; st++) sc[st] = (f32x4){0.f, 0.f, 0.f, 0.f};
    {
        bf16x8 qf[4];
#pragma unroll
        for (int ks = 0; ks < 4; ks++) qf[ks] = ld_frag(qg + (wave * 16 + r) * 136 + ks * 32 + q * 8);
#pragma unroll
        for (int st = 0; st < 4; st++) {
            if (st <= wave) {
#pragma unroll
                for (int ks = 0; ks < 4; ks++) sc[st] = mfma16(ld_frag(kg + (st * 16 + r) * 136 + ks * 32 + q * 8), qf[ks], sc[st]);
            }
        }
    }
    __syncthreads();
    {
        const int t = wave * 16 + r;
#pragma unroll
        for (int st = 0; st < 4; st++) {
            float pv[4];
#pragma unroll
            for (int j = 0; j < 4; j++) { const int s = st * 16 + 4 * q + j; pv[j] = (s <= t) ? sc[st][j] : 0.f; }
            *(u32x2*)(P + t * 72 + st * 16 + 4 * q) = (u32x2){pack2(pv[0], pv[1]), pack2(pv[2], pv[3])};
        }
    }
    __syncthreads();
    f32x4 o[4][4];
#pragma unroll
    for (int et = 0; et < 4; et++)
#pragma unroll
        for (int tt = 0; tt < 4; tt++) o[et][tt] = (f32x4){0.f, 0.f, 0.f, 0.f};
#pragma unroll
    for (int ks = 0; ks < 2; ks++) {
        bf16x8 pf[4];
#pragma unroll
        for (int tt = 0; tt < 4; tt++) pf[tt] = ld_frag(P + (tt * 16 + r) * 72 + ks * 32 + q * 8);
#pragma unroll
        for (int et = 0; et < 4; et++) {
            const bf16x8 a = ld_frag(vT + ((wave * 4 + et) * 16 + r) * 72 + ks * 32 + q * 8);
#pragma unroll
            for (int tt = 0; tt < 4; tt++) o[et][tt] = mfma16(a, pf[tt], o[et][tt]);
        }
    }
#pragma unroll
    for (int ks = 0; ks < 4; ks++) {
        bf16x8 qf[4];
#pragma unroll
        for (int tt = 0; tt < 4; tt++) qf[tt] = ld_frag(qg + (tt * 16 + r) * 136 + ks * 32 + q * 8);
#pragma unroll
        for (int et = 0; et < 4; et++) {
            const bf16x8 a = *(const bf16x8*)(ST + (size_t)((wave * 4 + et) * 16 + r) * 128 + ks * 32 + q * 8);
#pragma unroll
            for (int tt = 0; tt < 4; tt++) o[et][tt] = mfma16(a, qf[tt], o[et][tt]);
        }
    }
#pragma unroll
    for (int tt = 0; tt < 4; tt++) {
        float ss = 0.f;
#pragma unroll
        for (int et = 0; et < 4; et++)
#pragma unroll
            for (int j = 0; j < 4; j++) ss += o[et][tt][j] * o[et][tt][j];
        ss += __shfl_xor(ss, 16, 64);
        ss += __shfl_xor(ss, 32, 64);
        if (q == 0) red[wave * 64 + tt * 16 + r] = ss;
    }
    __syncthreads();
#pragma unroll
    for (int tt = 0; tt < 4; tt++) {
        const int t = tt * 16 + r;
        const float tot = red[t] + red[64 + t] + red[128 + t] + red[192 + t];
        const float rstd = rsqrtf(tot * (1.f / 256.f) + 1e-6f);
#pragma unroll
        for (int et = 0; et < 4; et++) {
            const int e = (wave * 4 + et) * 16 + 4 * q;
            bf16_t* rp = Z + (size_t)(tok0 + t) * ZC + ZR_G + h * 256 + e;
            const u32x2 rv = *(const u32x2*)rp;
            const f32x4 gn = *(const f32x4*)(p.gla_norm_g + e);
            const float r0 = bf_lo(rv.x), r1 = bf_hi(rv.x), r2 = bf_lo(rv.y), r3 = bf_hi(rv.y);
            const f32x4 ov = o[et][tt];
            *(u32x2*)(ydst + (size_t)(tok0 + t) * ystride + h * 256 + e) = (u32x2){pack2(ov[0] * rstd * gn[0] * siluf_(r0), ov[1] * rstd * gn[1] * siluf_(r1)),
                                  pack2(ov[2] * rstd * gn[2] * siluf_(r2), ov[3] * rstd * gn[3] * siluf_(r3))};
        }
    }
    __syncthreads();
}

__device__ void phaseN1_task(const Params& p, int task, char* lds) {
    const int tid = TIDX, lane = tid & 63, wave = tid >> 6, r = lane & 15, q = lane >> 4;
    const int it = task & 15, g = (task >> 4) & 1, b = (task >> 5) & 7, kv = task >> 8;
    const bf16_t* Z = (const bf16_t*)(p.ws + OFF_Z);
    const bf16_t* W1 = (const bf16_t*)(p.ws + OFF_WC1) + (size_t)kv * 64 * 2048;
    const float* pe = kv ? p.pe_v : p.pe_k;
    const float* w2 = kv ? p.cv_w2 : p.ck_w2;
    const int zoff = (kv ? ZVC : ZKC) + g * 64;
    float* hid = (float*)lds;
    float* hid2 = (float*)(lds + 16384);
    int i = it * 8 + (r & 7); if (i > 126) i = 126;
    f32x4 acc[4];
#pragma unroll
    for (int nt = 0; nt < 4; nt++) acc[nt] = (f32x4){0.f, 0.f, 0.f, 0.f};
    for (int ks = 0; ks < 16; ks++) {
        const int k = wave * 512 + ks * 32 + q * 8;
        const int l = k >> 6, d = k & 63;
        const u32x4 zv = *(const u32x4*)(Z + (size_t)(b * SEQ + i * 16 + l) * ZC + zoff + d);
        const f32x4 p0 = *(const f32x4*)(pe + l * 64 + d), p1 = *(const f32x4*)(pe + l * 64 + d + 4);
        const u32x4 av = {pack2(bf_lo(zv.x) + p0[0], bf_hi(zv.x) + p0[1]), pack2(bf_lo(zv.y) + p0[2], bf_hi(zv.y) + p0[3]),
                          pack2(bf_lo(zv.z) + p1[0], bf_hi(zv.z) + p1[1]), pack2(bf_lo(zv.w) + p1[2], bf_hi(zv.w) + p1[3])};
        const bf16x8 a = __builtin_bit_cast(bf16x8, av);
#pragma unroll
        for (int nt = 0; nt < 4; nt++) {
            const bf16x8 bw = *(const bf16x8*)(W1 + (size_t)(nt * 16 + r) * 2048 + k);
            acc[nt] = mfma16(a, bw, acc[nt]);
        }
    }
#pragma unroll
    for (int nt = 0; nt < 4; nt++)
#pragma unroll
        for (int j = 0; j < 4; j++) hid[(wave * 16 + 4 * q + j) * 64 + nt * 16 + r] = acc[nt][j];
    __syncthreads();
    for (int e = tid; e < 1024; e += NTHREADS) hid2[e] = gelu_erf(hid[e] + hid[1024 + e] + hid[2048 + e] + hid[3072 + e]);
    __syncthreads();
    {
        const int il = tid >> 4, n2 = (tid & 15) * 4;
        f32x4 o = {0.f, 0.f, 0.f, 0.f};
        for (int n = 0; n < 64; n++) {
            const float hv = hid2[il * 64 + n];
            const f32x4 wv = *(const f32x4*)(w2 + n * 64 + n2);
            o += hv * wv;
        }
        const int ig = it * 8 + il;
        if (ig >= 127) o = (f32x4){0.f, 0.f, 0.f, 0.f};
        bf16_t* dst = (bf16_t*)(p.ws + OFF_CMP) + ((size_t)((kv * 8 + b) * 2 + g) * 128 + ig) * 64 + n2;
        if (il < 8) *(u32x2*)dst = (u32x2){pack2(o[0], o[1]), pack2(o[2], o[3])};
    }
    __syncthreads();
}

__device__ __forceinline__ void nsa_block_step(const bf16_t* Ks, const bf16_t* VT, const bf16x8 (&qf)[2][2], f32x4 (&O)[2][4], float (&m)[2], float (&l)[2],
                                               int klo, int khi, int r, int q) {
    f32x4 s[2][4];
#pragma unroll
    for (int x = 0; x < 2; x++)
#pragma unroll
        for (int kt = 0; kt < 4; kt++) s[x][kt] = (f32x4){0.f, 0.f, 0.f, 0.f};
#pragma unroll
    for (int kt = 0; kt < 4; kt++)
#pragma unroll
        for (int ks = 0; ks < 2; ks++) {
            const bf16x8 kf = ld_frag(Ks + (kt * 16 + r) * 64 + (((ks * 4 + q) ^ (r & 7)) * 8));
#pragma unroll
            for (int x = 0; x < 2; x++) s[x][kt] = mfma16(kf, qf[x][ks], s[x][kt]);
        }
    if (!__all((klo <= 0) && (khi >= 63))) {
        const int a = 4 * q - klo;
        const unsigned range = (unsigned)(khi - klo);
        const bool any = khi >= klo;
#pragma unroll
        for (int kt = 0; kt < 4; kt++)
#pragma unroll
            for (int j = 0; j < 4; j++) {
                const bool valid = any && ((unsigned)(kt * 16 + j + a) <= range);
#pragma unroll
                for (int x = 0; x < 2; x++) s[x][kt][j] = valid ? s[x][kt][j] : -3.0e38f;
            }
    }
    bf16x8 pbv[2][2];
#pragma unroll
    for (int x = 0; x < 2; x++) {
        float mx = fmaxf(fmaxf(fmaxf(s[x][0][0], s[x][0][1]), fmaxf(s[x][0][2], s[x][0][3])), fmaxf(fmaxf(s[x][1][0], s[x][1][1]), fmaxf(s[x][1][2], s[x][1][3])));
        mx = fmaxf(mx, fmaxf(fmaxf(fmaxf(s[x][2][0], s[x][2][1]), fmaxf(s[x][2][2], s[x][2][3])), fmaxf(fmaxf(s[x][3][0], s[x][3][1]), fmaxf(s[x][3][2], s[x][3][3]))));
        mx = fmaxf(mx, __shfl_xor(mx, 16, 64));
        mx = fmaxf(mx, __shfl_xor(mx, 32, 64));
        const float mnew = fmaxf(m[x], mx);
        const float alpha = exp2f_(m[x] - mnew);
        m[x] = mnew;
        float ls = 0.f;
#pragma unroll
        for (int kt = 0; kt < 4; kt++)
#pragma unroll
            for (int j = 0; j < 4; j++) { const float pv = exp2f_(s[x][kt][j] - mnew); s[x][kt][j] = pv; ls += pv; }
        l[x] = l[x] * alpha + ls;
#pragma unroll
        for (int dt = 0; dt < 4; dt++) O[x][dt] *= alpha;
#pragma unroll
        for (int s2 = 0; s2 < 2; s2++) {
            const u32x4 t4 = {pack2(s[x][2 * s2][0], s[x][2 * s2][1]), pack2(s[x][2 * s2][2], s[x][2 * s2][3]),
                              pack2(s[x][2 * s2 + 1][0], s[x][2 * s2 + 1][1]), pack2(s[x][2 * s2 + 1][2], s[x][2 * s2 + 1][3])};
            pbv[x][s2] = __builtin_bit_cast(bf16x8, t4);
        }
    }
#pragma unroll
    for (int s2 = 0; s2 < 2; s2++)
#pragma unroll
        for (int dt = 0; dt < 4; dt++) {
            const u32x2 lo = *(const u32x2*)(VT + (dt * 16 + r) * 72 + (2 * s2) * 16 + 4 * q);
            const u32x2 hi = *(const u32x2*)(VT + (dt * 16 + r) * 72 + (2 * s2 + 1) * 16 + 4 * q);
            const bf16x8 va = mk_frag(lo, hi);
#pragma unroll
            for (int x = 0; x < 2; x++) O[x][dt] = mfma16(va, pbv[x][s2], O[x][dt]);
        }
}

__device__ __forceinline__ void nsa_cmp_probs(const bf16_t* Kc, const bf16x8 (&qfx)[2], int nv, int r, int q, f32x4 (&s)[8]) {
#pragma unroll
    for (int kt = 0; kt < 8; kt++) s[kt] = (f32x4){0.f, 0.f, 0.f, 0.f};
#pragma unroll
    for (int kt = 0; kt < 8; kt++)
#pragma unroll
        for (int ks = 0; ks < 2; ks++) s[kt] = mfma16(ld_frag(Kc + (kt * 16 + r) * 72 + ks * 32 + q * 8), qfx[ks], s[kt]);
    float mx = -1e30f;
#pragma unroll
    for (int kt = 0; kt < 8; kt++)
#pragma unroll
        for (int j = 0; j < 4; j++) if (kt * 16 + 4 * q + j < nv) mx = fmaxf(mx, s[kt][j]);
    mx = fmaxf(mx, __shfl_xor(mx, 16, 64));
    mx = fmaxf(mx, __shfl_xor(mx, 32, 64));
    float ls = 0.f;
#pragma unroll
    for (int kt = 0; kt < 8; kt++)
#pragma unroll
        for (int j = 0; j < 4; j++) {
            const float pv = (kt * 16 + 4 * q + j < nv) ? exp2f_(s[kt][j] - mx) : 0.f;
            s[kt][j] = pv; ls += pv;
        }
    ls += __shfl_xor(ls, 16, 64);
    ls += __shfl_xor(ls, 32, 64);
    const float inv = nv > 0 ? 1.f / ls : 0.f;
#pragma unroll
    for (int kt = 0; kt < 8; kt++) s[kt] *= inv;
}

__device__ void phaseN2_task(const Params& p, int task, char* lds, bf16_t* ydst, int ystride, volatile unsigned* uex, char* ldsb) {
    const int tid = TIDX, lane = tid & 63, wave = tid >> 6, r = lane & 15, q = lane >> 4;
    const int t512 = tid + half_id() * 256;
    const int pair = task >> 1, g = pair & 1, b = (pair >> 1) & 7;
    const int hi_ = pair >> 4, kq_ = hi_ >> 4, aa_ = hi_ & 15;
    const int tpi_ = kq_ == 0 ? 63 - aa_ : (kq_ == 1 ? 32 + aa_ : (kq_ == 2 ? 31 - aa_ : aa_));
    const int tt = tpi_ * 2 + (task & 1);
    const int t0 = tt * 16, t = t0 + r;
    const int cur = t0 >> 6;
    bf16_t* Z = (bf16_t*)(p.ws + OFF_Z);
    const size_t rowb = (size_t)b * SEQ;
    bf16_t* Kc = (bf16_t*)ldsb;
    bf16_t* VcT = (bf16_t*)(ldsb + 18432);
    bf16_t* Ks = (bf16_t*)ldsb;
    bf16_t* VT = (bf16_t*)(ldsb + 18432);
    float* impw = (float*)(lds + 35840);
    float* scs = (float*)(lds + 35840 + 32768);
    unsigned* selm = (unsigned*)(lds + 35840 + 32768 + 2048);

    bf16x8 qf[2][2];
#pragma unroll
    for (int x = 0; x < 2; x++)
#pragma unroll
        for (int ks = 0; ks < 2; ks++) qf[x][ks] = *(const bf16x8*)(Z + (rowb + t) * ZC + ZQ_N + (g * 8 + 2 * wave + x) * 64 + ks * 32 + q * 8);
    f32x4* ofl = (f32x4*)(lds + 35840);

    f32x4 Og[2][4];
    {
        const bf16_t* kc = (const bf16_t*)(p.ws + OFF_CMP) + (size_t)((0 * 8 + b) * 2 + g) * 128 * 64;
        const bf16_t* vc = (const bf16_t*)(p.ws + OFF_CMP) + (size_t)((1 * 8 + b) * 2 + g) * 128 * 64;
        {
            const int key = t512 >> 2, ch = (t512 & 3) * 16;
#pragma unroll
            for (int v4 = 0; v4 < 2; v4++) *(u32x4*)(Kc + key * 72 + ch + v4 * 8) = *(const u32x4*)(kc + key * 64 + ch + v4 * 8);
            const int k2 = t512 & 127, dc = (t512 >> 7) * 16;
#pragma unroll
            for (int v4 = 0; v4 < 2; v4++) {
                const u32x4 a = *(const u32x4*)(vc + k2 * 64 + dc + v4 * 8);
                const unsigned w[4] = {a.x, a.y, a.z, a.w};
#pragma unroll
                for (int j = 0; j < 8; j++) VcT[(dc + v4 * 8 + j) * 136 + k2] = (bf16_t)((j & 1) ? (w[j >> 1] >> 16) : (w[j >> 1] & 0xffffu));
            }
        }
        __syncthreads();
        int nv = t >= 31 ? ((t - 31) >> 4) + 1 : 0;
        if (nv > 127) nv = 127;
        f32x4 isum[8];
#pragma unroll
        for (int kt = 0; kt < 8; kt++) isum[kt] = (f32x4){0.f, 0.f, 0.f, 0.f};
#pragma unroll
        for (int x = 0; x < 2; x++) {
            f32x4 s[8];
            nsa_cmp_probs(Kc, qf[x], nv, r, q, s);
#pragma unroll
            for (int kt = 0; kt < 8; kt++) isum[kt] += s[kt];
            f32x4 Oc[4];
#pragma unroll
            for (int dt = 0; dt < 4; dt++) Oc[dt] = (f32x4){0.f, 0.f, 0.f, 0.f};
            __builtin_amdgcn_sched_barrier(0);
#pragma unroll
            for (int s2 = 0; s2 < 4; s2++) {
                const u32x4 t4 = {pack2(s[2 * s2][0], s[2 * s2][1]), pack2(s[2 * s2][2], s[2 * s2][3]),
                                  pack2(s[2 * s2 + 1][0], s[2 * s2 + 1][1]), pack2(s[2 * s2 + 1][2], s[2 * s2 + 1][3])};
                const bf16x8 pbv = __builtin_bit_cast(bf16x8, t4);
#pragma unroll
                for (int dt = 0; dt < 4; dt++) {
                    const u32x2 lo = *(const u32x2*)(VcT + (dt * 16 + r) * 136 + (2 * s2) * 16 + 4 * q);
                    const u32x2 hi = *(const u32x2*)(VcT + (dt * 16 + r) * 136 + (2 * s2 + 1) * 16 + 4 * q);
                    Oc[dt] = mfma16(mk_frag(lo, hi), pbv, Oc[dt]);
                }
            }
            const float g0 = sigmoidf_(bf2f(Z[(rowb + t) * ZC + ZGATE + 0 * 16 + g * 8 + 2 * wave + x]));
#pragma unroll
            for (int dt = 0; dt < 4; dt++) Og[x][dt] = g0 * Oc[dt];
            __builtin_amdgcn_sched_barrier(0);
        }
#pragma unroll
        for (int kt = 0; kt < 8; kt++) *(f32x4*)(impw + (wave * 16 + r) * 128 + kt * 16 + 4 * q) = isum[kt];
        __syncthreads();
#pragma unroll
        for (int pass = 0; pass < 2; pass++) {
            const int tk = pass * 8 + (tid >> 5), j = tid & 31;
            const int i0 = j == 0 ? 0 : 4 * j - 1, i1 = (4 * j + 3 > 126) ? 126 : 4 * j + 3;
            float sc = 0.f;
            for (int i = i0; i <= i1; i++) sc += (impw[(0 * 16 + tk) * 128 + i] + impw[(1 * 16 + tk) * 128 + i]) + (impw[(2 * 16 + tk) * 128 + i] + impw[(3 * 16 + tk) * 128 + i]);
            const bool forced = (j == 0) || (j == cur) || (j == cur - 1);
            scs[tk * 32 + j] = forced ? 1e6f : (j <= cur ? sc : -1.f);
        }
        __syncthreads();
#pragma unroll
        for (int pass = 0; pass < 2; pass++) {
            const int tk = pass * 8 + (tid >> 5), j = tid & 31;
            const float mine = scs[tk * 32 + j];
            int rank = 0;
            for (int j2 = 0; j2 < 32; j2++) { const float o = scs[tk * 32 + j2]; rank += (o > mine || (o == mine && j2 < j)) ? 1 : 0; }
            const unsigned long long bal = __ballot(rank < 16);
            if ((lane & 31) == 0) selm[tk] = (unsigned)(lane ? (bal >> 32) : (bal & 0xffffffffull));
        }
        __syncthreads();
    }
#pragma unroll
    for (int x = 0; x < 2; x++)
#pragma unroll
        for (int dt = 0; dt < 4; dt++) ofl[(wave * 8 + x * 4 + dt) * 64 + lane] = Og[x][dt];
    const unsigned mysel = selm[r];
    unsigned uni = 0;
#pragma unroll
    for (int i = 0; i < 16; i++) uni |= selm[i];
    if (tid == 0) uex[half_id()] = uni;
    __syncthreads();
    uni = uex[0] | uex[1];
    uni &= (cur == 31) ? 0xffffffffu : ((2u << cur) - 1u);
    uni |= 1u;

    {
        const int lo = (t0 & ~31) - 511;
        const int jb0 = lo > 0 ? (lo >> 6) : 0;
        const int kkey = t512 >> 3, kch = (t512 & 7) * 8;
        const int vd = t512 >> 3, vch = (t512 & 7) * 8;
        const bf16_t* vtb = (const bf16_t*)(p.ws + OFF_VT) + ((size_t)(b * 2 + g) * 64 + vd) * SEQ + vch;
        u32x4 kreg, vreg;
        int br = 0, j = 0;
        {
            const bf16_t* kb = Z + (rowb + 0) * ZC + ZKS + g * 64;
            kreg = *(const u32x4*)(kb + (size_t)kkey * ZC + kch);
            vreg = *(const u32x4*)(vtb);
        }
        f32x4 O[2][4];
        float m[2] = {-1e30f, -1e30f}, l[2] = {0.f, 0.f};
#pragma unroll
        for (int x = 0; x < 2; x++)
#pragma unroll
            for (int dt = 0; dt < 4; dt++) O[x][dt] = (f32x4){0.f, 0.f, 0.f, 0.f};
        for (;;) {
            __syncthreads();
            *(u32x4*)(Ks + kkey * 64 + (((kch >> 3) ^ (kkey & 7)) * 8)) = kreg;
            *(u32x4*)(VT + vd * 72 + vch) = vreg;
            __syncthreads();
            int nbr, nj;
            if (br == 0) {
                const unsigned rem = (j >= 31) ? 0u : (uni & ~((2u << j) - 1u));
                if (rem) { nbr = 0; nj = __ffs((int)rem) - 1; } else { nbr = 1; nj = jb0; }
            } else {
                if (j < cur) { nbr = 1; nj = j + 1; } else { nbr = 2; nj = 0; }
            }
            if (nbr < 2) {
                const bf16_t* kb = Z + (rowb + nj * 64) * ZC + (nbr ? ZKW : ZKS) + g * 64;
                kreg = *(const u32x4*)(kb + (size_t)kkey * ZC + kch);
                vreg = *(const u32x4*)(vtb + (size_t)nbr * (8 * 2 * 64) * SEQ + nj * 64);
            }
            int klo = 0, khi = -1;
            if (br == 0) { if ((mysel >> j) & 1u) khi = t - j * 64; }
            else { khi = t - j * 64; klo = t - 511 - j * 64; }
            klo = klo < 0 ? 0 : klo;
            khi = khi > 63 ? 63 : khi;
            nsa_block_step(Ks, VT, qf, O, m, l, klo, khi, r, q);
            if (nbr != br) {
#pragma unroll
                for (int x = 0; x < 2; x++) {
                    float lt = l[x];
                    lt += __shfl_xor(lt, 16, 64);
                    lt += __shfl_xor(lt, 32, 64);
                    const float sc = sigmoidf_(bf2f(Z[(rowb + t) * ZC + ZGATE + (br + 1) * 16 + g * 8 + 2 * wave + x])) / lt;
#pragma unroll
                    for (int dt = 0; dt < 4; dt++) { ofl[(wave * 8 + x * 4 + dt) * 64 + lane] += sc * O[x][dt]; O[x][dt] = (f32x4){0.f, 0.f, 0.f, 0.f}; }
                    m[x] = -1e30f; l[x] = 0.f;
                }
            }
            if (nbr == 2) break;
            br = nbr; j = nj;
        }
#pragma unroll
        for (int x = 0; x < 2; x++)
#pragma unroll
            for (int dt = 0; dt < 4; dt++) {
                const f32x4 v = ofl[(wave * 8 + x * 4 + dt) * 64 + lane];
                *(u32x2*)(ydst + (rowb + t) * ystride + (g * 8 + 2 * wave + x) * 64 + dt * 16 + 4 * q) = (u32x2){pack2(v[0], v[1]), pack2(v[2], v[3])};
            }
    }
    __syncthreads();
}

__device__ void phaseM1(const Params& p, char* lds) {
    const int tid_ = TIDX512; const int lane = tid_ & 63, wave = tid_ >> 6;
    const int wr = wave >> 2, wc = wave & 3, r = lane & 15, q = lane >> 4;
    const bf16_t* H = (const bf16_t*)(p.ws + OFF_H);
    const bf16_t* Z = (const bf16_t*)(p.ws + OFF_Z);
    bf16_t* M = (bf16_t*)(p.ws + OFF_M);
    u32x4* SG = (u32x4*)p.out;
    u32x4* PA = (u32x4*)((char*)p.out + 33554432);
    TileIter tit(4, lds);
    int bm, bn;
    while (tit.next(bm, bn)) {
        const int m0 = bm * 256, n0 = bn * 256;
        const int pbase = launder_i(((bm * 4 + bn) * 16) * 512 + tid_);
        for (int br = 0; br < 2; br++) {
            f32x4 acc[8][4];
            zero_acc(acc);
            gemm_core(acc, H, DM, (const bf16_t*)(p.ws + OFF_WM) + (size_t)br * 1024 * 1024, DM, DM, m0, n0, lds);
            {
#pragma unroll
                for (int mi = 0; mi < 8; mi++)
#pragma unroll
                    for (int nh = 0; nh < 2; nh++) {
                        const f32x4 a0 = acc[mi][2 * nh], a1 = acc[mi][2 * nh + 1];
                        SG[(size_t)pbase + (mi * 2 + nh) * 512] = (u32x4){pack2(sigmoidf_(a0[0]), sigmoidf_(a0[1])), pack2(sigmoidf_(a0[2]), sigmoidf_(a0[3])),
                                                                          pack2(sigmoidf_(a1[0]), sigmoidf_(a1[1])), pack2(sigmoidf_(a1[2]), sigmoidf_(a1[3]))};
                    }
            }
            zero_acc(acc);
            gemm_core(acc, Z + (br ? ZQ_N : ZR_G), ZC, (const bf16_t*)(p.ws + (br ? OFF_WB : OFF_WA)), DM, DM, m0, n0, lds);
            if (br == 0) {
#pragma unroll
                for (int mi = 0; mi < 8; mi++)
#pragma unroll
                    for (int nh = 0; nh < 2; nh++) {
                        const u32x4 sg = SG[(size_t)pbase + (mi * 2 + nh) * 512];
                        const f32x4 a0 = acc[mi][2 * nh], a1 = acc[mi][2 * nh + 1];
                        PA[(size_t)pbase + (mi * 2 + nh) * 512] = (u32x4){pack2(bf_lo(sg.x) * a0[0], bf_hi(sg.x) * a0[1]), pack2(bf_lo(sg.y) * a0[2], bf_hi(sg.y) * a0[3]),
                                                                          pack2(bf_lo(sg.z) * a1[0], bf_hi(sg.z) * a1[1]), pack2(bf_lo(sg.w) * a1[2], bf_hi(sg.w) * a1[3])};
                    }
            } else {
#pragma unroll
                for (int mi = 0; mi < 8; mi++)
#pragma unroll
                    for (int nh = 0; nh < 2; nh++) {
                        const u32x4 sg = SG[(size_t)pbase + (mi * 2 + nh) * 512];
                        const u32x4 pv = PA[(size_t)pbase + (mi * 2 + nh) * 512];
                        const f32x4 a0 = acc[mi][2 * nh], a1 = acc[mi][2 * nh + 1];
                        epi_fill(lds, wr, wc, r, q, mi, 2 * nh, (f32x4){bf_lo(sg.x) * a0[0] + bf_lo(pv.x), bf_hi(sg.x) * a0[1] + bf_hi(pv.x),
                                                                         bf_lo(sg.y) * a0[2] + bf_lo(pv.y), bf_hi(sg.y) * a0[3] + bf_hi(pv.y)});
                        epi_fill(lds, wr, wc, r, q, mi, 2 * nh + 1, (f32x4){bf_lo(sg.z) * a1[0] + bf_lo(pv.z), bf_hi(sg.z) * a1[1] + bf_hi(pv.z),
                                                                             bf_lo(sg.w) * a1[2] + bf_lo(pv.w), bf_hi(sg.w) * a1[3] + bf_hi(pv.w)});
                    }
                __syncthreads();
                epi_store(lds, M, DM, m0, n0, DM);
                __syncthreads();
            }
        }
    }
}

__device__ void phaseM2(const Params& p, char* lds) {
    const int tid_ = TIDX512; const int lane = tid_ & 63, wave = tid_ >> 6;
    const int wr = wave >> 2, wc = wave & 3, r = lane & 15, q = lane >> 4;
    const bf16_t* M = (const bf16_t*)(p.ws + OFF_M);
    const float* mod = (const float*)(p.ws + OFF_MOD);
    TileIter tit(4, lds);
    int bm, bn;
    while (tit.next(bm, bn)) {
        const int m0 = bm * 256, n0 = bn * 256;
        f32x4 acc[8][4];
        zero_acc(acc);
        gemm_core(acc, M, DM, (const bf16_t*)(p.ws + OFF_WO), DM, DM, m0, n0, lds);
#pragma unroll
        for (int mi = 0; mi < 8; mi++)
#pragma unroll
            for (int ni = 0; ni < 4; ni++) {
                const int tok = m0 + wr * 128 + mi * 16 + r, col = n0 + wc * 64 + ni * 16 + 4 * q;
                const f32x4 xv = *(const f32x4*)(p.x + (size_t)tok * DM + col);
                const f32x4 gt = *(const f32x4*)(mod + (tok >> 11) * 6144 + 2 * 1024 + col);
                *(f32x4*)(p.out + (size_t)tok * DM + col) = xv + gt * acc[mi][ni];
            }
    }
    {
        const int tid_ = TIDX; const int lane = tid_ & 63, wave = tid_ >> 6;
        unsigned char* tq = (unsigned char*)(p.ws + OFF_UB);
        float* tsc = (float*)(p.ws + OFF_UB + 33554432);
        for (int row = vblk() * 4 + wave; row < 32768; row += vgrid() * 4) {
            const bool isv = row >= 16384;
            const float* srcp = (isv ? p.peer_v : p.peer_u) + (size_t)(row & 16383) * DM + lane * 16;
            f32x4 a[4];
            float mx = 0.f;
#pragma unroll
            for (int i = 0; i < 4; i++) {
                a[i] = *(const f32x4*)(srcp + i * 4);
                mx = fmaxf(mx, fmaxf(fmaxf(fabsf(a[i][0]), fabsf(a[i][1])), fmaxf(fabsf(a[i][2]), fabsf(a[i][3]))));
            }
            mx = wave_max(mx);
            const float inv = mx > 0.f ? 127.f / mx : 0.f;
            const int off = isv ? 128 : 0;
            unsigned w[4];
#pragma unroll
            for (int i = 0; i < 4; i++) {
                unsigned pk = 0;
#pragma unroll
                for (int j = 0; j < 4; j++) {
                    int qi = (int)rintf(a[i][j] * inv);
                    qi = qi > 127 ? 127 : (qi < -127 ? -127 : qi);
                    pk |= ((unsigned)(qi + off) & 0xffu) << (8 * j);
                }
                w[i] = pk;
            }
            *(u32x4*)(tq + (size_t)row * DM + lane * 16) = (u32x4){w[0], w[1], w[2], w[3]};
            if (lane == 0) tsc[row] = mx * (1.f / 127.f);
        }
    }
}

__device__ void phaseP1(const Params& p, char* lds) {
    const int tid_ = TIDX512; const int lane = tid_ & 63, wave = tid_ >> 6;
    const int wr = wave >> 2, wc = wave & 3, r = lane & 15, q = lane >> 4;
    const bf16_t* H = (const bf16_t*)(p.ws + OFF_H);
    bf16_t* QP = (bf16_t*)(p.ws + OFF_QP);
    TileIter tit(8, lds);
    int bm, bn;
    while (tit.next(bm, bn)) {
        const int m0 = bm * 256, n0 = bn * 256;
        f32x4 acc[8][4];
        zero_acc(acc);
        gemm_core(acc, H, DM, (const bf16_t*)(p.ws + OFF_WQ), DM, DM, m0, n0, lds);
#pragma unroll
        for (int mi = 0; mi < 8; mi++)
#pragma unroll
            for (int ni = 0; ni < 4; ni++) epi_fill(lds, wr, wc, r, q, mi, ni, acc[mi][ni]);
        __syncthreads();
        epi_store(lds, QP, 2048, m0, n0, 2048);
        __syncthreads();
    }
}

__constant__ unsigned char c_cand_a[64] = {0,0,0,0,0,0,0,0,0,0,0,0,0,0,0,0, 1,1,1,1,1,1,1,1, 2,2,2,2,2, 3,3,3,3, 4,4,4, 5,5, 6,6, 7,7, 8,9,10,11,12,13,14,15, 0,0,0,0,0,0,0,0,0,0,0,0,0,0};
__constant__ unsigned char c_cand_b[64] = {0,1,2,3,4,5,6,7,8,9,10,11,12,13,14,15, 0,1,2,3,4,5,6,7, 0,1,2,3,4, 0,1,2,3, 0,1,2, 0,1, 0,1, 0,1, 0,0,0,0,0,0,0,0, 0,0,0,0,0,0,0,0,0,0,0,0,0,0};

__device__ __forceinline__ unsigned f2key(float f) { const unsigned u = __float_as_uint(f); return (u & 0x80000000u) ? ~u : (u | 0x80000000u); }
__device__ __forceinline__ float key2f(unsigned k) { const unsigned u = (k & 0x80000000u) ? (k & 0x7fffffffu) : ~k; return __uint_as_float(u); }
__device__ __forceinline__ void cex_desc(unsigned& a, unsigned& b) { const unsigned hi = a > b ? a : b, lo = a > b ? b : a; a = hi; b = lo; }
__device__ __forceinline__ void sort16_desc(unsigned (&a)[16]) {
#pragma unroll
    for (int k = 2; k <= 16; k <<= 1)
#pragma unroll
        for (int j = k >> 1; j > 0; j >>= 1)
#pragma unroll
            for (int i = 0; i < 16; i++) {
                const int l = i ^ j;
                if (l > i) { if ((i & k) == 0) cex_desc(a[i], a[l]); else cex_desc(a[l], a[i]); }
            }
}
__device__ __forceinline__ void merge16_desc(unsigned (&a)[16], const unsigned (&b)[16]) {
#pragma unroll
    for (int i = 0; i < 16; i++) a[i] = a[i] > b[15 - i] ? a[i] : b[15 - i];
#pragma unroll
    for (int j = 8; j > 0; j >>= 1)
#pragma unroll
        for (int i = 0; i < 16; i++) { const int l = i ^ j; if (l > i) cex_desc(a[i], a[l]); }
}

__device__ void phaseP2_task(const Params& p, int task, char* lds) {
    const int tid = TIDX, lane = tid & 63, wave = tid >> 6, r = lane & 15, q = lane >> 4;
    const int h = task & 7, tile = task >> 3;
    const int tok0 = tile * 64;
    const bf16_t* QP = (const bf16_t*)(p.ws + OFF_QP);
    float* S = (float*)lds;
    unsigned* LL = (unsigned*)(lds + 65536);
    {
        const bf16_t* qrow = QP + (size_t)(tok0 + wave * 16 + r) * 2048 + h * 256 + q * 8;
        bf16x8 bq[2][4];
#pragma unroll
        for (int half = 0; half < 2; half++)
#pragma unroll
            for (int ks = 0; ks < 4; ks++) bq[half][ks] = *(const bf16x8*)(qrow + half * 128 + ks * 32);
#pragma unroll
        for (int half = 0; half < 2; half++) {
            const bf16_t* KB = (const bf16_t*)(p.ws + OFF_K1B) + (size_t)half * 131072 + (size_t)h * 128 * 128 + (size_t)r * 128 + q * 8;
            f32x4 acc[8];
#pragma unroll
            for (int nt = 0; nt < 8; nt++) acc[nt] = (f32x4){0.f, 0.f, 0.f, 0.f};
            bf16x8 ak[8];
#pragma unroll
            for (int nt = 0; nt < 8; nt++) ak[nt] = *(const bf16x8*)(KB + (size_t)nt * 16 * 128);
#pragma unroll
            for (int ks = 0; ks < 4; ks++) {
                bf16x8 an[8];
                if (ks + 1 < 4) {
#pragma unroll
                    for (int nt = 0; nt < 8; nt++) an[nt] = *(const bf16x8*)(KB + (size_t)nt * 16 * 128 + (ks + 1) * 32);
                }
#pragma unroll
                for (int nt = 0; nt < 8; nt++) acc[nt] = mfma16(ak[nt], bq[half][ks], acc[nt]);
                if (ks + 1 < 4) {
#pragma unroll
                    for (int nt = 0; nt < 8; nt++) ak[nt] = an[nt];
                }
            }
#pragma unroll
            for (int nt = 0; nt < 8; nt++)
#pragma unroll
                for (int j = 0; j < 4; j++) S[(half * 128 + nt * 16 + 4 * q + j) * 64 + wave * 16 + r] = acc[nt][j];
        }
    }
    __syncthreads();
    {
        const int row = tid & 127, part = tid >> 7, half = row >> 6, tk = row & 63;
        unsigned L[16];
        const float* sp = S + (half * 128 + part * 64) * 64 + tk;
#pragma unroll
        for (int k = 0; k < 16; k++) L[k] = (f2key(sp[k * 64]) & ~127u) | (unsigned)(127 - (part * 64 + k));
        sort16_desc(L);
        for (int gq = 1; gq < 4; gq++) {
            unsigned G[16];
#pragma unroll
            for (int k = 0; k < 16; k++) G[k] = (f2key(sp[(gq * 16 + k) * 64]) & ~127u) | (unsigned)(127 - (part * 64 + gq * 16 + k));
            sort16_desc(G);
            merge16_desc(L, G);
        }
        __syncthreads();
        unsigned* LP = (unsigned*)lds;
#pragma unroll
        for (int k = 0; k < 16; k++) LP[((part * 2 + half) * 16 + k) * 64 + tk] = L[k];
        __syncthreads();
        if (tid < 128) {
            unsigned A[16], Bq[16];
#pragma unroll
            for (int k = 0; k < 16; k++) { A[k] = LP[((0 * 2 + half) * 16 + k) * 64 + tk]; Bq[k] = LP[((1 * 2 + half) * 16 + k) * 64 + tk]; }
            merge16_desc(A, Bq);
#pragma unroll
            for (int k = 0; k < 16; k++) LL[(half * 16 + k) * 64 + tk] = A[k];
        }
    }
    __syncthreads();
    if (tid < 64) {
        const int tk = tid;
        float v1[16], v2[16];
#pragma unroll
        for (int k = 0; k < 16; k++) { v1[k] = key2f(LL[k * 64 + tk] & ~127u); v2[k] = key2f(LL[(16 + k) * 64 + tk] & ~127u); }
        unsigned C[64];
#pragma unroll
        for (int k = 0; k < 64; k++) C[k] = 0u;
        {
            int c = 0;
#pragma unroll
            for (int a = 0; a < 16; a++)
#pragma unroll
                for (int b = 0; b < 16; b++)
                    if ((a + 1) * (b + 1) <= 16) { C[c] = (f2key(v1[a] + v2[b]) & ~63u) | (unsigned)(63 - c); c++; }
        }
        unsigned T[16];
#pragma unroll
        for (int k = 0; k < 16; k++) T[k] = C[k];
        sort16_desc(T);
#pragma unroll
        for (int gq = 1; gq < 4; gq++) {
            unsigned G[16];
#pragma unroll
            for (int k = 0; k < 16; k++) G[k] = C[gq * 16 + k];
            sort16_desc(G);
            merge16_desc(T, G);
        }
        const float mx = key2f(T[0] & ~63u);
        float e[16], sum = 0.f;
#pragma unroll
        for (int k = 0; k < 16; k++) { e[k] = __expf(key2f(T[k] & ~63u) - mx); sum += e[k]; }
        const float inv = 1.f / sum;
        int ei[16];
#pragma unroll
        for (int k = 0; k < 16; k++) {
            const int cc = 63 - (int)(T[k] & 63u);
            const int a = c_cand_a[cc], b = c_cand_b[cc];
            const int i1 = 127 - (int)(LL[a * 64 + tk] & 127u), i2 = 127 - (int)(LL[(16 + b) * 64 + tk] & 127u);
            ei[k] = i1 * 128 + i2;
            e[k] *= inv;
        }
        int* eidx = (int*)(p.ws + OFF_EIDX) + (size_t)(tok0 + tk) * 128 + h * 16;
        float* gw = (float*)(p.ws + OFF_GW) + (size_t)(tok0 + tk) * 128 + h * 16;
#pragma unroll
        for (int k4 = 0; k4 < 4; k4++) {
            *(u32x4*)(eidx + k4 * 4) = (u32x4){(unsigned)ei[k4 * 4], (unsigned)ei[k4 * 4 + 1], (unsigned)ei[k4 * 4 + 2], (unsigned)ei[k4 * 4 + 3]};
            *(f32x4*)(gw + k4 * 4) = (f32x4){e[k4 * 4], e[k4 * 4 + 1], e[k4 * 4 + 2], e[k4 * 4 + 3]};
        }
    }
    __syncthreads();
}

__device__ __forceinline__ float ub0(unsigned w) { return (float)(w & 0xffu); }
__device__ __forceinline__ float ub1(unsigned w) { return (float)((w >> 8) & 0xffu); }
__device__ __forceinline__ float ub2(unsigned w) { return (float)((w >> 16) & 0xffu); }
__device__ __forceinline__ float ub3(unsigned w) { return (float)(w >> 24); }
struct P3Sc { float su, sv, gm; };
constexpr int P3_REC = 2048;
__device__ __forceinline__ void p3_load_u(u32x4 (&ur)[4], P3Sc& sc, const unsigned char* __restrict__ UQ, const float* __restrict__ tsc,
                                          int lane, int ul, int g, const unsigned* rec) {
#pragma unroll
    for (int u = 0; u < 4; u++) ur[u] = *(const u32x4*)(UQ + (size_t)rec[4 * g + u] * DM + lane * 16);
    const int em = (int)rec[4 * g + ul];
    sc.gm = __uint_as_float(rec[128 + 4 * g + ul]);
    sc.su = tsc[em];
    sc.sv = tsc[16384 + em];
}
__device__ __forceinline__ void p3_load_v(u32x4 (&vr)[4], const unsigned char* __restrict__ VQ, int lane, int g, const unsigned* rec) {
#pragma unroll
    for (int u = 0; u < 4; u++) vr[u] = *(const u32x4*)(VQ + (size_t)rec[4 * g + u] * DM + lane * 16);
}
__device__ __forceinline__ void p3_dots(const u32x4 (&ur)[4], const unsigned* rec, int lane, int (&pt)[4]) {
    const u32x4 qh = *(const u32x4*)(rec + 256 + lane * 4);
#pragma unroll
    for (int u = 0; u < 4; u++) {
        int d = __builtin_amdgcn_sdot4((int)ur[u].x, (int)qh.x, 0, false);
        d = __builtin_amdgcn_sdot4((int)ur[u].y, (int)qh.y, d, false);
        d = __builtin_amdgcn_sdot4((int)ur[u].z, (int)qh.z, d, false);
        d = __builtin_amdgcn_sdot4((int)ur[u].w, (int)qh.w, d, false);
        pt[u] = d;
    }
}
__device__ __forceinline__ float p3_weight(const int (&pt)[4], int lane, float sh, const P3Sc& sc) {
    int m2[2], m1;
    const bool c0 = lane & 1;
#pragma unroll
    for (int j = 0; j < 2; j++) { const int keep = c0 ? pt[j + 2] : pt[j], send = c0 ? pt[j] : pt[j + 2]; m2[j] = keep + __shfl_xor(send, 1, 64); }
    const bool c1 = lane & 2;
    { const int keep = c1 ? m2[1] : m2[0], send = c1 ? m2[0] : m2[1]; m1 = keep + __shfl_xor(send, 2, 64); }
    m1 += __shfl_xor(m1, 4, 64);
    m1 += __shfl_xor(m1, 8, 64);
    m1 += __shfl_xor(m1, 16, 64);
    m1 += __shfl_xor(m1, 32, 64);
    const float aval = (float)m1 * (sh * sc.su);
    return sc.gm * gelu_erf(aval) * sc.sv;
}
__device__ __forceinline__ void p3_axpy(const u32x4 (&vr)[4], float ws, float (&acc)[16], float& wsum) {
#pragma unroll
    for (int u = 0; u < 4; u++) {
        const int src_lane = ((u >> 1) & 1) | ((u & 1) << 1);
        const float wu = __shfl(ws, src_lane, 64);
        wsum += wu;
        const unsigned vw[4] = {vr[u].x, vr[u].y, vr[u].z, vr[u].w};
#pragma unroll
        for (int i = 0; i < 4; i++) {
            acc[i * 4 + 0] += wu * ub0(vw[i]); acc[i * 4 + 1] += wu * ub1(vw[i]);
            acc[i * 4 + 2] += wu * ub2(vw[i]); acc[i * 4 + 3] += wu * ub3(vw[i]);
        }
    }
}
__device__ __forceinline__ void p3_token(const Params& p, int tok, int lane, unsigned* rec, float& sh) {
    const bf16_t* H = (const bf16_t*)(p.ws + OFF_H);
    const int* eidx = (const int*)(p.ws + OFF_EIDX);
    const float* gwp = (const float*)(p.ws + OFF_GW);
    {
        const u32x4 a = *(const u32x4*)(H + (size_t)tok * DM + lane * 16), b = *(const u32x4*)(H + (size_t)tok * DM + lane * 16 + 8);
        const unsigned hw[8] = {a.x, a.y, a.z, a.w, b.x, b.y, b.z, b.w};
        float hv[16];
        float mx = 0.f;
#pragma unroll
        for (int i = 0; i < 8; i++) { hv[2 * i] = bf_lo(hw[i]); hv[2 * i + 1] = bf_hi(hw[i]); mx = fmaxf(mx, fmaxf(fabsf(hv[2 * i]), fabsf(hv[2 * i + 1]))); }
        mx = wave_max(mx);
        const float inv = mx > 0.f ? 127.f / mx : 0.f;
        sh = mx * (1.f / 127.f);
        unsigned qh[4];
#pragma unroll
        for (int i = 0; i < 4; i++) {
            unsigned pk = 0;
#pragma unroll
            for (int j = 0; j < 4; j++) pk |= ((unsigned)((int)rintf(hv[i * 4 + j] * inv)) & 0xffu) << (8 * j);
            qh[i] = pk;
        }
        *(u32x4*)(rec + 256 + lane * 4) = (u32x4){qh[0], qh[1], qh[2], qh[3]};
    }
    const int e0 = eidx[(size_t)tok * 128 + lane], e1 = eidx[(size_t)tok * 128 + 64 + lane];
    const float g0 = gwp[(size_t)tok * 128 + lane], g1 = gwp[(size_t)tok * 128 + 64 + lane];
    const int k0 = e0 >> 10, k1 = e1 >> 10;
    int pos0 = 0, pos1 = 0, base = 0;
#pragma unroll
    for (int v = 0; v < 16; v++) {
        const unsigned long long m0 = __ballot(k0 == v), m1 = __ballot(k1 == v);
        const int c0 = __popcll(m0);
        const int r0 = __builtin_amdgcn_mbcnt_hi((unsigned)(m0 >> 32), __builtin_amdgcn_mbcnt_lo((unsigned)m0, 0u));
        const int r1 = __builtin_amdgcn_mbcnt_hi((unsigned)(m1 >> 32), __builtin_amdgcn_mbcnt_lo((unsigned)m1, 0u));
        pos0 = (k0 == v) ? base + r0 : pos0;
        pos1 = (k1 == v) ? base + c0 + r1 : pos1;
        base += c0 + __popcll(m1);
    }
    rec[pos0] = (unsigned)e0; rec[pos1] = (unsigned)e1;
    rec[128 + pos0] = __float_as_uint(g0); rec[128 + pos1] = __float_as_uint(g1);
}
__device__ __forceinline__ void p3_finish(const Params& p, float* dstp, int tok, int lane, const float (&acc)[16], float wsum) {
    const float* mod = (const float*)(p.ws + OFF_MOD);
    const int b = tok >> 11;
    float x2[16];
    float ss = 0.f;
#pragma unroll
    for (int i = 0; i < 4; i++) {
        const int d = lane * 16 + i * 4;
        const f32x4 xv = *(const f32x4*)(p.out + (size_t)tok * DM + d);
        const f32x4 gt = *(const f32x4*)(mod + b * 6144 + 5 * 1024 + d);
#pragma unroll
        for (int j = 0; j < 4; j++) { const float v = xv[j] + gt[j] * (acc[i * 4 + j] - 128.f * wsum); x2[i * 4 + j] = v; ss += v * v; }
    }
    ss = wave_sum(ss);
    const float rstd = rsqrtf(ss * (1.f / 1024.f) + 1e-6f);
#pragma unroll
    for (int i = 0; i < 4; i++) {
        const int d = lane * 16 + i * 4;
        const f32x4 fg = *(const f32x4*)(p.final_g + d);
        f32x4 o;
#pragma unroll
        for (int j = 0; j < 4; j++) o[j] = x2[i * 4 + j] * rstd * fg[j];
        *(f32x4*)(dstp + (size_t)tok * DM + d) = o;
    }
}
__device__ void phaseP3(const Params& p, float* dstp, char* lds) {
    const int tid_ = TIDX; const int lane = tid_ & 63, wave = tid_ >> 6;
    const unsigned char* UQ = (const unsigned char*)(p.ws + OFF_UB);
    const unsigned char* VQ = UQ + 16777216;
    const float* tsc = (const float*)(p.ws + OFF_UB + 33554432);
    const int ul = ((lane & 1) << 1) | ((lane >> 1) & 1);
    constexpr int TPW = 2;
    unsigned* recs = (unsigned*)(lds + wave * TPW * P3_REC);
    for (int tb = (vblk() * 4 + wave) * TPW; tb < NTOK; tb += vgrid() * 4 * TPW) {
        float sh[TPW], acc[TPW][16], wsm[TPW];
        __builtin_amdgcn_wave_barrier();
#pragma unroll
        for (int k = 0; k < TPW; k++) {
            p3_token(p, tb + k, lane, recs + k * (P3_REC / 4), sh[k]);
#pragma unroll
            for (int i = 0; i < 16; i++) acc[k][i] = 0.f;
            wsm[k] = 0.f;
        }
        __builtin_amdgcn_wave_barrier();
        u32x4 ur[4], vr[4];
        P3Sc sc[TPW];
        p3_load_u(ur, sc[0], UQ, tsc, lane, ul, 0, recs);
        p3_load_v(vr, VQ, lane, 0, recs);
        for (int g = 0; g < 32; g++) {
#pragma unroll
            for (int k = 0; k < TPW; k++) {
                const int kn = (k + 1) % TPW;
                const int gn = (k + 1 == TPW) ? g + 1 : g;
                int pt[4];
                p3_dots(ur, recs + k * (P3_REC / 4), lane, pt);
                if (gn < 32) p3_load_u(ur, sc[kn], UQ, tsc, lane, ul, gn, recs + kn * (P3_REC / 4));
                const float w = p3_weight(pt, lane, sh[k], sc[k]);
                p3_axpy(vr, w, acc[k], wsm[k]);
                if (gn < 32) p3_load_v(vr, VQ, lane, gn, recs + kn * (P3_REC / 4));
            }
        }
#pragma unroll
        for (int k = 0; k < TPW; k++) p3_finish(p, dstp, tb + k, lane, acc[k], wsm[k]);
    }
}

#define XB_TMO      128
#define XB_XCNT(j)  (256  + 64 * (j))
#define XB_XSUB(j)  (1280 + 64 * (j))
#define XB_XGEN(j)  (2304 + 64 * (j))
#define XB_TOP      3328
#define XB_TOPGEN   3392
#define XCD_BAR_WORDS 3456
#define XB_SPIN_CAP (1u << 22)
#define LAS __attribute__((address_space(3)))
__device__ __forceinline__ unsigned xb_ld(unsigned* p)              { return __hip_atomic_load(p, __ATOMIC_RELAXED, __HIP_MEMORY_SCOPE_AGENT); }
__device__ __forceinline__ unsigned xb_add(unsigned* p, unsigned v) { return __hip_atomic_fetch_add(p, v, __ATOMIC_RELAXED, __HIP_MEMORY_SCOPE_AGENT); }
__device__ __forceinline__ unsigned xb_xcc_id() { return (unsigned)__builtin_amdgcn_s_getreg((3 << 11) | 20) & 0xFu; }
#define XB_SPIN(cond, bar) do { unsigned _sp = 0; while (cond) { __builtin_amdgcn_s_sleep(1); \
    if ((++_sp & 255u) == 0u) { if (xb_ld(&(bar)[XB_TMO])) break; if (_sp > XB_SPIN_CAP) { atomicAdd(&(bar)[XB_TMO], 1u); break; } } } } while (0)
struct XcdBarrier { unsigned* bar; unsigned x; volatile LAS unsigned* st; };
__device__ __forceinline__ XcdBarrier xcd_barrier_post(unsigned* bar, volatile LAS unsigned* st) {
    XcdBarrier b; b.bar = bar; b.x = xb_xcc_id(); b.st = st;
    if (threadIdx.x == 0) { st[2] = xb_add(&bar[XB_XCNT(b.x)], 1u); st[4] = b.x; }
    return b;
}
__device__ __forceinline__ void xcd_barrier_complete(unsigned* bar, unsigned x, unsigned& nloc, unsigned& nx, unsigned& bal) {
    const unsigned G = gridDim.x * gridDim.y * gridDim.z;
    unsigned sum, cnt, mine, c64, sp = 0u;
    for (;;) {
        sum = 0u; cnt = 0u; mine = 0u; c64 = 0u;
#pragma unroll
        for (unsigned j = 0; j < 16; ++j) { const unsigned c = xb_ld(&bar[XB_XCNT(j)]); sum += c; cnt += (c > 0u) ? 1u : 0u; c64 += (j < 8 && c == 64u) ? 1u : 0u; mine = (j == x) ? c : mine; }
        if (sum == G) break;
        __builtin_amdgcn_s_sleep(1);
        if ((++sp & 255u) == 0u) { if (xb_ld(&bar[XB_TMO])) break; if (sp > XB_SPIN_CAP) { atomicAdd(&bar[XB_TMO], 1u); break; } }
    }
    nloc = mine > 0u ? mine : 1u; nx = cnt > 0u ? cnt : 1u; bal = (sum == G && cnt == 8u && c64 == 8u) ? 1u : 0u;
}
__device__ __forceinline__ void xcd_barrier(const XcdBarrier& b) {
    asm volatile("s_waitcnt vmcnt(0)" ::: "memory");
    __syncthreads();
    if (threadIdx.x == 0) {
        unsigned* bar = b.bar;
        __builtin_amdgcn_s_waitcnt(0);
        unsigned nloc = b.st[0], nx = b.st[1];
        if (nloc == 0u) { unsigned bal; xcd_barrier_complete(bar, b.x, nloc, nx, bal); b.st[0] = nloc; b.st[1] = nx; b.st[3] = bal; }
        const unsigned old = xb_add(&bar[XB_XSUB(b.x)], 1u);
        const unsigned gen = old / nloc;
        if (old + 1u == (gen + 1u) * nloc) {
            __builtin_amdgcn_fence(__ATOMIC_RELEASE, "agent");
            asm volatile("s_waitcnt vmcnt(0)" ::: "memory");
            const unsigned og = xb_add(&bar[XB_TOP], 1u);
            const unsigned tg = og / nx;
            if (og + 1u == (tg + 1u) * nx) xb_add(&bar[XB_TOPGEN], 1u);
            else XB_SPIN(xb_ld(&bar[XB_TOPGEN]) == tg, bar);
            __builtin_amdgcn_fence(__ATOMIC_ACQUIRE, "agent");
            xb_add(&bar[XB_XGEN(b.x)], 1u);
            asm volatile("s_waitcnt vmcnt(0)" ::: "memory");
        } else {
            XB_SPIN(xb_ld(&bar[XB_XGEN(b.x)]) == gen, bar);
            __builtin_amdgcn_fence(__ATOMIC_ACQUIRE, "agent");
            asm volatile("s_waitcnt vmcnt(0)" ::: "memory");
        }
    }
    __syncthreads();
}

typedef __attribute__((address_space(4))) const Params* KParamsPtr;
__device__ __forceinline__ const Params& fresh_params() {
    KParamsPtr kp = (KParamsPtr)__builtin_amdgcn_kernarg_segment_ptr();
    asm volatile("" : "+s"(kp));
    return *(const Params*)kp;
}
#define PF fresh_params()
__global__ void __launch_bounds__(BLOCK_THREADS, 2) mega(Params p_unused) {
    __shared__ __attribute__((aligned(16))) char lds[LDS_BYTES];
    cg::grid_group grid = cg::this_grid();
    volatile LAS unsigned* st = (volatile LAS unsigned*)(lds + 2 * LDS_MAIN);
    if (threadIdx.x < 16) st[threadIdx.x] = 0u;
    __syncthreads();
    XcdBarrier xb = xcd_barrier_post((unsigned*)PF.ws, st);
    char* hl = lds + half_id() * LDS_MAIN;
    volatile unsigned* uex = (volatile unsigned*)(lds + 2 * LDS_MAIN + 32);

    phaseA(PF, hl);
    if (PF.ws == nullptr) grid.sync();
    xcd_barrier(xb);
    { const Params& q_ = PF; phase_modnorm(q_, q_.x, q_.norm1_g, 0, 1, (bf16_t*)(q_.ws + OFF_H)); };
    xcd_barrier(xb);
    phaseC(PF, lds);
    xcd_barrier(xb);
    for (int task = vblk(); task < 1024; task += vgrid()) phaseG1_task(PF, task, hl);
    for (int task = vblk(); task < 512; task += vgrid()) phaseN1_task(PF, task, hl);
    xcd_barrier(xb);
    phaseG2(PF);
    phaseA2(PF, hl);
    xcd_barrier(xb);
    for (int task = vblk(); task < 2048; task += vgrid()) phaseN2_task(PF, task, hl, (bf16_t*)(PF.ws + OFF_Z) + ZQ_N, ZC, uex, lds);
    for (int task = vblk(); task < 1024; task += vgrid()) phaseG3_task(PF, task, hl, (bf16_t*)(PF.ws + OFF_Z) + ZR_G, ZC);
    xcd_barrier(xb);
    phaseM1(PF, lds);
    xcd_barrier(xb);
    phaseM2(PF, lds);
    xcd_barrier(xb);
    { const Params& q_ = PF; phase_modnorm(q_, q_.out, q_.norm2_g, 3, 4, (bf16_t*)(q_.ws + OFF_H)); };
    xcd_barrier(xb);
    phaseP1(PF, lds);
    xcd_barrier(xb);
    for (int task = vblk(); task < 2048; task += vgrid()) phaseP2_task(PF, task, hl);
    xcd_barrier(xb);
    { const Params& q_ = PF; phaseP3(q_, q_.out, hl); };
}

extern "C" void kernel_launch(void* const* d_in, const int* in_sizes, int n_in, void* d_out, int out_size, void* d_ws, size_t ws_size, hipStream_t stream) {
    Params p{};
    p.x = (const float*)d_in[0]; p.c = (const float*)d_in[1]; p.pos = (const int*)d_in[2]; p.ada_w = (const float*)d_in[3]; p.ada_b = (const float*)d_in[4];
    p.norm1_g = (const float*)d_in[5]; p.norm2_g = (const float*)d_in[6]; p.final_g = (const float*)d_in[7]; p.w_in = (const float*)d_in[8];
    p.gla_wa2 = (const float*)d_in[9]; p.gla_ba2 = (const float*)d_in[10]; p.gla_norm_g = (const float*)d_in[11]; p.pe_k = (const float*)d_in[12]; p.pe_v = (const float*)d_in[13];
    p.ck_w1 = (const float*)d_in[14]; p.ck_w2 = (const float*)d_in[15]; p.cv_w1 = (const float*)d_in[16]; p.cv_w2 = (const float*)d_in[17];
    p.w_branch_a = (const float*)d_in[18]; p.w_branch_b = (const float*)d_in[19]; p.w_out = (const float*)d_in[20]; p.peer_wq = (const float*)d_in[21];
    p.peer_k1 = (const float*)d_in[22]; p.peer_k2 = (const float*)d_in[23]; p.peer_u = (const float*)d_in[24]; p.peer_v = (const float*)d_in[25];
    p.out = (float*)d_out; p.ws = (char*)d_ws;
    static int grid_blocks = 0;
    if (!grid_blocks) {
        int dev = 0, cus = 0, per_cu = 0;
        hipGetDevice(&dev);
        hipDeviceGetAttribute(&cus, hipDeviceAttributeMultiprocessorCount, dev);
        hipOccupancyMaxActiveBlocksPerMultiprocessor(&per_cu, mega, BLOCK_THREADS, 0);
        if (per_cu > 1) per_cu = 1;
        if (per_cu < 1) per_cu = 1;
        grid_blocks = cus * per_cu;
    }
    hipMemsetAsync(d_ws, 0, XCD_BAR_WORDS * 4, stream);
    void* args[] = {&p};
    hipError_t e = hipLaunchCooperativeKernel((void*)mega, dim3(grid_blocks), dim3(BLOCK_THREADS), args, 0, stream);
    if (e != hipSuccess) fprintf(stderr, "cooperative launch failed: %s (grid %d)\n", hipGetErrorString(e), grid_blocks);
}
```

```cpp
#include <hip/hip_runtime.h>
#include <hip/hip_cooperative_groups.h>
#include <stdio.h>
namespace cg = cooperative_groups;
#include <stdint.h>
#include <stddef.h>
#include <math.h>

typedef unsigned short bf16_t;
typedef short bf16x8 __attribute__((ext_vector_type(8)));
typedef float f32x4 __attribute__((ext_vector_type(4)));
typedef unsigned u32x4 __attribute__((ext_vector_type(4)));
typedef unsigned u32x2 __attribute__((ext_vector_type(2)));
typedef float f32x2 __attribute__((ext_vector_type(2)));
typedef float f32x16 __attribute__((ext_vector_type(16)));
typedef float f32x32 __attribute__((ext_vector_type(32)));
typedef unsigned u32x6 __attribute__((ext_vector_type(6)));

constexpr int DM = 1024, NB = 8, SEQ = 2048, NTOK = NB * SEQ;
constexpr int ZC = 4992;
constexpr int ZQ_G = 0, ZK_G = 512, ZV_G = 1024, ZR_G = 2048, ZQ_N = 3072, ZKC = 4096, ZVC = 4224, ZKS = 4352, ZVS = 4480,
              ZKW = 4608, ZVW = 4736, ZGATE = 4864, ZLR = 4912;
constexpr int LDS_MAIN = 73728;
constexpr int LDS_BYTES = 2 * LDS_MAIN + 64;
constexpr int NTHREADS = 256;
constexpr int BLOCK_THREADS = 512;

constexpr size_t OFF_MOD = 16384;
constexpr size_t OFF_ROPE = 212992;
constexpr size_t OFF_CMP = 1261568;
constexpr size_t OFF_DEC = 1785856;
constexpr size_t OFF_K1B = 2310144;
constexpr size_t OFF_WC1 = 2834432;
constexpr size_t OFF_WIN = 4194304;
constexpr size_t OFF_WM = 14417920;
constexpr size_t OFF_WA = 18612224;
constexpr size_t OFF_WB = 20709376;
constexpr size_t OFF_WO = 22806528;
constexpr size_t OFF_WQ = 24903680;
constexpr size_t OFF_H = 29360128;
constexpr size_t OFF_M = 62914560;
constexpr size_t OFF_Z = 96468992;
constexpr size_t OFF_VT = OFF_Z + (size_t)NTOK * ZC * 2;
constexpr size_t OFF_QP = OFF_Z;
constexpr size_t OFF_UB = OFF_Z + 67108864;
constexpr size_t OFF_VB = OFF_UB + 33554432;
constexpr size_t OFF_X1B = OFF_VB + 1048576;
constexpr size_t OFF_EIDX = OFF_VB + 33554432 + 1048576;
constexpr size_t OFF_GW = OFF_EIDX + 8388608;

struct Params {
    const float* x; const float* c; const int* pos; const float* ada_w; const float* ada_b;
    const float* norm1_g; const float* norm2_g; const float* final_g; const float* w_in;
    const float* gla_wa2; const float* gla_ba2; const float* gla_norm_g; const float* pe_k; const float* pe_v;
    const float* ck_w1; const float* ck_w2; const float* cv_w1; const float* cv_w2;
    const float* w_branch_a; const float* w_branch_b; const float* w_out; const float* peer_wq;
    const float* peer_k1; const float* peer_k2; const float* peer_u; const float* peer_v;
    float* out; char* ws;
};

__device__ __forceinline__ unsigned f2bf_u(float f) { unsigned u = __float_as_uint(f); return (u + 0x7fffu + ((u >> 16) & 1u)) >> 16; }
__device__ __forceinline__ bf16_t f2bf(float f) { return (bf16_t)f2bf_u(f); }
typedef float f32x2_ __attribute__((ext_vector_type(2)));
typedef __bf16 bf16x2_ __attribute__((ext_vector_type(2)));
__device__ __forceinline__ unsigned pack2(float lo, float hi) {
    const f32x2_ v = {lo, hi};
    return __builtin_bit_cast(unsigned, __builtin_convertvector(v, bf16x2_));
}
__device__ __forceinline__ float bf_lo(unsigned u) { return __uint_as_float(u << 16); }
__device__ __forceinline__ float bf_hi(unsigned u) { return __uint_as_float(u & 0xffff0000u); }
__device__ __forceinline__ float bf2f(bf16_t h) { return __uint_as_float(((unsigned)h) << 16); }
__device__ __forceinline__ float wave_sum(float v) {
#pragma unroll
    for (int o = 32; o > 0; o >>= 1) v += __shfl_xor(v, o, 64);
    return v;
}
__device__ __forceinline__ float xrow_max(float v) {
    const auto a = __builtin_amdgcn_permlane16_swap(__float_as_uint(v), __float_as_uint(v), false, false);
    v = fmaxf(__uint_as_float(a[0]), __uint_as_float(a[1]));
    const auto b = __builtin_amdgcn_permlane32_swap(__float_as_uint(v), __float_as_uint(v), false, false);
    return fmaxf(__uint_as_float(b[0]), __uint_as_float(b[1]));
}
__device__ __forceinline__ float xrow_sum(float v) {
    const auto a = __builtin_amdgcn_permlane16_swap(__float_as_uint(v), __float_as_uint(v), false, false);
    v = __uint_as_float(a[0]) + __uint_as_float(a[1]);
    const auto b = __builtin_amdgcn_permlane32_swap(__float_as_uint(v), __float_as_uint(v), false, false);
    return __uint_as_float(b[0]) + __uint_as_float(b[1]);
}
__device__ __forceinline__ float wave_max(float v) {
#pragma unroll
    for (int o = 32; o > 0; o >>= 1) v = fmaxf(v, __shfl_xor(v, o, 64));
    return v;
}
__device__ __forceinline__ int launder_i(int x) { asm volatile("" : "+v"(x)); return x; }
#define TIDX (launder_i((int)threadIdx.x) & 255)
#define TIDX512 launder_i((int)threadIdx.x)
__device__ __forceinline__ int half_id() { return __builtin_amdgcn_readfirstlane((int)(threadIdx.x >> 8)); }
__device__ __forceinline__ int vblk() { return (int)blockIdx.x * 2 + half_id(); }
__device__ __forceinline__ int vgrid() { return (int)gridDim.x * 2; }
__device__ __forceinline__ float exp2f_(float x) { return __builtin_amdgcn_exp2f(x); }
__device__ __forceinline__ float sigmoidf_(float x) { return __builtin_amdgcn_rcpf(1.f + __expf(-x)); }
__device__ __forceinline__ float siluf_(float x) { return x * __builtin_amdgcn_rcpf(1.f + __expf(-x)); }
__device__ __forceinline__ float gelu_erf(float v) {
    const float t = __builtin_amdgcn_rcpf(fabsf(v) * 0.2316418882f + 1.0f);
    float qp = t * 0.5307027145f + (-0.7265760135f);
    qp = qp * t + 0.7107068705f; qp = qp * t + (-0.142248368f); qp = qp * t + 0.127414796f; qp = qp * t;
    const float m = v * (qp * __builtin_amdgcn_exp2f(v * v * (-0.72134752044f)));
    return v < 0.f ? m : v - m;
}
__device__ __forceinline__ f32x4 mfma16(bf16x8 a, bf16x8 b, f32x4 c) { return __builtin_amdgcn_mfma_f32_16x16x32_bf16(a, b, c, 0, 0, 0); }
__device__ __forceinline__ bf16x8 ld_frag(const bf16_t* p) { return *(const bf16x8*)p; }
__device__ __forceinline__ bf16x8 mk_frag(u32x2 lo, u32x2 hi) { u32x4 t = {lo.x, lo.y, hi.x, hi.y}; return __builtin_bit_cast(bf16x8, t); }

#define WAIT_V(n) asm volatile("s_waitcnt vmcnt(" #n ")" ::: "memory")
__device__ __forceinline__ void glds16(const bf16_t* g, char* l) { __builtin_amdgcn_global_load_lds((const unsigned*)g, (unsigned*)l, 16, 0, 0); }
struct GemmSrc { const bf16_t* xsrc; const bf16_t* wsrc; int ldx, ldw, dsw; };
__device__ __forceinline__ GemmSrc gemm_src(const bf16_t* __restrict__ X, int ldx, const bf16_t* __restrict__ W, int ldw, int m0, int n0) {
    const int tid = TIDX512, lane = tid & 63, wave = tid >> 6;
    const int R0 = wave * 32 + (lane >> 3);
    const int f0 = (R0 >> 1) & 7, pos = lane & 7;
    const int sw_e = (pos ^ f0) * 8, sw_o = (pos ^ ((f0 + 4) & 7)) * 8;
    GemmSrc g;
    g.xsrc = X + (size_t)(m0 + R0) * ldx + sw_e;
    g.wsrc = W + (size_t)(n0 + R0) * ldw + sw_e;
    g.ldx = ldx; g.ldw = ldw; g.dsw = sw_o - sw_e;
    return g;
}
__device__ __forceinline__ void gemm_issue(const GemmSrc& g, int kt, int s, char* lds) {
    const int tid = TIDX512, lane = tid & 63, wave = tid >> 6;
    char* xdst = lds + s * 65536 + wave * 4096 + lane * 16;
    char* wdst = xdst + 32768;
#pragma unroll
    for (int i = 0; i < 4; i++) {
        const int d = (i & 1) ? g.dsw : 0;
        glds16(g.xsrc + (size_t)i * 8 * g.ldx + kt * 64 + d, xdst + i * 1024);
        glds16(g.wsrc + (size_t)i * 8 * g.ldw + kt * 64 + d, wdst + i * 1024);
    }
}
__device__ __forceinline__ void gemm_prologue(const GemmSrc& g, char* lds) { gemm_issue(g, 0, 0, lds); }
__device__ __forceinline__ void gemm_mainloop(f32x4 (&acc)[8][4], const GemmSrc& g, int K, char* lds) {
    const int tid = TIDX512, lane = tid & 63, wave = tid >> 6;
    const int wr = wave >> 2, wc = wave & 3, r = lane & 15, q = lane >> 4;
    const int KT = K / 64;
    const int rdo0 = r * 128 + ((q ^ (r >> 1)) * 16), rdo1 = r * 128 + (((4 + q) ^ (r >> 1)) * 16);
    const int woff = 32768 + wc * 64 * 128, xoff = wr * 128 * 128;
    for (int kt = 0; kt < KT; kt++) {
        WAIT_V(0);
        __builtin_amdgcn_s_barrier();
        const char* st = lds + (kt & 1) * 65536;
        bf16x8 afA[4], afB[4], bX[4], bY[4];
#pragma unroll
        for (int ni = 0; ni < 4; ni++) afA[ni] = *(const bf16x8*)(st + woff + ni * 16 * 128 + rdo0);
#pragma unroll
        for (int mi = 0; mi < 4; mi++) bX[mi] = *(const bf16x8*)(st + xoff + mi * 16 * 128 + rdo0);
        if (kt + 1 < KT) gemm_issue(g, kt + 1, (kt + 1) & 1, lds);
#pragma unroll
        for (int mi = 0; mi < 4; mi++) bY[mi] = *(const bf16x8*)(st + xoff + (4 + mi) * 16 * 128 + rdo0);
#pragma unroll
        for (int ni = 0; ni < 4; ni++) afB[ni] = *(const bf16x8*)(st + woff + ni * 16 * 128 + rdo1);
#pragma unroll
        for (int mi = 0; mi < 4; mi++)
#pragma unroll
            for (int ni = 0; ni < 4; ni++) acc[mi][ni] = mfma16(afA[ni], bX[mi], acc[mi][ni]);
        __builtin_amdgcn_sched_barrier(0);
#pragma unroll
        for (int mi = 0; mi < 4; mi++) bX[mi] = *(const bf16x8*)(st + xoff + mi * 16 * 128 + rdo1);
#pragma unroll
        for (int mi = 0; mi < 4; mi++)
#pragma unroll
            for (int ni = 0; ni < 4; ni++) acc[4 + mi][ni] = mfma16(afA[ni], bY[mi], acc[4 + mi][ni]);
        __builtin_amdgcn_sched_barrier(0);
#pragma unroll
        for (int mi = 0; mi < 4; mi++) bY[mi] = *(const bf16x8*)(st + xoff + (4 + mi) * 16 * 128 + rdo1);
#pragma unroll
        for (int mi = 0; mi < 4; mi++)
#pragma unroll
            for (int ni = 0; ni < 4; ni++) acc[mi][ni] = mfma16(afB[ni], bX[mi], acc[mi][ni]);
        __builtin_amdgcn_sched_barrier(0);
#pragma unroll
        for (int mi = 0; mi < 4; mi++)
#pragma unroll
            for (int ni = 0; ni < 4; ni++) acc[4 + mi][ni] = mfma16(afB[ni], bY[mi], acc[4 + mi][ni]);
        __builtin_amdgcn_sched_barrier(0);
    }
}
__device__ __forceinline__ void gemm_core(f32x4 (&acc)[8][4], const bf16_t* __restrict__ X, int ldx, const bf16_t* __restrict__ W, int ldw,
                                          int K, int m0, int n0, char* lds) {
    const GemmSrc g = gemm_src(X, ldx, W, ldw, m0, n0);
    gemm_prologue(g, lds);
    gemm_mainloop(acc, g, K, lds);
    __syncthreads();
}
__device__ __forceinline__ void zero_acc(f32x4 (&acc)[8][4]) {
#pragma unroll
    for (int a = 0; a < 8; a++)
#pragma unroll
        for (int b = 0; b < 4; b++) acc[a][b] = (f32x4){0.f, 0.f, 0.f, 0.f};
}

constexpr int EPI_ROWB = 528;
__device__ __forceinline__ void epi_fill(char* lds, int wr, int wc, int r, int q, int mi, int ni, f32x4 v) {
    *(u32x2*)(lds + (wr * 128 + mi * 16 + r) * EPI_ROWB + (wc * 64 + ni * 16 + 4 * q) * 2) = (u32x2){pack2(v[0], v[1]), pack2(v[2], v[3])};
}
__device__ __forceinline__ void epi_store(const char* lds, bf16_t* __restrict__ O, int ldo, int m0, int n0, int ncols_valid) {
    const int t = TIDX512;
    const int chunk = t & 31, rsub = t >> 5;
    if (n0 + chunk * 8 < ncols_valid) {
#pragma unroll
        for (int ps = 0; ps < 16; ps++) {
            const int row = ps * 16 + rsub;
            const u32x4 v = *(const u32x4*)(lds + row * EPI_ROWB + chunk * 16);
            *(u32x4*)(O + (size_t)(m0 + row) * ldo + n0 + chunk * 8) = v;
        }
    }
}

struct TileIter {
    int nt, i, x, li; bool fancy;
    __device__ TileIter(int ntiles_n, const char*) { nt = ntiles_n; fancy = (gridDim.x == 256) && ((nt & 3) == 0); x = blockIdx.x & 7; li = blockIdx.x >> 3; i = fancy ? 0 : blockIdx.x; }
    __device__ bool next(int& bm, int& bn) {
        if (fancy) {
            if (i * 4 >= nt) return false;
            bm = x * 8 + (li & 7); bn = i * 4 + (li >> 3); i++; return true;
        }
        if (i >= 64 * nt) return false;
        bn = i % nt; bm = i / nt; i += gridDim.x; return true;
    }
};

struct MapId { __device__ int operator()(int n) const { return n; } };
struct MapWin {
    __device__ int operator()(int n) const { return n < 3072 ? n : (n < 4912 ? n + 16 : (n < 4928 ? n - 1840 : -1)); }
};
struct MapOff { int off; __device__ int operator()(int n) const { return n + off; } };

template <class Map>
__device__ __forceinline__ void tconv_tile(const float* __restrict__ src, int ldsrc, bf16_t* __restrict__ dst, int ldd, int n0, int k0, Map map, float* t) {
    const int tid = TIDX;
    const int n = tid & 63, kb = tid >> 6;
    const int sc = map(n0 + n);
#pragma unroll
    for (int i = 0; i < 16; i++) { const int k = i * 4 + kb; t[k * 65 + n] = sc >= 0 ? src[(size_t)(k0 + k) * ldsrc + sc] : 0.f; }
    __syncthreads();
    const int nn = tid >> 2, kk = (tid & 3) * 16;
    unsigned w[8];
#pragma unroll
    for (int j = 0; j < 8; j++) w[j] = pack2(t[(kk + 2 * j) * 65 + nn], t[(kk + 2 * j + 1) * 65 + nn]);
    u32x4* d = (u32x4*)(dst + (size_t)(n0 + nn) * ldd + k0 + kk);
    d[0] = (u32x4){w[0], w[1], w[2], w[3]};
    d[1] = (u32x4){w[4], w[5], w[6], w[7]};
    __syncthreads();
}

struct TDesc { const float* src; bf16_t* dst; int ldsrc, ldd, n0, k0, mapkind, mapoff; };
__device__ __forceinline__ int td_col(const TDesc& d, int n) {
    if (d.mapkind == 0) return n + d.mapoff;
    return n < 3072 ? n : (n < 4912 ? n + 16 : (n < 4928 ? n - 1840 : -1));
}
__device__ __forceinline__ void tconv_load(const TDesc& d, float (&v)[16]) {
    const int tid = TIDX;
    const int n = tid & 63, kb = tid >> 6;
    const int sc = td_col(d, d.n0 + n);
#pragma unroll
    for (int i = 0; i < 16; i++) v[i] = sc >= 0 ? d.src[(size_t)(d.k0 + i * 4 + kb) * d.ldsrc + sc] : 0.f;
}
__device__ __forceinline__ void tconv_finish(const TDesc& d, const float (&v)[16], float* t) {
    const int tid = TIDX;
    const int n = tid & 63, kb = tid >> 6;
#pragma unroll
    for (int i = 0; i < 16; i++) t[(i * 4 + kb) * 65 + n] = v[i];
    __syncthreads();
    const int nn = tid >> 2, kk = (tid & 3) * 16;
    unsigned w[8];
#pragma unroll
    for (int j = 0; j < 8; j++) w[j] = pack2(t[(kk + 2 * j) * 65 + nn], t[(kk + 2 * j + 1) * 65 + nn]);
    u32x4* o = (u32x4*)(d.dst + (size_t)(d.n0 + nn) * d.ldd + d.k0 + kk);
    o[0] = (u32x4){w[0], w[1], w[2], w[3]};
    o[1] = (u32x4){w[4], w[5], w[6], w[7]};
    __syncthreads();
}
constexpr int TA_MOD = 192, TA_WIN = 78 * 16, TA_WM = 32 * 16, TA_SQ = 16 * 16, TA_WQ = 32 * 16, TA_WC = 32, TA_K12 = 64, TA_ROPE = 512;
constexpr int TA_E0 = TA_MOD, TA_E1 = TA_E0 + TA_WIN, TA_E2 = TA_E1 + TA_WM, TA_E3 = TA_E2 + TA_SQ, TA_E4 = TA_E3 + TA_SQ, TA_E5 = TA_E4 + TA_SQ,
              TA_E6 = TA_E5 + TA_WQ, TA_E7 = TA_E6 + TA_WC, TA_E8 = TA_E7 + TA_WC, TA_E9 = TA_E8 + TA_K12, TA_E10 = TA_E9 + TA_K12, TA_E11 = TA_E10 + TA_ROPE;

__device__ __forceinline__ bool ta_is_tconv(int task) { return (task >= TA_E0 && task < TA_E6) || (task >= TA_E6 && task < TA_E8); }
__device__ __forceinline__ TDesc ta_desc(const Params& p, int task) {
    TDesc d; d.mapkind = 0; d.mapoff = 0; d.ldd = 1024;
    if (task < TA_E1) { const int tt = task - TA_E0; d.src = p.w_in; d.ldsrc = 6976; d.dst = (bf16_t*)(p.ws + OFF_WIN); d.n0 = (tt >> 4) * 64; d.k0 = (tt & 15) * 64; d.mapkind = 1; }
    else if (task < TA_E2) { const int tt = task - TA_E1; d.src = p.w_in; d.ldsrc = 6976; d.dst = (bf16_t*)(p.ws + OFF_WM); d.n0 = (tt >> 4) * 64; d.k0 = (tt & 15) * 64; d.mapoff = 4928; }
    else if (task < TA_E3) { const int tt = task - TA_E2; d.src = p.w_branch_a; d.ldsrc = 1024; d.dst = (bf16_t*)(p.ws + OFF_WA); d.n0 = (tt >> 4) * 64; d.k0 = (tt & 15) * 64; }
    else if (task < TA_E4) { const int tt = task - TA_E3; d.src = p.w_branch_b; d.ldsrc = 1024; d.dst = (bf16_t*)(p.ws + OFF_WB); d.n0 = (tt >> 4) * 64; d.k0 = (tt & 15) * 64; }
    else if (task < TA_E5) { const int tt = task - TA_E4; d.src = p.w_out; d.ldsrc = 1024; d.dst = (bf16_t*)(p.ws + OFF_WO); d.n0 = (tt >> 4) * 64; d.k0 = (tt & 15) * 64; }
    else if (task < TA_E6) { const int tt = task - TA_E5; d.src = p.peer_wq; d.ldsrc = 2048; d.dst = (bf16_t*)(p.ws + OFF_WQ); d.n0 = (tt >> 4) * 64; d.k0 = (tt & 15) * 64; }
    else if (task < TA_E7) { const int tt = task - TA_E6; d.src = p.ck_w1; d.ldsrc = 64; d.dst = (bf16_t*)(p.ws + OFF_WC1); d.ldd = 2048; d.n0 = 0; d.k0 = tt * 64; }
    else { const int tt = task - TA_E7; d.src = p.cv_w1; d.ldsrc = 64; d.dst = (bf16_t*)(p.ws + OFF_WC1) + 64 * 2048; d.ldd = 2048; d.n0 = 0; d.k0 = tt * 64; }
    return d;
}
__device__ void phaseA(const Params& p, char* lds) {
    const int tid = TIDX;
    float* fl = (float*)lds;
    constexpr int N0 = TA_E1 + (TA_E8 - TA_E6) + (TA_E11 - TA_E10);
    float pre[16];
    bool pre_valid = false;
    for (int idx = vblk(); idx < N0; idx += vgrid()) {
        const int task = idx < TA_E1 ? idx : (idx < TA_E1 + (TA_E8 - TA_E6) ? idx - TA_E1 + TA_E6 : idx - TA_E1 - (TA_E8 - TA_E6) + TA_E10);
        if (ta_is_tconv(task)) {
            const TDesc d = ta_desc(p, task);
            float cur[16];
            if (pre_valid) {
#pragma unroll
                for (int i = 0; i < 16; i++) cur[i] = pre[i];
            } else tconv_load(d, cur);
            const int idxn = idx + vgrid();
            const int taskn = idxn < TA_E1 ? idxn : (idxn < TA_E1 + (TA_E8 - TA_E6) ? idxn - TA_E1 + TA_E6 : idxn - TA_E1 - (TA_E8 - TA_E6) + TA_E10);
            pre_valid = idxn < N0 && ta_is_tconv(taskn);
            if (pre_valid) { const TDesc dn = ta_desc(p, taskn); tconv_load(dn, pre); }
            tconv_finish(d, cur, fl);
        } else if (task < TA_E0) {
            float* sc = fl;
            float* red = fl + 8192;
            {
                f32x4 cv[8];
#pragma unroll
                for (int i = 0; i < 8; i++) cv[i] = *(const f32x4*)(p.c + (i * 256 + tid) * 4);
#pragma unroll
                for (int i = 0; i < 8; i++) *(f32x4*)(sc + (i * 256 + tid) * 4) = (f32x4){siluf_(cv[i][0]), siluf_(cv[i][1]), siluf_(cv[i][2]), siluf_(cv[i][3])};
            }
            __syncthreads();
            const int n = task * 32 + (tid & 31), kg = tid >> 5;
            float a[8];
#pragma unroll
            for (int b = 0; b < 8; b++) a[b] = 0.f;
            for (int k0 = kg * 128; k0 < kg * 128 + 128; k0 += 16) {
                float w[16];
#pragma unroll
                for (int i = 0; i < 16; i++) w[i] = p.ada_w[(size_t)(k0 + i) * 6144 + n];
#pragma unroll
                for (int i = 0; i < 16; i++)
#pragma unroll
                    for (int b = 0; b < 8; b++) a[b] += sc[b * 1024 + k0 + i] * w[i];
            }
#pragma unroll
            for (int b = 0; b < 8; b++) red[(kg * 8 + b) * 32 + (tid & 31)] = a[b];
            __syncthreads();
            {
                const int b = tid >> 5, nn = tid & 31;
                float s = 0.f;
#pragma unroll
                for (int g = 0; g < 8; g++) s += red[(g * 8 + b) * 32 + nn];
                ((float*)(p.ws + OFF_MOD))[b * 6144 + task * 32 + nn] = s + p.ada_b[task * 32 + nn];
            }
            __syncthreads();
        } else if (task < TA_E1) {
            const int tt = task - TA_E0;
            tconv_tile(p.w_in, 6976, (bf16_t*)(p.ws + OFF_WIN), 1024, (tt >> 4) * 64, (tt & 15) * 64, MapWin(), fl);
        } else if (task < TA_E6) {
        } else if (task < TA_E7) {
            const int tt = task - TA_E6;
            tconv_tile(p.ck_w1, 64, (bf16_t*)(p.ws + OFF_WC1), 2048, 0, tt * 64, MapId(), fl);
        } else if (task < TA_E8) {
            const int tt = task - TA_E7;
            tconv_tile(p.cv_w1, 64, (bf16_t*)(p.ws + OFF_WC1) + 64 * 2048, 2048, 0, tt * 64, MapId(), fl);
        } else if (task < TA_E10) {
        } else {
            const int tt = task - TA_E10;
            const int e = tt * 256 + tid;
            const int tok = e >> 3, i = e & 7;
            const float invf[8] = {1.0f, 0.1939227432012558f, 0.03760603070259094f, 0.007292664609849453f,
                                   0.0014142135623842478f, 0.00027424818836152554f, 5.318296098266728e-05f, 1.0313386155758053e-05f};
            float fr = invf[0];
#pragma unroll
            for (int j = 1; j < 8; j++) fr = (i == j) ? invf[j] : fr;
            const float ang = (float)p.pos[tok] * fr;
            const double rev = (double)ang * 0.15915494309189533577;
            const float fpart = (float)(rev - floor(rev));
            float* cs = (float*)(p.ws + OFF_ROPE);
            cs[e * 2] = __builtin_amdgcn_cosf(fpart);
            cs[e * 2 + 1] = __builtin_amdgcn_sinf(fpart);
        }
    }
}

__device__ void phaseA2(const Params& p, char* lds) {
    const int tid = TIDX;
    float* fl = (float*)lds;
    constexpr int N1 = (TA_E6 - TA_E1) + (TA_E10 - TA_E8);
    float pre[16];
    bool pre_valid = false;
    for (int idx = vblk(); idx < N1; idx += vgrid()) {
        const int task = idx < (TA_E6 - TA_E1) ? idx + TA_E1 : idx - (TA_E6 - TA_E1) + TA_E8;
        if (task >= TA_E1 && task < TA_E6) {
            const TDesc d = ta_desc(p, task);
            float cur[16];
            if (pre_valid) {
#pragma unroll
                for (int i = 0; i < 16; i++) cur[i] = pre[i];
            } else tconv_load(d, cur);
            const int idxn = idx + vgrid();
            const int taskn = idxn < (TA_E6 - TA_E1) ? idxn + TA_E1 : idxn - (TA_E6 - TA_E1) + TA_E8;
            pre_valid = idxn < N1 && taskn >= TA_E1 && taskn < TA_E6;
            if (pre_valid) { const TDesc dn = ta_desc(p, taskn); tconv_load(dn, pre); }
            tconv_finish(d, cur, fl);
        } else if (task < TA_E2) {
            const int tt = task - TA_E1;
            tconv_tile(p.w_in, 6976, (bf16_t*)(p.ws + OFF_WM), 1024, (tt >> 4) * 64, (tt & 15) * 64, MapOff{4928}, fl);
        } else if (task < TA_E3) {
            const int tt = task - TA_E2;
            tconv_tile(p.w_branch_a, 1024, (bf16_t*)(p.ws + OFF_WA), 1024, (tt >> 4) * 64, (tt & 15) * 64, MapId(), fl);
        } else if (task < TA_E4) {
            const int tt = task - TA_E3;
            tconv_tile(p.w_branch_b, 1024, (bf16_t*)(p.ws + OFF_WB), 1024, (tt >> 4) * 64, (tt & 15) * 64, MapId(), fl);
        } else if (task < TA_E5) {
            const int tt = task - TA_E4;
            tconv_tile(p.w_out, 1024, (bf16_t*)(p.ws + OFF_WO), 1024, (tt >> 4) * 64, (tt & 15) * 64, MapId(), fl);
        } else if (task < TA_E6) {
            const int tt = task - TA_E5;
            tconv_tile(p.peer_wq, 2048, (bf16_t*)(p.ws + OFF_WQ), 1024, (tt >> 4) * 64, (tt & 15) * 64, MapId(), fl);
        } else if (task < TA_E10) {
            const bool second = task >= TA_E9;
            const int tt = task - (second ? TA_E9 : TA_E8);
            const float* src = second ? p.peer_k2 : p.peer_k1;
            bf16_t* dst = (bf16_t*)(p.ws + OFF_K1B) + (second ? 131072 : 0);
            const int i = tt * 2048 + tid * 8;
            const f32x4 a = *(const f32x4*)(src + i), b = *(const f32x4*)(src + i + 4);
            *(u32x4*)(dst + i) = (u32x4){pack2(a[0], a[1]), pack2(a[2], a[3]), pack2(b[0], b[1]), pack2(b[2], b[3])};
        }
    }
}

__device__ void phase_modnorm(const Params& p, const float* __restrict__ src, const bf16_t* __restrict__ srcb, const float* __restrict__ g, int shift_idx, int scale_idx, bf16_t* __restrict__ dst) {
    const int tid_ = TIDX; const int lane = tid_ & 63, wave = tid_ >> 6;
    const float* mod = (const float*)(p.ws + OFF_MOD);
    for (int tok = vblk() * 4 + wave; tok < NTOK; tok += vgrid() * 4) {
        const int b = tok >> 11;
        const float* xr = src + (size_t)tok * DM;
        f32x4 v[4];
        float ss = 0.f;
#pragma unroll
        for (int c = 0; c < 4; c++) {
            if (srcb) {
                const u32x2 w = *(const u32x2*)(srcb + (size_t)tok * DM + c * 256 + lane * 4);
                v[c] = (f32x4){bf_lo(w.x), bf_hi(w.x), bf_lo(w.y), bf_hi(w.y)};
            } else v[c] = *(const f32x4*)(xr + c * 256 + lane * 4);
            ss += v[c][0] * v[c][0] + v[c][1] * v[c][1] + v[c][2] * v[c][2] + v[c][3] * v[c][3];
        }
        ss = wave_sum(ss);
        const float rstd = rsqrtf(ss * (1.f / 1024.f) + 1e-6f);
#pragma unroll
        for (int c = 0; c < 4; c++) {
            const int d = c * 256 + lane * 4;
            const f32x4 gg = *(const f32x4*)(g + d);
            const f32x4 sc = *(const f32x4*)(mod + b * 6144 + scale_idx * 1024 + d);
            const f32x4 sh = *(const f32x4*)(mod + b * 6144 + shift_idx * 1024 + d);
            float o[4];
#pragma unroll
            for (int j = 0; j < 4; j++) o[j] = (v[c][j] * rstd) * gg[j] * (1.f + sc[j]) + sh[j];
            *(u32x2*)(dst + (size_t)tok * DM + d) = (u32x2){pack2(o[0], o[1]), pack2(o[2], o[3])};
        }
    }
}

__device__ void phaseC(const Params& p, char* lds) {
    const int tid_ = TIDX512; const int lane = tid_ & 63, wave = tid_ >> 6;
    const int wr = wave >> 2, wc = wave & 3, r = lane & 15, q = lane >> 4;
    const bf16_t* H = (const bf16_t*)(p.ws + OFF_H);
    const bf16_t* W = (const bf16_t*)(p.ws + OFF_WIN);
    bf16_t* Z = (bf16_t*)(p.ws + OFF_Z);
    const float* cs = (const float*)(p.ws + OFF_ROPE);
    constexpr int NTN = (ZC + 255) / 256;
    TileIter tit(NTN, lds);
    int bm, bn;
    while (tit.next(bm, bn)) {
        const int m0 = bm * 256, n0 = bn * 256;
        f32x4 acc[8][4];
        zero_acc(acc);
        gemm_core(acc, H, DM, W, DM, DM, m0, n0, lds);
        const int c0 = n0 + wc * 64;
        const bool isq = (c0 >= ZQ_N && c0 < ZKC);
        const bool rope = isq || (c0 >= ZKC && c0 < ZGATE && ((c0 - ZKC) & 255) < 128);
        const float scl = isq ? 0.18033688011112042f : 1.f;
#pragma unroll
        for (int mi = 0; mi < 8; mi++) {
            const int tok = m0 + wr * 128 + mi * 16 + r;
            if (rope) {
                f32x4 v = acc[mi][0];
                f32x4 pr;
#pragma unroll
                for (int j = 0; j < 4; j++) pr[j] = __shfl_xor(v[j], 32, 64);
                const int ib = (q & 1) * 4;
                const f32x4 k0 = *(const f32x4*)(cs + (size_t)tok * 16 + ib * 2);
                const f32x4 k1 = *(const f32x4*)(cs + (size_t)tok * 16 + ib * 2 + 4);
                const float cc[4] = {k0[0], k0[2], k1[0], k1[2]}, sn[4] = {k0[1], k0[3], k1[1], k1[3]};
#pragma unroll
                for (int j = 0; j < 4; j++) v[j] = (q < 2) ? (v[j] * cc[j] - pr[j] * sn[j]) : (v[j] * cc[j] + pr[j] * sn[j]);
                acc[mi][0] = v;
            }
#pragma unroll
            for (int ni = 0; ni < 4; ni++) epi_fill(lds, wr, wc, r, q, mi, ni, acc[mi][ni] * scl);
        }
        if ((c0 >= ZVS && c0 < ZVS + 128) || (c0 >= ZVW && c0 < ZVW + 128)) {
            const int brn = c0 >= ZVW ? 1 : 0, gg = ((c0 - (brn ? ZVW : ZVS)) >> 6) & 1;
            const int bb = m0 >> 11, ts = (m0 & 2047) + wr * 128 + r;
            bf16_t* vt = (bf16_t*)(p.ws + OFF_VT) + ((size_t)((brn * 8 + bb) * 2 + gg) * 64) * SEQ + ts;
#pragma unroll
            for (int mi = 0; mi < 8; mi++)
#pragma unroll
                for (int ni = 0; ni < 4; ni++)
#pragma unroll
                    for (int j = 0; j < 4; j++) vt[(size_t)(ni * 16 + 4 * q + j) * SEQ + mi * 16] = f2bf(acc[mi][ni][j]);
        }
        __syncthreads();
        epi_store(lds, Z, ZC, m0, n0, ZC);
        __syncthreads();
    }
}

__device__ __forceinline__ void gla_prep(const Params& p, int tok0, int h, char* lds) {
    const int tid = TIDX;
    float* bc = (float*)lds;
    float* lrs = (float*)(lds + 32768);
    const bf16_t* Z = (const bf16_t*)(p.ws + OFF_Z);
    for (int i = tid; i < 1024; i += NTHREADS) { const int t = i >> 4, rr = i & 15; lrs[i] = bf2f(Z[(size_t)(tok0 + t) * ZC + ZLR + rr]); }
    const int d = tid & 127, th = tid >> 7;
    float w[16];
#pragma unroll
    for (int rr = 0; rr < 16; rr++) w[rr] = p.gla_wa2[rr * 512 + h * 128 + d];
    const float bias = p.gla_ba2[h * 128 + d];
    __syncthreads();
    float run = 0.f;
    for (int t = th * 32; t < th * 32 + 32; t++) {
        float xv = bias;
#pragma unroll
        for (int rr = 0; rr < 16; rr++) xv += lrs[t * 16 + rr] * w[rr];
        const float ls = fminf(xv, 0.f) - __logf(1.f + __expf(-fabsf(xv)));
        run += ls * (1.f / 16.f);
        bc[t * 128 + d] = run;
    }
    __syncthreads();
    if (th == 1) {
        const float add = bc[31 * 128 + d];
        for (int t = 32; t < 64; t++) bc[t * 128 + d] += add;
    }
    __syncthreads();
}

__device__ void phaseG1_task(const Params& p, int task, char* lds) {
    const int tid = TIDX, lane = tid & 63, wave = tid >> 6, r = lane & 15, q = lane >> 4;
    const int c = task & 31, h = (task >> 5) & 3, b = task >> 7;
    const int tok0 = b * SEQ + c * 64;
    const bf16_t* Z = (const bf16_t*)(p.ws + OFF_Z);
    bf16_t* L = (bf16_t*)p.out;
    float* bc = (float*)lds;
    bf16_t* klT = (bf16_t*)(lds + 36864);
    bf16_t* vT = (bf16_t*)(lds + 36864 + 18432);
    gla_prep(p, tok0, h, lds);
    if (tid < 128) ((float*)(p.ws + OFF_DEC))[task * 128 + tid] = __expf(bc[63 * 128 + tid]);
    {
        f32x4* bg = (f32x4*)(p.ws + OFF_M) + (size_t)task * 2048;
#pragma unroll
        for (int i = 0; i < 8; i++) bg[i * 256 + tid] = ((const f32x4*)bc)[i * 256 + tid];
    }
    {
        const int s = lane, dc = wave * 32;
        const bf16_t* kp = Z + (size_t)(tok0 + s) * ZC + ZK_G + h * 128 + dc;
#pragma unroll
        for (int v4 = 0; v4 < 4; v4++) {
            const u32x4 kv = *(const u32x4*)(kp + v4 * 8);
            const unsigned kw[4] = {kv.x, kv.y, kv.z, kv.w};
#pragma unroll
            for (int j = 0; j < 8; j++) {
                const int d = dc + v4 * 8 + j;
                const float kval = (j & 1) ? bf_hi(kw[j >> 1]) : bf_lo(kw[j >> 1]);
                klT[d * 72 + s] = f2bf(kval * __expf(bc[63 * 128 + d] - bc[s * 128 + d]));
            }
        }
    }
    for (int eh = 0; eh < 2; eh++) {
        __syncthreads();
        {
            const int s = lane, ec = wave * 32;
            const bf16_t* vp = Z + (size_t)(tok0 + s) * ZC + ZV_G + h * 256 + eh * 128 + ec;
#pragma unroll
            for (int v4 = 0; v4 < 4; v4++) {
                const u32x4 vv = *(const u32x4*)(vp + v4 * 8);
                const unsigned vw[4] = {vv.x, vv.y, vv.z, vv.w};
#pragma unroll
                for (int j = 0; j < 8; j++) vT[(ec + v4 * 8 + j) * 72 + s] = (bf16_t)((j & 1) ? (vw[j >> 1] >> 16) : (vw[j >> 1] & 0xffffu));
            }
        }
        __syncthreads();
        f32x4 acc[8][2];
#pragma unroll
        for (int dt = 0; dt < 8; dt++) { acc[dt][0] = (f32x4){0.f, 0.f, 0.f, 0.f}; acc[dt][1] = (f32x4){0.f, 0.f, 0.f, 0.f}; }
#pragma unroll
        for (int ks = 0; ks < 2; ks++) {
            bf16x8 bv[2];
#pragma unroll
            for (int x = 0; x < 2; x++) bv[x] = ld_frag(vT + ((2 * wave + x) * 16 + r) * 72 + ks * 32 + q * 8);
#pragma unroll
            for (int dt = 0; dt < 8; dt++) {
                const bf16x8 a = ld_frag(klT + (dt * 16 + r) * 72 + ks * 32 + q * 8);
#pragma unroll
                for (int x = 0; x < 2; x++) acc[dt][x] = mfma16(a, bv[x], acc[dt][x]);
            }
        }
#pragma unroll
        for (int dt = 0; dt < 8; dt++)
#pragma unroll
            for (int x = 0; x < 2; x++) {
                const int e = eh * 128 + (2 * wave + x) * 16 + r, d = dt * 16 + 4 * q;
                const f32x4 v = acc[dt][x];
                *(u32x2*)(L + ((size_t)task * 256 + e) * 128 + d) = (u32x2){pack2(v[0], v[1]), pack2(v[2], v[3])};
            }
    }
    __syncthreads();
}

__device__ void phaseG2(const Params& p) {
    bf16_t* L = (bf16_t*)p.out;
    const float* dec = (const float*)(p.ws + OFF_DEC);
    for (int idx = vblk() * NTHREADS + (int)(threadIdx.x & 255); idx < 32 * 256 * 16; idx += vgrid() * NTHREADS) {
        const int d8 = idx & 15, e = (idx >> 4) & 255, bh = idx >> 12;
        float st[8];
#pragma unroll
        for (int j = 0; j < 8; j++) st[j] = 0.f;
        for (int c = 0; c < 32; c++) {
            const int task = bh * 32 + c;
            u32x4* ptr = (u32x4*)(L + ((size_t)task * 256 + e) * 128 + d8 * 8);
            const u32x4 lv = *ptr;
            const f32x4 d0 = *(const f32x4*)(dec + task * 128 + d8 * 8), d1 = *(const f32x4*)(dec + task * 128 + d8 * 8 + 4);
            *ptr = (u32x4){pack2(st[0], st[1]), pack2(st[2], st[3]), pack2(st[4], st[5]), pack2(st[6], st[7])};
            st[0] = d0[0] * st[0] + bf_lo(lv.x); st[1] = d0[1] * st[1] + bf_hi(lv.x);
            st[2] = d0[2] * st[2] + bf_lo(lv.y); st[3] = d0[3] * st[3] + bf_hi(lv.y);
            st[4] = d1[0] * st[4] + bf_lo(lv.z); st[5] = d1[1] * st[5] + bf_hi(lv.z);
            st[6] = d1[2] * st[6] + bf_lo(lv.w); st[7] = d1[3] * st[7] + bf_hi(lv.w);
        }
    }
}

__device__ void phaseG3_task(const Params& p, int task, char* lds, bf16_t* ydst, int ystride) {
    const int tid = TIDX, lane = tid & 63, wave = tid >> 6, r = lane & 15, q = lane >> 4;
    const int c = task & 31, h = (task >> 5) & 3, b = task >> 7;
    const int tok0 = b * SEQ + c * 64;
    bf16_t* Z = (bf16_t*)(p.ws + OFF_Z);
    const bf16_t* ST = (const bf16_t*)p.out + (size_t)task * 256 * 128;
    float* bc = (float*)lds;
    bf16_t* vT = (bf16_t*)lds;
    bf16_t* qg = (bf16_t*)(lds + 36864);
    bf16_t* kg = (bf16_t*)(lds + 36864 + 17408);
    bf16_t* P = kg;
    float* red = (float*)(lds + 36864 + 2 * 17408);
    {
        const f32x4* bg = (const f32x4*)(p.ws + OFF_M) + (size_t)task * 2048;
#pragma unroll
        for (int i = 0; i < 8; i++) ((f32x4*)bc)[i * 256 + tid] = bg[i * 256 + tid];
    }
    __syncthreads();
    {
        const int t = tid >> 2, dc = (tid & 3) * 32;
        const bf16_t* qp = Z + (size_t)(tok0 + t) * ZC + ZQ_G + h * 128 + dc;
        const bf16_t* kp = Z + (size_t)(tok0 + t) * ZC + ZK_G + h * 128 + dc;
#pragma unroll
        for (int v4 = 0; v4 < 4; v4++) {
            const u32x4 qv = *(const u32x4*)(qp + v4 * 8), kv = *(const u32x4*)(kp + v4 * 8);
            const unsigned qw[4] = {qv.x, qv.y, qv.z, qv.w}, kw[4] = {kv.x, kv.y, kv.z, kv.w};
            unsigned qo[4], ko[4];
#pragma unroll
            for (int j2 = 0; j2 < 4; j2++) {
                const int d = dc + v4 * 8 + j2 * 2;
                const float b0 = bc[t * 128 + d], b1 = bc[t * 128 + d + 1];
                qo[j2] = pack2(bf_lo(qw[j2]) * 0.08838834764831845f * __expf(b0), bf_hi(qw[j2]) * 0.08838834764831845f * __expf(b1));
                ko[j2] = pack2(bf_lo(kw[j2]) * __expf(-b0), bf_hi(kw[j2]) * __expf(-b1));
            }
            *(u32x4*)(qg + t * 136 + dc + v4 * 8) = (u32x4){qo[0], qo[1], qo[2], qo[3]};
            *(u32x4*)(kg + t * 136 + dc + v4 * 8) = (u32x4){ko[0], ko[1], ko[2], ko[3]};
        }
    }
    __syncthreads();
    {
        const int s = lane, ec = wave * 64;
        const bf16_t* vp = Z + (size_t)(tok0 + s) * ZC + ZV_G + h * 256 + ec;
#pragma unroll
        for (int v4 = 0; v4 < 8; v4++) {
            const u32x4 vv = *(const u32x4*)(vp + v4 * 8);
            const unsigned vw[4] = {vv.x, vv.y, vv.z, vv.w};
#pragma unroll
            for (int j = 0; j < 8; j++) vT[(ec + v4 * 8 + j) * 72 + s] = (bf16_t)((j & 1) ? (vw[j >> 1] >> 16) : (vw[j >> 1] & 0xffffu));
        }
    }
    f32x4 sc[4];
#pragma unroll
    for (int st = 0; st < 4; st++) sc[st] = (f32x4){0.f, 0.f, 0.f, 0.f};
    {
        bf16x8 qf[4];
#pragma unroll
        for (int ks = 0; ks < 4; ks++) qf[ks] = ld_frag(qg + (wave * 16 + r) * 136 + ks * 32 + q * 8);
#pragma unroll
        for (int st = 0; st < 4; st++) {
            if (st <= wave) {
#pragma unroll
                for (int ks = 0; ks < 4; ks++) sc[st] = mfma16(ld_frag(kg + (st * 16 + r) * 136 + ks * 32 + q * 8), qf[ks], sc[st]);
            }
        }
    }
    __syncthreads();
    {
        const int t = wave * 16 + r;
#pragma unroll
        for (int st = 0; st < 4; st++) {
            float pv[4];
#pragma unroll
            for (int j = 0; j < 4; j++) { const int s = st * 16 + 4 * q + j; pv[j] = (s <= t) ? sc[st][j] : 0.f; }
            *(u32x2*)(P + t * 72 + st * 16 + 4 * q) = (u32x2){pack2(pv[0], pv[1]), pack2(pv[2], pv[3])};
        }
    }
    __syncthreads();
    f32x4 o[4][4];
#pragma unroll
    for (int et = 0; et < 4; et++)
#pragma unroll
        for (int tt = 0; tt < 4; tt++) o[et][tt] = (f32x4){0.f, 0.f, 0.f, 0.f};
#pragma unroll
    for (int ks = 0; ks < 2; ks++) {
        bf16x8 pf[4];
#pragma unroll
        for (int tt = 0; tt < 4; tt++) pf[tt] = ld_frag(P + (tt * 16 + r) * 72 + ks * 32 + q * 8);
#pragma unroll
        for (int et = 0; et < 4; et++) {
            const bf16x8 a = ld_frag(vT + ((wave * 4 + et) * 16 + r) * 72 + ks * 32 + q * 8);
#pragma unroll
            for (int tt = 0; tt < 4; tt++) o[et][tt] = mfma16(a, pf[tt], o[et][tt]);
        }
    }
#pragma unroll
    for (int ks = 0; ks < 4; ks++) {
        bf16x8 qf[4];
#pragma unroll
        for (int tt = 0; tt < 4; tt++) qf[tt] = ld_frag(qg + (tt * 16 + r) * 136 + ks * 32 + q * 8);
#pragma unroll
        for (int et = 0; et < 4; et++) {
            const bf16x8 a = *(const bf16x8*)(ST + (size_t)((wave * 4 + et) * 16 + r) * 128 + ks * 32 + q * 8);
#pragma unroll
            for (int tt = 0; tt < 4; tt++) o[et][tt] = mfma16(a, qf[tt], o[et][tt]);
        }
    }
#pragma unroll
    for (int tt = 0; tt < 4; tt++) {
        float ss = 0.f;
#pragma unroll
        for (int et = 0; et < 4; et++)
#pragma unroll
            for (int j = 0; j < 4; j++) ss += o[et][tt][j] * o[et][tt][j];
        ss = xrow_sum(ss);
        if (q == 0) red[wave * 64 + tt * 16 + r] = ss;
    }
    __syncthreads();
#pragma unroll
    for (int tt = 0; tt < 4; tt++) {
        const int t = tt * 16 + r;
        const float tot = red[t] + red[64 + t] + red[128 + t] + red[192 + t];
        const float rstd = rsqrtf(tot * (1.f / 256.f) + 1e-6f);
#pragma unroll
        for (int et = 0; et < 4; et++) {
            const int e = (wave * 4 + et) * 16 + 4 * q;
            bf16_t* rp = Z + (size_t)(tok0 + t) * ZC + ZR_G + h * 256 + e;
            const u32x2 rv = *(const u32x2*)rp;
            const f32x4 gn = *(const f32x4*)(p.gla_norm_g + e);
            const float r0 = bf_lo(rv.x), r1 = bf_hi(rv.x), r2 = bf_lo(rv.y), r3 = bf_hi(rv.y);
            const f32x4 ov = o[et][tt];
            *(u32x2*)(ydst + (size_t)(tok0 + t) * ystride + h * 256 + e) = (u32x2){pack2(ov[0] * rstd * gn[0] * siluf_(r0), ov[1] * rstd * gn[1] * siluf_(r1)),
                                  pack2(ov[2] * rstd * gn[2] * siluf_(r2), ov[3] * rstd * gn[3] * siluf_(r3))};
        }
    }
    __syncthreads();
}

__device__ void phaseN1_wg(const Params& p, int task, char* ldsb) {
    const int tid = TIDX512, lane = tid & 63, wave = tid >> 6, r = lane & 15, q = lane >> 4;
    const int it = task & 7, g = (task >> 3) & 1, b = (task >> 4) & 7, kv = task >> 7;
    const bf16_t* Z = (const bf16_t*)(p.ws + OFF_Z);
    const bf16_t* W1 = (const bf16_t*)(p.ws + OFF_WC1) + (size_t)kv * 64 * 2048;
    const float* pe = kv ? p.pe_v : p.pe_k;
    const float* w2 = kv ? p.cv_w2 : p.ck_w2;
    const int zoff = (kv ? ZVC : ZKC) + g * 64;
    float* hid = (float*)ldsb;
    float* hid2 = (float*)(ldsb + 32768);
    float* w2s = (float*)(ldsb + 36864);
    {
        f32x4 wv[2];
#pragma unroll
        for (int k = 0; k < 2; k++) wv[k] = *(const f32x4*)(w2 + (k * 512 + tid) * 4);
#pragma unroll
        for (int k = 0; k < 2; k++) *(f32x4*)(w2s + (k * 512 + tid) * 4) = wv[k];
    }
    int i = it * 16 + r; if (i > 126) i = 126;
    f32x4 acc[4];
#pragma unroll
    for (int nt = 0; nt < 4; nt++) acc[nt] = (f32x4){0.f, 0.f, 0.f, 0.f};
#pragma unroll 4
    for (int ks = 0; ks < 8; ks++) {
        const int k = wave * 256 + ks * 32 + q * 8;
        const int l = k >> 6, d = k & 63;
        const u32x4 zv = *(const u32x4*)(Z + (size_t)(b * SEQ + i * 16 + l) * ZC + zoff + d);
        const f32x4 p0 = *(const f32x4*)(pe + l * 64 + d), p1 = *(const f32x4*)(pe + l * 64 + d + 4);
        const u32x4 av = {pack2(bf_lo(zv.x) + p0[0], bf_hi(zv.x) + p0[1]), pack2(bf_lo(zv.y) + p0[2], bf_hi(zv.y) + p0[3]),
                          pack2(bf_lo(zv.z) + p1[0], bf_hi(zv.z) + p1[1]), pack2(bf_lo(zv.w) + p1[2], bf_hi(zv.w) + p1[3])};
        const bf16x8 a = __builtin_bit_cast(bf16x8, av);
#pragma unroll
        for (int nt = 0; nt < 4; nt++) {
            const bf16x8 bw = *(const bf16x8*)(W1 + (size_t)(nt * 16 + r) * 2048 + k);
            acc[nt] = mfma16(a, bw, acc[nt]);
        }
    }
#pragma unroll
    for (int nt = 0; nt < 4; nt++)
#pragma unroll
        for (int j = 0; j < 4; j++) hid[(wave * 16 + 4 * q + j) * 64 + nt * 16 + r] = acc[nt][j];
    __syncthreads();
    for (int e = tid; e < 1024; e += BLOCK_THREADS) {
        float s = 0.f;
#pragma unroll
        for (int w = 0; w < 8; w++) s += hid[w * 1024 + e];
        hid2[e] = gelu_erf(s);
    }
    __syncthreads();
    {
        const int il = tid >> 5, n2 = (tid & 31) * 2;
        float o0 = 0.f, o1 = 0.f;
#pragma unroll 16
        for (int n = 0; n < 64; n++) {
            const float hv = hid2[il * 64 + n];
            const f32x2 wv = *(const f32x2*)(w2s + n * 64 + n2);
            o0 += hv * wv[0]; o1 += hv * wv[1];
        }
        const int ig = it * 16 + il;
        if (ig >= 127) { o0 = 0.f; o1 = 0.f; }
        bf16_t* dst = (bf16_t*)(p.ws + OFF_CMP) + ((size_t)((kv * 8 + b) * 2 + g) * 128 + ig) * 64 + n2;
        *(unsigned*)dst = pack2(o0, o1);
    }
    __syncthreads();
}

__device__ __forceinline__ void nsa_block_step(const bf16_t* Ks, const bf16_t* VT, const bf16x8 (&qf)[2][2], f32x4 (&O)[2][4], float (&m)[2], float (&l)[2],
                                               int klo, int khi, int r, int q) {
    f32x4 s[2][4];
#pragma unroll
    for (int x = 0; x < 2; x++)
#pragma unroll
        for (int kt = 0; kt < 4; kt++) s[x][kt] = (f32x4){0.f, 0.f, 0.f, 0.f};
#pragma unroll
    for (int kt = 0; kt < 4; kt++)
#pragma unroll
        for (int ks = 0; ks < 2; ks++) {
            const bf16x8 kf = ld_frag(Ks + (kt * 16 + r) * 64 + (((ks * 4 + q) ^ (r & 7)) * 8));
#pragma unroll
            for (int x = 0; x < 2; x++) s[x][kt] = mfma16(kf, qf[x][ks], s[x][kt]);
        }
    if (!__all((klo <= 0) && (khi >= 63))) {
        const int a = 4 * q - klo;
        const unsigned range = (unsigned)(khi - klo);
        const bool any = khi >= klo;
#pragma unroll
        for (int kt = 0; kt < 4; kt++)
#pragma unroll
            for (int j = 0; j < 4; j++) {
                const bool valid = any && ((unsigned)(kt * 16 + j + a) <= range);
#pragma unroll
                for (int x = 0; x < 2; x++) s[x][kt][j] = valid ? s[x][kt][j] : -3.0e38f;
            }
    }
    bf16x8 pbv[2][2];
#pragma unroll
    for (int x = 0; x < 2; x++) {
        float mx = fmaxf(fmaxf(fmaxf(s[x][0][0], s[x][0][1]), fmaxf(s[x][0][2], s[x][0][3])), fmaxf(fmaxf(s[x][1][0], s[x][1][1]), fmaxf(s[x][1][2], s[x][1][3])));
        mx = fmaxf(mx, fmaxf(fmaxf(fmaxf(s[x][2][0], s[x][2][1]), fmaxf(s[x][2][2], s[x][2][3])), fmaxf(fmaxf(s[x][3][0], s[x][3][1]), fmaxf(s[x][3][2], s[x][3][3]))));
        mx = xrow_max(mx);
        const float mnew = fmaxf(m[x], mx);
        const float alpha = exp2f_(m[x] - mnew);
        m[x] = mnew;
        float ls = 0.f;
#pragma unroll
        for (int kt = 0; kt < 4; kt++)
#pragma unroll
            for (int j = 0; j < 4; j++) { const float pv = exp2f_(s[x][kt][j] - mnew); s[x][kt][j] = pv; ls += pv; }
        l[x] = l[x] * alpha + ls;
#pragma unroll
        for (int dt = 0; dt < 4; dt++) O[x][dt] *= alpha;
#pragma unroll
        for (int s2 = 0; s2 < 2; s2++) {
            const u32x4 t4 = {pack2(s[x][2 * s2][0], s[x][2 * s2][1]), pack2(s[x][2 * s2][2], s[x][2 * s2][3]),
                              pack2(s[x][2 * s2 + 1][0], s[x][2 * s2 + 1][1]), pack2(s[x][2 * s2 + 1][2], s[x][2 * s2 + 1][3])};
            pbv[x][s2] = __builtin_bit_cast(bf16x8, t4);
        }
    }
#pragma unroll
    for (int s2 = 0; s2 < 2; s2++)
#pragma unroll
        for (int dt = 0; dt < 4; dt++) {
            const u32x2 lo = *(const u32x2*)(VT + (dt * 16 + r) * 72 + (2 * s2) * 16 + 4 * q);
            const u32x2 hi = *(const u32x2*)(VT + (dt * 16 + r) * 72 + (2 * s2 + 1) * 16 + 4 * q);
            const bf16x8 va = mk_frag(lo, hi);
#pragma unroll
            for (int x = 0; x < 2; x++) O[x][dt] = mfma16(va, pbv[x][s2], O[x][dt]);
        }
}

__device__ __forceinline__ void nsa_cmp_probs(const bf16_t* Kc, const bf16x8 (&qfx)[2], int nv, int r, int q, f32x4 (&s)[8]) {
#pragma unroll
    for (int kt = 0; kt < 8; kt++) s[kt] = (f32x4){0.f, 0.f, 0.f, 0.f};
#pragma unroll
    for (int kt = 0; kt < 8; kt++)
#pragma unroll
        for (int ks = 0; ks < 2; ks++) s[kt] = mfma16(ld_frag(Kc + (kt * 16 + r) * 72 + ks * 32 + q * 8), qfx[ks], s[kt]);
    float mx = -1e30f;
#pragma unroll
    for (int kt = 0; kt < 8; kt++)
#pragma unroll
        for (int j = 0; j < 4; j++) if (kt * 16 + 4 * q + j < nv) mx = fmaxf(mx, s[kt][j]);
    mx = xrow_max(mx);
    float ls = 0.f;
#pragma unroll
    for (int kt = 0; kt < 8; kt++)
#pragma unroll
        for (int j = 0; j < 4; j++) {
            const float pv = (kt * 16 + 4 * q + j < nv) ? exp2f_(s[kt][j] - mx) : 0.f;
            s[kt][j] = pv; ls += pv;
        }
    ls = xrow_sum(ls);
    const float inv = nv > 0 ? 1.f / ls : 0.f;
#pragma unroll
    for (int kt = 0; kt < 8; kt++) s[kt] *= inv;
}

__device__ void phaseN2_task(const Params& p, int task, char* lds, bf16_t* ydst, int ystride, volatile unsigned* uex, char* ldsb) {
    const int tid = TIDX, lane = tid & 63, wave = tid >> 6, r = lane & 15, q = lane >> 4;
    const int t512 = tid + half_id() * 256;
    const int pair = task >> 1, g = pair & 1, b = (pair >> 1) & 7;
    const int hi_ = pair >> 4, kq_ = hi_ >> 4, aa_ = hi_ & 15;
    const int tpi_ = kq_ == 0 ? 63 - aa_ : (kq_ == 1 ? 32 + aa_ : (kq_ == 2 ? 31 - aa_ : aa_));
    const int tt = tpi_ * 2 + (task & 1);
    const int t0 = tt * 16, t = t0 + r;
    const int cur = t0 >> 6;
    bf16_t* Z = (bf16_t*)(p.ws + OFF_Z);
    const size_t rowb = (size_t)b * SEQ;
    bf16_t* Kc = (bf16_t*)ldsb;
    bf16_t* VcT = (bf16_t*)(ldsb + 18432);
    bf16_t* Ks = (bf16_t*)ldsb;
    bf16_t* VT = (bf16_t*)(ldsb + 18432);
    float* impw = (float*)(lds + 35840);
    float* scs = (float*)(lds + 35840 + 32768);
    unsigned* selm = (unsigned*)(lds + 35840 + 32768 + 2048);

    bf16x8 qf[2][2];
#pragma unroll
    for (int x = 0; x < 2; x++)
#pragma unroll
        for (int ks = 0; ks < 2; ks++) qf[x][ks] = *(const bf16x8*)(Z + (rowb + t) * ZC + ZQ_N + (g * 8 + 2 * wave + x) * 64 + ks * 32 + q * 8);
    f32x4* ofl = (f32x4*)(lds + 35840);
    float gatev[3][2];
#pragma unroll
    for (int bb = 0; bb < 3; bb++)
#pragma unroll
        for (int x = 0; x < 2; x++) gatev[bb][x] = bf2f(Z[(rowb + t) * ZC + ZGATE + bb * 16 + g * 8 + 2 * wave + x]);

    f32x4 Og[2][4];
    {
        const bf16_t* kc = (const bf16_t*)(p.ws + OFF_CMP) + (size_t)((0 * 8 + b) * 2 + g) * 128 * 64;
        const bf16_t* vc = (const bf16_t*)(p.ws + OFF_CMP) + (size_t)((1 * 8 + b) * 2 + g) * 128 * 64;
        {
            const int key = t512 >> 2, ch = (t512 & 3) * 16;
#pragma unroll
            for (int v4 = 0; v4 < 2; v4++) *(u32x4*)(Kc + key * 72 + ch + v4 * 8) = *(const u32x4*)(kc + key * 64 + ch + v4 * 8);
            const int k2 = t512 & 127, dc = (t512 >> 7) * 16;
#pragma unroll
            for (int v4 = 0; v4 < 2; v4++) {
                const u32x4 a = *(const u32x4*)(vc + k2 * 64 + dc + v4 * 8);
                const unsigned w[4] = {a.x, a.y, a.z, a.w};
#pragma unroll
                for (int j = 0; j < 8; j++) VcT[(dc + v4 * 8 + j) * 136 + k2] = (bf16_t)((j & 1) ? (w[j >> 1] >> 16) : (w[j >> 1] & 0xffffu));
            }
        }
        __syncthreads();
        int nv = t >= 31 ? ((t - 31) >> 4) + 1 : 0;
        if (nv > 127) nv = 127;
        f32x4 isum[8];
#pragma unroll
        for (int kt = 0; kt < 8; kt++) isum[kt] = (f32x4){0.f, 0.f, 0.f, 0.f};
#pragma unroll
        for (int x = 0; x < 2; x++) {
            f32x4 s[8];
            nsa_cmp_probs(Kc, qf[x], nv, r, q, s);
#pragma unroll
            for (int kt = 0; kt < 8; kt++) isum[kt] += s[kt];
            f32x4 Oc[4];
#pragma unroll
            for (int dt = 0; dt < 4; dt++) Oc[dt] = (f32x4){0.f, 0.f, 0.f, 0.f};
            __builtin_amdgcn_sched_barrier(0);
#pragma unroll
            for (int s2 = 0; s2 < 4; s2++) {
                const u32x4 t4 = {pack2(s[2 * s2][0], s[2 * s2][1]), pack2(s[2 * s2][2], s[2 * s2][3]),
                                  pack2(s[2 * s2 + 1][0], s[2 * s2 + 1][1]), pack2(s[2 * s2 + 1][2], s[2 * s2 + 1][3])};
                const bf16x8 pbv = __builtin_bit_cast(bf16x8, t4);
#pragma unroll
                for (int dt = 0; dt < 4; dt++) {
                    const u32x2 lo = *(const u32x2*)(VcT + (dt * 16 + r) * 136 + (2 * s2) * 16 + 4 * q);
                    const u32x2 hi = *(const u32x2*)(VcT + (dt * 16 + r) * 136 + (2 * s2 + 1) * 16 + 4 * q);
                    Oc[dt] = mfma16(mk_frag(lo, hi), pbv, Oc[dt]);
                }
            }
            const float g0 = sigmoidf_(gatev[0][x]);
#pragma unroll
            for (int dt = 0; dt < 4; dt++) Og[x][dt] = g0 * Oc[dt];
            __builtin_amdgcn_sched_barrier(0);
        }
#pragma unroll
        for (int kt = 0; kt < 8; kt++) *(f32x4*)(impw + (wave * 16 + r) * 128 + kt * 16 + 4 * q) = isum[kt];
        __syncthreads();
#pragma unroll
        for (int pass = 0; pass < 2; pass++) {
            const int tk = pass * 8 + (tid >> 5), j = tid & 31;
            const int i0 = j == 0 ? 0 : 4 * j - 1, i1 = (4 * j + 3 > 126) ? 126 : 4 * j + 3;
            float sc = 0.f;
            for (int i = i0; i <= i1; i++) sc += (impw[(0 * 16 + tk) * 128 + i] + impw[(1 * 16 + tk) * 128 + i]) + (impw[(2 * 16 + tk) * 128 + i] + impw[(3 * 16 + tk) * 128 + i]);
            const bool forced = (j == 0) || (j == cur) || (j == cur - 1);
            scs[tk * 32 + j] = forced ? 1e6f : (j <= cur ? sc : -1.f);
        }
        __syncthreads();
#pragma unroll
        for (int pass = 0; pass < 2; pass++) {
            const int tk = pass * 8 + (tid >> 5), j = tid & 31;
            const float mine = scs[tk * 32 + j];
            int rank = 0;
            for (int j2 = 0; j2 < 32; j2++) { const float o = scs[tk * 32 + j2]; rank += (o > mine || (o == mine && j2 < j)) ? 1 : 0; }
            const unsigned long long bal = __ballot(rank < 16);
            if ((lane & 31) == 0) selm[tk] = (unsigned)(lane ? (bal >> 32) : (bal & 0xffffffffull));
        }
        __syncthreads();
    }
#pragma unroll
    for (int x = 0; x < 2; x++)
#pragma unroll
        for (int dt = 0; dt < 4; dt++) ofl[(wave * 8 + x * 4 + dt) * 64 + lane] = Og[x][dt];
    const unsigned mysel = selm[r];
    unsigned uni = 0;
#pragma unroll
    for (int i = 0; i < 16; i++) uni |= selm[i];
    if (tid == 0) uex[half_id()] = uni;
    __syncthreads();
    uni = uex[0] | uex[1];
    uni &= (cur == 31) ? 0xffffffffu : ((2u << cur) - 1u);
    uni |= 1u;

    {
        const int lo = (t0 & ~31) - 511;
        const int jb0 = lo > 0 ? (lo >> 6) : 0;
        const int kkey = t512 >> 3, kch = (t512 & 7) * 8;
        const int vd = t512 >> 3, vch = (t512 & 7) * 8;
        const bf16_t* vtb = (const bf16_t*)(p.ws + OFF_VT) + ((size_t)(b * 2 + g) * 64 + vd) * SEQ + vch;
        u32x4 kreg, vreg;
        int br = 0, j = 0;
        {
            const bf16_t* kb = Z + (rowb + 0) * ZC + ZKS + g * 64;
            kreg = *(const u32x4*)(kb + (size_t)kkey * ZC + kch);
            vreg = *(const u32x4*)(vtb);
        }
        f32x4 O[2][4];
        float m[2] = {-1e30f, -1e30f}, l[2] = {0.f, 0.f};
#pragma unroll
        for (int x = 0; x < 2; x++)
#pragma unroll
            for (int dt = 0; dt < 4; dt++) O[x][dt] = (f32x4){0.f, 0.f, 0.f, 0.f};
        for (;;) {
            __syncthreads();
            *(u32x4*)(Ks + kkey * 64 + (((kch >> 3) ^ (kkey & 7)) * 8)) = kreg;
            *(u32x4*)(VT + vd * 72 + vch) = vreg;
            __syncthreads();
            int nbr, nj;
            if (br == 0) {
                const unsigned rem = (j >= 31) ? 0u : (uni & ~((2u << j) - 1u));
                if (rem) { nbr = 0; nj = __ffs((int)rem) - 1; } else { nbr = 1; nj = jb0; }
            } else {
                if (j < cur) { nbr = 1; nj = j + 1; } else { nbr = 2; nj = 0; }
            }
            if (nbr < 2) {
                const bf16_t* kb = Z + (rowb + nj * 64) * ZC + (nbr ? ZKW : ZKS) + g * 64;
                kreg = *(const u32x4*)(kb + (size_t)kkey * ZC + kch);
                vreg = *(const u32x4*)(vtb + (size_t)nbr * (8 * 2 * 64) * SEQ + nj * 64);
            }
            int klo = 0, khi = -1;
            if (br == 0) { if ((mysel >> j) & 1u) khi = t - j * 64; }
            else { khi = t - j * 64; klo = t - 511 - j * 64; }
            klo = klo < 0 ? 0 : klo;
            khi = khi > 63 ? 63 : khi;
            nsa_block_step(Ks, VT, qf, O, m, l, klo, khi, r, q);
            if (nbr != br) {
#pragma unroll
                for (int x = 0; x < 2; x++) {
                    float lt = l[x];
                    lt = xrow_sum(lt);
                    const float sc = sigmoidf_(br == 0 ? gatev[1][x] : gatev[2][x]) / lt;
#pragma unroll
                    for (int dt = 0; dt < 4; dt++) { ofl[(wave * 8 + x * 4 + dt) * 64 + lane] += sc * O[x][dt]; O[x][dt] = (f32x4){0.f, 0.f, 0.f, 0.f}; }
                    m[x] = -1e30f; l[x] = 0.f;
                }
            }
            if (nbr == 2) break;
            br = nbr; j = nj;
        }
    }
    __syncthreads();
    {
        const int hd = lane >> 3, d8 = (lane & 7) * 8, dt = d8 >> 4, q0 = (d8 & 15) >> 2;
        const f32x4* src = ofl + ((hd >> 1) * 8 + (hd & 1) * 4 + dt) * 64 + q0 * 16;
#pragma unroll
        for (int i = 0; i < 4; i++) {
            const int tk = wave * 4 + i;
            const f32x4 v0 = src[tk], v1 = src[16 + tk];
            *(u32x4*)(ydst + (rowb + t0 + tk) * ystride + g * 512 + lane * 8) = (u32x4){pack2(v0[0], v0[1]), pack2(v0[2], v0[3]), pack2(v1[0], v1[1]), pack2(v1[2], v1[3])};
        }
    }
    __syncthreads();
}

__device__ void phaseM1(const Params& p, char* lds) {
    const int tid_ = TIDX512; const int lane = tid_ & 63, wave = tid_ >> 6;
    const int wr = wave >> 2, wc = wave & 3, r = lane & 15, q = lane >> 4;
    const bf16_t* H = (const bf16_t*)(p.ws + OFF_H);
    const bf16_t* Z = (const bf16_t*)(p.ws + OFF_Z);
    bf16_t* M = (bf16_t*)(p.ws + OFF_M);
    u32x4* SG = (u32x4*)p.out;
    u32x4* PA = (u32x4*)((char*)p.out + 33554432);
    TileIter tit(4, lds);
    int bm, bn;
    while (tit.next(bm, bn)) {
        const int m0 = bm * 256, n0 = bn * 256;
        const int pbase = launder_i(((bm * 4 + bn) * 16) * 512 + tid_);
        GemmSrc g = gemm_src(H, DM, (const bf16_t*)(p.ws + OFF_WM), DM, m0, n0);
        gemm_prologue(g, lds);
        for (int br = 0; br < 2; br++) {
            f32x4 acc[8][4];
            zero_acc(acc);
            gemm_mainloop(acc, g, DM, lds);
            __syncthreads();
            g = gemm_src(Z + (br ? ZQ_N : ZR_G), ZC, (const bf16_t*)(p.ws + (br ? OFF_WB : OFF_WA)), DM, m0, n0);
            gemm_prologue(g, lds);
            {
#pragma unroll
                for (int mi = 0; mi < 8; mi++)
#pragma unroll
                    for (int nh = 0; nh < 2; nh++) {
                        const f32x4 a0 = acc[mi][2 * nh], a1 = acc[mi][2 * nh + 1];
                        SG[(size_t)launder_i(pbase + (mi * 2 + nh) * 512)] = (u32x4){pack2(sigmoidf_(a0[0]), sigmoidf_(a0[1])), pack2(sigmoidf_(a0[2]), sigmoidf_(a0[3])),
                                                                          pack2(sigmoidf_(a1[0]), sigmoidf_(a1[1])), pack2(sigmoidf_(a1[2]), sigmoidf_(a1[3]))};
                    }
            }
            zero_acc(acc);
            gemm_mainloop(acc, g, DM, lds);
            __syncthreads();
            if (br == 0) {
                g = gemm_src(H, DM, (const bf16_t*)(p.ws + OFF_WM) + (size_t)1024 * 1024, DM, m0, n0);
                gemm_prologue(g, lds);
            }
            if (br == 0) {
#pragma unroll
                for (int mi = 0; mi < 8; mi++)
#pragma unroll
                    for (int nh = 0; nh < 2; nh++) {
                        const u32x4 sg = SG[(size_t)launder_i(pbase + (mi * 2 + nh) * 512)];
                        const f32x4 a0 = acc[mi][2 * nh], a1 = acc[mi][2 * nh + 1];
                        PA[(size_t)launder_i(pbase + (mi * 2 + nh) * 512)] = (u32x4){pack2(bf_lo(sg.x) * a0[0], bf_hi(sg.x) * a0[1]), pack2(bf_lo(sg.y) * a0[2], bf_hi(sg.y) * a0[3]),
                                                                          pack2(bf_lo(sg.z) * a1[0], bf_hi(sg.z) * a1[1]), pack2(bf_lo(sg.w) * a1[2], bf_hi(sg.w) * a1[3])};
                    }
            } else {
#pragma unroll
                for (int mi = 0; mi < 8; mi++)
#pragma unroll
                    for (int nh = 0; nh < 2; nh++) {
                        const u32x4 sg = SG[(size_t)launder_i(pbase + (mi * 2 + nh) * 512)];
                        const u32x4 pv = PA[(size_t)launder_i(pbase + (mi * 2 + nh) * 512)];
                        const f32x4 a0 = acc[mi][2 * nh], a1 = acc[mi][2 * nh + 1];
                        epi_fill(lds, wr, wc, r, q, mi, 2 * nh, (f32x4){bf_lo(sg.x) * a0[0] + bf_lo(pv.x), bf_hi(sg.x) * a0[1] + bf_hi(pv.x),
                                                                         bf_lo(sg.y) * a0[2] + bf_lo(pv.y), bf_hi(sg.y) * a0[3] + bf_hi(pv.y)});
                        epi_fill(lds, wr, wc, r, q, mi, 2 * nh + 1, (f32x4){bf_lo(sg.z) * a1[0] + bf_lo(pv.z), bf_hi(sg.z) * a1[1] + bf_hi(pv.z),
                                                                             bf_lo(sg.w) * a1[2] + bf_lo(pv.w), bf_hi(sg.w) * a1[3] + bf_hi(pv.w)});
                    }
                __syncthreads();
                epi_store(lds, M, DM, m0, n0, DM);
                __syncthreads();
            }
        }
    }
}

__device__ void phaseM2(const Params& p, char* lds) {
    const int tid_ = TIDX512; const int lane = tid_ & 63, wave = tid_ >> 6;
    const int wr = wave >> 2, wc = wave & 3, r = lane & 15, q = lane >> 4;
    const bf16_t* M = (const bf16_t*)(p.ws + OFF_M);
    const float* mod = (const float*)(p.ws + OFF_MOD);
    TileIter tit(4, lds);
    int bm, bn;
    while (tit.next(bm, bn)) {
        const int m0 = bm * 256, n0 = bn * 256;
        f32x4 acc[8][4];
        zero_acc(acc);
        gemm_core(acc, M, DM, (const bf16_t*)(p.ws + OFF_WO), DM, DM, m0, n0, lds);
#pragma unroll
        for (int mi = 0; mi < 8; mi++)
#pragma unroll
            for (int ni = 0; ni < 4; ni++) {
                const int tok = m0 + wr * 128 + mi * 16 + r, col = n0 + wc * 64 + ni * 16 + 4 * q;
                const f32x4 xv = *(const f32x4*)(p.x + (size_t)tok * DM + col);
                const f32x4 gt = *(const f32x4*)(mod + (tok >> 11) * 6144 + 2 * 1024 + col);
                epi_fill(lds, wr, wc, r, q, mi, ni, xv + gt * acc[mi][ni]);
            }
        __syncthreads();
        epi_store(lds, (bf16_t*)(p.ws + OFF_X1B), DM, m0, n0, DM);
        __syncthreads();
    }
    {
        const int tid_ = TIDX; const int lane = tid_ & 63, wave = tid_ >> 6;
        unsigned char* tq = (unsigned char*)(p.ws + OFF_UB);
        float* tsc = (float*)(p.ws + OFF_UB + 33554432);
        for (int row = vblk() * 4 + wave; row < 32768; row += vgrid() * 4) {
            const bool isv = row >= 16384;
            const float* srcp = (isv ? p.peer_v : p.peer_u) + (size_t)(row & 16383) * DM + lane * 16;
            f32x4 a[4];
            float mx = 0.f;
#pragma unroll
            for (int i = 0; i < 4; i++) {
                a[i] = *(const f32x4*)(srcp + i * 4);
                mx = fmaxf(mx, fmaxf(fmaxf(fabsf(a[i][0]), fabsf(a[i][1])), fmaxf(fabsf(a[i][2]), fabsf(a[i][3]))));
            }
            mx = wave_max(mx);
            if (isv) {
                const float inv = mx > 0.f ? 6.f / mx : 0.f;
                unsigned w[2];
#pragma unroll
                for (int i = 0; i < 2; i++) {
                    unsigned t = 0u;
                    t = __builtin_amdgcn_cvt_scalef32_pk_fp4_f32(t, a[2 * i][0] * inv, a[2 * i][1] * inv, 1.0f, 0);
                    t = __builtin_amdgcn_cvt_scalef32_pk_fp4_f32(t, a[2 * i][2] * inv, a[2 * i][3] * inv, 1.0f, 1);
                    t = __builtin_amdgcn_cvt_scalef32_pk_fp4_f32(t, a[2 * i + 1][0] * inv, a[2 * i + 1][1] * inv, 1.0f, 2);
                    t = __builtin_amdgcn_cvt_scalef32_pk_fp4_f32(t, a[2 * i + 1][2] * inv, a[2 * i + 1][3] * inv, 1.0f, 3);
                    w[i] = t;
                }
                *(u32x2*)(tq + 16777216 + (size_t)(row - 16384) * 512 + lane * 8) = (u32x2){w[0], w[1]};
                if (lane == 0) tsc[2 * (row - 16384) + 1] = mx * (1.f / 6.f);
            } else {
                float ssq = 0.f;
#pragma unroll
                for (int i = 0; i < 4; i++) ssq += a[i][0] * a[i][0] + a[i][1] * a[i][1] + a[i][2] * a[i][2] + a[i][3] * a[i][3];
                ssq = wave_sum(ssq);
                mx = fminf(mx, 2.4f * sqrtf(ssq * (1.f / 1024.f)));
                const float inv = mx > 0.f ? 7.f / mx : 0.f;
                unsigned w2[2] = {0u, 0u};
#pragma unroll
                for (int i = 0; i < 4; i++)
#pragma unroll
                    for (int j = 0; j < 4; j++) {
                        const int e = i * 4 + j;
                        int qi = (int)rintf(a[i][j] * inv);
                        qi = qi > 7 ? 7 : (qi < -7 ? -7 : qi);
                        w2[e >> 3] |= (unsigned)(qi & 15) << ((e & 7) * 4);
                    }
                *(u32x2*)(tq + (size_t)row * 512 + lane * 8) = (u32x2){w2[0], w2[1]};
                if (lane == 0) tsc[2 * row] = mx * (1.f / 7.f);
            }
        }
    }
}

__device__ void phaseP1(const Params& p, char* lds) {
    const int tid_ = TIDX512; const int lane = tid_ & 63, wave = tid_ >> 6;
    const int wr = wave >> 2, wc = wave & 3, r = lane & 15, q = lane >> 4;
    const bf16_t* H = (const bf16_t*)(p.ws + OFF_H);
    bf16_t* QP = (bf16_t*)(p.ws + OFF_QP);
    TileIter tit(8, lds);
    int bm, bn;
    while (tit.next(bm, bn)) {
        const int m0 = bm * 256, n0 = bn * 256;
        f32x4 acc[8][4];
        zero_acc(acc);
        gemm_core(acc, H, DM, (const bf16_t*)(p.ws + OFF_WQ), DM, DM, m0, n0, lds);
#pragma unroll
        for (int mi = 0; mi < 8; mi++)
#pragma unroll
            for (int ni = 0; ni < 4; ni++) epi_fill(lds, wr, wc, r, q, mi, ni, acc[mi][ni]);
        __syncthreads();
        epi_store(lds, QP, 2048, m0, n0, 2048);
        __syncthreads();
    }
}

__constant__ unsigned char c_cand_a[64] = {0,0,0,0,0,0,0,0,0,0,0,0,0,0,0,0, 1,1,1,1,1,1,1,1, 2,2,2,2,2, 3,3,3,3, 4,4,4, 5,5, 6,6, 7,7, 8,9,10,11,12,13,14,15, 0,0,0,0,0,0,0,0,0,0,0,0,0,0};
__constant__ unsigned char c_cand_b[64] = {0,1,2,3,4,5,6,7,8,9,10,11,12,13,14,15, 0,1,2,3,4,5,6,7, 0,1,2,3,4, 0,1,2,3, 0,1,2, 0,1, 0,1, 0,1, 0,0,0,0,0,0,0,0, 0,0,0,0,0,0,0,0,0,0,0,0,0,0};

__device__ __forceinline__ unsigned f2key(float f) { const unsigned u = __float_as_uint(f); return (u & 0x80000000u) ? ~u : (u | 0x80000000u); }
__device__ __forceinline__ float key2f(unsigned k) { const unsigned u = (k & 0x80000000u) ? (k & 0x7fffffffu) : ~k; return __uint_as_float(u); }
__device__ __forceinline__ void cex_desc(unsigned& a, unsigned& b) { const unsigned hi = a > b ? a : b, lo = a > b ? b : a; a = hi; b = lo; }
__device__ __forceinline__ void sort16_desc(unsigned (&a)[16]) {
    cex_desc(a[0], a[13]); cex_desc(a[1], a[12]); cex_desc(a[2], a[15]); cex_desc(a[3], a[14]); cex_desc(a[4], a[8]); cex_desc(a[5], a[6]); cex_desc(a[7], a[11]); cex_desc(a[9], a[10]);
    cex_desc(a[0], a[5]); cex_desc(a[1], a[7]); cex_desc(a[2], a[9]); cex_desc(a[3], a[4]); cex_desc(a[6], a[13]); cex_desc(a[8], a[14]); cex_desc(a[10], a[15]); cex_desc(a[11], a[12]);
    cex_desc(a[0], a[1]); cex_desc(a[2], a[3]); cex_desc(a[4], a[5]); cex_desc(a[6], a[8]); cex_desc(a[7], a[9]); cex_desc(a[10], a[11]); cex_desc(a[12], a[13]); cex_desc(a[14], a[15]);
    cex_desc(a[0], a[2]); cex_desc(a[1], a[3]); cex_desc(a[4], a[10]); cex_desc(a[5], a[11]); cex_desc(a[6], a[7]); cex_desc(a[8], a[9]); cex_desc(a[12], a[14]); cex_desc(a[13], a[15]);
    cex_desc(a[1], a[2]); cex_desc(a[3], a[12]); cex_desc(a[4], a[6]); cex_desc(a[5], a[7]); cex_desc(a[8], a[10]); cex_desc(a[9], a[11]); cex_desc(a[13], a[14]);
    cex_desc(a[1], a[4]); cex_desc(a[2], a[6]); cex_desc(a[5], a[8]); cex_desc(a[7], a[10]); cex_desc(a[9], a[13]); cex_desc(a[11], a[14]);
    cex_desc(a[2], a[4]); cex_desc(a[3], a[6]); cex_desc(a[9], a[12]); cex_desc(a[11], a[13]);
    cex_desc(a[3], a[5]); cex_desc(a[6], a[8]); cex_desc(a[7], a[9]); cex_desc(a[10], a[12]);
    cex_desc(a[3], a[4]); cex_desc(a[5], a[6]); cex_desc(a[7], a[8]); cex_desc(a[9], a[10]); cex_desc(a[11], a[12]);
    cex_desc(a[6], a[7]); cex_desc(a[8], a[9]);
}
__device__ __forceinline__ void merge16_desc(unsigned (&a)[16], const unsigned (&b)[16]) {
#pragma unroll
    for (int i = 0; i < 16; i++) a[i] = a[i] > b[15 - i] ? a[i] : b[15 - i];
#pragma unroll
    for (int j = 8; j > 0; j >>= 1)
#pragma unroll
        for (int i = 0; i < 16; i++) { const int l = i ^ j; if (l > i) cex_desc(a[i], a[l]); }
}

__device__ __forceinline__ void p2_xmerge16(unsigned (&L)[16]) {
    {
        unsigned A[16], B[16];
#pragma unroll
        for (int k = 0; k < 16; k++) { const auto s = __builtin_amdgcn_permlane16_swap(L[k], L[k], false, false); A[k] = s[0]; B[k] = s[1]; }
        merge16_desc(A, B);
#pragma unroll
        for (int k = 0; k < 16; k++) L[k] = A[k];
    }
    {
        unsigned A[16], B[16];
#pragma unroll
        for (int k = 0; k < 16; k++) { const auto s = __builtin_amdgcn_permlane32_swap(L[k], L[k], false, false); A[k] = s[0]; B[k] = s[1]; }
        merge16_desc(A, B);
#pragma unroll
        for (int k = 0; k < 16; k++) L[k] = A[k];
    }
}
__device__ void phaseP2_group(const Params& p, int task0, int stride, int ntask, char* lds) {
    const int tid = TIDX, lane = tid & 63, r = lane & 15, q = lane >> 4;
    const int wave = __builtin_amdgcn_readfirstlane(tid >> 6);
    const int h = task0 & 7;
    const bf16_t* QP = (const bf16_t*)(p.ws + OFF_QP);
    char* KL = lds;
    unsigned* LL4 = (unsigned*)(lds + 32768);
#pragma unroll 1
    for (int half = 0; half < 2; half++) {
        __syncthreads();
        {
            const int c = tid & 15, r0 = tid >> 4;
            const bf16_t* KB = (const bf16_t*)(p.ws + OFF_K1B) + (size_t)half * 131072 + (size_t)h * 128 * 128;
            u32x4 kv[8];
#pragma unroll
            for (int ps = 0; ps < 8; ps++) kv[ps] = *(const u32x4*)(KB + (size_t)(ps * 16 + r0) * 128 + c * 8);
#pragma unroll
            for (int ps = 0; ps < 8; ps++) { const int R = ps * 16 + r0; *(u32x4*)(KL + R * 256 + ((c ^ (R & 15)) * 16)) = kv[ps]; }
        }
        bf16x8 bqc[4];
        {
            const bf16_t* qrow = QP + (size_t)((task0 >> 3) * 64 + wave * 16 + r) * 2048 + h * 256 + half * 128 + q * 8;
#pragma unroll
            for (int ks = 0; ks < 4; ks++) bqc[ks] = *(const bf16x8*)(qrow + ks * 32);
        }
        __syncthreads();
#pragma unroll 1
        for (int tk = 0; tk < ntask; tk++) {
            bf16x8 bqn[4];
            if (tk + 1 < ntask) {
                const bf16_t* qrow = QP + (size_t)(((task0 + (tk + 1) * stride) >> 3) * 64 + wave * 16 + r) * 2048 + h * 256 + half * 128 + q * 8;
#pragma unroll
                for (int ks = 0; ks < 4; ks++) bqn[ks] = *(const bf16x8*)(qrow + ks * 32);
            }
            f32x4 acc[8];
#pragma unroll
            for (int nt = 0; nt < 8; nt++) acc[nt] = (f32x4){0.f, 0.f, 0.f, 0.f};
#pragma unroll
            for (int ks = 0; ks < 4; ks++)
#pragma unroll
                for (int nt = 0; nt < 8; nt++) {
                    const bf16x8 ak = *(const bf16x8*)(KL + (nt * 16 + r) * 256 + (((ks * 4 + q) ^ r) * 16));
                    acc[nt] = mfma16(ak, bqc[ks], acc[nt]);
                }
            unsigned L[16], G[16];
#pragma unroll
            for (int nt = 0; nt < 4; nt++)
#pragma unroll
                for (int j = 0; j < 4; j++) {
                    L[nt * 4 + j] = (f2key(acc[nt][j]) & ~127u) | (unsigned)(127 - (nt * 16 + 4 * q + j));
                    G[nt * 4 + j] = (f2key(acc[nt + 4][j]) & ~127u) | (unsigned)(127 - ((nt + 4) * 16 + 4 * q + j));
                }
            sort16_desc(L);
            sort16_desc(G);
            merge16_desc(L, G);
            p2_xmerge16(L);
            if (q == 0) {
#pragma unroll
                for (int k = 0; k < 16; k++) LL4[((tk * 2 + half) * 16 + k) * 64 + wave * 16 + r] = L[k];
            }
            if (tk + 1 < ntask) {
#pragma unroll
                for (int ks = 0; ks < 4; ks++) bqc[ks] = bqn[ks];
            }
        }
    }
    __syncthreads();
    if (wave < ntask) {
        const unsigned* LL = LL4 + wave * 2 * 16 * 64;
        const int tok0 = ((task0 + wave * stride) >> 3) * 64;
        const int tk = lane;
        float v1[16], v2[16];
#pragma unroll
        for (int k = 0; k < 16; k++) { v1[k] = key2f(LL[k * 64 + tk] & ~127u); v2[k] = key2f(LL[(16 + k) * 64 + tk] & ~127u); }
        unsigned C[64];
#pragma unroll
        for (int k = 0; k < 64; k++) C[k] = 0u;
        {
            int c = 0;
#pragma unroll
            for (int a = 0; a < 16; a++)
#pragma unroll
                for (int b = 0; b < 16; b++)
                    if ((a + 1) * (b + 1) <= 16) { C[c] = (f2key(v1[a] + v2[b]) & ~63u) | (unsigned)(63 - c); c++; }
        }
        unsigned T[16];
#pragma unroll
        for (int k = 0; k < 16; k++) T[k] = C[k];
        sort16_desc(T);
#pragma unroll
        for (int gq = 1; gq < 4; gq++) {
            unsigned G[16];
#pragma unroll
            for (int k = 0; k < 16; k++) G[k] = C[gq * 16 + k];
            sort16_desc(G);
            merge16_desc(T, G);
        }
        const float mx = key2f(T[0] & ~63u);
        float e[16], sum = 0.f;
#pragma unroll
        for (int k = 0; k < 16; k++) { e[k] = __expf(key2f(T[k] & ~63u) - mx); sum += e[k]; }
        const float inv = 1.f / sum;
        int ei[16];
#pragma unroll
        for (int k = 0; k < 16; k++) {
            const int cc = 63 - (int)(T[k] & 63u);
            const int a = c_cand_a[cc], b = c_cand_b[cc];
            const int i1 = 127 - (int)(LL[a * 64 + tk] & 127u), i2 = 127 - (int)(LL[(16 + b) * 64 + tk] & 127u);
            ei[k] = i1 * 128 + i2;
            e[k] *= inv;
        }
        int* eidx = (int*)(p.ws + OFF_EIDX) + (size_t)(tok0 + tk) * 128 + h * 16;
        float* gw = (float*)(p.ws + OFF_GW) + (size_t)(tok0 + tk) * 128 + h * 16;
#pragma unroll
        for (int k4 = 0; k4 < 4; k4++) {
            *(u32x4*)(eidx + k4 * 4) = (u32x4){(unsigned)ei[k4 * 4], (unsigned)ei[k4 * 4 + 1], (unsigned)ei[k4 * 4 + 2], (unsigned)ei[k4 * 4 + 3]};
            *(f32x4*)(gw + k4 * 4) = (f32x4){e[k4 * 4], e[k4 * 4 + 1], e[k4 * 4 + 2], e[k4 * 4 + 3]};
        }
    }
}

__device__ __forceinline__ float ub0(unsigned w) { return (float)(w & 0xffu); }
__device__ __forceinline__ float ub1(unsigned w) { return (float)((w >> 8) & 0xffu); }
__device__ __forceinline__ float ub2(unsigned w) { return (float)((w >> 16) & 0xffu); }
__device__ __forceinline__ float ub3(unsigned w) { return (float)(w >> 24); }
struct P3Sc { float su, sv, gm; };
constexpr int P3_REC = 2560;
__device__ __forceinline__ void p3_load_u(u32x2 (&ur)[4], P3Sc& sc, const unsigned char* __restrict__ UQ, const float* __restrict__ tsc,
                                          int lane, int ul, int g, const unsigned* rec) {
#pragma unroll
    for (int u = 0; u < 4; u++) ur[u] = *(const u32x2*)(UQ + (size_t)rec[4 * g + u] * 512 + lane * 8);
    sc.gm = __uint_as_float(rec[128 + 4 * g + ul]);
    sc.su = __uint_as_float(rec[512 + 4 * g + ul]);
    sc.sv = 1.f;
}
__device__ __forceinline__ void p3_load_v(u32x2 (&vr)[4], const unsigned char* __restrict__ VQ, int lane, int g, const unsigned* rec) {
#pragma unroll
    for (int u = 0; u < 4; u++) vr[u] = *(const u32x2*)(VQ + (size_t)rec[4 * g + u] * 512 + lane * 8);
}
__device__ __forceinline__ void p3_dots(const u32x2 (&ur)[4], const unsigned* rec, int lane, int (&pt)[4]) {
    const u32x4 qh = *(const u32x4*)(rec + 256 + lane * 4);
#pragma unroll
    for (int u = 0; u < 4; u++) {
        const int w0 = (int)ur[u].x, w1 = (int)ur[u].y;
        int dh = __builtin_amdgcn_sdot8(w0, (int)qh.x, 0, false);
        dh = __builtin_amdgcn_sdot8(w1, (int)qh.z, dh, false);
        int dl = __builtin_amdgcn_sdot8(w0, (int)qh.y, 0, false);
        dl = __builtin_amdgcn_sdot8(w1, (int)qh.w, dl, false);
        pt[u] = (dh << 4) + dl;
    }
}
template <int CTRL> __device__ __forceinline__ int dpp_i(int v) { return __builtin_amdgcn_mov_dpp(v, CTRL, 0xF, 0xF, true); }
__device__ __forceinline__ int xrow_sum_i(int v) {
    const auto a = __builtin_amdgcn_permlane16_swap((unsigned)v, (unsigned)v, false, false);
    v = (int)a[0] + (int)a[1];
    const auto b = __builtin_amdgcn_permlane32_swap((unsigned)v, (unsigned)v, false, false);
    return (int)b[0] + (int)b[1];
}
__device__ __forceinline__ float p3_weight(const int (&pt)[4], int lane, float sh, int hs8, const P3Sc& sc) {
    int m2[2], m1;
    const bool c0 = lane & 1;
#pragma unroll
    for (int j = 0; j < 2; j++) { const int keep = c0 ? pt[j + 2] : pt[j], send = c0 ? pt[j] : pt[j + 2]; m2[j] = keep + dpp_i<0xB1>(send); }
    const bool c1 = lane & 2;
    { const int keep = c1 ? m2[1] : m2[0], send = c1 ? m2[0] : m2[1]; m1 = keep + dpp_i<0x4E>(send); }
    m1 += dpp_i<0x124>(m1);
    m1 += dpp_i<0x128>(m1);
    m1 = xrow_sum_i(m1);
    const float aval = (float)(m1 - hs8) * sc.su;
    return sc.gm * gelu_erf(aval);
}
__device__ __forceinline__ void p3_axpy(const u32x2 (&vr)[4], float ws, f32x2 (&acc)[8]) {
#pragma unroll
    for (int u = 0; u < 4; u++) {
        const int la = ((u >> 1) & 1) | ((u & 1) << 1);
        const float wu = __builtin_bit_cast(float, __builtin_amdgcn_readlane(__builtin_bit_cast(int, ws), la));
        const f32x2 w2 = {wu, wu};
        const unsigned vw[2] = {vr[u].x, vr[u].y};
#pragma unroll
        for (int i = 0; i < 2; i++) {
            acc[i * 4 + 0] = __builtin_elementwise_fma(w2, __builtin_amdgcn_cvt_scalef32_pk_f32_fp4(vw[i], 1.0f, 0), acc[i * 4 + 0]);
            acc[i * 4 + 1] = __builtin_elementwise_fma(w2, __builtin_amdgcn_cvt_scalef32_pk_f32_fp4(vw[i], 1.0f, 1), acc[i * 4 + 1]);
            acc[i * 4 + 2] = __builtin_elementwise_fma(w2, __builtin_amdgcn_cvt_scalef32_pk_f32_fp4(vw[i], 1.0f, 2), acc[i * 4 + 2]);
            acc[i * 4 + 3] = __builtin_elementwise_fma(w2, __builtin_amdgcn_cvt_scalef32_pk_f32_fp4(vw[i], 1.0f, 3), acc[i * 4 + 3]);
        }
    }
}
__device__ __forceinline__ void p3_token(const Params& p, int tok, int lane, unsigned* rec, float& sh, int& hs8) {
    const bf16_t* H = (const bf16_t*)(p.ws + OFF_H);
    const int* eidx = (const int*)(p.ws + OFF_EIDX);
    const float* gwp = (const float*)(p.ws + OFF_GW);
    {
        const u32x4 a = *(const u32x4*)(H + (size_t)tok * DM + lane * 16), b = *(const u32x4*)(H + (size_t)tok * DM + lane * 16 + 8);
        const unsigned hw[8] = {a.x, a.y, a.z, a.w, b.x, b.y, b.z, b.w};
        float hv[16];
        float mx = 0.f;
#pragma unroll
        for (int i = 0; i < 8; i++) { hv[2 * i] = bf_lo(hw[i]); hv[2 * i + 1] = bf_hi(hw[i]); mx = fmaxf(mx, fmaxf(fabsf(hv[2 * i]), fabsf(hv[2 * i + 1]))); }
        mx = wave_max(mx);
        const float inv = mx > 0.f ? 119.f / mx : 0.f;
        sh = mx * (1.f / 119.f);
        unsigned qh[4] = {0u, 0u, 0u, 0u};
#pragma unroll
        for (int e = 0; e < 16; e++) {
            const int qi = (int)rintf(hv[e] * inv);
            const int hh = (qi + 8) >> 4, hl = qi - 16 * hh;
            qh[(e >> 3) * 2] |= (unsigned)(hh & 15) << ((e & 7) * 4);
            qh[(e >> 3) * 2 + 1] |= (unsigned)(hl & 15) << ((e & 7) * 4);
        }
        hs8 = 0;
        *(u32x4*)(rec + 256 + lane * 4) = (u32x4){qh[0], qh[1], qh[2], qh[3]};
    }
    const int e0 = eidx[(size_t)tok * 128 + lane], e1 = eidx[(size_t)tok * 128 + 64 + lane];
    const float g0 = gwp[(size_t)tok * 128 + lane], g1 = gwp[(size_t)tok * 128 + 64 + lane];
    const int k0 = e0 >> 11, k1 = e1 >> 11;
    int pos0 = 0, pos1 = 0, base = 0;
#pragma unroll
    for (int v = 0; v < 8; v++) {
        const unsigned long long m0 = __ballot(k0 == v), m1 = __ballot(k1 == v);
        const int c0 = __popcll(m0);
        const int r0 = __builtin_amdgcn_mbcnt_hi((unsigned)(m0 >> 32), __builtin_amdgcn_mbcnt_lo((unsigned)m0, 0u));
        const int r1 = __builtin_amdgcn_mbcnt_hi((unsigned)(m1 >> 32), __builtin_amdgcn_mbcnt_lo((unsigned)m1, 0u));
        pos0 = (k0 == v) ? base + r0 : pos0;
        pos1 = (k1 == v) ? base + c0 + r1 : pos1;
        base += c0 + __popcll(m1);
    }
    const float* tsc = (const float*)(p.ws + OFF_UB + 33554432);
    const f32x2 s0 = *(const f32x2*)(tsc + 2 * e0), s1 = *(const f32x2*)(tsc + 2 * e1);
    rec[pos0] = (unsigned)e0; rec[pos1] = (unsigned)e1;
    rec[128 + pos0] = __float_as_uint(g0 * s0[1]); rec[128 + pos1] = __float_as_uint(g1 * s1[1]);
    rec[512 + pos0] = __float_as_uint(sh * s0[0]); rec[512 + pos1] = __float_as_uint(sh * s1[0]);
}
__device__ __forceinline__ void p3_finish(const Params& p, float* dstp, int tok, int lane, const f32x2 (&acc)[8], float* tr) {
    const float* mod = (const float*)(p.ws + OFF_MOD);
    const int b = tok >> 11;
    float own[16];
#pragma unroll
    for (int i = 0; i < 16; i++) own[i] = acc[i >> 1][i & 1];
    const int d0 = lane * 16;
    float x2[16];
    float ss = 0.f;
    const bf16_t* x1b = (const bf16_t*)(p.ws + OFF_X1B) + (size_t)tok * DM + d0;
    const u32x4 xa = *(const u32x4*)x1b, xb = *(const u32x4*)(x1b + 8);
    const unsigned xw[8] = {xa.x, xa.y, xa.z, xa.w, xb.x, xb.y, xb.z, xb.w};
#pragma unroll
    for (int i = 0; i < 4; i++) {
        const int d = d0 + i * 4;
        const f32x4 xv = {bf_lo(xw[2 * i]), bf_hi(xw[2 * i]), bf_lo(xw[2 * i + 1]), bf_hi(xw[2 * i + 1])};
        const f32x4 gt = *(const f32x4*)(mod + b * 6144 + 5 * 1024 + d);
#pragma unroll
        for (int j = 0; j < 4; j++) { const float v = xv[j] + gt[j] * own[i * 4 + j]; x2[i * 4 + j] = v; ss += v * v; }
    }
    ss = wave_sum(ss);
    const float rstd = rsqrtf(ss * (1.f / 1024.f) + 1e-6f);
#pragma unroll
    for (int i = 0; i < 4; i++) {
        const int d = d0 + i * 4;
        const f32x4 fg = *(const f32x4*)(p.final_g + d);
        f32x4 o;
#pragma unroll
        for (int j = 0; j < 4; j++) o[j] = x2[i * 4 + j] * rstd * fg[j];
        *(f32x4*)(tr + d) = o;
    }
    __builtin_amdgcn_fence(__ATOMIC_RELEASE, "wavefront");
    __builtin_amdgcn_wave_barrier();
    __builtin_amdgcn_fence(__ATOMIC_ACQUIRE, "wavefront");
#pragma unroll
    for (int j = 0; j < 4; j++) {
        const f32x4 v = *(const f32x4*)(tr + j * 256 + lane * 4);
        *(f32x4*)(dstp + (size_t)tok * DM + j * 256 + lane * 4) = v;
    }
    __builtin_amdgcn_wave_barrier();
}
__device__ void phaseP3(const Params& p, float* dstp, char* lds) {
    const int tid_ = TIDX; const int lane = tid_ & 63, wave = tid_ >> 6;
    const unsigned char* UQ = (const unsigned char*)(p.ws + OFF_UB);
    const unsigned char* VQ = UQ + 16777216;
    const float* tsc = (const float*)(p.ws + OFF_UB + 33554432);
    const int ul = ((lane & 1) << 1) | ((lane >> 1) & 1);
    constexpr int TPW = 2;
    unsigned* recs = (unsigned*)(lds + wave * TPW * P3_REC);
    for (int tb = (vblk() * 4 + wave) * TPW; tb < NTOK; tb += vgrid() * 4 * TPW) {
        float sh[TPW];
        f32x2 acc[TPW][8];
        int hs8[TPW];
        __builtin_amdgcn_wave_barrier();
#pragma unroll
        for (int k = 0; k < TPW; k++) {
            p3_token(p, tb + k, lane, recs + k * (P3_REC / 4), sh[k], hs8[k]);
#pragma unroll
            for (int i = 0; i < 8; i++) acc[k][i] = (f32x2){0.f, 0.f};
        }
        __builtin_amdgcn_wave_barrier();
        u32x2 ur[TPW][4];
        u32x2 vr[TPW][4];
        P3Sc sc[TPW];
#pragma unroll
        for (int k = 0; k < TPW; k++) {
            p3_load_u(ur[k], sc[k], UQ, tsc, lane, ul, 0, recs + k * (P3_REC / 4));
            p3_load_v(vr[k], VQ, lane, 0, recs + k * (P3_REC / 4));
        }
        for (int g = 0; g < 32; g++) {
#pragma unroll
            for (int k = 0; k < TPW; k++) {
                int pt[4];
                p3_dots(ur[k], recs + k * (P3_REC / 4), lane, pt);
                const P3Sc sck = sc[k];
                if (g + 1 < 32) p3_load_u(ur[k], sc[k], UQ, tsc, lane, ul, g + 1, recs + k * (P3_REC / 4));
                const float w = p3_weight(pt, lane, sh[k], hs8[k], sck);
                p3_axpy(vr[k], w, acc[k]);
                if (g + 1 < 32) p3_load_v(vr[k], VQ, lane, g + 1, recs + k * (P3_REC / 4));
            }
        }
#pragma unroll
        for (int k = 0; k < TPW; k++) p3_finish(p, dstp, tb + k, lane, acc[k], (float*)recs);
    }
}

#define XB_TMO      128
#define XB_XCNT(j)  (256  + 64 * (j))
#define XB_XSUB(j)  (1280 + 64 * (j))
#define XB_XGEN(j)  (2304 + 64 * (j))
#define XB_TOP      3328
#define XB_TOPGEN   3392
#define XCD_BAR_WORDS 3456
#define XB_SPIN_CAP (1u << 22)
#define LAS __attribute__((address_space(3)))
__device__ __forceinline__ unsigned xb_ld(unsigned* p)              { return __hip_atomic_load(p, __ATOMIC_RELAXED, __HIP_MEMORY_SCOPE_AGENT); }
__device__ __forceinline__ unsigned xb_add(unsigned* p, unsigned v) { return __hip_atomic_fetch_add(p, v, __ATOMIC_RELAXED, __HIP_MEMORY_SCOPE_AGENT); }
__device__ __forceinline__ unsigned xb_xcc_id() { return (unsigned)__builtin_amdgcn_s_getreg((3 << 11) | 20) & 0xFu; }
#define XB_SPIN(cond, bar) do { unsigned _sp = 0; while (cond) { __builtin_amdgcn_s_sleep(1); \
    if ((++_sp & 255u) == 0u) { if (xb_ld(&(bar)[XB_TMO])) break; if (_sp > XB_SPIN_CAP) { atomicAdd(&(bar)[XB_TMO], 1u); break; } } } } while (0)
struct XcdBarrier { unsigned* bar; unsigned x; volatile LAS unsigned* st; };
__device__ __forceinline__ XcdBarrier xcd_barrier_post(unsigned* bar, volatile LAS unsigned* st) {
    XcdBarrier b; b.bar = bar; b.x = xb_xcc_id(); b.st = st;
    if (threadIdx.x == 0) { st[2] = xb_add(&bar[XB_XCNT(b.x)], 1u); st[4] = b.x; }
    return b;
}
__device__ __forceinline__ void xcd_barrier_complete(unsigned* bar, unsigned x, unsigned& nloc, unsigned& nx, unsigned& bal) {
    const unsigned G = gridDim.x * gridDim.y * gridDim.z;
    unsigned sum, cnt, mine, c64, sp = 0u;
    for (;;) {
        sum = 0u; cnt = 0u; mine = 0u; c64 = 0u;
#pragma unroll
        for (unsigned j = 0; j < 16; ++j) { const unsigned c = xb_ld(&bar[XB_XCNT(j)]); sum += c; cnt += (c > 0u) ? 1u : 0u; c64 += (j < 8 && c == 64u) ? 1u : 0u; mine = (j == x) ? c : mine; }
        if (sum == G) break;
        __builtin_amdgcn_s_sleep(1);
        if ((++sp & 255u) == 0u) { if (xb_ld(&bar[XB_TMO])) break; if (sp > XB_SPIN_CAP) { atomicAdd(&bar[XB_TMO], 1u); break; } }
    }
    nloc = mine > 0u ? mine : 1u; nx = cnt > 0u ? cnt : 1u; bal = (sum == G && cnt == 8u && c64 == 8u) ? 1u : 0u;
}
__device__ __forceinline__ void xcd_barrier(const XcdBarrier& b) {
    asm volatile("s_waitcnt vmcnt(0)" ::: "memory");
    __syncthreads();
    if (threadIdx.x == 0) {
        unsigned* bar = b.bar;
        __builtin_amdgcn_s_waitcnt(0);
        unsigned nloc = b.st[0], nx = b.st[1];
        if (nloc == 0u) { unsigned bal; xcd_barrier_complete(bar, b.x, nloc, nx, bal); b.st[0] = nloc; b.st[1] = nx; b.st[3] = bal; }
        const unsigned old = xb_add(&bar[XB_XSUB(b.x)], 1u);
        const unsigned gen = old / nloc;
        if (old + 1u == (gen + 1u) * nloc) {
            __builtin_amdgcn_fence(__ATOMIC_RELEASE, "agent");
            asm volatile("s_waitcnt vmcnt(0)" ::: "memory");
            const unsigned og = xb_add(&bar[XB_TOP], 1u);
            const unsigned tg = og / nx;
            if (og + 1u == (tg + 1u) * nx) xb_add(&bar[XB_TOPGEN], 1u);
            else XB_SPIN(xb_ld(&bar[XB_TOPGEN]) == tg, bar);
            __builtin_amdgcn_fence(__ATOMIC_ACQUIRE, "agent");
            xb_add(&bar[XB_XGEN(b.x)], 1u);
            asm volatile("s_waitcnt vmcnt(0)" ::: "memory");
        } else {
            XB_SPIN(xb_ld(&bar[XB_XGEN(b.x)]) == gen, bar);
            __builtin_amdgcn_fence(__ATOMIC_ACQUIRE, "agent");
            asm volatile("s_waitcnt vmcnt(0)" ::: "memory");
        }
    }
    __syncthreads();
}

typedef __attribute__((address_space(4))) const Params* KParamsPtr;
__device__ __forceinline__ const Params& fresh_params() {
    KParamsPtr kp = (KParamsPtr)__builtin_amdgcn_kernarg_segment_ptr();
    asm volatile("" : "+s"(kp));
    return *(const Params*)kp;
}
#define PF fresh_params()
__global__ void __launch_bounds__(BLOCK_THREADS, 2) mega(Params p_unused) {
    __shared__ __attribute__((aligned(16))) char lds[LDS_BYTES];
    cg::grid_group grid = cg::this_grid();
    volatile LAS unsigned* st = (volatile LAS unsigned*)(lds + 2 * LDS_MAIN);
    if (threadIdx.x < 16) st[threadIdx.x] = 0u;
    __syncthreads();
    XcdBarrier xb = xcd_barrier_post((unsigned*)PF.ws, st);
    char* hl = lds + half_id() * LDS_MAIN;
    volatile unsigned* uex = (volatile unsigned*)(lds + 2 * LDS_MAIN + 32);

    phaseA(PF, hl);
    if (PF.ws == nullptr) grid.sync();
    xcd_barrier(xb);
    { const Params& q_ = PF; phase_modnorm(q_, q_.x, nullptr, q_.norm1_g, 0, 1, (bf16_t*)(q_.ws + OFF_H)); };
    xcd_barrier(xb);
    phaseC(PF, lds);
    xcd_barrier(xb);
    for (int task = vblk(); task < 1024; task += vgrid()) phaseG1_task(PF, task, hl);
    for (int task = blockIdx.x; task < 256; task += gridDim.x) phaseN1_wg(PF, task, lds);
    xcd_barrier(xb);
    phaseG2(PF);
    phaseA2(PF, hl);
    xcd_barrier(xb);
    for (int task = vblk(); task < 2048; task += vgrid()) phaseN2_task(PF, task, hl, (bf16_t*)(PF.ws + OFF_Z) + ZQ_N, ZC, uex, lds);
    for (int task = vblk(); task < 1024; task += vgrid()) phaseG3_task(PF, task, hl, (bf16_t*)(PF.ws + OFF_Z) + ZR_G, ZC);
    xcd_barrier(xb);
    phaseM1(PF, lds);
    xcd_barrier(xb);
    phaseM2(PF, lds);
    xcd_barrier(xb);
    { const Params& q_ = PF; phase_modnorm(q_, q_.x, (const bf16_t*)(q_.ws + OFF_X1B), q_.norm2_g, 3, 4, (bf16_t*)(q_.ws + OFF_H)); };
    xcd_barrier(xb);
    phaseP1(PF, lds);
    xcd_barrier(xb);
    {
        const int vg = vgrid(), gsz = (vg & 7) == 0 ? 4 : 1;
        for (int t0 = vblk(); t0 < 2048; t0 += gsz * vg) {
            const int rem = (2048 - t0 + vg - 1) / vg;
            phaseP2_group(PF, t0, vg, rem < gsz ? rem : gsz, hl);
        }
    }
    xcd_barrier(xb);
    { const Params& q_ = PF; phaseP3(q_, q_.out, hl); };
}

extern "C" void kernel_launch(void* const* d_in, const int* in_sizes, int n_in, void* d_out, int out_size, void* d_ws, size_t ws_size, hipStream_t stream) {
    Params p{};
    p.x = (const float*)d_in[0]; p.c = (const float*)d_in[1]; p.pos = (const int*)d_in[2]; p.ada_w = (const float*)d_in[3]; p.ada_b = (const float*)d_in[4];
    p.norm1_g = (const float*)d_in[5]; p.norm2_g = (const float*)d_in[6]; p.final_g = (const float*)d_in[7]; p.w_in = (const float*)d_in[8];
    p.gla_wa2 = (const float*)d_in[9]; p.gla_ba2 = (const float*)d_in[10]; p.gla_norm_g = (const float*)d_in[11]; p.pe_k = (const float*)d_in[12]; p.pe_v = (const float*)d_in[13];
    p.ck_w1 = (const float*)d_in[14]; p.ck_w2 = (const float*)d_in[15]; p.cv_w1 = (const float*)d_in[16]; p.cv_w2 = (const float*)d_in[17];
    p.w_branch_a = (const float*)d_in[18]; p.w_branch_b = (const float*)d_in[19]; p.w_out = (const float*)d_in[20]; p.peer_wq = (const float*)d_in[21];
    p.peer_k1 = (const float*)d_in[22]; p.peer_k2 = (const float*)d_in[23]; p.peer_u = (const float*)d_in[24]; p.peer_v = (const float*)d_in[25];
    p.out = (float*)d_out; p.ws = (char*)d_ws;
    static int grid_blocks = 0;
    if (!grid_blocks) {
        int dev = 0, cus = 0, per_cu = 0;
        hipGetDevice(&dev);
        hipDeviceGetAttribute(&cus, hipDeviceAttributeMultiprocessorCount, dev);
        hipOccupancyMaxActiveBlocksPerMultiprocessor(&per_cu, mega, BLOCK_THREADS, 0);
        if (per_cu > 1) per_cu = 1;
        if (per_cu < 1) per_cu = 1;
        grid_blocks = cus * per_cu;
    }
    hipMemsetAsync(d_ws, 0, XCD_BAR_WORDS * 4, stream);
    void* args[] = {&p};
    hipError_t e = hipLaunchCooperativeKernel((void*)mega, dim3(grid_blocks), dim3(BLOCK_THREADS), args, 0, stream);
    if (e != hipSuccess) fprintf(stderr, "cooperative launch failed: %s (grid %d)\n", hipGetErrorString(e), grid_blocks);
}
```
